# Optimizing an MI355X kernel written in HIP

```python
import math
import jax, jax.numpy as jnp
from jax import lax
import numpy as np

D_MODEL = 1024
BATCH = 2
SEQ = 8192
DEPTH = 2

HEAD_DIM = 64
MIX_WIDTH = D_MODEL
N_MIXERS = 4
HEADS_PER_MIXER = MIX_WIDTH // (N_MIXERS * HEAD_DIM)
GROUP_WIDTH = HEADS_PER_MIXER * HEAD_DIM
N_HEADS_TOTAL = N_MIXERS * HEADS_PER_MIXER
QUERY_BLOCK = 128
NUM_BUCKETS = 32
REL_MAX_DIST = 2048
DILATED_CONFIGS = ((128, 1), (512, 4), (2048, 16))
SWA_WINDOW = 128
SWA_KV_HEADS = HEADS_PER_MIXER // 2
DIFF_QK_DIM = HEAD_DIM // 2
CMP_LEN = 32
CMP_STRIDE = 16
CMP_HIDDEN = 256
SLC_BLOCK = 64
SLC_TOPK = 16
NSA_WINDOW = 512
NSA_BRANCHES = 3
RMS_EPS = 1e-6
NEG_INF = -1e30
FORCE_SELECT = 1e9
TINY = 1e-30
PROJ_SIZES = (
    GROUP_WIDTH, GROUP_WIDTH, GROUP_WIDTH,
    GROUP_WIDTH, SWA_KV_HEADS * HEAD_DIM, SWA_KV_HEADS * HEAD_DIM,
    GROUP_WIDTH, GROUP_WIDTH, GROUP_WIDTH,
    GROUP_WIDTH, HEAD_DIM, HEAD_DIM, HEAD_DIM, HEAD_DIM, HEAD_DIM, HEAD_DIM,
    HEADS_PER_MIXER * NSA_BRANCHES,
    MIX_WIDTH,
)
PROJ_WIDTH = sum(PROJ_SIZES)

kernel_name = 'hybrid_parallel_heads_dilated_swa_diff_nsa'


def rms_norm(t, g):
    tf = t.astype(jnp.float32)
    y = tf * lax.rsqrt(jnp.mean(tf * tf, axis=-1, keepdims=True) + RMS_EPS) * g.astype(jnp.float32)
    return y.astype(t.dtype)


def t5_bucket(dist):
    n = jnp.maximum(dist, 0)
    max_exact = NUM_BUCKETS // 2
    nf = jnp.maximum(n, 1).astype(jnp.float32)
    large = max_exact + (jnp.log(nf / max_exact) / math.log(REL_MAX_DIST / max_exact)
                         * (NUM_BUCKETS - max_exact)).astype(jnp.int32)
    large = jnp.minimum(large, NUM_BUCKETS - 1)
    return jnp.where(n < max_exact, n, large)


def rel_bias(dist, table_h):
    return jnp.take(table_h, t5_bucket(dist), axis=0).astype(jnp.float32)


def masked_probs(s, valid, sink=None):
    s = jnp.where(valid, s, NEG_INF)
    m = jnp.max(s, axis=-1, keepdims=True)
    if sink is not None:
        m = jnp.maximum(m, sink)
    p = jnp.exp(s - m) * valid
    den = jnp.sum(p, axis=-1, keepdims=True)
    if sink is not None:
        den = den + jnp.exp(sink - m)
    return p, m, den


def banded_attention(q, k, v, table_h, max_dist, dist_scale=1, sink=None):
    bt, nh, seq_len, dh = q.shape
    n_prev = -(-max_dist // QUERY_BLOCK)
    nb = -(-seq_len // QUERY_BLOCK)
    pad = nb * QUERY_BLOCK - seq_len
    pad_seq = lambda t: jnp.pad(t, ((0, 0), (0, 0), (0, pad), (0, 0))).reshape(bt, nh, nb, QUERY_BLOCK, dh)
    qb = pad_seq(q)
    front = ((0, 0), (0, 0), (n_prev, 0), (0, 0), (0, 0))
    kbp = jnp.pad(pad_seq(k), front)
    vbp = jnp.pad(pad_seq(v), front)
    kk = jnp.concatenate([kbp[:, :, i:i + nb] for i in range(n_prev + 1)], axis=3)
    vv = jnp.concatenate([vbp[:, :, i:i + nb] for i in range(n_prev + 1)], axis=3)
    s = jnp.einsum('bhnqd,bhnkd->bhnqk', qb, kk).astype(jnp.float32) * (dh ** -0.5)
    qi = jnp.arange(QUERY_BLOCK)
    kj = jnp.arange((n_prev + 1) * QUERY_BLOCK) - n_prev * QUERY_BLOCK
    dist = qi[:, None] - kj[None, :]
    kpos = jnp.arange(nb)[:, None] * QUERY_BLOCK + kj[None, :]
    valid = ((dist >= 0) & (dist <= max_dist))[None] & (kpos >= 0)[:, None, :]
    s = s + rel_bias(dist * dist_scale, table_h).transpose(2, 0, 1)[:, None]
    if sink is not None:
        sink = sink.astype(jnp.float32).reshape(-1, 1, 1, 1)
    p, m, den = masked_probs(s, valid, sink)
    o = jnp.einsum('bhnqk,bhnkd->bhnqd', p, vv.astype(jnp.float32)) / den
    lse = (m + jnp.log(den))[..., 0]
    o = o.reshape(bt, nh, nb * QUERY_BLOCK, dh)[:, :, :seq_len]
    lse = lse.reshape(bt, nh, nb * QUERY_BLOCK)[:, :, :seq_len]
    return o.astype(q.dtype), lse


def dilated_attention(q, k, v, table_h):
    b, nh, s, dh = q.shape
    outs, lses = [], []
    for window, rate in DILATED_CONFIGS:
        fold = lambda t: t.reshape(b, nh, s // rate, rate, dh).transpose(0, 3, 1, 2, 4).reshape(b * rate, nh, s // rate, dh)
        o, lse = banded_attention(fold(q), fold(k), fold(v), table_h, window // rate, dist_scale=rate)
        outs.append(o.reshape(b, rate, nh, s // rate, dh).transpose(0, 2, 3, 1, 4).reshape(b, nh, s, dh).astype(jnp.float32))
        lses.append(lse.reshape(b, rate, nh, s // rate).transpose(0, 2, 3, 1).reshape(b, nh, s))
    wts = jax.nn.softmax(jnp.stack(lses, axis=0), axis=0)
    return jnp.sum(wts[..., None] * jnp.stack(outs, axis=0), axis=0).astype(q.dtype)


def diff_attention(q, k, v, lam, table_h):
    b, nh, s, _, dq = q.shape
    dv = v.shape[-1]
    kpos = jnp.arange(s)
    vf = v.astype(jnp.float32)
    lam = lam.astype(jnp.float32)

    def block(n):
        qb = lax.dynamic_slice_in_dim(q, n * QUERY_BLOCK, QUERY_BLOCK, axis=2)
        sc = jnp.einsum('bhqcd,bhkcd->bhcqk', qb, k).astype(jnp.float32) * (dq ** -0.5)
        qpos = n * QUERY_BLOCK + jnp.arange(QUERY_BLOCK)
        dist = qpos[:, None] - kpos[None, :]
        sc = sc + rel_bias(dist, table_h).transpose(2, 0, 1)[:, None]
        p, _, den = masked_probs(sc, dist >= 0)
        p = p / den
        a = p[:, :, 0] - lam * p[:, :, 1]
        return jnp.einsum('bhqk,bhkd->bhqd', a, vf)

    o = lax.map(block, jnp.arange(s // QUERY_BLOCK))
    return o.transpose(1, 2, 0, 3, 4).reshape(b, nh, s, dv)


def compress(t, pos, w1, b1, w2, b2):
    b, s, dh = t.shape
    chunks = t.reshape(b, s // CMP_STRIDE, CMP_STRIDE, dh)
    blocks = jnp.concatenate([chunks[:, :-1], chunks[:, 1:]], axis=2) + pos
    blocks = blocks.reshape(b, blocks.shape[1], CMP_LEN * dh)
    return jax.nn.gelu(blocks @ w1 + b1) @ w2 + b2


def nsa_attention(q, k_c, v_c, k_s, v_s, k_w, v_w, gates, cmp_pos, cmp_w1, cmp_b1, cmp_w2, cmp_b2, k_gains, table_h):
    b, nh, s, dh = q.shape
    scale = dh ** -0.5
    kc = rms_norm(compress(k_c, cmp_pos[0], cmp_w1[0], cmp_b1[0], cmp_w2[0], cmp_b2[0]), k_gains[0])
    vc = compress(v_c, cmp_pos[1], cmp_w1[1], cmp_b1[1], cmp_w2[1], cmp_b2[1]).astype(jnp.float32)
    n_cmp = kc.shape[1]
    cmp_end = jnp.arange(n_cmp) * CMP_STRIDE + CMP_LEN - 1
    n_blk = s // SLC_BLOCK
    n_sel = min(SLC_TOPK, n_blk)
    blk_ids = jnp.arange(n_blk)
    overlap = ((cmp_end[:, None] - CMP_LEN + 1 < (blk_ids[None, :] + 1) * SLC_BLOCK)
               & (cmp_end[:, None] >= blk_ids[None, :] * SLC_BLOCK)).astype(jnp.float32)
    ks_blocks = rms_norm(k_s, k_gains[1]).reshape(b, n_blk, SLC_BLOCK, dh)
    vs_blocks = v_s.reshape(b, n_blk, SLC_BLOCK, dh)
    b_idx = jnp.arange(b)[:, None, None]

    def chunk(n):
        qb = lax.dynamic_slice_in_dim(q, n * QUERY_BLOCK, QUERY_BLOCK, axis=2)
        qpos = n * QUERY_BLOCK + jnp.arange(QUERY_BLOCK)
        cdist = qpos[:, None] - cmp_end[None, :]
        sc = jnp.einsum('bhqd,bcd->bhqc', qb, kc).astype(jnp.float32) * scale
        sc = sc + rel_bias(cdist, table_h).transpose(2, 0, 1)
        p, _, den = masked_probs(sc, cdist >= 0)
        p = p / jnp.maximum(den, TINY)
        o_cmp = jnp.einsum('bhqc,bcd->bhqd', p, vc)
        imp = jnp.einsum('bhqc,cj->bqj', p, overlap)
        cur = qpos // SLC_BLOCK
        forced = (blk_ids == 0) | (blk_ids == cur[:, None]) | (blk_ids == cur[:, None] - 1)
        imp = jnp.where(forced, FORCE_SELECT, jnp.where(blk_ids <= cur[:, None], imp, NEG_INF))
        _, idx = lax.top_k(imp, n_sel)
        ks = ks_blocks[b_idx, idx].reshape(b, QUERY_BLOCK, n_sel * SLC_BLOCK, dh)
        vs = vs_blocks[b_idx, idx].reshape(b, QUERY_BLOCK, n_sel * SLC_BLOCK, dh)
        kpos = (idx[..., None] * SLC_BLOCK + jnp.arange(SLC_BLOCK)).reshape(b, QUERY_BLOCK, n_sel * SLC_BLOCK)
        sdist = qpos[None, :, None] - kpos
        ss = jnp.einsum('bhqd,bqkd->bhqk', qb, ks).astype(jnp.float32) * scale
        ss = ss + jnp.moveaxis(rel_bias(sdist, table_h), -1, 1)
        p2, _, den2 = masked_probs(ss, (sdist >= 0)[:, None])
        o_slc = jnp.einsum('bhqk,bqkd->bhqd', p2, vs.astype(jnp.float32)) / den2
        return o_cmp, o_slc

    o_cmp, o_slc = lax.map(chunk, jnp.arange(s // QUERY_BLOCK))
    unblock = lambda o: o.transpose(1, 2, 0, 3, 4).reshape(b, nh, s, dh)
    kw = jnp.repeat(rms_norm(k_w, k_gains[2])[:, None], nh, axis=1)
    vw = jnp.repeat(v_w[:, None], nh, axis=1)
    o_win, _ = banded_attention(q, kw, vw, table_h, NSA_WINDOW - 1)
    g = jax.nn.sigmoid(gates.astype(jnp.float32))
    o = g[..., 0:1] * unblock(o_cmp) + g[..., 1:2] * unblock(o_slc) + g[..., 2:3] * o_win.astype(jnp.float32)
    return o.astype(q.dtype)


def setup_inputs(seed: int = 0) -> dict:
    key = jax.random.key(seed)
    ks = jax.random.split(key, 15)
    nrm = lambda k, shape, sc: sc * jax.random.normal(k, shape, jnp.float32)
    return {
        'x': nrm(ks[0], (BATCH, SEQ, D_MODEL), 1.0),
        'rel_bias_table': nrm(ks[1], (NUM_BUCKETS, N_HEADS_TOTAL), 0.5),
        'norm_w': 1.0 + nrm(ks[2], (DEPTH, D_MODEL), 0.02),
        'w_in': nrm(ks[3], (DEPTH, D_MODEL, PROJ_WIDTH), D_MODEL ** -0.5),
        'w_out': nrm(ks[4], (DEPTH, MIX_WIDTH, D_MODEL), MIX_WIDTH ** -0.5),
        'qk_gain': 1.0 + nrm(ks[5], (DEPTH, 8, HEAD_DIM), 0.02),
        'qk_gain_diff': 1.0 + nrm(ks[6], (DEPTH, 2, DIFF_QK_DIM), 0.02),
        'attn_sinks': nrm(ks[7], (DEPTH, HEADS_PER_MIXER), 1.0),
        'diff_lambda': nrm(ks[8], (DEPTH, 4, DIFF_QK_DIM), 0.1),
        'diff_subln': 1.0 + nrm(ks[9], (DEPTH, HEAD_DIM), 0.02),
        'cmp_pos': nrm(ks[10], (DEPTH, 2, CMP_LEN, HEAD_DIM), 0.02),
        'cmp_w1': nrm(ks[11], (DEPTH, 2, CMP_LEN * HEAD_DIM, CMP_HIDDEN), (CMP_LEN * HEAD_DIM) ** -0.5),
        'cmp_b1': nrm(ks[12], (DEPTH, 2, CMP_HIDDEN), 0.02),
        'cmp_w2': nrm(ks[13], (DEPTH, 2, CMP_HIDDEN, HEAD_DIM), CMP_HIDDEN ** -0.5),
        'cmp_b2': nrm(ks[14], (DEPTH, 2, HEAD_DIM), 0.02),
    }


def reference(x, rel_bias_table, norm_w, w_in, w_out, qk_gain, qk_gain_diff, attn_sinks, diff_lambda,
              diff_subln, cmp_pos, cmp_w1, cmp_b1, cmp_w2, cmp_b2):
    b, s, _ = x.shape
    split_points = np.cumsum(PROJ_SIZES)[:-1]
    tables = [rel_bias_table[:, m * HEADS_PER_MIXER:(m + 1) * HEADS_PER_MIXER] for m in range(N_MIXERS)]
    heads = lambda t: t.reshape(b, s, -1, HEAD_DIM).transpose(0, 2, 1, 3)
    merge = lambda o: o.transpose(0, 2, 1, 3).reshape(b, s, -1).astype(x.dtype)
    rep = HEADS_PER_MIXER // SWA_KV_HEADS
    for layer in range(DEPTH):
        g = qk_gain[layer]
        h = rms_norm(x, norm_w[layer]) @ w_in[layer]
        (a_q, a_k, a_v, b_q, b_k, b_v, c_q, c_k, c_v, d_q, d_kc, d_vc, d_ks, d_vs, d_kw, d_vw,
         d_gate, silu_gate) = jnp.split(h, split_points, axis=-1)
        o_a = dilated_attention(rms_norm(heads(a_q), g[0]), rms_norm(heads(a_k), g[1]), heads(a_v), tables[0])
        kb = jnp.repeat(rms_norm(heads(b_k), g[3]), rep, axis=1)
        vb = jnp.repeat(heads(b_v), rep, axis=1)
        o_b, _ = banded_attention(rms_norm(heads(b_q), g[2]), kb, vb, tables[1], SWA_WINDOW - 1,
                                  sink=attn_sinks[layer])
        split2 = lambda t: t.reshape(b, s, HEADS_PER_MIXER, 2, DIFF_QK_DIM).transpose(0, 2, 1, 3, 4)
        lambda_init = 0.8 - 0.6 * math.exp(-0.3 * layer)
        lq1, lk1, lq2, lk2 = diff_lambda[layer, 0], diff_lambda[layer, 1], diff_lambda[layer, 2], diff_lambda[layer, 3]
        lam = jnp.exp(jnp.sum(lq1 * lk1)) - jnp.exp(jnp.sum(lq2 * lk2)) + lambda_init
        o_c = diff_attention(rms_norm(split2(c_q), qk_gain_diff[layer, 0]), rms_norm(split2(c_k), qk_gain_diff[layer, 1]),
                             heads(c_v), lam, tables[2])
        o_c = rms_norm(o_c, diff_subln[layer]) * (1.0 - lambda_init)
        gates = d_gate.reshape(b, s, HEADS_PER_MIXER, NSA_BRANCHES).transpose(0, 2, 1, 3)
        o_d = nsa_attention(rms_norm(heads(d_q), g[4]), d_kc, d_vc, d_ks, d_vs, d_kw, d_vw, gates,
                            cmp_pos[layer], cmp_w1[layer], cmp_b1[layer], cmp_w2[layer], cmp_b2[layer],
                            g[5:8], tables[3])
        y = jnp.concatenate([merge(o_a), merge(o_b), merge(o_c), merge(o_d)], axis=-1) * jax.nn.silu(silu_gate)
        x = x + y @ w_out[layer]
    return x
```

```cpp
#include <hip/hip_runtime.h>
#include <stdint.h>
#include <math.h>

typedef unsigned short bf16_t;
__device__ __forceinline__ float bf2f(bf16_t v) { return __uint_as_float((unsigned)v << 16); }
__device__ __forceinline__ bf16_t f2bf(float f) { unsigned u = __float_as_uint(f); return (bf16_t)((u + 0x7fffu + ((u >> 16) & 1u)) >> 16); }

constexpr int NB = 2, S = 8192, DM = 1024, MROWS = NB * S, PW = 3724, HP = 3840;
constexpr int C_AQ = 0, C_AK = 256, C_AV = 512, C_BQ = 768, C_BK = 1024, C_BV = 1152, C_CQ = 1280, C_CK = 1536, C_CV = 1792,
              C_DQ = 2048, C_KC = 2304, C_VC = 2368, C_KS = 2432, C_VS = 2496, C_KW = 2560, C_VW = 2624, C_GT = 2688, C_SILU = 2816;
constexpr float EPS = 1e-6f;

__device__ __forceinline__ int t5_bucket(int n) {
    if (n < 16) return n < 0 ? 0 : n;
    int b = 16;
    b += (n >= 22); b += (n >= 30); b += (n >= 40); b += (n >= 54); b += (n >= 73); b += (n >= 99); b += (n >= 134); b += (n >= 182);
    b += (n >= 246); b += (n >= 332); b += (n >= 450); b += (n >= 609); b += (n >= 825); b += (n >= 1117); b += (n >= 1513);
    return b;
}

__global__ void __launch_bounds__(256) k_rmsnorm(const float* __restrict__ x, const float* __restrict__ g, bf16_t* __restrict__ xn) {
    const int wave = (blockIdx.x * 256 + threadIdx.x) >> 6, lane = threadIdx.x & 63;
    if (wave >= MROWS) return;
    const float* xr = x + (size_t)wave * DM;
    float v[16]; float ss = 0.f;
#pragma unroll
    for (int j = 0; j < 16; ++j) { v[j] = xr[lane + 64 * j]; ss += v[j] * v[j]; }
#pragma unroll
    for (int o = 1; o < 64; o <<= 1) ss += __shfl_xor(ss, o);
    const float rstd = rsqrtf(ss * (1.f / DM) + EPS);
#pragma unroll
    for (int j = 0; j < 16; ++j) xn[(size_t)wave * DM + lane + 64 * j] = f2bf(v[j] * rstd * g[lane + 64 * j]);
}

template <int MODE>
__global__ void __launch_bounds__(256) k_gemm(const bf16_t* __restrict__ A, const float* __restrict__ B, int N, int K,
                                              bf16_t* __restrict__ Hout, const float* xprev, float* out) {
    __shared__ float As[16][68];
    __shared__ float Bs[16][68];
    const int tid = threadIdx.x, tx = tid & 15, ty = tid >> 4;
    const int m0 = blockIdx.y * 64, n0 = blockIdx.x * 64;
    float acc[4][4];
#pragma unroll
    for (int i = 0; i < 4; ++i)
#pragma unroll
        for (int j = 0; j < 4; ++j) acc[i][j] = 0.f;
    const int ar = tid >> 2, ak = (tid & 3) * 4;
    const int bk = tid >> 4, bn = (tid & 15) * 4;
    for (int k0 = 0; k0 < K; k0 += 16) {
        {
            const uint2 raw = *(const uint2*)(A + (size_t)(m0 + ar) * K + k0 + ak);
            As[ak + 0][ar] = __uint_as_float(raw.x << 16); As[ak + 1][ar] = __uint_as_float(raw.x & 0xffff0000u);
            As[ak + 2][ar] = __uint_as_float(raw.y << 16); As[ak + 3][ar] = __uint_as_float(raw.y & 0xffff0000u);
            float4 bv = make_float4(0.f, 0.f, 0.f, 0.f);
            if (n0 + bn < N) bv = *(const float4*)(B + (size_t)(k0 + bk) * N + n0 + bn);
            Bs[bk][bn + 0] = bv.x; Bs[bk][bn + 1] = bv.y; Bs[bk][bn + 2] = bv.z; Bs[bk][bn + 3] = bv.w;
        }
        __syncthreads();
#pragma unroll
        for (int k = 0; k < 16; ++k) {
            float a[4], b[4];
#pragma unroll
            for (int i = 0; i < 4; ++i) a[i] = As[k][ty * 4 + i];
#pragma unroll
            for (int j = 0; j < 4; ++j) b[j] = Bs[k][tx * 4 + j];
#pragma unroll
            for (int i = 0; i < 4; ++i)
#pragma unroll
                for (int j = 0; j < 4; ++j) acc[i][j] += a[i] * b[j];
        }
        __syncthreads();
    }
#pragma unroll
    for (int i = 0; i < 4; ++i) {
        const int m = m0 + ty * 4 + i;
#pragma unroll
        for (int j = 0; j < 4; ++j) {
            const int n = n0 + tx * 4 + j;
            if (n < N) {
                if (MODE == 1) { const int c = n < 2700 ? n : n + 116; Hout[(size_t)m * HP + c] = f2bf(acc[i][j]); }
                else { out[(size_t)m * DM + n] = xprev[(size_t)m * DM + n] + acc[i][j]; }
            }
        }
    }
}

__global__ void __launch_bounds__(256) k_post_norm(bf16_t* __restrict__ H, const float* __restrict__ g  , const float* __restrict__ gd  ) {
    const int idx = blockIdx.x * 256 + threadIdx.x;
    const int row = idx / 36, slot = idx % 36;
    if (row >= MROWS) return;
    int col, len; const float* gain;
    if (slot < 4) { col = C_AQ + 64 * slot; len = 64; gain = g + 0 * 64; }
    else if (slot < 8) { col = C_AK + 64 * (slot - 4); len = 64; gain = g + 1 * 64; }
    else if (slot < 12) { col = C_BQ + 64 * (slot - 8); len = 64; gain = g + 2 * 64; }
    else if (slot < 14) { col = C_BK + 64 * (slot - 12); len = 64; gain = g + 3 * 64; }
    else if (slot < 22) { col = C_CQ + 32 * (slot - 14); len = 32; gain = gd; }
    else if (slot < 30) { col = C_CK + 32 * (slot - 22); len = 32; gain = gd + 32; }
    else if (slot < 34) { col = C_DQ + 64 * (slot - 30); len = 64; gain = g + 4 * 64; }
    else if (slot == 34) { col = C_KS; len = 64; gain = g + 6 * 64; }
    else { col = C_KW; len = 64; gain = g + 7 * 64; }
    bf16_t* p = H + (size_t)row * HP + col;
    float ss = 0.f;
    for (int d = 0; d < len; ++d) { const float v = bf2f(p[d]); ss += v * v; }
    const float r = rsqrtf(ss / (float)len + EPS);
    for (int d = 0; d < len; ++d) p[d] = f2bf(bf2f(p[d]) * r * gain[d]);
}
__global__ void __launch_bounds__(256) k_post_act(bf16_t* __restrict__ H) {
    const int idx = blockIdx.x * 256 + threadIdx.x;
    const int row = idx / 1036, c = idx % 1036;
    if (row >= MROWS) return;
    if (c < 12) { bf16_t* p = H + (size_t)row * HP + C_GT + c; const float v = bf2f(*p); *p = f2bf(1.f / (1.f + expf(-v))); }
    else { bf16_t* p = H + (size_t)row * HP + C_SILU + (c - 12); const float v = bf2f(*p); *p = f2bf(v / (1.f + expf(-v))); }
}

template <int D>
__device__ __forceinline__ float dot_row(const float* q, const bf16_t* kr) {
    float s = 0.f;
#pragma unroll
    for (int c = 0; c < D / 8; ++c) {
        const uint4 r = *(const uint4*)(kr + 8 * c);
        s += q[8 * c + 0] * __uint_as_float(r.x << 16) + q[8 * c + 1] * __uint_as_float(r.x & 0xffff0000u);
        s += q[8 * c + 2] * __uint_as_float(r.y << 16) + q[8 * c + 3] * __uint_as_float(r.y & 0xffff0000u);
        s += q[8 * c + 4] * __uint_as_float(r.z << 16) + q[8 * c + 5] * __uint_as_float(r.z & 0xffff0000u);
        s += q[8 * c + 6] * __uint_as_float(r.w << 16) + q[8 * c + 7] * __uint_as_float(r.w & 0xffff0000u);
    }
    return s;
}
__device__ __forceinline__ void os_step(float s, const bf16_t* vr, float& m, float& den, float* o) {
    const float mn = fmaxf(m, s), sc = __expf(m - mn), p = __expf(s - mn);
    den = den * sc + p; m = mn;
#pragma unroll
    for (int c = 0; c < 8; ++c) {
        const uint4 r = *(const uint4*)(vr + 8 * c);
        o[8 * c + 0] = o[8 * c + 0] * sc + p * __uint_as_float(r.x << 16); o[8 * c + 1] = o[8 * c + 1] * sc + p * __uint_as_float(r.x & 0xffff0000u);
        o[8 * c + 2] = o[8 * c + 2] * sc + p * __uint_as_float(r.y << 16); o[8 * c + 3] = o[8 * c + 3] * sc + p * __uint_as_float(r.y & 0xffff0000u);
        o[8 * c + 4] = o[8 * c + 4] * sc + p * __uint_as_float(r.z << 16); o[8 * c + 5] = o[8 * c + 5] * sc + p * __uint_as_float(r.z & 0xffff0000u);
        o[8 * c + 6] = o[8 * c + 6] * sc + p * __uint_as_float(r.w << 16); o[8 * c + 7] = o[8 * c + 7] * sc + p * __uint_as_float(r.w & 0xffff0000u);
    }
}
template <int D>
__device__ __forceinline__ void load_q(float* q, const bf16_t* p) {
#pragma unroll
    for (int c = 0; c < D / 8; ++c) {
        const uint4 r = *(const uint4*)(p + 8 * c);
        q[8 * c + 0] = __uint_as_float(r.x << 16); q[8 * c + 1] = __uint_as_float(r.x & 0xffff0000u);
        q[8 * c + 2] = __uint_as_float(r.y << 16); q[8 * c + 3] = __uint_as_float(r.y & 0xffff0000u);
        q[8 * c + 4] = __uint_as_float(r.z << 16); q[8 * c + 5] = __uint_as_float(r.z & 0xffff0000u);
        q[8 * c + 6] = __uint_as_float(r.w << 16); q[8 * c + 7] = __uint_as_float(r.w & 0xffff0000u);
    }
}

__global__ void __launch_bounds__(256) k_attn_ab(const bf16_t* __restrict__ H, const float* __restrict__ tab, const float* __restrict__ sinks, bf16_t* __restrict__ Y) {
    const int idx = blockIdx.x * 256 + threadIdx.x;
    const int t = idx % S, h = (idx / S) % 4, b = (idx / (4 * S)) % NB, grp = idx / (4 * S * NB);
    if (grp >= 2) return;
    const size_t row = (size_t)b * S + t;
    float q[64], o[64];
#pragma unroll
    for (int d = 0; d < 64; ++d) o[d] = 0.f;
    float m, den;
    if (grp == 0) {
        load_q<64>(q, H + row * HP + C_AQ + 64 * h);
        m = -1e30f; den = 0.f;
        for (int cfg = 0; cfg < 3; ++cfg) {
            const int rate = cfg == 0 ? 1 : (cfg == 1 ? 4 : 16);
            for (int j = 0; j <= 128; ++j) {
                const int kp = t - j * rate;
                if (kp < 0) break;
                const bf16_t* kr = H + ((size_t)b * S + kp) * HP;
                const float s = dot_row<64>(q, kr + C_AK + 64 * h) * 0.125f + tab[t5_bucket(j * rate) * 16 + 0 + h];
                os_step(s, kr + C_AV + 64 * h, m, den, o);
            }
        }
        const float inv = 1.f / den;
#pragma unroll
        for (int d = 0; d < 64; ++d) Y[row * DM + 64 * h + d] = f2bf(o[d] * inv * bf2f(H[row * HP + C_SILU + 64 * h + d]));
    } else {
        load_q<64>(q, H + row * HP + C_BQ + 64 * h);
        m = sinks[h]; den = 1.f;
        const int kvh = h >> 1;
        for (int j = 0; j <= 127; ++j) {
            const int kp = t - j;
            if (kp < 0) break;
            const bf16_t* kr = H + ((size_t)b * S + kp) * HP;
            const float s = dot_row<64>(q, kr + C_BK + 64 * kvh) * 0.125f + tab[t5_bucket(j) * 16 + 4 + h];
            os_step(s, kr + C_BV + 64 * kvh, m, den, o);
        }
        const float inv = 1.f / den;
#pragma unroll
        for (int d = 0; d < 64; ++d) Y[row * DM + 256 + 64 * h + d] = f2bf(o[d] * inv * bf2f(H[row * HP + C_SILU + 256 + 64 * h + d]));
    }
}

__global__ void __launch_bounds__(256) k_attn_c(const bf16_t* __restrict__ H, const float* __restrict__ tab, float* __restrict__ CT) {
    const int idx = blockIdx.x * 256 + threadIdx.x;
    const int t = S - 1 - (idx % S), comp = (idx / S) % 2, h = (idx / (2 * S)) % 4, b = idx / (8 * S);
    if (b >= NB) return;
    const size_t row = (size_t)b * S + t;
    float q[32], o[64];
    load_q<32>(q, H + row * HP + C_CQ + 64 * h + 32 * comp);
#pragma unroll
    for (int d = 0; d < 64; ++d) o[d] = 0.f;
    float m = -1e30f, den = 0.f;
    const float sc = 0.17677669529663687f;
    for (int kp = 0; kp <= t; ++kp) {
        const bf16_t* kr = H + ((size_t)b * S + kp) * HP;
        const float s = dot_row<32>(q, kr + C_CK + 64 * h + 32 * comp) * sc + tab[t5_bucket(t - kp) * 16 + 8 + h];
        os_step(s, kr + C_CV + 64 * h, m, den, o);
    }
    const float inv = 1.f / den;
    float* dst = CT + ((row * 4 + h) * 2 + comp) * 64;
#pragma unroll
    for (int d = 0; d < 64; ++d) dst[d] = o[d] * inv;
}
__global__ void __launch_bounds__(256) k_c_fin(const float* __restrict__ CT, const bf16_t* __restrict__ H, const float* __restrict__ dl  ,
                                               const float* __restrict__ subln, float lambda_init, bf16_t* __restrict__ Y) {
    const int idx = blockIdx.x * 256 + threadIdx.x;
    if (idx >= MROWS * 4) return;
    const int h = idx & 3; const size_t row = idx >> 2;
    float s1 = 0.f, s2 = 0.f;
    for (int i = 0; i < 32; ++i) { s1 += dl[i] * dl[32 + i]; s2 += dl[64 + i] * dl[96 + i]; }
    const float lam = expf(s1) - expf(s2) + lambda_init;
    const float* p0 = CT + ((row * 4 + h) * 2) * 64; const float* p1 = p0 + 64;
    float ss = 0.f;
    for (int d = 0; d < 64; ++d) { const float a = p0[d] - lam * p1[d]; ss += a * a; }
    const float r = rsqrtf(ss * (1.f / 64.f) + EPS) * (1.f - lambda_init);
    for (int d = 0; d < 64; ++d) {
        const float a = p0[d] - lam * p1[d];
        Y[row * DM + 512 + 64 * h + d] = f2bf(a * r * subln[d] * bf2f(H[row * HP + C_SILU + 512 + 64 * h + d]));
    }
}

__global__ void __launch_bounds__(256) k_cmp1(const bf16_t* __restrict__ H, const float* __restrict__ pos  , const float* __restrict__ w1  ,
                                              const float* __restrict__ b1  , float* __restrict__ hid  ) {
    const int j = threadIdx.x, i = blockIdx.x % 511, b = (blockIdx.x / 511) % NB, kv = blockIdx.x / (511 * NB);
    const int col = kv == 0 ? C_KC : C_VC;
    float acc = b1[kv * 256 + j];
    const float* w = w1 + (size_t)kv * 2048 * 256 + j;
    const float* pp = pos + kv * 2048;
    for (int tok = 0; tok < 32; ++tok) {
        const bf16_t* hr = H + ((size_t)b * S + 16 * i + tok) * HP + col;
        for (int d = 0; d < 64; ++d) acc += (bf2f(hr[d]) + pp[tok * 64 + d]) * w[(size_t)(tok * 64 + d) * 256];
    }
    const float x = acc;
    const float gl = 0.5f * x * (1.f + tanhf(0.7978845608028654f * (x + 0.044715f * x * x * x)));
    hid[((size_t)(kv * NB + b) * 511 + i) * 256 + j] = gl;
}
__global__ void __launch_bounds__(64) k_cmp2(const float* __restrict__ hid, const float* __restrict__ w2  , const float* __restrict__ b2  ,
                                             const float* __restrict__ g5, float* __restrict__ KC, float* __restrict__ VC) {
    const int d = threadIdx.x, i = blockIdx.x % 511, b = (blockIdx.x / 511) % NB, kv = blockIdx.x / (511 * NB);
    const float* hp = hid + ((size_t)(kv * NB + b) * 511 + i) * 256;
    float acc = b2[kv * 64 + d];
    for (int j = 0; j < 256; ++j) acc += hp[j] * w2[(size_t)kv * 256 * 64 + j * 64 + d];
    if (kv == 0) {
        float ss = acc * acc;
#pragma unroll
        for (int o = 1; o < 64; o <<= 1) ss += __shfl_xor(ss, o);
        KC[((size_t)b * 512 + i) * 64 + d] = acc * rsqrtf(ss * (1.f / 64.f) + EPS) * g5[d];
    } else VC[((size_t)b * 512 + i) * 64 + d] = acc;
}

__global__ void __launch_bounds__(256) k_d_cmp(const bf16_t* __restrict__ H, const float* __restrict__ KC, const float* __restrict__ VC, const float* __restrict__ tab,
                                               float* __restrict__ OC, float* __restrict__ IMP  ) {
    const int idx = blockIdx.x * 256 + threadIdx.x;
    const int t = idx % S, h = (idx / S) % 4, b = idx / (4 * S);
    if (b >= NB) return;
    const size_t row = (size_t)b * S + t;
    float q[64], o[64];
    load_q<64>(q, H + row * HP + C_DQ + 64 * h);
#pragma unroll
    for (int d = 0; d < 64; ++d) o[d] = 0.f;
    const int nc = (t >= 31) ? ((t - 31) / 16 + 1) : 0;
    float m = -1e30f, den = 0.f;
    for (int c = 0; c < nc; ++c) {
        const float* kr = KC + ((size_t)b * 512 + c) * 64;
        float s = 0.f;
#pragma unroll
        for (int d = 0; d < 64; ++d) s += q[d] * kr[d];
        s = s * 0.125f + tab[t5_bucket(t - (16 * c + 31)) * 16 + 12 + h];
        const float mn = fmaxf(m, s); den = den * __expf(m - mn) + __expf(s - mn); m = mn;
    }
    const float inv = nc > 0 ? 1.f / den : 0.f;
    for (int c = 0; c < nc; ++c) {
        const float* kr = KC + ((size_t)b * 512 + c) * 64;
        float s = 0.f;
#pragma unroll
        for (int d = 0; d < 64; ++d) s += q[d] * kr[d];
        s = s * 0.125f + tab[t5_bucket(t - (16 * c + 31)) * 16 + 12 + h];
        const float p = __expf(s - m) * inv;
        const float* vr = VC + ((size_t)b * 512 + c) * 64;
#pragma unroll
        for (int d = 0; d < 64; ++d) o[d] += p * vr[d];
        atomicAdd(&IMP[row * 128 + (c >> 2)], p);
        if ((c & 3) == 3 && (c >> 2) + 1 < 128) atomicAdd(&IMP[row * 128 + (c >> 2) + 1], p);
    }
#pragma unroll
    for (int d = 0; d < 64; ++d) OC[row * 256 + 64 * h + d] = o[d];
}
__global__ void __launch_bounds__(256) k_topk(const float* __restrict__ IMP, unsigned* __restrict__ SEL) {
    const int idx = blockIdx.x * 256 + threadIdx.x;
    if (idx >= MROWS) return;
    const int t = idx % S; const int cur = t >> 6;
    const float* ip = IMP + (size_t)idx * 128;
    unsigned m0 = 0, m1 = 0, m2 = 0, m3 = 0;
    for (int it = 0; it < 16; ++it) {
        float best = -INFINITY; int bi = -1;
        for (int j = 0; j < 128; ++j) {
            const unsigned w = j < 32 ? m0 : (j < 64 ? m1 : (j < 96 ? m2 : m3));
            if ((w >> (j & 31)) & 1u) continue;
            const bool forced = (j == 0) | (j == cur) | (j == cur - 1);
            const float v = forced ? 1e9f : (j <= cur ? ip[j] : -1e30f);
            if (v > best) { best = v; bi = j; }
        }
        const unsigned bit = 1u << (bi & 31);
        if (bi < 32) m0 |= bit; else if (bi < 64) m1 |= bit; else if (bi < 96) m2 |= bit; else m3 |= bit;
    }
    SEL[(size_t)idx * 4 + 0] = m0; SEL[(size_t)idx * 4 + 1] = m1; SEL[(size_t)idx * 4 + 2] = m2; SEL[(size_t)idx * 4 + 3] = m3;
}
__global__ void __launch_bounds__(256) k_d_sw(const bf16_t* __restrict__ H, const unsigned* __restrict__ SEL, const float* __restrict__ tab,
                                              float* __restrict__ OS, float* __restrict__ OW) {
    const int idx = blockIdx.x * 256 + threadIdx.x;
    const int t = idx % S, h = (idx / S) % 4, b = (idx / (4 * S)) % NB, br = idx / (4 * S * NB);
    if (br >= 2) return;
    const size_t row = (size_t)b * S + t;
    float q[64], o[64];
    load_q<64>(q, H + row * HP + C_DQ + 64 * h);
#pragma unroll
    for (int d = 0; d < 64; ++d) o[d] = 0.f;
    float m = -1e30f, den = 0.f;
    if (br == 0) {
        const int cur = t >> 6;
        for (int j = 0; j <= cur; ++j) {
            if (!((SEL[row * 4 + (j >> 5)] >> (j & 31)) & 1u)) continue;
            for (int kk = 0; kk < 64; ++kk) {
                const int kp = 64 * j + kk;
                if (kp > t) break;
                const bf16_t* kr = H + ((size_t)b * S + kp) * HP;
                const float s = dot_row<64>(q, kr + C_KS) * 0.125f + tab[t5_bucket(t - kp) * 16 + 12 + h];
                os_step(s, kr + C_VS, m, den, o);
            }
        }
        const float inv = 1.f / den;
#pragma unroll
        for (int d = 0; d < 64; ++d) OS[row * 256 + 64 * h + d] = o[d] * inv;
    } else {
        const int k0 = t - 511 < 0 ? 0 : t - 511;
        for (int kp = k0; kp <= t; ++kp) {
            const bf16_t* kr = H + ((size_t)b * S + kp) * HP;
            const float s = dot_row<64>(q, kr + C_KW) * 0.125f + tab[t5_bucket(t - kp) * 16 + 12 + h];
            os_step(s, kr + C_VW, m, den, o);
        }
        const float inv = 1.f / den;
#pragma unroll
        for (int d = 0; d < 64; ++d) OW[row * 256 + 64 * h + d] = o[d] * inv;
    }
}
__global__ void __launch_bounds__(256) k_d_fin(const bf16_t* __restrict__ H, const float* __restrict__ OC, const float* __restrict__ OS, const float* __restrict__ OW, bf16_t* __restrict__ Y) {
    const size_t idx = (size_t)blockIdx.x * 256 + threadIdx.x;
    if (idx >= (size_t)MROWS * 256) return;
    const size_t row = idx >> 8; const int col = idx & 255, h = col >> 6;
    const bf16_t* hr = H + row * HP;
    const float g0 = bf2f(hr[C_GT + 3 * h + 0]), g1 = bf2f(hr[C_GT + 3 * h + 1]), g2 = bf2f(hr[C_GT + 3 * h + 2]);
    const float o = g0 * OC[idx] + g1 * OS[idx] + g2 * OW[idx];
    Y[row * DM + 768 + col] = f2bf(o * bf2f(hr[C_SILU + 768 + col]));
}

extern "C" void kernel_launch(void* const* d_in, const int* in_sizes, int n_in, void* d_out, int out_size, void* d_ws, size_t ws_size, hipStream_t stream) {
    const float* x = (const float*)d_in[0]; const float* tab = (const float*)d_in[1]; const float* norm_w = (const float*)d_in[2];
    const float* w_in = (const float*)d_in[3]; const float* w_out = (const float*)d_in[4]; const float* qk_gain = (const float*)d_in[5];
    const float* qk_gain_diff = (const float*)d_in[6]; const float* sinks = (const float*)d_in[7]; const float* diff_lambda = (const float*)d_in[8];
    const float* diff_subln = (const float*)d_in[9]; const float* cmp_pos = (const float*)d_in[10]; const float* cmp_w1 = (const float*)d_in[11];
    const float* cmp_b1 = (const float*)d_in[12]; const float* cmp_w2 = (const float*)d_in[13]; const float* cmp_b2 = (const float*)d_in[14];
    float* out = (float*)d_out;
    char* ws = (char*)d_ws;
    const size_t MiB = 1u << 20;
    bf16_t* H = (bf16_t*)(ws);
    bf16_t* XN = (bf16_t*)(ws + 121 * MiB);
    bf16_t* Y = XN;
    float* T0 = (float*)(ws + 154 * MiB);
    float* OC = T0; float* OS_ = T0 + (size_t)MROWS * 256; float* OW = T0 + (size_t)MROWS * 512; float* CT = T0;
    float* IMP = (float*)(ws + 203 * MiB);
    unsigned* SEL = (unsigned*)(ws + 212 * MiB);
    float* HID = (float*)(ws + 213 * MiB);
    float* KC = (float*)(ws + 216 * MiB); float* VC = (float*)(ws + 217 * MiB);
    for (int l = 0; l < 2; ++l) {
        const float* xprev = l == 0 ? x : out;
        k_rmsnorm<<<MROWS / 4, 256, 0, stream>>>(xprev, norm_w + l * DM, XN);
        k_gemm<1><<<dim3((PW + 63) / 64, MROWS / 64), 256, 0, stream>>>(XN, w_in + (size_t)l * DM * PW, PW, DM, H, nullptr, nullptr);
        k_post_norm<<<(MROWS * 36 + 255) / 256, 256, 0, stream>>>(H, qk_gain + l * 512, qk_gain_diff + l * 64);
        k_post_act<<<(MROWS * 1036 + 255) / 256, 256, 0, stream>>>(H);
        k_attn_ab<<<(2 * NB * 4 * S) / 256, 256, 0, stream>>>(H, tab, sinks + l * 4, Y);
        k_attn_c<<<(NB * 8 * S) / 256, 256, 0, stream>>>(H, tab, CT);
        const float lambda_init = 0.8f - 0.6f * expf(-0.3f * (float)l);
        k_c_fin<<<(MROWS * 4) / 256, 256, 0, stream>>>(CT, H, diff_lambda + l * 128, diff_subln + l * 64, lambda_init, Y);
        k_cmp1<<<2 * NB * 511, 256, 0, stream>>>(H, cmp_pos + (size_t)l * 2 * 2048, cmp_w1 + (size_t)l * 2 * 2048 * 256, cmp_b1 + l * 512, HID);
        k_cmp2<<<2 * NB * 511, 64, 0, stream>>>(HID, cmp_w2 + (size_t)l * 2 * 256 * 64, cmp_b2 + l * 128, qk_gain + l * 512 + 5 * 64, KC, VC);
        hipMemsetAsync(IMP, 0, (size_t)MROWS * 128 * 4, stream);
        k_d_cmp<<<(NB * 4 * S) / 256, 256, 0, stream>>>(H, KC, VC, tab, OC, IMP);
        k_topk<<<MROWS / 256, 256, 0, stream>>>(IMP, SEL);
        k_d_sw<<<(2 * NB * 4 * S) / 256, 256, 0, stream>>>(H, SEL, tab, OS_, OW);
        k_d_fin<<<(MROWS * 256) / 256, 256, 0, stream>>>(H, OC, OS_, OW, Y);
        k_gemm<2><<<dim3(DM / 64, MROWS / 64), 256, 0, stream>>>(Y, w_out + (size_t)l * DM * DM, DM, DM, nullptr, xprev, out);
    }
}
```

```cpp
#include <hip/hip_runtime.h>
#include <stdint.h>
#include <math.h>

typedef unsigned short bf16_t;
__device__ __forceinline__ float bf2f(bf16_t v) { return __uint_as_float((unsigned)v << 16); }
__device__ __forceinline__ bf16_t f2bf(float f) { unsigned u = __float_as_uint(f); return (bf16_t)((u + 0x7fffu + ((u >> 16) & 1u)) >> 16); }

constexpr int NB = 2, S = 8192, DM = 1024, MROWS = NB * S, PW = 3724, HP = 3840;
constexpr int C_AQ = 0, C_AK = 256, C_AV = 512, C_BQ = 768, C_BK = 1024, C_BV = 1152, C_CQ = 1280, C_CK = 1536, C_CV = 1792,
              C_DQ = 2048, C_KC = 2304, C_VC = 2368, C_KS = 2432, C_VS = 2496, C_KW = 2560, C_VW = 2624, C_GT = 2688, C_SILU = 2816;
constexpr float EPS = 1e-6f;
__device__ __forceinline__ int opq(int v) { asm volatile("" : "+v"(v)); return v; }

__device__ __forceinline__ int t5_bucket(int n) {
    if (n < 16) return n < 0 ? 0 : n;
    int b = 16;
    b += (n >= 22); b += (n >= 30); b += (n >= 40); b += (n >= 54); b += (n >= 73); b += (n >= 99); b += (n >= 134); b += (n >= 182);
    b += (n >= 246); b += (n >= 332); b += (n >= 450); b += (n >= 609); b += (n >= 825); b += (n >= 1117); b += (n >= 1513);
    return b;
}

__device__ __forceinline__ void k_rmsnorm(const int wave, const int lane, const float* __restrict__ x, const float* __restrict__ g, bf16_t* __restrict__ xn) {
    if (wave >= MROWS) return;
    const float4* xr = (const float4*)(x + (size_t)wave * DM);
    float4 v[4]; float ss = 0.f;
#pragma unroll
    for (int j = 0; j < 4; ++j) { v[j] = xr[lane + 64 * j]; ss += (v[j].x * v[j].x + v[j].y * v[j].y) + (v[j].z * v[j].z + v[j].w * v[j].w); }
#pragma unroll
    for (int o = 1; o < 64; o <<= 1) ss += __shfl_xor(ss, o);
    const float rstd = rsqrtf(ss * (1.f / DM) + EPS);
#pragma unroll
    for (int j = 0; j < 4; ++j) {
        const float4 gg = ((const float4*)g)[lane + 64 * j];
        uint2 o; o.x = (unsigned)f2bf(v[j].x * rstd * gg.x) | ((unsigned)f2bf(v[j].y * rstd * gg.y) << 16);
        o.y = (unsigned)f2bf(v[j].z * rstd * gg.z) | ((unsigned)f2bf(v[j].w * rstd * gg.w) << 16);
        ((uint2*)(xn + (size_t)wave * DM))[lane + 64 * j] = o;
    }
}

template <int D>
__device__ __forceinline__ float dot_row(const float* q, const bf16_t* kr) {
    float s = 0.f;
#pragma unroll
    for (int c = 0; c < D / 8; ++c) {
        const uint4 r = *(const uint4*)(kr + 8 * c);
        s += q[8 * c + 0] * __uint_as_float(r.x << 16) + q[8 * c + 1] * __uint_as_float(r.x & 0xffff0000u);
        s += q[8 * c + 2] * __uint_as_float(r.y << 16) + q[8 * c + 3] * __uint_as_float(r.y & 0xffff0000u);
        s += q[8 * c + 4] * __uint_as_float(r.z << 16) + q[8 * c + 5] * __uint_as_float(r.z & 0xffff0000u);
        s += q[8 * c + 6] * __uint_as_float(r.w << 16) + q[8 * c + 7] * __uint_as_float(r.w & 0xffff0000u);
        if (c & 1) asm volatile("" ::: "memory");
    }
    return s;
}
__device__ __forceinline__ void os_step(float s, const bf16_t* vr, float& m, float& den, float* o) {
    const float mn = fmaxf(m, s), sc = __expf(m - mn), p = __expf(s - mn);
    den = den * sc + p; m = mn;
#pragma unroll
    for (int c = 0; c < 8; ++c) {
        const uint4 r = *(const uint4*)(vr + 8 * c);
        o[8 * c + 0] = o[8 * c + 0] * sc + p * __uint_as_float(r.x << 16); o[8 * c + 1] = o[8 * c + 1] * sc + p * __uint_as_float(r.x & 0xffff0000u);
        o[8 * c + 2] = o[8 * c + 2] * sc + p * __uint_as_float(r.y << 16); o[8 * c + 3] = o[8 * c + 3] * sc + p * __uint_as_float(r.y & 0xffff0000u);
        o[8 * c + 4] = o[8 * c + 4] * sc + p * __uint_as_float(r.z << 16); o[8 * c + 5] = o[8 * c + 5] * sc + p * __uint_as_float(r.z & 0xffff0000u);
        o[8 * c + 6] = o[8 * c + 6] * sc + p * __uint_as_float(r.w << 16); o[8 * c + 7] = o[8 * c + 7] * sc + p * __uint_as_float(r.w & 0xffff0000u);
        if (c & 1) asm volatile("" ::: "memory");
    }
}
template <int D>
__device__ __forceinline__ void load_q(float* q, const bf16_t* p) {
#pragma unroll
    for (int c = 0; c < D / 8; ++c) {
        const uint4 r = *(const uint4*)(p + 8 * c);
        q[8 * c + 0] = __uint_as_float(r.x << 16); q[8 * c + 1] = __uint_as_float(r.x & 0xffff0000u);
        q[8 * c + 2] = __uint_as_float(r.y << 16); q[8 * c + 3] = __uint_as_float(r.y & 0xffff0000u);
        q[8 * c + 4] = __uint_as_float(r.z << 16); q[8 * c + 5] = __uint_as_float(r.z & 0xffff0000u);
        q[8 * c + 6] = __uint_as_float(r.w << 16); q[8 * c + 7] = __uint_as_float(r.w & 0xffff0000u);
    }
}

#define LAS __attribute__((address_space(3)))
namespace pg8 {
#define PG8_LAS __attribute__((address_space(3)))
typedef unsigned short bf16_t;
typedef short bf16x8 __attribute__((ext_vector_type(8)));
typedef float f32x4 __attribute__((ext_vector_type(4)));
typedef unsigned u32x4 __attribute__((ext_vector_type(4)));
constexpr int BM = 256, BK = 64, HALF = 128, HTB = HALF * BK * 2  , STAGE_BYTES = 8 * HTB, NXCD = 8, WGM = 8;

__host__ __device__ __forceinline__ int lds_byte(int r, int c) { const int st = (r >> 4) * 2 + (c >> 5), rr = r & 15, cc = c & 31, ob = rr * 64 + cc * 2; return st * 1024 + (ob ^ (((ob >> 9) & 1) << 5)); }
__host__ __device__ __forceinline__ void stage_rc(int b, int& R, int& C) { const int st = b / 1024, sb = b % 1024, swz = sb ^ (((sb >> 9) & 1) << 5); R = (st >> 1) * 16 + swz / 64; C = (st & 1) * 32 + (swz % 64) / 2; }
__host__ __device__ __forceinline__ int perm32(int rho) { const int n = rho >> 4, i = rho & 15; return 8 * (i >> 2) + 4 * n + (i & 3); }

struct Unit { int pm, pn; };
struct Gemm { const bf16_t* A; const bf16_t* Bt; int M, N, K; };

struct StaticOrder {
    int nM, nN, nwg, G, c;
    __host__ __device__ void init(int M, int N, int G_, int c_) { nM = M / BM; nN = N / BM; nwg = nM * nN; G = G_; c = c_; }
    __host__ __device__ bool next(int i, Unit& u) const {
        const long L = (long)i * G + c; if (L >= nwg) return false;
        int wgid = (int)L; { const int q = nwg / NXCD, r = nwg % NXCD, xcd = wgid % NXCD, off = wgid / NXCD; wgid = (xcd < r ? xcd * (q + 1) : r * (q + 1) + (xcd - r) * q) + off; }
        const int nig = WGM * nN, gid = wgid / nig, fm = gid * WGM, gsz = (nM - fm) < WGM ? (nM - fm) : WGM;
        u.pm = fm + ((wgid % nig) % gsz); u.pn = (wgid % nig) / gsz; return true;
    }
    __device__ __forceinline__ void a_ready(const Unit&) const {}
    __device__ __forceinline__ void done(const Unit&) const {}
};

__device__ __forceinline__ unsigned cvt_pk_bf16(float lo, float hi) { unsigned r; asm volatile("v_cvt_pk_bf16_f32 %0, %1, %2" : "=v"(r) : "v"(lo), "v"(hi)); return r; }
template <class Epi, class Sched, bool ALIGN_EPI = false, bool SP2 = false>
__device__ __forceinline__ void gemm_phase(PG8_LAS unsigned char* lds, const Gemm g, const Sched& S, const Epi& E) {
    const int tid = opq(threadIdx.x), wid = __builtin_amdgcn_readfirstlane(tid >> 6), lane = tid & 63, wr = wid >> 2, wc = wid & 3, fr = lane & 15, fq = lane >> 4;
    const int K = g.K, nt = K / BK;
    unsigned voffA[2], voffB[2];
#pragma unroll
    for (int i = 0; i < 2; ++i) { int R, C; stage_rc(tid * 16 + i * 8192, R, C); const int Rb = Epi::PERM ? ((R & ~31) + perm32(R & 31)) : R;
        voffA[i] = (unsigned)(R * K + C) * 2u; voffB[i] = (unsigned)(Rb * K + C) * 2u; }
    const size_t kstep = (size_t)(BK * 2);
    const size_t hstep = (size_t)HALF * K * 2;
    const size_t tstep = 2 * hstep;
    const unsigned ldsw = (unsigned)wid * 1024u;
    const int aoff = lds_byte(wr * 64 + fr, fq * 8), boff = lds_byte(wc * 32 + fr, fq * 8);
#define PG8_SA(b, h) (((b) * 2 + (h)) * HTB)
#define PG8_SB(b, h) ((4 + (b) * 2 + (h)) * HTB)
#define PG8_STAGE(bufoff, gbase, voff) do { _Pragma("unroll") for (int _i = 0; _i < 2; ++_i) \
        __builtin_amdgcn_global_load_lds((const unsigned*)((const char*)(gbase) + (voff)[_i]), (PG8_LAS unsigned*)(lds + (bufoff) + ldsw + _i * 8192), 16, 0, 0); } while (0)
#define PG8_LDA(dst, b, h) do { _Pragma("unroll") for (int m = 0; m < 4; ++m) _Pragma("unroll") for (int k = 0; k < 2; ++k) dst[m][k] = *(const PG8_LAS bf16x8*)(lds + PG8_SA(b, h) + aoff + m * 2048 + k * 1024); } while (0)
#define PG8_LDB(dst, b, h) do { _Pragma("unroll") for (int n = 0; n < 2; ++n) _Pragma("unroll") for (int k = 0; k < 2; ++k) dst[n][k] = *(const PG8_LAS bf16x8*)(lds + PG8_SB(b, h) + boff + n * 2048 + k * 1024); } while (0)
#define PG8_MMA(ai, bj, At, Bt) do { __builtin_amdgcn_s_setprio(1); _Pragma("unroll") for (int m = 0; m < 4; ++m) _Pragma("unroll") for (int n = 0; n < 2; ++n) _Pragma("unroll") for (int k = 0; k < 2; ++k) \
        acc[ai][bj][m][n] = __builtin_amdgcn_mfma_f32_16x16x32_bf16(Bt[n][k], At[m][k], acc[ai][bj][m][n], 0, 0, 0); __builtin_amdgcn_s_setprio(0); } while (0)
#define PG8_WAIT_V(n) asm volatile("s_waitcnt vmcnt(" #n ")" ::: "memory")
#define PG8_WAIT_L(n) asm volatile("s_waitcnt lgkmcnt(" #n ")" ::: "memory")
#define PG8_BAR __builtin_amdgcn_s_barrier()
#define PG8_SCHED __builtin_amdgcn_sched_barrier(0)
    Unit cur, nxt; int ui = 0;
    if (!S.next(0, cur)) return;
    f32x4 acc[2][2][4][2];
#pragma unroll
    for (int a = 0; a < 2; ++a)
#pragma unroll
        for (int b = 0; b < 2; ++b)
#pragma unroll
            for (int m = 0; m < 4; ++m)
#pragma unroll
                for (int n = 0; n < 2; ++n) acc[a][b][m][n] = (f32x4){0.f, 0.f, 0.f, 0.f};
    bf16x8 At[4][2], B0[2][2], B1[2][2];
    const char* cA = (const char*)g.A + (size_t)cur.pm * tstep; const char* cB = (const char*)g.Bt + (size_t)cur.pn * tstep;
    S.a_ready(cur);
    if constexpr (SP2) {
        PG8_STAGE(PG8_SB(0, 0), cB, voffB); PG8_STAGE(PG8_SB(0, 1), cB + hstep, voffB); PG8_STAGE(PG8_SA(0, 0), cA, voffA); PG8_STAGE(PG8_SA(0, 1), cA + hstep, voffA);
        if (wr == 1) PG8_BAR;
        PG8_WAIT_V(2); PG8_BAR;
        PG8_STAGE(PG8_SB(1, 0), cB + kstep, voffB); PG8_STAGE(PG8_SA(1, 0), cA + kstep, voffA); PG8_STAGE(PG8_SB(1, 1), cB + hstep + kstep, voffB);
        PG8_WAIT_V(6); PG8_BAR;
    } else {
        PG8_STAGE(PG8_SB(0, 0), cB, voffB); PG8_STAGE(PG8_SA(0, 0), cA, voffA); PG8_STAGE(PG8_SB(0, 1), cB + hstep, voffB); PG8_STAGE(PG8_SA(0, 1), cA + hstep, voffA);
        if (wr == 1) PG8_BAR;
        PG8_WAIT_V(4); PG8_BAR;
        PG8_STAGE(PG8_SB(1, 0), cB + kstep, voffB); PG8_STAGE(PG8_SA(1, 0), cA + kstep, voffA); PG8_STAGE(PG8_SB(1, 1), cB + hstep + kstep, voffB);
        PG8_WAIT_V(6); PG8_BAR;
    }
    for (;;) {
        const bool has_next = S.next(ui + 1, nxt);
        const char* nA = has_next ? (const char*)g.A + (size_t)nxt.pm * tstep : cA; const char* nB = has_next ? (const char*)g.Bt + (size_t)nxt.pn * tstep : cB;
        for (int t = 0; t < nt; t += 2) {
            const bool last = (t == nt - 2);
            const char* a1 = cA + (size_t)(t + 1) * kstep;
            const char* a2 = last ? nA : cA + (size_t)(t + 2) * kstep; const char* b2 = last ? nB : cB + (size_t)(t + 2) * kstep;
            const char* a3 = a2 + kstep; const char* b3 = b2 + kstep;
            if (last && has_next) S.a_ready(nxt);
            if constexpr (SP2) {
            PG8_LDB(B0, 0, 0); PG8_LDB(B1, 0, 1); PG8_SCHED; PG8_LDA(At, 0, 0); PG8_STAGE(PG8_SA(1, 1), a1 + hstep, voffA);
            PG8_WAIT_V(8); PG8_WAIT_L(0); PG8_BAR; PG8_MMA(0, 0, At, B0); PG8_MMA(0, 1, At, B1); PG8_BAR; PG8_SCHED;
            PG8_LDA(At, 0, 1); PG8_STAGE(PG8_SB(0, 0), b2, voffB); PG8_STAGE(PG8_SB(0, 1), b2 + hstep, voffB); PG8_STAGE(PG8_SA(0, 0), a2, voffA);
            PG8_WAIT_V(8); PG8_WAIT_L(0); PG8_BAR; PG8_MMA(1, 0, At, B0); PG8_MMA(1, 1, At, B1); PG8_BAR; PG8_SCHED;
            PG8_LDB(B0, 1, 0); PG8_LDB(B1, 1, 1); PG8_SCHED; PG8_LDA(At, 1, 0); PG8_STAGE(PG8_SA(0, 1), a2 + hstep, voffA);
            PG8_WAIT_V(8); PG8_WAIT_L(0); PG8_BAR; PG8_MMA(0, 0, At, B0); PG8_MMA(0, 1, At, B1); PG8_BAR; PG8_SCHED;
            PG8_LDA(At, 1, 1); PG8_STAGE(PG8_SB(1, 0), b3, voffB); PG8_STAGE(PG8_SB(1, 1), b3 + hstep, voffB); PG8_STAGE(PG8_SA(1, 0), a3, voffA);
            PG8_WAIT_V(8); PG8_WAIT_L(0); PG8_BAR; PG8_MMA(1, 0, At, B0); PG8_MMA(1, 1, At, B1); PG8_BAR; PG8_SCHED;
            } else {
            PG8_LDB(B0, 0, 0); PG8_SCHED; PG8_LDA(At, 0, 0); PG8_STAGE(PG8_SA(1, 1), a1 + hstep, voffA);
            PG8_WAIT_L(8); PG8_BAR; PG8_WAIT_L(0); PG8_MMA(0, 0, At, B0); PG8_BAR; PG8_SCHED;
            PG8_LDB(B1, 0, 1); PG8_STAGE(PG8_SB(0, 0), b2, voffB);
            PG8_BAR; PG8_WAIT_L(0); PG8_MMA(0, 1, At, B1); PG8_BAR;
            PG8_LDA(At, 0, 1); PG8_STAGE(PG8_SA(0, 0), a2, voffA);
            PG8_BAR; PG8_WAIT_L(0); PG8_MMA(1, 0, At, B0); PG8_BAR; PG8_SCHED;
            PG8_STAGE(PG8_SB(0, 1), b2 + hstep, voffB);
            PG8_WAIT_V(6); PG8_BAR; PG8_MMA(1, 1, At, B1); PG8_BAR;
            PG8_LDB(B0, 1, 0); PG8_SCHED; PG8_LDA(At, 1, 0); PG8_STAGE(PG8_SA(0, 1), a2 + hstep, voffA);
            PG8_WAIT_L(8); PG8_BAR; PG8_WAIT_L(0); PG8_MMA(0, 0, At, B0); PG8_BAR; PG8_SCHED;
            PG8_LDB(B1, 1, 1); PG8_STAGE(PG8_SB(1, 0), b3, voffB);
            PG8_BAR; PG8_WAIT_L(0); PG8_MMA(0, 1, At, B1); PG8_BAR;
            PG8_LDA(At, 1, 1); PG8_STAGE(PG8_SA(1, 0), a3, voffA);
            PG8_BAR; PG8_WAIT_L(0); PG8_MMA(1, 0, At, B0); PG8_BAR; PG8_SCHED;
            PG8_STAGE(PG8_SB(1, 1), b3 + hstep, voffB);
            PG8_WAIT_V(6); PG8_BAR; PG8_MMA(1, 1, At, B1); PG8_BAR;
            }
        }
        if constexpr (ALIGN_EPI) { if (wr == 0) PG8_BAR; }
        if constexpr (!Epi::AFTER_DRAIN) { E(acc, cur, wr, wc, fr, fq); S.done(cur); }
        if (!has_next) break;
#pragma unroll
        for (int a = 0; a < 2; ++a)
#pragma unroll
            for (int b = 0; b < 2; ++b)
#pragma unroll
                for (int m = 0; m < 4; ++m)
#pragma unroll
                    for (int n = 0; n < 2; ++n) acc[a][b][m][n] = (f32x4){0.f, 0.f, 0.f, 0.f};
        cur = nxt; cA = nA; cB = nB; ++ui;
        if constexpr (ALIGN_EPI) { if (wr == 1) PG8_BAR; }
    }
    PG8_WAIT_V(0);
    if constexpr (!ALIGN_EPI) { if (wr == 0) PG8_BAR; }
    PG8_BAR;
    if constexpr (Epi::AFTER_DRAIN) { E.fused(acc, cur, wr, wc, fr, fq, lds, wid, lane); S.done(cur); }
#undef PG8_SA
#undef PG8_SB
#undef PG8_STAGE
#undef PG8_LDA
#undef PG8_LDB
#undef PG8_MMA
#undef PG8_WAIT_V
#undef PG8_WAIT_L
#undef PG8_BAR
#undef PG8_SCHED
}
}

namespace pg8 {
struct EpiProj {
    static constexpr bool PERM = true, AFTER_DRAIN = false;
    bf16_t* H; const float* g; const float* gd;
    const float* rowss;
    __device__ __forceinline__ void operator()(const f32x4 (&acc)[2][2][4][2], const Unit& u, int wr, int wc, int fr, int fq) const {
        const int pn = u.pn;
        int mode = 0; const float* gain = nullptr;
        const float qs = (pn == 0 || pn == 3 || pn == 8) ? 0.125f * 1.4426950408889634f : (pn == 5 ? 0.17677669529663687f * 1.4426950408889634f : 1.f);
        if (pn == 0) { mode = 1; gain = g; } else if (pn == 1) { mode = 1; gain = g + 64; } else if (pn == 3) { mode = 1; gain = g + 128; }
        else if (pn == 4) { if (wc < 2) { mode = 1; gain = g + 192; } }
        else if (pn == 5) { mode = 2; gain = gd; } else if (pn == 6) { mode = 2; gain = gd + 32; }
        else if (pn == 8) { mode = 1; gain = g + 256; }
        else if (pn == 9) { if (wc == 2) { mode = 1; gain = g + 384; } }
        else if (pn == 10) { if (wc == 0) { mode = 1; gain = g + 448; } else if (wc == 2) mode = 4; }
        else if (pn >= 11) mode = 3;
        f32x4 gv[2][2];
#pragma unroll
        for (int bj = 0; bj < 2; ++bj)
#pragma unroll
            for (int n = 0; n < 2; ++n) gv[bj][n] = (f32x4){1.f, 1.f, 1.f, 1.f};
        if (mode == 1) {
#pragma unroll
            for (int bj = 0; bj < 2; ++bj)
#pragma unroll
                for (int n = 0; n < 2; ++n) gv[bj][n] = *(const f32x4*)(gain + 32 * bj + 8 * fq + 4 * n);
        } else if (mode == 2) {
#pragma unroll
            for (int bj = 0; bj < 2; ++bj)
#pragma unroll
                for (int n = 0; n < 2; ++n) gv[bj][n] = *(const f32x4*)(gain + 8 * fq + 4 * n);
        }
        const int col0 = pn * BM + 64 * wc + 8 * fq;
#pragma unroll
        for (int ai = 0; ai < 2; ++ai)
#pragma unroll
            for (int m = 0; m < 4; ++m) {
                const int row = u.pm * BM + ai * HALF + wr * 64 + m * 16 + fr;
                f32x4 v[2][2];
                const float rsc = rowss ? rsqrtf((float)((const unsigned long long*)rowss)[row] * (1.f / (1048576.f * 1024.f)) + 1e-6f) : 1.f;
#pragma unroll
                for (int bj = 0; bj < 2; ++bj)
#pragma unroll
                    for (int n = 0; n < 2; ++n) v[bj][n] = acc[ai][bj][m][n] * rsc;
                if (mode == 1 || mode == 2) {
                    float s0 = 0.f, s1 = 0.f;
#pragma unroll
                    for (int n = 0; n < 2; ++n) {
                        s0 += v[0][n][0] * v[0][n][0] + v[0][n][1] * v[0][n][1] + v[0][n][2] * v[0][n][2] + v[0][n][3] * v[0][n][3];
                        s1 += v[1][n][0] * v[1][n][0] + v[1][n][1] * v[1][n][1] + v[1][n][2] * v[1][n][2] + v[1][n][3] * v[1][n][3];
                    }
                    s0 += __shfl_xor(s0, 16); s0 += __shfl_xor(s0, 32);
                    s1 += __shfl_xor(s1, 16); s1 += __shfl_xor(s1, 32);
                    float r0, r1;
                    if (mode == 1) { r0 = r1 = rsqrtf((s0 + s1) * (1.f / 64.f) + 1e-6f) * qs; }
                    else { r0 = rsqrtf(s0 * (1.f / 32.f) + 1e-6f) * qs; r1 = rsqrtf(s1 * (1.f / 32.f) + 1e-6f) * qs; }
#pragma unroll
                    for (int n = 0; n < 2; ++n) { v[0][n] = v[0][n] * r0 * gv[0][n]; v[1][n] = v[1][n] * r1 * gv[1][n]; }
                } else if (mode == 3) {
#pragma unroll
                    for (int bj = 0; bj < 2; ++bj)
#pragma unroll
                        for (int n = 0; n < 2; ++n)
#pragma unroll
                            for (int e = 0; e < 4; ++e) { const float x = v[bj][n][e]; v[bj][n][e] = x * __builtin_amdgcn_rcpf(1.f + __expf(-x)); }
                } else if (mode == 4) {
#pragma unroll
                    for (int bj = 0; bj < 2; ++bj)
#pragma unroll
                        for (int n = 0; n < 2; ++n)
#pragma unroll
                            for (int e = 0; e < 4; ++e) { const float x = v[bj][n][e]; v[bj][n][e] = __builtin_amdgcn_rcpf(1.f + __expf(-x)); }
                }
                bf16_t* rowp = H + (size_t)row * 3840 + col0;
#pragma unroll
                for (int bj = 0; bj < 2; ++bj) {
                    u32x4 w; w.x = cvt_pk_bf16(v[bj][0][0], v[bj][0][1]); w.y = cvt_pk_bf16(v[bj][0][2], v[bj][0][3]);
                    w.z = cvt_pk_bf16(v[bj][1][0], v[bj][1][1]); w.w = cvt_pk_bf16(v[bj][1][2], v[bj][1][3]);
                    *(u32x4*)(rowp + 32 * bj) = w;
                }
            }
    }
};
struct EpiOut {
    static constexpr bool PERM = false, AFTER_DRAIN = false;
    const float* xprev; float* out;
    PG8_LAS float* exch;
    bf16_t* xn; const float* gnext; float* rowss;
    __device__ __forceinline__ void operator()(const f32x4 (&acc)[2][2][4][2], const Unit& u, int wr, int wc, int fr, int fq) const {
        const int col0 = u.pn * BM + wc * 32 + 4 * fq;
        f32x4 gn[2][2];
#pragma unroll
        for (int bj = 0; bj < 2; ++bj)
#pragma unroll
            for (int n = 0; n < 2; ++n) gn[bj][n] = xn ? *(const f32x4*)(gnext + col0 + bj * HALF + n * 16) : (f32x4){0.f, 0.f, 0.f, 0.f};
#pragma unroll
        for (int ai = 0; ai < 2; ++ai)
#pragma unroll
            for (int m = 0; m < 4; ++m) {
                const int row = u.pm * BM + ai * HALF + wr * 64 + m * 16 + fr;
                const size_t off = (size_t)row * 1024 + col0;
                float ss = 0.f;
#pragma unroll
                for (int bj = 0; bj < 2; ++bj)
#pragma unroll
                    for (int n = 0; n < 2; ++n) {
                        const f32x4 b = *(const f32x4*)(xprev + off + bj * HALF + n * 16);
                        const f32x4 v = b + acc[ai][bj][m][n];
                        *(f32x4*)(out + off + bj * HALF + n * 16) = v;
                        if (xn) {
                            ss += (v[0] * v[0] + v[1] * v[1]) + (v[2] * v[2] + v[3] * v[3]);
                            const f32x4 w = v * gn[bj][n];
                            uint2 o; o.x = cvt_pk_bf16(w[0], w[1]); o.y = cvt_pk_bf16(w[2], w[3]);
                            *(uint2*)(xn + off + bj * HALF + n * 16) = o;
                        }
                    }
                if (xn) {
                    ss += __shfl_xor(ss, 16); ss += __shfl_xor(ss, 32);
                    if (fq == 0) exch[(ai * HALF + wr * 64 + m * 16 + fr) * 4 + wc] = ss;
                }
            }
        if (xn) {
            asm volatile("s_waitcnt lgkmcnt(0)" ::: "memory"); __builtin_amdgcn_s_barrier(); asm volatile("" ::: "memory");
            if (wc == 0) {
                const int lane = fq * 16 + fr;
#pragma unroll
                for (int k = 0; k < 2; ++k) {
                    const int rl = k * HALF + wr * 64 + lane;
                    const f32x4 p = *(const PG8_LAS f32x4*)(exch + rl * 4);
                    const float tot = (p[0] + p[1]) + (p[2] + p[3]);
                    atomicAdd((unsigned long long*)rowss + (u.pm * BM + rl), (unsigned long long)(tot * 1048576.f + 0.5f));
                }
            }
        }
    }
};
}

template <int MODE>
__device__ __forceinline__ void p0_transpose_item(const float* __restrict__ W, bf16_t* __restrict__ WT, LAS float* scr, int item, int lane, int KR = 1024, int NC = 1024) {
    const int NSRC = MODE == 0 ? 3724 : NC, NG = MODE == 0 ? 120 : NC / 32;
    const int kb = item / NG, nb = item % NG, k0 = 64 * kb, hc0 = 32 * nb;
    const int hc = hc0 + (lane & 31);
    int src = hc;
    if (MODE == 0) src = hc < 2700 ? hc : (hc < 2816 ? -1 : hc - 116);
#pragma unroll 8
    for (int i = 0; i < 32; ++i) { const int kk = 2 * i + (lane >> 5); scr[kk * 33 + (lane & 31)] = src >= 0 ? W[(size_t)(k0 + kk) * NSRC + src] : 0.f; }
    asm volatile("s_waitcnt lgkmcnt(0)" ::: "memory");
    const int c = lane & 7;
#pragma unroll
    for (int j = 0; j < 4; ++j) {
        const int n = (lane >> 3) + 8 * j; const LAS float* s = scr + (8 * c) * 33 + n;
        const int hcn = hc0 + n;
        int drow = hcn;
        if (MODE == 0) drow = (hcn & ~255) + ((hcn >> 5) & 1) * 128 + ((hcn >> 6) & 3) * 32 + (hcn & 31);
        uint4 o; o.x = (unsigned)f2bf(s[0]) | ((unsigned)f2bf(s[33]) << 16); o.y = (unsigned)f2bf(s[66]) | ((unsigned)f2bf(s[99]) << 16);
        o.z = (unsigned)f2bf(s[132]) | ((unsigned)f2bf(s[165]) << 16); o.w = (unsigned)f2bf(s[198]) | ((unsigned)f2bf(s[231]) << 16);
        *(uint4*)(WT + (size_t)drow * KR + k0 + 8 * c) = o;
    }
    asm volatile("s_waitcnt lgkmcnt(0)" ::: "memory");
}

namespace att {
typedef short bf16x8 __attribute__((ext_vector_type(8)));
typedef short v4i16 __attribute__((ext_vector_type(4)));
typedef float f32x16 __attribute__((ext_vector_type(16)));
typedef float f32x2_t __attribute__((ext_vector_type(2)));
typedef __bf16 bf16x2_t __attribute__((ext_vector_type(2)));
typedef unsigned u32x4 __attribute__((ext_vector_type(4)));
typedef float f32x4 __attribute__((ext_vector_type(4)));
__device__ __forceinline__ unsigned cvtpk(float lo, float hi) { f32x2_t v = {lo, hi}; bf16x2_t b = __builtin_convertvector(v, bf16x2_t); return __builtin_bit_cast(unsigned, b); }
__device__ __forceinline__ int crow(int r, int h) { return (r & 3) + 8 * (r >> 2) + 4 * h; }
constexpr float LOG2E = 1.4426950408889634f;
constexpr int L_KV = 0, KVB = 16384  , L_TAB = 32768  , L_WSCR = 83968  , L_IMP = 92160  , L_Q = 124928, L_SEL = 125184  , L_SB = 126464  ;

struct StageRegs { u32x4 k, v; };
__device__ __forceinline__ void stage_load(StageRegs& sr, const bf16_t* kp, const bf16_t* vp, bool valid, int ch) {
    sr.k = (u32x4){0u, 0u, 0u, 0u}; sr.v = sr.k;
    if (valid) { sr.k = *(const u32x4*)(kp + ch * 8); sr.v = *(const u32x4*)(vp + ch * 8); }
}
__device__ __forceinline__ void stage_write(LAS unsigned char* buf, const StageRegs& sr, int row, int ch) {
    *(LAS u32x4*)(buf + row * 128 + ((ch ^ (row & 7)) << 4)) = sr.k;
    *(LAS u32x4*)(buf + 8192 + (ch >> 2) * 4096 + row * 64 + (ch & 3) * 16) = sr.v;
}
__device__ __forceinline__ f32x16 load_tab16(const LAS float* tbl, int TSP, int jb) {
    const int sh = jb & 3; const LAS float* tp = tbl + sh * TSP + (jb - sh);
    const f32x4 t0 = *(const LAS f32x4*)(tp), t1 = *(const LAS f32x4*)(tp + 8), t2 = *(const LAS f32x4*)(tp + 16), t3 = *(const LAS f32x4*)(tp + 24);
    return (f32x16){t0[0], t0[1], t0[2], t0[3], t1[0], t1[1], t1[2], t1[3], t2[0], t2[1], t2[2], t2[3], t3[0], t3[1], t3[2], t3[3]};
}
__device__ __forceinline__ float exp_sum16(f32x16& acc) {
    float sa = 0.f, sb = 0.f;
#pragma unroll
    for (int r = 0; r < 16; r += 2) {
        acc[r] = __builtin_amdgcn_exp2f(acc[r]); acc[r + 1] = __builtin_amdgcn_exp2f(acc[r + 1]);
        sa += acc[r]; asm volatile("" : "+v"(sa)); sb += acc[r + 1]; asm volatile("" : "+v"(sb));
    }
    return sa + sb;
}
__device__ __forceinline__ f32x16 splat16(float v) { return (f32x16){v, v, v, v, v, v, v, v, v, v, v, v, v, v, v, v}; }
template <int S0, int S1>
__device__ __forceinline__ void qk_sub(f32x16& acc, const LAS unsigned char* buf, int sub, const bf16x8* qf, int lane) {
    const int key = 32 * sub + (lane & 31), h = lane >> 5;
#pragma unroll
    for (int s = S0; s < S1; ++s) {
        const bf16x8 kf = *(const LAS bf16x8*)(buf + key * 128 + (((2 * s + h) ^ (key & 7)) << 4));
        acc = __builtin_amdgcn_mfma_f32_32x32x16_bf16(kf, qf[s], acc, 0, 0, 0);
    }
}
__device__ __forceinline__ void pack_p(const f32x16& p, bf16x8& pa0, bf16x8& pa1) {
    u32x4 w0, w1;
    w0.x = cvtpk(p[0], p[1]); w0.y = cvtpk(p[2], p[3]); w0.z = cvtpk(p[4], p[5]); w0.w = cvtpk(p[6], p[7]);
    w1.x = cvtpk(p[8], p[9]); w1.y = cvtpk(p[10], p[11]); w1.z = cvtpk(p[12], p[13]); w1.w = cvtpk(p[14], p[15]);
    pa0 = __builtin_bit_cast(bf16x8, w0); pa1 = __builtin_bit_cast(bf16x8, w1);
}
__device__ __forceinline__ void pv_sub(f32x16* o, const LAS unsigned char* buf, int sub, const bf16x8& pa0, const bf16x8& pa1, int lane) {
    const int h = lane >> 5, g16 = (lane >> 4) & 1, q4 = (lane & 15) >> 2, p4 = lane & 3;
    const LAS unsigned char* vb = buf + 8192 + (32 * sub + 4 * h + q4) * 64 + (16 * g16 + 4 * p4) * 2;
#pragma unroll
    for (int dt = 0; dt < 2; ++dt) {
#pragma unroll
        for (int s2 = 0; s2 < 2; ++s2) {
            const v4i16 lo = __builtin_amdgcn_ds_read_tr16_b64_v4i16((LAS v4i16*)(vb + dt * 4096 + s2 * 1024));
            const v4i16 hi = __builtin_amdgcn_ds_read_tr16_b64_v4i16((LAS v4i16*)(vb + dt * 4096 + s2 * 1024 + 512));
            const bf16x8 vf = (bf16x8){lo[0], lo[1], lo[2], lo[3], hi[0], hi[1], hi[2], hi[3]};
            o[dt] = __builtin_amdgcn_mfma_f32_32x32x16_bf16(s2 == 0 ? pa0 : pa1, vf, o[dt], 0, 0, 0);
        }
    }
}

__device__ __forceinline__ void pv_sub2(f32x16* oa, f32x16* ob, const LAS unsigned char* buf, int sub, const bf16x8& a0, const bf16x8& a1, const bf16x8& b0, const bf16x8& b1, int lane) {
    const int h = lane >> 5, g16 = (lane >> 4) & 1, q4 = (lane & 15) >> 2, p4 = lane & 3;
    const LAS unsigned char* vb = buf + 8192 + (32 * sub + 4 * h + q4) * 64 + (16 * g16 + 4 * p4) * 2;
#pragma unroll
    for (int dt = 0; dt < 2; ++dt) {
#pragma unroll
        for (int s2 = 0; s2 < 2; ++s2) {
            const v4i16 lo = __builtin_amdgcn_ds_read_tr16_b64_v4i16((LAS v4i16*)(vb + dt * 4096 + s2 * 1024));
            const v4i16 hi = __builtin_amdgcn_ds_read_tr16_b64_v4i16((LAS v4i16*)(vb + dt * 4096 + s2 * 1024 + 512));
            const bf16x8 vf = (bf16x8){lo[0], lo[1], lo[2], lo[3], hi[0], hi[1], hi[2], hi[3]};
            oa[dt] = __builtin_amdgcn_mfma_f32_32x32x16_bf16(s2 == 0 ? a0 : a1, vf, oa[dt], 0, 0, 0);
            ob[dt] = __builtin_amdgcn_mfma_f32_32x32x16_bf16(s2 == 0 ? b0 : b1, vf, ob[dt], 0, 0, 0);
        }
    }
}

struct BandArgs {
    const bf16_t* Hb;
    int cq, ck, cv;
    int rate, cls, f0, maxd;
    const float* bias;
    float M;
    float sinkterm;
    bf16_t* OA; float* DA;
    bf16_t* Y; int ycol;
    int hd; size_t brow;
};
template <int MODE>
__device__ __forceinline__ void banded_unit(LAS unsigned char* lds, const BandArgs& P) {
    const int tid = opq(threadIdx.x), lane = tid & 63, w = __builtin_amdgcn_readfirstlane(tid >> 6), h = lane >> 5;
    LAS float* sb = (LAS float*)(lds + L_SB);
    LAS float* tbl = (LAS float*)(lds + L_TAB);
    const int KPREV = ((P.maxd + 63) >> 6) << 6, ntl = (KPREV + 256) >> 6;
    const int t0 = (KPREV - P.f0) > 0 ? ((KPREV - P.f0) >> 6) : 0;
    const int srow = tid >> 3, sch = tid & 7;
    StageRegs sr;
    {
        const int kf = P.f0 - KPREV + 64 * t0 + srow;
        const bf16_t* rp = P.Hb + ((size_t)kf * P.rate + P.cls) * HP;
        stage_load(sr, rp + P.ck, rp + P.cv, true, sch);
    }
    const int fq0 = P.f0 + 32 * w;
    bf16x8 qf[4];
    {
        const size_t tq = (size_t)(fq0 + (lane & 31)) * P.rate + P.cls;
        const bf16_t* qp = P.Hb + tq * HP + P.cq + 8 * h;
#pragma unroll
        for (int s = 0; s < 4; ++s) qf[s] = *(const bf16x8*)(qp + 16 * s);
    }
    if (tid < 32) sb[tid] = (P.bias[tid * 16] - P.M) * LOG2E;
    __syncthreads();
    const int DMAXI = P.maxd + 62, TS = P.maxd + 125, TSP = (TS + 7) & ~3;
    for (int e = tid; e < 4 * TSP; e += 512) {
        const int sh = e / TSP, j = e - sh * TSP + sh, dist = DMAXI - j;
        tbl[e] = (j < TS && dist >= 0 && dist <= P.maxd) ? sb[t5_bucket(dist * P.rate)] : -1e30f;
    }
    asm volatile("" : "+v"(qf[0]), "+v"(qf[1]), "+v"(qf[2]), "+v"(qf[3]));
    f32x16 o[2]; o[0] = (f32x16){}; o[1] = (f32x16){};
    float den = 0.f;
    stage_write(lds + L_KV, sr, srow, sch);
    __syncthreads();
    for (int t = t0; t < ntl; ++t) {
        LAS unsigned char* buf = lds + L_KV + ((t - t0) & 1) * KVB;
        const int kf0 = P.f0 - KPREV + 64 * t;
        if (t + 1 < ntl) {
            const int kf = kf0 + 64 + srow;
            const bf16_t* rp = P.Hb + ((size_t)kf * P.rate + P.cls) * HP;
            stage_load(sr, rp + P.ck, rp + P.cv, true, sch);
        }
#pragma unroll
        for (int sub = 0; sub < 2; ++sub) {
            const int kfs = kf0 + 32 * sub;
            if (kfs <= fq0 + 31 && kfs + 31 >= fq0 - P.maxd) {
                const int jb = DMAXI - ((fq0 - kfs) + (lane & 31) - 4 * h);
                f32x16 acc = load_tab16(tbl, TSP, jb);
                qk_sub<0, 4>(acc, buf, sub, qf, lane);
#pragma unroll
                for (int r = 0; r < 1; ++r) den += exp_sum16(acc);
                bf16x8 pa0, pa1; pack_p(acc, pa0, pa1);
                pv_sub(o, buf, sub, pa0, pa1, lane);
            }
        }
        if (t + 1 < ntl) stage_write(lds + L_KV + ((t - t0 + 1) & 1) * KVB, sr, srow, sch);
        __syncthreads();
    }
    float dtot = den + __shfl_xor(den, 32);
    if (MODE == 1) dtot += P.sinkterm;
    LAS float* ws_ = (LAS float*)(lds + L_WSCR) + w * 64;
    if (h == 0) ws_[lane] = dtot;
    if (MODE == 0 && h == 0) {
        const size_t tq = (size_t)(fq0 + lane) * P.rate + P.cls;
        P.DA[(P.brow + tq) * 4 + P.hd] = dtot;
    }
    asm volatile("s_waitcnt lgkmcnt(0)" ::: "memory");
#pragma unroll
    for (int r = 0; r < 16; ++r) {
        const int qi = crow(r, h);
        const float inv = __builtin_amdgcn_rcpf(ws_[qi]);
        const size_t row = P.brow + (size_t)(fq0 + qi) * P.rate + P.cls;
#pragma unroll
        for (int dt = 0; dt < 2; ++dt) {
            const int d = 32 * dt + (lane & 31);
            const float val = o[dt][r] * inv;
            if (MODE == 0) P.OA[row * 256 + P.hd * 64 + d] = f2bf(val);
            else P.Y[row * DM + P.ycol + d] = f2bf(val * bf2f(P.Hb[(row - P.brow) * HP + C_SILU + P.ycol + d]));
        }
    }
}

__device__ __forceinline__ void diff_p1(const LAS float* tp, const LAS unsigned char* buf, int sub, const bf16x8* qf, int lane, bf16x8& pa0, bf16x8& pa1, bf16x8& pb0, bf16x8& pb1) {
    const f32x4 t0 = *(const LAS f32x4*)(tp), t1 = *(const LAS f32x4*)(tp + 8), t2 = *(const LAS f32x4*)(tp + 16), t3 = *(const LAS f32x4*)(tp + 24);
    const f32x16 T = (f32x16){t0[0], t0[1], t0[2], t0[3], t1[0], t1[1], t1[2], t1[3], t2[0], t2[1], t2[2], t2[3], t3[0], t3[1], t3[2], t3[3]};
    const int key = 32 * sub + (lane & 31), h = lane >> 5;
    const LAS unsigned char* kp = buf + key * 128;
    const bf16x8 k0 = *(const LAS bf16x8*)(kp + (((0 + h) ^ (key & 7)) << 4)), k1 = *(const LAS bf16x8*)(kp + (((2 + h) ^ (key & 7)) << 4));
    const bf16x8 k2 = *(const LAS bf16x8*)(kp + (((4 + h) ^ (key & 7)) << 4)), k3 = *(const LAS bf16x8*)(kp + (((6 + h) ^ (key & 7)) << 4));
    f32x16 a1 = __builtin_amdgcn_mfma_f32_32x32x16_bf16(k0, qf[0], T, 0, 0, 0);
    f32x16 a2 = __builtin_amdgcn_mfma_f32_32x32x16_bf16(k2, qf[2], T, 0, 0, 0);
    a1 = __builtin_amdgcn_mfma_f32_32x32x16_bf16(k1, qf[1], a1, 0, 0, 0);
    a2 = __builtin_amdgcn_mfma_f32_32x32x16_bf16(k3, qf[3], a2, 0, 0, 0);
#pragma unroll
    for (int r = 0; r < 16; ++r) { a1[r] = __builtin_amdgcn_exp2f(a1[r]); a2[r] = __builtin_amdgcn_exp2f(a2[r]); }
    pack_p(a1, pa0, pa1); pack_p(a2, pb0, pb1);
}
__device__ __forceinline__ void diff_p2(const LAS unsigned char* buf, int sub, int lane, const bf16x8& pa0, const bf16x8& pa1, const bf16x8& pb0, const bf16x8& pb1, f32x16& dn1, f32x16& dn2, f32x16* o1, f32x16* o2) {
    const bf16x8 ones = (bf16x8){0x3F80, 0x3F80, 0x3F80, 0x3F80, 0x3F80, 0x3F80, 0x3F80, 0x3F80};
    dn1 = __builtin_amdgcn_mfma_f32_32x32x16_bf16(pa0, ones, dn1, 0, 0, 0);
    dn2 = __builtin_amdgcn_mfma_f32_32x32x16_bf16(pb0, ones, dn2, 0, 0, 0);
    dn1 = __builtin_amdgcn_mfma_f32_32x32x16_bf16(pa1, ones, dn1, 0, 0, 0);
    dn2 = __builtin_amdgcn_mfma_f32_32x32x16_bf16(pb1, ones, dn2, 0, 0, 0);
    pv_sub2(o1, o2, buf, sub, pa0, pa1, pb0, pb1, lane);
}

struct DiffArgs {
    const bf16_t* Hb; int hd, qb; size_t brow;
    const float* bias; float M; float lam, lambda_init; const float* subln;
    bf16_t* Y;
};
constexpr int D_SB = 49152, D_TAB = 49664;
__device__ __forceinline__ void diff_unit(LAS unsigned char* lds, const DiffArgs& P) {
    const int tid = opq(threadIdx.x), lane = tid & 63, w = __builtin_amdgcn_readfirstlane(tid >> 6), h = lane >> 5;
    LAS float* sb = (LAS float*)(lds + D_SB);
    LAS float* tbl = (LAS float*)(lds + D_TAB);
    constexpr int DTOP = 1574, TS = DTOP + 63, TSP = (TS + 7) & ~3;
    __syncthreads();
    if (tid < 32) sb[tid] = (P.bias[tid * 16] - P.M) * LOG2E;
    __syncthreads();
    for (int e = tid; e < 4 * TSP; e += 512) {
        const int sh = e / TSP, j = e - sh * TSP + sh, dist = DTOP - j;
        tbl[e] = (j < TS && dist >= 0) ? sb[t5_bucket(dist)] : -1e30f;
    }
    LAS float* farc = tbl + 4 * TSP;
    LAS float* deadr = farc + 32;
    if (tid < 32) { farc[tid] = sb[31]; deadr[tid] = -1e30f; }
    const int q0w = P.qb * 256 + 32 * w;
    const int cq = C_CQ + 64 * P.hd, ck = C_CK + 64 * P.hd, cv = C_CV + 64 * P.hd;
    bf16x8 qf[4];
    {
        const bf16_t* qp = P.Hb + (size_t)(q0w + (lane & 31)) * HP + cq + 8 * h;
#pragma unroll
        for (int s = 0; s < 4; ++s) qf[s] = *(const bf16x8*)(qp + 16 * s);
        asm volatile("" : "+v"(qf[0]), "+v"(qf[1]), "+v"(qf[2]), "+v"(qf[3]));
    }
    const int ntl = 4 * (P.qb + 1);
    const int srow = tid >> 3, sch = tid & 7;
    f32x16 o1[2], o2[2]; o1[0] = (f32x16){}; o1[1] = (f32x16){}; o2[0] = (f32x16){}; o2[1] = (f32x16){};
    f32x16 dn1 = (f32x16){}, dn2 = (f32x16){};
    StageRegs sr;
    {
        const bf16_t* rp = P.Hb + (size_t)srow * HP;
        stage_load(sr, rp + ck, rp + cv, true, sch);
        stage_write(lds, sr, srow, sch);
    }
    __syncthreads();
#define DIFF_TP(KS) ({ const int ks_ = (KS); const int jb_ = DTOP - ((q0w - ks_) + (lane & 31) - 4 * h), sh_ = jb_ & 3; \
        const LAS float* tp_ = tbl + sh_ * TSP + (jb_ - sh_); tp_ = (q0w - ks_ - 31 >= 1513) ? farc : tp_; tp_ = (ks_ > q0w + 31) ? deadr : tp_; tp_; })
#define DIFF_STAGE_LOAD(t) do { const int tn_ = (t) + 1 < ntl ? (t) + 1 : (t); const bf16_t* rp_ = P.Hb + (size_t)(64 * tn_ + srow) * HP; stage_load(sr, rp_ + ck, rp_ + cv, true, sch); } while (0)
    if (w < 4) {
        int cur = 0;
        for (int t = 0; t < ntl; ++t) {
            LAS unsigned char* buf = lds + cur * KVB;
            const int nxt = cur == 2 ? 0 : cur + 1;
            DIFF_STAGE_LOAD(t);
            bf16x8 pa0, pa1, pb0, pb1;
            diff_p1(DIFF_TP(64 * t), buf, 0, qf, lane, pa0, pa1, pb0, pb1);
            diff_p2(buf, 0, lane, pa0, pa1, pb0, pb1, dn1, dn2, o1, o2);
            diff_p1(DIFF_TP(64 * t + 32), buf, 1, qf, lane, pa0, pa1, pb0, pb1);
            diff_p2(buf, 1, lane, pa0, pa1, pb0, pb1, dn1, dn2, o1, o2);
            stage_write(lds + nxt * KVB, sr, srow, sch);
            __syncthreads();
            cur = nxt;
        }
    } else {
        const bf16x8 zero8 = (bf16x8){0, 0, 0, 0, 0, 0, 0, 0};
        bf16x8 qa0 = zero8, qa1 = zero8, qb0 = zero8, qb1 = zero8;
        int cur = 0, prv = 0;
        __builtin_amdgcn_s_setprio(1);
        for (int t = 0; t < ntl; ++t) {
            LAS unsigned char* buf = lds + cur * KVB;
            const int nxt = cur == 2 ? 0 : cur + 1;
            DIFF_STAGE_LOAD(t);
            diff_p2(lds + prv * KVB, 1, lane, qa0, qa1, qb0, qb1, dn1, dn2, o1, o2);
            bf16x8 pa0, pa1, pb0, pb1;
            diff_p1(DIFF_TP(64 * t), buf, 0, qf, lane, pa0, pa1, pb0, pb1);
            diff_p2(buf, 0, lane, pa0, pa1, pb0, pb1, dn1, dn2, o1, o2);
            diff_p1(DIFF_TP(64 * t + 32), buf, 1, qf, lane, qa0, qa1, qb0, qb1);
            stage_write(lds + nxt * KVB, sr, srow, sch);
            __syncthreads();
            prv = cur; cur = nxt;
        }
        diff_p2(lds + prv * KVB, 1, lane, qa0, qa1, qb0, qb1, dn1, dn2, o1, o2);
        __builtin_amdgcn_s_setprio(0);
    }
    __syncthreads();
#undef DIFF_TP
#undef DIFF_STAGE_LOAD
    const float g0 = P.subln[lane & 31] * (1.f - P.lambda_init), g1 = P.subln[32 + (lane & 31)] * (1.f - P.lambda_init);
    const int ycol = 512 + 64 * P.hd;
#pragma unroll
    for (int r = 0; r < 16; ++r) {
        const int qi = crow(r, h);
        const float i1 = __builtin_amdgcn_rcpf(dn1[r]), i2 = P.lam * __builtin_amdgcn_rcpf(dn2[r]);
        const float a0 = o1[0][r] * i1 - o2[0][r] * i2, a1 = o1[1][r] * i1 - o2[1][r] * i2;
        float ss = a0 * a0 + a1 * a1;
        ss += __shfl_xor(ss, 1); ss += __shfl_xor(ss, 2); ss += __shfl_xor(ss, 4); ss += __shfl_xor(ss, 8); ss += __shfl_xor(ss, 16);
        const float rs = rsqrtf(ss * (1.f / 64.f) + 1e-6f);
        const size_t trow = (size_t)(q0w + qi);
        const bf16_t* sp = P.Hb + trow * HP + C_SILU + ycol;
        bf16_t* yp = P.Y + (P.brow + trow) * DM + ycol;
        yp[lane & 31] = f2bf(a0 * rs * g0 * bf2f(sp[lane & 31]));
        yp[32 + (lane & 31)] = f2bf(a1 * rs * g1 * bf2f(sp[32 + (lane & 31)]));
    }
}
struct CmpArgs {
    const bf16_t* Hb;
    int col;
    int rt;
    const float* pos;
    const bf16_t* W1T;
    const float* b1;
    const bf16_t* W2T;
    const float* b2;
    const float* gain;
    bf16_t* OUT;
};
__device__ __forceinline__ void cmp_unit(LAS unsigned char* lds, const CmpArgs& P) {
    const int tid = opq(threadIdx.x), lane = tid & 63, w = __builtin_amdgcn_readfirstlane(tid >> 6), h = lane >> 5;
    LAS unsigned char* hidl = lds + L_KV;
    LAS float* ssx = (LAS float*)(lds + L_KV + 32768 - 512);
    int i = 32 * P.rt + (lane & 31); if (i > 510) i = 510;
    f32x16 acc = (f32x16){};
    const bf16_t* w1p = P.W1T + (size_t)(32 * w + (lane & 31)) * 2048 + 8 * h;
    const bf16_t* hp = P.Hb + (size_t)(16 * i) * HP + P.col + 8 * h;
    const float* pp = P.pos + 8 * h;
#pragma unroll 4
    for (int ks = 0; ks < 128; ++ks) {
        const int tok = ks >> 2, d0 = 16 * (ks & 3);
        const u32x4 raw = *(const u32x4*)(hp + (size_t)tok * HP + d0);
        const f32x4 p0 = *(const f32x4*)(pp + tok * 64 + d0), p1 = *(const f32x4*)(pp + tok * 64 + d0 + 4);
        u32x4 aw;
        aw.x = cvtpk(__uint_as_float(raw.x << 16) + p0[0], __uint_as_float(raw.x & 0xffff0000u) + p0[1]);
        aw.y = cvtpk(__uint_as_float(raw.y << 16) + p0[2], __uint_as_float(raw.y & 0xffff0000u) + p0[3]);
        aw.z = cvtpk(__uint_as_float(raw.z << 16) + p1[0], __uint_as_float(raw.z & 0xffff0000u) + p1[1]);
        aw.w = cvtpk(__uint_as_float(raw.w << 16) + p1[2], __uint_as_float(raw.w & 0xffff0000u) + p1[3]);
        const bf16x8 af = __builtin_bit_cast(bf16x8, aw);
        const bf16x8 bfr = *(const bf16x8*)(w1p + 16 * ks);
        acc = __builtin_amdgcn_mfma_f32_32x32x16_bf16(af, bfr, acc, 0, 0, 0);
    }
    {
        const int j = 32 * w + (lane & 31); const float bb = P.b1[j];
#pragma unroll
        for (int r = 0; r < 16; ++r) {
            const float x = acc[r] + bb;
            const float u = 0.7978845608028654f * (x + 0.044715f * x * x * x);
            const float th = 1.f - 2.f / (1.f + __expf(2.f * u));
            const float gl = 0.5f * x * (1.f + th);
            *(LAS bf16_t*)(hidl + crow(r, h) * 528 + j * 2) = f2bf(gl);
        }
    }
    __syncthreads();
    float outv[16]; float ssp[16];
    if (w < 2) {
        f32x16 a2 = (f32x16){};
        const bf16_t* w2p = P.W2T + (size_t)(32 * w + (lane & 31)) * 256 + 8 * h;
#pragma unroll
        for (int ks = 0; ks < 16; ++ks) {
            const bf16x8 af = *(const LAS bf16x8*)(hidl + (lane & 31) * 528 + (16 * ks + 8 * h) * 2);
            const bf16x8 bfr = *(const bf16x8*)(w2p + 16 * ks);
            a2 = __builtin_amdgcn_mfma_f32_32x32x16_bf16(af, bfr, a2, 0, 0, 0);
        }
        const float bb = P.b2[32 * w + (lane & 31)];
#pragma unroll
        for (int r = 0; r < 16; ++r) {
            outv[r] = a2[r] + bb;
            float ss = outv[r] * outv[r];
            ss += __shfl_xor(ss, 1); ss += __shfl_xor(ss, 2); ss += __shfl_xor(ss, 4); ss += __shfl_xor(ss, 8); ss += __shfl_xor(ss, 16);
            ssp[r] = ss;
            if ((lane & 31) == 0) ssx[w * 32 + crow(r, h)] = ss;
        }
    }
    __syncthreads();
    if (w < 2) {
        const int d = 32 * w + (lane & 31);
        const float gn = P.gain ? P.gain[d] : 1.f;
#pragma unroll
        for (int r = 0; r < 16; ++r) {
            const int row = 32 * P.rt + crow(r, h);
            float v = outv[r];
            if (P.gain) { const float tot = ssx[crow(r, h)] + ssx[32 + crow(r, h)]; v = v * rsqrtf(tot * (1.f / 64.f) + 1e-6f) * gn; }
            if (row <= 510) P.OUT[(size_t)row * 64 + d] = f2bf(v);
        }
    }
    __syncthreads();
}

struct NsaArgs {
    const bf16_t* Hb; size_t brow; int qb;
    const bf16_t* KC; const bf16_t* VC;
    const float* bias;
    const float* Mv;
    bf16_t* Y; unsigned* cdone;
};
constexpr int GTOP = 2015, GTS = 2519, WTOP = 549, WTS = 588, DEAD = 4 * GTS + 4 * WTS;
__device__ __forceinline__ void nsa_unit(LAS unsigned char* lds, const NsaArgs& P) {
    const int tid = opq(threadIdx.x), lane = tid & 63, w = __builtin_amdgcn_readfirstlane(tid >> 6), hh = lane >> 5;
    const int n = lane & 31, q8 = n >> 2, hd = n & 3;
    LAS float* tg = (LAS float*)(lds + L_TAB);
    LAS float* tw = tg + 4 * GTS;
    LAS float* dead = tg + DEAD;
    LAS float* impw = (LAS float*)(lds + L_IMP) + w * 1024;
    LAS unsigned* selw = (LAS unsigned*)(lds + L_SEL) + w * 32;
    LAS unsigned* uni = (LAS unsigned*)(lds + L_SEL) + 256;
    LAS float* ws_ = (LAS float*)(lds + L_WSCR) + w * 256;
    LAS float* sbh = (LAS float*)(lds + L_SB);
    if (tid < 128) sbh[tid] = (P.bias[(tid & 31) * 16 + (tid >> 5)] - P.Mv[tid >> 5]) * LOG2E;
    __syncthreads();
    for (int e = tid; e < 4 * GTS; e += 512) { const int hq = e / GTS, j = e % GTS, dist = GTOP - j;
        tg[e] = dist >= 0 ? sbh[hq * 32 + t5_bucket(dist)] : -1e30f; }
    for (int e = tid; e < 4 * WTS; e += 512) { const int hq = e / WTS, j = e % WTS, dist = WTOP - j;
        tw[e] = (dist >= 0 && dist <= 511) ? sbh[hq * 32 + t5_bucket(dist)] : -1e30f; }
    if (tid < 64) dead[tid] = -1e30f;
    for (int e = lane; e < 1024; e += 64) impw[e] = 0.f;
    if (tid < 4) uni[tid] = 0u;
    const float cfar = sbh[hd * 32 + 31];
    const int tq = 64 * P.qb + 8 * w + q8;
    const int twmin = 64 * P.qb + 8 * w, twmax = twmin + 7;
    bf16x8 qf[4];
    {
        const bf16_t* qp = P.Hb + (size_t)tq * HP + C_DQ + 64 * hd + 8 * hh;
#pragma unroll
        for (int s = 0; s < 4; ++s) qf[s] = *(const bf16x8*)(qp + 16 * s);
        asm volatile("" : "+v"(qf[0]), "+v"(qf[1]), "+v"(qf[2]), "+v"(qf[3]));
    }
    {
        const bf16_t* gp = P.Hb + (size_t)tq * HP + C_GT + 3 * hd;
        if (hh == 0) { ws_[n] = bf2f(gp[0]); ws_[32 + n] = bf2f(gp[1]); ws_[64 + n] = bf2f(gp[2]); }
    }
    const int srow = tid >> 3, sch = tid & 7;
    StageRegs sr;
    f32x16 o[2], outv[2];
    float den = 0.f;
    o[0] = (f32x16){}; o[1] = (f32x16){};
    {
        const int kt0 = P.qb >= 8 ? P.qb - 8 : 0, nkt = P.qb - kt0 + 1;
        {
            const bf16_t* rp = P.Hb + (size_t)(64 * kt0 + srow) * HP;
            stage_load(sr, rp + C_KW, rp + C_VW, true, sch);
            stage_write(lds + L_KV, sr, srow, sch);
        }
        __syncthreads();
        for (int t = 0; t < nkt; ++t) {
            LAS unsigned char* buf = lds + L_KV + (t & 1) * KVB;
            if (t + 1 < nkt) { const bf16_t* rp = P.Hb + (size_t)(64 * (kt0 + t + 1) + srow) * HP; stage_load(sr, rp + C_KW, rp + C_VW, true, sch); }
#pragma unroll
            for (int sub = 0; sub < 2; ++sub) {
                const int kb = 64 * (kt0 + t) + 32 * sub;
                if (kb <= twmax && kb + 31 >= twmin - 511) {
                    f32x16 acc;
                    const LAS float* tb = tw + hd * WTS + (WTOP - (tq - kb - 4 * hh));
#pragma unroll
                    for (int r = 0; r < 16; ++r) acc[r] = tb[(r & 3) + 8 * (r >> 2)];
                    qk_sub<0, 4>(acc, buf, sub, qf, lane);
#pragma unroll
                    for (int r = 0; r < 1; ++r) den += exp_sum16(acc);
                    bf16x8 pa0, pa1; pack_p(acc, pa0, pa1);
                    pv_sub(o, buf, sub, pa0, pa1, lane);
                }
            }
            if (t + 1 < nkt) stage_write(lds + L_KV + ((t + 1) & 1) * KVB, sr, srow, sch);
            __syncthreads();
        }
    }
    {
        const float dt = den + __shfl_xor(den, 32);
        if (hh == 0) ws_[128 + n] = __builtin_amdgcn_rcpf(dt);
        asm volatile("s_waitcnt lgkmcnt(0)" ::: "memory");
#pragma unroll
        for (int r = 0; r < 16; ++r) { const int nn = crow(r, hh); const float gi = ws_[64 + nn] * ws_[128 + nn]; outv[0][r] = o[0][r] * gi; outv[1][r] = o[1][r] * gi; }
    }
    if (opq(threadIdx.x) == 128) {
        unsigned sp = 0;
        while (__hip_atomic_load(P.cdone, __ATOMIC_RELAXED, __HIP_MEMORY_SCOPE_AGENT) < 64u) { __builtin_amdgcn_s_sleep(2); if (++sp > (1u << 24)) break; }
        __builtin_amdgcn_fence(__ATOMIC_ACQUIRE, "agent"); asm volatile("s_waitcnt vmcnt(0)" ::: "memory");
    }
    __syncthreads();
    const int tlast = 64 * P.qb + 63;
    const int ntc = tlast >= 31 ? (((tlast - 31) >> 4) >> 6) + 1 : 0;
    float invden = 0.f; den = 0.f;
    o[0] = (f32x16){}; o[1] = (f32x16){};
    for (int pass = 0; pass < 2; ++pass) {
        if (ntc > 0) {
            __syncthreads();
            stage_load(sr, P.KC + (size_t)srow * 64, P.VC + (size_t)srow * 64, true, sch);
            stage_write(lds + L_KV, sr, srow, sch);
            __syncthreads();
            for (int t = 0; t < ntc; ++t) {
                LAS unsigned char* buf = lds + L_KV + (t & 1) * KVB;
                if (t + 1 < ntc) stage_load(sr, P.KC + (size_t)(64 * (t + 1) + srow) * 64, P.VC + (size_t)(64 * (t + 1) + srow) * 64, true, sch);
#pragma unroll
                for (int sub = 0; sub < 2; ++sub) {
                    const int cb = 64 * t + 32 * sub;
                    if (16 * cb + 31 <= twmax) {
                        f32x16 acc;
                        const int dmin = twmin - 16 * (cb + 31) - 31;
                        if (dmin >= 1513) acc = splat16(cfar);
                        else {
                            const LAS float* tb = tg + hd * GTS + (GTOP - (tq - 31 - 16 * cb - 64 * hh));
#pragma unroll
                            for (int r = 0; r < 16; ++r) acc[r] = tb[16 * ((r & 3) + 8 * (r >> 2))];
                        }
                        qk_sub<0, 4>(acc, buf, sub, qf, lane);
#pragma unroll
                        for (int r = 0; r < 16; ++r) acc[r] = __builtin_amdgcn_exp2f(acc[r]);
                        if (pass == 0) {
#pragma unroll
                            for (int r = 0; r < 16; ++r) { den += acc[r]; asm volatile("" : "+v"(den)); }
                        } else {
#pragma unroll
                            for (int r = 0; r < 16; ++r) acc[r] *= invden;
#pragma unroll
                            for (int g = 0; g < 4; ++g) {
                                float G = (acc[4 * g] + acc[4 * g + 1]) + (acc[4 * g + 2] + acc[4 * g + 3]), C = acc[4 * g + 3];
                                G += __shfl_xor(G, 1); G += __shfl_xor(G, 2); C += __shfl_xor(C, 1); C += __shfl_xor(C, 2);
                                if (hd == 0) {
                                    const int j = (cb >> 2) + 2 * g + hh;
                                    __hip_atomic_fetch_add(impw + q8 * 128 + j, G, __ATOMIC_RELAXED, __HIP_MEMORY_SCOPE_WORKGROUP);
                                    if (j + 1 < 128) __hip_atomic_fetch_add(impw + q8 * 128 + j + 1, C, __ATOMIC_RELAXED, __HIP_MEMORY_SCOPE_WORKGROUP);
                                }
                            }
                            bf16x8 pa0, pa1; pack_p(acc, pa0, pa1);
                            pv_sub(o, buf, sub, pa0, pa1, lane);
                        }
                    }
                }
                if (t + 1 < ntc) stage_write(lds + L_KV + ((t + 1) & 1) * KVB, sr, srow, sch);
                __syncthreads();
            }
        }
        if (pass == 0) { const float dt = den + __shfl_xor(den, 32); invden = dt > 0.f ? 1.f / dt : 0.f; }
    }
    asm volatile("s_waitcnt lgkmcnt(0)" ::: "memory");
#pragma unroll
    for (int r = 0; r < 16; ++r) { const float g0 = ws_[crow(r, hh)]; outv[0][r] += o[0][r] * g0; outv[1][r] += o[1][r] * g0; }
    {
        const int qsel = lane >> 3, sb = lane & 7;
        unsigned key[16];
#pragma unroll
        for (int i4 = 0; i4 < 4; ++i4) {
            const f32x4 v = *(const LAS f32x4*)(impw + qsel * 128 + sb * 16 + 4 * i4);
#pragma unroll
            for (int e = 0; e < 4; ++e) {
                const int j = sb * 16 + 4 * i4 + e;
                const bool forced = (j == 0) | (j == P.qb) | (j == P.qb - 1);
                key[4 * i4 + e] = forced ? 0xFFFFFFFFu : (j <= P.qb ? __float_as_uint(v[e]) + 1u : 0u);
            }
        }
        unsigned T = 0u;
        for (int bit = 31; bit >= 0; --bit) {
            const unsigned cand = T | (1u << bit);
            int cnt = 0;
#pragma unroll
            for (int i = 0; i < 16; ++i) cnt += key[i] >= cand ? 1 : 0;
            cnt += __shfl_xor(cnt, 1); cnt += __shfl_xor(cnt, 2); cnt += __shfl_xor(cnt, 4);
            if (cnt >= 16) T = cand;
        }
        int cgt = 0, ceq = 0;
#pragma unroll
        for (int i = 0; i < 16; ++i) { cgt += key[i] > T ? 1 : 0; ceq += key[i] == T ? 1 : 0; }
        int cg = cgt; cg += __shfl_xor(cg, 1); cg += __shfl_xor(cg, 2); cg += __shfl_xor(cg, 4);
        int pre = 0;
#pragma unroll
        for (int k = 0; k < 8; ++k) { const int v = __shfl(ceq, (lane & ~7) + k); if (k < sb) pre += v; }
        int need = 16 - cg - pre;
        unsigned bits = 0u;
#pragma unroll
        for (int i = 0; i < 16; ++i) {
            const int j = sb * 16 + i;
            bool s_ = key[i] > T;
            if (key[i] == T) { if (need > 0) { s_ = true; } --need; }
            if (s_ && j <= P.qb) bits |= 1u << i;
        }
        const unsigned other = __shfl_xor(bits, 1);
        const unsigned word = (sb & 1) ? ((bits << 16) | other) : (bits | (other << 16));
        if ((sb & 1) == 0) { selw[qsel * 4 + (sb >> 1)] = word; __hip_atomic_fetch_or(uni + (sb >> 1), word, __ATOMIC_RELAXED, __HIP_MEMORY_SCOPE_WORKGROUP); }
    }
    __syncthreads();
    unsigned lm0 = selw[q8 * 4 + 0], lm1 = selw[q8 * 4 + 1], lm2 = selw[q8 * 4 + 2], lm3 = selw[q8 * 4 + 3];
    unsigned wm0 = 0, wm1 = 0, wm2 = 0, wm3 = 0;
#pragma unroll
    for (int k = 0; k < 8; ++k) { wm0 |= selw[k * 4 + 0]; wm1 |= selw[k * 4 + 1]; wm2 |= selw[k * 4 + 2]; wm3 |= selw[k * 4 + 3]; }
    wm0 = __builtin_amdgcn_readfirstlane(wm0); wm1 = __builtin_amdgcn_readfirstlane(wm1); wm2 = __builtin_amdgcn_readfirstlane(wm2); wm3 = __builtin_amdgcn_readfirstlane(wm3);
    const unsigned um0 = __builtin_amdgcn_readfirstlane(uni[0]), um1 = __builtin_amdgcn_readfirstlane(uni[1]), um2 = __builtin_amdgcn_readfirstlane(uni[2]), um3 = __builtin_amdgcn_readfirstlane(uni[3]);
#define NSA_WORD(a0, a1, a2, a3, j) ((j) < 32 ? (a0) : ((j) < 64 ? (a1) : ((j) < 96 ? (a2) : (a3))))
#define NSA_NEXT(j, res) do { int _j = (j); res = 128; while (_j < 128) { const unsigned _w = NSA_WORD(um0, um1, um2, um3, _j) >> (_j & 31); if (_w) { res = _j + __builtin_ctz(_w); break; } _j = (_j | 31) + 1; } } while (0)
    o[0] = (f32x16){}; o[1] = (f32x16){}; den = 0.f;
#define NSA_SLC_COMPUTE(JJ, BUF) do { \
        if ((NSA_WORD(wm0, wm1, wm2, wm3, (JJ)) >> ((JJ) & 31)) & 1u) { \
            const bool lsel = (NSA_WORD(lm0, lm1, lm2, lm3, (JJ)) >> ((JJ) & 31)) & 1u; \
            _Pragma("unroll") for (int sub = 0; sub < 2; ++sub) { \
                const int kb = 64 * (JJ) + 32 * sub; \
                if (kb <= twmax) { \
                    f32x16 acc; \
                    if (twmin - kb - 31 >= 1513) acc = splat16(lsel ? cfar : -1e30f); \
                    else { const LAS float* tb = lsel ? tg + hd * GTS + (GTOP - (tq - kb - 4 * hh)) : dead; \
                        _Pragma("unroll") for (int r = 0; r < 16; ++r) acc[r] = tb[(r & 3) + 8 * (r >> 2)]; } \
                    qk_sub<0, 4>(acc, (BUF), sub, qf, lane); \
                    den += exp_sum16(acc); \
                    bf16x8 pa0, pa1; pack_p(acc, pa0, pa1); \
                    pv_sub(o, (BUF), sub, pa0, pa1, lane); \
                } } } } while (0)
#define NSA_SLC_LOAD(JJ, SR) do { const bf16_t* rp_ = P.Hb + (size_t)(64 * (JJ) + srow) * HP; stage_load(SR, rp_ + C_KS, rp_ + C_VS, true, sch); } while (0)
    if (w >= 4) __builtin_amdgcn_s_setprio(1);
    {
        StageRegs srB;
        LAS unsigned char* pb0 = lds + L_KV; LAS unsigned char* pb1 = lds + L_IMP;
        int ja, jb2; NSA_NEXT(0, ja); jb2 = 128; if (ja < 128) { NSA_NEXT(ja + 1, jb2); }
        if (ja < 128) { NSA_SLC_LOAD(ja, sr); stage_write(pb0, sr, srow, sch); }
        if (jb2 < 128) { NSA_SLC_LOAD(jb2, srB); stage_write(pb0 + KVB, srB, srow, sch); }
        __syncthreads();
        int p = 0;
        while (ja < 128) {
            LAS unsigned char* cb = p ? pb1 : pb0; LAS unsigned char* nbuf = p ? pb0 : pb1;
            int na = 128, nb = 128;
            if (jb2 < 128) { NSA_NEXT(jb2 + 1, na); }
            if (na < 128) { NSA_NEXT(na + 1, nb); }
            if (na < 128) NSA_SLC_LOAD(na, sr);
            if (nb < 128) NSA_SLC_LOAD(nb, srB);
            NSA_SLC_COMPUTE(ja, cb);
            if (jb2 < 128) NSA_SLC_COMPUTE(jb2, cb + KVB);
            if (na < 128) stage_write(nbuf, sr, srow, sch);
            if (nb < 128) stage_write(nbuf + KVB, srB, srow, sch);
            __syncthreads();
            ja = na; jb2 = nb; p ^= 1;
        }
    }
    __builtin_amdgcn_s_setprio(0);
#undef NSA_SLC_COMPUTE
#undef NSA_SLC_LOAD
    {
        const float dt = den + __shfl_xor(den, 32);
        if (hh == 0) ws_[96 + n] = 1.f / dt;
        asm volatile("s_waitcnt lgkmcnt(0)" ::: "memory");
#pragma unroll
        for (int r = 0; r < 16; ++r) { const float gi = ws_[32 + crow(r, hh)] * ws_[96 + crow(r, hh)]; outv[0][r] += o[0][r] * gi; outv[1][r] += o[1][r] * gi; }
    }
    {
#pragma unroll
        for (int r = 0; r < 16; ++r) {
            const int nn = crow(r, hh);
            const size_t trow = (size_t)(64 * P.qb + 8 * w + (nn >> 2));
            const int ycol = 768 + 64 * (nn & 3);
            const bf16_t* sp = P.Hb + trow * HP + C_SILU + ycol;
            bf16_t* yp = P.Y + (P.brow + trow) * DM + ycol;
            yp[n] = f2bf(outv[0][r] * bf2f(sp[n]));
            yp[32 + n] = f2bf(outv[1][r] * bf2f(sp[32 + n]));
        }
    }
    __syncthreads();
#undef NSA_WORD
#undef NSA_NEXT
}
}

#define XB_TMO      128
#define XB_XCNT(j)  (256  + 64 * (j))
#define XB_XSUB(j)  (1280 + 64 * (j))
#define XB_XGEN(j)  (2304 + 64 * (j))
#define XB_TOP      3328
#define XB_TOPGEN   3392
#define XCD_BAR_WORDS 3456
#define XB_SPIN_CAP (1u << 22)
__device__ __forceinline__ unsigned xb_ld(unsigned* p)              { return __hip_atomic_load(p, __ATOMIC_RELAXED, __HIP_MEMORY_SCOPE_AGENT); }
__device__ __forceinline__ unsigned xb_add(unsigned* p, unsigned v) { return __hip_atomic_fetch_add(p, v, __ATOMIC_RELAXED, __HIP_MEMORY_SCOPE_AGENT); }
__device__ __forceinline__ unsigned xb_xcc_id() { return (unsigned)__builtin_amdgcn_s_getreg((3 << 11) | 20) & 0xFu; }
#define XB_SPIN(cond, bar) do { unsigned _sp = 0; while (cond) { __builtin_amdgcn_s_sleep(1); \
    if ((++_sp & 255u) == 0u) { if (xb_ld(&(bar)[XB_TMO])) break; if (_sp > XB_SPIN_CAP) { atomicAdd(&(bar)[XB_TMO], 1u); break; } } } } while (0)
struct XcdBarrier { unsigned* bar; unsigned x; volatile LAS unsigned* st; };
__device__ __forceinline__ XcdBarrier xcd_barrier_post(unsigned* bar, volatile LAS unsigned* st) {
    XcdBarrier b; b.bar = bar; b.x = xb_xcc_id(); b.st = st;
    if (threadIdx.x == 0) (void)xb_add(&bar[XB_XCNT(b.x)], 1u);
    return b;
}
__device__ __forceinline__ void xcd_barrier_complete(unsigned* bar, unsigned x, unsigned& nloc, unsigned& nx) {
    const unsigned G = gridDim.x * gridDim.y * gridDim.z;
    unsigned sum, cnt, mine, sp = 0u;
    for (;;) {
        sum = 0u; cnt = 0u; mine = 0u;
#pragma unroll
        for (unsigned j = 0; j < 16; ++j) { const unsigned c = xb_ld(&bar[XB_XCNT(j)]); sum += c; cnt += (c > 0u) ? 1u : 0u; mine = (j == x) ? c : mine; }
        if (sum == G) break;
        __builtin_amdgcn_s_sleep(1);
        if ((++sp & 255u) == 0u) { if (xb_ld(&bar[XB_TMO])) break; if (sp > XB_SPIN_CAP) { atomicAdd(&bar[XB_TMO], 1u); break; } }
    }
    nloc = mine > 0u ? mine : 1u; nx = cnt > 0u ? cnt : 1u;
}
__device__ __forceinline__ void xcd_barrier(const XcdBarrier& b) {
    asm volatile("s_waitcnt vmcnt(0)" ::: "memory");
    __syncthreads();
    if (threadIdx.x == 0) {
        unsigned* bar = b.bar;
        __builtin_amdgcn_s_waitcnt(0);
        unsigned nloc = b.st[0], nx = b.st[1];
        if (nloc == 0u) { xcd_barrier_complete(bar, b.x, nloc, nx); b.st[0] = nloc; b.st[1] = nx; }
        const unsigned old = xb_add(&bar[XB_XSUB(b.x)], 1u);
        const unsigned gen = old / nloc;
        if (old + 1u == (gen + 1u) * nloc) {
            __builtin_amdgcn_fence(__ATOMIC_RELEASE, "agent");
            asm volatile("s_waitcnt vmcnt(0)" ::: "memory");
            const unsigned og = xb_add(&bar[XB_TOP], 1u);
            const unsigned tg = og / nx;
            if (og + 1u == (tg + 1u) * nx) xb_add(&bar[XB_TOPGEN], 1u);
            else XB_SPIN(xb_ld(&bar[XB_TOPGEN]) == tg, bar);
            __builtin_amdgcn_fence(__ATOMIC_ACQUIRE, "agent");
            xb_add(&bar[XB_XGEN(b.x)], 1u);
            asm volatile("s_waitcnt vmcnt(0)" ::: "memory");
        } else {
            XB_SPIN(xb_ld(&bar[XB_XGEN(b.x)]) == gen, bar);
            __builtin_amdgcn_fence(__ATOMIC_ACQUIRE, "agent");
            asm volatile("s_waitcnt vmcnt(0)" ::: "memory");
        }
    }
    __syncthreads();
}

constexpr int NT = 512, LDS_BYTES = 147456, MISC_OFF = 131072 + 320;
#ifndef R_C
#define R_C 1
#endif
#ifndef R_D
#define R_D 1
#endif
#ifndef R_AB
#define R_AB 1
#endif
#ifndef R_G1
#define R_G1 1
#endif
constexpr size_t MiB = 1u << 20;
constexpr size_t WS_CTL = 0, CTL_ZERO_BYTES = 65536;
constexpr size_t WS_H = 2 * MiB, WS_XN = 124 * MiB, WS_T0 = 158 * MiB, WS_IMP = 208 * MiB, WS_SEL = 217 * MiB, WS_HID = 218 * MiB, WS_KC = 221 * MiB, WS_VC = 222 * MiB, WS_WIN = 224 * MiB, WS_WOUT = 240 * MiB, WS_MX = 1 * MiB, WS_DA = 245 * MiB, WS_CW1 = 246 * MiB, WS_CW2 = 250 * MiB, WS_RSS = 251 * MiB;

struct Args { const float* in[15]; float* out; unsigned char* ws; };

__global__ void __launch_bounds__(NT, 2) mega_fwd(Args args) {
    extern __shared__ __attribute__((aligned(16))) unsigned char lds[];
    const int tid = threadIdx.x, lane = tid & 63, wid = tid >> 6;
    const int G = gridDim.x, bid = blockIdx.x;
    volatile LAS unsigned* MISC = (volatile LAS unsigned*)((LAS unsigned char*)lds + MISC_OFF);
    if (tid < 32) MISC[tid] = 0u;
    __syncthreads();
    unsigned char* ws = args.ws;
    XcdBarrier bar = xcd_barrier_post((unsigned*)(ws + WS_CTL) + 4096, MISC + 8);
    const float* x = args.in[0]; const float* tab = args.in[1]; const float* norm_w = args.in[2];
    const float* w_in = args.in[3]; const float* w_out = args.in[4]; const float* qk_gain = args.in[5];
    const float* qk_gain_diff = args.in[6]; const float* sinks = args.in[7]; const float* diff_lambda = args.in[8];
    const float* diff_subln = args.in[9]; const float* cmp_pos = args.in[10]; const float* cmp_w1 = args.in[11];
    const float* cmp_b1 = args.in[12]; const float* cmp_w2 = args.in[13]; const float* cmp_b2 = args.in[14];
    float* out = args.out;
    bf16_t* H = (bf16_t*)(ws + WS_H);
    bf16_t* XN = (bf16_t*)(ws + WS_XN); bf16_t* Y = XN;
    float* T0 = (float*)(ws + WS_T0);
    float* OC = T0; float* OS_ = T0 + (size_t)MROWS * 256; float* OW = T0 + (size_t)MROWS * 512; float* CT = T0;
    float* IMP = (float*)(ws + WS_IMP); unsigned* SEL = (unsigned*)(ws + WS_SEL); float* HID = (float*)(ws + WS_HID);
    float* KC = (float*)(ws + WS_KC); float* VC = (float*)(ws + WS_VC);
    const int GT = G * NT, GW = G * 8;
    bf16_t* WinT = (bf16_t*)(ws + WS_WIN); bf16_t* WoutT = (bf16_t*)(ws + WS_WOUT);
#define GRID_BAR() do { XcdBarrier b2_ = bar; asm volatile("" : "+s"(b2_.x)); xcd_barrier(b2_); } while (0)
    {
        LAS float* scr = (LAS float*)((LAS unsigned char*)lds + wid * 16384);
        const int gw0 = bid * 8 + wid;
        constexpr int I_IN = 16 * 120, I_OUT = 16 * 32, I_C1 = 32 * 8, I_C2 = 4 * 2, I_L = I_IN + I_OUT + 2 * I_C1 + 2 * I_C2, NITEMS = 2 * I_L;
        bf16_t* CW1T = (bf16_t*)(ws + WS_CW1); bf16_t* CW2T = (bf16_t*)(ws + WS_CW2);
        for (int it = gw0; it < NITEMS; it += GW) {
            const int l = it / I_L; int r = it % I_L;
            if (r < I_IN) { p0_transpose_item<0>(w_in + (size_t)l * DM * PW, WinT + (size_t)l * HP * DM, scr, r, lane); continue; } r -= I_IN;
            if (r < I_OUT) { p0_transpose_item<1>(w_out + (size_t)l * DM * DM, WoutT + (size_t)l * DM * DM, scr, r, lane); continue; } r -= I_OUT;
            if (r < 2 * I_C1) { const int kv = r / I_C1; p0_transpose_item<1>(cmp_w1 + (size_t)(l * 2 + kv) * 2048 * 256, CW1T + (size_t)(l * 2 + kv) * 256 * 2048, scr, r % I_C1, lane, 2048, 256); continue; } r -= 2 * I_C1;
            { const int kv = r / I_C2; p0_transpose_item<1>(cmp_w2 + (size_t)(l * 2 + kv) * 256 * 64, CW2T + (size_t)(l * 2 + kv) * 64 * 256, scr, r % I_C2, lane, 256, 64); }
        }
        if (bid == 1 && tid < 256) { bf16_t* KCb = (bf16_t*)(ws + WS_KC); KCb[(size_t)(tid >> 6) * 512 * 64 + 511 * 64 + (tid & 63)] = 0; }
        for (int w = gw0; w < MROWS; w += GW) k_rmsnorm(w, lane, x, norm_w, XN);
        for (int v = bid * NT + tid; v < MROWS; v += GT) ((unsigned long long*)(ws + WS_RSS))[v] = 0ull;
        if (bid == 0 && wid == 0) {
            float* MX = (float*)(ws + WS_MX);
            for (int l = 0; l < 2; ++l) {
                float mg[8];
#pragma unroll
                for (int i = 0; i < 8; ++i) { float v = fabsf(qk_gain[l * 512 + i * 64 + lane]);
#pragma unroll
                    for (int o = 1; o < 64; o <<= 1) v = fmaxf(v, __shfl_xor(v, o));
                    mg[i] = v; }
                float md0 = lane < 32 ? fabsf(qk_gain_diff[l * 64 + lane]) : 0.f, md1 = lane < 32 ? fabsf(qk_gain_diff[l * 64 + 32 + lane]) : 0.f;
#pragma unroll
                for (int o = 1; o < 64; o <<= 1) { md0 = fmaxf(md0, __shfl_xor(md0, o)); md1 = fmaxf(md1, __shfl_xor(md1, o)); }
                for (int gh = 0; gh < 16; ++gh) {
                    float mb = lane < 32 ? fabsf(tab[lane * 16 + gh]) : 0.f;
#pragma unroll
                    for (int o = 1; o < 64; o <<= 1) mb = fmaxf(mb, __shfl_xor(mb, o));
                    const int grp = gh >> 2, hh = gh & 3; float Mv;
                    if (grp == 0) Mv = 8.f * mg[0] * mg[1] + mb;
                    else if (grp == 1) Mv = fmaxf(8.f * mg[2] * mg[3] + mb, sinks[l * 4 + hh]);
                    else if (grp == 2) Mv = 5.656854249f * md0 * md1 + mb;
                    else Mv = 8.f * mg[4] * fmaxf(mg[5], fmaxf(mg[6], mg[7])) + mb;
                    if (lane == 0) MX[l * 16 + gh] = Mv;
                }
                float s1 = lane < 32 ? diff_lambda[l * 128 + lane] * diff_lambda[l * 128 + 32 + lane] : 0.f;
                float s2 = lane < 32 ? diff_lambda[l * 128 + 64 + lane] * diff_lambda[l * 128 + 96 + lane] : 0.f;
#pragma unroll
                for (int o = 1; o < 64; o <<= 1) { s1 += __shfl_xor(s1, o); s2 += __shfl_xor(s2, o); }
                const float lambda_init = 0.8f - 0.6f * expf(-0.3f * (float)l);
                if (lane == 0) { MX[32 + l] = expf(s1) - expf(s2) + lambda_init; MX[34 + l] = lambda_init; }
            }
        }
    }
    GRID_BAR();
#pragma unroll 1
    for (int l = 0; l < 2; ++l) {
        const float* xprev = l == 0 ? x : out;
        { pg8::Gemm g{XN, WinT + (size_t)l * HP * DM, MROWS, HP, DM}; pg8::StaticOrder So; So.init(MROWS, HP, G, bid);
          pg8::EpiProj E{H, qk_gain + l * 512, qk_gain_diff + l * 64, l == 0 ? nullptr : (const float*)(ws + WS_RSS)};
          for (int rep = 0; rep < R_G1; ++rep) pg8::gemm_phase<pg8::EpiProj, pg8::StaticOrder, true, true>((LAS unsigned char*)lds, g, So, E); }
        GRID_BAR();
        {
            const float* MX = (const float*)(ws + WS_MX);
            bf16_t* OA = (bf16_t*)(ws + WS_T0); float* DA = (float*)(ws + WS_DA);
            bf16_t* KCb = (bf16_t*)(ws + WS_KC);
            const bf16_t* CW1T = (const bf16_t*)(ws + WS_CW1); const bf16_t* CW2T = (const bf16_t*)(ws + WS_CW2);
            LAS unsigned* qw = (LAS unsigned*)((LAS unsigned char*)lds + att::L_Q);
            unsigned* qctr = (unsigned*)(ws + WS_CTL) + 8192 + 128 * l;
            unsigned* cdone = qctr + 64;
            constexpr int B0 = 64, B1 = B0 + 160 * R_C, B2 = B1 + 256 * R_D, B3 = B2 + 96 * R_C, B4 = B3 + 768 * R_AB, NUV = B4 + 256 * R_AB;
            for (;;) {
                if (opq(threadIdx.x) == 0) *qw = atomicAdd(qctr, 1u);
                __syncthreads();
                const int uv = (int)*qw;
                __syncthreads();
                if (uv >= NUV) break;
                int u;
                if (uv < B0) u = uv; else if (uv < B1) u = 64 + (uv - B0) / R_C; else if (uv < B2) u = 224 + (uv - B1) / R_D; else if (uv < B3) u = 480 + (uv - B2) / R_C;
                else if (uv < B4) u = 576 + (uv - B3) / R_AB; else u = 1344 + (uv - B4) / R_AB;
                if (u < 64) {
                    const int kv = u >> 5, b = (u >> 4) & 1, rt = u & 15;
                    att::CmpArgs P; P.Hb = H + (size_t)b * S * HP; P.col = kv == 0 ? C_KC : C_VC; P.rt = rt;
                    P.pos = cmp_pos + (size_t)(l * 2 + kv) * 2048; P.W1T = CW1T + (size_t)(l * 2 + kv) * 256 * 2048; P.b1 = cmp_b1 + (l * 2 + kv) * 256;
                    P.W2T = CW2T + (size_t)(l * 2 + kv) * 64 * 256; P.b2 = cmp_b2 + (l * 2 + kv) * 64; P.gain = kv == 0 ? qk_gain + l * 512 + 5 * 64 : nullptr;
                    P.OUT = KCb + (size_t)(kv * NB + b) * 512 * 64;
                    att::cmp_unit((LAS unsigned char*)lds, P);
                    asm volatile("s_waitcnt vmcnt(0)" ::: "memory");
                    __syncthreads();
                    if (opq(threadIdx.x) == 64) { __builtin_amdgcn_fence(__ATOMIC_RELEASE, "agent"); asm volatile("s_waitcnt vmcnt(0)" ::: "memory");
                        __hip_atomic_fetch_add(cdone, 1u, __ATOMIC_RELAXED, __HIP_MEMORY_SCOPE_AGENT); }
                    __syncthreads();
                } else if ((u >= 64 && u < 224) || (u >= 480 && u < 576)) {
                    int qb, bh;
                    if (u < 224) { qb = 31 - ((u - 64) >> 3); bh = (u - 64) & 7; } else { qb = 11 - ((u - 480) >> 3); bh = (u - 480) & 7; }
                    const int b = bh >> 2, hd = bh & 3;
                    att::DiffArgs P; P.Hb = H + (size_t)b * S * HP; P.hd = hd; P.qb = qb; P.brow = (size_t)b * S;
                    P.bias = tab + 8 + hd; P.M = MX[l * 16 + 8 + hd]; P.lam = MX[32 + l]; P.lambda_init = MX[34 + l]; P.subln = diff_subln + l * 64; P.Y = Y;
                    att::diff_unit((LAS unsigned char*)lds, P);
                } else if (u < 480) {
                    const int idx = u - 224, qb64 = 127 - (idx >> 1), b = idx & 1;
                    att::NsaArgs P; P.Hb = H + (size_t)b * S * HP; P.brow = (size_t)b * S; P.qb = qb64;
                    P.KC = KCb + (size_t)(0 * NB + b) * 512 * 64; P.VC = KCb + (size_t)(1 * NB + b) * 512 * 64;
                    P.bias = tab + 12; P.Mv = MX + l * 16 + 12; P.Y = Y; P.cdone = cdone;
                    att::nsa_unit((LAS unsigned char*)lds, P);
                } else if (u < 1344) {
                    const int v = u - 576, cfg = v >> 8, b = (v >> 7) & 1, hd = (v >> 5) & 3, ti = v & 31;
                    const int rate = cfg == 0 ? 1 : (cfg == 1 ? 4 : 16), tpc = 32 / rate;
                    att::BandArgs P; P.Hb = H + (size_t)b * S * HP; P.cq = C_AQ + 64 * hd; P.ck = C_AK + 64 * hd; P.cv = C_AV + 64 * hd;
                    P.rate = rate; P.cls = ti / tpc; P.f0 = (ti % tpc) * 256; P.maxd = 128; P.bias = tab + hd; P.M = MX[l * 16 + hd]; P.sinkterm = 0.f;
                    P.OA = OA + (size_t)cfg * MROWS * 256; P.DA = DA + (size_t)cfg * MROWS * 4; P.Y = nullptr; P.ycol = 0; P.hd = hd; P.brow = (size_t)b * S;
                    att::banded_unit<0>((LAS unsigned char*)lds, P);
                } else {
                    const int v = u - 1344, b = (v >> 7) & 1, hd = (v >> 5) & 3, ti = v & 31;
                    att::BandArgs P; P.Hb = H + (size_t)b * S * HP; P.cq = C_BQ + 64 * hd; P.ck = C_BK + 64 * (hd >> 1); P.cv = C_BV + 64 * (hd >> 1);
                    P.rate = 1; P.cls = 0; P.f0 = ti * 256; P.maxd = 127; P.bias = tab + 4 + hd; P.M = MX[l * 16 + 4 + hd];
                    P.sinkterm = __expf(sinks[l * 4 + hd] - P.M);
                    P.OA = nullptr; P.DA = nullptr; P.Y = Y; P.ycol = 256 + 64 * hd; P.hd = hd; P.brow = (size_t)b * S;
                    att::banded_unit<1>((LAS unsigned char*)lds, P);
                }
            }
        }
        GRID_BAR();
        {
            const bf16_t* OA = (const bf16_t*)(ws + WS_T0); const float* DA = (const float*)(ws + WS_DA);
            for (int v = (bid * NT + opq(threadIdx.x)); v < MROWS * 32; v += GT) {
                const int row = v >> 5, hd = (v >> 3) & 3, c8 = v & 7;
                float acc8[8] = {0.f, 0.f, 0.f, 0.f, 0.f, 0.f, 0.f, 0.f}; float dsum = 0.f;
#pragma unroll
                for (int cfg = 0; cfg < 3; ++cfg) {
                    const float dn = DA[((size_t)cfg * MROWS + row) * 4 + hd]; dsum += dn;
                    const uint4 r4 = *(const uint4*)(OA + ((size_t)cfg * MROWS + row) * 256 + hd * 64 + c8 * 8);
                    acc8[0] += dn * __uint_as_float(r4.x << 16); acc8[1] += dn * __uint_as_float(r4.x & 0xffff0000u);
                    acc8[2] += dn * __uint_as_float(r4.y << 16); acc8[3] += dn * __uint_as_float(r4.y & 0xffff0000u);
                    acc8[4] += dn * __uint_as_float(r4.z << 16); acc8[5] += dn * __uint_as_float(r4.z & 0xffff0000u);
                    acc8[6] += dn * __uint_as_float(r4.w << 16); acc8[7] += dn * __uint_as_float(r4.w & 0xffff0000u);
                }
                const float inv = 1.f / dsum;
                const uint4 s4 = *(const uint4*)(H + (size_t)row * HP + C_SILU + hd * 64 + c8 * 8);
                uint4 o4;
                o4.x = (unsigned)f2bf(acc8[0] * inv * __uint_as_float(s4.x << 16)) | ((unsigned)f2bf(acc8[1] * inv * __uint_as_float(s4.x & 0xffff0000u)) << 16);
                o4.y = (unsigned)f2bf(acc8[2] * inv * __uint_as_float(s4.y << 16)) | ((unsigned)f2bf(acc8[3] * inv * __uint_as_float(s4.y & 0xffff0000u)) << 16);
                o4.z = (unsigned)f2bf(acc8[4] * inv * __uint_as_float(s4.z << 16)) | ((unsigned)f2bf(acc8[5] * inv * __uint_as_float(s4.z & 0xffff0000u)) << 16);
                o4.w = (unsigned)f2bf(acc8[6] * inv * __uint_as_float(s4.w << 16)) | ((unsigned)f2bf(acc8[7] * inv * __uint_as_float(s4.w & 0xffff0000u)) << 16);
                *(uint4*)(Y + (size_t)row * DM + hd * 64 + c8 * 8) = o4;
            }
        }
        GRID_BAR();
        { pg8::Gemm g{Y, WoutT + (size_t)l * DM * DM, MROWS, DM, DM}; pg8::StaticOrder So; So.init(MROWS, DM, G, bid);
          pg8::EpiOut E{xprev, out, (LAS float*)((LAS unsigned char*)lds + 132096), l == 0 ? XN : nullptr, norm_w + DM, (float*)(ws + WS_RSS)};
          pg8::gemm_phase<pg8::EpiOut, pg8::StaticOrder, true, true>((LAS unsigned char*)lds, g, So, E); }
        if (l == 0) GRID_BAR();
    }
}

extern "C" void kernel_launch(void* const* d_in, const int* in_sizes, int n_in, void* d_out, int out_size, void* d_ws, size_t ws_size, hipStream_t stream) {
    static int grid = 0;
    if (grid == 0) {
        int dev = 0, cus = 0;
        (void)hipGetDevice(&dev);
        (void)hipDeviceGetAttribute(&cus, hipDeviceAttributeMultiprocessorCount, dev);
        (void)hipFuncSetAttribute((const void*)mega_fwd, hipFuncAttributeMaxDynamicSharedMemorySize, LDS_BYTES);
        grid = cus > 0 ? cus : 256;
    }
    (void)hipMemsetAsync((char*)d_ws + WS_CTL, 0, CTL_ZERO_BYTES, stream);
    Args a{};
    for (int i = 0; i < 15; ++i) a.in[i] = (const float*)d_in[i];
    a.out = (float*)d_out; a.ws = (unsigned char*)d_ws;
    hipLaunchKernelGGL(mega_fwd, dim3(grid), dim3(NT), LDS_BYTES, stream, a);
}
```

```cpp
#include <hip/hip_runtime.h>
#include <stdint.h>
#include <math.h>

typedef unsigned short bf16_t;
__device__ __forceinline__ float bf2f(bf16_t v) { return __uint_as_float((unsigned)v << 16); }
__device__ __forceinline__ bf16_t f2bf(float f) { unsigned u = __float_as_uint(f); return (bf16_t)((u + 0x7fffu + ((u >> 16) & 1u)) >> 16); }

constexpr int NB = 2, S = 8192, DM = 1024, MROWS = NB * S, PW = 3724, HP = 3840;
constexpr int C_AQ = 0, C_AK = 256, C_AV = 512, C_BQ = 768, C_BK = 1024, C_BV = 1152, C_CQ = 1280, C_CK = 1536, C_CV = 1792,
              C_DQ = 2048, C_KC = 2304, C_VC = 2368, C_KS = 2432, C_VS = 2496, C_KW = 2560, C_VW = 2624, C_GT = 2688, C_SILU = 2816;
constexpr float EPS = 1e-6f;
__device__ __forceinline__ int opq(int v) { asm volatile("" : "+v"(v)); return v; }

__device__ __forceinline__ int t5_bucket(int n) {
    if (n < 16) return n < 0 ? 0 : n;
    int b = 16;
    b += (n >= 22); b += (n >= 30); b += (n >= 40); b += (n >= 54); b += (n >= 73); b += (n >= 99); b += (n >= 134); b += (n >= 182);
    b += (n >= 246); b += (n >= 332); b += (n >= 450); b += (n >= 609); b += (n >= 825); b += (n >= 1117); b += (n >= 1513);
    return b;
}

__device__ __forceinline__ void k_rmsnorm(const int wave, const int lane, const float* __restrict__ x, const float* __restrict__ g, bf16_t* __restrict__ xn) {
    if (wave >= MROWS) return;
    const float4* xr = (const float4*)(x + (size_t)wave * DM);
    float4 v[4]; float ss = 0.f;
#pragma unroll
    for (int j = 0; j < 4; ++j) { v[j] = xr[lane + 64 * j]; ss += (v[j].x * v[j].x + v[j].y * v[j].y) + (v[j].z * v[j].z + v[j].w * v[j].w); }
#pragma unroll
    for (int o = 1; o < 64; o <<= 1) ss += __shfl_xor(ss, o);
    const float rstd = rsqrtf(ss * (1.f / DM) + EPS);
#pragma unroll
    for (int j = 0; j < 4; ++j) {
        const float4 gg = ((const float4*)g)[lane + 64 * j];
        uint2 o; o.x = (unsigned)f2bf(v[j].x * rstd * gg.x) | ((unsigned)f2bf(v[j].y * rstd * gg.y) << 16);
        o.y = (unsigned)f2bf(v[j].z * rstd * gg.z) | ((unsigned)f2bf(v[j].w * rstd * gg.w) << 16);
        ((uint2*)(xn + (size_t)wave * DM))[lane + 64 * j] = o;
    }
}

template <int D>
__device__ __forceinline__ float dot_row(const float* q, const bf16_t* kr) {
    float s = 0.f;
#pragma unroll
    for (int c = 0; c < D / 8; ++c) {
        const uint4 r = *(const uint4*)(kr + 8 * c);
        s += q[8 * c + 0] * __uint_as_float(r.x << 16) + q[8 * c + 1] * __uint_as_float(r.x & 0xffff0000u);
        s += q[8 * c + 2] * __uint_as_float(r.y << 16) + q[8 * c + 3] * __uint_as_float(r.y & 0xffff0000u);
        s += q[8 * c + 4] * __uint_as_float(r.z << 16) + q[8 * c + 5] * __uint_as_float(r.z & 0xffff0000u);
        s += q[8 * c + 6] * __uint_as_float(r.w << 16) + q[8 * c + 7] * __uint_as_float(r.w & 0xffff0000u);
        if (c & 1) asm volatile("" ::: "memory");
    }
    return s;
}
__device__ __forceinline__ void os_step(float s, const bf16_t* vr, float& m, float& den, float* o) {
    const float mn = fmaxf(m, s), sc = __expf(m - mn), p = __expf(s - mn);
    den = den * sc + p; m = mn;
#pragma unroll
    for (int c = 0; c < 8; ++c) {
        const uint4 r = *(const uint4*)(vr + 8 * c);
        o[8 * c + 0] = o[8 * c + 0] * sc + p * __uint_as_float(r.x << 16); o[8 * c + 1] = o[8 * c + 1] * sc + p * __uint_as_float(r.x & 0xffff0000u);
        o[8 * c + 2] = o[8 * c + 2] * sc + p * __uint_as_float(r.y << 16); o[8 * c + 3] = o[8 * c + 3] * sc + p * __uint_as_float(r.y & 0xffff0000u);
        o[8 * c + 4] = o[8 * c + 4] * sc + p * __uint_as_float(r.z << 16); o[8 * c + 5] = o[8 * c + 5] * sc + p * __uint_as_float(r.z & 0xffff0000u);
        o[8 * c + 6] = o[8 * c + 6] * sc + p * __uint_as_float(r.w << 16); o[8 * c + 7] = o[8 * c + 7] * sc + p * __uint_as_float(r.w & 0xffff0000u);
        if (c & 1) asm volatile("" ::: "memory");
    }
}
template <int D>
__device__ __forceinline__ void load_q(float* q, const bf16_t* p) {
#pragma unroll
    for (int c = 0; c < D / 8; ++c) {
        const uint4 r = *(const uint4*)(p + 8 * c);
        q[8 * c + 0] = __uint_as_float(r.x << 16); q[8 * c + 1] = __uint_as_float(r.x & 0xffff0000u);
        q[8 * c + 2] = __uint_as_float(r.y << 16); q[8 * c + 3] = __uint_as_float(r.y & 0xffff0000u);
        q[8 * c + 4] = __uint_as_float(r.z << 16); q[8 * c + 5] = __uint_as_float(r.z & 0xffff0000u);
        q[8 * c + 6] = __uint_as_float(r.w << 16); q[8 * c + 7] = __uint_as_float(r.w & 0xffff0000u);
    }
}

#define LAS __attribute__((address_space(3)))
namespace pg8 {
#define PG8_LAS __attribute__((address_space(3)))
typedef unsigned short bf16_t;
typedef short bf16x8 __attribute__((ext_vector_type(8)));
typedef float f32x4 __attribute__((ext_vector_type(4)));
typedef unsigned u32x4 __attribute__((ext_vector_type(4)));
constexpr int BM = 256, BK = 64, HALF = 128, HTB = HALF * BK * 2  , STAGE_BYTES = 8 * HTB, NXCD = 8, WGM = 8;

__host__ __device__ __forceinline__ int lds_byte(int r, int c) { const int st = (r >> 4) * 2 + (c >> 5), rr = r & 15, cc = c & 31, ob = rr * 64 + cc * 2; return st * 1024 + (ob ^ (((ob >> 9) & 1) << 5)); }
__host__ __device__ __forceinline__ void stage_rc(int b, int& R, int& C) { const int st = b / 1024, sb = b % 1024, swz = sb ^ (((sb >> 9) & 1) << 5); R = (st >> 1) * 16 + swz / 64; C = (st & 1) * 32 + (swz % 64) / 2; }
__host__ __device__ __forceinline__ int perm32(int rho) { const int n = rho >> 4, i = rho & 15; return 8 * (i >> 2) + 4 * n + (i & 3); }

struct Unit { int pm, pn; };
struct Gemm { const bf16_t* A; const bf16_t* Bt; int M, N, K; };

struct StaticOrder {
    int nM, nN, nwg, G, c;
    __host__ __device__ void init(int M, int N, int G_, int c_) { nM = M / BM; nN = N / BM; nwg = nM * nN; G = G_; c = c_; }
    __host__ __device__ bool next(int i, Unit& u) const {
        const long L = (long)i * G + c; if (L >= nwg) return false;
        int wgid = (int)L; { const int q = nwg / NXCD, r = nwg % NXCD, xcd = wgid % NXCD, off = wgid / NXCD; wgid = (xcd < r ? xcd * (q + 1) : r * (q + 1) + (xcd - r) * q) + off; }
        const int nig = WGM * nN, gid = wgid / nig, fm = gid * WGM, gsz = (nM - fm) < WGM ? (nM - fm) : WGM;
        u.pm = fm + ((wgid % nig) % gsz); u.pn = (wgid % nig) / gsz; return true;
    }
    __device__ __forceinline__ void a_ready(const Unit&) const {}
    __device__ __forceinline__ void done(const Unit&) const {}
};

__device__ __forceinline__ unsigned cvt_pk_bf16(float lo, float hi) { unsigned r; asm volatile("v_cvt_pk_bf16_f32 %0, %1, %2" : "=v"(r) : "v"(lo), "v"(hi)); return r; }
template <class Epi, class Sched, bool ALIGN_EPI = false, bool SP2 = false>
__device__ __forceinline__ void gemm_phase(PG8_LAS unsigned char* lds, const Gemm g, const Sched& S, const Epi& E) {
    const int tid = opq(threadIdx.x), wid = __builtin_amdgcn_readfirstlane(tid >> 6), lane = tid & 63, wr = wid >> 2, wc = wid & 3, fr = lane & 15, fq = lane >> 4;
    const int K = g.K, nt = K / BK;
    unsigned voffA[2], voffB[2];
#pragma unroll
    for (int i = 0; i < 2; ++i) { int R, C; stage_rc(tid * 16 + i * 8192, R, C); const int Rb = Epi::PERM ? ((R & ~31) + perm32(R & 31)) : R;
        voffA[i] = (unsigned)(R * K + C) * 2u; voffB[i] = (unsigned)(Rb * K + C) * 2u; }
    const size_t kstep = (size_t)(BK * 2);
    const size_t hstep = (size_t)HALF * K * 2;
    const size_t tstep = 2 * hstep;
    const unsigned ldsw = (unsigned)wid * 1024u;
    const int aoff = lds_byte(wr * 64 + fr, fq * 8), boff = lds_byte(wc * 32 + fr, fq * 8);
#define PG8_SA(b, h) (((b) * 2 + (h)) * HTB)
#define PG8_SB(b, h) ((4 + (b) * 2 + (h)) * HTB)
#define PG8_STAGE(bufoff, gbase, voff) do { _Pragma("unroll") for (int _i = 0; _i < 2; ++_i) \
        __builtin_amdgcn_global_load_lds((const unsigned*)((const char*)(gbase) + (voff)[_i]), (PG8_LAS unsigned*)(lds + (bufoff) + ldsw + _i * 8192), 16, 0, 0); } while (0)
#define PG8_LDA(dst, b, h) do { _Pragma("unroll") for (int m = 0; m < 4; ++m) _Pragma("unroll") for (int k = 0; k < 2; ++k) dst[m][k] = *(const PG8_LAS bf16x8*)(lds + PG8_SA(b, h) + aoff + m * 2048 + k * 1024); } while (0)
#define PG8_LDB(dst, b, h) do { _Pragma("unroll") for (int n = 0; n < 2; ++n) _Pragma("unroll") for (int k = 0; k < 2; ++k) dst[n][k] = *(const PG8_LAS bf16x8*)(lds + PG8_SB(b, h) + boff + n * 2048 + k * 1024); } while (0)
#define PG8_MMA(ai, bj, At, Bt) do { __builtin_amdgcn_s_setprio(1); _Pragma("unroll") for (int m = 0; m < 4; ++m) _Pragma("unroll") for (int n = 0; n < 2; ++n) _Pragma("unroll") for (int k = 0; k < 2; ++k) \
        acc[ai][bj][m][n] = __builtin_amdgcn_mfma_f32_16x16x32_bf16(Bt[n][k], At[m][k], acc[ai][bj][m][n], 0, 0, 0); __builtin_amdgcn_s_setprio(0); } while (0)
#define PG8_WAIT_V(n) asm volatile("s_waitcnt vmcnt(" #n ")" ::: "memory")
#define PG8_WAIT_L(n) asm volatile("s_waitcnt lgkmcnt(" #n ")" ::: "memory")
#define PG8_BAR __builtin_amdgcn_s_barrier()
#define PG8_SCHED __builtin_amdgcn_sched_barrier(0)
    Unit cur, nxt; int ui = 0;
    if (!S.next(0, cur)) return;
    f32x4 acc[2][2][4][2];
#pragma unroll
    for (int a = 0; a < 2; ++a)
#pragma unroll
        for (int b = 0; b < 2; ++b)
#pragma unroll
            for (int m = 0; m < 4; ++m)
#pragma unroll
                for (int n = 0; n < 2; ++n) acc[a][b][m][n] = (f32x4){0.f, 0.f, 0.f, 0.f};
    bf16x8 At[4][2], B0[2][2], B1[2][2];
    const char* cA = (const char*)g.A + (size_t)cur.pm * tstep; const char* cB = (const char*)g.Bt + (size_t)cur.pn * tstep;
    S.a_ready(cur);
    if constexpr (SP2) {
        PG8_STAGE(PG8_SB(0, 0), cB, voffB); PG8_STAGE(PG8_SB(0, 1), cB + hstep, voffB); PG8_STAGE(PG8_SA(0, 0), cA, voffA); PG8_STAGE(PG8_SA(0, 1), cA + hstep, voffA);
        if (wr == 1) PG8_BAR;
        PG8_WAIT_V(2); PG8_BAR;
        PG8_STAGE(PG8_SB(1, 0), cB + kstep, voffB); PG8_STAGE(PG8_SA(1, 0), cA + kstep, voffA); PG8_STAGE(PG8_SB(1, 1), cB + hstep + kstep, voffB);
        PG8_WAIT_V(6); PG8_BAR;
    } else {
        PG8_STAGE(PG8_SB(0, 0), cB, voffB); PG8_STAGE(PG8_SA(0, 0), cA, voffA); PG8_STAGE(PG8_SB(0, 1), cB + hstep, voffB); PG8_STAGE(PG8_SA(0, 1), cA + hstep, voffA);
        if (wr == 1) PG8_BAR;
        PG8_WAIT_V(4); PG8_BAR;
        PG8_STAGE(PG8_SB(1, 0), cB + kstep, voffB); PG8_STAGE(PG8_SA(1, 0), cA + kstep, voffA); PG8_STAGE(PG8_SB(1, 1), cB + hstep + kstep, voffB);
        PG8_WAIT_V(6); PG8_BAR;
    }
    for (;;) {
        const bool has_next = S.next(ui + 1, nxt);
        const char* nA = has_next ? (const char*)g.A + (size_t)nxt.pm * tstep : cA; const char* nB = has_next ? (const char*)g.Bt + (size_t)nxt.pn * tstep : cB;
        for (int t = 0; t < nt; t += 2) {
            const bool last = (t == nt - 2);
            const char* a1 = cA + (size_t)(t + 1) * kstep;
            const char* a2 = last ? nA : cA + (size_t)(t + 2) * kstep; const char* b2 = last ? nB : cB + (size_t)(t + 2) * kstep;
            const char* a3 = a2 + kstep; const char* b3 = b2 + kstep;
            if (last && has_next) S.a_ready(nxt);
            if constexpr (SP2) {
            PG8_LDB(B0, 0, 0); PG8_LDB(B1, 0, 1); PG8_SCHED; PG8_LDA(At, 0, 0); PG8_STAGE(PG8_SA(1, 1), a1 + hstep, voffA);
            PG8_WAIT_V(8); PG8_WAIT_L(0); PG8_BAR; PG8_MMA(0, 0, At, B0); PG8_MMA(0, 1, At, B1); PG8_BAR; PG8_SCHED;
            PG8_LDA(At, 0, 1); PG8_STAGE(PG8_SB(0, 0), b2, voffB); PG8_STAGE(PG8_SB(0, 1), b2 + hstep, voffB); PG8_STAGE(PG8_SA(0, 0), a2, voffA);
            PG8_WAIT_V(8); PG8_WAIT_L(0); PG8_BAR; PG8_MMA(1, 0, At, B0); PG8_MMA(1, 1, At, B1); PG8_BAR; PG8_SCHED;
            PG8_LDB(B0, 1, 0); PG8_LDB(B1, 1, 1); PG8_SCHED; PG8_LDA(At, 1, 0); PG8_STAGE(PG8_SA(0, 1), a2 + hstep, voffA);
            PG8_WAIT_V(8); PG8_WAIT_L(0); PG8_BAR; PG8_MMA(0, 0, At, B0); PG8_MMA(0, 1, At, B1); PG8_BAR; PG8_SCHED;
            PG8_LDA(At, 1, 1); PG8_STAGE(PG8_SB(1, 0), b3, voffB); PG8_STAGE(PG8_SB(1, 1), b3 + hstep, voffB); PG8_STAGE(PG8_SA(1, 0), a3, voffA);
            PG8_WAIT_V(8); PG8_WAIT_L(0); PG8_BAR; PG8_MMA(1, 0, At, B0); PG8_MMA(1, 1, At, B1); PG8_BAR; PG8_SCHED;
            } else {
            PG8_LDB(B0, 0, 0); PG8_SCHED; PG8_LDA(At, 0, 0); PG8_STAGE(PG8_SA(1, 1), a1 + hstep, voffA);
            PG8_WAIT_L(8); PG8_BAR; PG8_WAIT_L(0); PG8_MMA(0, 0, At, B0); PG8_BAR; PG8_SCHED;
            PG8_LDB(B1, 0, 1); PG8_STAGE(PG8_SB(0, 0), b2, voffB);
            PG8_BAR; PG8_WAIT_L(0); PG8_MMA(0, 1, At, B1); PG8_BAR;
            PG8_LDA(At, 0, 1); PG8_STAGE(PG8_SA(0, 0), a2, voffA);
            PG8_BAR; PG8_WAIT_L(0); PG8_MMA(1, 0, At, B0); PG8_BAR; PG8_SCHED;
            PG8_STAGE(PG8_SB(0, 1), b2 + hstep, voffB);
            PG8_WAIT_V(6); PG8_BAR; PG8_MMA(1, 1, At, B1); PG8_BAR;
            PG8_LDB(B0, 1, 0); PG8_SCHED; PG8_LDA(At, 1, 0); PG8_STAGE(PG8_SA(0, 1), a2 + hstep, voffA);
            PG8_WAIT_L(8); PG8_BAR; PG8_WAIT_L(0); PG8_MMA(0, 0, At, B0); PG8_BAR; PG8_SCHED;
            PG8_LDB(B1, 1, 1); PG8_STAGE(PG8_SB(1, 0), b3, voffB);
            PG8_BAR; PG8_WAIT_L(0); PG8_MMA(0, 1, At, B1); PG8_BAR;
            PG8_LDA(At, 1, 1); PG8_STAGE(PG8_SA(1, 0), a3, voffA);
            PG8_BAR; PG8_WAIT_L(0); PG8_MMA(1, 0, At, B0); PG8_BAR; PG8_SCHED;
            PG8_STAGE(PG8_SB(1, 1), b3 + hstep, voffB);
            PG8_WAIT_V(6); PG8_BAR; PG8_MMA(1, 1, At, B1); PG8_BAR;
            }
        }
        if constexpr (ALIGN_EPI) { if (wr == 0) PG8_BAR; }
        if constexpr (!Epi::AFTER_DRAIN) { E(acc, cur, wr, wc, fr, fq); S.done(cur); }
        if (!has_next) break;
#pragma unroll
        for (int a = 0; a < 2; ++a)
#pragma unroll
            for (int b = 0; b < 2; ++b)
#pragma unroll
                for (int m = 0; m < 4; ++m)
#pragma unroll
                    for (int n = 0; n < 2; ++n) acc[a][b][m][n] = (f32x4){0.f, 0.f, 0.f, 0.f};
        cur = nxt; cA = nA; cB = nB; ++ui;
        if constexpr (ALIGN_EPI) { if (wr == 1) PG8_BAR; }
    }
    PG8_WAIT_V(0);
    if constexpr (!ALIGN_EPI) { if (wr == 0) PG8_BAR; }
    PG8_BAR;
    if constexpr (Epi::AFTER_DRAIN) { E.fused(acc, cur, wr, wc, fr, fq, lds, wid, lane); S.done(cur); }
#undef PG8_SA
#undef PG8_SB
#undef PG8_STAGE
#undef PG8_LDA
#undef PG8_LDB
#undef PG8_MMA
#undef PG8_WAIT_V
#undef PG8_WAIT_L
#undef PG8_BAR
#undef PG8_SCHED
}
}

namespace pg8 {
struct EpiProj {
    static constexpr bool PERM = true, AFTER_DRAIN = false;
    bf16_t* H; const float* g; const float* gd;
    const float* rowss;
    __device__ __forceinline__ void operator()(const f32x4 (&acc)[2][2][4][2], const Unit& u, int wr, int wc, int fr, int fq) const {
        const int pn = u.pn;
        int mode = 0; const float* gain = nullptr;
        const float qs = (pn == 0 || pn == 3 || pn == 8) ? 0.125f * 1.4426950408889634f : (pn == 5 ? 0.17677669529663687f * 1.4426950408889634f : 1.f);
        if (pn == 0) { mode = 1; gain = g; } else if (pn == 1) { mode = 1; gain = g + 64; } else if (pn == 3) { mode = 1; gain = g + 128; }
        else if (pn == 4) { if (wc < 2) { mode = 1; gain = g + 192; } }
        else if (pn == 5) { mode = 2; gain = gd; } else if (pn == 6) { mode = 2; gain = gd + 32; }
        else if (pn == 8) { mode = 1; gain = g + 256; }
        else if (pn == 9) { if (wc == 2) { mode = 1; gain = g + 384; } }
        else if (pn == 10) { if (wc == 0) { mode = 1; gain = g + 448; } else if (wc == 2) mode = 4; }
        else if (pn >= 11) mode = 3;
        f32x4 gv[2][2];
#pragma unroll
        for (int bj = 0; bj < 2; ++bj)
#pragma unroll
            for (int n = 0; n < 2; ++n) gv[bj][n] = (f32x4){1.f, 1.f, 1.f, 1.f};
        if (mode == 1) {
#pragma unroll
            for (int bj = 0; bj < 2; ++bj)
#pragma unroll
                for (int n = 0; n < 2; ++n) gv[bj][n] = *(const f32x4*)(gain + 32 * bj + 8 * fq + 4 * n);
        } else if (mode == 2) {
#pragma unroll
            for (int bj = 0; bj < 2; ++bj)
#pragma unroll
                for (int n = 0; n < 2; ++n) gv[bj][n] = *(const f32x4*)(gain + 8 * fq + 4 * n);
        }
        const int col0 = pn * BM + 64 * wc + 8 * fq;
#pragma unroll
        for (int ai = 0; ai < 2; ++ai)
#pragma unroll
            for (int m = 0; m < 4; ++m) {
                const int row = u.pm * BM + ai * HALF + wr * 64 + m * 16 + fr;
                f32x4 v[2][2];
                const float rsc = rowss ? rsqrtf((float)((const unsigned long long*)rowss)[row] * (1.f / (1048576.f * 1024.f)) + 1e-6f) : 1.f;
#pragma unroll
                for (int bj = 0; bj < 2; ++bj)
#pragma unroll
                    for (int n = 0; n < 2; ++n) v[bj][n] = acc[ai][bj][m][n] * rsc;
                if (mode == 1 || mode == 2) {
                    float s0 = 0.f, s1 = 0.f;
#pragma unroll
                    for (int n = 0; n < 2; ++n) {
                        s0 += v[0][n][0] * v[0][n][0] + v[0][n][1] * v[0][n][1] + v[0][n][2] * v[0][n][2] + v[0][n][3] * v[0][n][3];
                        s1 += v[1][n][0] * v[1][n][0] + v[1][n][1] * v[1][n][1] + v[1][n][2] * v[1][n][2] + v[1][n][3] * v[1][n][3];
                    }
                    s0 += __shfl_xor(s0, 16); s0 += __shfl_xor(s0, 32);
                    s1 += __shfl_xor(s1, 16); s1 += __shfl_xor(s1, 32);
                    float r0, r1;
                    if (mode == 1) { r0 = r1 = rsqrtf((s0 + s1) * (1.f / 64.f) + 1e-6f) * qs; }
                    else { r0 = rsqrtf(s0 * (1.f / 32.f) + 1e-6f) * qs; r1 = rsqrtf(s1 * (1.f / 32.f) + 1e-6f) * qs; }
#pragma unroll
                    for (int n = 0; n < 2; ++n) { v[0][n] = v[0][n] * r0 * gv[0][n]; v[1][n] = v[1][n] * r1 * gv[1][n]; }
                } else if (mode == 3) {
#pragma unroll
                    for (int bj = 0; bj < 2; ++bj)
#pragma unroll
                        for (int n = 0; n < 2; ++n)
#pragma unroll
                            for (int e = 0; e < 4; ++e) { const float x = v[bj][n][e]; v[bj][n][e] = x * __builtin_amdgcn_rcpf(1.f + __expf(-x)); }
                } else if (mode == 4) {
#pragma unroll
                    for (int bj = 0; bj < 2; ++bj)
#pragma unroll
                        for (int n = 0; n < 2; ++n)
#pragma unroll
                            for (int e = 0; e < 4; ++e) { const float x = v[bj][n][e]; v[bj][n][e] = __builtin_amdgcn_rcpf(1.f + __expf(-x)); }
                }
                bf16_t* rowp = H + (size_t)row * 3840 + col0;
#pragma unroll
                for (int bj = 0; bj < 2; ++bj) {
                    u32x4 w; w.x = cvt_pk_bf16(v[bj][0][0], v[bj][0][1]); w.y = cvt_pk_bf16(v[bj][0][2], v[bj][0][3]);
                    w.z = cvt_pk_bf16(v[bj][1][0], v[bj][1][1]); w.w = cvt_pk_bf16(v[bj][1][2], v[bj][1][3]);
                    *(u32x4*)(rowp + 32 * bj) = w;
                }
            }
    }
};
struct EpiOut {
    static constexpr bool PERM = false, AFTER_DRAIN = false;
    const float* xprev; float* out;
    PG8_LAS float* exch;
    bf16_t* xn; const float* gnext; float* rowss;
    __device__ __forceinline__ void operator()(const f32x4 (&acc)[2][2][4][2], const Unit& u, int wr, int wc, int fr, int fq) const {
        const int col0 = u.pn * BM + wc * 32 + 4 * fq;
        f32x4 gn[2][2];
#pragma unroll
        for (int bj = 0; bj < 2; ++bj)
#pragma unroll
            for (int n = 0; n < 2; ++n) gn[bj][n] = xn ? *(const f32x4*)(gnext + col0 + bj * HALF + n * 16) : (f32x4){0.f, 0.f, 0.f, 0.f};
#pragma unroll
        for (int ai = 0; ai < 2; ++ai)
#pragma unroll
            for (int m = 0; m < 4; ++m) {
                const int row = u.pm * BM + ai * HALF + wr * 64 + m * 16 + fr;
                const size_t off = (size_t)row * 1024 + col0;
                float ss = 0.f;
#pragma unroll
                for (int bj = 0; bj < 2; ++bj)
#pragma unroll
                    for (int n = 0; n < 2; ++n) {
                        const f32x4 b = *(const f32x4*)(xprev + off + bj * HALF + n * 16);
                        const f32x4 v = b + acc[ai][bj][m][n];
                        *(f32x4*)(out + off + bj * HALF + n * 16) = v;
                        if (xn) {
                            ss += (v[0] * v[0] + v[1] * v[1]) + (v[2] * v[2] + v[3] * v[3]);
                            const f32x4 w = v * gn[bj][n];
                            uint2 o; o.x = cvt_pk_bf16(w[0], w[1]); o.y = cvt_pk_bf16(w[2], w[3]);
                            *(uint2*)(xn + off + bj * HALF + n * 16) = o;
                        }
                    }
                if (xn) {
                    ss += __shfl_xor(ss, 16); ss += __shfl_xor(ss, 32);
                    if (fq == 0) exch[(ai * HALF + wr * 64 + m * 16 + fr) * 4 + wc] = ss;
                }
            }
        if (xn) {
            asm volatile("s_waitcnt lgkmcnt(0)" ::: "memory"); __builtin_amdgcn_s_barrier(); asm volatile("" ::: "memory");
            if (wc == 0) {
                const int lane = fq * 16 + fr;
#pragma unroll
                for (int k = 0; k < 2; ++k) {
                    const int rl = k * HALF + wr * 64 + lane;
                    const f32x4 p = *(const PG8_LAS f32x4*)(exch + rl * 4);
                    const float tot = (p[0] + p[1]) + (p[2] + p[3]);
                    atomicAdd((unsigned long long*)rowss + (u.pm * BM + rl), (unsigned long long)(tot * 1048576.f + 0.5f));
                }
            }
        }
    }
};
}

template <int MODE>
__device__ __forceinline__ void p0_transpose_item(const float* __restrict__ W, bf16_t* __restrict__ WT, LAS float* scr, int item, int lane, int KR = 1024, int NC = 1024) {
    const int NSRC = MODE == 0 ? 3724 : NC, NG = MODE == 0 ? 120 : NC / 32;
    const int kb = item / NG, nb = item % NG, k0 = 64 * kb, hc0 = 32 * nb;
    const int hc = hc0 + (lane & 31);
    int src = hc;
    if (MODE == 0) src = hc < 2700 ? hc : (hc < 2816 ? -1 : hc - 116);
#pragma unroll 8
    for (int i = 0; i < 32; ++i) { const int kk = 2 * i + (lane >> 5); scr[kk * 33 + (lane & 31)] = src >= 0 ? W[(size_t)(k0 + kk) * NSRC + src] : 0.f; }
    asm volatile("s_waitcnt lgkmcnt(0)" ::: "memory");
    const int c = lane & 7;
#pragma unroll
    for (int j = 0; j < 4; ++j) {
        const int n = (lane >> 3) + 8 * j; const LAS float* s = scr + (8 * c) * 33 + n;
        const int hcn = hc0 + n;
        int drow = hcn;
        if (MODE == 0) drow = (hcn & ~255) + ((hcn >> 5) & 1) * 128 + ((hcn >> 6) & 3) * 32 + (hcn & 31);
        uint4 o; o.x = (unsigned)f2bf(s[0]) | ((unsigned)f2bf(s[33]) << 16); o.y = (unsigned)f2bf(s[66]) | ((unsigned)f2bf(s[99]) << 16);
        o.z = (unsigned)f2bf(s[132]) | ((unsigned)f2bf(s[165]) << 16); o.w = (unsigned)f2bf(s[198]) | ((unsigned)f2bf(s[231]) << 16);
        *(uint4*)(WT + (size_t)drow * KR + k0 + 8 * c) = o;
    }
    asm volatile("s_waitcnt lgkmcnt(0)" ::: "memory");
}

namespace att {
typedef short bf16x8 __attribute__((ext_vector_type(8)));
typedef short v4i16 __attribute__((ext_vector_type(4)));
typedef float f32x16 __attribute__((ext_vector_type(16)));
typedef float f32x2_t __attribute__((ext_vector_type(2)));
typedef __bf16 bf16x2_t __attribute__((ext_vector_type(2)));
typedef unsigned u32x4 __attribute__((ext_vector_type(4)));
typedef float f32x4 __attribute__((ext_vector_type(4)));
__device__ __forceinline__ unsigned cvtpk(float lo, float hi) { f32x2_t v = {lo, hi}; bf16x2_t b = __builtin_convertvector(v, bf16x2_t); return __builtin_bit_cast(unsigned, b); }
__device__ __forceinline__ int crow(int r, int h) { return (r & 3) + 8 * (r >> 2) + 4 * h; }
constexpr float LOG2E = 1.4426950408889634f;
constexpr int L_KV = 0, KVB = 16384  , L_TAB = 32768  , L_WSCR = 83968  , L_IMP = 92160  , L_Q = 124928, L_SEL = 125184  , L_SB = 126464  ;

struct StageRegs { u32x4 k, v; };
__device__ __forceinline__ void stage_load(StageRegs& sr, const bf16_t* kp, const bf16_t* vp, bool valid, int ch) {
    sr.k = (u32x4){0u, 0u, 0u, 0u}; sr.v = sr.k;
    if (valid) { sr.k = *(const u32x4*)(kp + ch * 8); sr.v = *(const u32x4*)(vp + ch * 8); }
}
__device__ __forceinline__ void stage_write(LAS unsigned char* buf, const StageRegs& sr, int row, int ch) {
    *(LAS u32x4*)(buf + row * 128 + ((ch ^ (row & 7)) << 4)) = sr.k;
    *(LAS u32x4*)(buf + 8192 + (ch >> 2) * 4096 + row * 64 + (ch & 3) * 16) = sr.v;
}
__device__ __forceinline__ f32x16 load_tab16(const LAS float* tbl, int TSP, int jb) {
    const int sh = jb & 3; const LAS float* tp = tbl + sh * TSP + (jb - sh);
    const f32x4 t0 = *(const LAS f32x4*)(tp), t1 = *(const LAS f32x4*)(tp + 8), t2 = *(const LAS f32x4*)(tp + 16), t3 = *(const LAS f32x4*)(tp + 24);
    return (f32x16){t0[0], t0[1], t0[2], t0[3], t1[0], t1[1], t1[2], t1[3], t2[0], t2[1], t2[2], t2[3], t3[0], t3[1], t3[2], t3[3]};
}
__device__ __forceinline__ float exp_sum16(f32x16& acc) {
    float sa = 0.f, sb = 0.f;
#pragma unroll
    for (int r = 0; r < 16; r += 2) {
        acc[r] = __builtin_amdgcn_exp2f(acc[r]); acc[r + 1] = __builtin_amdgcn_exp2f(acc[r + 1]);
        sa += acc[r]; asm volatile("" : "+v"(sa)); sb += acc[r + 1]; asm volatile("" : "+v"(sb));
    }
    return sa + sb;
}
__device__ __forceinline__ f32x16 splat16(float v) { return (f32x16){v, v, v, v, v, v, v, v, v, v, v, v, v, v, v, v}; }
template <int S0, int S1>
__device__ __forceinline__ void qk_sub(f32x16& acc, const LAS unsigned char* buf, int sub, const bf16x8* qf, int lane) {
    const int key = 32 * sub + (lane & 31), h = lane >> 5;
#pragma unroll
    for (int s = S0; s < S1; ++s) {
        const bf16x8 kf = *(const LAS bf16x8*)(buf + key * 128 + (((2 * s + h) ^ (key & 7)) << 4));
        acc = __builtin_amdgcn_mfma_f32_32x32x16_bf16(kf, qf[s], acc, 0, 0, 0);
    }
}
__device__ __forceinline__ void pack_p(const f32x16& p, bf16x8& pa0, bf16x8& pa1) {
    u32x4 w0, w1;
    w0.x = cvtpk(p[0], p[1]); w0.y = cvtpk(p[2], p[3]); w0.z = cvtpk(p[4], p[5]); w0.w = cvtpk(p[6], p[7]);
    w1.x = cvtpk(p[8], p[9]); w1.y = cvtpk(p[10], p[11]); w1.z = cvtpk(p[12], p[13]); w1.w = cvtpk(p[14], p[15]);
    pa0 = __builtin_bit_cast(bf16x8, w0); pa1 = __builtin_bit_cast(bf16x8, w1);
}
__device__ __forceinline__ void pv_sub(f32x16* o, const LAS unsigned char* buf, int sub, const bf16x8& pa0, const bf16x8& pa1, int lane) {
    const int h = lane >> 5, g16 = (lane >> 4) & 1, q4 = (lane & 15) >> 2, p4 = lane & 3;
    const LAS unsigned char* vb = buf + 8192 + (32 * sub + 4 * h + q4) * 64 + (16 * g16 + 4 * p4) * 2;
#pragma unroll
    for (int dt = 0; dt < 2; ++dt) {
#pragma unroll
        for (int s2 = 0; s2 < 2; ++s2) {
            const v4i16 lo = __builtin_amdgcn_ds_read_tr16_b64_v4i16((LAS v4i16*)(vb + dt * 4096 + s2 * 1024));
            const v4i16 hi = __builtin_amdgcn_ds_read_tr16_b64_v4i16((LAS v4i16*)(vb + dt * 4096 + s2 * 1024 + 512));
            const bf16x8 vf = (bf16x8){lo[0], lo[1], lo[2], lo[3], hi[0], hi[1], hi[2], hi[3]};
            o[dt] = __builtin_amdgcn_mfma_f32_32x32x16_bf16(s2 == 0 ? pa0 : pa1, vf, o[dt], 0, 0, 0);
        }
    }
}

__device__ __forceinline__ void pv_sub2(f32x16* oa, f32x16* ob, const LAS unsigned char* buf, int sub, const bf16x8& a0, const bf16x8& a1, const bf16x8& b0, const bf16x8& b1, int lane) {
    const int h = lane >> 5, g16 = (lane >> 4) & 1, q4 = (lane & 15) >> 2, p4 = lane & 3;
    const LAS unsigned char* vb = buf + 8192 + (32 * sub + 4 * h + q4) * 64 + (16 * g16 + 4 * p4) * 2;
#pragma unroll
    for (int dt = 0; dt < 2; ++dt) {
#pragma unroll
        for (int s2 = 0; s2 < 2; ++s2) {
            const v4i16 lo = __builtin_amdgcn_ds_read_tr16_b64_v4i16((LAS v4i16*)(vb + dt * 4096 + s2 * 1024));
            const v4i16 hi = __builtin_amdgcn_ds_read_tr16_b64_v4i16((LAS v4i16*)(vb + dt * 4096 + s2 * 1024 + 512));
            const bf16x8 vf = (bf16x8){lo[0], lo[1], lo[2], lo[3], hi[0], hi[1], hi[2], hi[3]};
            oa[dt] = __builtin_amdgcn_mfma_f32_32x32x16_bf16(s2 == 0 ? a0 : a1, vf, oa[dt], 0, 0, 0);
            ob[dt] = __builtin_amdgcn_mfma_f32_32x32x16_bf16(s2 == 0 ? b0 : b1, vf, ob[dt], 0, 0, 0);
        }
    }
}

struct BandArgs {
    const bf16_t* Hb;
    int cq, ck, cv;
    int rate, cls, f0, maxd;
    const float* bias;
    float M;
    float sinkterm;
    bf16_t* OA; float* DA;
    bf16_t* Y; int ycol;
    int hd; size_t brow;
};
template <int MODE>
__device__ __forceinline__ void banded_unit(LAS unsigned char* lds, const BandArgs& P) {
    const int tid = opq(threadIdx.x), lane = tid & 63, w = __builtin_amdgcn_readfirstlane(tid >> 6), h = lane >> 5;
    LAS float* sb = (LAS float*)(lds + L_SB);
    LAS float* tbl = (LAS float*)(lds + L_TAB);
    const int KPREV = ((P.maxd + 63) >> 6) << 6, ntl = (KPREV + 256) >> 6;
    const int t0 = (KPREV - P.f0) > 0 ? ((KPREV - P.f0) >> 6) : 0;
    const int srow = tid >> 3, sch = tid & 7;
    StageRegs sr;
    {
        const int kf = P.f0 - KPREV + 64 * t0 + srow;
        const bf16_t* rp = P.Hb + ((size_t)kf * P.rate + P.cls) * HP;
        stage_load(sr, rp + P.ck, rp + P.cv, true, sch);
    }
    const int fq0 = P.f0 + 32 * w;
    bf16x8 qf[4];
    {
        const size_t tq = (size_t)(fq0 + (lane & 31)) * P.rate + P.cls;
        const bf16_t* qp = P.Hb + tq * HP + P.cq + 8 * h;
#pragma unroll
        for (int s = 0; s < 4; ++s) qf[s] = *(const bf16x8*)(qp + 16 * s);
    }
    if (tid < 32) sb[tid] = (P.bias[tid * 16] - P.M) * LOG2E;
    __syncthreads();
    const int DMAXI = P.maxd + 62, TS = P.maxd + 125, TSP = (TS + 7) & ~3;
    for (int e = tid; e < 4 * TSP; e += 512) {
        const int sh = e / TSP, j = e - sh * TSP + sh, dist = DMAXI - j;
        tbl[e] = (j < TS && dist >= 0 && dist <= P.maxd) ? sb[t5_bucket(dist * P.rate)] : -1e30f;
    }
    asm volatile("" : "+v"(qf[0]), "+v"(qf[1]), "+v"(qf[2]), "+v"(qf[3]));
    f32x16 o[2]; o[0] = (f32x16){}; o[1] = (f32x16){};
    float den = 0.f;
    stage_write(lds + L_KV, sr, srow, sch);
    __syncthreads();
    for (int t = t0; t < ntl; ++t) {
        LAS unsigned char* buf = lds + L_KV + ((t - t0) & 1) * KVB;
        const int kf0 = P.f0 - KPREV + 64 * t;
        if (t + 1 < ntl) {
            const int kf = kf0 + 64 + srow;
            const bf16_t* rp = P.Hb + ((size_t)kf * P.rate + P.cls) * HP;
            stage_load(sr, rp + P.ck, rp + P.cv, true, sch);
        }
#pragma unroll
        for (int sub = 0; sub < 2; ++sub) {
            const int kfs = kf0 + 32 * sub;
            if (kfs <= fq0 + 31 && kfs + 31 >= fq0 - P.maxd) {
                const int jb = DMAXI - ((fq0 - kfs) + (lane & 31) - 4 * h);
                f32x16 acc = load_tab16(tbl, TSP, jb);
                qk_sub<0, 4>(acc, buf, sub, qf, lane);
#pragma unroll
                for (int r = 0; r < 1; ++r) den += exp_sum16(acc);
                bf16x8 pa0, pa1; pack_p(acc, pa0, pa1);
                pv_sub(o, buf, sub, pa0, pa1, lane);
            }
        }
        if (t + 1 < ntl) stage_write(lds + L_KV + ((t - t0 + 1) & 1) * KVB, sr, srow, sch);
        __syncthreads();
    }
    float dtot = den + __shfl_xor(den, 32);
    if (MODE == 1) dtot += P.sinkterm;
    LAS float* ws_ = (LAS float*)(lds + L_WSCR) + w * 64;
    if (h == 0) ws_[lane] = dtot;
    if (MODE == 0 && h == 0) {
        const size_t tq = (size_t)(fq0 + lane) * P.rate + P.cls;
        P.DA[(P.brow + tq) * 4 + P.hd] = dtot;
    }
    asm volatile("s_waitcnt lgkmcnt(0)" ::: "memory");
#pragma unroll
    for (int r = 0; r < 16; ++r) {
        const int qi = crow(r, h);
        const float inv = __builtin_amdgcn_rcpf(ws_[qi]);
        const size_t row = P.brow + (size_t)(fq0 + qi) * P.rate + P.cls;
#pragma unroll
        for (int dt = 0; dt < 2; ++dt) {
            const int d = 32 * dt + (lane & 31);
            const float val = o[dt][r] * inv;
            if (MODE == 0) P.OA[row * 256 + P.hd * 64 + d] = f2bf(val);
            else P.Y[row * DM + P.ycol + d] = f2bf(val * bf2f(P.Hb[(row - P.brow) * HP + C_SILU + P.ycol + d]));
        }
    }
}

__device__ __forceinline__ void diff_p1(const LAS float* tp, const LAS unsigned char* buf, int sub, const bf16x8* qf, int lane, bf16x8& pa0, bf16x8& pa1, bf16x8& pb0, bf16x8& pb1) {
    const f32x4 t0 = *(const LAS f32x4*)(tp), t1 = *(const LAS f32x4*)(tp + 8), t2 = *(const LAS f32x4*)(tp + 16), t3 = *(const LAS f32x4*)(tp + 24);
    const f32x16 T = (f32x16){t0[0], t0[1], t0[2], t0[3], t1[0], t1[1], t1[2], t1[3], t2[0], t2[1], t2[2], t2[3], t3[0], t3[1], t3[2], t3[3]};
    const int key = 32 * sub + (lane & 31), h = lane >> 5;
    const LAS unsigned char* kp = buf + key * 128;
    const bf16x8 k0 = *(const LAS bf16x8*)(kp + (((0 + h) ^ (key & 7)) << 4)), k1 = *(const LAS bf16x8*)(kp + (((2 + h) ^ (key & 7)) << 4));
    const bf16x8 k2 = *(const LAS bf16x8*)(kp + (((4 + h) ^ (key & 7)) << 4)), k3 = *(const LAS bf16x8*)(kp + (((6 + h) ^ (key & 7)) << 4));
    f32x16 a1 = __builtin_amdgcn_mfma_f32_32x32x16_bf16(k0, qf[0], T, 0, 0, 0);
    f32x16 a2 = __builtin_amdgcn_mfma_f32_32x32x16_bf16(k2, qf[2], T, 0, 0, 0);
    a1 = __builtin_amdgcn_mfma_f32_32x32x16_bf16(k1, qf[1], a1, 0, 0, 0);
    a2 = __builtin_amdgcn_mfma_f32_32x32x16_bf16(k3, qf[3], a2, 0, 0, 0);
#pragma unroll
    for (int r = 0; r < 16; ++r) { a1[r] = __builtin_amdgcn_exp2f(a1[r]); a2[r] = __builtin_amdgcn_exp2f(a2[r]); }
    pack_p(a1, pa0, pa1); pack_p(a2, pb0, pb1);
}
__device__ __forceinline__ void diff_p2(const LAS unsigned char* buf, int sub, int lane, const bf16x8& pa0, const bf16x8& pa1, const bf16x8& pb0, const bf16x8& pb1, f32x16& dn1, f32x16& dn2, f32x16* o1, f32x16* o2) {
    const bf16x8 ones = (bf16x8){0x3F80, 0x3F80, 0x3F80, 0x3F80, 0x3F80, 0x3F80, 0x3F80, 0x3F80};
    dn1 = __builtin_amdgcn_mfma_f32_32x32x16_bf16(pa0, ones, dn1, 0, 0, 0);
    dn2 = __builtin_amdgcn_mfma_f32_32x32x16_bf16(pb0, ones, dn2, 0, 0, 0);
    dn1 = __builtin_amdgcn_mfma_f32_32x32x16_bf16(pa1, ones, dn1, 0, 0, 0);
    dn2 = __builtin_amdgcn_mfma_f32_32x32x16_bf16(pb1, ones, dn2, 0, 0, 0);
    pv_sub2(o1, o2, buf, sub, pa0, pa1, pb0, pb1, lane);
}

struct DiffArgs {
    const bf16_t* Hb; int hd, qb; size_t brow;
    const float* bias; float M; float lam, lambda_init; const float* subln;
    bf16_t* Y;
};
constexpr int D_SB = 49152, D_TAB = 49664;
__device__ __forceinline__ void diff_unit(LAS unsigned char* lds, const DiffArgs& P) {
    const int tid = opq(threadIdx.x), lane = tid & 63, w = __builtin_amdgcn_readfirstlane(tid >> 6), h = lane >> 5;
    LAS float* sb = (LAS float*)(lds + D_SB);
    LAS float* tbl = (LAS float*)(lds + D_TAB);
    constexpr int DTOP = 1574, TS = DTOP + 63, TSP = (TS + 7) & ~3;
    __syncthreads();
    if (tid < 32) sb[tid] = (P.bias[tid * 16] - P.M) * LOG2E;
    __syncthreads();
    for (int e = tid; e < 4 * TSP; e += 512) {
        const int sh = e / TSP, j = e - sh * TSP + sh, dist = DTOP - j;
        tbl[e] = (j < TS && dist >= 0) ? sb[t5_bucket(dist)] : -1e30f;
    }
    LAS float* farc = tbl + 4 * TSP;
    LAS float* deadr = farc + 32;
    if (tid < 32) { farc[tid] = sb[31]; deadr[tid] = -1e30f; }
    const int q0w = P.qb * 256 + 32 * w;
    const int cq = C_CQ + 64 * P.hd, ck = C_CK + 64 * P.hd, cv = C_CV + 64 * P.hd;
    bf16x8 qf[4];
    {
        const bf16_t* qp = P.Hb + (size_t)(q0w + (lane & 31)) * HP + cq + 8 * h;
#pragma unroll
        for (int s = 0; s < 4; ++s) qf[s] = *(const bf16x8*)(qp + 16 * s);
        asm volatile("" : "+v"(qf[0]), "+v"(qf[1]), "+v"(qf[2]), "+v"(qf[3]));
    }
    const int ntl = 4 * (P.qb + 1);
    const int srow = tid >> 3, sch = tid & 7;
    f32x16 o1[2], o2[2]; o1[0] = (f32x16){}; o1[1] = (f32x16){}; o2[0] = (f32x16){}; o2[1] = (f32x16){};
    f32x16 dn1 = (f32x16){}, dn2 = (f32x16){};
    StageRegs sr;
    {
        const bf16_t* rp = P.Hb + (size_t)srow * HP;
        stage_load(sr, rp + ck, rp + cv, true, sch);
        stage_write(lds, sr, srow, sch);
    }
    __syncthreads();
#define DIFF_TP(KS) ({ const int ks_ = (KS); const int jb_ = DTOP - ((q0w - ks_) + (lane & 31) - 4 * h), sh_ = jb_ & 3; \
        const LAS float* tp_ = tbl + sh_ * TSP + (jb_ - sh_); tp_ = (q0w - ks_ - 31 >= 1513) ? farc : tp_; tp_ = (ks_ > q0w + 31) ? deadr : tp_; tp_; })
#define DIFF_STAGE_LOAD(t) do { const int tn_ = (t) + 1 < ntl ? (t) + 1 : (t); const bf16_t* rp_ = P.Hb + (size_t)(64 * tn_ + srow) * HP; stage_load(sr, rp_ + ck, rp_ + cv, true, sch); } while (0)
    if (w < 4) {
        int cur = 0;
        for (int t = 0; t < ntl; ++t) {
            LAS unsigned char* buf = lds + cur * KVB;
            const int nxt = cur == 2 ? 0 : cur + 1;
            DIFF_STAGE_LOAD(t);
            bf16x8 pa0, pa1, pb0, pb1;
            diff_p1(DIFF_TP(64 * t), buf, 0, qf, lane, pa0, pa1, pb0, pb1);
            diff_p2(buf, 0, lane, pa0, pa1, pb0, pb1, dn1, dn2, o1, o2);
            diff_p1(DIFF_TP(64 * t + 32), buf, 1, qf, lane, pa0, pa1, pb0, pb1);
            diff_p2(buf, 1, lane, pa0, pa1, pb0, pb1, dn1, dn2, o1, o2);
            stage_write(lds + nxt * KVB, sr, srow, sch);
            __syncthreads();
            cur = nxt;
        }
    } else {
        const bf16x8 zero8 = (bf16x8){0, 0, 0, 0, 0, 0, 0, 0};
        bf16x8 qa0 = zero8, qa1 = zero8, qb0 = zero8, qb1 = zero8;
        int cur = 0, prv = 0;
        __builtin_amdgcn_s_setprio(1);
        for (int t = 0; t < ntl; ++t) {
            LAS unsigned char* buf = lds + cur * KVB;
            const int nxt = cur == 2 ? 0 : cur + 1;
            DIFF_STAGE_LOAD(t);
            diff_p2(lds + prv * KVB, 1, lane, qa0, qa1, qb0, qb1, dn1, dn2, o1, o2);
            bf16x8 pa0, pa1, pb0, pb1;
            diff_p1(DIFF_TP(64 * t), buf, 0, qf, lane, pa0, pa1, pb0, pb1);
            diff_p2(buf, 0, lane, pa0, pa1, pb0, pb1, dn1, dn2, o1, o2);
            diff_p1(DIFF_TP(64 * t + 32), buf, 1, qf, lane, qa0, qa1, qb0, qb1);
            stage_write(lds + nxt * KVB, sr, srow, sch);
            __syncthreads();
            prv = cur; cur = nxt;
        }
        diff_p2(lds + prv * KVB, 1, lane, qa0, qa1, qb0, qb1, dn1, dn2, o1, o2);
        __builtin_amdgcn_s_setprio(0);
    }
    __syncthreads();
#undef DIFF_TP
#undef DIFF_STAGE_LOAD
    const float g0 = P.subln[lane & 31] * (1.f - P.lambda_init), g1 = P.subln[32 + (lane & 31)] * (1.f - P.lambda_init);
    const int ycol = 512 + 64 * P.hd;
#pragma unroll
    for (int r = 0; r < 16; ++r) {
        const int qi = crow(r, h);
        const float i1 = __builtin_amdgcn_rcpf(dn1[r]), i2 = P.lam * __builtin_amdgcn_rcpf(dn2[r]);
        const float a0 = o1[0][r] * i1 - o2[0][r] * i2, a1 = o1[1][r] * i1 - o2[1][r] * i2;
        float ss = a0 * a0 + a1 * a1;
        ss += __shfl_xor(ss, 1); ss += __shfl_xor(ss, 2); ss += __shfl_xor(ss, 4); ss += __shfl_xor(ss, 8); ss += __shfl_xor(ss, 16);
        const float rs = rsqrtf(ss * (1.f / 64.f) + 1e-6f);
        const size_t trow = (size_t)(q0w + qi);
        const bf16_t* sp = P.Hb + trow * HP + C_SILU + ycol;
        bf16_t* yp = P.Y + (P.brow + trow) * DM + ycol;
        yp[lane & 31] = f2bf(a0 * rs * g0 * bf2f(sp[lane & 31]));
        yp[32 + (lane & 31)] = f2bf(a1 * rs * g1 * bf2f(sp[32 + (lane & 31)]));
    }
}
struct CmpArgs {
    const bf16_t* Hb;
    int col;
    int rt;
    const float* pos;
    const bf16_t* W1T;
    const float* b1;
    const bf16_t* W2T;
    const float* b2;
    const float* gain;
    bf16_t* OUT;
};
__device__ __forceinline__ void cmp_unit(LAS unsigned char* lds, const CmpArgs& P) {
    const int tid = opq(threadIdx.x), lane = tid & 63, w = __builtin_amdgcn_readfirstlane(tid >> 6), h = lane >> 5;
    LAS unsigned char* hidl = lds + L_KV;
    LAS float* ssx = (LAS float*)(lds + L_KV + 32768 - 512);
    LAS unsigned char* abuf = lds + L_TAB;
    f32x16 acc = (f32x16){};
    const bf16_t* w1p = P.W1T + (size_t)(32 * w + (lane & 31)) * 2048 + 8 * h;
    u32x4 araw[2]; f32x4 apos[2][2];
#define CMP_ALOAD(ch) do { _Pragma("unroll") for (int q_ = 0; q_ < 2; ++q_) { const int p_ = tid + 512 * q_, row_ = p_ >> 5, kc_ = p_ & 31; \
        int ir_ = 32 * P.rt + row_; if (ir_ > 510) ir_ = 510; const int tok_ = 4 * (ch) + (kc_ >> 3), d_ = 8 * (kc_ & 7); \
        araw[q_] = *(const u32x4*)(P.Hb + (size_t)(16 * ir_ + tok_) * HP + P.col + d_); \
        apos[q_][0] = *(const f32x4*)(P.pos + tok_ * 64 + d_); apos[q_][1] = *(const f32x4*)(P.pos + tok_ * 64 + d_ + 4); } } while (0)
#define CMP_AWRITE(bufi) do { _Pragma("unroll") for (int q_ = 0; q_ < 2; ++q_) { const int p_ = tid + 512 * q_, row_ = p_ >> 5, kc_ = p_ & 31; u32x4 aw_; \
        aw_.x = cvtpk(__uint_as_float(araw[q_].x << 16) + apos[q_][0][0], __uint_as_float(araw[q_].x & 0xffff0000u) + apos[q_][0][1]); \
        aw_.y = cvtpk(__uint_as_float(araw[q_].y << 16) + apos[q_][0][2], __uint_as_float(araw[q_].y & 0xffff0000u) + apos[q_][0][3]); \
        aw_.z = cvtpk(__uint_as_float(araw[q_].z << 16) + apos[q_][1][0], __uint_as_float(araw[q_].z & 0xffff0000u) + apos[q_][1][1]); \
        aw_.w = cvtpk(__uint_as_float(araw[q_].w << 16) + apos[q_][1][2], __uint_as_float(araw[q_].w & 0xffff0000u) + apos[q_][1][3]); \
        *(LAS u32x4*)(abuf + (bufi) * 16896 + row_ * 528 + kc_ * 16) = aw_; } } while (0)
    CMP_ALOAD(0); CMP_AWRITE(0);
    __syncthreads();
    for (int ch = 0; ch < 8; ++ch) {
        const int cn = ch + 1 < 8 ? ch + 1 : ch;
        CMP_ALOAD(cn);
        const LAS unsigned char* ab = abuf + (ch & 1) * 16896 + (lane & 31) * 528 + 16 * h;
        bf16x8 bfr[16];
#pragma unroll
        for (int ks = 0; ks < 16; ++ks) bfr[ks] = *(const bf16x8*)(w1p + 256 * ch + 16 * ks);
#pragma unroll
        for (int ks = 0; ks < 16; ++ks) {
            const bf16x8 af = *(const LAS bf16x8*)(ab + 32 * ks);
            acc = __builtin_amdgcn_mfma_f32_32x32x16_bf16(af, bfr[ks], acc, 0, 0, 0);
        }
        CMP_AWRITE((ch + 1) & 1);
        __syncthreads();
    }
#undef CMP_ALOAD
#undef CMP_AWRITE
    {
        const int j = 32 * w + (lane & 31); const float bb = P.b1[j];
#pragma unroll
        for (int r = 0; r < 16; ++r) {
            const float x = acc[r] + bb;
            const float u = 0.7978845608028654f * (x + 0.044715f * x * x * x);
            const float th = 1.f - 2.f / (1.f + __expf(2.f * u));
            const float gl = 0.5f * x * (1.f + th);
            *(LAS bf16_t*)(hidl + crow(r, h) * 528 + j * 2) = f2bf(gl);
        }
    }
    __syncthreads();
    float outv[16]; float ssp[16];
    if (w < 2) {
        f32x16 a2 = (f32x16){};
        const bf16_t* w2p = P.W2T + (size_t)(32 * w + (lane & 31)) * 256 + 8 * h;
#pragma unroll
        for (int ks = 0; ks < 16; ++ks) {
            const bf16x8 af = *(const LAS bf16x8*)(hidl + (lane & 31) * 528 + (16 * ks + 8 * h) * 2);
            const bf16x8 bfr = *(const bf16x8*)(w2p + 16 * ks);
            a2 = __builtin_amdgcn_mfma_f32_32x32x16_bf16(af, bfr, a2, 0, 0, 0);
        }
        const float bb = P.b2[32 * w + (lane & 31)];
#pragma unroll
        for (int r = 0; r < 16; ++r) {
            outv[r] = a2[r] + bb;
            float ss = outv[r] * outv[r];
            ss += __shfl_xor(ss, 1); ss += __shfl_xor(ss, 2); ss += __shfl_xor(ss, 4); ss += __shfl_xor(ss, 8); ss += __shfl_xor(ss, 16);
            ssp[r] = ss;
            if ((lane & 31) == 0) ssx[w * 32 + crow(r, h)] = ss;
        }
    }
    __syncthreads();
    if (w < 2) {
        const int d = 32 * w + (lane & 31);
        const float gn = P.gain ? P.gain[d] : 1.f;
#pragma unroll
        for (int r = 0; r < 16; ++r) {
            const int row = 32 * P.rt + crow(r, h);
            float v = outv[r];
            if (P.gain) { const float tot = ssx[crow(r, h)] + ssx[32 + crow(r, h)]; v = v * rsqrtf(tot * (1.f / 64.f) + 1e-6f) * gn; }
            if (row <= 510) P.OUT[(size_t)row * 64 + d] = f2bf(v);
        }
    }
    __syncthreads();
}

struct NsaArgs {
    const bf16_t* Hb; size_t brow; int qb;
    const bf16_t* KC; const bf16_t* VC;
    const float* bias;
    const float* Mv;
    bf16_t* Y; unsigned* cdone;
};
constexpr int GTOP = 2015, GTS = 2519, WTOP = 549, WTS = 588, DEAD = 4 * GTS + 4 * WTS;
__device__ __forceinline__ void nsa_unit(LAS unsigned char* lds, const NsaArgs& P) {
    const int tid = opq(threadIdx.x), lane = tid & 63, w = __builtin_amdgcn_readfirstlane(tid >> 6), hh = lane >> 5;
    const int n = lane & 31, q8 = n >> 2, hd = n & 3;
    LAS float* tg = (LAS float*)(lds + L_TAB);
    LAS float* tw = tg + 4 * GTS;
    LAS float* dead = tg + DEAD;
    LAS float* impw = (LAS float*)(lds + L_IMP) + w * 1024;
    LAS unsigned* selw = (LAS unsigned*)(lds + L_SEL) + w * 32;
    LAS unsigned* uni = (LAS unsigned*)(lds + L_SEL) + 256;
    LAS float* ws_ = (LAS float*)(lds + L_WSCR) + w * 256;
    LAS float* sbh = (LAS float*)(lds + L_SB);
    if (tid < 128) sbh[tid] = (P.bias[(tid & 31) * 16 + (tid >> 5)] - P.Mv[tid >> 5]) * LOG2E;
    __syncthreads();
    for (int e = tid; e < 4 * GTS; e += 512) { const int hq = e / GTS, j = e % GTS, dist = GTOP - j;
        tg[e] = dist >= 0 ? sbh[hq * 32 + t5_bucket(dist)] : -1e30f; }
    for (int e = tid; e < 4 * WTS; e += 512) { const int hq = e / WTS, j = e % WTS, dist = WTOP - j;
        tw[e] = (dist >= 0 && dist <= 511) ? sbh[hq * 32 + t5_bucket(dist)] : -1e30f; }
    if (tid < 64) dead[tid] = -1e30f;
    for (int e = lane; e < 1024; e += 64) impw[e] = 0.f;
    if (tid < 4) uni[tid] = 0u;
    const float cfar = sbh[hd * 32 + 31];
    const int tq = 64 * P.qb + 8 * w + q8;
    const int twmin = 64 * P.qb + 8 * w, twmax = twmin + 7;
    bf16x8 qf[4];
    {
        const bf16_t* qp = P.Hb + (size_t)tq * HP + C_DQ + 64 * hd + 8 * hh;
#pragma unroll
        for (int s = 0; s < 4; ++s) qf[s] = *(const bf16x8*)(qp + 16 * s);
        asm volatile("" : "+v"(qf[0]), "+v"(qf[1]), "+v"(qf[2]), "+v"(qf[3]));
    }
    {
        const bf16_t* gp = P.Hb + (size_t)tq * HP + C_GT + 3 * hd;
        if (hh == 0) { ws_[n] = bf2f(gp[0]); ws_[32 + n] = bf2f(gp[1]); ws_[64 + n] = bf2f(gp[2]); }
    }
    const int srow = tid >> 3, sch = tid & 7;
    StageRegs sr;
    f32x16 o[2], outv[2];
    float den = 0.f;
    o[0] = (f32x16){}; o[1] = (f32x16){};
    {
        const int kt0 = P.qb >= 8 ? P.qb - 8 : 0, nkt = P.qb - kt0 + 1;
        {
            const bf16_t* rp = P.Hb + (size_t)(64 * kt0 + srow) * HP;
            stage_load(sr, rp + C_KW, rp + C_VW, true, sch);
            stage_write(lds + L_KV, sr, srow, sch);
        }
        __syncthreads();
        for (int t = 0; t < nkt; ++t) {
            LAS unsigned char* buf = lds + L_KV + (t & 1) * KVB;
            if (t + 1 < nkt) { const bf16_t* rp = P.Hb + (size_t)(64 * (kt0 + t + 1) + srow) * HP; stage_load(sr, rp + C_KW, rp + C_VW, true, sch); }
#pragma unroll
            for (int sub = 0; sub < 2; ++sub) {
                const int kb = 64 * (kt0 + t) + 32 * sub;
                if (kb <= twmax && kb + 31 >= twmin - 511) {
                    f32x16 acc;
                    const LAS float* tb = tw + hd * WTS + (WTOP - (tq - kb - 4 * hh));
#pragma unroll
                    for (int r = 0; r < 16; ++r) acc[r] = tb[(r & 3) + 8 * (r >> 2)];
                    qk_sub<0, 4>(acc, buf, sub, qf, lane);
#pragma unroll
                    for (int r = 0; r < 1; ++r) den += exp_sum16(acc);
                    bf16x8 pa0, pa1; pack_p(acc, pa0, pa1);
                    pv_sub(o, buf, sub, pa0, pa1, lane);
                }
            }
            if (t + 1 < nkt) stage_write(lds + L_KV + ((t + 1) & 1) * KVB, sr, srow, sch);
            __syncthreads();
        }
    }
    {
        const float dt = den + __shfl_xor(den, 32);
        if (hh == 0) ws_[128 + n] = __builtin_amdgcn_rcpf(dt);
        asm volatile("s_waitcnt lgkmcnt(0)" ::: "memory");
#pragma unroll
        for (int r = 0; r < 16; ++r) { const int nn = crow(r, hh); const float gi = ws_[64 + nn] * ws_[128 + nn]; outv[0][r] = o[0][r] * gi; outv[1][r] = o[1][r] * gi; }
    }
    if (opq(threadIdx.x) == 128) {
        unsigned sp = 0;
        while (__hip_atomic_load(P.cdone, __ATOMIC_RELAXED, __HIP_MEMORY_SCOPE_AGENT) < 64u) { __builtin_amdgcn_s_sleep(2); if (++sp > (1u << 24)) break; }
        __builtin_amdgcn_fence(__ATOMIC_ACQUIRE, "agent"); asm volatile("s_waitcnt vmcnt(0)" ::: "memory");
    }
    __syncthreads();
    const int tlast = 64 * P.qb + 63;
    const int ntc = tlast >= 31 ? (((tlast - 31) >> 4) >> 6) + 1 : 0;
    float invden = 0.f; den = 0.f;
    o[0] = (f32x16){}; o[1] = (f32x16){};
    for (int pass = 0; pass < 2; ++pass) {
        if (ntc > 0) {
            __syncthreads();
            stage_load(sr, P.KC + (size_t)srow * 64, P.VC + (size_t)srow * 64, true, sch);
            stage_write(lds + L_KV, sr, srow, sch);
            __syncthreads();
            for (int t = 0; t < ntc; ++t) {
                LAS unsigned char* buf = lds + L_KV + (t & 1) * KVB;
                if (t + 1 < ntc) stage_load(sr, P.KC + (size_t)(64 * (t + 1) + srow) * 64, P.VC + (size_t)(64 * (t + 1) + srow) * 64, true, sch);
#pragma unroll
                for (int sub = 0; sub < 2; ++sub) {
                    const int cb = 64 * t + 32 * sub;
                    if (16 * cb + 31 <= twmax) {
                        f32x16 acc;
                        const int dmin = twmin - 16 * (cb + 31) - 31;
                        if (dmin >= 1513) acc = splat16(cfar);
                        else {
                            const LAS float* tb = tg + hd * GTS + (GTOP - (tq - 31 - 16 * cb - 64 * hh));
#pragma unroll
                            for (int r = 0; r < 16; ++r) acc[r] = tb[16 * ((r & 3) + 8 * (r >> 2))];
                        }
                        qk_sub<0, 4>(acc, buf, sub, qf, lane);
#pragma unroll
                        for (int r = 0; r < 16; ++r) acc[r] = __builtin_amdgcn_exp2f(acc[r]);
                        if (pass == 0) {
#pragma unroll
                            for (int r = 0; r < 16; ++r) { den += acc[r]; asm volatile("" : "+v"(den)); }
                        } else {
#pragma unroll
                            for (int r = 0; r < 16; ++r) acc[r] *= invden;
#pragma unroll
                            for (int g = 0; g < 4; ++g) {
                                float G = (acc[4 * g] + acc[4 * g + 1]) + (acc[4 * g + 2] + acc[4 * g + 3]), C = acc[4 * g + 3];
                                G += __shfl_xor(G, 1); G += __shfl_xor(G, 2); C += __shfl_xor(C, 1); C += __shfl_xor(C, 2);
                                if (hd == 0) {
                                    const int j = (cb >> 2) + 2 * g + hh;
                                    __hip_atomic_fetch_add(impw + q8 * 128 + j, G, __ATOMIC_RELAXED, __HIP_MEMORY_SCOPE_WORKGROUP);
                                    if (j + 1 < 128) __hip_atomic_fetch_add(impw + q8 * 128 + j + 1, C, __ATOMIC_RELAXED, __HIP_MEMORY_SCOPE_WORKGROUP);
                                }
                            }
                            bf16x8 pa0, pa1; pack_p(acc, pa0, pa1);
                            pv_sub(o, buf, sub, pa0, pa1, lane);
                        }
                    }
                }
                if (t + 1 < ntc) stage_write(lds + L_KV + ((t + 1) & 1) * KVB, sr, srow, sch);
                __syncthreads();
            }
        }
        if (pass == 0) { const float dt = den + __shfl_xor(den, 32); invden = dt > 0.f ? 1.f / dt : 0.f; }
    }
    asm volatile("s_waitcnt lgkmcnt(0)" ::: "memory");
#pragma unroll
    for (int r = 0; r < 16; ++r) { const float g0 = ws_[crow(r, hh)]; outv[0][r] += o[0][r] * g0; outv[1][r] += o[1][r] * g0; }
    {
        const int qsel = lane >> 3, sb = lane & 7;
        unsigned key[16];
#pragma unroll
        for (int i4 = 0; i4 < 4; ++i4) {
            const f32x4 v = *(const LAS f32x4*)(impw + qsel * 128 + sb * 16 + 4 * i4);
#pragma unroll
            for (int e = 0; e < 4; ++e) {
                const int j = sb * 16 + 4 * i4 + e;
                const bool forced = (j == 0) | (j == P.qb) | (j == P.qb - 1);
                key[4 * i4 + e] = forced ? 0xFFFFFFFFu : (j <= P.qb ? __float_as_uint(v[e]) + 1u : 0u);
            }
        }
        unsigned T = 0u;
        for (int bit = 31; bit >= 0; --bit) {
            const unsigned cand = T | (1u << bit);
            int cnt = 0;
#pragma unroll
            for (int i = 0; i < 16; ++i) cnt += key[i] >= cand ? 1 : 0;
            cnt += __shfl_xor(cnt, 1); cnt += __shfl_xor(cnt, 2); cnt += __shfl_xor(cnt, 4);
            if (cnt >= 16) T = cand;
        }
        int cgt = 0, ceq = 0;
#pragma unroll
        for (int i = 0; i < 16; ++i) { cgt += key[i] > T ? 1 : 0; ceq += key[i] == T ? 1 : 0; }
        int cg = cgt; cg += __shfl_xor(cg, 1); cg += __shfl_xor(cg, 2); cg += __shfl_xor(cg, 4);
        int pre = 0;
#pragma unroll
        for (int k = 0; k < 8; ++k) { const int v = __shfl(ceq, (lane & ~7) + k); if (k < sb) pre += v; }
        int need = 16 - cg - pre;
        unsigned bits = 0u;
#pragma unroll
        for (int i = 0; i < 16; ++i) {
            const int j = sb * 16 + i;
            bool s_ = key[i] > T;
            if (key[i] == T) { if (need > 0) { s_ = true; } --need; }
            if (s_ && j <= P.qb) bits |= 1u << i;
        }
        const unsigned other = __shfl_xor(bits, 1);
        const unsigned word = (sb & 1) ? ((bits << 16) | other) : (bits | (other << 16));
        if ((sb & 1) == 0) { selw[qsel * 4 + (sb >> 1)] = word; __hip_atomic_fetch_or(uni + (sb >> 1), word, __ATOMIC_RELAXED, __HIP_MEMORY_SCOPE_WORKGROUP); }
    }
    __syncthreads();
    unsigned lm0 = selw[q8 * 4 + 0], lm1 = selw[q8 * 4 + 1], lm2 = selw[q8 * 4 + 2], lm3 = selw[q8 * 4 + 3];
    unsigned wm0 = 0, wm1 = 0, wm2 = 0, wm3 = 0;
#pragma unroll
    for (int k = 0; k < 8; ++k) { wm0 |= selw[k * 4 + 0]; wm1 |= selw[k * 4 + 1]; wm2 |= selw[k * 4 + 2]; wm3 |= selw[k * 4 + 3]; }
    wm0 = __builtin_amdgcn_readfirstlane(wm0); wm1 = __builtin_amdgcn_readfirstlane(wm1); wm2 = __builtin_amdgcn_readfirstlane(wm2); wm3 = __builtin_amdgcn_readfirstlane(wm3);
    const unsigned um0 = __builtin_amdgcn_readfirstlane(uni[0]), um1 = __builtin_amdgcn_readfirstlane(uni[1]), um2 = __builtin_amdgcn_readfirstlane(uni[2]), um3 = __builtin_amdgcn_readfirstlane(uni[3]);
#define NSA_WORD(a0, a1, a2, a3, j) ((j) < 32 ? (a0) : ((j) < 64 ? (a1) : ((j) < 96 ? (a2) : (a3))))
#define NSA_NEXT(j, res) do { int _j = (j); res = 128; while (_j < 128) { const unsigned _w = NSA_WORD(um0, um1, um2, um3, _j) >> (_j & 31); if (_w) { res = _j + __builtin_ctz(_w); break; } _j = (_j | 31) + 1; } } while (0)
    o[0] = (f32x16){}; o[1] = (f32x16){}; den = 0.f;
#define NSA_SLC_COMPUTE(JJ, BUF) do { \
        if ((NSA_WORD(wm0, wm1, wm2, wm3, (JJ)) >> ((JJ) & 31)) & 1u) { \
            const bool lsel = (NSA_WORD(lm0, lm1, lm2, lm3, (JJ)) >> ((JJ) & 31)) & 1u; \
            _Pragma("unroll") for (int sub = 0; sub < 2; ++sub) { \
                const int kb = 64 * (JJ) + 32 * sub; \
                if (kb <= twmax) { \
                    f32x16 acc; \
                    if (twmin - kb - 31 >= 1513) acc = splat16(lsel ? cfar : -1e30f); \
                    else { const LAS float* tb = lsel ? tg + hd * GTS + (GTOP - (tq - kb - 4 * hh)) : dead; \
                        _Pragma("unroll") for (int r = 0; r < 16; ++r) acc[r] = tb[(r & 3) + 8 * (r >> 2)]; } \
                    qk_sub<0, 4>(acc, (BUF), sub, qf, lane); \
                    den += exp_sum16(acc); \
                    bf16x8 pa0, pa1; pack_p(acc, pa0, pa1); \
                    pv_sub(o, (BUF), sub, pa0, pa1, lane); \
                } } } } while (0)
#define NSA_SLC_LOAD(JJ, SR) do { const bf16_t* rp_ = P.Hb + (size_t)(64 * (JJ) + srow) * HP; stage_load(SR, rp_ + C_KS, rp_ + C_VS, true, sch); } while (0)
    {
        StageRegs srB;
        LAS unsigned char* pb0 = lds + L_KV; LAS unsigned char* pb1 = lds + L_IMP;
        int ja, jb2; NSA_NEXT(0, ja); jb2 = 128; if (ja < 128) { NSA_NEXT(ja + 1, jb2); }
        if (ja < 128) { NSA_SLC_LOAD(ja, sr); stage_write(pb0, sr, srow, sch); }
        if (jb2 < 128) { NSA_SLC_LOAD(jb2, srB); stage_write(pb0 + KVB, srB, srow, sch); }
        __syncthreads();
        int p = 0;
        while (ja < 128) {
            LAS unsigned char* cb = p ? pb1 : pb0; LAS unsigned char* nbuf = p ? pb0 : pb1;
            int na = 128, nb = 128;
            if (jb2 < 128) { NSA_NEXT(jb2 + 1, na); }
            if (na < 128) { NSA_NEXT(na + 1, nb); }
            if (na < 128) NSA_SLC_LOAD(na, sr);
            if (nb < 128) NSA_SLC_LOAD(nb, srB);
            NSA_SLC_COMPUTE(ja, cb);
            if (jb2 < 128) NSA_SLC_COMPUTE(jb2, cb + KVB);
            if (na < 128) stage_write(nbuf, sr, srow, sch);
            if (nb < 128) stage_write(nbuf + KVB, srB, srow, sch);
            __syncthreads();
            ja = na; jb2 = nb; p ^= 1;
        }
    }
#undef NSA_SLC_COMPUTE
#undef NSA_SLC_LOAD
    {
        const float dt = den + __shfl_xor(den, 32);
        if (hh == 0) ws_[96 + n] = 1.f / dt;
        asm volatile("s_waitcnt lgkmcnt(0)" ::: "memory");
#pragma unroll
        for (int r = 0; r < 16; ++r) { const float gi = ws_[32 + crow(r, hh)] * ws_[96 + crow(r, hh)]; outv[0][r] += o[0][r] * gi; outv[1][r] += o[1][r] * gi; }
    }
    {
#pragma unroll
        for (int r = 0; r < 16; ++r) {
            const int nn = crow(r, hh);
            const size_t trow = (size_t)(64 * P.qb + 8 * w + (nn >> 2));
            const int ycol = 768 + 64 * (nn & 3);
            const bf16_t* sp = P.Hb + trow * HP + C_SILU + ycol;
            bf16_t* yp = P.Y + (P.brow + trow) * DM + ycol;
            yp[n] = f2bf(outv[0][r] * bf2f(sp[n]));
            yp[32 + n] = f2bf(outv[1][r] * bf2f(sp[32 + n]));
        }
    }
    __syncthreads();
#undef NSA_WORD
#undef NSA_NEXT
}
}

#define XB_TMO      128
#define XB_XCNT(j)  (256  + 64 * (j))
#define XB_XSUB(j)  (1280 + 64 * (j))
#define XB_XGEN(j)  (2304 + 64 * (j))
#define XB_TOP      3328
#define XB_TOPGEN   3392
#define XCD_BAR_WORDS 3456
#define XB_SPIN_CAP (1u << 22)
__device__ __forceinline__ unsigned xb_ld(unsigned* p)              { return __hip_atomic_load(p, __ATOMIC_RELAXED, __HIP_MEMORY_SCOPE_AGENT); }
__device__ __forceinline__ unsigned xb_add(unsigned* p, unsigned v) { return __hip_atomic_fetch_add(p, v, __ATOMIC_RELAXED, __HIP_MEMORY_SCOPE_AGENT); }
__device__ __forceinline__ unsigned xb_xcc_id() { return (unsigned)__builtin_amdgcn_s_getreg((3 << 11) | 20) & 0xFu; }
#define XB_SPIN(cond, bar) do { unsigned _sp = 0; while (cond) { __builtin_amdgcn_s_sleep(1); \
    if ((++_sp & 255u) == 0u) { if (xb_ld(&(bar)[XB_TMO])) break; if (_sp > XB_SPIN_CAP) { atomicAdd(&(bar)[XB_TMO], 1u); break; } } } } while (0)
struct XcdBarrier { unsigned* bar; unsigned x; volatile LAS unsigned* st; };
__device__ __forceinline__ XcdBarrier xcd_barrier_post(unsigned* bar, volatile LAS unsigned* st) {
    XcdBarrier b; b.bar = bar; b.x = xb_xcc_id(); b.st = st;
    if (threadIdx.x == 0) (void)xb_add(&bar[XB_XCNT(b.x)], 1u);
    return b;
}
__device__ __forceinline__ void xcd_barrier_complete(unsigned* bar, unsigned x, unsigned& nloc, unsigned& nx) {
    const unsigned G = gridDim.x * gridDim.y * gridDim.z;
    unsigned sum, cnt, mine, sp = 0u;
    for (;;) {
        sum = 0u; cnt = 0u; mine = 0u;
#pragma unroll
        for (unsigned j = 0; j < 16; ++j) { const unsigned c = xb_ld(&bar[XB_XCNT(j)]); sum += c; cnt += (c > 0u) ? 1u : 0u; mine = (j == x) ? c : mine; }
        if (sum == G) break;
        __builtin_amdgcn_s_sleep(1);
        if ((++sp & 255u) == 0u) { if (xb_ld(&bar[XB_TMO])) break; if (sp > XB_SPIN_CAP) { atomicAdd(&bar[XB_TMO], 1u); break; } }
    }
    nloc = mine > 0u ? mine : 1u; nx = cnt > 0u ? cnt : 1u;
}
__device__ __forceinline__ void xcd_barrier(const XcdBarrier& b) {
    asm volatile("s_waitcnt vmcnt(0)" ::: "memory");
    __syncthreads();
    if (threadIdx.x == 0) {
        unsigned* bar = b.bar;
        __builtin_amdgcn_s_waitcnt(0);
        unsigned nloc = b.st[0], nx = b.st[1];
        if (nloc == 0u) { xcd_barrier_complete(bar, b.x, nloc, nx); b.st[0] = nloc; b.st[1] = nx; }
        const unsigned old = xb_add(&bar[XB_XSUB(b.x)], 1u);
        const unsigned gen = old / nloc;
        if (old + 1u == (gen + 1u) * nloc) {
            __builtin_amdgcn_fence(__ATOMIC_RELEASE, "agent");
            asm volatile("s_waitcnt vmcnt(0)" ::: "memory");
            const unsigned og = xb_add(&bar[XB_TOP], 1u);
            const unsigned tg = og / nx;
            if (og + 1u == (tg + 1u) * nx) xb_add(&bar[XB_TOPGEN], 1u);
            else XB_SPIN(xb_ld(&bar[XB_TOPGEN]) == tg, bar);
            __builtin_amdgcn_fence(__ATOMIC_ACQUIRE, "agent");
            xb_add(&bar[XB_XGEN(b.x)], 1u);
            asm volatile("s_waitcnt vmcnt(0)" ::: "memory");
        } else {
            XB_SPIN(xb_ld(&bar[XB_XGEN(b.x)]) == gen, bar);
            __builtin_amdgcn_fence(__ATOMIC_ACQUIRE, "agent");
            asm volatile("s_waitcnt vmcnt(0)" ::: "memory");
        }
    }
    __syncthreads();
}

constexpr int NT = 512, LDS_BYTES = 147456, MISC_OFF = 131072 + 320;
#ifndef R_C
#define R_C 1
#endif
#ifndef R_D
#define R_D 1
#endif
#ifndef R_AB
#define R_AB 1
#endif
#ifndef R_G1
#define R_G1 1
#endif
constexpr size_t MiB = 1u << 20;
constexpr size_t WS_CTL = 0, CTL_ZERO_BYTES = 65536;
constexpr size_t WS_H = 2 * MiB, WS_XN = 124 * MiB, WS_T0 = 158 * MiB, WS_IMP = 208 * MiB, WS_SEL = 217 * MiB, WS_HID = 218 * MiB, WS_KC = 221 * MiB, WS_VC = 222 * MiB, WS_WIN = 224 * MiB, WS_WOUT = 240 * MiB, WS_MX = 1 * MiB, WS_DA = 245 * MiB, WS_CW1 = 246 * MiB, WS_CW2 = 250 * MiB, WS_RSS = 251 * MiB;

struct Args { const float* in[15]; float* out; unsigned char* ws; };

__global__ void __launch_bounds__(NT, 2) mega_fwd(Args args) {
    extern __shared__ __attribute__((aligned(16))) unsigned char lds[];
    const int tid = threadIdx.x, lane = tid & 63, wid = tid >> 6;
    const int G = gridDim.x, bid = blockIdx.x;
    volatile LAS unsigned* MISC = (volatile LAS unsigned*)((LAS unsigned char*)lds + MISC_OFF);
    if (tid < 32) MISC[tid] = 0u;
    __syncthreads();
    unsigned char* ws = args.ws;
    XcdBarrier bar = xcd_barrier_post((unsigned*)(ws + WS_CTL) + 4096, MISC + 8);
    const float* x = args.in[0]; const float* tab = args.in[1]; const float* norm_w = args.in[2];
    const float* w_in = args.in[3]; const float* w_out = args.in[4]; const float* qk_gain = args.in[5];
    const float* qk_gain_diff = args.in[6]; const float* sinks = args.in[7]; const float* diff_lambda = args.in[8];
    const float* diff_subln = args.in[9]; const float* cmp_pos = args.in[10]; const float* cmp_w1 = args.in[11];
    const float* cmp_b1 = args.in[12]; const float* cmp_w2 = args.in[13]; const float* cmp_b2 = args.in[14];
    float* out = args.out;
    bf16_t* H = (bf16_t*)(ws + WS_H);
    bf16_t* XN = (bf16_t*)(ws + WS_XN); bf16_t* Y = XN;
    float* T0 = (float*)(ws + WS_T0);
    float* OC = T0; float* OS_ = T0 + (size_t)MROWS * 256; float* OW = T0 + (size_t)MROWS * 512; float* CT = T0;
    float* IMP = (float*)(ws + WS_IMP); unsigned* SEL = (unsigned*)(ws + WS_SEL); float* HID = (float*)(ws + WS_HID);
    float* KC = (float*)(ws + WS_KC); float* VC = (float*)(ws + WS_VC);
    const int GT = G * NT, GW = G * 8;
    bf16_t* WinT = (bf16_t*)(ws + WS_WIN); bf16_t* WoutT = (bf16_t*)(ws + WS_WOUT);
#define GRID_BAR() do { XcdBarrier b2_ = bar; asm volatile("" : "+s"(b2_.x)); xcd_barrier(b2_); } while (0)
    {
        LAS float* scr = (LAS float*)((LAS unsigned char*)lds + wid * 16384);
        const int gw0 = bid * 8 + wid;
        constexpr int I_IN = 16 * 120, I_OUT = 16 * 32, I_C1 = 32 * 8, I_C2 = 4 * 2, I_L = I_IN + I_OUT + 2 * I_C1 + 2 * I_C2, NITEMS = 2 * I_L;
        bf16_t* CW1T = (bf16_t*)(ws + WS_CW1); bf16_t* CW2T = (bf16_t*)(ws + WS_CW2);
        for (int it = gw0; it < NITEMS; it += GW) {
            const int l = it / I_L; int r = it % I_L;
            if (r < I_IN) { p0_transpose_item<0>(w_in + (size_t)l * DM * PW, WinT + (size_t)l * HP * DM, scr, r, lane); continue; } r -= I_IN;
            if (r < I_OUT) { p0_transpose_item<1>(w_out + (size_t)l * DM * DM, WoutT + (size_t)l * DM * DM, scr, r, lane); continue; } r -= I_OUT;
            if (r < 2 * I_C1) { const int kv = r / I_C1; p0_transpose_item<1>(cmp_w1 + (size_t)(l * 2 + kv) * 2048 * 256, CW1T + (size_t)(l * 2 + kv) * 256 * 2048, scr, r % I_C1, lane, 2048, 256); continue; } r -= 2 * I_C1;
            { const int kv = r / I_C2; p0_transpose_item<1>(cmp_w2 + (size_t)(l * 2 + kv) * 256 * 64, CW2T + (size_t)(l * 2 + kv) * 64 * 256, scr, r % I_C2, lane, 256, 64); }
        }
        if (bid == 1 && tid < 256) { bf16_t* KCb = (bf16_t*)(ws + WS_KC); KCb[(size_t)(tid >> 6) * 512 * 64 + 511 * 64 + (tid & 63)] = 0; }
        for (int w = gw0; w < MROWS; w += GW) k_rmsnorm(w, lane, x, norm_w, XN);
        for (int v = bid * NT + tid; v < MROWS; v += GT) ((unsigned long long*)(ws + WS_RSS))[v] = 0ull;
        if (bid == 0 && wid == 0) {
            float* MX = (float*)(ws + WS_MX);
            for (int l = 0; l < 2; ++l) {
                float mg[8];
#pragma unroll
                for (int i = 0; i < 8; ++i) { float v = fabsf(qk_gain[l * 512 + i * 64 + lane]);
#pragma unroll
                    for (int o = 1; o < 64; o <<= 1) v = fmaxf(v, __shfl_xor(v, o));
                    mg[i] = v; }
                float md0 = lane < 32 ? fabsf(qk_gain_diff[l * 64 + lane]) : 0.f, md1 = lane < 32 ? fabsf(qk_gain_diff[l * 64 + 32 + lane]) : 0.f;
#pragma unroll
                for (int o = 1; o < 64; o <<= 1) { md0 = fmaxf(md0, __shfl_xor(md0, o)); md1 = fmaxf(md1, __shfl_xor(md1, o)); }
                for (int gh = 0; gh < 16; ++gh) {
                    float mb = lane < 32 ? fabsf(tab[lane * 16 + gh]) : 0.f;
#pragma unroll
                    for (int o = 1; o < 64; o <<= 1) mb = fmaxf(mb, __shfl_xor(mb, o));
                    const int grp = gh >> 2, hh = gh & 3; float Mv;
                    if (grp == 0) Mv = 8.f * mg[0] * mg[1] + mb;
                    else if (grp == 1) Mv = fmaxf(8.f * mg[2] * mg[3] + mb, sinks[l * 4 + hh]);
                    else if (grp == 2) Mv = 5.656854249f * md0 * md1 + mb;
                    else Mv = 8.f * mg[4] * fmaxf(mg[5], fmaxf(mg[6], mg[7])) + mb;
                    if (lane == 0) MX[l * 16 + gh] = Mv;
                }
                float s1 = lane < 32 ? diff_lambda[l * 128 + lane] * diff_lambda[l * 128 + 32 + lane] : 0.f;
                float s2 = lane < 32 ? diff_lambda[l * 128 + 64 + lane] * diff_lambda[l * 128 + 96 + lane] : 0.f;
#pragma unroll
                for (int o = 1; o < 64; o <<= 1) { s1 += __shfl_xor(s1, o); s2 += __shfl_xor(s2, o); }
                const float lambda_init = 0.8f - 0.6f * expf(-0.3f * (float)l);
                if (lane == 0) { MX[32 + l] = expf(s1) - expf(s2) + lambda_init; MX[34 + l] = lambda_init; }
            }
        }
    }
    GRID_BAR();
#pragma unroll 1
    for (int l = 0; l < 2; ++l) {
        const float* xprev = l == 0 ? x : out;
        { pg8::Gemm g{XN, WinT + (size_t)l * HP * DM, MROWS, HP, DM}; pg8::StaticOrder So; So.init(MROWS, HP, G, bid);
          pg8::EpiProj E{H, qk_gain + l * 512, qk_gain_diff + l * 64, l == 0 ? nullptr : (const float*)(ws + WS_RSS)};
          for (int rep = 0; rep < R_G1; ++rep) pg8::gemm_phase<pg8::EpiProj, pg8::StaticOrder, true, true>((LAS unsigned char*)lds, g, So, E); }
        GRID_BAR();
        {
            const float* MX = (const float*)(ws + WS_MX);
            bf16_t* OA = (bf16_t*)(ws + WS_T0); float* DA = (float*)(ws + WS_DA);
            bf16_t* KCb = (bf16_t*)(ws + WS_KC);
            const bf16_t* CW1T = (const bf16_t*)(ws + WS_CW1); const bf16_t* CW2T = (const bf16_t*)(ws + WS_CW2);
            LAS unsigned* qw = (LAS unsigned*)((LAS unsigned char*)lds + att::L_Q);
            unsigned* qctr = (unsigned*)(ws + WS_CTL) + 8192 + 128 * l;
            unsigned* cdone = qctr + 64;
            constexpr int B0 = 64, B1 = B0 + 160 * R_C, B2 = B1 + 256 * R_D, B3 = B2 + 96 * R_C, B4 = B3 + 768 * R_AB, NUV = B4 + 256 * R_AB;
            for (;;) {
                if (opq(threadIdx.x) == 0) *qw = atomicAdd(qctr, 1u);
                __syncthreads();
                const int uv = (int)*qw;
                __syncthreads();
                if (uv >= NUV) break;
                int u;
                if (uv < B0) u = uv; else if (uv < B1) u = 64 + (uv - B0) / R_C; else if (uv < B2) u = 224 + (uv - B1) / R_D; else if (uv < B3) u = 480 + (uv - B2) / R_C;
                else if (uv < B4) u = 576 + (uv - B3) / R_AB; else u = 1344 + (uv - B4) / R_AB;
                if (u < 64) {
                    const int kv = u >> 5, b = (u >> 4) & 1, rt = u & 15;
                    att::CmpArgs P; P.Hb = H + (size_t)b * S * HP; P.col = kv == 0 ? C_KC : C_VC; P.rt = rt;
                    P.pos = cmp_pos + (size_t)(l * 2 + kv) * 2048; P.W1T = CW1T + (size_t)(l * 2 + kv) * 256 * 2048; P.b1 = cmp_b1 + (l * 2 + kv) * 256;
                    P.W2T = CW2T + (size_t)(l * 2 + kv) * 64 * 256; P.b2 = cmp_b2 + (l * 2 + kv) * 64; P.gain = kv == 0 ? qk_gain + l * 512 + 5 * 64 : nullptr;
                    P.OUT = KCb + (size_t)(kv * NB + b) * 512 * 64;
                    att::cmp_unit((LAS unsigned char*)lds, P);
                    asm volatile("s_waitcnt vmcnt(0)" ::: "memory");
                    __syncthreads();
                    if (opq(threadIdx.x) == 64) { __builtin_amdgcn_fence(__ATOMIC_RELEASE, "agent"); asm volatile("s_waitcnt vmcnt(0)" ::: "memory");
                        __hip_atomic_fetch_add(cdone, 1u, __ATOMIC_RELAXED, __HIP_MEMORY_SCOPE_AGENT); }
                    __syncthreads();
                } else if ((u >= 64 && u < 224) || (u >= 480 && u < 576)) {
                    int qb, bh;
                    if (u < 224) { qb = 31 - ((u - 64) >> 3); bh = (u - 64) & 7; } else { qb = 11 - ((u - 480) >> 3); bh = (u - 480) & 7; }
                    const int b = bh >> 2, hd = bh & 3;
                    att::DiffArgs P; P.Hb = H + (size_t)b * S * HP; P.hd = hd; P.qb = qb; P.brow = (size_t)b * S;
                    P.bias = tab + 8 + hd; P.M = MX[l * 16 + 8 + hd]; P.lam = MX[32 + l]; P.lambda_init = MX[34 + l]; P.subln = diff_subln + l * 64; P.Y = Y;
                    att::diff_unit((LAS unsigned char*)lds, P);
                } else if (u < 480) {
                    const int idx = u - 224, qb64 = 127 - (idx >> 1), b = idx & 1;
                    att::NsaArgs P; P.Hb = H + (size_t)b * S * HP; P.brow = (size_t)b * S; P.qb = qb64;
                    P.KC = KCb + (size_t)(0 * NB + b) * 512 * 64; P.VC = KCb + (size_t)(1 * NB + b) * 512 * 64;
                    P.bias = tab + 12; P.Mv = MX + l * 16 + 12; P.Y = Y; P.cdone = cdone;
                    att::nsa_unit((LAS unsigned char*)lds, P);
                } else if (u < 1344) {
                    const int v = u - 576, cfg = v >> 8, b = (v >> 7) & 1, hd = (v >> 5) & 3, ti = v & 31;
                    const int rate = cfg == 0 ? 1 : (cfg == 1 ? 4 : 16), tpc = 32 / rate;
                    att::BandArgs P; P.Hb = H + (size_t)b * S * HP; P.cq = C_AQ + 64 * hd; P.ck = C_AK + 64 * hd; P.cv = C_AV + 64 * hd;
                    P.rate = rate; P.cls = ti / tpc; P.f0 = (ti % tpc) * 256; P.maxd = 128; P.bias = tab + hd; P.M = MX[l * 16 + hd]; P.sinkterm = 0.f;
                    P.OA = OA + (size_t)cfg * MROWS * 256; P.DA = DA + (size_t)cfg * MROWS * 4; P.Y = nullptr; P.ycol = 0; P.hd = hd; P.brow = (size_t)b * S;
                    att::banded_unit<0>((LAS unsigned char*)lds, P);
                } else {
                    const int v = u - 1344, b = (v >> 7) & 1, hd = (v >> 5) & 3, ti = v & 31;
                    att::BandArgs P; P.Hb = H + (size_t)b * S * HP; P.cq = C_BQ + 64 * hd; P.ck = C_BK + 64 * (hd >> 1); P.cv = C_BV + 64 * (hd >> 1);
                    P.rate = 1; P.cls = 0; P.f0 = ti * 256; P.maxd = 127; P.bias = tab + 4 + hd; P.M = MX[l * 16 + 4 + hd];
                    P.sinkterm = __expf(sinks[l * 4 + hd] - P.M);
                    P.OA = nullptr; P.DA = nullptr; P.Y = Y; P.ycol = 256 + 64 * hd; P.hd = hd; P.brow = (size_t)b * S;
                    att::banded_unit<1>((LAS unsigned char*)lds, P);
                }
            }
        }
        GRID_BAR();
        {
            const bf16_t* OA = (const bf16_t*)(ws + WS_T0); const float* DA = (const float*)(ws + WS_DA);
            for (int v = (bid * NT + opq(threadIdx.x)); v < MROWS * 32; v += GT) {
                const int row = v >> 5, hd = (v >> 3) & 3, c8 = v & 7;
                float acc8[8] = {0.f, 0.f, 0.f, 0.f, 0.f, 0.f, 0.f, 0.f}; float dsum = 0.f;
#pragma unroll
                for (int cfg = 0; cfg < 3; ++cfg) {
                    const float dn = DA[((size_t)cfg * MROWS + row) * 4 + hd]; dsum += dn;
                    const uint4 r4 = *(const uint4*)(OA + ((size_t)cfg * MROWS + row) * 256 + hd * 64 + c8 * 8);
                    acc8[0] += dn * __uint_as_float(r4.x << 16); acc8[1] += dn * __uint_as_float(r4.x & 0xffff0000u);
                    acc8[2] += dn * __uint_as_float(r4.y << 16); acc8[3] += dn * __uint_as_float(r4.y & 0xffff0000u);
                    acc8[4] += dn * __uint_as_float(r4.z << 16); acc8[5] += dn * __uint_as_float(r4.z & 0xffff0000u);
                    acc8[6] += dn * __uint_as_float(r4.w << 16); acc8[7] += dn * __uint_as_float(r4.w & 0xffff0000u);
                }
                const float inv = 1.f / dsum;
                const uint4 s4 = *(const uint4*)(H + (size_t)row * HP + C_SILU + hd * 64 + c8 * 8);
                uint4 o4;
                o4.x = (unsigned)f2bf(acc8[0] * inv * __uint_as_float(s4.x << 16)) | ((unsigned)f2bf(acc8[1] * inv * __uint_as_float(s4.x & 0xffff0000u)) << 16);
                o4.y = (unsigned)f2bf(acc8[2] * inv * __uint_as_float(s4.y << 16)) | ((unsigned)f2bf(acc8[3] * inv * __uint_as_float(s4.y & 0xffff0000u)) << 16);
                o4.z = (unsigned)f2bf(acc8[4] * inv * __uint_as_float(s4.z << 16)) | ((unsigned)f2bf(acc8[5] * inv * __uint_as_float(s4.z & 0xffff0000u)) << 16);
                o4.w = (unsigned)f2bf(acc8[6] * inv * __uint_as_float(s4.w << 16)) | ((unsigned)f2bf(acc8[7] * inv * __uint_as_float(s4.w & 0xffff0000u)) << 16);
                *(uint4*)(Y + (size_t)row * DM + hd * 64 + c8 * 8) = o4;
            }
        }
        GRID_BAR();
        { pg8::Gemm g{Y, WoutT + (size_t)l * DM * DM, MROWS, DM, DM}; pg8::StaticOrder So; So.init(MROWS, DM, G, bid);
          pg8::EpiOut E{xprev, out, (LAS float*)((LAS unsigned char*)lds + 132096), l == 0 ? XN : nullptr, norm_w + DM, (float*)(ws + WS_RSS)};
          pg8::gemm_phase<pg8::EpiOut, pg8::StaticOrder, true, true>((LAS unsigned char*)lds, g, So, E); }
        if (l == 0) GRID_BAR();
    }
}

extern "C" void kernel_launch(void* const* d_in, const int* in_sizes, int n_in, void* d_out, int out_size, void* d_ws, size_t ws_size, hipStream_t stream) {
    static int grid = 0;
    if (grid == 0) {
        int dev = 0, cus = 0;
        (void)hipGetDevice(&dev);
        (void)hipDeviceGetAttribute(&cus, hipDeviceAttributeMultiprocessorCount, dev);
        (void)hipFuncSetAttribute((const void*)mega_fwd, hipFuncAttributeMaxDynamicSharedMemorySize, LDS_BYTES);
        grid = cus > 0 ? cus : 256;
    }
    (void)hipMemsetAsync((char*)d_ws + WS_CTL, 0, CTL_ZERO_BYTES, stream);
    Args a{};
    for (int i = 0; i < 15; ++i) a.in[i] = (const float*)d_in[i];
    a.out = (float*)d_out; a.ws = (unsigned char*)d_ws;
    hipLaunchKernelGGL(mega_fwd, dim3(grid), dim3(NT), LDS_BYTES, stream, a);
}
```

```cpp
#include <hip/hip_runtime.h>
#include <stdint.h>
#include <math.h>

typedef unsigned short bf16_t;
__device__ __forceinline__ float bf2f(bf16_t v) { return __uint_as_float((unsigned)v << 16); }
__device__ __forceinline__ bf16_t f2bf(float f) { unsigned u = __float_as_uint(f); return (bf16_t)((u + 0x7fffu + ((u >> 16) & 1u)) >> 16); }

constexpr int NB = 2, S = 8192, DM = 1024, MROWS = NB * S, PW = 3724, HP = 3840;
constexpr int C_AQ = 0, C_AK = 256, C_AV = 512, C_BQ = 768, C_BK = 1024, C_BV = 1152, C_CQ = 1280, C_CK = 1536, C_CV = 1792,
              C_DQ = 2048, C_KC = 2304, C_VC = 2368, C_KS = 2432, C_VS = 2496, C_KW = 2560, C_VW = 2624, C_GT = 2688, C_SILU = 2816;
constexpr float EPS = 1e-6f;
__device__ __forceinline__ int opq(int v) { asm volatile("" : "+v"(v)); return v; }

__device__ __forceinline__ int t5_bucket(int n) {
    if (n < 16) return n < 0 ? 0 : n;
    int b = 16;
    b += (n >= 22); b += (n >= 30); b += (n >= 40); b += (n >= 54); b += (n >= 73); b += (n >= 99); b += (n >= 134); b += (n >= 182);
    b += (n >= 246); b += (n >= 332); b += (n >= 450); b += (n >= 609); b += (n >= 825); b += (n >= 1117); b += (n >= 1513);
    return b;
}

__device__ __forceinline__ void k_rmsnorm(const int wave, const int lane, const float* __restrict__ x, const float* __restrict__ g, bf16_t* __restrict__ xn) {
    if (wave >= MROWS) return;
    const float4* xr = (const float4*)(x + (size_t)wave * DM);
    float4 v[4]; float ss = 0.f;
#pragma unroll
    for (int j = 0; j < 4; ++j) { v[j] = xr[lane + 64 * j]; ss += (v[j].x * v[j].x + v[j].y * v[j].y) + (v[j].z * v[j].z + v[j].w * v[j].w); }
#pragma unroll
    for (int o = 1; o < 64; o <<= 1) ss += __shfl_xor(ss, o);
    const float rstd = rsqrtf(ss * (1.f / DM) + EPS);
#pragma unroll
    for (int j = 0; j < 4; ++j) {
        const float4 gg = ((const float4*)g)[lane + 64 * j];
        uint2 o; o.x = (unsigned)f2bf(v[j].x * rstd * gg.x) | ((unsigned)f2bf(v[j].y * rstd * gg.y) << 16);
        o.y = (unsigned)f2bf(v[j].z * rstd * gg.z) | ((unsigned)f2bf(v[j].w * rstd * gg.w) << 16);
        ((uint2*)(xn + (size_t)wave * DM))[lane + 64 * j] = o;
    }
}

template <int D>
__device__ __forceinline__ float dot_row(const float* q, const bf16_t* kr) {
    float s = 0.f;
#pragma unroll
    for (int c = 0; c < D / 8; ++c) {
        const uint4 r = *(const uint4*)(kr + 8 * c);
        s += q[8 * c + 0] * __uint_as_float(r.x << 16) + q[8 * c + 1] * __uint_as_float(r.x & 0xffff0000u);
        s += q[8 * c + 2] * __uint_as_float(r.y << 16) + q[8 * c + 3] * __uint_as_float(r.y & 0xffff0000u);
        s += q[8 * c + 4] * __uint_as_float(r.z << 16) + q[8 * c + 5] * __uint_as_float(r.z & 0xffff0000u);
        s += q[8 * c + 6] * __uint_as_float(r.w << 16) + q[8 * c + 7] * __uint_as_float(r.w & 0xffff0000u);
        if (c & 1) asm volatile("" ::: "memory");
    }
    return s;
}
__device__ __forceinline__ void os_step(float s, const bf16_t* vr, float& m, float& den, float* o) {
    const float mn = fmaxf(m, s), sc = __expf(m - mn), p = __expf(s - mn);
    den = den * sc + p; m = mn;
#pragma unroll
    for (int c = 0; c < 8; ++c) {
        const uint4 r = *(const uint4*)(vr + 8 * c);
        o[8 * c + 0] = o[8 * c + 0] * sc + p * __uint_as_float(r.x << 16); o[8 * c + 1] = o[8 * c + 1] * sc + p * __uint_as_float(r.x & 0xffff0000u);
        o[8 * c + 2] = o[8 * c + 2] * sc + p * __uint_as_float(r.y << 16); o[8 * c + 3] = o[8 * c + 3] * sc + p * __uint_as_float(r.y & 0xffff0000u);
        o[8 * c + 4] = o[8 * c + 4] * sc + p * __uint_as_float(r.z << 16); o[8 * c + 5] = o[8 * c + 5] * sc + p * __uint_as_float(r.z & 0xffff0000u);
        o[8 * c + 6] = o[8 * c + 6] * sc + p * __uint_as_float(r.w << 16); o[8 * c + 7] = o[8 * c + 7] * sc + p * __uint_as_float(r.w & 0xffff0000u);
        if (c & 1) asm volatile("" ::: "memory");
    }
}
template <int D>
__device__ __forceinline__ void load_q(float* q, const bf16_t* p) {
#pragma unroll
    for (int c = 0; c < D / 8; ++c) {
        const uint4 r = *(const uint4*)(p + 8 * c);
        q[8 * c + 0] = __uint_as_float(r.x << 16); q[8 * c + 1] = __uint_as_float(r.x & 0xffff0000u);
        q[8 * c + 2] = __uint_as_float(r.y << 16); q[8 * c + 3] = __uint_as_float(r.y & 0xffff0000u);
        q[8 * c + 4] = __uint_as_float(r.z << 16); q[8 * c + 5] = __uint_as_float(r.z & 0xffff0000u);
        q[8 * c + 6] = __uint_as_float(r.w << 16); q[8 * c + 7] = __uint_as_float(r.w & 0xffff0000u);
    }
}

#define LAS __attribute__((address_space(3)))
namespace pg8 {
#define PG8_LAS __attribute__((address_space(3)))
typedef unsigned short bf16_t;
typedef short bf16x8 __attribute__((ext_vector_type(8)));
typedef float f32x4 __attribute__((ext_vector_type(4)));
typedef unsigned u32x4 __attribute__((ext_vector_type(4)));
constexpr int BM = 256, BK = 64, HALF = 128, HTB = HALF * BK * 2  , STAGE_BYTES = 8 * HTB, NXCD = 8, WGM = 8;

__host__ __device__ __forceinline__ int lds_byte(int r, int c) { const int st = (r >> 4) * 2 + (c >> 5), rr = r & 15, cc = c & 31, ob = rr * 64 + cc * 2; return st * 1024 + (ob ^ (((ob >> 9) & 1) << 5)); }
__host__ __device__ __forceinline__ void stage_rc(int b, int& R, int& C) { const int st = b / 1024, sb = b % 1024, swz = sb ^ (((sb >> 9) & 1) << 5); R = (st >> 1) * 16 + swz / 64; C = (st & 1) * 32 + (swz % 64) / 2; }
__host__ __device__ __forceinline__ int perm32(int rho) { const int n = rho >> 4, i = rho & 15; return 8 * (i >> 2) + 4 * n + (i & 3); }

struct Unit { int pm, pn; };
struct Gemm { const bf16_t* A; const bf16_t* Bt; int M, N, K; };

struct StaticOrder {
    int nM, nN, nwg, G, c;
    __host__ __device__ void init(int M, int N, int G_, int c_) { nM = M / BM; nN = N / BM; nwg = nM * nN; G = G_; c = c_; }
    __host__ __device__ bool next(int i, Unit& u) const {
        const long L = (long)i * G + c; if (L >= nwg) return false;
        int wgid = (int)L; { const int q = nwg / NXCD, r = nwg % NXCD, xcd = wgid % NXCD, off = wgid / NXCD; wgid = (xcd < r ? xcd * (q + 1) : r * (q + 1) + (xcd - r) * q) + off; }
        const int nig = WGM * nN, gid = wgid / nig, fm = gid * WGM, gsz = (nM - fm) < WGM ? (nM - fm) : WGM;
        u.pm = fm + ((wgid % nig) % gsz); u.pn = (wgid % nig) / gsz; return true;
    }
    __device__ __forceinline__ void a_ready(const Unit&) const {}
    __device__ __forceinline__ void done(const Unit&) const {}
};

__device__ __forceinline__ unsigned cvt_pk_bf16(float lo, float hi) { unsigned r; asm volatile("v_cvt_pk_bf16_f32 %0, %1, %2" : "=v"(r) : "v"(lo), "v"(hi)); return r; }
template <class Epi, class Sched, bool ALIGN_EPI = false, bool SP2 = false>
__device__ __forceinline__ void gemm_phase(PG8_LAS unsigned char* lds, const Gemm g, const Sched& S, const Epi& E) {
    const int tid = opq(threadIdx.x), wid = __builtin_amdgcn_readfirstlane(tid >> 6), lane = tid & 63, wr = wid >> 2, wc = wid & 3, fr = lane & 15, fq = lane >> 4;
    const int K = g.K, nt = K / BK;
    unsigned voffA[2], voffB[2];
#pragma unroll
    for (int i = 0; i < 2; ++i) { int R, C; stage_rc(tid * 16 + i * 8192, R, C); const int Rb = Epi::PERM ? ((R & ~31) + perm32(R & 31)) : R;
        voffA[i] = (unsigned)(R * K + C) * 2u; voffB[i] = (unsigned)(Rb * K + C) * 2u; }
    const size_t kstep = (size_t)(BK * 2);
    const size_t hstep = (size_t)HALF * K * 2;
    const size_t tstep = 2 * hstep;
    const unsigned ldsw = (unsigned)wid * 1024u;
    const int aoff = lds_byte(wr * 64 + fr, fq * 8), boff = lds_byte(wc * 32 + fr, fq * 8);
#define PG8_SA(b, h) (((b) * 2 + (h)) * HTB)
#define PG8_SB(b, h) ((4 + (b) * 2 + (h)) * HTB)
#define PG8_STAGE(bufoff, gbase, voff) do { _Pragma("unroll") for (int _i = 0; _i < 2; ++_i) \
        __builtin_amdgcn_global_load_lds((const unsigned*)((const char*)(gbase) + (voff)[_i]), (PG8_LAS unsigned*)(lds + (bufoff) + ldsw + _i * 8192), 16, 0, 0); } while (0)
#define PG8_LDA(dst, b, h) do { _Pragma("unroll") for (int m = 0; m < 4; ++m) _Pragma("unroll") for (int k = 0; k < 2; ++k) dst[m][k] = *(const PG8_LAS bf16x8*)(lds + PG8_SA(b, h) + aoff + m * 2048 + k * 1024); } while (0)
#define PG8_LDB(dst, b, h) do { _Pragma("unroll") for (int n = 0; n < 2; ++n) _Pragma("unroll") for (int k = 0; k < 2; ++k) dst[n][k] = *(const PG8_LAS bf16x8*)(lds + PG8_SB(b, h) + boff + n * 2048 + k * 1024); } while (0)
#define PG8_MMA(ai, bj, At, Bt) do { __builtin_amdgcn_s_setprio(1); _Pragma("unroll") for (int m = 0; m < 4; ++m) _Pragma("unroll") for (int n = 0; n < 2; ++n) _Pragma("unroll") for (int k = 0; k < 2; ++k) \
        acc[ai][bj][m][n] = __builtin_amdgcn_mfma_f32_16x16x32_bf16(Bt[n][k], At[m][k], acc[ai][bj][m][n], 0, 0, 0); __builtin_amdgcn_s_setprio(0); } while (0)
#define PG8_WAIT_V(n) asm volatile("s_waitcnt vmcnt(" #n ")" ::: "memory")
#define PG8_WAIT_L(n) asm volatile("s_waitcnt lgkmcnt(" #n ")" ::: "memory")
#define PG8_BAR __builtin_amdgcn_s_barrier()
#define PG8_SCHED __builtin_amdgcn_sched_barrier(0)
    Unit cur, nxt; int ui = 0;
    if (!S.next(0, cur)) return;
    f32x4 acc[2][2][4][2];
#pragma unroll
    for (int a = 0; a < 2; ++a)
#pragma unroll
        for (int b = 0; b < 2; ++b)
#pragma unroll
            for (int m = 0; m < 4; ++m)
#pragma unroll
                for (int n = 0; n < 2; ++n) acc[a][b][m][n] = (f32x4){0.f, 0.f, 0.f, 0.f};
    bf16x8 At[4][2], B0[2][2], B1[2][2];
    const char* cA = (const char*)g.A + (size_t)cur.pm * tstep; const char* cB = (const char*)g.Bt + (size_t)cur.pn * tstep;
    S.a_ready(cur);
    if constexpr (SP2) {
        PG8_STAGE(PG8_SB(0, 0), cB, voffB); PG8_STAGE(PG8_SB(0, 1), cB + hstep, voffB); PG8_STAGE(PG8_SA(0, 0), cA, voffA); PG8_STAGE(PG8_SA(0, 1), cA + hstep, voffA);
        if (wr == 1) PG8_BAR;
        PG8_WAIT_V(2); PG8_BAR;
        PG8_STAGE(PG8_SB(1, 0), cB + kstep, voffB); PG8_STAGE(PG8_SA(1, 0), cA + kstep, voffA); PG8_STAGE(PG8_SB(1, 1), cB + hstep + kstep, voffB);
        PG8_WAIT_V(6); PG8_BAR;
    } else {
        PG8_STAGE(PG8_SB(0, 0), cB, voffB); PG8_STAGE(PG8_SA(0, 0), cA, voffA); PG8_STAGE(PG8_SB(0, 1), cB + hstep, voffB); PG8_STAGE(PG8_SA(0, 1), cA + hstep, voffA);
        if (wr == 1) PG8_BAR;
        PG8_WAIT_V(4); PG8_BAR;
        PG8_STAGE(PG8_SB(1, 0), cB + kstep, voffB); PG8_STAGE(PG8_SA(1, 0), cA + kstep, voffA); PG8_STAGE(PG8_SB(1, 1), cB + hstep + kstep, voffB);
        PG8_WAIT_V(6); PG8_BAR;
    }
    for (;;) {
        const bool has_next = S.next(ui + 1, nxt);
        const char* nA = has_next ? (const char*)g.A + (size_t)nxt.pm * tstep : cA; const char* nB = has_next ? (const char*)g.Bt + (size_t)nxt.pn * tstep : cB;
        for (int t = 0; t < nt; t += 2) {
            const bool last = (t == nt - 2);
            const char* a1 = cA + (size_t)(t + 1) * kstep;
            const char* a2 = last ? nA : cA + (size_t)(t + 2) * kstep; const char* b2 = last ? nB : cB + (size_t)(t + 2) * kstep;
            const char* a3 = a2 + kstep; const char* b3 = b2 + kstep;
            if (last && has_next) S.a_ready(nxt);
            if constexpr (SP2) {
            PG8_LDB(B0, 0, 0); PG8_LDB(B1, 0, 1); PG8_SCHED; PG8_LDA(At, 0, 0); PG8_STAGE(PG8_SA(1, 1), a1 + hstep, voffA);
            PG8_WAIT_V(8); PG8_WAIT_L(0); PG8_BAR; PG8_MMA(0, 0, At, B0); PG8_MMA(0, 1, At, B1); PG8_BAR; PG8_SCHED;
            PG8_LDA(At, 0, 1); PG8_STAGE(PG8_SB(0, 0), b2, voffB); PG8_STAGE(PG8_SB(0, 1), b2 + hstep, voffB); PG8_STAGE(PG8_SA(0, 0), a2, voffA);
            PG8_WAIT_V(8); PG8_WAIT_L(0); PG8_BAR; PG8_MMA(1, 0, At, B0); PG8_MMA(1, 1, At, B1); PG8_BAR; PG8_SCHED;
            PG8_LDB(B0, 1, 0); PG8_LDB(B1, 1, 1); PG8_SCHED; PG8_LDA(At, 1, 0); PG8_STAGE(PG8_SA(0, 1), a2 + hstep, voffA);
            PG8_WAIT_V(8); PG8_WAIT_L(0); PG8_BAR; PG8_MMA(0, 0, At, B0); PG8_MMA(0, 1, At, B1); PG8_BAR; PG8_SCHED;
            PG8_LDA(At, 1, 1); PG8_STAGE(PG8_SB(1, 0), b3, voffB); PG8_STAGE(PG8_SB(1, 1), b3 + hstep, voffB); PG8_STAGE(PG8_SA(1, 0), a3, voffA);
            PG8_WAIT_V(8); PG8_WAIT_L(0); PG8_BAR; PG8_MMA(1, 0, At, B0); PG8_MMA(1, 1, At, B1); PG8_BAR; PG8_SCHED;
            } else {
            PG8_LDB(B0, 0, 0); PG8_SCHED; PG8_LDA(At, 0, 0); PG8_STAGE(PG8_SA(1, 1), a1 + hstep, voffA);
            PG8_WAIT_L(8); PG8_BAR; PG8_WAIT_L(0); PG8_MMA(0, 0, At, B0); PG8_BAR; PG8_SCHED;
            PG8_LDB(B1, 0, 1); PG8_STAGE(PG8_SB(0, 0), b2, voffB);
            PG8_BAR; PG8_WAIT_L(0); PG8_MMA(0, 1, At, B1); PG8_BAR;
            PG8_LDA(At, 0, 1); PG8_STAGE(PG8_SA(0, 0), a2, voffA);
            PG8_BAR; PG8_WAIT_L(0); PG8_MMA(1, 0, At, B0); PG8_BAR; PG8_SCHED;
            PG8_STAGE(PG8_SB(0, 1), b2 + hstep, voffB);
            PG8_WAIT_V(6); PG8_BAR; PG8_MMA(1, 1, At, B1); PG8_BAR;
            PG8_LDB(B0, 1, 0); PG8_SCHED; PG8_LDA(At, 1, 0); PG8_STAGE(PG8_SA(0, 1), a2 + hstep, voffA);
            PG8_WAIT_L(8); PG8_BAR; PG8_WAIT_L(0); PG8_MMA(0, 0, At, B0); PG8_BAR; PG8_SCHED;
            PG8_LDB(B1, 1, 1); PG8_STAGE(PG8_SB(1, 0), b3, voffB);
            PG8_BAR; PG8_WAIT_L(0); PG8_MMA(0, 1, At, B1); PG8_BAR;
            PG8_LDA(At, 1, 1); PG8_STAGE(PG8_SA(1, 0), a3, voffA);
            PG8_BAR; PG8_WAIT_L(0); PG8_MMA(1, 0, At, B0); PG8_BAR; PG8_SCHED;
            PG8_STAGE(PG8_SB(1, 1), b3 + hstep, voffB);
            PG8_WAIT_V(6); PG8_BAR; PG8_MMA(1, 1, At, B1); PG8_BAR;
            }
        }
        if constexpr (ALIGN_EPI) { if (wr == 0) PG8_BAR; }
        if constexpr (!Epi::AFTER_DRAIN) { E(acc, cur, wr, wc, fr, fq); S.done(cur); }
        if (!has_next) break;
#pragma unroll
        for (int a = 0; a < 2; ++a)
#pragma unroll
            for (int b = 0; b < 2; ++b)
#pragma unroll
                for (int m = 0; m < 4; ++m)
#pragma unroll
                    for (int n = 0; n < 2; ++n) acc[a][b][m][n] = (f32x4){0.f, 0.f, 0.f, 0.f};
        cur = nxt; cA = nA; cB = nB; ++ui;
        if constexpr (ALIGN_EPI) { if (wr == 1) PG8_BAR; }
    }
    PG8_WAIT_V(0);
    if constexpr (!ALIGN_EPI) { if (wr == 0) PG8_BAR; }
    PG8_BAR;
    if constexpr (Epi::AFTER_DRAIN) { E.fused(acc, cur, wr, wc, fr, fq, lds, wid, lane); S.done(cur); }
#undef PG8_SA
#undef PG8_SB
#undef PG8_STAGE
#undef PG8_LDA
#undef PG8_LDB
#undef PG8_MMA
#undef PG8_WAIT_V
#undef PG8_WAIT_L
#undef PG8_BAR
#undef PG8_SCHED
}
}

namespace pg8 {
struct EpiProj {
    static constexpr bool PERM = true, AFTER_DRAIN = false;
    bf16_t* H; const float* g; const float* gd;
    const float* rowss;
    __device__ __forceinline__ void operator()(const f32x4 (&acc)[2][2][4][2], const Unit& u, int wr, int wc, int fr, int fq) const {
        const int pn = u.pn;
        int mode = 0; const float* gain = nullptr;
        const float qs = (pn == 0 || pn == 3 || pn == 8) ? 0.125f * 1.4426950408889634f : (pn == 5 ? 0.17677669529663687f * 1.4426950408889634f : 1.f);
        if (pn == 0) { mode = 1; gain = g; } else if (pn == 1) { mode = 1; gain = g + 64; } else if (pn == 3) { mode = 1; gain = g + 128; }
        else if (pn == 4) { if (wc < 2) { mode = 1; gain = g + 192; } }
        else if (pn == 5) { mode = 2; gain = gd; } else if (pn == 6) { mode = 2; gain = gd + 32; }
        else if (pn == 8) { mode = 1; gain = g + 256; }
        else if (pn == 9) { if (wc == 2) { mode = 1; gain = g + 384; } }
        else if (pn == 10) { if (wc == 0) { mode = 1; gain = g + 448; } else if (wc == 2) mode = 4; }
        else if (pn >= 11) mode = 3;
        f32x4 gv[2][2];
#pragma unroll
        for (int bj = 0; bj < 2; ++bj)
#pragma unroll
            for (int n = 0; n < 2; ++n) gv[bj][n] = (f32x4){1.f, 1.f, 1.f, 1.f};
        if (mode == 1) {
#pragma unroll
            for (int bj = 0; bj < 2; ++bj)
#pragma unroll
                for (int n = 0; n < 2; ++n) gv[bj][n] = *(const f32x4*)(gain + 32 * bj + 8 * fq + 4 * n);
        } else if (mode == 2) {
#pragma unroll
            for (int bj = 0; bj < 2; ++bj)
#pragma unroll
                for (int n = 0; n < 2; ++n) gv[bj][n] = *(const f32x4*)(gain + 8 * fq + 4 * n);
        }
        const int col0 = pn * BM + 64 * wc + 8 * fq;
#pragma unroll
        for (int ai = 0; ai < 2; ++ai)
#pragma unroll
            for (int m = 0; m < 4; ++m) {
                const int row = u.pm * BM + ai * HALF + wr * 64 + m * 16 + fr;
                f32x4 v[2][2];
                const float rsc = rowss ? rsqrtf((float)((const unsigned long long*)rowss)[row] * (1.f / (1048576.f * 1024.f)) + 1e-6f) : 1.f;
#pragma unroll
                for (int bj = 0; bj < 2; ++bj)
#pragma unroll
                    for (int n = 0; n < 2; ++n) v[bj][n] = acc[ai][bj][m][n] * rsc;
                if (mode == 1 || mode == 2) {
                    float s0 = 0.f, s1 = 0.f;
#pragma unroll
                    for (int n = 0; n < 2; ++n) {
                        s0 += v[0][n][0] * v[0][n][0] + v[0][n][1] * v[0][n][1] + v[0][n][2] * v[0][n][2] + v[0][n][3] * v[0][n][3];
                        s1 += v[1][n][0] * v[1][n][0] + v[1][n][1] * v[1][n][1] + v[1][n][2] * v[1][n][2] + v[1][n][3] * v[1][n][3];
                    }
                    s0 += __shfl_xor(s0, 16); s0 += __shfl_xor(s0, 32);
                    s1 += __shfl_xor(s1, 16); s1 += __shfl_xor(s1, 32);
                    float r0, r1;
                    if (mode == 1) { r0 = r1 = rsqrtf((s0 + s1) * (1.f / 64.f) + 1e-6f) * qs; }
                    else { r0 = rsqrtf(s0 * (1.f / 32.f) + 1e-6f) * qs; r1 = rsqrtf(s1 * (1.f / 32.f) + 1e-6f) * qs; }
#pragma unroll
                    for (int n = 0; n < 2; ++n) { v[0][n] = v[0][n] * r0 * gv[0][n]; v[1][n] = v[1][n] * r1 * gv[1][n]; }
                } else if (mode == 3) {
#pragma unroll
                    for (int bj = 0; bj < 2; ++bj)
#pragma unroll
                        for (int n = 0; n < 2; ++n)
#pragma unroll
                            for (int e = 0; e < 4; ++e) { const float x = v[bj][n][e]; v[bj][n][e] = x * __builtin_amdgcn_rcpf(1.f + __expf(-x)); }
                } else if (mode == 4) {
#pragma unroll
                    for (int bj = 0; bj < 2; ++bj)
#pragma unroll
                        for (int n = 0; n < 2; ++n)
#pragma unroll
                            for (int e = 0; e < 4; ++e) { const float x = v[bj][n][e]; v[bj][n][e] = __builtin_amdgcn_rcpf(1.f + __expf(-x)); }
                }
                bf16_t* rowp = H + (size_t)row * 3840 + col0;
#pragma unroll
                for (int bj = 0; bj < 2; ++bj) {
                    u32x4 w; w.x = cvt_pk_bf16(v[bj][0][0], v[bj][0][1]); w.y = cvt_pk_bf16(v[bj][0][2], v[bj][0][3]);
                    w.z = cvt_pk_bf16(v[bj][1][0], v[bj][1][1]); w.w = cvt_pk_bf16(v[bj][1][2], v[bj][1][3]);
                    *(u32x4*)(rowp + 32 * bj) = w;
                }
            }
    }
};
struct EpiOut {
    static constexpr bool PERM = false, AFTER_DRAIN = false;
    const float* xprev; float* out;
    PG8_LAS float* exch;
    bf16_t* xn; const float* gnext; float* rowss;
    __device__ __forceinline__ void operator()(const f32x4 (&acc)[2][2][4][2], const Unit& u, int wr, int wc, int fr, int fq) const {
        const int col0 = u.pn * BM + wc * 32 + 4 * fq;
        f32x4 gn[2][2];
#pragma unroll
        for (int bj = 0; bj < 2; ++bj)
#pragma unroll
            for (int n = 0; n < 2; ++n) gn[bj][n] = xn ? *(const f32x4*)(gnext + col0 + bj * HALF + n * 16) : (f32x4){0.f, 0.f, 0.f, 0.f};
#pragma unroll
        for (int ai = 0; ai < 2; ++ai)
#pragma unroll
            for (int m = 0; m < 4; ++m) {
                const int row = u.pm * BM + ai * HALF + wr * 64 + m * 16 + fr;
                const size_t off = (size_t)row * 1024 + col0;
                float ss = 0.f;
#pragma unroll
                for (int bj = 0; bj < 2; ++bj)
#pragma unroll
                    for (int n = 0; n < 2; ++n) {
                        const f32x4 b = *(const f32x4*)(xprev + off + bj * HALF + n * 16);
                        const f32x4 v = b + acc[ai][bj][m][n];
                        *(f32x4*)(out + off + bj * HALF + n * 16) = v;
                        if (xn) {
                            ss += (v[0] * v[0] + v[1] * v[1]) + (v[2] * v[2] + v[3] * v[3]);
                            const f32x4 w = v * gn[bj][n];
                            uint2 o; o.x = cvt_pk_bf16(w[0], w[1]); o.y = cvt_pk_bf16(w[2], w[3]);
                            *(uint2*)(xn + off + bj * HALF + n * 16) = o;
                        }
                    }
                if (xn) {
                    ss += __shfl_xor(ss, 16); ss += __shfl_xor(ss, 32);
                    if (fq == 0) exch[(ai * HALF + wr * 64 + m * 16 + fr) * 4 + wc] = ss;
                }
            }
        if (xn) {
            asm volatile("s_waitcnt lgkmcnt(0)" ::: "memory"); __builtin_amdgcn_s_barrier(); asm volatile("" ::: "memory");
            if (wc == 0) {
                const int lane = fq * 16 + fr;
#pragma unroll
                for (int k = 0; k < 2; ++k) {
                    const int rl = k * HALF + wr * 64 + lane;
                    const f32x4 p = *(const PG8_LAS f32x4*)(exch + rl * 4);
                    const float tot = (p[0] + p[1]) + (p[2] + p[3]);
                    atomicAdd((unsigned long long*)rowss + (u.pm * BM + rl), (unsigned long long)(tot * 1048576.f + 0.5f));
                }
            }
        }
    }
};
}

template <int MODE>
__device__ __forceinline__ void p0_transpose_item(const float* __restrict__ W, bf16_t* __restrict__ WT, LAS float* scr, int item, int lane, int KR = 1024, int NC = 1024) {
    const int NSRC = MODE == 0 ? 3724 : NC, NG = MODE == 0 ? 120 : NC / 32;
    const int kb = item / NG, nb = item % NG, k0 = 64 * kb, hc0 = 32 * nb;
    const int hc = hc0 + (lane & 31);
    int src = hc;
    if (MODE == 0) src = hc < 2700 ? hc : (hc < 2816 ? -1 : hc - 116);
#pragma unroll 8
    for (int i = 0; i < 32; ++i) { const int kk = 2 * i + (lane >> 5); scr[kk * 33 + (lane & 31)] = src >= 0 ? W[(size_t)(k0 + kk) * NSRC + src] : 0.f; }
    asm volatile("s_waitcnt lgkmcnt(0)" ::: "memory");
    const int c = lane & 7;
#pragma unroll
    for (int j = 0; j < 4; ++j) {
        const int n = (lane >> 3) + 8 * j; const LAS float* s = scr + (8 * c) * 33 + n;
        const int hcn = hc0 + n;
        int drow = hcn;
        if (MODE == 0) drow = (hcn & ~255) + ((hcn >> 5) & 1) * 128 + ((hcn >> 6) & 3) * 32 + (hcn & 31);
        uint4 o; o.x = (unsigned)f2bf(s[0]) | ((unsigned)f2bf(s[33]) << 16); o.y = (unsigned)f2bf(s[66]) | ((unsigned)f2bf(s[99]) << 16);
        o.z = (unsigned)f2bf(s[132]) | ((unsigned)f2bf(s[165]) << 16); o.w = (unsigned)f2bf(s[198]) | ((unsigned)f2bf(s[231]) << 16);
        if (MODE == 2) { const int k = k0 + 8 * c; *(uint4*)(WT + ((size_t)((((drow >> 5) * 8 + (k >> 8)) * 16 + ((k >> 4) & 15)) * 64 + ((k >> 3) & 1) * 32 + (drow & 31))) * 8) = o; }
        else *(uint4*)(WT + (size_t)drow * KR + k0 + 8 * c) = o;
    }
    asm volatile("s_waitcnt lgkmcnt(0)" ::: "memory");
}

namespace att {
typedef short bf16x8 __attribute__((ext_vector_type(8)));
typedef short v4i16 __attribute__((ext_vector_type(4)));
typedef float f32x16 __attribute__((ext_vector_type(16)));
typedef float f32x2_t __attribute__((ext_vector_type(2)));
typedef __bf16 bf16x2_t __attribute__((ext_vector_type(2)));
typedef unsigned u32x4 __attribute__((ext_vector_type(4)));
typedef float f32x4 __attribute__((ext_vector_type(4)));
__device__ __forceinline__ unsigned cvtpk(float lo, float hi) { f32x2_t v = {lo, hi}; bf16x2_t b = __builtin_convertvector(v, bf16x2_t); return __builtin_bit_cast(unsigned, b); }
__device__ __forceinline__ int crow(int r, int h) { return (r & 3) + 8 * (r >> 2) + 4 * h; }
constexpr float LOG2E = 1.4426950408889634f;
constexpr int L_KV = 0, KVB = 16384  , L_TAB = 32768  , L_WSCR = 83968  , L_IMP = 92160  , L_Q = 124928, L_SEL = 125184  , L_SB = 126464  ;

struct StageRegs { u32x4 k, v; };
__device__ __forceinline__ void stage_load(StageRegs& sr, const bf16_t* kp, const bf16_t* vp, bool valid, int ch) {
    sr.k = (u32x4){0u, 0u, 0u, 0u}; sr.v = sr.k;
    if (valid) { sr.k = *(const u32x4*)(kp + ch * 8); sr.v = *(const u32x4*)(vp + ch * 8); }
}
__device__ __forceinline__ void stage_write(LAS unsigned char* buf, const StageRegs& sr, int row, int ch) {
    *(LAS u32x4*)(buf + row * 128 + ((ch ^ (row & 7)) << 4)) = sr.k;
    *(LAS u32x4*)(buf + 8192 + (ch >> 2) * 4096 + row * 64 + (ch & 3) * 16) = sr.v;
}
__device__ __forceinline__ f32x16 load_tab16(const LAS float* tbl, int TSP, int jb) {
    const int sh = jb & 3; const LAS float* tp = tbl + sh * TSP + (jb - sh);
    const f32x4 t0 = *(const LAS f32x4*)(tp), t1 = *(const LAS f32x4*)(tp + 8), t2 = *(const LAS f32x4*)(tp + 16), t3 = *(const LAS f32x4*)(tp + 24);
    return (f32x16){t0[0], t0[1], t0[2], t0[3], t1[0], t1[1], t1[2], t1[3], t2[0], t2[1], t2[2], t2[3], t3[0], t3[1], t3[2], t3[3]};
}
__device__ __forceinline__ float exp_sum16(f32x16& acc) {
    float sa = 0.f, sb = 0.f;
#pragma unroll
    for (int r = 0; r < 16; r += 2) {
        acc[r] = __builtin_amdgcn_exp2f(acc[r]); acc[r + 1] = __builtin_amdgcn_exp2f(acc[r + 1]);
        sa += acc[r]; asm volatile("" : "+v"(sa)); sb += acc[r + 1]; asm volatile("" : "+v"(sb));
    }
    return sa + sb;
}
__device__ __forceinline__ f32x16 splat16(float v) { return (f32x16){v, v, v, v, v, v, v, v, v, v, v, v, v, v, v, v}; }
template <int S0, int S1>
__device__ __forceinline__ void qk_sub(f32x16& acc, const LAS unsigned char* buf, int sub, const bf16x8* qf, int lane) {
    const int key = 32 * sub + (lane & 31), h = lane >> 5;
#pragma unroll
    for (int s = S0; s < S1; ++s) {
        const bf16x8 kf = *(const LAS bf16x8*)(buf + key * 128 + (((2 * s + h) ^ (key & 7)) << 4));
        acc = __builtin_amdgcn_mfma_f32_32x32x16_bf16(kf, qf[s], acc, 0, 0, 0);
    }
}
__device__ __forceinline__ void pack_p(const f32x16& p, bf16x8& pa0, bf16x8& pa1) {
    u32x4 w0, w1;
    w0.x = cvtpk(p[0], p[1]); w0.y = cvtpk(p[2], p[3]); w0.z = cvtpk(p[4], p[5]); w0.w = cvtpk(p[6], p[7]);
    w1.x = cvtpk(p[8], p[9]); w1.y = cvtpk(p[10], p[11]); w1.z = cvtpk(p[12], p[13]); w1.w = cvtpk(p[14], p[15]);
    pa0 = __builtin_bit_cast(bf16x8, w0); pa1 = __builtin_bit_cast(bf16x8, w1);
}
__device__ __forceinline__ void pv_sub(f32x16* o, const LAS unsigned char* buf, int sub, const bf16x8& pa0, const bf16x8& pa1, int lane) {
    const int h = lane >> 5, g16 = (lane >> 4) & 1, q4 = (lane & 15) >> 2, p4 = lane & 3;
    const LAS unsigned char* vb = buf + 8192 + (32 * sub + 4 * h + q4) * 64 + (16 * g16 + 4 * p4) * 2;
#pragma unroll
    for (int dt = 0; dt < 2; ++dt) {
#pragma unroll
        for (int s2 = 0; s2 < 2; ++s2) {
            const v4i16 lo = __builtin_amdgcn_ds_read_tr16_b64_v4i16((LAS v4i16*)(vb + dt * 4096 + s2 * 1024));
            const v4i16 hi = __builtin_amdgcn_ds_read_tr16_b64_v4i16((LAS v4i16*)(vb + dt * 4096 + s2 * 1024 + 512));
            const bf16x8 vf = (bf16x8){lo[0], lo[1], lo[2], lo[3], hi[0], hi[1], hi[2], hi[3]};
            o[dt] = __builtin_amdgcn_mfma_f32_32x32x16_bf16(s2 == 0 ? pa0 : pa1, vf, o[dt], 0, 0, 0);
        }
    }
}

__device__ __forceinline__ void pv_sub2(f32x16* oa, f32x16* ob, const LAS unsigned char* buf, int sub, const bf16x8& a0, const bf16x8& a1, const bf16x8& b0, const bf16x8& b1, int lane) {
    const int h = lane >> 5, g16 = (lane >> 4) & 1, q4 = (lane & 15) >> 2, p4 = lane & 3;
    const LAS unsigned char* vb = buf + 8192 + (32 * sub + 4 * h + q4) * 64 + (16 * g16 + 4 * p4) * 2;
#pragma unroll
    for (int dt = 0; dt < 2; ++dt) {
#pragma unroll
        for (int s2 = 0; s2 < 2; ++s2) {
            const v4i16 lo = __builtin_amdgcn_ds_read_tr16_b64_v4i16((LAS v4i16*)(vb + dt * 4096 + s2 * 1024));
            const v4i16 hi = __builtin_amdgcn_ds_read_tr16_b64_v4i16((LAS v4i16*)(vb + dt * 4096 + s2 * 1024 + 512));
            const bf16x8 vf = (bf16x8){lo[0], lo[1], lo[2], lo[3], hi[0], hi[1], hi[2], hi[3]};
            oa[dt] = __builtin_amdgcn_mfma_f32_32x32x16_bf16(s2 == 0 ? a0 : a1, vf, oa[dt], 0, 0, 0);
            ob[dt] = __builtin_amdgcn_mfma_f32_32x32x16_bf16(s2 == 0 ? b0 : b1, vf, ob[dt], 0, 0, 0);
        }
    }
}

struct BandArgs {
    const bf16_t* Hb;
    int cq, ck, cv;
    int rate, cls, f0, maxd;
    const float* bias;
    float M;
    float sinkterm;
    bf16_t* OA; float* DA;
    bf16_t* Y; int ycol;
    int hd; size_t brow;
};
template <int MODE>
__device__ __forceinline__ void banded_unit(LAS unsigned char* lds, const BandArgs& P) {
    const int tid = opq(threadIdx.x), lane = tid & 63, w = __builtin_amdgcn_readfirstlane(tid >> 6), h = lane >> 5;
    LAS float* sb = (LAS float*)(lds + L_SB);
    LAS float* tbl = (LAS float*)(lds + L_TAB);
    const int KPREV = ((P.maxd + 63) >> 6) << 6, ntl = (KPREV + 256) >> 6;
    const int t0 = (KPREV - P.f0) > 0 ? ((KPREV - P.f0) >> 6) : 0;
    const int srow = tid >> 3, sch = tid & 7;
    StageRegs sr;
    {
        const int kf = P.f0 - KPREV + 64 * t0 + srow;
        const bf16_t* rp = P.Hb + ((size_t)kf * P.rate + P.cls) * HP;
        stage_load(sr, rp + P.ck, rp + P.cv, true, sch);
    }
    const int fq0 = P.f0 + 32 * w;
    bf16x8 qf[4];
    {
        const size_t tq = (size_t)(fq0 + (lane & 31)) * P.rate + P.cls;
        const bf16_t* qp = P.Hb + tq * HP + P.cq + 8 * h;
#pragma unroll
        for (int s = 0; s < 4; ++s) qf[s] = *(const bf16x8*)(qp + 16 * s);
    }
    if (tid < 32) sb[tid] = (P.bias[tid * 16] - P.M) * LOG2E;
    __syncthreads();
    const int DMAXI = P.maxd + 62, TS = P.maxd + 125, TSP = (TS + 7) & ~3;
    for (int e = tid; e < 4 * TSP; e += 512) {
        const int sh = e / TSP, j = e - sh * TSP + sh, dist = DMAXI - j;
        tbl[e] = (j < TS && dist >= 0 && dist <= P.maxd) ? sb[t5_bucket(dist * P.rate)] : -1e30f;
    }
    asm volatile("" : "+v"(qf[0]), "+v"(qf[1]), "+v"(qf[2]), "+v"(qf[3]));
    f32x16 o[2]; o[0] = (f32x16){}; o[1] = (f32x16){};
    float den = 0.f;
    stage_write(lds + L_KV, sr, srow, sch);
    __syncthreads();
    for (int t = t0; t < ntl; ++t) {
        LAS unsigned char* buf = lds + L_KV + ((t - t0) & 1) * KVB;
        const int kf0 = P.f0 - KPREV + 64 * t;
        if (t + 1 < ntl) {
            const int kf = kf0 + 64 + srow;
            const bf16_t* rp = P.Hb + ((size_t)kf * P.rate + P.cls) * HP;
            stage_load(sr, rp + P.ck, rp + P.cv, true, sch);
        }
#pragma unroll
        for (int sub = 0; sub < 2; ++sub) {
            const int kfs = kf0 + 32 * sub;
            if (kfs <= fq0 + 31 && kfs + 31 >= fq0 - P.maxd) {
                const int jb = DMAXI - ((fq0 - kfs) + (lane & 31) - 4 * h);
                f32x16 acc = load_tab16(tbl, TSP, jb);
                qk_sub<0, 4>(acc, buf, sub, qf, lane);
#pragma unroll
                for (int r = 0; r < 1; ++r) den += exp_sum16(acc);
                bf16x8 pa0, pa1; pack_p(acc, pa0, pa1);
                pv_sub(o, buf, sub, pa0, pa1, lane);
            }
        }
        if (t + 1 < ntl) stage_write(lds + L_KV + ((t - t0 + 1) & 1) * KVB, sr, srow, sch);
        __syncthreads();
    }
    float dtot = den + __shfl_xor(den, 32);
    if (MODE == 1) dtot += P.sinkterm;
    LAS float* ws_ = (LAS float*)(lds + L_WSCR) + w * 64;
    if (h == 0) ws_[lane] = dtot;
    if (MODE == 0 && h == 0) {
        const size_t tq = (size_t)(fq0 + lane) * P.rate + P.cls;
        P.DA[(P.brow + tq) * 4 + P.hd] = dtot;
    }
    asm volatile("s_waitcnt lgkmcnt(0)" ::: "memory");
#pragma unroll
    for (int r = 0; r < 16; ++r) {
        const int qi = crow(r, h);
        const float inv = __builtin_amdgcn_rcpf(ws_[qi]);
        const size_t row = P.brow + (size_t)(fq0 + qi) * P.rate + P.cls;
#pragma unroll
        for (int dt = 0; dt < 2; ++dt) {
            const int d = 32 * dt + (lane & 31);
            const float val = o[dt][r] * inv;
            if (MODE == 0) P.OA[row * 256 + P.hd * 64 + d] = f2bf(val);
            else P.Y[row * DM + P.ycol + d] = f2bf(val * bf2f(P.Hb[(row - P.brow) * HP + C_SILU + P.ycol + d]));
        }
    }
}

__device__ __forceinline__ void diff_p1(const LAS float* tp, const LAS unsigned char* buf, int sub, const bf16x8* qf, int lane, bf16x8& pa0, bf16x8& pa1, bf16x8& pb0, bf16x8& pb1) {
    const f32x4 t0 = *(const LAS f32x4*)(tp), t1 = *(const LAS f32x4*)(tp + 8), t2 = *(const LAS f32x4*)(tp + 16), t3 = *(const LAS f32x4*)(tp + 24);
    const f32x16 T = (f32x16){t0[0], t0[1], t0[2], t0[3], t1[0], t1[1], t1[2], t1[3], t2[0], t2[1], t2[2], t2[3], t3[0], t3[1], t3[2], t3[3]};
    const int key = 32 * sub + (lane & 31), h = lane >> 5;
    const LAS unsigned char* kp = buf + key * 128;
    const bf16x8 k0 = *(const LAS bf16x8*)(kp + (((0 + h) ^ (key & 7)) << 4)), k1 = *(const LAS bf16x8*)(kp + (((2 + h) ^ (key & 7)) << 4));
    const bf16x8 k2 = *(const LAS bf16x8*)(kp + (((4 + h) ^ (key & 7)) << 4)), k3 = *(const LAS bf16x8*)(kp + (((6 + h) ^ (key & 7)) << 4));
    f32x16 a1 = __builtin_amdgcn_mfma_f32_32x32x16_bf16(k0, qf[0], T, 0, 0, 0);
    f32x16 a2 = __builtin_amdgcn_mfma_f32_32x32x16_bf16(k2, qf[2], T, 0, 0, 0);
    a1 = __builtin_amdgcn_mfma_f32_32x32x16_bf16(k1, qf[1], a1, 0, 0, 0);
    a2 = __builtin_amdgcn_mfma_f32_32x32x16_bf16(k3, qf[3], a2, 0, 0, 0);
#pragma unroll
    for (int r = 0; r < 16; ++r) { a1[r] = __builtin_amdgcn_exp2f(a1[r]); a2[r] = __builtin_amdgcn_exp2f(a2[r]); }
    pack_p(a1, pa0, pa1); pack_p(a2, pb0, pb1);
}
__device__ __forceinline__ void diff_p2(const LAS unsigned char* buf, int sub, int lane, const bf16x8& pa0, const bf16x8& pa1, const bf16x8& pb0, const bf16x8& pb1, f32x16& dn1, f32x16& dn2, f32x16* o1, f32x16* o2) {
    const bf16x8 ones = (bf16x8){0x3F80, 0x3F80, 0x3F80, 0x3F80, 0x3F80, 0x3F80, 0x3F80, 0x3F80};
    dn1 = __builtin_amdgcn_mfma_f32_32x32x16_bf16(pa0, ones, dn1, 0, 0, 0);
    dn2 = __builtin_amdgcn_mfma_f32_32x32x16_bf16(pb0, ones, dn2, 0, 0, 0);
    dn1 = __builtin_amdgcn_mfma_f32_32x32x16_bf16(pa1, ones, dn1, 0, 0, 0);
    dn2 = __builtin_amdgcn_mfma_f32_32x32x16_bf16(pb1, ones, dn2, 0, 0, 0);
    pv_sub2(o1, o2, buf, sub, pa0, pa1, pb0, pb1, lane);
}

struct DiffArgs {
    const bf16_t* Hb; int hd, qb; size_t brow;
    const float* bias; float M; float lam, lambda_init; const float* subln;
    bf16_t* Y;
};
constexpr int D_SB = 49152, D_TAB = 49664;
__device__ __forceinline__ void diff_unit(LAS unsigned char* lds, const DiffArgs& P) {
    const int tid = opq(threadIdx.x), lane = tid & 63, w = __builtin_amdgcn_readfirstlane(tid >> 6), h = lane >> 5;
    LAS float* sb = (LAS float*)(lds + D_SB);
    LAS float* tbl = (LAS float*)(lds + D_TAB);
    constexpr int DTOP = 1574, TS = DTOP + 63, TSP = (TS + 7) & ~3;
    __syncthreads();
    if (tid < 32) sb[tid] = (P.bias[tid * 16] - P.M) * LOG2E;
    __syncthreads();
    for (int e = tid; e < 4 * TSP; e += 512) {
        const int sh = e / TSP, j = e - sh * TSP + sh, dist = DTOP - j;
        tbl[e] = (j < TS && dist >= 0) ? sb[t5_bucket(dist)] : -1e30f;
    }
    LAS float* farc = tbl + 4 * TSP;
    LAS float* deadr = farc + 32;
    if (tid < 32) { farc[tid] = sb[31]; deadr[tid] = -1e30f; }
    const int q0w = P.qb * 256 + 32 * w;
    const int cq = C_CQ + 64 * P.hd, ck = C_CK + 64 * P.hd, cv = C_CV + 64 * P.hd;
    bf16x8 qf[4];
    {
        const bf16_t* qp = P.Hb + (size_t)(q0w + (lane & 31)) * HP + cq + 8 * h;
#pragma unroll
        for (int s = 0; s < 4; ++s) qf[s] = *(const bf16x8*)(qp + 16 * s);
        asm volatile("" : "+v"(qf[0]), "+v"(qf[1]), "+v"(qf[2]), "+v"(qf[3]));
    }
    const int ntl = 4 * (P.qb + 1);
    const int srow = tid >> 3, sch = tid & 7;
    f32x16 o1[2], o2[2]; o1[0] = (f32x16){}; o1[1] = (f32x16){}; o2[0] = (f32x16){}; o2[1] = (f32x16){};
    f32x16 dn1 = (f32x16){}, dn2 = (f32x16){};
    StageRegs sr;
    {
        const bf16_t* rp = P.Hb + (size_t)srow * HP;
        stage_load(sr, rp + ck, rp + cv, true, sch);
        stage_write(lds, sr, srow, sch);
    }
    __syncthreads();
#define DIFF_TP(KS) ({ const int ks_ = (KS); const int jb_ = DTOP - ((q0w - ks_) + (lane & 31) - 4 * h), sh_ = jb_ & 3; \
        const LAS float* tp_ = tbl + sh_ * TSP + (jb_ - sh_); tp_ = (q0w - ks_ - 31 >= 1513) ? farc : tp_; tp_ = (ks_ > q0w + 31) ? deadr : tp_; tp_; })
#define DIFF_STAGE_LOAD(t) do { const int tn_ = (t) + 1 < ntl ? (t) + 1 : (t); const bf16_t* rp_ = P.Hb + (size_t)(64 * tn_ + srow) * HP; stage_load(sr, rp_ + ck, rp_ + cv, true, sch); } while (0)
    if (w < 4) {
        int cur = 0;
        for (int t = 0; t < ntl; ++t) {
            LAS unsigned char* buf = lds + cur * KVB;
            const int nxt = cur == 2 ? 0 : cur + 1;
            DIFF_STAGE_LOAD(t);
            bf16x8 pa0, pa1, pb0, pb1;
            diff_p1(DIFF_TP(64 * t), buf, 0, qf, lane, pa0, pa1, pb0, pb1);
            diff_p2(buf, 0, lane, pa0, pa1, pb0, pb1, dn1, dn2, o1, o2);
            diff_p1(DIFF_TP(64 * t + 32), buf, 1, qf, lane, pa0, pa1, pb0, pb1);
            diff_p2(buf, 1, lane, pa0, pa1, pb0, pb1, dn1, dn2, o1, o2);
            stage_write(lds + nxt * KVB, sr, srow, sch);
            __syncthreads();
            cur = nxt;
        }
    } else {
        const bf16x8 zero8 = (bf16x8){0, 0, 0, 0, 0, 0, 0, 0};
        bf16x8 qa0 = zero8, qa1 = zero8, qb0 = zero8, qb1 = zero8;
        int cur = 0, prv = 0;
        __builtin_amdgcn_s_setprio(1);
        for (int t = 0; t < ntl; ++t) {
            LAS unsigned char* buf = lds + cur * KVB;
            const int nxt = cur == 2 ? 0 : cur + 1;
            DIFF_STAGE_LOAD(t);
            diff_p2(lds + prv * KVB, 1, lane, qa0, qa1, qb0, qb1, dn1, dn2, o1, o2);
            bf16x8 pa0, pa1, pb0, pb1;
            diff_p1(DIFF_TP(64 * t), buf, 0, qf, lane, pa0, pa1, pb0, pb1);
            diff_p2(buf, 0, lane, pa0, pa1, pb0, pb1, dn1, dn2, o1, o2);
            diff_p1(DIFF_TP(64 * t + 32), buf, 1, qf, lane, qa0, qa1, qb0, qb1);
            stage_write(lds + nxt * KVB, sr, srow, sch);
            __syncthreads();
            prv = cur; cur = nxt;
        }
        diff_p2(lds + prv * KVB, 1, lane, qa0, qa1, qb0, qb1, dn1, dn2, o1, o2);
        __builtin_amdgcn_s_setprio(0);
    }
    __syncthreads();
#undef DIFF_TP
#undef DIFF_STAGE_LOAD
    const float g0 = P.subln[lane & 31] * (1.f - P.lambda_init), g1 = P.subln[32 + (lane & 31)] * (1.f - P.lambda_init);
    const int ycol = 512 + 64 * P.hd;
#pragma unroll
    for (int r = 0; r < 16; ++r) {
        const int qi = crow(r, h);
        const float i1 = __builtin_amdgcn_rcpf(dn1[r]), i2 = P.lam * __builtin_amdgcn_rcpf(dn2[r]);
        const float a0 = o1[0][r] * i1 - o2[0][r] * i2, a1 = o1[1][r] * i1 - o2[1][r] * i2;
        float ss = a0 * a0 + a1 * a1;
        ss += __shfl_xor(ss, 1); ss += __shfl_xor(ss, 2); ss += __shfl_xor(ss, 4); ss += __shfl_xor(ss, 8); ss += __shfl_xor(ss, 16);
        const float rs = rsqrtf(ss * (1.f / 64.f) + 1e-6f);
        const size_t trow = (size_t)(q0w + qi);
        const bf16_t* sp = P.Hb + trow * HP + C_SILU + ycol;
        bf16_t* yp = P.Y + (P.brow + trow) * DM + ycol;
        yp[lane & 31] = f2bf(a0 * rs * g0 * bf2f(sp[lane & 31]));
        yp[32 + (lane & 31)] = f2bf(a1 * rs * g1 * bf2f(sp[32 + (lane & 31)]));
    }
}
struct CmpArgs {
    const bf16_t* Hb;
    int col;
    int rt;
    const float* pos;
    const bf16_t* W1T;
    const float* b1;
    const bf16_t* W2T;
    const float* b2;
    const float* gain;
    bf16_t* OUT;
};
__device__ __forceinline__ void cmp_unit(LAS unsigned char* lds, const CmpArgs& P) {
    const int tid = opq(threadIdx.x), lane = tid & 63, w = __builtin_amdgcn_readfirstlane(tid >> 6), h = lane >> 5;
    LAS unsigned char* hidl = lds + L_KV;
    LAS float* ssx = (LAS float*)(lds + L_KV + 32768 - 512);
    LAS unsigned char* abuf = lds + L_TAB;
    f32x16 acc = (f32x16){};
    const bf16_t* w1p = P.W1T + (size_t)w * (8 * 16 * 64 * 8) + lane * 8;
    u32x4 araw[2]; f32x4 apos[2][2];
#define CMP_ALOAD(ch) do { _Pragma("unroll") for (int q_ = 0; q_ < 2; ++q_) { const int p_ = tid + 512 * q_, row_ = p_ >> 5, kc_ = p_ & 31; \
        int ir_ = 32 * P.rt + row_; if (ir_ > 510) ir_ = 510; const int tok_ = 4 * (ch) + (kc_ >> 3), d_ = 8 * (kc_ & 7); \
        araw[q_] = *(const u32x4*)(P.Hb + (size_t)(16 * ir_ + tok_) * HP + P.col + d_); \
        apos[q_][0] = *(const f32x4*)(P.pos + tok_ * 64 + d_); apos[q_][1] = *(const f32x4*)(P.pos + tok_ * 64 + d_ + 4); } } while (0)
#define CMP_AWRITE(bufi) do { _Pragma("unroll") for (int q_ = 0; q_ < 2; ++q_) { const int p_ = tid + 512 * q_, row_ = p_ >> 5, kc_ = p_ & 31; u32x4 aw_; \
        aw_.x = cvtpk(__uint_as_float(araw[q_].x << 16) + apos[q_][0][0], __uint_as_float(araw[q_].x & 0xffff0000u) + apos[q_][0][1]); \
        aw_.y = cvtpk(__uint_as_float(araw[q_].y << 16) + apos[q_][0][2], __uint_as_float(araw[q_].y & 0xffff0000u) + apos[q_][0][3]); \
        aw_.z = cvtpk(__uint_as_float(araw[q_].z << 16) + apos[q_][1][0], __uint_as_float(araw[q_].z & 0xffff0000u) + apos[q_][1][1]); \
        aw_.w = cvtpk(__uint_as_float(araw[q_].w << 16) + apos[q_][1][2], __uint_as_float(araw[q_].w & 0xffff0000u) + apos[q_][1][3]); \
        *(LAS u32x4*)(abuf + (bufi) * 16896 + row_ * 528 + kc_ * 16) = aw_; } } while (0)
    CMP_ALOAD(0); CMP_AWRITE(0);
    __syncthreads();
    for (int ch = 0; ch < 8; ++ch) {
        const int cn = ch + 1 < 8 ? ch + 1 : ch;
        CMP_ALOAD(cn);
        const LAS unsigned char* ab = abuf + (ch & 1) * 16896 + (lane & 31) * 528 + 16 * h;
        bf16x8 bfr[16];
#pragma unroll
        for (int ks = 0; ks < 16; ++ks) bfr[ks] = *(const bf16x8*)(w1p + (ch * 16 + ks) * 512);
#pragma unroll
        for (int ks = 0; ks < 16; ++ks) {
            const bf16x8 af = *(const LAS bf16x8*)(ab + 32 * ks);
            acc = __builtin_amdgcn_mfma_f32_32x32x16_bf16(af, bfr[ks], acc, 0, 0, 0);
        }
        CMP_AWRITE((ch + 1) & 1);
        __syncthreads();
    }
#undef CMP_ALOAD
#undef CMP_AWRITE
    {
        const int j = 32 * w + (lane & 31); const float bb = P.b1[j];
#pragma unroll
        for (int r = 0; r < 16; ++r) {
            const float x = acc[r] + bb;
            const float u = 0.7978845608028654f * (x + 0.044715f * x * x * x);
            const float th = 1.f - 2.f / (1.f + __expf(2.f * u));
            const float gl = 0.5f * x * (1.f + th);
            *(LAS bf16_t*)(hidl + crow(r, h) * 528 + j * 2) = f2bf(gl);
        }
    }
    __syncthreads();
    float outv[16]; float ssp[16];
    if (w < 2) {
        f32x16 a2 = (f32x16){};
        const bf16_t* w2p = P.W2T + (size_t)(32 * w + (lane & 31)) * 256 + 8 * h;
#pragma unroll
        for (int ks = 0; ks < 16; ++ks) {
            const bf16x8 af = *(const LAS bf16x8*)(hidl + (lane & 31) * 528 + (16 * ks + 8 * h) * 2);
            const bf16x8 bfr = *(const bf16x8*)(w2p + 16 * ks);
            a2 = __builtin_amdgcn_mfma_f32_32x32x16_bf16(af, bfr, a2, 0, 0, 0);
        }
        const float bb = P.b2[32 * w + (lane & 31)];
#pragma unroll
        for (int r = 0; r < 16; ++r) {
            outv[r] = a2[r] + bb;
            float ss = outv[r] * outv[r];
            ss += __shfl_xor(ss, 1); ss += __shfl_xor(ss, 2); ss += __shfl_xor(ss, 4); ss += __shfl_xor(ss, 8); ss += __shfl_xor(ss, 16);
            ssp[r] = ss;
            if ((lane & 31) == 0) ssx[w * 32 + crow(r, h)] = ss;
        }
    }
    __syncthreads();
    if (w < 2) {
        const int d = 32 * w + (lane & 31);
        const float gn = P.gain ? P.gain[d] : 1.f;
#pragma unroll
        for (int r = 0; r < 16; ++r) {
            const int row = 32 * P.rt + crow(r, h);
            float v = outv[r];
            if (P.gain) { const float tot = ssx[crow(r, h)] + ssx[32 + crow(r, h)]; v = v * rsqrtf(tot * (1.f / 64.f) + 1e-6f) * gn; }
            if (row <= 510) P.OUT[(size_t)row * 64 + d] = f2bf(v);
        }
    }
    __syncthreads();
}

struct NsaArgs {
    const bf16_t* Hb; size_t brow; int qb;
    const bf16_t* KC; const bf16_t* VC;
    const float* bias;
    const float* Mv;
    bf16_t* Y; unsigned* cdone;
};
constexpr int GTOP = 2015, GTS = 2519, WTOP = 549, WTS = 588, DEAD = 4 * GTS + 4 * WTS;
__device__ __forceinline__ void nsa_unit(LAS unsigned char* lds, const NsaArgs& P) {
    const int tid = opq(threadIdx.x), lane = tid & 63, w = __builtin_amdgcn_readfirstlane(tid >> 6), hh = lane >> 5;
    const int n = lane & 31, q8 = n >> 2, hd = n & 3;
    LAS float* tg = (LAS float*)(lds + L_TAB);
    LAS float* tw = tg + 4 * GTS;
    LAS float* dead = tg + DEAD;
    LAS float* impw = (LAS float*)(lds + L_IMP) + w * 1024;
    LAS unsigned* selw = (LAS unsigned*)(lds + L_SEL) + w * 32;
    LAS unsigned* uni = (LAS unsigned*)(lds + L_SEL) + 256;
    LAS float* ws_ = (LAS float*)(lds + L_WSCR) + w * 256;
    LAS float* sbh = (LAS float*)(lds + L_SB);
    if (tid < 128) sbh[tid] = (P.bias[(tid & 31) * 16 + (tid >> 5)] - P.Mv[tid >> 5]) * LOG2E;
    __syncthreads();
    for (int e = tid; e < 4 * GTS; e += 512) { const int hq = e / GTS, j = e % GTS, dist = GTOP - j;
        tg[e] = dist >= 0 ? sbh[hq * 32 + t5_bucket(dist)] : -1e30f; }
    for (int e = tid; e < 4 * WTS; e += 512) { const int hq = e / WTS, j = e % WTS, dist = WTOP - j;
        tw[e] = (dist >= 0 && dist <= 511) ? sbh[hq * 32 + t5_bucket(dist)] : -1e30f; }
    if (tid < 64) dead[tid] = -1e30f;
    for (int e = lane; e < 1024; e += 64) impw[e] = 0.f;
    if (tid < 4) uni[tid] = 0u;
    const float cfar = sbh[hd * 32 + 31];
    const int tq = 64 * P.qb + 8 * w + q8;
    const int twmin = 64 * P.qb + 8 * w, twmax = twmin + 7;
    bf16x8 qf[4];
    {
        const bf16_t* qp = P.Hb + (size_t)tq * HP + C_DQ + 64 * hd + 8 * hh;
#pragma unroll
        for (int s = 0; s < 4; ++s) qf[s] = *(const bf16x8*)(qp + 16 * s);
        asm volatile("" : "+v"(qf[0]), "+v"(qf[1]), "+v"(qf[2]), "+v"(qf[3]));
    }
    {
        const bf16_t* gp = P.Hb + (size_t)tq * HP + C_GT + 3 * hd;
        if (hh == 0) { ws_[n] = bf2f(gp[0]); ws_[32 + n] = bf2f(gp[1]); ws_[64 + n] = bf2f(gp[2]); }
    }
    const int srow = tid >> 3, sch = tid & 7;
    StageRegs sr;
    f32x16 o[2], outv[2];
    float den = 0.f;
    o[0] = (f32x16){}; o[1] = (f32x16){};
    {
        const int kt0 = P.qb >= 8 ? P.qb - 8 : 0, nkt = P.qb - kt0 + 1;
        {
            const bf16_t* rp = P.Hb + (size_t)(64 * kt0 + srow) * HP;
            stage_load(sr, rp + C_KW, rp + C_VW, true, sch);
            stage_write(lds + L_KV, sr, srow, sch);
        }
        __syncthreads();
        for (int t = 0; t < nkt; ++t) {
            LAS unsigned char* buf = lds + L_KV + (t & 1) * KVB;
            if (t + 1 < nkt) { const bf16_t* rp = P.Hb + (size_t)(64 * (kt0 + t + 1) + srow) * HP; stage_load(sr, rp + C_KW, rp + C_VW, true, sch); }
#pragma unroll
            for (int sub = 0; sub < 2; ++sub) {
                const int kb = 64 * (kt0 + t) + 32 * sub;
                if (kb <= twmax && kb + 31 >= twmin - 511) {
                    f32x16 acc;
                    const LAS float* tb = tw + hd * WTS + (WTOP - (tq - kb - 4 * hh));
#pragma unroll
                    for (int r = 0; r < 16; ++r) acc[r] = tb[(r & 3) + 8 * (r >> 2)];
                    qk_sub<0, 4>(acc, buf, sub, qf, lane);
#pragma unroll
                    for (int r = 0; r < 1; ++r) den += exp_sum16(acc);
                    bf16x8 pa0, pa1; pack_p(acc, pa0, pa1);
                    pv_sub(o, buf, sub, pa0, pa1, lane);
                }
            }
            if (t + 1 < nkt) stage_write(lds + L_KV + ((t + 1) & 1) * KVB, sr, srow, sch);
            __syncthreads();
        }
    }
    {
        const float dt = den + __shfl_xor(den, 32);
        if (hh == 0) ws_[128 + n] = __builtin_amdgcn_rcpf(dt);
        asm volatile("s_waitcnt lgkmcnt(0)" ::: "memory");
#pragma unroll
        for (int r = 0; r < 16; ++r) { const int nn = crow(r, hh); const float gi = ws_[64 + nn] * ws_[128 + nn]; outv[0][r] = o[0][r] * gi; outv[1][r] = o[1][r] * gi; }
    }
    if (opq(threadIdx.x) == 128) {
        unsigned sp = 0;
        while (__hip_atomic_load(P.cdone, __ATOMIC_RELAXED, __HIP_MEMORY_SCOPE_AGENT) < 64u) { __builtin_amdgcn_s_sleep(2); if (++sp > (1u << 24)) break; }
        __builtin_amdgcn_fence(__ATOMIC_ACQUIRE, "agent"); asm volatile("s_waitcnt vmcnt(0)" ::: "memory");
    }
    __syncthreads();
    const int tlast = 64 * P.qb + 63;
    const int ntc = tlast >= 31 ? (((tlast - 31) >> 4) >> 6) + 1 : 0;
    float invden = 0.f; den = 0.f;
    o[0] = (f32x16){}; o[1] = (f32x16){};
    for (int pass = 0; pass < 2; ++pass) {
        if (ntc > 0) {
            __syncthreads();
            stage_load(sr, P.KC + (size_t)srow * 64, P.VC + (size_t)srow * 64, true, sch);
            stage_write(lds + L_KV, sr, srow, sch);
            __syncthreads();
            for (int t = 0; t < ntc; ++t) {
                LAS unsigned char* buf = lds + L_KV + (t & 1) * KVB;
                if (t + 1 < ntc) stage_load(sr, P.KC + (size_t)(64 * (t + 1) + srow) * 64, P.VC + (size_t)(64 * (t + 1) + srow) * 64, true, sch);
#pragma unroll
                for (int sub = 0; sub < 2; ++sub) {
                    const int cb = 64 * t + 32 * sub;
                    if (16 * cb + 31 <= twmax) {
                        f32x16 acc;
                        const int dmin = twmin - 16 * (cb + 31) - 31;
                        if (dmin >= 1513) acc = splat16(cfar);
                        else {
                            const LAS float* tb = tg + hd * GTS + (GTOP - (tq - 31 - 16 * cb - 64 * hh));
#pragma unroll
                            for (int r = 0; r < 16; ++r) acc[r] = tb[16 * ((r & 3) + 8 * (r >> 2))];
                        }
                        qk_sub<0, 4>(acc, buf, sub, qf, lane);
#pragma unroll
                        for (int r = 0; r < 16; ++r) acc[r] = __builtin_amdgcn_exp2f(acc[r]);
                        if (pass == 0) {
#pragma unroll
                            for (int r = 0; r < 16; ++r) { den += acc[r]; asm volatile("" : "+v"(den)); }
                        } else {
#pragma unroll
                            for (int r = 0; r < 16; ++r) acc[r] *= invden;
#pragma unroll
                            for (int g = 0; g < 4; ++g) {
                                float G = (acc[4 * g] + acc[4 * g + 1]) + (acc[4 * g + 2] + acc[4 * g + 3]), C = acc[4 * g + 3];
                                G += __shfl_xor(G, 1); G += __shfl_xor(G, 2); C += __shfl_xor(C, 1); C += __shfl_xor(C, 2);
                                if (hd == 0) {
                                    const int j = (cb >> 2) + 2 * g + hh;
                                    __hip_atomic_fetch_add(impw + q8 * 128 + j, G, __ATOMIC_RELAXED, __HIP_MEMORY_SCOPE_WORKGROUP);
                                    if (j + 1 < 128) __hip_atomic_fetch_add(impw + q8 * 128 + j + 1, C, __ATOMIC_RELAXED, __HIP_MEMORY_SCOPE_WORKGROUP);
                                }
                            }
                            bf16x8 pa0, pa1; pack_p(acc, pa0, pa1);
                            pv_sub(o, buf, sub, pa0, pa1, lane);
                        }
                    }
                }
                if (t + 1 < ntc) stage_write(lds + L_KV + ((t + 1) & 1) * KVB, sr, srow, sch);
                __syncthreads();
            }
        }
        if (pass == 0) { const float dt = den + __shfl_xor(den, 32); invden = dt > 0.f ? 1.f / dt : 0.f; }
    }
    asm volatile("s_waitcnt lgkmcnt(0)" ::: "memory");
#pragma unroll
    for (int r = 0; r < 16; ++r) { const float g0 = ws_[crow(r, hh)]; outv[0][r] += o[0][r] * g0; outv[1][r] += o[1][r] * g0; }
    {
        const int qsel = lane >> 3, sb = lane & 7;
        unsigned key[16];
#pragma unroll
        for (int i4 = 0; i4 < 4; ++i4) {
            const f32x4 v = *(const LAS f32x4*)(impw + qsel * 128 + sb * 16 + 4 * i4);
#pragma unroll
            for (int e = 0; e < 4; ++e) {
                const int j = sb * 16 + 4 * i4 + e;
                const bool forced = (j == 0) | (j == P.qb) | (j == P.qb - 1);
                key[4 * i4 + e] = forced ? 0xFFFFFFFFu : (j <= P.qb ? __float_as_uint(v[e]) + 1u : 0u);
            }
        }
        unsigned T = 0u;
        for (int bit = 31; bit >= 0; --bit) {
            const unsigned cand = T | (1u << bit);
            int cnt = 0;
#pragma unroll
            for (int i = 0; i < 16; ++i) cnt += key[i] >= cand ? 1 : 0;
            cnt += __shfl_xor(cnt, 1); cnt += __shfl_xor(cnt, 2); cnt += __shfl_xor(cnt, 4);
            if (cnt >= 16) T = cand;
        }
        int cgt = 0, ceq = 0;
#pragma unroll
        for (int i = 0; i < 16; ++i) { cgt += key[i] > T ? 1 : 0; ceq += key[i] == T ? 1 : 0; }
        int cg = cgt; cg += __shfl_xor(cg, 1); cg += __shfl_xor(cg, 2); cg += __shfl_xor(cg, 4);
        int pre = 0;
#pragma unroll
        for (int k = 0; k < 8; ++k) { const int v = __shfl(ceq, (lane & ~7) + k); if (k < sb) pre += v; }
        int need = 16 - cg - pre;
        unsigned bits = 0u;
#pragma unroll
        for (int i = 0; i < 16; ++i) {
            const int j = sb * 16 + i;
            bool s_ = key[i] > T;
            if (key[i] == T) { if (need > 0) { s_ = true; } --need; }
            if (s_ && j <= P.qb) bits |= 1u << i;
        }
        const unsigned other = __shfl_xor(bits, 1);
        const unsigned word = (sb & 1) ? ((bits << 16) | other) : (bits | (other << 16));
        if ((sb & 1) == 0) { selw[qsel * 4 + (sb >> 1)] = word; __hip_atomic_fetch_or(uni + (sb >> 1), word, __ATOMIC_RELAXED, __HIP_MEMORY_SCOPE_WORKGROUP); }
    }
    __syncthreads();
    unsigned lm0 = selw[q8 * 4 + 0], lm1 = selw[q8 * 4 + 1], lm2 = selw[q8 * 4 + 2], lm3 = selw[q8 * 4 + 3];
    unsigned wm0 = 0, wm1 = 0, wm2 = 0, wm3 = 0;
#pragma unroll
    for (int k = 0; k < 8; ++k) { wm0 |= selw[k * 4 + 0]; wm1 |= selw[k * 4 + 1]; wm2 |= selw[k * 4 + 2]; wm3 |= selw[k * 4 + 3]; }
    wm0 = __builtin_amdgcn_readfirstlane(wm0); wm1 = __builtin_amdgcn_readfirstlane(wm1); wm2 = __builtin_amdgcn_readfirstlane(wm2); wm3 = __builtin_amdgcn_readfirstlane(wm3);
    const unsigned um0 = __builtin_amdgcn_readfirstlane(uni[0]), um1 = __builtin_amdgcn_readfirstlane(uni[1]), um2 = __builtin_amdgcn_readfirstlane(uni[2]), um3 = __builtin_amdgcn_readfirstlane(uni[3]);
#define NSA_WORD(a0, a1, a2, a3, j) ((j) < 32 ? (a0) : ((j) < 64 ? (a1) : ((j) < 96 ? (a2) : (a3))))
#define NSA_NEXT(j, res) do { int _j = (j); res = 128; while (_j < 128) { const unsigned _w = NSA_WORD(um0, um1, um2, um3, _j) >> (_j & 31); if (_w) { res = _j + __builtin_ctz(_w); break; } _j = (_j | 31) + 1; } } while (0)
    o[0] = (f32x16){}; o[1] = (f32x16){}; den = 0.f;
#define NSA_SLC_COMPUTE(JJ, BUF) do { \
        if ((NSA_WORD(wm0, wm1, wm2, wm3, (JJ)) >> ((JJ) & 31)) & 1u) { \
            const bool lsel = (NSA_WORD(lm0, lm1, lm2, lm3, (JJ)) >> ((JJ) & 31)) & 1u; \
            _Pragma("unroll") for (int sub = 0; sub < 2; ++sub) { \
                const int kb = 64 * (JJ) + 32 * sub; \
                if (kb <= twmax) { \
                    f32x16 acc; \
                    if (twmin - kb - 31 >= 1513) acc = splat16(lsel ? cfar : -1e30f); \
                    else { const LAS float* tb = lsel ? tg + hd * GTS + (GTOP - (tq - kb - 4 * hh)) : dead; \
                        _Pragma("unroll") for (int r = 0; r < 16; ++r) acc[r] = tb[(r & 3) + 8 * (r >> 2)]; } \
                    qk_sub<0, 4>(acc, (BUF), sub, qf, lane); \
                    den += exp_sum16(acc); \
                    bf16x8 pa0, pa1; pack_p(acc, pa0, pa1); \
                    pv_sub(o, (BUF), sub, pa0, pa1, lane); \
                } } } } while (0)
#define NSA_SLC_LOAD(JJ, SR) do { const bf16_t* rp_ = P.Hb + (size_t)(64 * (JJ) + srow) * HP; stage_load(SR, rp_ + C_KS, rp_ + C_VS, true, sch); } while (0)
    {
        StageRegs srB;
        LAS unsigned char* pb0 = lds + L_KV; LAS unsigned char* pb1 = lds + L_IMP;
        int ja, jb2; NSA_NEXT(0, ja); jb2 = 128; if (ja < 128) { NSA_NEXT(ja + 1, jb2); }
        if (ja < 128) { NSA_SLC_LOAD(ja, sr); stage_write(pb0, sr, srow, sch); }
        if (jb2 < 128) { NSA_SLC_LOAD(jb2, srB); stage_write(pb0 + KVB, srB, srow, sch); }
        __syncthreads();
        int p = 0;
        while (ja < 128) {
            LAS unsigned char* cb = p ? pb1 : pb0; LAS unsigned char* nbuf = p ? pb0 : pb1;
            int na = 128, nb = 128;
            if (jb2 < 128) { NSA_NEXT(jb2 + 1, na); }
            if (na < 128) { NSA_NEXT(na + 1, nb); }
            if (na < 128) NSA_SLC_LOAD(na, sr);
            if (nb < 128) NSA_SLC_LOAD(nb, srB);
            NSA_SLC_COMPUTE(ja, cb);
            if (jb2 < 128) NSA_SLC_COMPUTE(jb2, cb + KVB);
            if (na < 128) stage_write(nbuf, sr, srow, sch);
            if (nb < 128) stage_write(nbuf + KVB, srB, srow, sch);
            __syncthreads();
            ja = na; jb2 = nb; p ^= 1;
        }
    }
#undef NSA_SLC_COMPUTE
#undef NSA_SLC_LOAD
    {
        const float dt = den + __shfl_xor(den, 32);
        if (hh == 0) ws_[96 + n] = 1.f / dt;
        asm volatile("s_waitcnt lgkmcnt(0)" ::: "memory");
#pragma unroll
        for (int r = 0; r < 16; ++r) { const float gi = ws_[32 + crow(r, hh)] * ws_[96 + crow(r, hh)]; outv[0][r] += o[0][r] * gi; outv[1][r] += o[1][r] * gi; }
    }
    {
#pragma unroll
        for (int r = 0; r < 16; ++r) {
            const int nn = crow(r, hh);
            const size_t trow = (size_t)(64 * P.qb + 8 * w + (nn >> 2));
            const int ycol = 768 + 64 * (nn & 3);
            const bf16_t* sp = P.Hb + trow * HP + C_SILU + ycol;
            bf16_t* yp = P.Y + (P.brow + trow) * DM + ycol;
            yp[n] = f2bf(outv[0][r] * bf2f(sp[n]));
            yp[32 + n] = f2bf(outv[1][r] * bf2f(sp[32 + n]));
        }
    }
    __syncthreads();
#undef NSA_WORD
#undef NSA_NEXT
}
}

#define XB_TMO      128
#define XB_XCNT(j)  (256  + 64 * (j))
#define XB_XSUB(j)  (1280 + 64 * (j))
#define XB_XGEN(j)  (2304 + 64 * (j))
#define XB_TOP      3328
#define XB_TOPGEN   3392
#define XCD_BAR_WORDS 3456
#define XB_SPIN_CAP (1u << 22)
__device__ __forceinline__ unsigned xb_ld(unsigned* p)              { return __hip_atomic_load(p, __ATOMIC_RELAXED, __HIP_MEMORY_SCOPE_AGENT); }
__device__ __forceinline__ unsigned xb_add(unsigned* p, unsigned v) { return __hip_atomic_fetch_add(p, v, __ATOMIC_RELAXED, __HIP_MEMORY_SCOPE_AGENT); }
__device__ __forceinline__ unsigned xb_xcc_id() { return (unsigned)__builtin_amdgcn_s_getreg((3 << 11) | 20) & 0xFu; }
#define XB_SPIN(cond, bar) do { unsigned _sp = 0; while (cond) { __builtin_amdgcn_s_sleep(1); \
    if ((++_sp & 255u) == 0u) { if (xb_ld(&(bar)[XB_TMO])) break; if (_sp > XB_SPIN_CAP) { atomicAdd(&(bar)[XB_TMO], 1u); break; } } } } while (0)
struct XcdBarrier { unsigned* bar; unsigned x; volatile LAS unsigned* st; };
__device__ __forceinline__ XcdBarrier xcd_barrier_post(unsigned* bar, volatile LAS unsigned* st) {
    XcdBarrier b; b.bar = bar; b.x = xb_xcc_id(); b.st = st;
    if (threadIdx.x == 0) (void)xb_add(&bar[XB_XCNT(b.x)], 1u);
    return b;
}
__device__ __forceinline__ void xcd_barrier_complete(unsigned* bar, unsigned x, unsigned& nloc, unsigned& nx) {
    const unsigned G = gridDim.x * gridDim.y * gridDim.z;
    unsigned sum, cnt, mine, sp = 0u;
    for (;;) {
        sum = 0u; cnt = 0u; mine = 0u;
#pragma unroll
        for (unsigned j = 0; j < 16; ++j) { const unsigned c = xb_ld(&bar[XB_XCNT(j)]); sum += c; cnt += (c > 0u) ? 1u : 0u; mine = (j == x) ? c : mine; }
        if (sum == G) break;
        __builtin_amdgcn_s_sleep(1);
        if ((++sp & 255u) == 0u) { if (xb_ld(&bar[XB_TMO])) break; if (sp > XB_SPIN_CAP) { atomicAdd(&bar[XB_TMO], 1u); break; } }
    }
    nloc = mine > 0u ? mine : 1u; nx = cnt > 0u ? cnt : 1u;
}
__device__ __forceinline__ void xcd_barrier(const XcdBarrier& b) {
    asm volatile("s_waitcnt vmcnt(0)" ::: "memory");
    __syncthreads();
    if (threadIdx.x == 0) {
        unsigned* bar = b.bar;
        __builtin_amdgcn_s_waitcnt(0);
        unsigned nloc = b.st[0], nx = b.st[1];
        if (nloc == 0u) { xcd_barrier_complete(bar, b.x, nloc, nx); b.st[0] = nloc; b.st[1] = nx; }
        const unsigned old = xb_add(&bar[XB_XSUB(b.x)], 1u);
        const unsigned gen = old / nloc;
        if (old + 1u == (gen + 1u) * nloc) {
            __builtin_amdgcn_fence(__ATOMIC_RELEASE, "agent");
            asm volatile("s_waitcnt vmcnt(0)" ::: "memory");
            const unsigned og = xb_add(&bar[XB_TOP], 1u);
            const unsigned tg = og / nx;
            if (og + 1u == (tg + 1u) * nx) xb_add(&bar[XB_TOPGEN], 1u);
            else XB_SPIN(xb_ld(&bar[XB_TOPGEN]) == tg, bar);
            __builtin_amdgcn_fence(__ATOMIC_ACQUIRE, "agent");
            xb_add(&bar[XB_XGEN(b.x)], 1u);
            asm volatile("s_waitcnt vmcnt(0)" ::: "memory");
        } else {
            XB_SPIN(xb_ld(&bar[XB_XGEN(b.x)]) == gen, bar);
            __builtin_amdgcn_fence(__ATOMIC_ACQUIRE, "agent");
            asm volatile("s_waitcnt vmcnt(0)" ::: "memory");
        }
    }
    __syncthreads();
}

constexpr int NT = 512, LDS_BYTES = 147456, MISC_OFF = 131072 + 320;
#ifndef R_C
#define R_C 1
#endif
#ifndef R_D
#define R_D 1
#endif
#ifndef R_AB
#define R_AB 1
#endif
#ifndef R_G1
#define R_G1 1
#endif
constexpr size_t MiB = 1u << 20;
constexpr size_t WS_CTL = 0, CTL_ZERO_BYTES = 65536;
constexpr size_t WS_H = 2 * MiB, WS_XN = 124 * MiB, WS_T0 = 158 * MiB, WS_IMP = 208 * MiB, WS_SEL = 217 * MiB, WS_HID = 218 * MiB, WS_KC = 221 * MiB, WS_VC = 222 * MiB, WS_WIN = 224 * MiB, WS_WOUT = 240 * MiB, WS_MX = 1 * MiB, WS_DA = 245 * MiB, WS_CW1 = 246 * MiB, WS_CW2 = 250 * MiB, WS_RSS = 251 * MiB;

struct Args { const float* in[15]; float* out; unsigned char* ws; };

__global__ void __launch_bounds__(NT, 2) mega_fwd(Args args) {
    extern __shared__ __attribute__((aligned(16))) unsigned char lds[];
    const int tid = threadIdx.x, lane = tid & 63, wid = tid >> 6;
    const int G = gridDim.x, bid = blockIdx.x;
    volatile LAS unsigned* MISC = (volatile LAS unsigned*)((LAS unsigned char*)lds + MISC_OFF);
    if (tid < 32) MISC[tid] = 0u;
    __syncthreads();
    unsigned char* ws = args.ws;
    XcdBarrier bar = xcd_barrier_post((unsigned*)(ws + WS_CTL) + 4096, MISC + 8);
    const float* x = args.in[0]; const float* tab = args.in[1]; const float* norm_w = args.in[2];
    const float* w_in = args.in[3]; const float* w_out = args.in[4]; const float* qk_gain = args.in[5];
    const float* qk_gain_diff = args.in[6]; const float* sinks = args.in[7]; const float* diff_lambda = args.in[8];
    const float* diff_subln = args.in[9]; const float* cmp_pos = args.in[10]; const float* cmp_w1 = args.in[11];
    const float* cmp_b1 = args.in[12]; const float* cmp_w2 = args.in[13]; const float* cmp_b2 = args.in[14];
    float* out = args.out;
    bf16_t* H = (bf16_t*)(ws + WS_H);
    bf16_t* XN = (bf16_t*)(ws + WS_XN); bf16_t* Y = XN;
    float* T0 = (float*)(ws + WS_T0);
    float* OC = T0; float* OS_ = T0 + (size_t)MROWS * 256; float* OW = T0 + (size_t)MROWS * 512; float* CT = T0;
    float* IMP = (float*)(ws + WS_IMP); unsigned* SEL = (unsigned*)(ws + WS_SEL); float* HID = (float*)(ws + WS_HID);
    float* KC = (float*)(ws + WS_KC); float* VC = (float*)(ws + WS_VC);
    const int GT = G * NT, GW = G * 8;
    bf16_t* WinT = (bf16_t*)(ws + WS_WIN); bf16_t* WoutT = (bf16_t*)(ws + WS_WOUT);
#define GRID_BAR() do { XcdBarrier b2_ = bar; asm volatile("" : "+s"(b2_.x)); xcd_barrier(b2_); } while (0)
    {
        LAS float* scr = (LAS float*)((LAS unsigned char*)lds + wid * 16384);
        const int gw0 = bid * 8 + wid;
        constexpr int I_IN = 16 * 120, I_OUT = 16 * 32, I_C1 = 32 * 8, I_C2 = 4 * 2, I_L = I_IN + I_OUT + 2 * I_C1 + 2 * I_C2, NITEMS = 2 * I_L;
        bf16_t* CW1T = (bf16_t*)(ws + WS_CW1); bf16_t* CW2T = (bf16_t*)(ws + WS_CW2);
        for (int it = gw0; it < NITEMS; it += GW) {
            const int l = it / I_L; int r = it % I_L;
            if (r < I_IN) { p0_transpose_item<0>(w_in + (size_t)l * DM * PW, WinT + (size_t)l * HP * DM, scr, r, lane); continue; } r -= I_IN;
            if (r < I_OUT) { p0_transpose_item<1>(w_out + (size_t)l * DM * DM, WoutT + (size_t)l * DM * DM, scr, r, lane); continue; } r -= I_OUT;
            if (r < 2 * I_C1) { const int kv = r / I_C1; p0_transpose_item<2>(cmp_w1 + (size_t)(l * 2 + kv) * 2048 * 256, CW1T + (size_t)(l * 2 + kv) * 256 * 2048, scr, r % I_C1, lane, 2048, 256); continue; } r -= 2 * I_C1;
            { const int kv = r / I_C2; p0_transpose_item<1>(cmp_w2 + (size_t)(l * 2 + kv) * 256 * 64, CW2T + (size_t)(l * 2 + kv) * 64 * 256, scr, r % I_C2, lane, 256, 64); }
        }
        if (bid == 1 && tid < 256) { bf16_t* KCb = (bf16_t*)(ws + WS_KC); KCb[(size_t)(tid >> 6) * 512 * 64 + 511 * 64 + (tid & 63)] = 0; }
        for (int w = gw0; w < MROWS; w += GW) k_rmsnorm(w, lane, x, norm_w, XN);
        for (int v = bid * NT + tid; v < MROWS; v += GT) ((unsigned long long*)(ws + WS_RSS))[v] = 0ull;
        if (bid == 0 && wid == 0) {
            float* MX = (float*)(ws + WS_MX);
            for (int l = 0; l < 2; ++l) {
                float mg[8];
#pragma unroll
                for (int i = 0; i < 8; ++i) { float v = fabsf(qk_gain[l * 512 + i * 64 + lane]);
#pragma unroll
                    for (int o = 1; o < 64; o <<= 1) v = fmaxf(v, __shfl_xor(v, o));
                    mg[i] = v; }
                float md0 = lane < 32 ? fabsf(qk_gain_diff[l * 64 + lane]) : 0.f, md1 = lane < 32 ? fabsf(qk_gain_diff[l * 64 + 32 + lane]) : 0.f;
#pragma unroll
                for (int o = 1; o < 64; o <<= 1) { md0 = fmaxf(md0, __shfl_xor(md0, o)); md1 = fmaxf(md1, __shfl_xor(md1, o)); }
                for (int gh = 0; gh < 16; ++gh) {
                    float mb = lane < 32 ? fabsf(tab[lane * 16 + gh]) : 0.f;
#pragma unroll
                    for (int o = 1; o < 64; o <<= 1) mb = fmaxf(mb, __shfl_xor(mb, o));
                    const int grp = gh >> 2, hh = gh & 3; float Mv;
                    if (grp == 0) Mv = 8.f * mg[0] * mg[1] + mb;
                    else if (grp == 1) Mv = fmaxf(8.f * mg[2] * mg[3] + mb, sinks[l * 4 + hh]);
                    else if (grp == 2) Mv = 5.656854249f * md0 * md1 + mb;
                    else Mv = 8.f * mg[4] * fmaxf(mg[5], fmaxf(mg[6], mg[7])) + mb;
                    if (lane == 0) MX[l * 16 + gh] = Mv;
                }
                float s1 = lane < 32 ? diff_lambda[l * 128 + lane] * diff_lambda[l * 128 + 32 + lane] : 0.f;
                float s2 = lane < 32 ? diff_lambda[l * 128 + 64 + lane] * diff_lambda[l * 128 + 96 + lane] : 0.f;
#pragma unroll
                for (int o = 1; o < 64; o <<= 1) { s1 += __shfl_xor(s1, o); s2 += __shfl_xor(s2, o); }
                const float lambda_init = 0.8f - 0.6f * expf(-0.3f * (float)l);
                if (lane == 0) { MX[32 + l] = expf(s1) - expf(s2) + lambda_init; MX[34 + l] = lambda_init; }
            }
        }
    }
    GRID_BAR();
#pragma unroll 1
    for (int l = 0; l < 2; ++l) {
        const float* xprev = l == 0 ? x : out;
        { pg8::Gemm g{XN, WinT + (size_t)l * HP * DM, MROWS, HP, DM}; pg8::StaticOrder So; So.init(MROWS, HP, G, bid);
          pg8::EpiProj E{H, qk_gain + l * 512, qk_gain_diff + l * 64, l == 0 ? nullptr : (const float*)(ws + WS_RSS)};
          for (int rep = 0; rep < R_G1; ++rep) pg8::gemm_phase<pg8::EpiProj, pg8::StaticOrder, true, true>((LAS unsigned char*)lds, g, So, E); }
        GRID_BAR();
        {
            const float* MX = (const float*)(ws + WS_MX);
            bf16_t* OA = (bf16_t*)(ws + WS_T0); float* DA = (float*)(ws + WS_DA);
            bf16_t* KCb = (bf16_t*)(ws + WS_KC);
            const bf16_t* CW1T = (const bf16_t*)(ws + WS_CW1); const bf16_t* CW2T = (const bf16_t*)(ws + WS_CW2);
            LAS unsigned* qw = (LAS unsigned*)((LAS unsigned char*)lds + att::L_Q);
            unsigned* qctr = (unsigned*)(ws + WS_CTL) + 8192 + 128 * l;
            unsigned* cdone = qctr + 64;
            constexpr int B0 = 64, B1 = B0 + 160 * R_C, B2 = B1 + 256 * R_D, B3 = B2 + 96 * R_C, B4 = B3 + 768 * R_AB, NUV = B4 + 256 * R_AB;
            for (;;) {
                if (opq(threadIdx.x) == 0) *qw = atomicAdd(qctr, 1u);
                __syncthreads();
                const int uv = (int)*qw;
                __syncthreads();
                if (uv >= NUV) break;
                int u;
                if (uv < B0) u = uv; else if (uv < B1) u = 64 + (uv - B0) / R_C; else if (uv < B2) u = 224 + (uv - B1) / R_D; else if (uv < B3) u = 480 + (uv - B2) / R_C;
                else if (uv < B4) u = 576 + (uv - B3) / R_AB; else u = 1344 + (uv - B4) / R_AB;
                if (u < 64) {
                    const int kv = u >> 5, b = (u >> 4) & 1, rt = u & 15;
                    att::CmpArgs P; P.Hb = H + (size_t)b * S * HP; P.col = kv == 0 ? C_KC : C_VC; P.rt = rt;
                    P.pos = cmp_pos + (size_t)(l * 2 + kv) * 2048; P.W1T = CW1T + (size_t)(l * 2 + kv) * 256 * 2048; P.b1 = cmp_b1 + (l * 2 + kv) * 256;
                    P.W2T = CW2T + (size_t)(l * 2 + kv) * 64 * 256; P.b2 = cmp_b2 + (l * 2 + kv) * 64; P.gain = kv == 0 ? qk_gain + l * 512 + 5 * 64 : nullptr;
                    P.OUT = KCb + (size_t)(kv * NB + b) * 512 * 64;
                    att::cmp_unit((LAS unsigned char*)lds, P);
                    asm volatile("s_waitcnt vmcnt(0)" ::: "memory");
                    __syncthreads();
                    if (opq(threadIdx.x) == 64) { __builtin_amdgcn_fence(__ATOMIC_RELEASE, "agent"); asm volatile("s_waitcnt vmcnt(0)" ::: "memory");
                        __hip_atomic_fetch_add(cdone, 1u, __ATOMIC_RELAXED, __HIP_MEMORY_SCOPE_AGENT); }
                    __syncthreads();
                } else if ((u >= 64 && u < 224) || (u >= 480 && u < 576)) {
                    int qb, bh;
                    if (u < 224) { qb = 31 - ((u - 64) >> 3); bh = (u - 64) & 7; } else { qb = 11 - ((u - 480) >> 3); bh = (u - 480) & 7; }
                    const int b = bh >> 2, hd = bh & 3;
                    att::DiffArgs P; P.Hb = H + (size_t)b * S * HP; P.hd = hd; P.qb = qb; P.brow = (size_t)b * S;
                    P.bias = tab + 8 + hd; P.M = MX[l * 16 + 8 + hd]; P.lam = MX[32 + l]; P.lambda_init = MX[34 + l]; P.subln = diff_subln + l * 64; P.Y = Y;
                    att::diff_unit((LAS unsigned char*)lds, P);
                } else if (u < 480) {
                    const int idx = u - 224, qb64 = 127 - (idx >> 1), b = idx & 1;
                    att::NsaArgs P; P.Hb = H + (size_t)b * S * HP; P.brow = (size_t)b * S; P.qb = qb64;
                    P.KC = KCb + (size_t)(0 * NB + b) * 512 * 64; P.VC = KCb + (size_t)(1 * NB + b) * 512 * 64;
                    P.bias = tab + 12; P.Mv = MX + l * 16 + 12; P.Y = Y; P.cdone = cdone;
                    att::nsa_unit((LAS unsigned char*)lds, P);
                } else if (u < 1344) {
                    const int v = u - 576, cfg = v >> 8, b = (v >> 7) & 1, hd = (v >> 5) & 3, ti = v & 31;
                    const int rate = cfg == 0 ? 1 : (cfg == 1 ? 4 : 16), tpc = 32 / rate;
                    att::BandArgs P; P.Hb = H + (size_t)b * S * HP; P.cq = C_AQ + 64 * hd; P.ck = C_AK + 64 * hd; P.cv = C_AV + 64 * hd;
                    P.rate = rate; P.cls = ti / tpc; P.f0 = (ti % tpc) * 256; P.maxd = 128; P.bias = tab + hd; P.M = MX[l * 16 + hd]; P.sinkterm = 0.f;
                    P.OA = OA + (size_t)cfg * MROWS * 256; P.DA = DA + (size_t)cfg * MROWS * 4; P.Y = nullptr; P.ycol = 0; P.hd = hd; P.brow = (size_t)b * S;
                    att::banded_unit<0>((LAS unsigned char*)lds, P);
                } else {
                    const int v = u - 1344, b = (v >> 7) & 1, hd = (v >> 5) & 3, ti = v & 31;
                    att::BandArgs P; P.Hb = H + (size_t)b * S * HP; P.cq = C_BQ + 64 * hd; P.ck = C_BK + 64 * (hd >> 1); P.cv = C_BV + 64 * (hd >> 1);
                    P.rate = 1; P.cls = 0; P.f0 = ti * 256; P.maxd = 127; P.bias = tab + 4 + hd; P.M = MX[l * 16 + 4 + hd];
                    P.sinkterm = __expf(sinks[l * 4 + hd] - P.M);
                    P.OA = nullptr; P.DA = nullptr; P.Y = Y; P.ycol = 256 + 64 * hd; P.hd = hd; P.brow = (size_t)b * S;
                    att::banded_unit<1>((LAS unsigned char*)lds, P);
                }
            }
        }
        GRID_BAR();
        {
            const bf16_t* OA = (const bf16_t*)(ws + WS_T0); const float* DA = (const float*)(ws + WS_DA);
            for (int v = (bid * NT + opq(threadIdx.x)); v < MROWS * 32; v += GT) {
                const int row = v >> 5, hd = (v >> 3) & 3, c8 = v & 7;
                float acc8[8] = {0.f, 0.f, 0.f, 0.f, 0.f, 0.f, 0.f, 0.f}; float dsum = 0.f;
#pragma unroll
                for (int cfg = 0; cfg < 3; ++cfg) {
                    const float dn = DA[((size_t)cfg * MROWS + row) * 4 + hd]; dsum += dn;
                    const uint4 r4 = *(const uint4*)(OA + ((size_t)cfg * MROWS + row) * 256 + hd * 64 + c8 * 8);
                    acc8[0] += dn * __uint_as_float(r4.x << 16); acc8[1] += dn * __uint_as_float(r4.x & 0xffff0000u);
                    acc8[2] += dn * __uint_as_float(r4.y << 16); acc8[3] += dn * __uint_as_float(r4.y & 0xffff0000u);
                    acc8[4] += dn * __uint_as_float(r4.z << 16); acc8[5] += dn * __uint_as_float(r4.z & 0xffff0000u);
                    acc8[6] += dn * __uint_as_float(r4.w << 16); acc8[7] += dn * __uint_as_float(r4.w & 0xffff0000u);
                }
                const float inv = 1.f / dsum;
                const uint4 s4 = *(const uint4*)(H + (size_t)row * HP + C_SILU + hd * 64 + c8 * 8);
                uint4 o4;
                o4.x = (unsigned)f2bf(acc8[0] * inv * __uint_as_float(s4.x << 16)) | ((unsigned)f2bf(acc8[1] * inv * __uint_as_float(s4.x & 0xffff0000u)) << 16);
                o4.y = (unsigned)f2bf(acc8[2] * inv * __uint_as_float(s4.y << 16)) | ((unsigned)f2bf(acc8[3] * inv * __uint_as_float(s4.y & 0xffff0000u)) << 16);
                o4.z = (unsigned)f2bf(acc8[4] * inv * __uint_as_float(s4.z << 16)) | ((unsigned)f2bf(acc8[5] * inv * __uint_as_float(s4.z & 0xffff0000u)) << 16);
                o4.w = (unsigned)f2bf(acc8[6] * inv * __uint_as_float(s4.w << 16)) | ((unsigned)f2bf(acc8[7] * inv * __uint_as_float(s4.w & 0xffff0000u)) << 16);
                *(uint4*)(Y + (size_t)row * DM + hd * 64 + c8 * 8) = o4;
            }
        }
        GRID_BAR();
        { pg8::Gemm g{Y, WoutT + (size_t)l * DM * DM, MROWS, DM, DM}; pg8::StaticOrder So; So.init(MROWS, DM, G, bid);
          pg8::EpiOut E{xprev, out, (LAS float*)((LAS unsigned char*)lds + 132096), l == 0 ? XN : nullptr, norm_w + DM, (float*)(ws + WS_RSS)};
          pg8::gemm_phase<pg8::EpiOut, pg8::StaticOrder, true, true>((LAS unsigned char*)lds, g, So, E); }
        if (l == 0) GRID_BAR();
    }
}

extern "C" void kernel_launch(void* const* d_in, const int* in_sizes, int n_in, void* d_out, int out_size, void* d_ws, size_t ws_size, hipStream_t stream) {
    static int grid = 0;
    if (grid == 0) {
        int dev = 0, cus = 0;
        (void)hipGetDevice(&dev);
        (void)hipDeviceGetAttribute(&cus, hipDeviceAttributeMultiprocessorCount, dev);
        (void)hipFuncSetAttribute((const void*)mega_fwd, hipFuncAttributeMaxDynamicSharedMemorySize, LDS_BYTES);
        grid = cus > 0 ? cus : 256;
    }
    (void)hipMemsetAsync((char*)d_ws + WS_CTL, 0, CTL_ZERO_BYTES, stream);
    Args a{};
    for (int i = 0; i < 15; ++i) a.in[i] = (const float*)d_in[i];
    a.out = (float*)d_out; a.ws = (unsigned char*)d_ws;
    hipLaunchKernelGGL(mega_fwd, dim3(grid), dim3(NT), LDS_BYTES, stream, a);
}
```

```cpp
#include <hip/hip_runtime.h>
#include <stdint.h>
#include <math.h>

typedef unsigned short bf16_t;
__device__ __forceinline__ float bf2f(bf16_t v) { return __uint_as_float((unsigned)v << 16); }
__device__ __forceinline__ bf16_t f2bf(float f) { unsigned u = __float_as_uint(f); return (bf16_t)((u + 0x7fffu + ((u >> 16) & 1u)) >> 16); }

constexpr int NB = 2, S = 8192, DM = 1024, MROWS = NB * S, PW = 3724, HP = 3840;
constexpr int C_AQ = 0, C_AK = 256, C_AV = 512, C_BQ = 768, C_BK = 1024, C_BV = 1152, C_CQ = 1280, C_CK = 1536, C_CV = 1792,
              C_DQ = 2048, C_KC = 2304, C_VC = 2368, C_KS = 2432, C_VS = 2496, C_KW = 2560, C_VW = 2624, C_GT = 2688, C_SILU = 2816;
constexpr float EPS = 1e-6f;
__device__ __forceinline__ int opq(int v) { asm volatile("" : "+v"(v)); return v; }

__device__ __forceinline__ int t5_bucket(int n) {
    if (n < 16) return n < 0 ? 0 : n;
    int b = 16;
    b += (n >= 22); b += (n >= 30); b += (n >= 40); b += (n >= 54); b += (n >= 73); b += (n >= 99); b += (n >= 134); b += (n >= 182);
    b += (n >= 246); b += (n >= 332); b += (n >= 450); b += (n >= 609); b += (n >= 825); b += (n >= 1117); b += (n >= 1513);
    return b;
}

__device__ __forceinline__ void k_rmsnorm(const int wave, const int lane, const float* __restrict__ x, const float* __restrict__ g, bf16_t* __restrict__ xn) {
    if (wave >= MROWS) return;
    const float4* xr = (const float4*)(x + (size_t)wave * DM);
    float4 v[4]; float ss = 0.f;
#pragma unroll
    for (int j = 0; j < 4; ++j) { v[j] = xr[lane + 64 * j]; ss += (v[j].x * v[j].x + v[j].y * v[j].y) + (v[j].z * v[j].z + v[j].w * v[j].w); }
#pragma unroll
    for (int o = 1; o < 64; o <<= 1) ss += __shfl_xor(ss, o);
    const float rstd = rsqrtf(ss * (1.f / DM) + EPS);
#pragma unroll
    for (int j = 0; j < 4; ++j) {
        const float4 gg = ((const float4*)g)[lane + 64 * j];
        uint2 o; o.x = (unsigned)f2bf(v[j].x * rstd * gg.x) | ((unsigned)f2bf(v[j].y * rstd * gg.y) << 16);
        o.y = (unsigned)f2bf(v[j].z * rstd * gg.z) | ((unsigned)f2bf(v[j].w * rstd * gg.w) << 16);
        ((uint2*)(xn + (size_t)wave * DM))[lane + 64 * j] = o;
    }
}

template <int D>
__device__ __forceinline__ float dot_row(const float* q, const bf16_t* kr) {
    float s = 0.f;
#pragma unroll
    for (int c = 0; c < D / 8; ++c) {
        const uint4 r = *(const uint4*)(kr + 8 * c);
        s += q[8 * c + 0] * __uint_as_float(r.x << 16) + q[8 * c + 1] * __uint_as_float(r.x & 0xffff0000u);
        s += q[8 * c + 2] * __uint_as_float(r.y << 16) + q[8 * c + 3] * __uint_as_float(r.y & 0xffff0000u);
        s += q[8 * c + 4] * __uint_as_float(r.z << 16) + q[8 * c + 5] * __uint_as_float(r.z & 0xffff0000u);
        s += q[8 * c + 6] * __uint_as_float(r.w << 16) + q[8 * c + 7] * __uint_as_float(r.w & 0xffff0000u);
        if (c & 1) asm volatile("" ::: "memory");
    }
    return s;
}
__device__ __forceinline__ void os_step(float s, const bf16_t* vr, float& m, float& den, float* o) {
    const float mn = fmaxf(m, s), sc = __expf(m - mn), p = __expf(s - mn);
    den = den * sc + p; m = mn;
#pragma unroll
    for (int c = 0; c < 8; ++c) {
        const uint4 r = *(const uint4*)(vr + 8 * c);
        o[8 * c + 0] = o[8 * c + 0] * sc + p * __uint_as_float(r.x << 16); o[8 * c + 1] = o[8 * c + 1] * sc + p * __uint_as_float(r.x & 0xffff0000u);
        o[8 * c + 2] = o[8 * c + 2] * sc + p * __uint_as_float(r.y << 16); o[8 * c + 3] = o[8 * c + 3] * sc + p * __uint_as_float(r.y & 0xffff0000u);
        o[8 * c + 4] = o[8 * c + 4] * sc + p * __uint_as_float(r.z << 16); o[8 * c + 5] = o[8 * c + 5] * sc + p * __uint_as_float(r.z & 0xffff0000u);
        o[8 * c + 6] = o[8 * c + 6] * sc + p * __uint_as_float(r.w << 16); o[8 * c + 7] = o[8 * c + 7] * sc + p * __uint_as_float(r.w & 0xffff0000u);
        if (c & 1) asm volatile("" ::: "memory");
    }
}
template <int D>
__device__ __forceinline__ void load_q(float* q, const bf16_t* p) {
#pragma unroll
    for (int c = 0; c < D / 8; ++c) {
        const uint4 r = *(const uint4*)(p + 8 * c);
        q[8 * c + 0] = __uint_as_float(r.x << 16); q[8 * c + 1] = __uint_as_float(r.x & 0xffff0000u);
        q[8 * c + 2] = __uint_as_float(r.y << 16); q[8 * c + 3] = __uint_as_float(r.y & 0xffff0000u);
        q[8 * c + 4] = __uint_as_float(r.z << 16); q[8 * c + 5] = __uint_as_float(r.z & 0xffff0000u);
        q[8 * c + 6] = __uint_as_float(r.w << 16); q[8 * c + 7] = __uint_as_float(r.w & 0xffff0000u);
    }
}

#define LAS __attribute__((address_space(3)))
namespace pg8 {
#define PG8_LAS __attribute__((address_space(3)))
typedef unsigned short bf16_t;
typedef short bf16x8 __attribute__((ext_vector_type(8)));
typedef float f32x4 __attribute__((ext_vector_type(4)));
typedef unsigned u32x4 __attribute__((ext_vector_type(4)));
constexpr int BM = 256, BK = 64, HALF = 128, HTB = HALF * BK * 2  , STAGE_BYTES = 8 * HTB, NXCD = 8, WGM = 8;

__host__ __device__ __forceinline__ int lds_byte(int r, int c) { const int st = (r >> 4) * 2 + (c >> 5), rr = r & 15, cc = c & 31, ob = rr * 64 + cc * 2; return st * 1024 + (ob ^ (((ob >> 9) & 1) << 5)); }
__host__ __device__ __forceinline__ void stage_rc(int b, int& R, int& C) { const int st = b / 1024, sb = b % 1024, swz = sb ^ (((sb >> 9) & 1) << 5); R = (st >> 1) * 16 + swz / 64; C = (st & 1) * 32 + (swz % 64) / 2; }
__host__ __device__ __forceinline__ int perm32(int rho) { const int n = rho >> 4, i = rho & 15; return 8 * (i >> 2) + 4 * n + (i & 3); }

struct Unit { int pm, pn; };
struct Gemm { const bf16_t* A; const bf16_t* Bt; int M, N, K; };

struct StaticOrder {
    int nM, nN, nwg, G, c;
    __host__ __device__ void init(int M, int N, int G_, int c_) { nM = M / BM; nN = N / BM; nwg = nM * nN; G = G_; c = c_; }
    __host__ __device__ bool next(int i, Unit& u) const {
        const long L = (long)i * G + c; if (L >= nwg) return false;
        int wgid = (int)L; { const int q = nwg / NXCD, r = nwg % NXCD, xcd = wgid % NXCD, off = wgid / NXCD; wgid = (xcd < r ? xcd * (q + 1) : r * (q + 1) + (xcd - r) * q) + off; }
        const int nig = WGM * nN, gid = wgid / nig, fm = gid * WGM, gsz = (nM - fm) < WGM ? (nM - fm) : WGM;
        u.pm = fm + ((wgid % nig) % gsz); u.pn = (wgid % nig) / gsz; return true;
    }
    __device__ __forceinline__ void a_ready(const Unit&) const {}
    __device__ __forceinline__ void done(const Unit&) const {}
};

__device__ __forceinline__ unsigned cvt_pk_bf16(float lo, float hi) { unsigned r; asm volatile("v_cvt_pk_bf16_f32 %0, %1, %2" : "=v"(r) : "v"(lo), "v"(hi)); return r; }
template <class Epi, class Sched, bool ALIGN_EPI = false, bool SP2 = false>
__device__ __forceinline__ void gemm_phase(PG8_LAS unsigned char* lds, const Gemm g, const Sched& S, const Epi& E) {
    const int tid = opq(threadIdx.x), wid = __builtin_amdgcn_readfirstlane(tid >> 6), lane = tid & 63, wr = wid >> 2, wc = wid & 3, fr = lane & 15, fq = lane >> 4;
    const int K = g.K, nt = K / BK;
    unsigned voffA[2], voffB[2];
#pragma unroll
    for (int i = 0; i < 2; ++i) { int R, C; stage_rc(tid * 16 + i * 8192, R, C); const int Rb = Epi::PERM ? ((R & ~31) + perm32(R & 31)) : R;
        voffA[i] = (unsigned)(R * K + C) * 2u; voffB[i] = (unsigned)(Rb * K + C) * 2u; }
    const size_t kstep = (size_t)(BK * 2);
    const size_t hstep = (size_t)HALF * K * 2;
    const size_t tstep = 2 * hstep;
    const unsigned ldsw = (unsigned)wid * 1024u;
    const int aoff = lds_byte(wr * 64 + fr, fq * 8), boff = lds_byte(wc * 32 + fr, fq * 8);
#define PG8_SA(b, h) (((b) * 2 + (h)) * HTB)
#define PG8_SB(b, h) ((4 + (b) * 2 + (h)) * HTB)
#define PG8_STAGE(bufoff, gbase, voff) do { _Pragma("unroll") for (int _i = 0; _i < 2; ++_i) \
        __builtin_amdgcn_global_load_lds((const unsigned*)((const char*)(gbase) + (voff)[_i]), (PG8_LAS unsigned*)(lds + (bufoff) + ldsw + _i * 8192), 16, 0, 0); } while (0)
#define PG8_LDA(dst, b, h) do { _Pragma("unroll") for (int m = 0; m < 4; ++m) _Pragma("unroll") for (int k = 0; k < 2; ++k) dst[m][k] = *(const PG8_LAS bf16x8*)(lds + PG8_SA(b, h) + aoff + m * 2048 + k * 1024); } while (0)
#define PG8_LDB(dst, b, h) do { _Pragma("unroll") for (int n = 0; n < 2; ++n) _Pragma("unroll") for (int k = 0; k < 2; ++k) dst[n][k] = *(const PG8_LAS bf16x8*)(lds + PG8_SB(b, h) + boff + n * 2048 + k * 1024); } while (0)
#define PG8_MMA(ai, bj, At, Bt) do { __builtin_amdgcn_s_setprio(1); _Pragma("unroll") for (int m = 0; m < 4; ++m) _Pragma("unroll") for (int n = 0; n < 2; ++n) _Pragma("unroll") for (int k = 0; k < 2; ++k) \
        acc[ai][bj][m][n] = __builtin_amdgcn_mfma_f32_16x16x32_bf16(Bt[n][k], At[m][k], acc[ai][bj][m][n], 0, 0, 0); __builtin_amdgcn_s_setprio(0); } while (0)
#define PG8_WAIT_V(n) asm volatile("s_waitcnt vmcnt(" #n ")" ::: "memory")
#define PG8_WAIT_L(n) asm volatile("s_waitcnt lgkmcnt(" #n ")" ::: "memory")
#define PG8_BAR __builtin_amdgcn_s_barrier()
#define PG8_SCHED __builtin_amdgcn_sched_barrier(0)
    Unit cur, nxt; int ui = 0;
    if (!S.next(0, cur)) return;
    f32x4 acc[2][2][4][2];
#pragma unroll
    for (int a = 0; a < 2; ++a)
#pragma unroll
        for (int b = 0; b < 2; ++b)
#pragma unroll
            for (int m = 0; m < 4; ++m)
#pragma unroll
                for (int n = 0; n < 2; ++n) acc[a][b][m][n] = (f32x4){0.f, 0.f, 0.f, 0.f};
    bf16x8 At[4][2], B0[2][2], B1[2][2];
    const char* cA = (const char*)g.A + (size_t)cur.pm * tstep; const char* cB = (const char*)g.Bt + (size_t)cur.pn * tstep;
    S.a_ready(cur);
    if constexpr (SP2) {
        PG8_STAGE(PG8_SB(0, 0), cB, voffB); PG8_STAGE(PG8_SB(0, 1), cB + hstep, voffB); PG8_STAGE(PG8_SA(0, 0), cA, voffA); PG8_STAGE(PG8_SA(0, 1), cA + hstep, voffA);
        if (wr == 1) PG8_BAR;
        PG8_WAIT_V(2); PG8_BAR;
        PG8_STAGE(PG8_SB(1, 0), cB + kstep, voffB); PG8_STAGE(PG8_SA(1, 0), cA + kstep, voffA); PG8_STAGE(PG8_SB(1, 1), cB + hstep + kstep, voffB);
        PG8_WAIT_V(6); PG8_BAR;
    } else {
        PG8_STAGE(PG8_SB(0, 0), cB, voffB); PG8_STAGE(PG8_SA(0, 0), cA, voffA); PG8_STAGE(PG8_SB(0, 1), cB + hstep, voffB); PG8_STAGE(PG8_SA(0, 1), cA + hstep, voffA);
        if (wr == 1) PG8_BAR;
        PG8_WAIT_V(4); PG8_BAR;
        PG8_STAGE(PG8_SB(1, 0), cB + kstep, voffB); PG8_STAGE(PG8_SA(1, 0), cA + kstep, voffA); PG8_STAGE(PG8_SB(1, 1), cB + hstep + kstep, voffB);
        PG8_WAIT_V(6); PG8_BAR;
    }
    for (;;) {
        const bool has_next = S.next(ui + 1, nxt);
        const char* nA = has_next ? (const char*)g.A + (size_t)nxt.pm * tstep : cA; const char* nB = has_next ? (const char*)g.Bt + (size_t)nxt.pn * tstep : cB;
        for (int t = 0; t < nt; t += 2) {
            const bool last = (t == nt - 2);
            const char* a1 = cA + (size_t)(t + 1) * kstep;
            const char* a2 = last ? nA : cA + (size_t)(t + 2) * kstep; const char* b2 = last ? nB : cB + (size_t)(t + 2) * kstep;
            const char* a3 = a2 + kstep; const char* b3 = b2 + kstep;
            if (last && has_next) S.a_ready(nxt);
            if constexpr (SP2) {
            PG8_LDB(B0, 0, 0); PG8_LDB(B1, 0, 1); PG8_SCHED; PG8_LDA(At, 0, 0); PG8_STAGE(PG8_SA(1, 1), a1 + hstep, voffA);
            PG8_WAIT_V(8); PG8_WAIT_L(0); PG8_BAR; PG8_MMA(0, 0, At, B0); PG8_MMA(0, 1, At, B1); PG8_BAR; PG8_SCHED;
            PG8_LDA(At, 0, 1); PG8_STAGE(PG8_SB(0, 0), b2, voffB); PG8_STAGE(PG8_SB(0, 1), b2 + hstep, voffB); PG8_STAGE(PG8_SA(0, 0), a2, voffA);
            PG8_WAIT_V(8); PG8_WAIT_L(0); PG8_BAR; PG8_MMA(1, 0, At, B0); PG8_MMA(1, 1, At, B1); PG8_BAR; PG8_SCHED;
            PG8_LDB(B0, 1, 0); PG8_LDB(B1, 1, 1); PG8_SCHED; PG8_LDA(At, 1, 0); PG8_STAGE(PG8_SA(0, 1), a2 + hstep, voffA);
            PG8_WAIT_V(8); PG8_WAIT_L(0); PG8_BAR; PG8_MMA(0, 0, At, B0); PG8_MMA(0, 1, At, B1); PG8_BAR; PG8_SCHED;
            PG8_LDA(At, 1, 1); PG8_STAGE(PG8_SB(1, 0), b3, voffB); PG8_STAGE(PG8_SB(1, 1), b3 + hstep, voffB); PG8_STAGE(PG8_SA(1, 0), a3, voffA);
            PG8_WAIT_V(8); PG8_WAIT_L(0); PG8_BAR; PG8_MMA(1, 0, At, B0); PG8_MMA(1, 1, At, B1); PG8_BAR; PG8_SCHED;
            } else {
            PG8_LDB(B0, 0, 0); PG8_SCHED; PG8_LDA(At, 0, 0); PG8_STAGE(PG8_SA(1, 1), a1 + hstep, voffA);
            PG8_WAIT_L(8); PG8_BAR; PG8_WAIT_L(0); PG8_MMA(0, 0, At, B0); PG8_BAR; PG8_SCHED;
            PG8_LDB(B1, 0, 1); PG8_STAGE(PG8_SB(0, 0), b2, voffB);
            PG8_BAR; PG8_WAIT_L(0); PG8_MMA(0, 1, At, B1); PG8_BAR;
            PG8_LDA(At, 0, 1); PG8_STAGE(PG8_SA(0, 0), a2, voffA);
            PG8_BAR; PG8_WAIT_L(0); PG8_MMA(1, 0, At, B0); PG8_BAR; PG8_SCHED;
            PG8_STAGE(PG8_SB(0, 1), b2 + hstep, voffB);
            PG8_WAIT_V(6); PG8_BAR; PG8_MMA(1, 1, At, B1); PG8_BAR;
            PG8_LDB(B0, 1, 0); PG8_SCHED; PG8_LDA(At, 1, 0); PG8_STAGE(PG8_SA(0, 1), a2 + hstep, voffA);
            PG8_WAIT_L(8); PG8_BAR; PG8_WAIT_L(0); PG8_MMA(0, 0, At, B0); PG8_BAR; PG8_SCHED;
            PG8_LDB(B1, 1, 1); PG8_STAGE(PG8_SB(1, 0), b3, voffB);
            PG8_BAR; PG8_WAIT_L(0); PG8_MMA(0, 1, At, B1); PG8_BAR;
            PG8_LDA(At, 1, 1); PG8_STAGE(PG8_SA(1, 0), a3, voffA);
            PG8_BAR; PG8_WAIT_L(0); PG8_MMA(1, 0, At, B0); PG8_BAR; PG8_SCHED;
            PG8_STAGE(PG8_SB(1, 1), b3 + hstep, voffB);
            PG8_WAIT_V(6); PG8_BAR; PG8_MMA(1, 1, At, B1); PG8_BAR;
            }
        }
        if constexpr (ALIGN_EPI) { if (wr == 0) PG8_BAR; }
        if constexpr (!Epi::AFTER_DRAIN) { E(acc, cur, wr, wc, fr, fq); S.done(cur); }
        if (!has_next) break;
#pragma unroll
        for (int a = 0; a < 2; ++a)
#pragma unroll
            for (int b = 0; b < 2; ++b)
#pragma unroll
                for (int m = 0; m < 4; ++m)
#pragma unroll
                    for (int n = 0; n < 2; ++n) acc[a][b][m][n] = (f32x4){0.f, 0.f, 0.f, 0.f};
        cur = nxt; cA = nA; cB = nB; ++ui;
        if constexpr (ALIGN_EPI) { if (wr == 1) PG8_BAR; }
    }
    PG8_WAIT_V(0);
    if constexpr (!ALIGN_EPI) { if (wr == 0) PG8_BAR; }
    PG8_BAR;
    if constexpr (Epi::AFTER_DRAIN) { E.fused(acc, cur, wr, wc, fr, fq, lds, wid, lane); S.done(cur); }
#undef PG8_SA
#undef PG8_SB
#undef PG8_STAGE
#undef PG8_LDA
#undef PG8_LDB
#undef PG8_MMA
#undef PG8_WAIT_V
#undef PG8_WAIT_L
#undef PG8_BAR
#undef PG8_SCHED
}
}

namespace pg8 {
struct EpiProj {
    static constexpr bool PERM = true, AFTER_DRAIN = false;
    bf16_t* H; const float* g; const float* gd;
    const float* rowss;
    __device__ __forceinline__ void operator()(const f32x4 (&acc)[2][2][4][2], const Unit& u, int wr, int wc, int fr, int fq) const {
        const int pn = u.pn;
        int mode = 0; const float* gain = nullptr;
        const float qs = (pn == 0 || pn == 3 || pn == 8) ? 0.125f * 1.4426950408889634f : (pn == 5 ? 0.17677669529663687f * 1.4426950408889634f : 1.f);
        if (pn == 0) { mode = 1; gain = g; } else if (pn == 1) { mode = 1; gain = g + 64; } else if (pn == 3) { mode = 1; gain = g + 128; }
        else if (pn == 4) { if (wc < 2) { mode = 1; gain = g + 192; } }
        else if (pn == 5) { mode = 2; gain = gd; } else if (pn == 6) { mode = 2; gain = gd + 32; }
        else if (pn == 8) { mode = 1; gain = g + 256; }
        else if (pn == 9) { if (wc == 2) { mode = 1; gain = g + 384; } }
        else if (pn == 10) { if (wc == 0) { mode = 1; gain = g + 448; } else if (wc == 2) mode = 4; }
        else if (pn >= 11) mode = 3;
        f32x4 gv[2][2];
#pragma unroll
        for (int bj = 0; bj < 2; ++bj)
#pragma unroll
            for (int n = 0; n < 2; ++n) gv[bj][n] = (f32x4){1.f, 1.f, 1.f, 1.f};
        if (mode == 1) {
#pragma unroll
            for (int bj = 0; bj < 2; ++bj)
#pragma unroll
                for (int n = 0; n < 2; ++n) gv[bj][n] = *(const f32x4*)(gain + 32 * bj + 8 * fq + 4 * n);
        } else if (mode == 2) {
#pragma unroll
            for (int bj = 0; bj < 2; ++bj)
#pragma unroll
                for (int n = 0; n < 2; ++n) gv[bj][n] = *(const f32x4*)(gain + 8 * fq + 4 * n);
        }
        const int col0 = pn * BM + 64 * wc + 8 * fq;
#pragma unroll
        for (int ai = 0; ai < 2; ++ai)
#pragma unroll
            for (int m = 0; m < 4; ++m) {
                const int row = u.pm * BM + ai * HALF + wr * 64 + m * 16 + fr;
                f32x4 v[2][2];
                const float rsc = rowss ? rsqrtf((float)((const unsigned long long*)rowss)[row] * (1.f / (1048576.f * 1024.f)) + 1e-6f) : 1.f;
#pragma unroll
                for (int bj = 0; bj < 2; ++bj)
#pragma unroll
                    for (int n = 0; n < 2; ++n) v[bj][n] = acc[ai][bj][m][n] * rsc;
                if (mode == 1 || mode == 2) {
                    float s0 = 0.f, s1 = 0.f;
#pragma unroll
                    for (int n = 0; n < 2; ++n) {
                        s0 += v[0][n][0] * v[0][n][0] + v[0][n][1] * v[0][n][1] + v[0][n][2] * v[0][n][2] + v[0][n][3] * v[0][n][3];
                        s1 += v[1][n][0] * v[1][n][0] + v[1][n][1] * v[1][n][1] + v[1][n][2] * v[1][n][2] + v[1][n][3] * v[1][n][3];
                    }
                    s0 += __shfl_xor(s0, 16); s0 += __shfl_xor(s0, 32);
                    s1 += __shfl_xor(s1, 16); s1 += __shfl_xor(s1, 32);
                    float r0, r1;
                    if (mode == 1) { r0 = r1 = rsqrtf((s0 + s1) * (1.f / 64.f) + 1e-6f) * qs; }
                    else { r0 = rsqrtf(s0 * (1.f / 32.f) + 1e-6f) * qs; r1 = rsqrtf(s1 * (1.f / 32.f) + 1e-6f) * qs; }
#pragma unroll
                    for (int n = 0; n < 2; ++n) { v[0][n] = v[0][n] * r0 * gv[0][n]; v[1][n] = v[1][n] * r1 * gv[1][n]; }
                } else if (mode == 3) {
#pragma unroll
                    for (int bj = 0; bj < 2; ++bj)
#pragma unroll
                        for (int n = 0; n < 2; ++n)
#pragma unroll
                            for (int e = 0; e < 4; ++e) { const float x = v[bj][n][e]; v[bj][n][e] = x * __builtin_amdgcn_rcpf(1.f + __expf(-x)); }
                } else if (mode == 4) {
#pragma unroll
                    for (int bj = 0; bj < 2; ++bj)
#pragma unroll
                        for (int n = 0; n < 2; ++n)
#pragma unroll
                            for (int e = 0; e < 4; ++e) { const float x = v[bj][n][e]; v[bj][n][e] = __builtin_amdgcn_rcpf(1.f + __expf(-x)); }
                }
                bf16_t* rowp = H + (size_t)row * 3840 + col0;
#pragma unroll
                for (int bj = 0; bj < 2; ++bj) {
                    u32x4 w; w.x = cvt_pk_bf16(v[bj][0][0], v[bj][0][1]); w.y = cvt_pk_bf16(v[bj][0][2], v[bj][0][3]);
                    w.z = cvt_pk_bf16(v[bj][1][0], v[bj][1][1]); w.w = cvt_pk_bf16(v[bj][1][2], v[bj][1][3]);
                    *(u32x4*)(rowp + 32 * bj) = w;
                }
            }
    }
};
struct EpiOut {
    static constexpr bool PERM = false, AFTER_DRAIN = false;
    const float* xprev; float* out;
    PG8_LAS float* exch;
    bf16_t* xn; const float* gnext; float* rowss;
    __device__ __forceinline__ void operator()(const f32x4 (&acc)[2][2][4][2], const Unit& u, int wr, int wc, int fr, int fq) const {
        const int col0 = u.pn * BM + wc * 32 + 4 * fq;
        f32x4 gn[2][2];
#pragma unroll
        for (int bj = 0; bj < 2; ++bj)
#pragma unroll
            for (int n = 0; n < 2; ++n) gn[bj][n] = xn ? *(const f32x4*)(gnext + col0 + bj * HALF + n * 16) : (f32x4){0.f, 0.f, 0.f, 0.f};
#pragma unroll
        for (int ai = 0; ai < 2; ++ai)
#pragma unroll
            for (int m = 0; m < 4; ++m) {
                const int row = u.pm * BM + ai * HALF + wr * 64 + m * 16 + fr;
                const size_t off = (size_t)row * 1024 + col0;
                float ss = 0.f;
#pragma unroll
                for (int bj = 0; bj < 2; ++bj)
#pragma unroll
                    for (int n = 0; n < 2; ++n) {
                        const f32x4 b = *(const f32x4*)(xprev + off + bj * HALF + n * 16);
                        const f32x4 v = b + acc[ai][bj][m][n];
                        *(f32x4*)(out + off + bj * HALF + n * 16) = v;
                        if (xn) {
                            ss += (v[0] * v[0] + v[1] * v[1]) + (v[2] * v[2] + v[3] * v[3]);
                            const f32x4 w = v * gn[bj][n];
                            uint2 o; o.x = cvt_pk_bf16(w[0], w[1]); o.y = cvt_pk_bf16(w[2], w[3]);
                            *(uint2*)(xn + off + bj * HALF + n * 16) = o;
                        }
                    }
                if (xn) {
                    ss += __shfl_xor(ss, 16); ss += __shfl_xor(ss, 32);
                    if (fq == 0) exch[(ai * HALF + wr * 64 + m * 16 + fr) * 4 + wc] = ss;
                }
            }
        if (xn) {
            asm volatile("s_waitcnt lgkmcnt(0)" ::: "memory"); __builtin_amdgcn_s_barrier(); asm volatile("" ::: "memory");
            if (wc == 0) {
                const int lane = fq * 16 + fr;
#pragma unroll
                for (int k = 0; k < 2; ++k) {
                    const int rl = k * HALF + wr * 64 + lane;
                    const f32x4 p = *(const PG8_LAS f32x4*)(exch + rl * 4);
                    const float tot = (p[0] + p[1]) + (p[2] + p[3]);
                    atomicAdd((unsigned long long*)rowss + (u.pm * BM + rl), (unsigned long long)(tot * 1048576.f + 0.5f));
                }
            }
        }
    }
};
}

template <int MODE>
__device__ __forceinline__ void p0_transpose_item(const float* __restrict__ W, bf16_t* __restrict__ WT, LAS float* scr, int item, int lane, int KR = 1024, int NC = 1024) {
    const int NSRC = MODE == 0 ? 3724 : NC, NG = MODE == 0 ? 120 : NC / 32;
    const int kb = item / NG, nb = item % NG, k0 = 64 * kb, hc0 = 32 * nb;
    const int hc = hc0 + (lane & 31);
    int src = hc;
    if (MODE == 0) src = hc < 2700 ? hc : (hc < 2816 ? -1 : hc - 116);
#pragma unroll 8
    for (int i = 0; i < 32; ++i) { const int kk = 2 * i + (lane >> 5); scr[kk * 33 + (lane & 31)] = src >= 0 ? W[(size_t)(k0 + kk) * NSRC + src] : 0.f; }
    asm volatile("s_waitcnt lgkmcnt(0)" ::: "memory");
    const int c = lane & 7;
#pragma unroll
    for (int j = 0; j < 4; ++j) {
        const int n = (lane >> 3) + 8 * j; const LAS float* s = scr + (8 * c) * 33 + n;
        const int hcn = hc0 + n;
        int drow = hcn;
        if (MODE == 0) drow = (hcn & ~255) + ((hcn >> 5) & 1) * 128 + ((hcn >> 6) & 3) * 32 + (hcn & 31);
        uint4 o; o.x = (unsigned)f2bf(s[0]) | ((unsigned)f2bf(s[33]) << 16); o.y = (unsigned)f2bf(s[66]) | ((unsigned)f2bf(s[99]) << 16);
        o.z = (unsigned)f2bf(s[132]) | ((unsigned)f2bf(s[165]) << 16); o.w = (unsigned)f2bf(s[198]) | ((unsigned)f2bf(s[231]) << 16);
        if (MODE == 2) { const int k = k0 + 8 * c; *(uint4*)(WT + ((size_t)((((drow >> 5) * 8 + (k >> 8)) * 16 + ((k >> 4) & 15)) * 64 + ((k >> 3) & 1) * 32 + (drow & 31))) * 8) = o; }
        else *(uint4*)(WT + (size_t)drow * KR + k0 + 8 * c) = o;
    }
    asm volatile("s_waitcnt lgkmcnt(0)" ::: "memory");
}

namespace att {
typedef short bf16x8 __attribute__((ext_vector_type(8)));
typedef short v4i16 __attribute__((ext_vector_type(4)));
typedef float f32x16 __attribute__((ext_vector_type(16)));
typedef float f32x2_t __attribute__((ext_vector_type(2)));
typedef __bf16 bf16x2_t __attribute__((ext_vector_type(2)));
typedef unsigned u32x4 __attribute__((ext_vector_type(4)));
typedef float f32x4 __attribute__((ext_vector_type(4)));
__device__ __forceinline__ unsigned cvtpk(float lo, float hi) { f32x2_t v = {lo, hi}; bf16x2_t b = __builtin_convertvector(v, bf16x2_t); return __builtin_bit_cast(unsigned, b); }
__device__ __forceinline__ int crow(int r, int h) { return (r & 3) + 8 * (r >> 2) + 4 * h; }
constexpr float LOG2E = 1.4426950408889634f;
constexpr int L_KV = 0, KVB = 16384  , L_TAB = 32768  , L_WSCR = 83968  , L_IMP = 92160  , L_Q = 124928, L_SEL = 125184  , L_SB = 126464  ;

struct StageRegs { u32x4 k, v; };
__device__ __forceinline__ void stage_load(StageRegs& sr, const bf16_t* kp, const bf16_t* vp, bool valid, int ch) {
    sr.k = (u32x4){0u, 0u, 0u, 0u}; sr.v = sr.k;
    if (valid) { sr.k = *(const u32x4*)(kp + ch * 8); sr.v = *(const u32x4*)(vp + ch * 8); }
}
__device__ __forceinline__ void stage_write(LAS unsigned char* buf, const StageRegs& sr, int row, int ch) {
    *(LAS u32x4*)(buf + row * 128 + ((ch ^ (row & 7)) << 4)) = sr.k;
    *(LAS u32x4*)(buf + 8192 + (ch >> 2) * 4096 + row * 64 + (ch & 3) * 16) = sr.v;
}
__device__ __forceinline__ f32x16 load_tab16(const LAS float* tbl, int TSP, int jb) {
    const int sh = jb & 3; const LAS float* tp = tbl + sh * TSP + (jb - sh);
    const f32x4 t0 = *(const LAS f32x4*)(tp), t1 = *(const LAS f32x4*)(tp + 8), t2 = *(const LAS f32x4*)(tp + 16), t3 = *(const LAS f32x4*)(tp + 24);
    return (f32x16){t0[0], t0[1], t0[2], t0[3], t1[0], t1[1], t1[2], t1[3], t2[0], t2[1], t2[2], t2[3], t3[0], t3[1], t3[2], t3[3]};
}
__device__ __forceinline__ float exp_sum16(f32x16& acc) {
    float sa = 0.f, sb = 0.f;
#pragma unroll
    for (int r = 0; r < 16; r += 2) {
        acc[r] = __builtin_amdgcn_exp2f(acc[r]); acc[r + 1] = __builtin_amdgcn_exp2f(acc[r + 1]);
        sa += acc[r]; asm volatile("" : "+v"(sa)); sb += acc[r + 1]; asm volatile("" : "+v"(sb));
    }
    return sa + sb;
}
__device__ __forceinline__ f32x16 splat16(float v) { return (f32x16){v, v, v, v, v, v, v, v, v, v, v, v, v, v, v, v}; }
template <int S0, int S1>
__device__ __forceinline__ void qk_sub(f32x16& acc, const LAS unsigned char* buf, int sub, const bf16x8* qf, int lane) {
    const int key = 32 * sub + (lane & 31), h = lane >> 5;
    bf16x8 kf[S1 - S0];
#pragma unroll
    for (int s = S0; s < S1; ++s) kf[s - S0] = *(const LAS bf16x8*)(buf + key * 128 + (((2 * s + h) ^ (key & 7)) << 4));
    __builtin_amdgcn_sched_barrier(0);
#pragma unroll
    for (int s = S0; s < S1; ++s) acc = __builtin_amdgcn_mfma_f32_32x32x16_bf16(kf[s - S0], qf[s], acc, 0, 0, 0);
}
__device__ __forceinline__ void pack_p(const f32x16& p, bf16x8& pa0, bf16x8& pa1) {
    u32x4 w0, w1;
    w0.x = cvtpk(p[0], p[1]); w0.y = cvtpk(p[2], p[3]); w0.z = cvtpk(p[4], p[5]); w0.w = cvtpk(p[6], p[7]);
    w1.x = cvtpk(p[8], p[9]); w1.y = cvtpk(p[10], p[11]); w1.z = cvtpk(p[12], p[13]); w1.w = cvtpk(p[14], p[15]);
    pa0 = __builtin_bit_cast(bf16x8, w0); pa1 = __builtin_bit_cast(bf16x8, w1);
}
__device__ __forceinline__ void pv_sub(f32x16* o, const LAS unsigned char* buf, int sub, const bf16x8& pa0, const bf16x8& pa1, int lane) {
    const int h = lane >> 5, g16 = (lane >> 4) & 1, q4 = (lane & 15) >> 2, p4 = lane & 3;
    const LAS unsigned char* vb = buf + 8192 + (32 * sub + 4 * h + q4) * 64 + (16 * g16 + 4 * p4) * 2;
    bf16x8 vf[2][2];
#pragma unroll
    for (int dt = 0; dt < 2; ++dt) {
#pragma unroll
        for (int s2 = 0; s2 < 2; ++s2) {
            const v4i16 lo = __builtin_amdgcn_ds_read_tr16_b64_v4i16((LAS v4i16*)(vb + dt * 4096 + s2 * 1024));
            const v4i16 hi = __builtin_amdgcn_ds_read_tr16_b64_v4i16((LAS v4i16*)(vb + dt * 4096 + s2 * 1024 + 512));
            vf[dt][s2] = (bf16x8){lo[0], lo[1], lo[2], lo[3], hi[0], hi[1], hi[2], hi[3]};
        }
    }
    __builtin_amdgcn_sched_barrier(0);
    o[0] = __builtin_amdgcn_mfma_f32_32x32x16_bf16(pa0, vf[0][0], o[0], 0, 0, 0);
    o[1] = __builtin_amdgcn_mfma_f32_32x32x16_bf16(pa0, vf[1][0], o[1], 0, 0, 0);
    o[0] = __builtin_amdgcn_mfma_f32_32x32x16_bf16(pa1, vf[0][1], o[0], 0, 0, 0);
    o[1] = __builtin_amdgcn_mfma_f32_32x32x16_bf16(pa1, vf[1][1], o[1], 0, 0, 0);
}

__device__ __forceinline__ void pv_sub2(f32x16* oa, f32x16* ob, const LAS unsigned char* buf, int sub, const bf16x8& a0, const bf16x8& a1, const bf16x8& b0, const bf16x8& b1, int lane) {
    const int h = lane >> 5, g16 = (lane >> 4) & 1, q4 = (lane & 15) >> 2, p4 = lane & 3;
    const LAS unsigned char* vb = buf + 8192 + (32 * sub + 4 * h + q4) * 64 + (16 * g16 + 4 * p4) * 2;
#pragma unroll
    for (int dt = 0; dt < 2; ++dt) {
#pragma unroll
        for (int s2 = 0; s2 < 2; ++s2) {
            const v4i16 lo = __builtin_amdgcn_ds_read_tr16_b64_v4i16((LAS v4i16*)(vb + dt * 4096 + s2 * 1024));
            const v4i16 hi = __builtin_amdgcn_ds_read_tr16_b64_v4i16((LAS v4i16*)(vb + dt * 4096 + s2 * 1024 + 512));
            const bf16x8 vf = (bf16x8){lo[0], lo[1], lo[2], lo[3], hi[0], hi[1], hi[2], hi[3]};
            oa[dt] = __builtin_amdgcn_mfma_f32_32x32x16_bf16(s2 == 0 ? a0 : a1, vf, oa[dt], 0, 0, 0);
            ob[dt] = __builtin_amdgcn_mfma_f32_32x32x16_bf16(s2 == 0 ? b0 : b1, vf, ob[dt], 0, 0, 0);
        }
    }
}

struct BandArgs {
    const bf16_t* Hb;
    int cq, ck, cv;
    int rate, cls, f0, maxd;
    const float* bias;
    float M;
    float sinkterm;
    bf16_t* OA; float* DA;
    bf16_t* Y; int ycol;
    int hd; size_t brow;
};
template <int MODE>
__device__ __forceinline__ void banded_unit(LAS unsigned char* lds, const BandArgs& P) {
    const int tid = opq(threadIdx.x), lane = tid & 63, w = __builtin_amdgcn_readfirstlane(tid >> 6), h = lane >> 5;
    LAS float* sb = (LAS float*)(lds + L_SB);
    LAS float* tbl = (LAS float*)(lds + L_TAB);
    const int KPREV = ((P.maxd + 63) >> 6) << 6, ntl = (KPREV + 256) >> 6;
    const int t0 = (KPREV - P.f0) > 0 ? ((KPREV - P.f0) >> 6) : 0;
    const int srow = tid >> 3, sch = tid & 7;
    StageRegs sr;
    {
        const int kf = P.f0 - KPREV + 64 * t0 + srow;
        const bf16_t* rp = P.Hb + ((size_t)kf * P.rate + P.cls) * HP;
        stage_load(sr, rp + P.ck, rp + P.cv, true, sch);
    }
    const int fq0 = P.f0 + 32 * w;
    bf16x8 qf[4];
    {
        const size_t tq = (size_t)(fq0 + (lane & 31)) * P.rate + P.cls;
        const bf16_t* qp = P.Hb + tq * HP + P.cq + 8 * h;
#pragma unroll
        for (int s = 0; s < 4; ++s) qf[s] = *(const bf16x8*)(qp + 16 * s);
    }
    if (tid < 32) sb[tid] = (P.bias[tid * 16] - P.M) * LOG2E;
    __syncthreads();
    const int DMAXI = P.maxd + 62, TS = P.maxd + 125, TSP = (TS + 7) & ~3;
    for (int e = tid; e < 4 * TSP; e += 512) {
        const int sh = e / TSP, j = e - sh * TSP + sh, dist = DMAXI - j;
        tbl[e] = (j < TS && dist >= 0 && dist <= P.maxd) ? sb[t5_bucket(dist * P.rate)] : -1e30f;
    }
    asm volatile("" : "+v"(qf[0]), "+v"(qf[1]), "+v"(qf[2]), "+v"(qf[3]));
    f32x16 o[2]; o[0] = (f32x16){}; o[1] = (f32x16){};
    float den = 0.f;
    stage_write(lds + L_KV, sr, srow, sch);
    __syncthreads();
    for (int t = t0; t < ntl; ++t) {
        LAS unsigned char* buf = lds + L_KV + ((t - t0) & 1) * KVB;
        const int kf0 = P.f0 - KPREV + 64 * t;
        if (t + 1 < ntl) {
            const int kf = kf0 + 64 + srow;
            const bf16_t* rp = P.Hb + ((size_t)kf * P.rate + P.cls) * HP;
            stage_load(sr, rp + P.ck, rp + P.cv, true, sch);
        }
#pragma unroll
        for (int sub = 0; sub < 2; ++sub) {
            const int kfs = kf0 + 32 * sub;
            if (kfs <= fq0 + 31 && kfs + 31 >= fq0 - P.maxd) {
                const int jb = DMAXI - ((fq0 - kfs) + (lane & 31) - 4 * h);
                f32x16 acc = load_tab16(tbl, TSP, jb);
                qk_sub<0, 4>(acc, buf, sub, qf, lane);
#pragma unroll
                for (int r = 0; r < 1; ++r) den += exp_sum16(acc);
                bf16x8 pa0, pa1; pack_p(acc, pa0, pa1);
                pv_sub(o, buf, sub, pa0, pa1, lane);
            }
        }
        if (t + 1 < ntl) stage_write(lds + L_KV + ((t - t0 + 1) & 1) * KVB, sr, srow, sch);
        __syncthreads();
    }
    float dtot = den + __shfl_xor(den, 32);
    if (MODE == 1) dtot += P.sinkterm;
    LAS float* ws_ = (LAS float*)(lds + L_WSCR) + w * 64;
    if (h == 0) ws_[lane] = dtot;
    if (MODE == 0 && h == 0) {
        const size_t tq = (size_t)(fq0 + lane) * P.rate + P.cls;
        P.DA[(P.brow + tq) * 4 + P.hd] = dtot;
    }
    asm volatile("s_waitcnt lgkmcnt(0)" ::: "memory");
#pragma unroll
    for (int r = 0; r < 16; ++r) {
        const int qi = crow(r, h);
        const float inv = __builtin_amdgcn_rcpf(ws_[qi]);
        const size_t row = P.brow + (size_t)(fq0 + qi) * P.rate + P.cls;
#pragma unroll
        for (int dt = 0; dt < 2; ++dt) {
            const int d = 32 * dt + (lane & 31);
            const float val = o[dt][r] * inv;
            if (MODE == 0) P.OA[row * 256 + P.hd * 64 + d] = f2bf(val);
            else P.Y[row * DM + P.ycol + d] = f2bf(val * bf2f(P.Hb[(row - P.brow) * HP + C_SILU + P.ycol + d]));
        }
    }
}

__device__ __forceinline__ void diff_p1(const LAS float* tp, const LAS unsigned char* buf, int sub, const bf16x8* qf, int lane, bf16x8& pa0, bf16x8& pa1, bf16x8& pb0, bf16x8& pb1) {
    const f32x4 t0 = *(const LAS f32x4*)(tp), t1 = *(const LAS f32x4*)(tp + 8), t2 = *(const LAS f32x4*)(tp + 16), t3 = *(const LAS f32x4*)(tp + 24);
    const f32x16 T = (f32x16){t0[0], t0[1], t0[2], t0[3], t1[0], t1[1], t1[2], t1[3], t2[0], t2[1], t2[2], t2[3], t3[0], t3[1], t3[2], t3[3]};
    const int key = 32 * sub + (lane & 31), h = lane >> 5;
    const LAS unsigned char* kp = buf + key * 128;
    const bf16x8 k0 = *(const LAS bf16x8*)(kp + (((0 + h) ^ (key & 7)) << 4)), k1 = *(const LAS bf16x8*)(kp + (((2 + h) ^ (key & 7)) << 4));
    const bf16x8 k2 = *(const LAS bf16x8*)(kp + (((4 + h) ^ (key & 7)) << 4)), k3 = *(const LAS bf16x8*)(kp + (((6 + h) ^ (key & 7)) << 4));
    f32x16 a1 = __builtin_amdgcn_mfma_f32_32x32x16_bf16(k0, qf[0], T, 0, 0, 0);
    f32x16 a2 = __builtin_amdgcn_mfma_f32_32x32x16_bf16(k2, qf[2], T, 0, 0, 0);
    a1 = __builtin_amdgcn_mfma_f32_32x32x16_bf16(k1, qf[1], a1, 0, 0, 0);
    a2 = __builtin_amdgcn_mfma_f32_32x32x16_bf16(k3, qf[3], a2, 0, 0, 0);
#pragma unroll
    for (int r = 0; r < 16; ++r) { a1[r] = __builtin_amdgcn_exp2f(a1[r]); a2[r] = __builtin_amdgcn_exp2f(a2[r]); }
    pack_p(a1, pa0, pa1); pack_p(a2, pb0, pb1);
}
__device__ __forceinline__ void diff_p2(const LAS unsigned char* buf, int sub, int lane, const bf16x8& pa0, const bf16x8& pa1, const bf16x8& pb0, const bf16x8& pb1, f32x16& dn1, f32x16& dn2, f32x16* o1, f32x16* o2) {
    const bf16x8 ones = (bf16x8){0x3F80, 0x3F80, 0x3F80, 0x3F80, 0x3F80, 0x3F80, 0x3F80, 0x3F80};
    dn1 = __builtin_amdgcn_mfma_f32_32x32x16_bf16(pa0, ones, dn1, 0, 0, 0);
    dn2 = __builtin_amdgcn_mfma_f32_32x32x16_bf16(pb0, ones, dn2, 0, 0, 0);
    dn1 = __builtin_amdgcn_mfma_f32_32x32x16_bf16(pa1, ones, dn1, 0, 0, 0);
    dn2 = __builtin_amdgcn_mfma_f32_32x32x16_bf16(pb1, ones, dn2, 0, 0, 0);
    pv_sub2(o1, o2, buf, sub, pa0, pa1, pb0, pb1, lane);
}

struct DiffArgs {
    const bf16_t* Hb; int hd, qb; size_t brow;
    const float* bias; float M; float lam, lambda_init; const float* subln;
    bf16_t* Y;
};
constexpr int D_SB = 49152, D_TAB = 49664;
__device__ __forceinline__ void diff_unit(LAS unsigned char* lds, const DiffArgs& P) {
    const int tid = opq(threadIdx.x), lane = tid & 63, w = __builtin_amdgcn_readfirstlane(tid >> 6), h = lane >> 5;
    LAS float* sb = (LAS float*)(lds + D_SB);
    LAS float* tbl = (LAS float*)(lds + D_TAB);
    constexpr int DTOP = 1574, TS = DTOP + 63, TSP = (TS + 7) & ~3;
    __syncthreads();
    if (tid < 32) sb[tid] = (P.bias[tid * 16] - P.M) * LOG2E;
    __syncthreads();
    for (int e = tid; e < 4 * TSP; e += 512) {
        const int sh = e / TSP, j = e - sh * TSP + sh, dist = DTOP - j;
        tbl[e] = (j < TS && dist >= 0) ? sb[t5_bucket(dist)] : -1e30f;
    }
    LAS float* farc = tbl + 4 * TSP;
    LAS float* deadr = farc + 32;
    if (tid < 32) { farc[tid] = sb[31]; deadr[tid] = -1e30f; }
    const int q0w = P.qb * 256 + 32 * w;
    const int cq = C_CQ + 64 * P.hd, ck = C_CK + 64 * P.hd, cv = C_CV + 64 * P.hd;
    bf16x8 qf[4];
    {
        const bf16_t* qp = P.Hb + (size_t)(q0w + (lane & 31)) * HP + cq + 8 * h;
#pragma unroll
        for (int s = 0; s < 4; ++s) qf[s] = *(const bf16x8*)(qp + 16 * s);
        asm volatile("" : "+v"(qf[0]), "+v"(qf[1]), "+v"(qf[2]), "+v"(qf[3]));
    }
    const int ntl = 4 * (P.qb + 1);
    const int srow = tid >> 3, sch = tid & 7;
    f32x16 o1[2], o2[2]; o1[0] = (f32x16){}; o1[1] = (f32x16){}; o2[0] = (f32x16){}; o2[1] = (f32x16){};
    f32x16 dn1 = (f32x16){}, dn2 = (f32x16){};
    StageRegs sr;
    {
        const bf16_t* rp = P.Hb + (size_t)srow * HP;
        stage_load(sr, rp + ck, rp + cv, true, sch);
        stage_write(lds, sr, srow, sch);
    }
    __syncthreads();
#define DIFF_TP(KS) ({ const int ks_ = (KS); const int jb_ = DTOP - ((q0w - ks_) + (lane & 31) - 4 * h), sh_ = jb_ & 3; \
        const LAS float* tp_ = tbl + sh_ * TSP + (jb_ - sh_); tp_ = (q0w - ks_ - 31 >= 1513) ? farc : tp_; tp_ = (ks_ > q0w + 31) ? deadr : tp_; tp_; })
#define DIFF_STAGE_LOAD(t) do { const int tn_ = (t) + 1 < ntl ? (t) + 1 : (t); const bf16_t* rp_ = P.Hb + (size_t)(64 * tn_ + srow) * HP; stage_load(sr, rp_ + ck, rp_ + cv, true, sch); } while (0)
    if (w < 4) {
        int cur = 0;
        for (int t = 0; t < ntl; ++t) {
            LAS unsigned char* buf = lds + cur * KVB;
            const int nxt = cur == 2 ? 0 : cur + 1;
            DIFF_STAGE_LOAD(t);
            bf16x8 pa0, pa1, pb0, pb1;
            diff_p1(DIFF_TP(64 * t), buf, 0, qf, lane, pa0, pa1, pb0, pb1);
            diff_p2(buf, 0, lane, pa0, pa1, pb0, pb1, dn1, dn2, o1, o2);
            diff_p1(DIFF_TP(64 * t + 32), buf, 1, qf, lane, pa0, pa1, pb0, pb1);
            diff_p2(buf, 1, lane, pa0, pa1, pb0, pb1, dn1, dn2, o1, o2);
            stage_write(lds + nxt * KVB, sr, srow, sch);
            __syncthreads();
            cur = nxt;
        }
    } else {
        const bf16x8 zero8 = (bf16x8){0, 0, 0, 0, 0, 0, 0, 0};
        bf16x8 qa0 = zero8, qa1 = zero8, qb0 = zero8, qb1 = zero8;
        int cur = 0, prv = 0;
        __builtin_amdgcn_s_setprio(1);
        for (int t = 0; t < ntl; ++t) {
            LAS unsigned char* buf = lds + cur * KVB;
            const int nxt = cur == 2 ? 0 : cur + 1;
            DIFF_STAGE_LOAD(t);
            diff_p2(lds + prv * KVB, 1, lane, qa0, qa1, qb0, qb1, dn1, dn2, o1, o2);
            bf16x8 pa0, pa1, pb0, pb1;
            diff_p1(DIFF_TP(64 * t), buf, 0, qf, lane, pa0, pa1, pb0, pb1);
            diff_p2(buf, 0, lane, pa0, pa1, pb0, pb1, dn1, dn2, o1, o2);
            diff_p1(DIFF_TP(64 * t + 32), buf, 1, qf, lane, qa0, qa1, qb0, qb1);
            stage_write(lds + nxt * KVB, sr, srow, sch);
            __syncthreads();
            prv = cur; cur = nxt;
        }
        diff_p2(lds + prv * KVB, 1, lane, qa0, qa1, qb0, qb1, dn1, dn2, o1, o2);
        __builtin_amdgcn_s_setprio(0);
    }
    __syncthreads();
#undef DIFF_TP
#undef DIFF_STAGE_LOAD
    const float g0 = P.subln[lane & 31] * (1.f - P.lambda_init), g1 = P.subln[32 + (lane & 31)] * (1.f - P.lambda_init);
    const int ycol = 512 + 64 * P.hd;
#pragma unroll
    for (int r = 0; r < 16; ++r) {
        const int qi = crow(r, h);
        const float i1 = __builtin_amdgcn_rcpf(dn1[r]), i2 = P.lam * __builtin_amdgcn_rcpf(dn2[r]);
        const float a0 = o1[0][r] * i1 - o2[0][r] * i2, a1 = o1[1][r] * i1 - o2[1][r] * i2;
        float ss = a0 * a0 + a1 * a1;
        ss += __shfl_xor(ss, 1); ss += __shfl_xor(ss, 2); ss += __shfl_xor(ss, 4); ss += __shfl_xor(ss, 8); ss += __shfl_xor(ss, 16);
        const float rs = rsqrtf(ss * (1.f / 64.f) + 1e-6f);
        const size_t trow = (size_t)(q0w + qi);
        const bf16_t* sp = P.Hb + trow * HP + C_SILU + ycol;
        bf16_t* yp = P.Y + (P.brow + trow) * DM + ycol;
        yp[lane & 31] = f2bf(a0 * rs * g0 * bf2f(sp[lane & 31]));
        yp[32 + (lane & 31)] = f2bf(a1 * rs * g1 * bf2f(sp[32 + (lane & 31)]));
    }
}
struct CmpArgs {
    const bf16_t* Hb;
    int col;
    int rt;
    const float* pos;
    const bf16_t* W1T;
    const float* b1;
    const bf16_t* W2T;
    const float* b2;
    const float* gain;
    bf16_t* OUT;
};
__device__ __forceinline__ void cmp_unit(LAS unsigned char* lds, const CmpArgs& P) {
    const int tid = opq(threadIdx.x), lane = tid & 63, w = __builtin_amdgcn_readfirstlane(tid >> 6), h = lane >> 5;
    LAS unsigned char* hidl = lds + L_KV;
    LAS float* ssx = (LAS float*)(lds + L_KV + 32768 - 512);
    LAS unsigned char* abuf = lds + L_TAB;
    f32x16 acc = (f32x16){};
    const bf16_t* w1p = P.W1T + (size_t)w * (8 * 16 * 64 * 8) + lane * 8;
    u32x4 araw[2]; f32x4 apos[2][2];
#define CMP_ALOAD(ch) do { _Pragma("unroll") for (int q_ = 0; q_ < 2; ++q_) { const int p_ = tid + 512 * q_, row_ = p_ >> 5, kc_ = p_ & 31; \
        int ir_ = 32 * P.rt + row_; if (ir_ > 510) ir_ = 510; const int tok_ = 4 * (ch) + (kc_ >> 3), d_ = 8 * (kc_ & 7); \
        araw[q_] = *(const u32x4*)(P.Hb + (size_t)(16 * ir_ + tok_) * HP + P.col + d_); \
        apos[q_][0] = *(const f32x4*)(P.pos + tok_ * 64 + d_); apos[q_][1] = *(const f32x4*)(P.pos + tok_ * 64 + d_ + 4); } } while (0)
#define CMP_AWRITE(bufi) do { _Pragma("unroll") for (int q_ = 0; q_ < 2; ++q_) { const int p_ = tid + 512 * q_, row_ = p_ >> 5, kc_ = p_ & 31; u32x4 aw_; \
        aw_.x = cvtpk(__uint_as_float(araw[q_].x << 16) + apos[q_][0][0], __uint_as_float(araw[q_].x & 0xffff0000u) + apos[q_][0][1]); \
        aw_.y = cvtpk(__uint_as_float(araw[q_].y << 16) + apos[q_][0][2], __uint_as_float(araw[q_].y & 0xffff0000u) + apos[q_][0][3]); \
        aw_.z = cvtpk(__uint_as_float(araw[q_].z << 16) + apos[q_][1][0], __uint_as_float(araw[q_].z & 0xffff0000u) + apos[q_][1][1]); \
        aw_.w = cvtpk(__uint_as_float(araw[q_].w << 16) + apos[q_][1][2], __uint_as_float(araw[q_].w & 0xffff0000u) + apos[q_][1][3]); \
        *(LAS u32x4*)(abuf + (bufi) * 16896 + row_ * 528 + kc_ * 16) = aw_; } } while (0)
    CMP_ALOAD(0); CMP_AWRITE(0);
    __syncthreads();
    for (int ch = 0; ch < 8; ++ch) {
        const int cn = ch + 1 < 8 ? ch + 1 : ch;
        CMP_ALOAD(cn);
        const LAS unsigned char* ab = abuf + (ch & 1) * 16896 + (lane & 31) * 528 + 16 * h;
        bf16x8 bfr[16];
#pragma unroll
        for (int ks = 0; ks < 16; ++ks) bfr[ks] = *(const bf16x8*)(w1p + (ch * 16 + ks) * 512);
#pragma unroll
        for (int ks = 0; ks < 16; ++ks) {
            const bf16x8 af = *(const LAS bf16x8*)(ab + 32 * ks);
            acc = __builtin_amdgcn_mfma_f32_32x32x16_bf16(af, bfr[ks], acc, 0, 0, 0);
        }
        CMP_AWRITE((ch + 1) & 1);
        __syncthreads();
    }
#undef CMP_ALOAD
#undef CMP_AWRITE
    {
        const int j = 32 * w + (lane & 31); const float bb = P.b1[j];
#pragma unroll
        for (int r = 0; r < 16; ++r) {
            const float x = acc[r] + bb;
            const float u = 0.7978845608028654f * (x + 0.044715f * x * x * x);
            const float th = 1.f - 2.f / (1.f + __expf(2.f * u));
            const float gl = 0.5f * x * (1.f + th);
            *(LAS bf16_t*)(hidl + crow(r, h) * 528 + j * 2) = f2bf(gl);
        }
    }
    __syncthreads();
    float outv[16]; float ssp[16];
    if (w < 2) {
        f32x16 a2 = (f32x16){};
        const bf16_t* w2p = P.W2T + (size_t)(32 * w + (lane & 31)) * 256 + 8 * h;
#pragma unroll
        for (int ks = 0; ks < 16; ++ks) {
            const bf16x8 af = *(const LAS bf16x8*)(hidl + (lane & 31) * 528 + (16 * ks + 8 * h) * 2);
            const bf16x8 bfr = *(const bf16x8*)(w2p + 16 * ks);
            a2 = __builtin_amdgcn_mfma_f32_32x32x16_bf16(af, bfr, a2, 0, 0, 0);
        }
        const float bb = P.b2[32 * w + (lane & 31)];
#pragma unroll
        for (int r = 0; r < 16; ++r) {
            outv[r] = a2[r] + bb;
            float ss = outv[r] * outv[r];
            ss += __shfl_xor(ss, 1); ss += __shfl_xor(ss, 2); ss += __shfl_xor(ss, 4); ss += __shfl_xor(ss, 8); ss += __shfl_xor(ss, 16);
            ssp[r] = ss;
            if ((lane & 31) == 0) ssx[w * 32 + crow(r, h)] = ss;
        }
    }
    __syncthreads();
    if (w < 2) {
        const int d = 32 * w + (lane & 31);
        const float gn = P.gain ? P.gain[d] : 1.f;
#pragma unroll
        for (int r = 0; r < 16; ++r) {
            const int row = 32 * P.rt + crow(r, h);
            float v = outv[r];
            if (P.gain) { const float tot = ssx[crow(r, h)] + ssx[32 + crow(r, h)]; v = v * rsqrtf(tot * (1.f / 64.f) + 1e-6f) * gn; }
            if (row <= 510) P.OUT[(size_t)row * 64 + d] = f2bf(v);
        }
    }
    __syncthreads();
}

struct NsaArgs {
    const bf16_t* Hb; size_t brow; int qb;
    const bf16_t* KC; const bf16_t* VC;
    const float* bias;
    const float* Mv;
    bf16_t* Y; unsigned* cdone;
};
constexpr int GTOP = 2015, GTS = 2519, WTOP = 549, WTS = 588, DEAD = 4 * GTS + 4 * WTS;
__device__ __forceinline__ void nsa_unit(LAS unsigned char* lds, const NsaArgs& P) {
    const int tid = opq(threadIdx.x), lane = tid & 63, w = __builtin_amdgcn_readfirstlane(tid >> 6), hh = lane >> 5;
    const int n = lane & 31, q8 = n >> 2, hd = n & 3;
    LAS float* tg = (LAS float*)(lds + L_TAB);
    LAS float* tw = tg + 4 * GTS;
    LAS float* dead = tg + DEAD;
    LAS float* impw = (LAS float*)(lds + L_IMP) + w * 1024;
    LAS unsigned* selw = (LAS unsigned*)(lds + L_SEL) + w * 32;
    LAS unsigned* uni = (LAS unsigned*)(lds + L_SEL) + 256;
    LAS float* ws_ = (LAS float*)(lds + L_WSCR) + w * 256;
    LAS float* sbh = (LAS float*)(lds + L_SB);
    if (tid < 128) sbh[tid] = (P.bias[(tid & 31) * 16 + (tid >> 5)] - P.Mv[tid >> 5]) * LOG2E;
    __syncthreads();
    for (int e = tid; e < 4 * GTS; e += 512) { const int hq = e / GTS, j = e % GTS, dist = GTOP - j;
        tg[e] = dist >= 0 ? sbh[hq * 32 + t5_bucket(dist)] : -1e30f; }
    for (int e = tid; e < 4 * WTS; e += 512) { const int hq = e / WTS, j = e % WTS, dist = WTOP - j;
        tw[e] = (dist >= 0 && dist <= 511) ? sbh[hq * 32 + t5_bucket(dist)] : -1e30f; }
    if (tid < 64) dead[tid] = -1e30f;
    for (int e = lane; e < 1024; e += 64) impw[e] = 0.f;
    if (tid < 4) uni[tid] = 0u;
    const float cfar = sbh[hd * 32 + 31];
    const int tq = 64 * P.qb + 8 * w + q8;
    const int twmin = 64 * P.qb + 8 * w, twmax = twmin + 7;
    bf16x8 qf[4];
    {
        const bf16_t* qp = P.Hb + (size_t)tq * HP + C_DQ + 64 * hd + 8 * hh;
#pragma unroll
        for (int s = 0; s < 4; ++s) qf[s] = *(const bf16x8*)(qp + 16 * s);
        asm volatile("" : "+v"(qf[0]), "+v"(qf[1]), "+v"(qf[2]), "+v"(qf[3]));
    }
    {
        const bf16_t* gp = P.Hb + (size_t)tq * HP + C_GT + 3 * hd;
        if (hh == 0) { ws_[n] = bf2f(gp[0]); ws_[32 + n] = bf2f(gp[1]); ws_[64 + n] = bf2f(gp[2]); }
    }
    const int srow = tid >> 3, sch = tid & 7;
    StageRegs sr;
    f32x16 o[2], outv[2];
    float den = 0.f;
    o[0] = (f32x16){}; o[1] = (f32x16){};
    {
        const int kt0 = P.qb >= 8 ? P.qb - 8 : 0, nkt = P.qb - kt0 + 1;
        {
            const bf16_t* rp = P.Hb + (size_t)(64 * kt0 + srow) * HP;
            stage_load(sr, rp + C_KW, rp + C_VW, true, sch);
            stage_write(lds + L_KV, sr, srow, sch);
        }
        __syncthreads();
        for (int t = 0; t < nkt; ++t) {
            LAS unsigned char* buf = lds + L_KV + (t & 1) * KVB;
            if (t + 1 < nkt) { const bf16_t* rp = P.Hb + (size_t)(64 * (kt0 + t + 1) + srow) * HP; stage_load(sr, rp + C_KW, rp + C_VW, true, sch); }
#pragma unroll
            for (int sub = 0; sub < 2; ++sub) {
                const int kb = 64 * (kt0 + t) + 32 * sub;
                if (kb <= twmax && kb + 31 >= twmin - 511) {
                    f32x16 acc;
                    const LAS float* tb = tw + hd * WTS + (WTOP - (tq - kb - 4 * hh));
#pragma unroll
                    for (int r = 0; r < 16; ++r) acc[r] = tb[(r & 3) + 8 * (r >> 2)];
                    qk_sub<0, 4>(acc, buf, sub, qf, lane);
#pragma unroll
                    for (int r = 0; r < 1; ++r) den += exp_sum16(acc);
                    bf16x8 pa0, pa1; pack_p(acc, pa0, pa1);
                    pv_sub(o, buf, sub, pa0, pa1, lane);
                }
            }
            if (t + 1 < nkt) stage_write(lds + L_KV + ((t + 1) & 1) * KVB, sr, srow, sch);
            __syncthreads();
        }
    }
    {
        const float dt = den + __shfl_xor(den, 32);
        if (hh == 0) ws_[128 + n] = __builtin_amdgcn_rcpf(dt);
        asm volatile("s_waitcnt lgkmcnt(0)" ::: "memory");
#pragma unroll
        for (int r = 0; r < 16; ++r) { const int nn = crow(r, hh); const float gi = ws_[64 + nn] * ws_[128 + nn]; outv[0][r] = o[0][r] * gi; outv[1][r] = o[1][r] * gi; }
    }
    if (opq(threadIdx.x) == 128) {
        unsigned sp = 0;
        while (__hip_atomic_load(P.cdone, __ATOMIC_RELAXED, __HIP_MEMORY_SCOPE_AGENT) < 64u) { __builtin_amdgcn_s_sleep(2); if (++sp > (1u << 24)) break; }
        __builtin_amdgcn_fence(__ATOMIC_ACQUIRE, "agent"); asm volatile("s_waitcnt vmcnt(0)" ::: "memory");
    }
    __syncthreads();
    const int tlast = 64 * P.qb + 63;
    const int ntc = tlast >= 31 ? (((tlast - 31) >> 4) >> 6) + 1 : 0;
    float invden = 0.f; den = 0.f;
    o[0] = (f32x16){}; o[1] = (f32x16){};
    for (int pass = 0; pass < 2; ++pass) {
        if (ntc > 0) {
            __syncthreads();
            stage_load(sr, P.KC + (size_t)srow * 64, P.VC + (size_t)srow * 64, true, sch);
            stage_write(lds + L_KV, sr, srow, sch);
            __syncthreads();
            for (int t = 0; t < ntc; ++t) {
                LAS unsigned char* buf = lds + L_KV + (t & 1) * KVB;
                if (t + 1 < ntc) stage_load(sr, P.KC + (size_t)(64 * (t + 1) + srow) * 64, P.VC + (size_t)(64 * (t + 1) + srow) * 64, true, sch);
#pragma unroll
                for (int sub = 0; sub < 2; ++sub) {
                    const int cb = 64 * t + 32 * sub;
                    if (16 * cb + 31 <= twmax) {
                        f32x16 acc;
                        const int dmin = twmin - 16 * (cb + 31) - 31;
                        if (dmin >= 1513) acc = splat16(cfar);
                        else {
                            const LAS float* tb = tg + hd * GTS + (GTOP - (tq - 31 - 16 * cb - 64 * hh));
#pragma unroll
                            for (int r = 0; r < 16; ++r) acc[r] = tb[16 * ((r & 3) + 8 * (r >> 2))];
                        }
                        qk_sub<0, 4>(acc, buf, sub, qf, lane);
#pragma unroll
                        for (int r = 0; r < 16; ++r) acc[r] = __builtin_amdgcn_exp2f(acc[r]);
                        if (pass == 0) {
#pragma unroll
                            for (int r = 0; r < 16; ++r) { den += acc[r]; asm volatile("" : "+v"(den)); }
                        } else {
#pragma unroll
                            for (int r = 0; r < 16; ++r) acc[r] *= invden;
#pragma unroll
                            for (int g = 0; g < 4; ++g) {
                                float G = (acc[4 * g] + acc[4 * g + 1]) + (acc[4 * g + 2] + acc[4 * g + 3]), C = acc[4 * g + 3];
                                G += __shfl_xor(G, 1); G += __shfl_xor(G, 2); C += __shfl_xor(C, 1); C += __shfl_xor(C, 2);
                                if (hd == 0) {
                                    const int j = (cb >> 2) + 2 * g + hh;
                                    __hip_atomic_fetch_add(impw + q8 * 128 + j, G, __ATOMIC_RELAXED, __HIP_MEMORY_SCOPE_WORKGROUP);
                                    if (j + 1 < 128) __hip_atomic_fetch_add(impw + q8 * 128 + j + 1, C, __ATOMIC_RELAXED, __HIP_MEMORY_SCOPE_WORKGROUP);
                                }
                            }
                            bf16x8 pa0, pa1; pack_p(acc, pa0, pa1);
                            pv_sub(o, buf, sub, pa0, pa1, lane);
                        }
                    }
                }
                if (t + 1 < ntc) stage_write(lds + L_KV + ((t + 1) & 1) * KVB, sr, srow, sch);
                __syncthreads();
            }
        }
        if (pass == 0) { const float dt = den + __shfl_xor(den, 32); invden = dt > 0.f ? 1.f / dt : 0.f; }
    }
    asm volatile("s_waitcnt lgkmcnt(0)" ::: "memory");
#pragma unroll
    for (int r = 0; r < 16; ++r) { const float g0 = ws_[crow(r, hh)]; outv[0][r] += o[0][r] * g0; outv[1][r] += o[1][r] * g0; }
    {
        const int qsel = lane >> 3, sb = lane & 7;
        unsigned key[16];
#pragma unroll
        for (int i4 = 0; i4 < 4; ++i4) {
            const f32x4 v = *(const LAS f32x4*)(impw + qsel * 128 + sb * 16 + 4 * i4);
#pragma unroll
            for (int e = 0; e < 4; ++e) {
                const int j = sb * 16 + 4 * i4 + e;
                const bool forced = (j == 0) | (j == P.qb) | (j == P.qb - 1);
                key[4 * i4 + e] = forced ? 0xFFFFFFFFu : (j <= P.qb ? __float_as_uint(v[e]) + 1u : 0u);
            }
        }
        unsigned T = 0u;
        for (int bit = 31; bit >= 0; --bit) {
            const unsigned cand = T | (1u << bit);
            int cnt = 0;
#pragma unroll
            for (int i = 0; i < 16; ++i) cnt += key[i] >= cand ? 1 : 0;
            cnt += __shfl_xor(cnt, 1); cnt += __shfl_xor(cnt, 2); cnt += __shfl_xor(cnt, 4);
            if (cnt >= 16) T = cand;
        }
        int cgt = 0, ceq = 0;
#pragma unroll
        for (int i = 0; i < 16; ++i) { cgt += key[i] > T ? 1 : 0; ceq += key[i] == T ? 1 : 0; }
        int cg = cgt; cg += __shfl_xor(cg, 1); cg += __shfl_xor(cg, 2); cg += __shfl_xor(cg, 4);
        int pre = 0;
#pragma unroll
        for (int k = 0; k < 8; ++k) { const int v = __shfl(ceq, (lane & ~7) + k); if (k < sb) pre += v; }
        int need = 16 - cg - pre;
        unsigned bits = 0u;
#pragma unroll
        for (int i = 0; i < 16; ++i) {
            const int j = sb * 16 + i;
            bool s_ = key[i] > T;
            if (key[i] == T) { if (need > 0) { s_ = true; } --need; }
            if (s_ && j <= P.qb) bits |= 1u << i;
        }
        const unsigned other = __shfl_xor(bits, 1);
        const unsigned word = (sb & 1) ? ((bits << 16) | other) : (bits | (other << 16));
        if ((sb & 1) == 0) { selw[qsel * 4 + (sb >> 1)] = word; __hip_atomic_fetch_or(uni + (sb >> 1), word, __ATOMIC_RELAXED, __HIP_MEMORY_SCOPE_WORKGROUP); }
    }
    __syncthreads();
    unsigned lm0 = selw[q8 * 4 + 0], lm1 = selw[q8 * 4 + 1], lm2 = selw[q8 * 4 + 2], lm3 = selw[q8 * 4 + 3];
    unsigned wm0 = 0, wm1 = 0, wm2 = 0, wm3 = 0;
#pragma unroll
    for (int k = 0; k < 8; ++k) { wm0 |= selw[k * 4 + 0]; wm1 |= selw[k * 4 + 1]; wm2 |= selw[k * 4 + 2]; wm3 |= selw[k * 4 + 3]; }
    wm0 = __builtin_amdgcn_readfirstlane(wm0); wm1 = __builtin_amdgcn_readfirstlane(wm1); wm2 = __builtin_amdgcn_readfirstlane(wm2); wm3 = __builtin_amdgcn_readfirstlane(wm3);
    const unsigned um0 = __builtin_amdgcn_readfirstlane(uni[0]), um1 = __builtin_amdgcn_readfirstlane(uni[1]), um2 = __builtin_amdgcn_readfirstlane(uni[2]), um3 = __builtin_amdgcn_readfirstlane(uni[3]);
#define NSA_WORD(a0, a1, a2, a3, j) ((j) < 32 ? (a0) : ((j) < 64 ? (a1) : ((j) < 96 ? (a2) : (a3))))
#define NSA_NEXT(j, res) do { int _j = (j); res = 128; while (_j < 128) { const unsigned _w = NSA_WORD(um0, um1, um2, um3, _j) >> (_j & 31); if (_w) { res = _j + __builtin_ctz(_w); break; } _j = (_j | 31) + 1; } } while (0)
    o[0] = (f32x16){}; o[1] = (f32x16){}; den = 0.f;
#define NSA_SLC_COMPUTE(JJ, BUF) do { \
        if ((NSA_WORD(wm0, wm1, wm2, wm3, (JJ)) >> ((JJ) & 31)) & 1u) { \
            const bool lsel = (NSA_WORD(lm0, lm1, lm2, lm3, (JJ)) >> ((JJ) & 31)) & 1u; \
            _Pragma("unroll") for (int sub = 0; sub < 2; ++sub) { \
                const int kb = 64 * (JJ) + 32 * sub; \
                if (kb <= twmax) { \
                    f32x16 acc; \
                    if (twmin - kb - 31 >= 1513) acc = splat16(lsel ? cfar : -1e30f); \
                    else { const LAS float* tb = lsel ? tg + hd * GTS + (GTOP - (tq - kb - 4 * hh)) : dead; \
                        _Pragma("unroll") for (int r = 0; r < 16; ++r) acc[r] = tb[(r & 3) + 8 * (r >> 2)]; } \
                    qk_sub<0, 4>(acc, (BUF), sub, qf, lane); \
                    den += exp_sum16(acc); \
                    bf16x8 pa0, pa1; pack_p(acc, pa0, pa1); \
                    pv_sub(o, (BUF), sub, pa0, pa1, lane); \
                } } } } while (0)
#define NSA_SLC_LOAD(JJ, SR) do { const bf16_t* rp_ = P.Hb + (size_t)(64 * (JJ) + srow) * HP; stage_load(SR, rp_ + C_KS, rp_ + C_VS, true, sch); } while (0)
    {
        StageRegs srB;
        LAS unsigned char* pb0 = lds + L_KV; LAS unsigned char* pb1 = lds + L_IMP;
        int ja, jb2; NSA_NEXT(0, ja); jb2 = 128; if (ja < 128) { NSA_NEXT(ja + 1, jb2); }
        if (ja < 128) { NSA_SLC_LOAD(ja, sr); stage_write(pb0, sr, srow, sch); }
        if (jb2 < 128) { NSA_SLC_LOAD(jb2, srB); stage_write(pb0 + KVB, srB, srow, sch); }
        __syncthreads();
        int p = 0;
        while (ja < 128) {
            LAS unsigned char* cb = p ? pb1 : pb0; LAS unsigned char* nbuf = p ? pb0 : pb1;
            int na = 128, nb = 128;
            if (jb2 < 128) { NSA_NEXT(jb2 + 1, na); }
            if (na < 128) { NSA_NEXT(na + 1, nb); }
            if (na < 128) NSA_SLC_LOAD(na, sr);
            if (nb < 128) NSA_SLC_LOAD(nb, srB);
            NSA_SLC_COMPUTE(ja, cb);
            if (jb2 < 128) NSA_SLC_COMPUTE(jb2, cb + KVB);
            if (na < 128) stage_write(nbuf, sr, srow, sch);
            if (nb < 128) stage_write(nbuf + KVB, srB, srow, sch);
            __syncthreads();
            ja = na; jb2 = nb; p ^= 1;
        }
    }
#undef NSA_SLC_COMPUTE
#undef NSA_SLC_LOAD
    {
        const float dt = den + __shfl_xor(den, 32);
        if (hh == 0) ws_[96 + n] = 1.f / dt;
        asm volatile("s_waitcnt lgkmcnt(0)" ::: "memory");
#pragma unroll
        for (int r = 0; r < 16; ++r) { const float gi = ws_[32 + crow(r, hh)] * ws_[96 + crow(r, hh)]; outv[0][r] += o[0][r] * gi; outv[1][r] += o[1][r] * gi; }
    }
    {
#pragma unroll
        for (int r = 0; r < 16; ++r) {
            const int nn = crow(r, hh);
            const size_t trow = (size_t)(64 * P.qb + 8 * w + (nn >> 2));
            const int ycol = 768 + 64 * (nn & 3);
            const bf16_t* sp = P.Hb + trow * HP + C_SILU + ycol;
            bf16_t* yp = P.Y + (P.brow + trow) * DM + ycol;
            yp[n] = f2bf(outv[0][r] * bf2f(sp[n]));
            yp[32 + n] = f2bf(outv[1][r] * bf2f(sp[32 + n]));
        }
    }
    __syncthreads();
#undef NSA_WORD
#undef NSA_NEXT
}
}

#define XB_TMO      128
#define XB_XCNT(j)  (256  + 64 * (j))
#define XB_XSUB(j)  (1280 + 64 * (j))
#define XB_XGEN(j)  (2304 + 64 * (j))
#define XB_TOP      3328
#define XB_TOPGEN   3392
#define XCD_BAR_WORDS 3456
#define XB_SPIN_CAP (1u << 22)
__device__ __forceinline__ unsigned xb_ld(unsigned* p)              { return __hip_atomic_load(p, __ATOMIC_RELAXED, __HIP_MEMORY_SCOPE_AGENT); }
__device__ __forceinline__ unsigned xb_add(unsigned* p, unsigned v) { return __hip_atomic_fetch_add(p, v, __ATOMIC_RELAXED, __HIP_MEMORY_SCOPE_AGENT); }
__device__ __forceinline__ unsigned xb_xcc_id() { return (unsigned)__builtin_amdgcn_s_getreg((3 << 11) | 20) & 0xFu; }
#define XB_SPIN(cond, bar) do { unsigned _sp = 0; while (cond) { __builtin_amdgcn_s_sleep(1); \
    if ((++_sp & 255u) == 0u) { if (xb_ld(&(bar)[XB_TMO])) break; if (_sp > XB_SPIN_CAP) { atomicAdd(&(bar)[XB_TMO], 1u); break; } } } } while (0)
struct XcdBarrier { unsigned* bar; unsigned x; volatile LAS unsigned* st; };
__device__ __forceinline__ XcdBarrier xcd_barrier_post(unsigned* bar, volatile LAS unsigned* st) {
    XcdBarrier b; b.bar = bar; b.x = xb_xcc_id(); b.st = st;
    if (threadIdx.x == 0) (void)xb_add(&bar[XB_XCNT(b.x)], 1u);
    return b;
}
__device__ __forceinline__ void xcd_barrier_complete(unsigned* bar, unsigned x, unsigned& nloc, unsigned& nx) {
    const unsigned G = gridDim.x * gridDim.y * gridDim.z;
    unsigned sum, cnt, mine, sp = 0u;
    for (;;) {
        sum = 0u; cnt = 0u; mine = 0u;
#pragma unroll
        for (unsigned j = 0; j < 16; ++j) { const unsigned c = xb_ld(&bar[XB_XCNT(j)]); sum += c; cnt += (c > 0u) ? 1u : 0u; mine = (j == x) ? c : mine; }
        if (sum == G) break;
        __builtin_amdgcn_s_sleep(1);
        if ((++sp & 255u) == 0u) { if (xb_ld(&bar[XB_TMO])) break; if (sp > XB_SPIN_CAP) { atomicAdd(&bar[XB_TMO], 1u); break; } }
    }
    nloc = mine > 0u ? mine : 1u; nx = cnt > 0u ? cnt : 1u;
}
__device__ __forceinline__ void xcd_barrier(const XcdBarrier& b) {
    asm volatile("s_waitcnt vmcnt(0)" ::: "memory");
    __syncthreads();
    if (threadIdx.x == 0) {
        unsigned* bar = b.bar;
        __builtin_amdgcn_s_waitcnt(0);
        unsigned nloc = b.st[0], nx = b.st[1];
        if (nloc == 0u) { xcd_barrier_complete(bar, b.x, nloc, nx); b.st[0] = nloc; b.st[1] = nx; }
        const unsigned old = xb_add(&bar[XB_XSUB(b.x)], 1u);
        const unsigned gen = old / nloc;
        if (old + 1u == (gen + 1u) * nloc) {
            __builtin_amdgcn_fence(__ATOMIC_RELEASE, "agent");
            asm volatile("s_waitcnt vmcnt(0)" ::: "memory");
            const unsigned og = xb_add(&bar[XB_TOP], 1u);
            const unsigned tg = og / nx;
            if (og + 1u == (tg + 1u) * nx) xb_add(&bar[XB_TOPGEN], 1u);
            else XB_SPIN(xb_ld(&bar[XB_TOPGEN]) == tg, bar);
            __builtin_amdgcn_fence(__ATOMIC_ACQUIRE, "agent");
            xb_add(&bar[XB_XGEN(b.x)], 1u);
            asm volatile("s_waitcnt vmcnt(0)" ::: "memory");
        } else {
            XB_SPIN(xb_ld(&bar[XB_XGEN(b.x)]) == gen, bar);
            __builtin_amdgcn_fence(__ATOMIC_ACQUIRE, "agent");
            asm volatile("s_waitcnt vmcnt(0)" ::: "memory");
        }
    }
    __syncthreads();
}

constexpr int NT = 512, LDS_BYTES = 147456, MISC_OFF = 131072 + 320;
#ifndef R_C
#define R_C 1
#endif
#ifndef R_D
#define R_D 1
#endif
#ifndef R_AB
#define R_AB 1
#endif
#ifndef R_G1
#define R_G1 1
#endif
constexpr size_t MiB = 1u << 20;
constexpr size_t WS_CTL = 0, CTL_ZERO_BYTES = 65536;
constexpr size_t WS_H = 2 * MiB, WS_XN = 124 * MiB, WS_T0 = 158 * MiB, WS_IMP = 208 * MiB, WS_SEL = 217 * MiB, WS_HID = 218 * MiB, WS_KC = 221 * MiB, WS_VC = 222 * MiB, WS_WIN = 224 * MiB, WS_WOUT = 240 * MiB, WS_MX = 1 * MiB, WS_DA = 245 * MiB, WS_CW1 = 246 * MiB, WS_CW2 = 250 * MiB, WS_RSS = 251 * MiB;

struct Args { const float* in[15]; float* out; unsigned char* ws; };

__global__ void __launch_bounds__(NT, 2) mega_fwd(Args args) {
    extern __shared__ __attribute__((aligned(16))) unsigned char lds[];
    const int tid = threadIdx.x, lane = tid & 63, wid = tid >> 6;
    const int G = gridDim.x, bid = blockIdx.x;
    volatile LAS unsigned* MISC = (volatile LAS unsigned*)((LAS unsigned char*)lds + MISC_OFF);
    if (tid < 32) MISC[tid] = 0u;
    __syncthreads();
    unsigned char* ws = args.ws;
    XcdBarrier bar = xcd_barrier_post((unsigned*)(ws + WS_CTL) + 4096, MISC + 8);
    const float* x = args.in[0]; const float* tab = args.in[1]; const float* norm_w = args.in[2];
    const float* w_in = args.in[3]; const float* w_out = args.in[4]; const float* qk_gain = args.in[5];
    const float* qk_gain_diff = args.in[6]; const float* sinks = args.in[7]; const float* diff_lambda = args.in[8];
    const float* diff_subln = args.in[9]; const float* cmp_pos = args.in[10]; const float* cmp_w1 = args.in[11];
    const float* cmp_b1 = args.in[12]; const float* cmp_w2 = args.in[13]; const float* cmp_b2 = args.in[14];
    float* out = args.out;
    bf16_t* H = (bf16_t*)(ws + WS_H);
    bf16_t* XN = (bf16_t*)(ws + WS_XN); bf16_t* Y = XN;
    float* T0 = (float*)(ws + WS_T0);
    float* OC = T0; float* OS_ = T0 + (size_t)MROWS * 256; float* OW = T0 + (size_t)MROWS * 512; float* CT = T0;
    float* IMP = (float*)(ws + WS_IMP); unsigned* SEL = (unsigned*)(ws + WS_SEL); float* HID = (float*)(ws + WS_HID);
    float* KC = (float*)(ws + WS_KC); float* VC = (float*)(ws + WS_VC);
    const int GT = G * NT, GW = G * 8;
    bf16_t* WinT = (bf16_t*)(ws + WS_WIN); bf16_t* WoutT = (bf16_t*)(ws + WS_WOUT);
#define GRID_BAR() do { XcdBarrier b2_ = bar; asm volatile("" : "+s"(b2_.x)); xcd_barrier(b2_); } while (0)
    {
        LAS float* scr = (LAS float*)((LAS unsigned char*)lds + wid * 16384);
        const int gw0 = bid * 8 + wid;
        constexpr int I_IN = 16 * 120, I_OUT = 16 * 32, I_C1 = 32 * 8, I_C2 = 4 * 2, I_L = I_IN + I_OUT + 2 * I_C1 + 2 * I_C2, NITEMS = 2 * I_L;
        bf16_t* CW1T = (bf16_t*)(ws + WS_CW1); bf16_t* CW2T = (bf16_t*)(ws + WS_CW2);
        for (int it = gw0; it < NITEMS; it += GW) {
            const int l = it / I_L; int r = it % I_L;
            if (r < I_IN) { p0_transpose_item<0>(w_in + (size_t)l * DM * PW, WinT + (size_t)l * HP * DM, scr, r, lane); continue; } r -= I_IN;
            if (r < I_OUT) { p0_transpose_item<1>(w_out + (size_t)l * DM * DM, WoutT + (size_t)l * DM * DM, scr, r, lane); continue; } r -= I_OUT;
            if (r < 2 * I_C1) { const int kv = r / I_C1; p0_transpose_item<2>(cmp_w1 + (size_t)(l * 2 + kv) * 2048 * 256, CW1T + (size_t)(l * 2 + kv) * 256 * 2048, scr, r % I_C1, lane, 2048, 256); continue; } r -= 2 * I_C1;
            { const int kv = r / I_C2; p0_transpose_item<1>(cmp_w2 + (size_t)(l * 2 + kv) * 256 * 64, CW2T + (size_t)(l * 2 + kv) * 64 * 256, scr, r % I_C2, lane, 256, 64); }
        }
        if (bid == 1 && tid < 256) { bf16_t* KCb = (bf16_t*)(ws + WS_KC); KCb[(size_t)(tid >> 6) * 512 * 64 + 511 * 64 + (tid & 63)] = 0; }
        for (int w = gw0; w < MROWS; w += GW) k_rmsnorm(w, lane, x, norm_w, XN);
        for (int v = bid * NT + tid; v < MROWS; v += GT) ((unsigned long long*)(ws + WS_RSS))[v] = 0ull;
        if (bid == 0 && wid == 0) {
            float* MX = (float*)(ws + WS_MX);
            for (int l = 0; l < 2; ++l) {
                float mg[8];
#pragma unroll
                for (int i = 0; i < 8; ++i) { float v = fabsf(qk_gain[l * 512 + i * 64 + lane]);
#pragma unroll
                    for (int o = 1; o < 64; o <<= 1) v = fmaxf(v, __shfl_xor(v, o));
                    mg[i] = v; }
                float md0 = lane < 32 ? fabsf(qk_gain_diff[l * 64 + lane]) : 0.f, md1 = lane < 32 ? fabsf(qk_gain_diff[l * 64 + 32 + lane]) : 0.f;
#pragma unroll
                for (int o = 1; o < 64; o <<= 1) { md0 = fmaxf(md0, __shfl_xor(md0, o)); md1 = fmaxf(md1, __shfl_xor(md1, o)); }
                for (int gh = 0; gh < 16; ++gh) {
                    float mb = lane < 32 ? fabsf(tab[lane * 16 + gh]) : 0.f;
#pragma unroll
                    for (int o = 1; o < 64; o <<= 1) mb = fmaxf(mb, __shfl_xor(mb, o));
                    const int grp = gh >> 2, hh = gh & 3; float Mv;
                    if (grp == 0) Mv = 8.f * mg[0] * mg[1] + mb;
                    else if (grp == 1) Mv = fmaxf(8.f * mg[2] * mg[3] + mb, sinks[l * 4 + hh]);
                    else if (grp == 2) Mv = 5.656854249f * md0 * md1 + mb;
                    else Mv = 8.f * mg[4] * fmaxf(mg[5], fmaxf(mg[6], mg[7])) + mb;
                    if (lane == 0) MX[l * 16 + gh] = Mv;
                }
                float s1 = lane < 32 ? diff_lambda[l * 128 + lane] * diff_lambda[l * 128 + 32 + lane] : 0.f;
                float s2 = lane < 32 ? diff_lambda[l * 128 + 64 + lane] * diff_lambda[l * 128 + 96 + lane] : 0.f;
#pragma unroll
                for (int o = 1; o < 64; o <<= 1) { s1 += __shfl_xor(s1, o); s2 += __shfl_xor(s2, o); }
                const float lambda_init = 0.8f - 0.6f * expf(-0.3f * (float)l);
                if (lane == 0) { MX[32 + l] = expf(s1) - expf(s2) + lambda_init; MX[34 + l] = lambda_init; }
            }
        }
    }
    GRID_BAR();
#pragma unroll 1
    for (int l = 0; l < 2; ++l) {
        const float* xprev = l == 0 ? x : out;
        { pg8::Gemm g{XN, WinT + (size_t)l * HP * DM, MROWS, HP, DM}; pg8::StaticOrder So; So.init(MROWS, HP, G, bid);
          pg8::EpiProj E{H, qk_gain + l * 512, qk_gain_diff + l * 64, l == 0 ? nullptr : (const float*)(ws + WS_RSS)};
          for (int rep = 0; rep < R_G1; ++rep) pg8::gemm_phase<pg8::EpiProj, pg8::StaticOrder, true, true>((LAS unsigned char*)lds, g, So, E); }
        GRID_BAR();
        {
            const float* MX = (const float*)(ws + WS_MX);
            bf16_t* OA = (bf16_t*)(ws + WS_T0); float* DA = (float*)(ws + WS_DA);
            bf16_t* KCb = (bf16_t*)(ws + WS_KC);
            const bf16_t* CW1T = (const bf16_t*)(ws + WS_CW1); const bf16_t* CW2T = (const bf16_t*)(ws + WS_CW2);
            LAS unsigned* qw = (LAS unsigned*)((LAS unsigned char*)lds + att::L_Q);
            unsigned* qctr = (unsigned*)(ws + WS_CTL) + 8192 + 128 * l;
            unsigned* cdone = qctr + 64;
            constexpr int B0 = 64, B1 = B0 + 160 * R_C, B2 = B1 + 256 * R_D, B3 = B2 + 96 * R_C, B4 = B3 + 768 * R_AB, NUV = B4 + 256 * R_AB;
            for (;;) {
                if (opq(threadIdx.x) == 0) *qw = atomicAdd(qctr, 1u);
                __syncthreads();
                const int uv = (int)*qw;
                __syncthreads();
                if (uv >= NUV) break;
                int u;
                if (uv < B0) u = uv; else if (uv < B1) u = 64 + (uv - B0) / R_C; else if (uv < B2) u = 224 + (uv - B1) / R_D; else if (uv < B3) u = 480 + (uv - B2) / R_C;
                else if (uv < B4) u = 576 + (uv - B3) / R_AB; else u = 1344 + (uv - B4) / R_AB;
                if (u < 64) {
                    const int kv = u >> 5, b = (u >> 4) & 1, rt = u & 15;
                    att::CmpArgs P; P.Hb = H + (size_t)b * S * HP; P.col = kv == 0 ? C_KC : C_VC; P.rt = rt;
                    P.pos = cmp_pos + (size_t)(l * 2 + kv) * 2048; P.W1T = CW1T + (size_t)(l * 2 + kv) * 256 * 2048; P.b1 = cmp_b1 + (l * 2 + kv) * 256;
                    P.W2T = CW2T + (size_t)(l * 2 + kv) * 64 * 256; P.b2 = cmp_b2 + (l * 2 + kv) * 64; P.gain = kv == 0 ? qk_gain + l * 512 + 5 * 64 : nullptr;
                    P.OUT = KCb + (size_t)(kv * NB + b) * 512 * 64;
                    att::cmp_unit((LAS unsigned char*)lds, P);
                    asm volatile("s_waitcnt vmcnt(0)" ::: "memory");
                    __syncthreads();
                    if (opq(threadIdx.x) == 64) { __builtin_amdgcn_fence(__ATOMIC_RELEASE, "agent"); asm volatile("s_waitcnt vmcnt(0)" ::: "memory");
                        __hip_atomic_fetch_add(cdone, 1u, __ATOMIC_RELAXED, __HIP_MEMORY_SCOPE_AGENT); }
                    __syncthreads();
                } else if ((u >= 64 && u < 224) || (u >= 480 && u < 576)) {
                    int qb, bh;
                    if (u < 224) { qb = 31 - ((u - 64) >> 3); bh = (u - 64) & 7; } else { qb = 11 - ((u - 480) >> 3); bh = (u - 480) & 7; }
                    const int b = bh >> 2, hd = bh & 3;
                    att::DiffArgs P; P.Hb = H + (size_t)b * S * HP; P.hd = hd; P.qb = qb; P.brow = (size_t)b * S;
                    P.bias = tab + 8 + hd; P.M = MX[l * 16 + 8 + hd]; P.lam = MX[32 + l]; P.lambda_init = MX[34 + l]; P.subln = diff_subln + l * 64; P.Y = Y;
                    att::diff_unit((LAS unsigned char*)lds, P);
                } else if (u < 480) {
                    const int idx = u - 224, qb64 = 127 - (idx >> 1), b = idx & 1;
                    att::NsaArgs P; P.Hb = H + (size_t)b * S * HP; P.brow = (size_t)b * S; P.qb = qb64;
                    P.KC = KCb + (size_t)(0 * NB + b) * 512 * 64; P.VC = KCb + (size_t)(1 * NB + b) * 512 * 64;
                    P.bias = tab + 12; P.Mv = MX + l * 16 + 12; P.Y = Y; P.cdone = cdone;
                    att::nsa_unit((LAS unsigned char*)lds, P);
                } else if (u < 1344) {
                    const int v = u - 576, cfg = v >> 8, b = (v >> 7) & 1, hd = (v >> 5) & 3, ti = v & 31;
                    const int rate = cfg == 0 ? 1 : (cfg == 1 ? 4 : 16), tpc = 32 / rate;
                    att::BandArgs P; P.Hb = H + (size_t)b * S * HP; P.cq = C_AQ + 64 * hd; P.ck = C_AK + 64 * hd; P.cv = C_AV + 64 * hd;
                    P.rate = rate; P.cls = ti / tpc; P.f0 = (ti % tpc) * 256; P.maxd = 128; P.bias = tab + hd; P.M = MX[l * 16 + hd]; P.sinkterm = 0.f;
                    P.OA = OA + (size_t)cfg * MROWS * 256; P.DA = DA + (size_t)cfg * MROWS * 4; P.Y = nullptr; P.ycol = 0; P.hd = hd; P.brow = (size_t)b * S;
                    att::banded_unit<0>((LAS unsigned char*)lds, P);
                } else {
                    const int v = u - 1344, b = (v >> 7) & 1, hd = (v >> 5) & 3, ti = v & 31;
                    att::BandArgs P; P.Hb = H + (size_t)b * S * HP; P.cq = C_BQ + 64 * hd; P.ck = C_BK + 64 * (hd >> 1); P.cv = C_BV + 64 * (hd >> 1);
                    P.rate = 1; P.cls = 0; P.f0 = ti * 256; P.maxd = 127; P.bias = tab + 4 + hd; P.M = MX[l * 16 + 4 + hd];
                    P.sinkterm = __expf(sinks[l * 4 + hd] - P.M);
                    P.OA = nullptr; P.DA = nullptr; P.Y = Y; P.ycol = 256 + 64 * hd; P.hd = hd; P.brow = (size_t)b * S;
                    att::banded_unit<1>((LAS unsigned char*)lds, P);
                }
            }
        }
        GRID_BAR();
        {
            const bf16_t* OA = (const bf16_t*)(ws + WS_T0); const float* DA = (const float*)(ws + WS_DA);
            for (int v = (bid * NT + opq(threadIdx.x)); v < MROWS * 32; v += GT) {
                const int row = v >> 5, hd = (v >> 3) & 3, c8 = v & 7;
                float acc8[8] = {0.f, 0.f, 0.f, 0.f, 0.f, 0.f, 0.f, 0.f}; float dsum = 0.f;
#pragma unroll
                for (int cfg = 0; cfg < 3; ++cfg) {
                    const float dn = DA[((size_t)cfg * MROWS + row) * 4 + hd]; dsum += dn;
                    const uint4 r4 = *(const uint4*)(OA + ((size_t)cfg * MROWS + row) * 256 + hd * 64 + c8 * 8);
                    acc8[0] += dn * __uint_as_float(r4.x << 16); acc8[1] += dn * __uint_as_float(r4.x & 0xffff0000u);
                    acc8[2] += dn * __uint_as_float(r4.y << 16); acc8[3] += dn * __uint_as_float(r4.y & 0xffff0000u);
                    acc8[4] += dn * __uint_as_float(r4.z << 16); acc8[5] += dn * __uint_as_float(r4.z & 0xffff0000u);
                    acc8[6] += dn * __uint_as_float(r4.w << 16); acc8[7] += dn * __uint_as_float(r4.w & 0xffff0000u);
                }
                const float inv = 1.f / dsum;
                const uint4 s4 = *(const uint4*)(H + (size_t)row * HP + C_SILU + hd * 64 + c8 * 8);
                uint4 o4;
                o4.x = (unsigned)f2bf(acc8[0] * inv * __uint_as_float(s4.x << 16)) | ((unsigned)f2bf(acc8[1] * inv * __uint_as_float(s4.x & 0xffff0000u)) << 16);
                o4.y = (unsigned)f2bf(acc8[2] * inv * __uint_as_float(s4.y << 16)) | ((unsigned)f2bf(acc8[3] * inv * __uint_as_float(s4.y & 0xffff0000u)) << 16);
                o4.z = (unsigned)f2bf(acc8[4] * inv * __uint_as_float(s4.z << 16)) | ((unsigned)f2bf(acc8[5] * inv * __uint_as_float(s4.z & 0xffff0000u)) << 16);
                o4.w = (unsigned)f2bf(acc8[6] * inv * __uint_as_float(s4.w << 16)) | ((unsigned)f2bf(acc8[7] * inv * __uint_as_float(s4.w & 0xffff0000u)) << 16);
                *(uint4*)(Y + (size_t)row * DM + hd * 64 + c8 * 8) = o4;
            }
        }
        GRID_BAR();
        { pg8::Gemm g{Y, WoutT + (size_t)l * DM * DM, MROWS, DM, DM}; pg8::StaticOrder So; So.init(MROWS, DM, G, bid);
          pg8::EpiOut E{xprev, out, (LAS float*)((LAS unsigned char*)lds + 132096), l == 0 ? XN : nullptr, norm_w + DM, (float*)(ws + WS_RSS)};
          pg8::gemm_phase<pg8::EpiOut, pg8::StaticOrder, true, true>((LAS unsigned char*)lds, g, So, E); }
        if (l == 0) GRID_BAR();
    }
}

extern "C" void kernel_launch(void* const* d_in, const int* in_sizes, int n_in, void* d_out, int out_size, void* d_ws, size_t ws_size, hipStream_t stream) {
    static int grid = 0;
    if (grid == 0) {
        int dev = 0, cus = 0;
        (void)hipGetDevice(&dev);
        (void)hipDeviceGetAttribute(&cus, hipDeviceAttributeMultiprocessorCount, dev);
        (void)hipFuncSetAttribute((const void*)mega_fwd, hipFuncAttributeMaxDynamicSharedMemorySize, LDS_BYTES);
        grid = cus > 0 ? cus : 256;
    }
    (void)hipMemsetAsync((char*)d_ws + WS_CTL, 0, CTL_ZERO_BYTES, stream);
    Args a{};
    for (int i = 0; i < 15; ++i) a.in[i] = (const float*)d_in[i];
    a.out = (float*)d_out; a.ws = (unsigned char*)d_ws;
    hipLaunchKernelGGL(mega_fwd, dim3(grid), dim3(NT), LDS_BYTES, stream, a);
}
```

```cpp
#include <hip/hip_runtime.h>
#include <stdint.h>
#include <math.h>

typedef unsigned short bf16_t;
__device__ __forceinline__ float bf2f(bf16_t v) { return __uint_as_float((unsigned)v << 16); }
__device__ __forceinline__ bf16_t f2bf(float f) { unsigned u = __float_as_uint(f); return (bf16_t)((u + 0x7fffu + ((u >> 16) & 1u)) >> 16); }

constexpr int NB = 2, S = 8192, DM = 1024, MROWS = NB * S, PW = 3724, HP = 3840;
constexpr int C_AQ = 0, C_AK = 256, C_AV = 512, C_BQ = 768, C_BK = 1024, C_BV = 1152, C_CQ = 1280, C_CK = 1536, C_CV = 1792,
              C_DQ = 2048, C_KC = 2304, C_VC = 2368, C_KS = 2432, C_VS = 2496, C_KW = 2560, C_VW = 2624, C_GT = 2688, C_SILU = 2816;
constexpr float EPS = 1e-6f;
__device__ __forceinline__ int opq(int v) { asm volatile("" : "+v"(v)); return v; }

__device__ __forceinline__ int t5_bucket(int n) {
    if (n < 16) return n < 0 ? 0 : n;
    int b = 16;
    b += (n >= 22); b += (n >= 30); b += (n >= 40); b += (n >= 54); b += (n >= 73); b += (n >= 99); b += (n >= 134); b += (n >= 182);
    b += (n >= 246); b += (n >= 332); b += (n >= 450); b += (n >= 609); b += (n >= 825); b += (n >= 1117); b += (n >= 1513);
    return b;
}

__device__ __forceinline__ void k_rmsnorm(const int wave, const int lane, const float* __restrict__ x, const float* __restrict__ g, bf16_t* __restrict__ xn) {
    if (wave >= MROWS) return;
    const float4* xr = (const float4*)(x + (size_t)wave * DM);
    float4 v[4]; float ss = 0.f;
#pragma unroll
    for (int j = 0; j < 4; ++j) { v[j] = xr[lane + 64 * j]; ss += (v[j].x * v[j].x + v[j].y * v[j].y) + (v[j].z * v[j].z + v[j].w * v[j].w); }
#pragma unroll
    for (int o = 1; o < 64; o <<= 1) ss += __shfl_xor(ss, o);
    const float rstd = rsqrtf(ss * (1.f / DM) + EPS);
#pragma unroll
    for (int j = 0; j < 4; ++j) {
        const float4 gg = ((const float4*)g)[lane + 64 * j];
        uint2 o; o.x = (unsigned)f2bf(v[j].x * rstd * gg.x) | ((unsigned)f2bf(v[j].y * rstd * gg.y) << 16);
        o.y = (unsigned)f2bf(v[j].z * rstd * gg.z) | ((unsigned)f2bf(v[j].w * rstd * gg.w) << 16);
        ((uint2*)(xn + (size_t)wave * DM))[lane + 64 * j] = o;
    }
}

template <int D>
__device__ __forceinline__ float dot_row(const float* q, const bf16_t* kr) {
    float s = 0.f;
#pragma unroll
    for (int c = 0; c < D / 8; ++c) {
        const uint4 r = *(const uint4*)(kr + 8 * c);
        s += q[8 * c + 0] * __uint_as_float(r.x << 16) + q[8 * c + 1] * __uint_as_float(r.x & 0xffff0000u);
        s += q[8 * c + 2] * __uint_as_float(r.y << 16) + q[8 * c + 3] * __uint_as_float(r.y & 0xffff0000u);
        s += q[8 * c + 4] * __uint_as_float(r.z << 16) + q[8 * c + 5] * __uint_as_float(r.z & 0xffff0000u);
        s += q[8 * c + 6] * __uint_as_float(r.w << 16) + q[8 * c + 7] * __uint_as_float(r.w & 0xffff0000u);
        if (c & 1) asm volatile("" ::: "memory");
    }
    return s;
}
__device__ __forceinline__ void os_step(float s, const bf16_t* vr, float& m, float& den, float* o) {
    const float mn = fmaxf(m, s), sc = __expf(m - mn), p = __expf(s - mn);
    den = den * sc + p; m = mn;
#pragma unroll
    for (int c = 0; c < 8; ++c) {
        const uint4 r = *(const uint4*)(vr + 8 * c);
        o[8 * c + 0] = o[8 * c + 0] * sc + p * __uint_as_float(r.x << 16); o[8 * c + 1] = o[8 * c + 1] * sc + p * __uint_as_float(r.x & 0xffff0000u);
        o[8 * c + 2] = o[8 * c + 2] * sc + p * __uint_as_float(r.y << 16); o[8 * c + 3] = o[8 * c + 3] * sc + p * __uint_as_float(r.y & 0xffff0000u);
        o[8 * c + 4] = o[8 * c + 4] * sc + p * __uint_as_float(r.z << 16); o[8 * c + 5] = o[8 * c + 5] * sc + p * __uint_as_float(r.z & 0xffff0000u);
        o[8 * c + 6] = o[8 * c + 6] * sc + p * __uint_as_float(r.w << 16); o[8 * c + 7] = o[8 * c + 7] * sc + p * __uint_as_float(r.w & 0xffff0000u);
        if (c & 1) asm volatile("" ::: "memory");
    }
}
template <int D>
__device__ __forceinline__ void load_q(float* q, const bf16_t* p) {
#pragma unroll
    for (int c = 0; c < D / 8; ++c) {
        const uint4 r = *(const uint4*)(p + 8 * c);
        q[8 * c + 0] = __uint_as_float(r.x << 16); q[8 * c + 1] = __uint_as_float(r.x & 0xffff0000u);
        q[8 * c + 2] = __uint_as_float(r.y << 16); q[8 * c + 3] = __uint_as_float(r.y & 0xffff0000u);
        q[8 * c + 4] = __uint_as_float(r.z << 16); q[8 * c + 5] = __uint_as_float(r.z & 0xffff0000u);
        q[8 * c + 6] = __uint_as_float(r.w << 16); q[8 * c + 7] = __uint_as_float(r.w & 0xffff0000u);
    }
}

#define LAS __attribute__((address_space(3)))
namespace pg8 {
#define PG8_LAS __attribute__((address_space(3)))
typedef unsigned short bf16_t;
typedef short bf16x8 __attribute__((ext_vector_type(8)));
typedef float f32x4 __attribute__((ext_vector_type(4)));
typedef unsigned u32x4 __attribute__((ext_vector_type(4)));
constexpr int BM = 256, BK = 64, HALF = 128, HTB = HALF * BK * 2  , STAGE_BYTES = 8 * HTB, NXCD = 8, WGM = 8;

__host__ __device__ __forceinline__ int lds_byte(int r, int c) { const int st = (r >> 4) * 2 + (c >> 5), rr = r & 15, cc = c & 31, ob = rr * 64 + cc * 2; return st * 1024 + (ob ^ (((ob >> 9) & 1) << 5)); }
__host__ __device__ __forceinline__ void stage_rc(int b, int& R, int& C) { const int st = b / 1024, sb = b % 1024, swz = sb ^ (((sb >> 9) & 1) << 5); R = (st >> 1) * 16 + swz / 64; C = (st & 1) * 32 + (swz % 64) / 2; }
__host__ __device__ __forceinline__ int perm32(int rho) { const int n = rho >> 4, i = rho & 15; return 8 * (i >> 2) + 4 * n + (i & 3); }

struct Unit { int pm, pn; };
struct Gemm { const bf16_t* A; const bf16_t* Bt; int M, N, K; };

struct StaticOrder {
    int nM, nN, nwg, G, c;
    __host__ __device__ void init(int M, int N, int G_, int c_) { nM = M / BM; nN = N / BM; nwg = nM * nN; G = G_; c = c_; }
    __host__ __device__ bool next(int i, Unit& u) const {
        const long L = (long)i * G + c; if (L >= nwg) return false;
        int wgid = (int)L; { const int q = nwg / NXCD, r = nwg % NXCD, xcd = wgid % NXCD, off = wgid / NXCD; wgid = (xcd < r ? xcd * (q + 1) : r * (q + 1) + (xcd - r) * q) + off; }
        const int nig = WGM * nN, gid = wgid / nig, fm = gid * WGM, gsz = (nM - fm) < WGM ? (nM - fm) : WGM;
        u.pm = fm + ((wgid % nig) % gsz); u.pn = (wgid % nig) / gsz; return true;
    }
    __device__ __forceinline__ void a_ready(const Unit&) const {}
    __device__ __forceinline__ void done(const Unit&) const {}
};

__device__ __forceinline__ unsigned cvt_pk_bf16(float lo, float hi) { unsigned r; asm volatile("v_cvt_pk_bf16_f32 %0, %1, %2" : "=v"(r) : "v"(lo), "v"(hi)); return r; }
template <class Epi, class Sched, bool ALIGN_EPI = false, bool SP2 = false>
__device__ __forceinline__ void gemm_phase(PG8_LAS unsigned char* lds, const Gemm g, const Sched& S, const Epi& E) {
    const int tid = opq(threadIdx.x), wid = __builtin_amdgcn_readfirstlane(tid >> 6), lane = tid & 63, wr = wid >> 2, wc = wid & 3, fr = lane & 15, fq = lane >> 4;
    const int K = g.K, nt = K / BK;
    unsigned voffA[2], voffB[2];
#pragma unroll
    for (int i = 0; i < 2; ++i) { int R, C; stage_rc(tid * 16 + i * 8192, R, C); const int Rb = Epi::PERM ? ((R & ~31) + perm32(R & 31)) : R;
        voffA[i] = (unsigned)(R * K + C) * 2u; voffB[i] = (unsigned)(Rb * K + C) * 2u; }
    const size_t kstep = (size_t)(BK * 2);
    const size_t hstep = (size_t)HALF * K * 2;
    const size_t tstep = 2 * hstep;
    const unsigned ldsw = (unsigned)wid * 1024u;
    const int aoff = lds_byte(wr * 64 + fr, fq * 8), boff = lds_byte(wc * 32 + fr, fq * 8);
#define PG8_SA(b, h) (((b) * 2 + (h)) * HTB)
#define PG8_SB(b, h) ((4 + (b) * 2 + (h)) * HTB)
#define PG8_STAGE(bufoff, gbase, voff) do { _Pragma("unroll") for (int _i = 0; _i < 2; ++_i) \
        __builtin_amdgcn_global_load_lds((const unsigned*)((const char*)(gbase) + (voff)[_i]), (PG8_LAS unsigned*)(lds + (bufoff) + ldsw + _i * 8192), 16, 0, 0); } while (0)
#define PG8_LDA(dst, b, h) do { _Pragma("unroll") for (int m = 0; m < 4; ++m) _Pragma("unroll") for (int k = 0; k < 2; ++k) dst[m][k] = *(const PG8_LAS bf16x8*)(lds + PG8_SA(b, h) + aoff + m * 2048 + k * 1024); } while (0)
#define PG8_LDB(dst, b, h) do { _Pragma("unroll") for (int n = 0; n < 2; ++n) _Pragma("unroll") for (int k = 0; k < 2; ++k) dst[n][k] = *(const PG8_LAS bf16x8*)(lds + PG8_SB(b, h) + boff + n * 2048 + k * 1024); } while (0)
#define PG8_MMA(ai, bj, At, Bt) do { __builtin_amdgcn_s_setprio(1); _Pragma("unroll") for (int m = 0; m < 4; ++m) _Pragma("unroll") for (int n = 0; n < 2; ++n) _Pragma("unroll") for (int k = 0; k < 2; ++k) \
        acc[ai][bj][m][n] = __builtin_amdgcn_mfma_f32_16x16x32_bf16(Bt[n][k], At[m][k], acc[ai][bj][m][n], 0, 0, 0); __builtin_amdgcn_s_setprio(0); } while (0)
#define PG8_WAIT_V(n) asm volatile("s_waitcnt vmcnt(" #n ")" ::: "memory")
#define PG8_WAIT_L(n) asm volatile("s_waitcnt lgkmcnt(" #n ")" ::: "memory")
#define PG8_BAR __builtin_amdgcn_s_barrier()
#define PG8_SCHED __builtin_amdgcn_sched_barrier(0)
    Unit cur, nxt; int ui = 0;
    if (!S.next(0, cur)) return;
    f32x4 acc[2][2][4][2];
#pragma unroll
    for (int a = 0; a < 2; ++a)
#pragma unroll
        for (int b = 0; b < 2; ++b)
#pragma unroll
            for (int m = 0; m < 4; ++m)
#pragma unroll
                for (int n = 0; n < 2; ++n) acc[a][b][m][n] = (f32x4){0.f, 0.f, 0.f, 0.f};
    bf16x8 At[4][2], B0[2][2], B1[2][2];
    const char* cA = (const char*)g.A + (size_t)cur.pm * tstep; const char* cB = (const char*)g.Bt + (size_t)cur.pn * tstep;
    S.a_ready(cur);
    if constexpr (SP2) {
        PG8_STAGE(PG8_SB(0, 0), cB, voffB); PG8_STAGE(PG8_SB(0, 1), cB + hstep, voffB); PG8_STAGE(PG8_SA(0, 0), cA, voffA); PG8_STAGE(PG8_SA(0, 1), cA + hstep, voffA);
        if (wr == 1) PG8_BAR;
        PG8_WAIT_V(2); PG8_BAR;
        PG8_STAGE(PG8_SB(1, 0), cB + kstep, voffB); PG8_STAGE(PG8_SA(1, 0), cA + kstep, voffA); PG8_STAGE(PG8_SB(1, 1), cB + hstep + kstep, voffB);
        PG8_WAIT_V(6); PG8_BAR;
    } else {
        PG8_STAGE(PG8_SB(0, 0), cB, voffB); PG8_STAGE(PG8_SA(0, 0), cA, voffA); PG8_STAGE(PG8_SB(0, 1), cB + hstep, voffB); PG8_STAGE(PG8_SA(0, 1), cA + hstep, voffA);
        if (wr == 1) PG8_BAR;
        PG8_WAIT_V(4); PG8_BAR;
        PG8_STAGE(PG8_SB(1, 0), cB + kstep, voffB); PG8_STAGE(PG8_SA(1, 0), cA + kstep, voffA); PG8_STAGE(PG8_SB(1, 1), cB + hstep + kstep, voffB);
        PG8_WAIT_V(6); PG8_BAR;
    }
    for (;;) {
        const bool has_next = S.next(ui + 1, nxt);
        const char* nA = has_next ? (const char*)g.A + (size_t)nxt.pm * tstep : cA; const char* nB = has_next ? (const char*)g.Bt + (size_t)nxt.pn * tstep : cB;
        for (int t = 0; t < nt; t += 2) {
            const bool last = (t == nt - 2);
            const char* a1 = cA + (size_t)(t + 1) * kstep;
            const char* a2 = last ? nA : cA + (size_t)(t + 2) * kstep; const char* b2 = last ? nB : cB + (size_t)(t + 2) * kstep;
            const char* a3 = a2 + kstep; const char* b3 = b2 + kstep;
            if (last && has_next) S.a_ready(nxt);
            if constexpr (SP2) {
            PG8_LDB(B0, 0, 0); PG8_LDB(B1, 0, 1); PG8_SCHED; PG8_LDA(At, 0, 0); PG8_STAGE(PG8_SA(1, 1), a1 + hstep, voffA);
            PG8_WAIT_V(8); PG8_WAIT_L(0); PG8_BAR; PG8_MMA(0, 0, At, B0); PG8_MMA(0, 1, At, B1); PG8_BAR; PG8_SCHED;
            PG8_LDA(At, 0, 1); PG8_STAGE(PG8_SB(0, 0), b2, voffB); PG8_STAGE(PG8_SB(0, 1), b2 + hstep, voffB); PG8_STAGE(PG8_SA(0, 0), a2, voffA);
            PG8_WAIT_V(8); PG8_WAIT_L(0); PG8_BAR; PG8_MMA(1, 0, At, B0); PG8_MMA(1, 1, At, B1); PG8_BAR; PG8_SCHED;
            PG8_LDB(B0, 1, 0); PG8_LDB(B1, 1, 1); PG8_SCHED; PG8_LDA(At, 1, 0); PG8_STAGE(PG8_SA(0, 1), a2 + hstep, voffA);
            PG8_WAIT_V(8); PG8_WAIT_L(0); PG8_BAR; PG8_MMA(0, 0, At, B0); PG8_MMA(0, 1, At, B1); PG8_BAR; PG8_SCHED;
            PG8_LDA(At, 1, 1); PG8_STAGE(PG8_SB(1, 0), b3, voffB); PG8_STAGE(PG8_SB(1, 1), b3 + hstep, voffB); PG8_STAGE(PG8_SA(1, 0), a3, voffA);
            PG8_WAIT_V(8); PG8_WAIT_L(0); PG8_BAR; PG8_MMA(1, 0, At, B0); PG8_MMA(1, 1, At, B1); PG8_BAR; PG8_SCHED;
            } else {
            PG8_LDB(B0, 0, 0); PG8_SCHED; PG8_LDA(At, 0, 0); PG8_STAGE(PG8_SA(1, 1), a1 + hstep, voffA);
            PG8_WAIT_L(8); PG8_BAR; PG8_WAIT_L(0); PG8_MMA(0, 0, At, B0); PG8_BAR; PG8_SCHED;
            PG8_LDB(B1, 0, 1); PG8_STAGE(PG8_SB(0, 0), b2, voffB);
            PG8_BAR; PG8_WAIT_L(0); PG8_MMA(0, 1, At, B1); PG8_BAR;
            PG8_LDA(At, 0, 1); PG8_STAGE(PG8_SA(0, 0), a2, voffA);
            PG8_BAR; PG8_WAIT_L(0); PG8_MMA(1, 0, At, B0); PG8_BAR; PG8_SCHED;
            PG8_STAGE(PG8_SB(0, 1), b2 + hstep, voffB);
            PG8_WAIT_V(6); PG8_BAR; PG8_MMA(1, 1, At, B1); PG8_BAR;
            PG8_LDB(B0, 1, 0); PG8_SCHED; PG8_LDA(At, 1, 0); PG8_STAGE(PG8_SA(0, 1), a2 + hstep, voffA);
            PG8_WAIT_L(8); PG8_BAR; PG8_WAIT_L(0); PG8_MMA(0, 0, At, B0); PG8_BAR; PG8_SCHED;
            PG8_LDB(B1, 1, 1); PG8_STAGE(PG8_SB(1, 0), b3, voffB);
            PG8_BAR; PG8_WAIT_L(0); PG8_MMA(0, 1, At, B1); PG8_BAR;
            PG8_LDA(At, 1, 1); PG8_STAGE(PG8_SA(1, 0), a3, voffA);
            PG8_BAR; PG8_WAIT_L(0); PG8_MMA(1, 0, At, B0); PG8_BAR; PG8_SCHED;
            PG8_STAGE(PG8_SB(1, 1), b3 + hstep, voffB);
            PG8_WAIT_V(6); PG8_BAR; PG8_MMA(1, 1, At, B1); PG8_BAR;
            }
        }
        if constexpr (ALIGN_EPI) { if (wr == 0) PG8_BAR; }
        if constexpr (!Epi::AFTER_DRAIN) { E(acc, cur, wr, wc, fr, fq); S.done(cur); }
        if (!has_next) break;
#pragma unroll
        for (int a = 0; a < 2; ++a)
#pragma unroll
            for (int b = 0; b < 2; ++b)
#pragma unroll
                for (int m = 0; m < 4; ++m)
#pragma unroll
                    for (int n = 0; n < 2; ++n) acc[a][b][m][n] = (f32x4){0.f, 0.f, 0.f, 0.f};
        cur = nxt; cA = nA; cB = nB; ++ui;
        if constexpr (ALIGN_EPI) { if (wr == 1) PG8_BAR; }
    }
    PG8_WAIT_V(0);
    if constexpr (!ALIGN_EPI) { if (wr == 0) PG8_BAR; }
    PG8_BAR;
    if constexpr (Epi::AFTER_DRAIN) { E.fused(acc, cur, wr, wc, fr, fq, lds, wid, lane); S.done(cur); }
#undef PG8_SA
#undef PG8_SB
#undef PG8_STAGE
#undef PG8_LDA
#undef PG8_LDB
#undef PG8_MMA
#undef PG8_WAIT_V
#undef PG8_WAIT_L
#undef PG8_BAR
#undef PG8_SCHED
}
}

namespace pg8 {
struct EpiProj {
    static constexpr bool PERM = true, AFTER_DRAIN = false;
    bf16_t* H; const float* g; const float* gd;
    const float* rowss;
    __device__ __forceinline__ void operator()(const f32x4 (&acc)[2][2][4][2], const Unit& u, int wr, int wc, int fr, int fq) const {
        const int pn = u.pn;
        int mode = 0; const float* gain = nullptr;
        const float qs = (pn == 0 || pn == 3 || pn == 8) ? 0.125f * 1.4426950408889634f : (pn == 5 ? 0.17677669529663687f * 1.4426950408889634f : 1.f);
        if (pn == 0) { mode = 1; gain = g; } else if (pn == 1) { mode = 1; gain = g + 64; } else if (pn == 3) { mode = 1; gain = g + 128; }
        else if (pn == 4) { if (wc < 2) { mode = 1; gain = g + 192; } }
        else if (pn == 5) { mode = 2; gain = gd; } else if (pn == 6) { mode = 2; gain = gd + 32; }
        else if (pn == 8) { mode = 1; gain = g + 256; }
        else if (pn == 9) { if (wc == 2) { mode = 1; gain = g + 384; } }
        else if (pn == 10) { if (wc == 0) { mode = 1; gain = g + 448; } else if (wc == 2) mode = 4; }
        else if (pn >= 11) mode = 3;
        f32x4 gv[2][2];
#pragma unroll
        for (int bj = 0; bj < 2; ++bj)
#pragma unroll
            for (int n = 0; n < 2; ++n) gv[bj][n] = (f32x4){1.f, 1.f, 1.f, 1.f};
        if (mode == 1) {
#pragma unroll
            for (int bj = 0; bj < 2; ++bj)
#pragma unroll
                for (int n = 0; n < 2; ++n) gv[bj][n] = *(const f32x4*)(gain + 32 * bj + 8 * fq + 4 * n);
        } else if (mode == 2) {
#pragma unroll
            for (int bj = 0; bj < 2; ++bj)
#pragma unroll
                for (int n = 0; n < 2; ++n) gv[bj][n] = *(const f32x4*)(gain + 8 * fq + 4 * n);
        }
        const int col0 = pn * BM + 64 * wc + 8 * fq;
#pragma unroll
        for (int ai = 0; ai < 2; ++ai)
#pragma unroll
            for (int m = 0; m < 4; ++m) {
                const int row = u.pm * BM + ai * HALF + wr * 64 + m * 16 + fr;
                f32x4 v[2][2];
                const float rsc = rowss ? rsqrtf((float)((const unsigned long long*)rowss)[row] * (1.f / (1048576.f * 1024.f)) + 1e-6f) : 1.f;
#pragma unroll
                for (int bj = 0; bj < 2; ++bj)
#pragma unroll
                    for (int n = 0; n < 2; ++n) v[bj][n] = acc[ai][bj][m][n] * rsc;
                if (mode == 1 || mode == 2) {
                    float s0 = 0.f, s1 = 0.f;
#pragma unroll
                    for (int n = 0; n < 2; ++n) {
                        s0 += v[0][n][0] * v[0][n][0] + v[0][n][1] * v[0][n][1] + v[0][n][2] * v[0][n][2] + v[0][n][3] * v[0][n][3];
                        s1 += v[1][n][0] * v[1][n][0] + v[1][n][1] * v[1][n][1] + v[1][n][2] * v[1][n][2] + v[1][n][3] * v[1][n][3];
                    }
                    s0 += __shfl_xor(s0, 16); s0 += __shfl_xor(s0, 32);
                    s1 += __shfl_xor(s1, 16); s1 += __shfl_xor(s1, 32);
                    float r0, r1;
                    if (mode == 1) { r0 = r1 = rsqrtf((s0 + s1) * (1.f / 64.f) + 1e-6f) * qs; }
                    else { r0 = rsqrtf(s0 * (1.f / 32.f) + 1e-6f) * qs; r1 = rsqrtf(s1 * (1.f / 32.f) + 1e-6f) * qs; }
#pragma unroll
                    for (int n = 0; n < 2; ++n) { v[0][n] = v[0][n] * r0 * gv[0][n]; v[1][n] = v[1][n] * r1 * gv[1][n]; }
                } else if (mode == 3) {
#pragma unroll
                    for (int bj = 0; bj < 2; ++bj)
#pragma unroll
                        for (int n = 0; n < 2; ++n)
#pragma unroll
                            for (int e = 0; e < 4; ++e) { const float x = v[bj][n][e]; v[bj][n][e] = x * __builtin_amdgcn_rcpf(1.f + __expf(-x)); }
                } else if (mode == 4) {
#pragma unroll
                    for (int bj = 0; bj < 2; ++bj)
#pragma unroll
                        for (int n = 0; n < 2; ++n)
#pragma unroll
                            for (int e = 0; e < 4; ++e) { const float x = v[bj][n][e]; v[bj][n][e] = __builtin_amdgcn_rcpf(1.f + __expf(-x)); }
                }
                bf16_t* rowp = H + (size_t)row * 3840 + col0;
#pragma unroll
                for (int bj = 0; bj < 2; ++bj) {
                    u32x4 w; w.x = cvt_pk_bf16(v[bj][0][0], v[bj][0][1]); w.y = cvt_pk_bf16(v[bj][0][2], v[bj][0][3]);
                    w.z = cvt_pk_bf16(v[bj][1][0], v[bj][1][1]); w.w = cvt_pk_bf16(v[bj][1][2], v[bj][1][3]);
                    *(u32x4*)(rowp + 32 * bj) = w;
                }
            }
    }
};
struct EpiOut {
    static constexpr bool PERM = false, AFTER_DRAIN = false;
    const float* xprev; float* out;
    PG8_LAS float* exch;
    bf16_t* xn; const float* gnext; float* rowss;
    __device__ __forceinline__ void operator()(const f32x4 (&acc)[2][2][4][2], const Unit& u, int wr, int wc, int fr, int fq) const {
        const int col0 = u.pn * BM + wc * 32 + 4 * fq;
        f32x4 gn[2][2];
#pragma unroll
        for (int bj = 0; bj < 2; ++bj)
#pragma unroll
            for (int n = 0; n < 2; ++n) gn[bj][n] = xn ? *(const f32x4*)(gnext + col0 + bj * HALF + n * 16) : (f32x4){0.f, 0.f, 0.f, 0.f};
#pragma unroll
        for (int ai = 0; ai < 2; ++ai)
#pragma unroll
            for (int m = 0; m < 4; ++m) {
                const int row = u.pm * BM + ai * HALF + wr * 64 + m * 16 + fr;
                const size_t off = (size_t)row * 1024 + col0;
                float ss = 0.f;
#pragma unroll
                for (int bj = 0; bj < 2; ++bj)
#pragma unroll
                    for (int n = 0; n < 2; ++n) {
                        const f32x4 b = *(const f32x4*)(xprev + off + bj * HALF + n * 16);
                        const f32x4 v = b + acc[ai][bj][m][n];
                        *(f32x4*)(out + off + bj * HALF + n * 16) = v;
                        if (xn) {
                            ss += (v[0] * v[0] + v[1] * v[1]) + (v[2] * v[2] + v[3] * v[3]);
                            const f32x4 w = v * gn[bj][n];
                            uint2 o; o.x = cvt_pk_bf16(w[0], w[1]); o.y = cvt_pk_bf16(w[2], w[3]);
                            *(uint2*)(xn + off + bj * HALF + n * 16) = o;
                        }
                    }
                if (xn) {
                    ss += __shfl_xor(ss, 16); ss += __shfl_xor(ss, 32);
                    if (fq == 0) exch[(ai * HALF + wr * 64 + m * 16 + fr) * 4 + wc] = ss;
                }
            }
        if (xn) {
            asm volatile("s_waitcnt lgkmcnt(0)" ::: "memory"); __builtin_amdgcn_s_barrier(); asm volatile("" ::: "memory");
            if (wc == 0) {
                const int lane = fq * 16 + fr;
#pragma unroll
                for (int k = 0; k < 2; ++k) {
                    const int rl = k * HALF + wr * 64 + lane;
                    const f32x4 p = *(const PG8_LAS f32x4*)(exch + rl * 4);
                    const float tot = (p[0] + p[1]) + (p[2] + p[3]);
                    atomicAdd((unsigned long long*)rowss + (u.pm * BM + rl), (unsigned long long)(tot * 1048576.f + 0.5f));
                }
            }
        }
    }
};
}

template <int MODE>
__device__ __forceinline__ void p0_transpose_item(const float* __restrict__ W, bf16_t* __restrict__ WT, LAS float* scr, int item, int lane, int KR = 1024, int NC = 1024) {
    const int NSRC = MODE == 0 ? 3724 : NC, NG = MODE == 0 ? 120 : NC / 32;
    const int kb = item / NG, nb = item % NG, k0 = 64 * kb, hc0 = 32 * nb;
    const int hc = hc0 + (lane & 31);
    int src = hc;
    if (MODE == 0) src = hc < 2700 ? hc : (hc < 2816 ? -1 : hc - 116);
#pragma unroll 8
    for (int i = 0; i < 32; ++i) { const int kk = 2 * i + (lane >> 5); scr[kk * 33 + (lane & 31)] = src >= 0 ? W[(size_t)(k0 + kk) * NSRC + src] : 0.f; }
    asm volatile("s_waitcnt lgkmcnt(0)" ::: "memory");
    const int c = lane & 7;
#pragma unroll
    for (int j = 0; j < 4; ++j) {
        const int n = (lane >> 3) + 8 * j; const LAS float* s = scr + (8 * c) * 33 + n;
        const int hcn = hc0 + n;
        int drow = hcn;
        if (MODE == 0) drow = (hcn & ~255) + ((hcn >> 5) & 1) * 128 + ((hcn >> 6) & 3) * 32 + (hcn & 31);
        uint4 o; o.x = (unsigned)f2bf(s[0]) | ((unsigned)f2bf(s[33]) << 16); o.y = (unsigned)f2bf(s[66]) | ((unsigned)f2bf(s[99]) << 16);
        o.z = (unsigned)f2bf(s[132]) | ((unsigned)f2bf(s[165]) << 16); o.w = (unsigned)f2bf(s[198]) | ((unsigned)f2bf(s[231]) << 16);
        if (MODE == 2) { const int k = k0 + 8 * c; *(uint4*)(WT + ((size_t)((((drow >> 5) * 8 + (k >> 8)) * 16 + ((k >> 4) & 15)) * 64 + ((k >> 3) & 1) * 32 + (drow & 31))) * 8) = o; }
        else *(uint4*)(WT + (size_t)drow * KR + k0 + 8 * c) = o;
    }
    asm volatile("s_waitcnt lgkmcnt(0)" ::: "memory");
}

namespace att {
typedef short bf16x8 __attribute__((ext_vector_type(8)));
typedef short v4i16 __attribute__((ext_vector_type(4)));
typedef float f32x16 __attribute__((ext_vector_type(16)));
typedef float f32x2_t __attribute__((ext_vector_type(2)));
typedef __bf16 bf16x2_t __attribute__((ext_vector_type(2)));
typedef unsigned u32x4 __attribute__((ext_vector_type(4)));
typedef float f32x4 __attribute__((ext_vector_type(4)));
__device__ __forceinline__ unsigned cvtpk(float lo, float hi) { f32x2_t v = {lo, hi}; bf16x2_t b = __builtin_convertvector(v, bf16x2_t); return __builtin_bit_cast(unsigned, b); }
__device__ __forceinline__ int crow(int r, int h) { return (r & 3) + 8 * (r >> 2) + 4 * h; }
constexpr float LOG2E = 1.4426950408889634f;
constexpr int L_KV = 0, KVB = 16384  , L_TAB = 32768  , L_WSCR = 83968  , L_IMP = 92160  , L_Q = 124928, L_SEL = 125184  , L_SB = 126464  ;

struct StageRegs { u32x4 k, v; };
__device__ __forceinline__ void stage_load(StageRegs& sr, const bf16_t* kp, const bf16_t* vp, bool valid, int ch) {
    sr.k = (u32x4){0u, 0u, 0u, 0u}; sr.v = sr.k;
    if (valid) { sr.k = *(const u32x4*)(kp + ch * 8); sr.v = *(const u32x4*)(vp + ch * 8); }
}
__device__ __forceinline__ void stage_write(LAS unsigned char* buf, const StageRegs& sr, int row, int ch) {
    *(LAS u32x4*)(buf + row * 128 + ((ch ^ (row & 7)) << 4)) = sr.k;
    *(LAS u32x4*)(buf + 8192 + (ch >> 2) * 4096 + row * 64 + (ch & 3) * 16) = sr.v;
}
__device__ __forceinline__ f32x16 load_tab16(const LAS float* tbl, int TSP, int jb) {
    const int sh = jb & 3; const LAS float* tp = tbl + sh * TSP + (jb - sh);
    const f32x4 t0 = *(const LAS f32x4*)(tp), t1 = *(const LAS f32x4*)(tp + 8), t2 = *(const LAS f32x4*)(tp + 16), t3 = *(const LAS f32x4*)(tp + 24);
    return (f32x16){t0[0], t0[1], t0[2], t0[3], t1[0], t1[1], t1[2], t1[3], t2[0], t2[1], t2[2], t2[3], t3[0], t3[1], t3[2], t3[3]};
}
__device__ __forceinline__ float exp_sum16(f32x16& acc) {
    float sa = 0.f, sb = 0.f;
#pragma unroll
    for (int r = 0; r < 16; r += 2) {
        acc[r] = __builtin_amdgcn_exp2f(acc[r]); acc[r + 1] = __builtin_amdgcn_exp2f(acc[r + 1]);
        sa += acc[r]; asm volatile("" : "+v"(sa)); sb += acc[r + 1]; asm volatile("" : "+v"(sb));
    }
    return sa + sb;
}
__device__ __forceinline__ f32x16 splat16(float v) { return (f32x16){v, v, v, v, v, v, v, v, v, v, v, v, v, v, v, v}; }
template <int S0, int S1>
__device__ __forceinline__ void qk_sub(f32x16& acc, const LAS unsigned char* buf, int sub, const bf16x8* qf, int lane) {
    const int key = 32 * sub + (lane & 31), h = lane >> 5;
    bf16x8 kf[S1 - S0];
#pragma unroll
    for (int s = S0; s < S1; ++s) kf[s - S0] = *(const LAS bf16x8*)(buf + key * 128 + (((2 * s + h) ^ (key & 7)) << 4));
    __builtin_amdgcn_sched_barrier(0);
#pragma unroll
    for (int s = S0; s < S1; ++s) acc = __builtin_amdgcn_mfma_f32_32x32x16_bf16(kf[s - S0], qf[s], acc, 0, 0, 0);
}
__device__ __forceinline__ void pack_p(const f32x16& p, bf16x8& pa0, bf16x8& pa1) {
    u32x4 w0, w1;
    w0.x = cvtpk(p[0], p[1]); w0.y = cvtpk(p[2], p[3]); w0.z = cvtpk(p[4], p[5]); w0.w = cvtpk(p[6], p[7]);
    w1.x = cvtpk(p[8], p[9]); w1.y = cvtpk(p[10], p[11]); w1.z = cvtpk(p[12], p[13]); w1.w = cvtpk(p[14], p[15]);
    pa0 = __builtin_bit_cast(bf16x8, w0); pa1 = __builtin_bit_cast(bf16x8, w1);
}
__device__ __forceinline__ void pv_sub(f32x16* o, const LAS unsigned char* buf, int sub, const bf16x8& pa0, const bf16x8& pa1, int lane) {
    const int h = lane >> 5, g16 = (lane >> 4) & 1, q4 = (lane & 15) >> 2, p4 = lane & 3;
    const LAS unsigned char* vb = buf + 8192 + (32 * sub + 4 * h + q4) * 64 + (16 * g16 + 4 * p4) * 2;
    bf16x8 vf[2][2];
#pragma unroll
    for (int dt = 0; dt < 2; ++dt) {
#pragma unroll
        for (int s2 = 0; s2 < 2; ++s2) {
            const v4i16 lo = __builtin_amdgcn_ds_read_tr16_b64_v4i16((LAS v4i16*)(vb + dt * 4096 + s2 * 1024));
            const v4i16 hi = __builtin_amdgcn_ds_read_tr16_b64_v4i16((LAS v4i16*)(vb + dt * 4096 + s2 * 1024 + 512));
            vf[dt][s2] = (bf16x8){lo[0], lo[1], lo[2], lo[3], hi[0], hi[1], hi[2], hi[3]};
        }
    }
    __builtin_amdgcn_sched_barrier(0);
    o[0] = __builtin_amdgcn_mfma_f32_32x32x16_bf16(pa0, vf[0][0], o[0], 0, 0, 0);
    o[1] = __builtin_amdgcn_mfma_f32_32x32x16_bf16(pa0, vf[1][0], o[1], 0, 0, 0);
    o[0] = __builtin_amdgcn_mfma_f32_32x32x16_bf16(pa1, vf[0][1], o[0], 0, 0, 0);
    o[1] = __builtin_amdgcn_mfma_f32_32x32x16_bf16(pa1, vf[1][1], o[1], 0, 0, 0);
}

__device__ __forceinline__ void pv_sub2(f32x16* oa, f32x16* ob, const LAS unsigned char* buf, int sub, const bf16x8& a0, const bf16x8& a1, const bf16x8& b0, const bf16x8& b1, int lane) {
    const int h = lane >> 5, g16 = (lane >> 4) & 1, q4 = (lane & 15) >> 2, p4 = lane & 3;
    const LAS unsigned char* vb = buf + 8192 + (32 * sub + 4 * h + q4) * 64 + (16 * g16 + 4 * p4) * 2;
#pragma unroll
    for (int dt = 0; dt < 2; ++dt) {
#pragma unroll
        for (int s2 = 0; s2 < 2; ++s2) {
            const v4i16 lo = __builtin_amdgcn_ds_read_tr16_b64_v4i16((LAS v4i16*)(vb + dt * 4096 + s2 * 1024));
            const v4i16 hi = __builtin_amdgcn_ds_read_tr16_b64_v4i16((LAS v4i16*)(vb + dt * 4096 + s2 * 1024 + 512));
            const bf16x8 vf = (bf16x8){lo[0], lo[1], lo[2], lo[3], hi[0], hi[1], hi[2], hi[3]};
            oa[dt] = __builtin_amdgcn_mfma_f32_32x32x16_bf16(s2 == 0 ? a0 : a1, vf, oa[dt], 0, 0, 0);
            ob[dt] = __builtin_amdgcn_mfma_f32_32x32x16_bf16(s2 == 0 ? b0 : b1, vf, ob[dt], 0, 0, 0);
        }
    }
}

struct BandArgs {
    const bf16_t* Hb;
    int cq, ck, cv;
    int rate, cls, f0, maxd;
    const float* bias;
    float M;
    float sinkterm;
    bf16_t* OA; float* DA;
    bf16_t* Y; int ycol;
    int hd; size_t brow;
};
template <int MODE>
__device__ __forceinline__ void banded_unit(LAS unsigned char* lds, const BandArgs& P) {
    const int tid = opq(threadIdx.x), lane = tid & 63, w = __builtin_amdgcn_readfirstlane(tid >> 6), h = lane >> 5;
    LAS float* sb = (LAS float*)(lds + L_SB);
    LAS float* tbl = (LAS float*)(lds + L_TAB);
    const int KPREV = ((P.maxd + 63) >> 6) << 6, ntl = (KPREV + 256) >> 6;
    const int t0 = (KPREV - P.f0) > 0 ? ((KPREV - P.f0) >> 6) : 0;
    const int srow = tid >> 3, sch = tid & 7;
    StageRegs sr;
    {
        const int kf = P.f0 - KPREV + 64 * t0 + srow;
        const bf16_t* rp = P.Hb + ((size_t)kf * P.rate + P.cls) * HP;
        stage_load(sr, rp + P.ck, rp + P.cv, true, sch);
    }
    const int fq0 = P.f0 + 32 * w;
    bf16x8 qf[4];
    {
        const size_t tq = (size_t)(fq0 + (lane & 31)) * P.rate + P.cls;
        const bf16_t* qp = P.Hb + tq * HP + P.cq + 8 * h;
#pragma unroll
        for (int s = 0; s < 4; ++s) qf[s] = *(const bf16x8*)(qp + 16 * s);
    }
    if (tid < 32) sb[tid] = (P.bias[tid * 16] - P.M) * LOG2E;
    __syncthreads();
    const int DMAXI = P.maxd + 62, TS = P.maxd + 125, TSP = (TS + 7) & ~3;
    for (int e = tid; e < 4 * TSP; e += 512) {
        const int sh = e / TSP, j = e - sh * TSP + sh, dist = DMAXI - j;
        tbl[e] = (j < TS && dist >= 0 && dist <= P.maxd) ? sb[t5_bucket(dist * P.rate)] : -1e30f;
    }
    asm volatile("" : "+v"(qf[0]), "+v"(qf[1]), "+v"(qf[2]), "+v"(qf[3]));
    f32x16 o[2]; o[0] = (f32x16){}; o[1] = (f32x16){};
    float den = 0.f;
    stage_write(lds + L_KV, sr, srow, sch);
    __syncthreads();
    for (int t = t0; t < ntl; ++t) {
        LAS unsigned char* buf = lds + L_KV + ((t - t0) & 1) * KVB;
        const int kf0 = P.f0 - KPREV + 64 * t;
        if (t + 1 < ntl) {
            const int kf = kf0 + 64 + srow;
            const bf16_t* rp = P.Hb + ((size_t)kf * P.rate + P.cls) * HP;
            stage_load(sr, rp + P.ck, rp + P.cv, true, sch);
        }
#pragma unroll
        for (int sub = 0; sub < 2; ++sub) {
            const int kfs = kf0 + 32 * sub;
            if (kfs <= fq0 + 31 && kfs + 31 >= fq0 - P.maxd) {
                const int jb = DMAXI - ((fq0 - kfs) + (lane & 31) - 4 * h);
                f32x16 acc = load_tab16(tbl, TSP, jb);
                qk_sub<0, 4>(acc, buf, sub, qf, lane);
#pragma unroll
                for (int r = 0; r < 1; ++r) den += exp_sum16(acc);
                bf16x8 pa0, pa1; pack_p(acc, pa0, pa1);
                pv_sub(o, buf, sub, pa0, pa1, lane);
            }
        }
        if (t + 1 < ntl) stage_write(lds + L_KV + ((t - t0 + 1) & 1) * KVB, sr, srow, sch);
        __syncthreads();
    }
    float dtot = den + __shfl_xor(den, 32);
    if (MODE == 1) dtot += P.sinkterm;
    LAS float* ws_ = (LAS float*)(lds + L_WSCR) + w * 64;
    if (h == 0) ws_[lane] = dtot;
    if (MODE == 0 && h == 0) {
        const size_t tq = (size_t)(fq0 + lane) * P.rate + P.cls;
        P.DA[(P.brow + tq) * 4 + P.hd] = dtot;
    }
    asm volatile("s_waitcnt lgkmcnt(0)" ::: "memory");
#pragma unroll
    for (int r = 0; r < 16; ++r) {
        const int qi = crow(r, h);
        const float inv = __builtin_amdgcn_rcpf(ws_[qi]);
        const size_t row = P.brow + (size_t)(fq0 + qi) * P.rate + P.cls;
#pragma unroll
        for (int dt = 0; dt < 2; ++dt) {
            const int d = 32 * dt + (lane & 31);
            const float val = o[dt][r] * inv;
            if (MODE == 0) P.OA[row * 256 + P.hd * 64 + d] = f2bf(val);
            else P.Y[row * DM + P.ycol + d] = f2bf(val * bf2f(P.Hb[(row - P.brow) * HP + C_SILU + P.ycol + d]));
        }
    }
}

__device__ __forceinline__ void diff_p1(const LAS float* tp, const LAS unsigned char* buf, int sub, const bf16x8* qf, int lane, bf16x8& pa0, bf16x8& pa1, bf16x8& pb0, bf16x8& pb1) {
    const f32x4 t0 = *(const LAS f32x4*)(tp), t1 = *(const LAS f32x4*)(tp + 8), t2 = *(const LAS f32x4*)(tp + 16), t3 = *(const LAS f32x4*)(tp + 24);
    const f32x16 T = (f32x16){t0[0], t0[1], t0[2], t0[3], t1[0], t1[1], t1[2], t1[3], t2[0], t2[1], t2[2], t2[3], t3[0], t3[1], t3[2], t3[3]};
    const int key = 32 * sub + (lane & 31), h = lane >> 5;
    const LAS unsigned char* kp = buf + key * 128;
    const bf16x8 k0 = *(const LAS bf16x8*)(kp + (((0 + h) ^ (key & 7)) << 4)), k1 = *(const LAS bf16x8*)(kp + (((2 + h) ^ (key & 7)) << 4));
    const bf16x8 k2 = *(const LAS bf16x8*)(kp + (((4 + h) ^ (key & 7)) << 4)), k3 = *(const LAS bf16x8*)(kp + (((6 + h) ^ (key & 7)) << 4));
    f32x16 a1 = __builtin_amdgcn_mfma_f32_32x32x16_bf16(k0, qf[0], T, 0, 0, 0);
    f32x16 a2 = __builtin_amdgcn_mfma_f32_32x32x16_bf16(k2, qf[2], T, 0, 0, 0);
    a1 = __builtin_amdgcn_mfma_f32_32x32x16_bf16(k1, qf[1], a1, 0, 0, 0);
    a2 = __builtin_amdgcn_mfma_f32_32x32x16_bf16(k3, qf[3], a2, 0, 0, 0);
#pragma unroll
    for (int r = 0; r < 16; ++r) { a1[r] = __builtin_amdgcn_exp2f(a1[r]); a2[r] = __builtin_amdgcn_exp2f(a2[r]); }
    pack_p(a1, pa0, pa1); pack_p(a2, pb0, pb1);
}
__device__ __forceinline__ void diff_p2(const LAS unsigned char* buf, int sub, int lane, const bf16x8& pa0, const bf16x8& pa1, const bf16x8& pb0, const bf16x8& pb1, f32x16& dn1, f32x16& dn2, f32x16* o1, f32x16* o2) {
    const bf16x8 ones = (bf16x8){0x3F80, 0x3F80, 0x3F80, 0x3F80, 0x3F80, 0x3F80, 0x3F80, 0x3F80};
    dn1 = __builtin_amdgcn_mfma_f32_32x32x16_bf16(pa0, ones, dn1, 0, 0, 0);
    dn2 = __builtin_amdgcn_mfma_f32_32x32x16_bf16(pb0, ones, dn2, 0, 0, 0);
    dn1 = __builtin_amdgcn_mfma_f32_32x32x16_bf16(pa1, ones, dn1, 0, 0, 0);
    dn2 = __builtin_amdgcn_mfma_f32_32x32x16_bf16(pb1, ones, dn2, 0, 0, 0);
    pv_sub2(o1, o2, buf, sub, pa0, pa1, pb0, pb1, lane);
}

struct DiffArgs {
    const bf16_t* Hb; int hd, qb; size_t brow;
    const float* bias; float M; float lam, lambda_init; const float* subln;
    bf16_t* Y;
};
constexpr int D_SB = 49152, D_TAB = 49664;
__device__ __forceinline__ void diff_unit(LAS unsigned char* lds, const DiffArgs& P) {
    const int tid = opq(threadIdx.x), lane = tid & 63, w = __builtin_amdgcn_readfirstlane(tid >> 6), h = lane >> 5;
    LAS float* sb = (LAS float*)(lds + D_SB);
    LAS float* tbl = (LAS float*)(lds + D_TAB);
    constexpr int DTOP = 1574, TS = DTOP + 63, TSP = (TS + 7) & ~3;
    __syncthreads();
    if (tid < 32) sb[tid] = (P.bias[tid * 16] - P.M) * LOG2E;
    __syncthreads();
    for (int e = tid; e < 4 * TSP; e += 512) {
        const int sh = e / TSP, j = e - sh * TSP + sh, dist = DTOP - j;
        tbl[e] = (j < TS && dist >= 0) ? sb[t5_bucket(dist)] : -1e30f;
    }
    LAS float* farc = tbl + 4 * TSP;
    LAS float* deadr = farc + 32;
    if (tid < 32) { farc[tid] = sb[31]; deadr[tid] = -1e30f; }
    const int q0w = P.qb * 256 + 32 * w;
    const int cq = C_CQ + 64 * P.hd, ck = C_CK + 64 * P.hd, cv = C_CV + 64 * P.hd;
    bf16x8 qf[4];
    {
        const bf16_t* qp = P.Hb + (size_t)(q0w + (lane & 31)) * HP + cq + 8 * h;
#pragma unroll
        for (int s = 0; s < 4; ++s) qf[s] = *(const bf16x8*)(qp + 16 * s);
        asm volatile("" : "+v"(qf[0]), "+v"(qf[1]), "+v"(qf[2]), "+v"(qf[3]));
    }
    const int ntl = 4 * (P.qb + 1);
    const int srow = tid >> 3, sch = tid & 7;
    f32x16 o1[2], o2[2]; o1[0] = (f32x16){}; o1[1] = (f32x16){}; o2[0] = (f32x16){}; o2[1] = (f32x16){};
    f32x16 dn1 = (f32x16){}, dn2 = (f32x16){};
    StageRegs sr;
    {
        const bf16_t* rp = P.Hb + (size_t)srow * HP;
        stage_load(sr, rp + ck, rp + cv, true, sch);
        stage_write(lds, sr, srow, sch);
    }
    __syncthreads();
#define DIFF_TP(KS) ({ const int ks_ = (KS); const int jb_ = DTOP - ((q0w - ks_) + (lane & 31) - 4 * h), sh_ = jb_ & 3; \
        const LAS float* tp_ = tbl + sh_ * TSP + (jb_ - sh_); tp_ = (q0w - ks_ - 31 >= 1513) ? farc : tp_; tp_ = (ks_ > q0w + 31) ? deadr : tp_; tp_; })
#define DIFF_STAGE_LOAD(t) do { const int tn_ = (t) + 1 < ntl ? (t) + 1 : (t); const bf16_t* rp_ = P.Hb + (size_t)(64 * tn_ + srow) * HP; stage_load(sr, rp_ + ck, rp_ + cv, true, sch); } while (0)
    if (w < 4) {
        int cur = 0;
        for (int t = 0; t < ntl; ++t) {
            LAS unsigned char* buf = lds + cur * KVB;
            const int nxt = cur == 2 ? 0 : cur + 1;
            DIFF_STAGE_LOAD(t);
            bf16x8 pa0, pa1, pb0, pb1;
            diff_p1(DIFF_TP(64 * t), buf, 0, qf, lane, pa0, pa1, pb0, pb1);
            diff_p2(buf, 0, lane, pa0, pa1, pb0, pb1, dn1, dn2, o1, o2);
            diff_p1(DIFF_TP(64 * t + 32), buf, 1, qf, lane, pa0, pa1, pb0, pb1);
            diff_p2(buf, 1, lane, pa0, pa1, pb0, pb1, dn1, dn2, o1, o2);
            stage_write(lds + nxt * KVB, sr, srow, sch);
            __syncthreads();
            cur = nxt;
        }
    } else {
        const bf16x8 zero8 = (bf16x8){0, 0, 0, 0, 0, 0, 0, 0};
        bf16x8 qa0 = zero8, qa1 = zero8, qb0 = zero8, qb1 = zero8;
        int cur = 0, prv = 0;
        __builtin_amdgcn_s_setprio(1);
        for (int t = 0; t < ntl; ++t) {
            LAS unsigned char* buf = lds + cur * KVB;
            const int nxt = cur == 2 ? 0 : cur + 1;
            DIFF_STAGE_LOAD(t);
            diff_p2(lds + prv * KVB, 1, lane, qa0, qa1, qb0, qb1, dn1, dn2, o1, o2);
            bf16x8 pa0, pa1, pb0, pb1;
            diff_p1(DIFF_TP(64 * t), buf, 0, qf, lane, pa0, pa1, pb0, pb1);
            diff_p2(buf, 0, lane, pa0, pa1, pb0, pb1, dn1, dn2, o1, o2);
            diff_p1(DIFF_TP(64 * t + 32), buf, 1, qf, lane, qa0, qa1, qb0, qb1);
            stage_write(lds + nxt * KVB, sr, srow, sch);
            __syncthreads();
            prv = cur; cur = nxt;
        }
        diff_p2(lds + prv * KVB, 1, lane, qa0, qa1, qb0, qb1, dn1, dn2, o1, o2);
        __builtin_amdgcn_s_setprio(0);
    }
    __syncthreads();
#undef DIFF_TP
#undef DIFF_STAGE_LOAD
    const float g0 = P.subln[lane & 31] * (1.f - P.lambda_init), g1 = P.subln[32 + (lane & 31)] * (1.f - P.lambda_init);
    const int ycol = 512 + 64 * P.hd;
#pragma unroll
    for (int r = 0; r < 16; ++r) {
        const int qi = crow(r, h);
        const float i1 = __builtin_amdgcn_rcpf(dn1[r]), i2 = P.lam * __builtin_amdgcn_rcpf(dn2[r]);
        const float a0 = o1[0][r] * i1 - o2[0][r] * i2, a1 = o1[1][r] * i1 - o2[1][r] * i2;
        float ss = a0 * a0 + a1 * a1;
        ss += __shfl_xor(ss, 1); ss += __shfl_xor(ss, 2); ss += __shfl_xor(ss, 4); ss += __shfl_xor(ss, 8); ss += __shfl_xor(ss, 16);
        const float rs = rsqrtf(ss * (1.f / 64.f) + 1e-6f);
        const size_t trow = (size_t)(q0w + qi);
        const bf16_t* sp = P.Hb + trow * HP + C_SILU + ycol;
        bf16_t* yp = P.Y + (P.brow + trow) * DM + ycol;
        yp[lane & 31] = f2bf(a0 * rs * g0 * bf2f(sp[lane & 31]));
        yp[32 + (lane & 31)] = f2bf(a1 * rs * g1 * bf2f(sp[32 + (lane & 31)]));
    }
}
struct CmpArgs {
    const bf16_t* Hb;
    int col;
    int rt;
    const float* pos;
    const bf16_t* W1T;
    const float* b1;
    const bf16_t* W2T;
    const float* b2;
    const float* gain;
    bf16_t* OUT;
};
__device__ __forceinline__ void cmp_unit(LAS unsigned char* lds, const CmpArgs& P) {
    const int tid = opq(threadIdx.x), lane = tid & 63, w = __builtin_amdgcn_readfirstlane(tid >> 6), h = lane >> 5;
    LAS unsigned char* hidl = lds + L_KV;
    LAS float* ssx = (LAS float*)(lds + L_KV + 32768 - 512);
    LAS unsigned char* abuf = lds + L_TAB;
    f32x16 acc = (f32x16){};
    const bf16_t* w1p = P.W1T + (size_t)w * (8 * 16 * 64 * 8) + lane * 8;
    u32x4 araw[2]; f32x4 apos[2][2];
#define CMP_ALOAD(ch) do { _Pragma("unroll") for (int q_ = 0; q_ < 2; ++q_) { const int p_ = tid + 512 * q_, row_ = p_ >> 5, kc_ = p_ & 31; \
        int ir_ = 32 * P.rt + row_; if (ir_ > 510) ir_ = 510; const int tok_ = 4 * (ch) + (kc_ >> 3), d_ = 8 * (kc_ & 7); \
        araw[q_] = *(const u32x4*)(P.Hb + (size_t)(16 * ir_ + tok_) * HP + P.col + d_); \
        apos[q_][0] = *(const f32x4*)(P.pos + tok_ * 64 + d_); apos[q_][1] = *(const f32x4*)(P.pos + tok_ * 64 + d_ + 4); } } while (0)
#define CMP_AWRITE(bufi) do { _Pragma("unroll") for (int q_ = 0; q_ < 2; ++q_) { const int p_ = tid + 512 * q_, row_ = p_ >> 5, kc_ = p_ & 31; u32x4 aw_; \
        aw_.x = cvtpk(__uint_as_float(araw[q_].x << 16) + apos[q_][0][0], __uint_as_float(araw[q_].x & 0xffff0000u) + apos[q_][0][1]); \
        aw_.y = cvtpk(__uint_as_float(araw[q_].y << 16) + apos[q_][0][2], __uint_as_float(araw[q_].y & 0xffff0000u) + apos[q_][0][3]); \
        aw_.z = cvtpk(__uint_as_float(araw[q_].z << 16) + apos[q_][1][0], __uint_as_float(araw[q_].z & 0xffff0000u) + apos[q_][1][1]); \
        aw_.w = cvtpk(__uint_as_float(araw[q_].w << 16) + apos[q_][1][2], __uint_as_float(araw[q_].w & 0xffff0000u) + apos[q_][1][3]); \
        *(LAS u32x4*)(abuf + (bufi) * 16896 + row_ * 528 + kc_ * 16) = aw_; } } while (0)
    CMP_ALOAD(0); CMP_AWRITE(0);
    __syncthreads();
    for (int ch = 0; ch < 8; ++ch) {
        const int cn = ch + 1 < 8 ? ch + 1 : ch;
        CMP_ALOAD(cn);
        const LAS unsigned char* ab = abuf + (ch & 1) * 16896 + (lane & 31) * 528 + 16 * h;
        bf16x8 bfr[16];
#pragma unroll
        for (int ks = 0; ks < 16; ++ks) bfr[ks] = *(const bf16x8*)(w1p + (ch * 16 + ks) * 512);
#pragma unroll
        for (int ks = 0; ks < 16; ++ks) {
            const bf16x8 af = *(const LAS bf16x8*)(ab + 32 * ks);
            acc = __builtin_amdgcn_mfma_f32_32x32x16_bf16(af, bfr[ks], acc, 0, 0, 0);
        }
        CMP_AWRITE((ch + 1) & 1);
        __syncthreads();
    }
#undef CMP_ALOAD
#undef CMP_AWRITE
    {
        const int j = 32 * w + (lane & 31); const float bb = P.b1[j];
#pragma unroll
        for (int r = 0; r < 16; ++r) {
            const float x = acc[r] + bb;
            const float u = 0.7978845608028654f * (x + 0.044715f * x * x * x);
            const float th = 1.f - 2.f / (1.f + __expf(2.f * u));
            const float gl = 0.5f * x * (1.f + th);
            *(LAS bf16_t*)(hidl + crow(r, h) * 528 + j * 2) = f2bf(gl);
        }
    }
    __syncthreads();
    float outv[16]; float ssp[16];
    if (w < 2) {
        f32x16 a2 = (f32x16){};
        const bf16_t* w2p = P.W2T + (size_t)(32 * w + (lane & 31)) * 256 + 8 * h;
#pragma unroll
        for (int ks = 0; ks < 16; ++ks) {
            const bf16x8 af = *(const LAS bf16x8*)(hidl + (lane & 31) * 528 + (16 * ks + 8 * h) * 2);
            const bf16x8 bfr = *(const bf16x8*)(w2p + 16 * ks);
            a2 = __builtin_amdgcn_mfma_f32_32x32x16_bf16(af, bfr, a2, 0, 0, 0);
        }
        const float bb = P.b2[32 * w + (lane & 31)];
#pragma unroll
        for (int r = 0; r < 16; ++r) {
            outv[r] = a2[r] + bb;
            float ss = outv[r] * outv[r];
            ss += __shfl_xor(ss, 1); ss += __shfl_xor(ss, 2); ss += __shfl_xor(ss, 4); ss += __shfl_xor(ss, 8); ss += __shfl_xor(ss, 16);
            ssp[r] = ss;
            if ((lane & 31) == 0) ssx[w * 32 + crow(r, h)] = ss;
        }
    }
    __syncthreads();
    if (w < 2) {
        const int d = 32 * w + (lane & 31);
        const float gn = P.gain ? P.gain[d] : 1.f;
#pragma unroll
        for (int r = 0; r < 16; ++r) {
            const int row = 32 * P.rt + crow(r, h);
            float v = outv[r];
            if (P.gain) { const float tot = ssx[crow(r, h)] + ssx[32 + crow(r, h)]; v = v * rsqrtf(tot * (1.f / 64.f) + 1e-6f) * gn; }
            if (row <= 510) P.OUT[(size_t)row * 64 + d] = f2bf(v);
        }
    }
    __syncthreads();
}

struct NsaArgs {
    const bf16_t* Hb; size_t brow; int qb;
    const bf16_t* KC; const bf16_t* VC;
    const float* bias;
    const float* Mv;
    bf16_t* Y; unsigned* cdone;
    float* scr;
};
constexpr int GTOP = 2015, GTS = 2519, WTOP = 549, WTS = 588, DEAD = 4 * GTS + 4 * WTS;
__device__ __forceinline__ void nsa_unit(LAS unsigned char* lds, const NsaArgs& P) {
    const int tid = opq(threadIdx.x), lane = tid & 63, w = __builtin_amdgcn_readfirstlane(tid >> 6), hh = lane >> 5;
    const int n = lane & 31, q8 = n >> 2, hd = n & 3;
    LAS float* tg = (LAS float*)(lds + L_TAB);
    LAS float* tw = tg + 4 * GTS;
    LAS float* dead = tg + DEAD;
    LAS float* impw = (LAS float*)(lds + L_IMP) + w * 1024;
    LAS unsigned* selw = (LAS unsigned*)(lds + L_SEL) + w * 32;
    LAS unsigned* uni = (LAS unsigned*)(lds + L_SEL) + 256;
    LAS float* ws_ = (LAS float*)(lds + L_WSCR) + w * 256;
    LAS float* sbh = (LAS float*)(lds + L_SB);
    if (tid < 128) sbh[tid] = (P.bias[(tid & 31) * 16 + (tid >> 5)] - P.Mv[tid >> 5]) * LOG2E;
    __syncthreads();
    for (int e = tid; e < 4 * GTS; e += 512) { const int hq = e / GTS, j = e % GTS, dist = GTOP - j;
        tg[e] = dist >= 0 ? sbh[hq * 32 + t5_bucket(dist)] : -1e30f; }
    for (int e = tid; e < 4 * WTS; e += 512) { const int hq = e / WTS, j = e % WTS, dist = WTOP - j;
        tw[e] = (dist >= 0 && dist <= 511) ? sbh[hq * 32 + t5_bucket(dist)] : -1e30f; }
    if (tid < 64) dead[tid] = -1e30f;
    for (int e = lane; e < 1024; e += 64) impw[e] = 0.f;
    if (tid < 4) uni[tid] = 0u;
    const float cfar = sbh[hd * 32 + 31];
    const int tq = 64 * P.qb + 8 * w + q8;
    const int twmin = 64 * P.qb + 8 * w, twmax = twmin + 7;
    bf16x8 qf[4];
    {
        const bf16_t* qp = P.Hb + (size_t)tq * HP + C_DQ + 64 * hd + 8 * hh;
#pragma unroll
        for (int s = 0; s < 4; ++s) qf[s] = *(const bf16x8*)(qp + 16 * s);
        asm volatile("" : "+v"(qf[0]), "+v"(qf[1]), "+v"(qf[2]), "+v"(qf[3]));
    }
    {
        const bf16_t* gp = P.Hb + (size_t)tq * HP + C_GT + 3 * hd;
        if (hh == 0) { ws_[n] = bf2f(gp[0]); ws_[32 + n] = bf2f(gp[1]); ws_[64 + n] = bf2f(gp[2]); }
    }
    const int srow = tid >> 3, sch = tid & 7;
    StageRegs sr;
    f32x16 o[2], outv[2];
    float den = 0.f;
    o[0] = (f32x16){}; o[1] = (f32x16){};
    {
        const int kt0 = P.qb >= 8 ? P.qb - 8 : 0, nkt = P.qb - kt0 + 1;
        {
            const bf16_t* rp = P.Hb + (size_t)(64 * kt0 + srow) * HP;
            stage_load(sr, rp + C_KW, rp + C_VW, true, sch);
            stage_write(lds + L_KV, sr, srow, sch);
        }
        __syncthreads();
        for (int t = 0; t < nkt; ++t) {
            LAS unsigned char* buf = lds + L_KV + (t & 1) * KVB;
            if (t + 1 < nkt) { const bf16_t* rp = P.Hb + (size_t)(64 * (kt0 + t + 1) + srow) * HP; stage_load(sr, rp + C_KW, rp + C_VW, true, sch); }
#pragma unroll
            for (int sub = 0; sub < 2; ++sub) {
                const int kb = 64 * (kt0 + t) + 32 * sub;
                if (kb <= twmax && kb + 31 >= twmin - 511) {
                    f32x16 acc;
                    const LAS float* tb = tw + hd * WTS + (WTOP - (tq - kb - 4 * hh));
#pragma unroll
                    for (int r = 0; r < 16; ++r) acc[r] = tb[(r & 3) + 8 * (r >> 2)];
                    qk_sub<0, 4>(acc, buf, sub, qf, lane);
#pragma unroll
                    for (int r = 0; r < 1; ++r) den += exp_sum16(acc);
                    bf16x8 pa0, pa1; pack_p(acc, pa0, pa1);
                    pv_sub(o, buf, sub, pa0, pa1, lane);
                }
            }
            if (t + 1 < nkt) stage_write(lds + L_KV + ((t + 1) & 1) * KVB, sr, srow, sch);
            __syncthreads();
        }
    }
    {
        const float dt = den + __shfl_xor(den, 32);
        if (hh == 0) ws_[128 + n] = __builtin_amdgcn_rcpf(dt);
        asm volatile("s_waitcnt lgkmcnt(0)" ::: "memory");
#pragma unroll
        for (int r = 0; r < 16; ++r) { const int nn = crow(r, hh); const float gi = ws_[64 + nn] * ws_[128 + nn]; outv[0][r] = o[0][r] * gi; outv[1][r] = o[1][r] * gi; }
    }
    if (opq(threadIdx.x) == 128) {
        unsigned sp = 0;
        while (__hip_atomic_load(P.cdone, __ATOMIC_RELAXED, __HIP_MEMORY_SCOPE_AGENT) < 64u) { __builtin_amdgcn_s_sleep(2); if (++sp > (1u << 24)) break; }
        __builtin_amdgcn_fence(__ATOMIC_ACQUIRE, "agent"); asm volatile("s_waitcnt vmcnt(0)" ::: "memory");
    }
    __syncthreads();
    const int tlast = 64 * P.qb + 63;
    const int ntc = tlast >= 31 ? (((tlast - 31) >> 4) >> 6) + 1 : 0;
    float invden = 0.f; den = 0.f;
    o[0] = (f32x16){}; o[1] = (f32x16){};
    for (int pass = 0; pass < 2; ++pass) {
        if (ntc > 0) {
            __syncthreads();
            stage_load(sr, P.KC + (size_t)srow * 64, P.VC + (size_t)srow * 64, true, sch);
            stage_write(lds + L_KV, sr, srow, sch);
            __syncthreads();
            for (int t = 0; t < ntc; ++t) {
                LAS unsigned char* buf = lds + L_KV + (t & 1) * KVB;
                if (t + 1 < ntc) stage_load(sr, P.KC + (size_t)(64 * (t + 1) + srow) * 64, P.VC + (size_t)(64 * (t + 1) + srow) * 64, true, sch);
#pragma unroll
                for (int sub = 0; sub < 2; ++sub) {
                    const int cb = 64 * t + 32 * sub;
                    if (16 * cb + 31 <= twmax) {
                        f32x16 acc;
                        const int dmin = twmin - 16 * (cb + 31) - 31;
                        if (dmin >= 1513) acc = splat16(cfar);
                        else {
                            const LAS float* tb = tg + hd * GTS + (GTOP - (tq - 31 - 16 * cb - 64 * hh));
#pragma unroll
                            for (int r = 0; r < 16; ++r) acc[r] = tb[16 * ((r & 3) + 8 * (r >> 2))];
                        }
                        qk_sub<0, 4>(acc, buf, sub, qf, lane);
#pragma unroll
                        for (int r = 0; r < 16; ++r) acc[r] = __builtin_amdgcn_exp2f(acc[r]);
                        if (pass == 0) {
#pragma unroll
                            for (int r = 0; r < 16; ++r) { den += acc[r]; asm volatile("" : "+v"(den)); }
                        } else {
#pragma unroll
                            for (int r = 0; r < 16; ++r) acc[r] *= invden;
#pragma unroll
                            for (int g = 0; g < 4; ++g) {
                                float G = (acc[4 * g] + acc[4 * g + 1]) + (acc[4 * g + 2] + acc[4 * g + 3]), C = acc[4 * g + 3];
                                G += __shfl_xor(G, 1); G += __shfl_xor(G, 2); C += __shfl_xor(C, 1); C += __shfl_xor(C, 2);
                                if (hd == 0) {
                                    const int j = (cb >> 2) + 2 * g + hh;
                                    __hip_atomic_fetch_add(impw + q8 * 128 + j, G, __ATOMIC_RELAXED, __HIP_MEMORY_SCOPE_WORKGROUP);
                                    if (j + 1 < 128) __hip_atomic_fetch_add(impw + q8 * 128 + j + 1, C, __ATOMIC_RELAXED, __HIP_MEMORY_SCOPE_WORKGROUP);
                                }
                            }
                            bf16x8 pa0, pa1; pack_p(acc, pa0, pa1);
                            pv_sub(o, buf, sub, pa0, pa1, lane);
                        }
                    }
                }
                if (t + 1 < ntc) stage_write(lds + L_KV + ((t + 1) & 1) * KVB, sr, srow, sch);
                __syncthreads();
            }
        }
        if (pass == 0) { const float dt = den + __shfl_xor(den, 32); invden = dt > 0.f ? 1.f / dt : 0.f; }
    }
    asm volatile("s_waitcnt lgkmcnt(0)" ::: "memory");
#pragma unroll
    for (int r = 0; r < 16; ++r) { const float g0 = ws_[crow(r, hh)]; outv[0][r] += o[0][r] * g0; outv[1][r] += o[1][r] * g0; }
    {
        float* sp = P.scr + tid;
#pragma unroll
        for (int r = 0; r < 16; ++r) { sp[r * 512] = outv[0][r]; sp[(16 + r) * 512] = outv[1][r]; }
    }
    {
        const int qsel = lane >> 3, sb = lane & 7;
        unsigned key[16];
#pragma unroll
        for (int i4 = 0; i4 < 4; ++i4) {
            const f32x4 v = *(const LAS f32x4*)(impw + qsel * 128 + sb * 16 + 4 * i4);
#pragma unroll
            for (int e = 0; e < 4; ++e) {
                const int j = sb * 16 + 4 * i4 + e;
                const bool forced = (j == 0) | (j == P.qb) | (j == P.qb - 1);
                key[4 * i4 + e] = forced ? 0xFFFFFFFFu : (j <= P.qb ? __float_as_uint(v[e]) + 1u : 0u);
            }
        }
        unsigned T = 0u;
        for (int bit = 31; bit >= 0; --bit) {
            const unsigned cand = T | (1u << bit);
            int cnt = 0;
#pragma unroll
            for (int i = 0; i < 16; ++i) cnt += key[i] >= cand ? 1 : 0;
            cnt += __shfl_xor(cnt, 1); cnt += __shfl_xor(cnt, 2); cnt += __shfl_xor(cnt, 4);
            if (cnt >= 16) T = cand;
        }
        int cgt = 0, ceq = 0;
#pragma unroll
        for (int i = 0; i < 16; ++i) { cgt += key[i] > T ? 1 : 0; ceq += key[i] == T ? 1 : 0; }
        int cg = cgt; cg += __shfl_xor(cg, 1); cg += __shfl_xor(cg, 2); cg += __shfl_xor(cg, 4);
        int pre = 0;
#pragma unroll
        for (int k = 0; k < 8; ++k) { const int v = __shfl(ceq, (lane & ~7) + k); if (k < sb) pre += v; }
        int need = 16 - cg - pre;
        unsigned bits = 0u;
#pragma unroll
        for (int i = 0; i < 16; ++i) {
            const int j = sb * 16 + i;
            bool s_ = key[i] > T;
            if (key[i] == T) { if (need > 0) { s_ = true; } --need; }
            if (s_ && j <= P.qb) bits |= 1u << i;
        }
        const unsigned other = __shfl_xor(bits, 1);
        const unsigned word = (sb & 1) ? ((bits << 16) | other) : (bits | (other << 16));
        if ((sb & 1) == 0) { selw[qsel * 4 + (sb >> 1)] = word; __hip_atomic_fetch_or(uni + (sb >> 1), word, __ATOMIC_RELAXED, __HIP_MEMORY_SCOPE_WORKGROUP); }
    }
    __syncthreads();
    unsigned lm0 = selw[q8 * 4 + 0], lm1 = selw[q8 * 4 + 1], lm2 = selw[q8 * 4 + 2], lm3 = selw[q8 * 4 + 3];
    unsigned wm0 = 0, wm1 = 0, wm2 = 0, wm3 = 0;
#pragma unroll
    for (int k = 0; k < 8; ++k) { wm0 |= selw[k * 4 + 0]; wm1 |= selw[k * 4 + 1]; wm2 |= selw[k * 4 + 2]; wm3 |= selw[k * 4 + 3]; }
    wm0 = __builtin_amdgcn_readfirstlane(wm0); wm1 = __builtin_amdgcn_readfirstlane(wm1); wm2 = __builtin_amdgcn_readfirstlane(wm2); wm3 = __builtin_amdgcn_readfirstlane(wm3);
    const unsigned um0 = __builtin_amdgcn_readfirstlane(uni[0]), um1 = __builtin_amdgcn_readfirstlane(uni[1]), um2 = __builtin_amdgcn_readfirstlane(uni[2]), um3 = __builtin_amdgcn_readfirstlane(uni[3]);
#define NSA_WORD(a0, a1, a2, a3, j) ((j) < 32 ? (a0) : ((j) < 64 ? (a1) : ((j) < 96 ? (a2) : (a3))))
#define NSA_NEXT(j, res) do { int _j = (j); res = 128; while (_j < 128) { const unsigned _w = NSA_WORD(um0, um1, um2, um3, _j) >> (_j & 31); if (_w) { res = _j + __builtin_ctz(_w); break; } _j = (_j | 31) + 1; } } while (0)
    o[0] = (f32x16){}; o[1] = (f32x16){}; den = 0.f;
#define NSA_SLC_COMPUTE(JJ, BUF) do { \
        if ((NSA_WORD(wm0, wm1, wm2, wm3, (JJ)) >> ((JJ) & 31)) & 1u) { \
            const bool lsel = (NSA_WORD(lm0, lm1, lm2, lm3, (JJ)) >> ((JJ) & 31)) & 1u; \
            _Pragma("unroll") for (int sub = 0; sub < 2; ++sub) { \
                const int kb = 64 * (JJ) + 32 * sub; \
                if (kb <= twmax) { \
                    f32x16 acc; \
                    if (twmin - kb - 31 >= 1513) acc = splat16(lsel ? cfar : -1e30f); \
                    else { const LAS float* tb = lsel ? tg + hd * GTS + (GTOP - (tq - kb - 4 * hh)) : dead; \
                        _Pragma("unroll") for (int r = 0; r < 16; ++r) acc[r] = tb[(r & 3) + 8 * (r >> 2)]; } \
                    qk_sub<0, 4>(acc, (BUF), sub, qf, lane); \
                    den += exp_sum16(acc); \
                    bf16x8 pa0, pa1; pack_p(acc, pa0, pa1); \
                    pv_sub(o, (BUF), sub, pa0, pa1, lane); \
                } } } } while (0)
#define NSA_SLC_LOAD(JJ, SR) do { const bf16_t* rp_ = P.Hb + (size_t)(64 * (JJ) + srow) * HP; stage_load(SR, rp_ + C_KS, rp_ + C_VS, true, sch); } while (0)
    {
        LAS unsigned char* pb0 = lds + L_KV; LAS unsigned char* pb1 = lds + L_IMP;
        StageRegs a0, a1, b0, b1;
#define NSA_PAIR(prev, ra, rb) do { ra = 128; if ((prev) < 128) { NSA_NEXT((prev) + 1, ra); } rb = 128; if (ra < 128) { NSA_NEXT(ra + 1, rb); } } while (0)
#define NSA_SLC_LOADC(JJ, SR) do { const int jc_ = (JJ) < 128 ? (JJ) : 0; NSA_SLC_LOAD(jc_, SR); } while (0)
        int ca, cb_, n1a, n1b, n2a, n2b, n3a, n3b;
        NSA_NEXT(0, ca); cb_ = 128; if (ca < 128) { NSA_NEXT(ca + 1, cb_); }
        NSA_PAIR(cb_, n1a, n1b); NSA_PAIR(n1b, n2a, n2b);
        NSA_SLC_LOADC(ca, b0); NSA_SLC_LOADC(cb_, b1);
        NSA_SLC_LOADC(n1a, a0); NSA_SLC_LOADC(n1b, a1);
        stage_write(pb0, b0, srow, sch); stage_write(pb0 + KVB, b1, srow, sch);
        NSA_SLC_LOADC(n2a, b0); NSA_SLC_LOADC(n2b, b1);
        __syncthreads();
        for (;;) {
            NSA_SLC_COMPUTE(ca, pb0);
            if (cb_ < 128) NSA_SLC_COMPUTE(cb_, pb0 + KVB);
            stage_write(pb1, a0, srow, sch); stage_write(pb1 + KVB, a1, srow, sch);
            NSA_PAIR(n2b, n3a, n3b);
            NSA_SLC_LOADC(n3a, a0); NSA_SLC_LOADC(n3b, a1);
            __syncthreads();
            if (n1a >= 128) break;
            NSA_SLC_COMPUTE(n1a, pb1);
            if (n1b < 128) NSA_SLC_COMPUTE(n1b, pb1 + KVB);
            stage_write(pb0, b0, srow, sch); stage_write(pb0 + KVB, b1, srow, sch);
            int n4a, n4b; NSA_PAIR(n3b, n4a, n4b);
            NSA_SLC_LOADC(n4a, b0); NSA_SLC_LOADC(n4b, b1);
            __syncthreads();
            if (n2a >= 128) break;
            ca = n2a; cb_ = n2b; n1a = n3a; n1b = n3b; n2a = n4a; n2b = n4b;
        }
#undef NSA_PAIR
#undef NSA_SLC_LOADC
    }
#undef NSA_SLC_COMPUTE
#undef NSA_SLC_LOAD
    {
        const float dt = den + __shfl_xor(den, 32);
        if (hh == 0) ws_[96 + n] = 1.f / dt;
        asm volatile("s_waitcnt lgkmcnt(0)" ::: "memory");
        const float* sp = P.scr + tid;
#pragma unroll
        for (int r = 0; r < 16; ++r) { const float gi = ws_[32 + crow(r, hh)] * ws_[96 + crow(r, hh)]; outv[0][r] = sp[r * 512] + o[0][r] * gi; outv[1][r] = sp[(16 + r) * 512] + o[1][r] * gi; }
    }
    {
#pragma unroll
        for (int r = 0; r < 16; ++r) {
            const int nn = crow(r, hh);
            const size_t trow = (size_t)(64 * P.qb + 8 * w + (nn >> 2));
            const int ycol = 768 + 64 * (nn & 3);
            const bf16_t* sp = P.Hb + trow * HP + C_SILU + ycol;
            bf16_t* yp = P.Y + (P.brow + trow) * DM + ycol;
            yp[n] = f2bf(outv[0][r] * bf2f(sp[n]));
            yp[32 + n] = f2bf(outv[1][r] * bf2f(sp[32 + n]));
        }
    }
    __syncthreads();
#undef NSA_WORD
#undef NSA_NEXT
}
}

#define XB_TMO      128
#define XB_XCNT(j)  (256  + 64 * (j))
#define XB_XSUB(j)  (1280 + 64 * (j))
#define XB_XGEN(j)  (2304 + 64 * (j))
#define XB_TOP      3328
#define XB_TOPGEN   3392
#define XCD_BAR_WORDS 3456
#define XB_SPIN_CAP (1u << 22)
__device__ __forceinline__ unsigned xb_ld(unsigned* p)              { return __hip_atomic_load(p, __ATOMIC_RELAXED, __HIP_MEMORY_SCOPE_AGENT); }
__device__ __forceinline__ unsigned xb_add(unsigned* p, unsigned v) { return __hip_atomic_fetch_add(p, v, __ATOMIC_RELAXED, __HIP_MEMORY_SCOPE_AGENT); }
__device__ __forceinline__ unsigned xb_xcc_id() { return (unsigned)__builtin_amdgcn_s_getreg((3 << 11) | 20) & 0xFu; }
#define XB_SPIN(cond, bar) do { unsigned _sp = 0; while (cond) { __builtin_amdgcn_s_sleep(1); \
    if ((++_sp & 255u) == 0u) { if (xb_ld(&(bar)[XB_TMO])) break; if (_sp > XB_SPIN_CAP) { atomicAdd(&(bar)[XB_TMO], 1u); break; } } } } while (0)
struct XcdBarrier { unsigned* bar; unsigned x; volatile LAS unsigned* st; };
__device__ __forceinline__ XcdBarrier xcd_barrier_post(unsigned* bar, volatile LAS unsigned* st) {
    XcdBarrier b; b.bar = bar; b.x = xb_xcc_id(); b.st = st;
    if (threadIdx.x == 0) (void)xb_add(&bar[XB_XCNT(b.x)], 1u);
    return b;
}
__device__ __forceinline__ void xcd_barrier_complete(unsigned* bar, unsigned x, unsigned& nloc, unsigned& nx) {
    const unsigned G = gridDim.x * gridDim.y * gridDim.z;
    unsigned sum, cnt, mine, sp = 0u;
    for (;;) {
        sum = 0u; cnt = 0u; mine = 0u;
#pragma unroll
        for (unsigned j = 0; j < 16; ++j) { const unsigned c = xb_ld(&bar[XB_XCNT(j)]); sum += c; cnt += (c > 0u) ? 1u : 0u; mine = (j == x) ? c : mine; }
        if (sum == G) break;
        __builtin_amdgcn_s_sleep(1);
        if ((++sp & 255u) == 0u) { if (xb_ld(&bar[XB_TMO])) break; if (sp > XB_SPIN_CAP) { atomicAdd(&bar[XB_TMO], 1u); break; } }
    }
    nloc = mine > 0u ? mine : 1u; nx = cnt > 0u ? cnt : 1u;
}
__device__ __forceinline__ void xcd_barrier(const XcdBarrier& b) {
    asm volatile("s_waitcnt vmcnt(0)" ::: "memory");
    __syncthreads();
    if (threadIdx.x == 0) {
        unsigned* bar = b.bar;
        __builtin_amdgcn_s_waitcnt(0);
        unsigned nloc = b.st[0], nx = b.st[1];
        if (nloc == 0u) { xcd_barrier_complete(bar, b.x, nloc, nx); b.st[0] = nloc; b.st[1] = nx; }
        const unsigned old = xb_add(&bar[XB_XSUB(b.x)], 1u);
        const unsigned gen = old / nloc;
        if (old + 1u == (gen + 1u) * nloc) {
            __builtin_amdgcn_fence(__ATOMIC_RELEASE, "agent");
            asm volatile("s_waitcnt vmcnt(0)" ::: "memory");
            const unsigned og = xb_add(&bar[XB_TOP], 1u);
            const unsigned tg = og / nx;
            if (og + 1u == (tg + 1u) * nx) xb_add(&bar[XB_TOPGEN], 1u);
            else XB_SPIN(xb_ld(&bar[XB_TOPGEN]) == tg, bar);
            __builtin_amdgcn_fence(__ATOMIC_ACQUIRE, "agent");
            xb_add(&bar[XB_XGEN(b.x)], 1u);
            asm volatile("s_waitcnt vmcnt(0)" ::: "memory");
        } else {
            XB_SPIN(xb_ld(&bar[XB_XGEN(b.x)]) == gen, bar);
            __builtin_amdgcn_fence(__ATOMIC_ACQUIRE, "agent");
            asm volatile("s_waitcnt vmcnt(0)" ::: "memory");
        }
    }
    __syncthreads();
}

constexpr int NT = 512, LDS_BYTES = 147456, MISC_OFF = 131072 + 320;
#ifndef R_C
#define R_C 1
#endif
#ifndef R_D
#define R_D 1
#endif
#ifndef R_AB
#define R_AB 1
#endif
#ifndef R_G1
#define R_G1 1
#endif
constexpr size_t MiB = 1u << 20;
constexpr size_t WS_CTL = 0, CTL_ZERO_BYTES = 65536;
constexpr size_t WS_NSCR = 184 * MiB;
constexpr size_t WS_H = 2 * MiB, WS_XN = 124 * MiB, WS_T0 = 158 * MiB, WS_IMP = 208 * MiB, WS_SEL = 217 * MiB, WS_HID = 218 * MiB, WS_KC = 221 * MiB, WS_VC = 222 * MiB, WS_WIN = 224 * MiB, WS_WOUT = 240 * MiB, WS_MX = 1 * MiB, WS_DA = 245 * MiB, WS_CW1 = 246 * MiB, WS_CW2 = 250 * MiB, WS_RSS = 251 * MiB;

struct Args { const float* in[15]; float* out; unsigned char* ws; };

__global__ void __launch_bounds__(NT, 2) mega_fwd(Args args) {
    extern __shared__ __attribute__((aligned(16))) unsigned char lds[];
    const int tid = threadIdx.x, lane = tid & 63, wid = tid >> 6;
    const int G = gridDim.x, bid = blockIdx.x;
    volatile LAS unsigned* MISC = (volatile LAS unsigned*)((LAS unsigned char*)lds + MISC_OFF);
    if (tid < 32) MISC[tid] = 0u;
    __syncthreads();
    unsigned char* ws = args.ws;
    XcdBarrier bar = xcd_barrier_post((unsigned*)(ws + WS_CTL) + 4096, MISC + 8);
    const float* x = args.in[0]; const float* tab = args.in[1]; const float* norm_w = args.in[2];
    const float* w_in = args.in[3]; const float* w_out = args.in[4]; const float* qk_gain = args.in[5];
    const float* qk_gain_diff = args.in[6]; const float* sinks = args.in[7]; const float* diff_lambda = args.in[8];
    const float* diff_subln = args.in[9]; const float* cmp_pos = args.in[10]; const float* cmp_w1 = args.in[11];
    const float* cmp_b1 = args.in[12]; const float* cmp_w2 = args.in[13]; const float* cmp_b2 = args.in[14];
    float* out = args.out;
    bf16_t* H = (bf16_t*)(ws + WS_H);
    bf16_t* XN = (bf16_t*)(ws + WS_XN); bf16_t* Y = XN;
    float* T0 = (float*)(ws + WS_T0);
    float* OC = T0; float* OS_ = T0 + (size_t)MROWS * 256; float* OW = T0 + (size_t)MROWS * 512; float* CT = T0;
    float* IMP = (float*)(ws + WS_IMP); unsigned* SEL = (unsigned*)(ws + WS_SEL); float* HID = (float*)(ws + WS_HID);
    float* KC = (float*)(ws + WS_KC); float* VC = (float*)(ws + WS_VC);
    const int GT = G * NT, GW = G * 8;
    bf16_t* WinT = (bf16_t*)(ws + WS_WIN); bf16_t* WoutT = (bf16_t*)(ws + WS_WOUT);
#define GRID_BAR() do { XcdBarrier b2_ = bar; asm volatile("" : "+s"(b2_.x)); xcd_barrier(b2_); } while (0)
    {
        LAS float* scr = (LAS float*)((LAS unsigned char*)lds + wid * 16384);
        const int gw0 = bid * 8 + wid;
        constexpr int I_IN = 16 * 120, I_OUT = 16 * 32, I_C1 = 32 * 8, I_C2 = 4 * 2, I_L = I_IN + I_OUT + 2 * I_C1 + 2 * I_C2, NITEMS = 2 * I_L;
        bf16_t* CW1T = (bf16_t*)(ws + WS_CW1); bf16_t* CW2T = (bf16_t*)(ws + WS_CW2);
        for (int it = gw0; it < NITEMS; it += GW) {
            const int l = it / I_L; int r = it % I_L;
            if (r < I_IN) { p0_transpose_item<0>(w_in + (size_t)l * DM * PW, WinT + (size_t)l * HP * DM, scr, r, lane); continue; } r -= I_IN;
            if (r < I_OUT) { p0_transpose_item<1>(w_out + (size_t)l * DM * DM, WoutT + (size_t)l * DM * DM, scr, r, lane); continue; } r -= I_OUT;
            if (r < 2 * I_C1) { const int kv = r / I_C1; p0_transpose_item<2>(cmp_w1 + (size_t)(l * 2 + kv) * 2048 * 256, CW1T + (size_t)(l * 2 + kv) * 256 * 2048, scr, r % I_C1, lane, 2048, 256); continue; } r -= 2 * I_C1;
            { const int kv = r / I_C2; p0_transpose_item<1>(cmp_w2 + (size_t)(l * 2 + kv) * 256 * 64, CW2T + (size_t)(l * 2 + kv) * 64 * 256, scr, r % I_C2, lane, 256, 64); }
        }
        if (bid == 1 && tid < 256) { bf16_t* KCb = (bf16_t*)(ws + WS_KC); KCb[(size_t)(tid >> 6) * 512 * 64 + 511 * 64 + (tid & 63)] = 0; }
        for (int w = gw0; w < MROWS; w += GW) k_rmsnorm(w, lane, x, norm_w, XN);
        for (int v = bid * NT + tid; v < MROWS; v += GT) ((unsigned long long*)(ws + WS_RSS))[v] = 0ull;
        if (bid == 0 && wid == 0) {
            float* MX = (float*)(ws + WS_MX);
            for (int l = 0; l < 2; ++l) {
                float mg[8];
#pragma unroll
                for (int i = 0; i < 8; ++i) { float v = fabsf(qk_gain[l * 512 + i * 64 + lane]);
#pragma unroll
                    for (int o = 1; o < 64; o <<= 1) v = fmaxf(v, __shfl_xor(v, o));
                    mg[i] = v; }
                float md0 = lane < 32 ? fabsf(qk_gain_diff[l * 64 + lane]) : 0.f, md1 = lane < 32 ? fabsf(qk_gain_diff[l * 64 + 32 + lane]) : 0.f;
#pragma unroll
                for (int o = 1; o < 64; o <<= 1) { md0 = fmaxf(md0, __shfl_xor(md0, o)); md1 = fmaxf(md1, __shfl_xor(md1, o)); }
                for (int gh = 0; gh < 16; ++gh) {
                    float mb = lane < 32 ? fabsf(tab[lane * 16 + gh]) : 0.f;
#pragma unroll
                    for (int o = 1; o < 64; o <<= 1) mb = fmaxf(mb, __shfl_xor(mb, o));
                    const int grp = gh >> 2, hh = gh & 3; float Mv;
                    if (grp == 0) Mv = 8.f * mg[0] * mg[1] + mb;
                    else if (grp == 1) Mv = fmaxf(8.f * mg[2] * mg[3] + mb, sinks[l * 4 + hh]);
                    else if (grp == 2) Mv = 5.656854249f * md0 * md1 + mb;
                    else Mv = 8.f * mg[4] * fmaxf(mg[5], fmaxf(mg[6], mg[7])) + mb;
                    if (lane == 0) MX[l * 16 + gh] = Mv;
                }
                float s1 = lane < 32 ? diff_lambda[l * 128 + lane] * diff_lambda[l * 128 + 32 + lane] : 0.f;
                float s2 = lane < 32 ? diff_lambda[l * 128 + 64 + lane] * diff_lambda[l * 128 + 96 + lane] : 0.f;
#pragma unroll
                for (int o = 1; o < 64; o <<= 1) { s1 += __shfl_xor(s1, o); s2 += __shfl_xor(s2, o); }
                const float lambda_init = 0.8f - 0.6f * expf(-0.3f * (float)l);
                if (lane == 0) { MX[32 + l] = expf(s1) - expf(s2) + lambda_init; MX[34 + l] = lambda_init; }
            }
        }
    }
    GRID_BAR();
#pragma unroll 1
    for (int l = 0; l < 2; ++l) {
        const float* xprev = l == 0 ? x : out;
        { pg8::Gemm g{XN, WinT + (size_t)l * HP * DM, MROWS, HP, DM}; pg8::StaticOrder So; So.init(MROWS, HP, G, bid);
          pg8::EpiProj E{H, qk_gain + l * 512, qk_gain_diff + l * 64, l == 0 ? nullptr : (const float*)(ws + WS_RSS)};
          for (int rep = 0; rep < R_G1; ++rep) pg8::gemm_phase<pg8::EpiProj, pg8::StaticOrder, true, true>((LAS unsigned char*)lds, g, So, E); }
        GRID_BAR();
        {
            const float* MX = (const float*)(ws + WS_MX);
            bf16_t* OA = (bf16_t*)(ws + WS_T0); float* DA = (float*)(ws + WS_DA);
            bf16_t* KCb = (bf16_t*)(ws + WS_KC);
            const bf16_t* CW1T = (const bf16_t*)(ws + WS_CW1); const bf16_t* CW2T = (const bf16_t*)(ws + WS_CW2);
            LAS unsigned* qw = (LAS unsigned*)((LAS unsigned char*)lds + att::L_Q);
            unsigned* qctr = (unsigned*)(ws + WS_CTL) + 8192 + 128 * l;
            unsigned* cdone = qctr + 64;
            constexpr int B0 = 64, B1 = B0 + 160 * R_C, B2 = B1 + 256 * R_D, B3 = B2 + 96 * R_C, B4 = B3 + 768 * R_AB, NUV = B4 + 256 * R_AB;
            for (;;) {
                if (opq(threadIdx.x) == 0) *qw = atomicAdd(qctr, 1u);
                __syncthreads();
                const int uv = (int)*qw;
                __syncthreads();
                if (uv >= NUV) break;
                int u;
                if (uv < B0) u = uv; else if (uv < B1) u = 64 + (uv - B0) / R_C; else if (uv < B2) u = 224 + (uv - B1) / R_D; else if (uv < B3) u = 480 + (uv - B2) / R_C;
                else if (uv < B4) u = 576 + (uv - B3) / R_AB; else u = 1344 + (uv - B4) / R_AB;
                if (u < 64) {
                    const int kv = u >> 5, b = (u >> 4) & 1, rt = u & 15;
                    att::CmpArgs P; P.Hb = H + (size_t)b * S * HP; P.col = kv == 0 ? C_KC : C_VC; P.rt = rt;
                    P.pos = cmp_pos + (size_t)(l * 2 + kv) * 2048; P.W1T = CW1T + (size_t)(l * 2 + kv) * 256 * 2048; P.b1 = cmp_b1 + (l * 2 + kv) * 256;
                    P.W2T = CW2T + (size_t)(l * 2 + kv) * 64 * 256; P.b2 = cmp_b2 + (l * 2 + kv) * 64; P.gain = kv == 0 ? qk_gain + l * 512 + 5 * 64 : nullptr;
                    P.OUT = KCb + (size_t)(kv * NB + b) * 512 * 64;
                    att::cmp_unit((LAS unsigned char*)lds, P);
                    asm volatile("s_waitcnt vmcnt(0)" ::: "memory");
                    __syncthreads();
                    if (opq(threadIdx.x) == 64) { __builtin_amdgcn_fence(__ATOMIC_RELEASE, "agent"); asm volatile("s_waitcnt vmcnt(0)" ::: "memory");
                        __hip_atomic_fetch_add(cdone, 1u, __ATOMIC_RELAXED, __HIP_MEMORY_SCOPE_AGENT); }
                    __syncthreads();
                } else if ((u >= 64 && u < 224) || (u >= 480 && u < 576)) {
                    int qb, bh;
                    if (u < 224) { qb = 31 - ((u - 64) >> 3); bh = (u - 64) & 7; } else { qb = 11 - ((u - 480) >> 3); bh = (u - 480) & 7; }
                    const int b = bh >> 2, hd = bh & 3;
                    att::DiffArgs P; P.Hb = H + (size_t)b * S * HP; P.hd = hd; P.qb = qb; P.brow = (size_t)b * S;
                    P.bias = tab + 8 + hd; P.M = MX[l * 16 + 8 + hd]; P.lam = MX[32 + l]; P.lambda_init = MX[34 + l]; P.subln = diff_subln + l * 64; P.Y = Y;
                    att::diff_unit((LAS unsigned char*)lds, P);
                } else if (u < 480) {
                    const int idx = u - 224, qb64 = 127 - (idx >> 1), b = idx & 1;
                    att::NsaArgs P; P.Hb = H + (size_t)b * S * HP; P.brow = (size_t)b * S; P.qb = qb64;
                    P.KC = KCb + (size_t)(0 * NB + b) * 512 * 64; P.VC = KCb + (size_t)(1 * NB + b) * 512 * 64;
                    P.bias = tab + 12; P.Mv = MX + l * 16 + 12; P.Y = Y; P.cdone = cdone; P.scr = (float*)(ws + WS_NSCR) + (size_t)bid * 16384;
                    att::nsa_unit((LAS unsigned char*)lds, P);
                } else if (u < 1344) {
                    const int v = u - 576, cfg = v >> 8, b = (v >> 7) & 1, hd = (v >> 5) & 3, ti = v & 31;
                    const int rate = cfg == 0 ? 1 : (cfg == 1 ? 4 : 16), tpc = 32 / rate;
                    att::BandArgs P; P.Hb = H + (size_t)b * S * HP; P.cq = C_AQ + 64 * hd; P.ck = C_AK + 64 * hd; P.cv = C_AV + 64 * hd;
                    P.rate = rate; P.cls = ti / tpc; P.f0 = (ti % tpc) * 256; P.maxd = 128; P.bias = tab + hd; P.M = MX[l * 16 + hd]; P.sinkterm = 0.f;
                    P.OA = OA + (size_t)cfg * MROWS * 256; P.DA = DA + (size_t)cfg * MROWS * 4; P.Y = nullptr; P.ycol = 0; P.hd = hd; P.brow = (size_t)b * S;
                    att::banded_unit<0>((LAS unsigned char*)lds, P);
                } else {
                    const int v = u - 1344, b = (v >> 7) & 1, hd = (v >> 5) & 3, ti = v & 31;
                    att::BandArgs P; P.Hb = H + (size_t)b * S * HP; P.cq = C_BQ + 64 * hd; P.ck = C_BK + 64 * (hd >> 1); P.cv = C_BV + 64 * (hd >> 1);
                    P.rate = 1; P.cls = 0; P.f0 = ti * 256; P.maxd = 127; P.bias = tab + 4 + hd; P.M = MX[l * 16 + 4 + hd];
                    P.sinkterm = __expf(sinks[l * 4 + hd] - P.M);
                    P.OA = nullptr; P.DA = nullptr; P.Y = Y; P.ycol = 256 + 64 * hd; P.hd = hd; P.brow = (size_t)b * S;
                    att::banded_unit<1>((LAS unsigned char*)lds, P);
                }
            }
        }
        GRID_BAR();
        {
            const bf16_t* OA = (const bf16_t*)(ws + WS_T0); const float* DA = (const float*)(ws + WS_DA);
            for (int v = (bid * NT + opq(threadIdx.x)); v < MROWS * 32; v += GT) {
                const int row = v >> 5, hd = (v >> 3) & 3, c8 = v & 7;
                float acc8[8] = {0.f, 0.f, 0.f, 0.f, 0.f, 0.f, 0.f, 0.f}; float dsum = 0.f;
#pragma unroll
                for (int cfg = 0; cfg < 3; ++cfg) {
                    const float dn = DA[((size_t)cfg * MROWS + row) * 4 + hd]; dsum += dn;
                    const uint4 r4 = *(const uint4*)(OA + ((size_t)cfg * MROWS + row) * 256 + hd * 64 + c8 * 8);
                    acc8[0] += dn * __uint_as_float(r4.x << 16); acc8[1] += dn * __uint_as_float(r4.x & 0xffff0000u);
                    acc8[2] += dn * __uint_as_float(r4.y << 16); acc8[3] += dn * __uint_as_float(r4.y & 0xffff0000u);
                    acc8[4] += dn * __uint_as_float(r4.z << 16); acc8[5] += dn * __uint_as_float(r4.z & 0xffff0000u);
                    acc8[6] += dn * __uint_as_float(r4.w << 16); acc8[7] += dn * __uint_as_float(r4.w & 0xffff0000u);
                }
                const float inv = 1.f / dsum;
                const uint4 s4 = *(const uint4*)(H + (size_t)row * HP + C_SILU + hd * 64 + c8 * 8);
                uint4 o4;
                o4.x = (unsigned)f2bf(acc8[0] * inv * __uint_as_float(s4.x << 16)) | ((unsigned)f2bf(acc8[1] * inv * __uint_as_float(s4.x & 0xffff0000u)) << 16);
                o4.y = (unsigned)f2bf(acc8[2] * inv * __uint_as_float(s4.y << 16)) | ((unsigned)f2bf(acc8[3] * inv * __uint_as_float(s4.y & 0xffff0000u)) << 16);
                o4.z = (unsigned)f2bf(acc8[4] * inv * __uint_as_float(s4.z << 16)) | ((unsigned)f2bf(acc8[5] * inv * __uint_as_float(s4.z & 0xffff0000u)) << 16);
                o4.w = (unsigned)f2bf(acc8[6] * inv * __uint_as_float(s4.w << 16)) | ((unsigned)f2bf(acc8[7] * inv * __uint_as_float(s4.w & 0xffff0000u)) << 16);
                *(uint4*)(Y + (size_t)row * DM + hd * 64 + c8 * 8) = o4;
            }
        }
        GRID_BAR();
        { pg8::Gemm g{Y, WoutT + (size_t)l * DM * DM, MROWS, DM, DM}; pg8::StaticOrder So; So.init(MROWS, DM, G, bid);
          pg8::EpiOut E{xprev, out, (LAS float*)((LAS unsigned char*)lds + 132096), l == 0 ? XN : nullptr, norm_w + DM, (float*)(ws + WS_RSS)};
          pg8::gemm_phase<pg8::EpiOut, pg8::StaticOrder, true, true>((LAS unsigned char*)lds, g, So, E); }
        if (l == 0) GRID_BAR();
    }
}

extern "C" void kernel_launch(void* const* d_in, const int* in_sizes, int n_in, void* d_out, int out_size, void* d_ws, size_t ws_size, hipStream_t stream) {
    static int grid = 0;
    if (grid == 0) {
        int dev = 0, cus = 0;
        (void)hipGetDevice(&dev);
        (void)hipDeviceGetAttribute(&cus, hipDeviceAttributeMultiprocessorCount, dev);
        (void)hipFuncSetAttribute((const void*)mega_fwd, hipFuncAttributeMaxDynamicSharedMemorySize, LDS_BYTES);
        grid = cus > 0 ? cus : 256;
    }
    (void)hipMemsetAsync((char*)d_ws + WS_CTL, 0, CTL_ZERO_BYTES, stream);
    Args a{};
    for (int i = 0; i < 15; ++i) a.in[i] = (const float*)d_in[i];
    a.out = (float*)d_out; a.ws = (unsigned char*)d_ws;
    hipLaunchKernelGGL(mega_fwd, dim3(grid), dim3(NT), LDS_BYTES, stream, a);
}
```

```cpp
#include <hip/hip_runtime.h>
#include <stdint.h>
#include <math.h>

typedef unsigned short bf16_t;
__device__ __forceinline__ float bf2f(bf16_t v) { return __uint_as_float((unsigned)v << 16); }
__device__ __forceinline__ bf16_t f2bf(float f) { unsigned u = __float_as_uint(f); return (bf16_t)((u + 0x7fffu + ((u >> 16) & 1u)) >> 16); }

constexpr int NB = 2, S = 8192, DM = 1024, MROWS = NB * S, PW = 3724, HP = 3840;
constexpr int C_AQ = 0, C_AK = 256, C_AV = 512, C_BQ = 768, C_BK = 1024, C_BV = 1152, C_CQ = 1280, C_CK = 1536, C_CV = 1792,
              C_DQ = 2048, C_KC = 2304, C_VC = 2368, C_KS = 2432, C_VS = 2496, C_KW = 2560, C_VW = 2624, C_GT = 2688, C_SILU = 2816;
constexpr float EPS = 1e-6f;
__device__ __forceinline__ int opq(int v) { asm volatile("" : "+v"(v)); return v; }

__device__ __forceinline__ int t5_bucket(int n) {
    if (n < 16) return n < 0 ? 0 : n;
    int b = 16;
    b += (n >= 22); b += (n >= 30); b += (n >= 40); b += (n >= 54); b += (n >= 73); b += (n >= 99); b += (n >= 134); b += (n >= 182);
    b += (n >= 246); b += (n >= 332); b += (n >= 450); b += (n >= 609); b += (n >= 825); b += (n >= 1117); b += (n >= 1513);
    return b;
}

__device__ __forceinline__ void k_rmsnorm(const int wave, const int lane, const float* __restrict__ x, const float* __restrict__ g, bf16_t* __restrict__ xn) {
    if (wave >= MROWS) return;
    const float4* xr = (const float4*)(x + (size_t)wave * DM);
    float4 v[4]; float ss = 0.f;
#pragma unroll
    for (int j = 0; j < 4; ++j) { v[j] = xr[lane + 64 * j]; ss += (v[j].x * v[j].x + v[j].y * v[j].y) + (v[j].z * v[j].z + v[j].w * v[j].w); }
#pragma unroll
    for (int o = 1; o < 64; o <<= 1) ss += __shfl_xor(ss, o);
    const float rstd = rsqrtf(ss * (1.f / DM) + EPS);
#pragma unroll
    for (int j = 0; j < 4; ++j) {
        const float4 gg = ((const float4*)g)[lane + 64 * j];
        uint2 o; o.x = (unsigned)f2bf(v[j].x * rstd * gg.x) | ((unsigned)f2bf(v[j].y * rstd * gg.y) << 16);
        o.y = (unsigned)f2bf(v[j].z * rstd * gg.z) | ((unsigned)f2bf(v[j].w * rstd * gg.w) << 16);
        ((uint2*)(xn + (size_t)wave * DM))[lane + 64 * j] = o;
    }
}

template <int D>
__device__ __forceinline__ float dot_row(const float* q, const bf16_t* kr) {
    float s = 0.f;
#pragma unroll
    for (int c = 0; c < D / 8; ++c) {
        const uint4 r = *(const uint4*)(kr + 8 * c);
        s += q[8 * c + 0] * __uint_as_float(r.x << 16) + q[8 * c + 1] * __uint_as_float(r.x & 0xffff0000u);
        s += q[8 * c + 2] * __uint_as_float(r.y << 16) + q[8 * c + 3] * __uint_as_float(r.y & 0xffff0000u);
        s += q[8 * c + 4] * __uint_as_float(r.z << 16) + q[8 * c + 5] * __uint_as_float(r.z & 0xffff0000u);
        s += q[8 * c + 6] * __uint_as_float(r.w << 16) + q[8 * c + 7] * __uint_as_float(r.w & 0xffff0000u);
        if (c & 1) asm volatile("" ::: "memory");
    }
    return s;
}
__device__ __forceinline__ void os_step(float s, const bf16_t* vr, float& m, float& den, float* o) {
    const float mn = fmaxf(m, s), sc = __expf(m - mn), p = __expf(s - mn);
    den = den * sc + p; m = mn;
#pragma unroll
    for (int c = 0; c < 8; ++c) {
        const uint4 r = *(const uint4*)(vr + 8 * c);
        o[8 * c + 0] = o[8 * c + 0] * sc + p * __uint_as_float(r.x << 16); o[8 * c + 1] = o[8 * c + 1] * sc + p * __uint_as_float(r.x & 0xffff0000u);
        o[8 * c + 2] = o[8 * c + 2] * sc + p * __uint_as_float(r.y << 16); o[8 * c + 3] = o[8 * c + 3] * sc + p * __uint_as_float(r.y & 0xffff0000u);
        o[8 * c + 4] = o[8 * c + 4] * sc + p * __uint_as_float(r.z << 16); o[8 * c + 5] = o[8 * c + 5] * sc + p * __uint_as_float(r.z & 0xffff0000u);
        o[8 * c + 6] = o[8 * c + 6] * sc + p * __uint_as_float(r.w << 16); o[8 * c + 7] = o[8 * c + 7] * sc + p * __uint_as_float(r.w & 0xffff0000u);
        if (c & 1) asm volatile("" ::: "memory");
    }
}
template <int D>
__device__ __forceinline__ void load_q(float* q, const bf16_t* p) {
#pragma unroll
    for (int c = 0; c < D / 8; ++c) {
        const uint4 r = *(const uint4*)(p + 8 * c);
        q[8 * c + 0] = __uint_as_float(r.x << 16); q[8 * c + 1] = __uint_as_float(r.x & 0xffff0000u);
        q[8 * c + 2] = __uint_as_float(r.y << 16); q[8 * c + 3] = __uint_as_float(r.y & 0xffff0000u);
        q[8 * c + 4] = __uint_as_float(r.z << 16); q[8 * c + 5] = __uint_as_float(r.z & 0xffff0000u);
        q[8 * c + 6] = __uint_as_float(r.w << 16); q[8 * c + 7] = __uint_as_float(r.w & 0xffff0000u);
    }
}

#define LAS __attribute__((address_space(3)))
namespace pg8 {
#define PG8_LAS __attribute__((address_space(3)))
typedef unsigned short bf16_t;
typedef short bf16x8 __attribute__((ext_vector_type(8)));
typedef float f32x4 __attribute__((ext_vector_type(4)));
typedef unsigned u32x4 __attribute__((ext_vector_type(4)));
constexpr int BM = 256, BK = 64, HALF = 128, HTB = HALF * BK * 2  , STAGE_BYTES = 8 * HTB, NXCD = 8, WGM = 8;

__host__ __device__ __forceinline__ int lds_byte(int r, int c) { const int st = (r >> 4) * 2 + (c >> 5), rr = r & 15, cc = c & 31, ob = rr * 64 + cc * 2; return st * 1024 + (ob ^ (((ob >> 9) & 1) << 5)); }
__host__ __device__ __forceinline__ void stage_rc(int b, int& R, int& C) { const int st = b / 1024, sb = b % 1024, swz = sb ^ (((sb >> 9) & 1) << 5); R = (st >> 1) * 16 + swz / 64; C = (st & 1) * 32 + (swz % 64) / 2; }
__host__ __device__ __forceinline__ int perm32(int rho) { const int n = rho >> 4, i = rho & 15; return 8 * (i >> 2) + 4 * n + (i & 3); }

struct Unit { int pm, pn; };
struct Gemm { const bf16_t* A; const bf16_t* Bt; int M, N, K; };

struct StaticOrder {
    int nM, nN, nwg, G, c;
    __host__ __device__ void init(int M, int N, int G_, int c_) { nM = M / BM; nN = N / BM; nwg = nM * nN; G = G_; c = c_; }
    __host__ __device__ bool next(int i, Unit& u) const {
        const long L = (long)i * G + c; if (L >= nwg) return false;
        int wgid = (int)L; { const int q = nwg / NXCD, r = nwg % NXCD, xcd = wgid % NXCD, off = wgid / NXCD; wgid = (xcd < r ? xcd * (q + 1) : r * (q + 1) + (xcd - r) * q) + off; }
        const int nig = WGM * nN, gid = wgid / nig, fm = gid * WGM, gsz = (nM - fm) < WGM ? (nM - fm) : WGM;
        u.pm = fm + ((wgid % nig) % gsz); u.pn = (wgid % nig) / gsz; return true;
    }
    __device__ __forceinline__ void a_ready(const Unit&) const {}
    __device__ __forceinline__ void done(const Unit&) const {}
};

__device__ __forceinline__ unsigned cvt_pk_bf16(float lo, float hi) { unsigned r; asm volatile("v_cvt_pk_bf16_f32 %0, %1, %2" : "=v"(r) : "v"(lo), "v"(hi)); return r; }
template <class Epi, class Sched, bool ALIGN_EPI = false, bool SP2 = false>
__device__ __forceinline__ void gemm_phase(PG8_LAS unsigned char* lds, const Gemm g, const Sched& S, const Epi& E) {
    const int tid = opq(threadIdx.x), wid = __builtin_amdgcn_readfirstlane(tid >> 6), lane = tid & 63, wr = wid >> 2, wc = wid & 3, fr = lane & 15, fq = lane >> 4;
    const int K = g.K, nt = K / BK;
    unsigned voffA[2], voffB[2];
#pragma unroll
    for (int i = 0; i < 2; ++i) { int R, C; stage_rc(tid * 16 + i * 8192, R, C); const int Rb = Epi::PERM ? ((R & ~31) + perm32(R & 31)) : R;
        voffA[i] = (unsigned)(R * K + C) * 2u; voffB[i] = (unsigned)(Rb * K + C) * 2u; }
    const size_t kstep = (size_t)(BK * 2);
    const size_t hstep = (size_t)HALF * K * 2;
    const size_t tstep = 2 * hstep;
    const unsigned ldsw = (unsigned)wid * 1024u;
    const int aoff = lds_byte(wr * 64 + fr, fq * 8), boff = lds_byte(wc * 32 + fr, fq * 8);
#define PG8_SA(b, h) (((b) * 2 + (h)) * HTB)
#define PG8_SB(b, h) ((4 + (b) * 2 + (h)) * HTB)
#define PG8_STAGE(bufoff, gbase, voff) do { _Pragma("unroll") for (int _i = 0; _i < 2; ++_i) \
        __builtin_amdgcn_global_load_lds((const unsigned*)((const char*)(gbase) + (voff)[_i]), (PG8_LAS unsigned*)(lds + (bufoff) + ldsw + _i * 8192), 16, 0, 0); } while (0)
#define PG8_LDA(dst, b, h) do { _Pragma("unroll") for (int m = 0; m < 4; ++m) _Pragma("unroll") for (int k = 0; k < 2; ++k) dst[m][k] = *(const PG8_LAS bf16x8*)(lds + PG8_SA(b, h) + aoff + m * 2048 + k * 1024); } while (0)
#define PG8_LDB(dst, b, h) do { _Pragma("unroll") for (int n = 0; n < 2; ++n) _Pragma("unroll") for (int k = 0; k < 2; ++k) dst[n][k] = *(const PG8_LAS bf16x8*)(lds + PG8_SB(b, h) + boff + n * 2048 + k * 1024); } while (0)
#define PG8_MMA(ai, bj, At, Bt) do { __builtin_amdgcn_s_setprio(1); _Pragma("unroll") for (int m = 0; m < 4; ++m) _Pragma("unroll") for (int n = 0; n < 2; ++n) _Pragma("unroll") for (int k = 0; k < 2; ++k) \
        acc[ai][bj][m][n] = __builtin_amdgcn_mfma_f32_16x16x32_bf16(Bt[n][k], At[m][k], acc[ai][bj][m][n], 0, 0, 0); __builtin_amdgcn_s_setprio(0); } while (0)
#define PG8_WAIT_V(n) asm volatile("s_waitcnt vmcnt(" #n ")" ::: "memory")
#define PG8_WAIT_L(n) asm volatile("s_waitcnt lgkmcnt(" #n ")" ::: "memory")
#define PG8_BAR __builtin_amdgcn_s_barrier()
#define PG8_SCHED __builtin_amdgcn_sched_barrier(0)
    Unit cur, nxt; int ui = 0;
    if (!S.next(0, cur)) return;
    f32x4 acc[2][2][4][2];
#pragma unroll
    for (int a = 0; a < 2; ++a)
#pragma unroll
        for (int b = 0; b < 2; ++b)
#pragma unroll
            for (int m = 0; m < 4; ++m)
#pragma unroll
                for (int n = 0; n < 2; ++n) acc[a][b][m][n] = (f32x4){0.f, 0.f, 0.f, 0.f};
    bf16x8 At[4][2], B0[2][2], B1[2][2];
    const char* cA = (const char*)g.A + (size_t)cur.pm * tstep; const char* cB = (const char*)g.Bt + (size_t)cur.pn * tstep;
    S.a_ready(cur);
    if constexpr (SP2) {
        PG8_STAGE(PG8_SB(0, 0), cB, voffB); PG8_STAGE(PG8_SB(0, 1), cB + hstep, voffB); PG8_STAGE(PG8_SA(0, 0), cA, voffA); PG8_STAGE(PG8_SA(0, 1), cA + hstep, voffA);
        if (wr == 1) PG8_BAR;
        PG8_WAIT_V(2); PG8_BAR;
        PG8_STAGE(PG8_SB(1, 0), cB + kstep, voffB); PG8_STAGE(PG8_SA(1, 0), cA + kstep, voffA); PG8_STAGE(PG8_SB(1, 1), cB + hstep + kstep, voffB);
        PG8_WAIT_V(6); PG8_BAR;
    } else {
        PG8_STAGE(PG8_SB(0, 0), cB, voffB); PG8_STAGE(PG8_SA(0, 0), cA, voffA); PG8_STAGE(PG8_SB(0, 1), cB + hstep, voffB); PG8_STAGE(PG8_SA(0, 1), cA + hstep, voffA);
        if (wr == 1) PG8_BAR;
        PG8_WAIT_V(4); PG8_BAR;
        PG8_STAGE(PG8_SB(1, 0), cB + kstep, voffB); PG8_STAGE(PG8_SA(1, 0), cA + kstep, voffA); PG8_STAGE(PG8_SB(1, 1), cB + hstep + kstep, voffB);
        PG8_WAIT_V(6); PG8_BAR;
    }
    for (;;) {
        const bool has_next = S.next(ui + 1, nxt);
        const char* nA = has_next ? (const char*)g.A + (size_t)nxt.pm * tstep : cA; const char* nB = has_next ? (const char*)g.Bt + (size_t)nxt.pn * tstep : cB;
        for (int t = 0; t < nt; t += 2) {
            const bool last = (t == nt - 2);
            const char* a1 = cA + (size_t)(t + 1) * kstep;
            const char* a2 = last ? nA : cA + (size_t)(t + 2) * kstep; const char* b2 = last ? nB : cB + (size_t)(t + 2) * kstep;
            const char* a3 = a2 + kstep; const char* b3 = b2 + kstep;
            if (last && has_next) S.a_ready(nxt);
            if constexpr (SP2) {
            PG8_LDB(B0, 0, 0); PG8_LDB(B1, 0, 1); PG8_SCHED; PG8_LDA(At, 0, 0); PG8_STAGE(PG8_SA(1, 1), a1 + hstep, voffA);
            PG8_WAIT_V(8); PG8_WAIT_L(0); PG8_BAR; PG8_MMA(0, 0, At, B0); PG8_MMA(0, 1, At, B1); PG8_BAR; PG8_SCHED;
            PG8_LDA(At, 0, 1); PG8_STAGE(PG8_SB(0, 0), b2, voffB); PG8_STAGE(PG8_SB(0, 1), b2 + hstep, voffB); PG8_STAGE(PG8_SA(0, 0), a2, voffA);
            PG8_WAIT_V(8); PG8_WAIT_L(0); PG8_BAR; PG8_MMA(1, 0, At, B0); PG8_MMA(1, 1, At, B1); PG8_BAR; PG8_SCHED;
            PG8_LDB(B0, 1, 0); PG8_LDB(B1, 1, 1); PG8_SCHED; PG8_LDA(At, 1, 0); PG8_STAGE(PG8_SA(0, 1), a2 + hstep, voffA);
            PG8_WAIT_V(8); PG8_WAIT_L(0); PG8_BAR; PG8_MMA(0, 0, At, B0); PG8_MMA(0, 1, At, B1); PG8_BAR; PG8_SCHED;
            PG8_LDA(At, 1, 1); PG8_STAGE(PG8_SB(1, 0), b3, voffB); PG8_STAGE(PG8_SB(1, 1), b3 + hstep, voffB); PG8_STAGE(PG8_SA(1, 0), a3, voffA);
            PG8_WAIT_V(8); PG8_WAIT_L(0); PG8_BAR; PG8_MMA(1, 0, At, B0); PG8_MMA(1, 1, At, B1); PG8_BAR; PG8_SCHED;
            } else {
            PG8_LDB(B0, 0, 0); PG8_SCHED; PG8_LDA(At, 0, 0); PG8_STAGE(PG8_SA(1, 1), a1 + hstep, voffA);
            PG8_WAIT_L(8); PG8_BAR; PG8_WAIT_L(0); PG8_MMA(0, 0, At, B0); PG8_BAR; PG8_SCHED;
            PG8_LDB(B1, 0, 1); PG8_STAGE(PG8_SB(0, 0), b2, voffB);
            PG8_BAR; PG8_WAIT_L(0); PG8_MMA(0, 1, At, B1); PG8_BAR;
            PG8_LDA(At, 0, 1); PG8_STAGE(PG8_SA(0, 0), a2, voffA);
            PG8_BAR; PG8_WAIT_L(0); PG8_MMA(1, 0, At, B0); PG8_BAR; PG8_SCHED;
            PG8_STAGE(PG8_SB(0, 1), b2 + hstep, voffB);
            PG8_WAIT_V(6); PG8_BAR; PG8_MMA(1, 1, At, B1); PG8_BAR;
            PG8_LDB(B0, 1, 0); PG8_SCHED; PG8_LDA(At, 1, 0); PG8_STAGE(PG8_SA(0, 1), a2 + hstep, voffA);
            PG8_WAIT_L(8); PG8_BAR; PG8_WAIT_L(0); PG8_MMA(0, 0, At, B0); PG8_BAR; PG8_SCHED;
            PG8_LDB(B1, 1, 1); PG8_STAGE(PG8_SB(1, 0), b3, voffB);
            PG8_BAR; PG8_WAIT_L(0); PG8_MMA(0, 1, At, B1); PG8_BAR;
            PG8_LDA(At, 1, 1); PG8_STAGE(PG8_SA(1, 0), a3, voffA);
            PG8_BAR; PG8_WAIT_L(0); PG8_MMA(1, 0, At, B0); PG8_BAR; PG8_SCHED;
            PG8_STAGE(PG8_SB(1, 1), b3 + hstep, voffB);
            PG8_WAIT_V(6); PG8_BAR; PG8_MMA(1, 1, At, B1); PG8_BAR;
            }
        }
        if constexpr (ALIGN_EPI) { if (wr == 0) PG8_BAR; }
        if constexpr (!Epi::AFTER_DRAIN) { E(acc, cur, wr, wc, fr, fq); S.done(cur); }
        if (!has_next) break;
#pragma unroll
        for (int a = 0; a < 2; ++a)
#pragma unroll
            for (int b = 0; b < 2; ++b)
#pragma unroll
                for (int m = 0; m < 4; ++m)
#pragma unroll
                    for (int n = 0; n < 2; ++n) acc[a][b][m][n] = (f32x4){0.f, 0.f, 0.f, 0.f};
        cur = nxt; cA = nA; cB = nB; ++ui;
        if constexpr (ALIGN_EPI) { if (wr == 1) PG8_BAR; }
    }
    PG8_WAIT_V(0);
    if constexpr (!ALIGN_EPI) { if (wr == 0) PG8_BAR; }
    PG8_BAR;
    if constexpr (Epi::AFTER_DRAIN) { E.fused(acc, cur, wr, wc, fr, fq, lds, wid, lane); S.done(cur); }
#undef PG8_SA
#undef PG8_SB
#undef PG8_STAGE
#undef PG8_LDA
#undef PG8_LDB
#undef PG8_MMA
#undef PG8_WAIT_V
#undef PG8_WAIT_L
#undef PG8_BAR
#undef PG8_SCHED
}
}

namespace pg8 {
struct EpiProj {
    static constexpr bool PERM = true, AFTER_DRAIN = false;
    bf16_t* H; const float* g; const float* gd;
    const float* rowss;
    __device__ __forceinline__ void operator()(const f32x4 (&acc)[2][2][4][2], const Unit& u, int wr, int wc, int fr, int fq) const {
        const int pn = u.pn;
        int mode = 0; const float* gain = nullptr;
        const float qs = (pn == 0 || pn == 3 || pn == 8) ? 0.125f * 1.4426950408889634f : (pn == 5 ? 0.17677669529663687f * 1.4426950408889634f : 1.f);
        if (pn == 0) { mode = 1; gain = g; } else if (pn == 1) { mode = 1; gain = g + 64; } else if (pn == 3) { mode = 1; gain = g + 128; }
        else if (pn == 4) { if (wc < 2) { mode = 1; gain = g + 192; } }
        else if (pn == 5) { mode = 2; gain = gd; } else if (pn == 6) { mode = 2; gain = gd + 32; }
        else if (pn == 8) { mode = 1; gain = g + 256; }
        else if (pn == 9) { if (wc == 2) { mode = 1; gain = g + 384; } }
        else if (pn == 10) { if (wc == 0) { mode = 1; gain = g + 448; } else if (wc == 2) mode = 4; }
        else if (pn >= 11) mode = 3;
        f32x4 gv[2][2];
#pragma unroll
        for (int bj = 0; bj < 2; ++bj)
#pragma unroll
            for (int n = 0; n < 2; ++n) gv[bj][n] = (f32x4){1.f, 1.f, 1.f, 1.f};
        if (mode == 1) {
#pragma unroll
            for (int bj = 0; bj < 2; ++bj)
#pragma unroll
                for (int n = 0; n < 2; ++n) gv[bj][n] = *(const f32x4*)(gain + 32 * bj + 8 * fq + 4 * n);
        } else if (mode == 2) {
#pragma unroll
            for (int bj = 0; bj < 2; ++bj)
#pragma unroll
                for (int n = 0; n < 2; ++n) gv[bj][n] = *(const f32x4*)(gain + 8 * fq + 4 * n);
        }
        const int col0 = pn * BM + 64 * wc + 8 * fq;
#pragma unroll
        for (int ai = 0; ai < 2; ++ai)
#pragma unroll
            for (int m = 0; m < 4; ++m) {
                const int row = u.pm * BM + ai * HALF + wr * 64 + m * 16 + fr;
                f32x4 v[2][2];
                const float rsc = rowss ? rsqrtf((float)((const unsigned long long*)rowss)[row] * (1.f / (1048576.f * 1024.f)) + 1e-6f) : 1.f;
#pragma unroll
                for (int bj = 0; bj < 2; ++bj)
#pragma unroll
                    for (int n = 0; n < 2; ++n) v[bj][n] = acc[ai][bj][m][n] * rsc;
                if (mode == 1 || mode == 2) {
                    float s0 = 0.f, s1 = 0.f;
#pragma unroll
                    for (int n = 0; n < 2; ++n) {
                        s0 += v[0][n][0] * v[0][n][0] + v[0][n][1] * v[0][n][1] + v[0][n][2] * v[0][n][2] + v[0][n][3] * v[0][n][3];
                        s1 += v[1][n][0] * v[1][n][0] + v[1][n][1] * v[1][n][1] + v[1][n][2] * v[1][n][2] + v[1][n][3] * v[1][n][3];
                    }
                    s0 += __shfl_xor(s0, 16); s0 += __shfl_xor(s0, 32);
                    s1 += __shfl_xor(s1, 16); s1 += __shfl_xor(s1, 32);
                    float r0, r1;
                    if (mode == 1) { r0 = r1 = rsqrtf((s0 + s1) * (1.f / 64.f) + 1e-6f) * qs; }
                    else { r0 = rsqrtf(s0 * (1.f / 32.f) + 1e-6f) * qs; r1 = rsqrtf(s1 * (1.f / 32.f) + 1e-6f) * qs; }
#pragma unroll
                    for (int n = 0; n < 2; ++n) { v[0][n] = v[0][n] * r0 * gv[0][n]; v[1][n] = v[1][n] * r1 * gv[1][n]; }
                } else if (mode == 3) {
#pragma unroll
                    for (int bj = 0; bj < 2; ++bj)
#pragma unroll
                        for (int n = 0; n < 2; ++n)
#pragma unroll
                            for (int e = 0; e < 4; ++e) { const float x = v[bj][n][e]; v[bj][n][e] = x * __builtin_amdgcn_rcpf(1.f + __expf(-x)); }
                } else if (mode == 4) {
#pragma unroll
                    for (int bj = 0; bj < 2; ++bj)
#pragma unroll
                        for (int n = 0; n < 2; ++n)
#pragma unroll
                            for (int e = 0; e < 4; ++e) { const float x = v[bj][n][e]; v[bj][n][e] = __builtin_amdgcn_rcpf(1.f + __expf(-x)); }
                }
                bf16_t* rowp = H + (size_t)row * 3840 + col0;
#pragma unroll
                for (int bj = 0; bj < 2; ++bj) {
                    u32x4 w; w.x = cvt_pk_bf16(v[bj][0][0], v[bj][0][1]); w.y = cvt_pk_bf16(v[bj][0][2], v[bj][0][3]);
                    w.z = cvt_pk_bf16(v[bj][1][0], v[bj][1][1]); w.w = cvt_pk_bf16(v[bj][1][2], v[bj][1][3]);
                    *(u32x4*)(rowp + 32 * bj) = w;
                }
            }
    }
};
struct EpiOut {
    static constexpr bool PERM = false, AFTER_DRAIN = false;
    const float* xprev; float* out;
    PG8_LAS float* exch;
    bf16_t* xn; const float* gnext; float* rowss;
    __device__ __forceinline__ void operator()(const f32x4 (&acc)[2][2][4][2], const Unit& u, int wr, int wc, int fr, int fq) const {
        const int col0 = u.pn * BM + wc * 32 + 4 * fq;
        f32x4 gn[2][2];
#pragma unroll
        for (int bj = 0; bj < 2; ++bj)
#pragma unroll
            for (int n = 0; n < 2; ++n) gn[bj][n] = xn ? *(const f32x4*)(gnext + col0 + bj * HALF + n * 16) : (f32x4){0.f, 0.f, 0.f, 0.f};
#pragma unroll
        for (int ai = 0; ai < 2; ++ai)
#pragma unroll
            for (int m = 0; m < 4; ++m) {
                const int row = u.pm * BM + ai * HALF + wr * 64 + m * 16 + fr;
                const size_t off = (size_t)row * 1024 + col0;
                float ss = 0.f;
#pragma unroll
                for (int bj = 0; bj < 2; ++bj)
#pragma unroll
                    for (int n = 0; n < 2; ++n) {
                        const f32x4 b = *(const f32x4*)(xprev + off + bj * HALF + n * 16);
                        const f32x4 v = b + acc[ai][bj][m][n];
                        *(f32x4*)(out + off + bj * HALF + n * 16) = v;
                        if (xn) {
                            ss += (v[0] * v[0] + v[1] * v[1]) + (v[2] * v[2] + v[3] * v[3]);
                            const f32x4 w = v * gn[bj][n];
                            uint2 o; o.x = cvt_pk_bf16(w[0], w[1]); o.y = cvt_pk_bf16(w[2], w[3]);
                            *(uint2*)(xn + off + bj * HALF + n * 16) = o;
                        }
                    }
                if (xn) {
                    ss += __shfl_xor(ss, 16); ss += __shfl_xor(ss, 32);
                    if (fq == 0) exch[(ai * HALF + wr * 64 + m * 16 + fr) * 4 + wc] = ss;
                }
            }
        if (xn) {
            asm volatile("s_waitcnt lgkmcnt(0)" ::: "memory"); __builtin_amdgcn_s_barrier(); asm volatile("" ::: "memory");
            if (wc == 0) {
                const int lane = fq * 16 + fr;
#pragma unroll
                for (int k = 0; k < 2; ++k) {
                    const int rl = k * HALF + wr * 64 + lane;
                    const f32x4 p = *(const PG8_LAS f32x4*)(exch + rl * 4);
                    const float tot = (p[0] + p[1]) + (p[2] + p[3]);
                    atomicAdd((unsigned long long*)rowss + (u.pm * BM + rl), (unsigned long long)(tot * 1048576.f + 0.5f));
                }
            }
        }
    }
};
}

template <int MODE>
__device__ __forceinline__ void p0_transpose_item(const float* __restrict__ W, bf16_t* __restrict__ WT, LAS float* scr, int item, int lane, int KR = 1024, int NC = 1024) {
    const int NSRC = MODE == 0 ? 3724 : NC, NG = MODE == 0 ? 120 : NC / 32;
    const int kb = item / NG, nb = item % NG, k0 = 64 * kb, hc0 = 32 * nb;
    const int hc = hc0 + (lane & 31);
    int src = hc;
    if (MODE == 0) src = hc < 2700 ? hc : (hc < 2816 ? -1 : hc - 116);
#pragma unroll 8
    for (int i = 0; i < 32; ++i) { const int kk = 2 * i + (lane >> 5); scr[kk * 33 + (lane & 31)] = src >= 0 ? W[(size_t)(k0 + kk) * NSRC + src] : 0.f; }
    asm volatile("s_waitcnt lgkmcnt(0)" ::: "memory");
    const int c = lane & 7;
#pragma unroll
    for (int j = 0; j < 4; ++j) {
        const int n = (lane >> 3) + 8 * j; const LAS float* s = scr + (8 * c) * 33 + n;
        const int hcn = hc0 + n;
        int drow = hcn;
        if (MODE == 0) drow = (hcn & ~255) + ((hcn >> 5) & 1) * 128 + ((hcn >> 6) & 3) * 32 + (hcn & 31);
        uint4 o; o.x = (unsigned)f2bf(s[0]) | ((unsigned)f2bf(s[33]) << 16); o.y = (unsigned)f2bf(s[66]) | ((unsigned)f2bf(s[99]) << 16);
        o.z = (unsigned)f2bf(s[132]) | ((unsigned)f2bf(s[165]) << 16); o.w = (unsigned)f2bf(s[198]) | ((unsigned)f2bf(s[231]) << 16);
        if (MODE == 2) { const int k = k0 + 8 * c; *(uint4*)(WT + ((size_t)((((drow >> 5) * 8 + (k >> 8)) * 16 + ((k >> 4) & 15)) * 64 + ((k >> 3) & 1) * 32 + (drow & 31))) * 8) = o; }
        else *(uint4*)(WT + (size_t)drow * KR + k0 + 8 * c) = o;
    }
    asm volatile("s_waitcnt lgkmcnt(0)" ::: "memory");
}

namespace att {
typedef short bf16x8 __attribute__((ext_vector_type(8)));
typedef short v4i16 __attribute__((ext_vector_type(4)));
typedef float f32x16 __attribute__((ext_vector_type(16)));
typedef float f32x2_t __attribute__((ext_vector_type(2)));
typedef __bf16 bf16x2_t __attribute__((ext_vector_type(2)));
typedef unsigned u32x4 __attribute__((ext_vector_type(4)));
typedef float f32x4 __attribute__((ext_vector_type(4)));
__device__ __forceinline__ unsigned cvtpk(float lo, float hi) { f32x2_t v = {lo, hi}; bf16x2_t b = __builtin_convertvector(v, bf16x2_t); return __builtin_bit_cast(unsigned, b); }
__device__ __forceinline__ int crow(int r, int h) { return (r & 3) + 8 * (r >> 2) + 4 * h; }
constexpr float LOG2E = 1.4426950408889634f;
constexpr int L_KV = 0, KVB = 16384  , L_TAB = 32768  , L_WSCR = 83968  , L_IMP = 92160  , L_Q = 124928, L_SEL = 125184  , L_SB = 126464  ;

struct StageRegs { u32x4 k, v; };
__device__ __forceinline__ void stage_load(StageRegs& sr, const bf16_t* kp, const bf16_t* vp, bool valid, int ch) {
    sr.k = (u32x4){0u, 0u, 0u, 0u}; sr.v = sr.k;
    if (valid) { sr.k = *(const u32x4*)(kp + ch * 8); sr.v = *(const u32x4*)(vp + ch * 8); }
}
__device__ __forceinline__ void stage_write(LAS unsigned char* buf, const StageRegs& sr, int row, int ch) {
    *(LAS u32x4*)(buf + row * 128 + ((ch ^ (row & 7)) << 4)) = sr.k;
    *(LAS u32x4*)(buf + 8192 + (ch >> 2) * 4096 + row * 64 + (ch & 3) * 16) = sr.v;
}
__device__ __forceinline__ f32x16 load_tab16(const LAS float* tbl, int TSP, int jb) {
    const int sh = jb & 3; const LAS float* tp = tbl + sh * TSP + (jb - sh);
    const f32x4 t0 = *(const LAS f32x4*)(tp), t1 = *(const LAS f32x4*)(tp + 8), t2 = *(const LAS f32x4*)(tp + 16), t3 = *(const LAS f32x4*)(tp + 24);
    return (f32x16){t0[0], t0[1], t0[2], t0[3], t1[0], t1[1], t1[2], t1[3], t2[0], t2[1], t2[2], t2[3], t3[0], t3[1], t3[2], t3[3]};
}
__device__ __forceinline__ float exp_sum16(f32x16& acc) {
    float sa = 0.f, sb = 0.f;
#pragma unroll
    for (int r = 0; r < 16; r += 2) {
        acc[r] = __builtin_amdgcn_exp2f(acc[r]); acc[r + 1] = __builtin_amdgcn_exp2f(acc[r + 1]);
        sa += acc[r]; asm volatile("" : "+v"(sa)); sb += acc[r + 1]; asm volatile("" : "+v"(sb));
    }
    return sa + sb;
}
__device__ __forceinline__ f32x16 splat16(float v) { return (f32x16){v, v, v, v, v, v, v, v, v, v, v, v, v, v, v, v}; }
template <int S0, int S1>
__device__ __forceinline__ void qk_sub(f32x16& acc, const LAS unsigned char* buf, int sub, const bf16x8* qf, int lane) {
    const int key = 32 * sub + (lane & 31), h = lane >> 5;
    bf16x8 kf[S1 - S0];
#pragma unroll
    for (int s = S0; s < S1; ++s) kf[s - S0] = *(const LAS bf16x8*)(buf + key * 128 + (((2 * s + h) ^ (key & 7)) << 4));
    __builtin_amdgcn_sched_barrier(0);
#pragma unroll
    for (int s = S0; s < S1; ++s) acc = __builtin_amdgcn_mfma_f32_32x32x16_bf16(kf[s - S0], qf[s], acc, 0, 0, 0);
}
__device__ __forceinline__ void pack_p(const f32x16& p, bf16x8& pa0, bf16x8& pa1) {
    u32x4 w0, w1;
    w0.x = cvtpk(p[0], p[1]); w0.y = cvtpk(p[2], p[3]); w0.z = cvtpk(p[4], p[5]); w0.w = cvtpk(p[6], p[7]);
    w1.x = cvtpk(p[8], p[9]); w1.y = cvtpk(p[10], p[11]); w1.z = cvtpk(p[12], p[13]); w1.w = cvtpk(p[14], p[15]);
    pa0 = __builtin_bit_cast(bf16x8, w0); pa1 = __builtin_bit_cast(bf16x8, w1);
}
__device__ __forceinline__ void pv_sub(f32x16* o, const LAS unsigned char* buf, int sub, const bf16x8& pa0, const bf16x8& pa1, int lane) {
    const int h = lane >> 5, g16 = (lane >> 4) & 1, q4 = (lane & 15) >> 2, p4 = lane & 3;
    const LAS unsigned char* vb = buf + 8192 + (32 * sub + 4 * h + q4) * 64 + (16 * g16 + 4 * p4) * 2;
    bf16x8 vf[2][2];
#pragma unroll
    for (int dt = 0; dt < 2; ++dt) {
#pragma unroll
        for (int s2 = 0; s2 < 2; ++s2) {
            const v4i16 lo = __builtin_amdgcn_ds_read_tr16_b64_v4i16((LAS v4i16*)(vb + dt * 4096 + s2 * 1024));
            const v4i16 hi = __builtin_amdgcn_ds_read_tr16_b64_v4i16((LAS v4i16*)(vb + dt * 4096 + s2 * 1024 + 512));
            vf[dt][s2] = (bf16x8){lo[0], lo[1], lo[2], lo[3], hi[0], hi[1], hi[2], hi[3]};
        }
    }
    __builtin_amdgcn_sched_barrier(0);
    o[0] = __builtin_amdgcn_mfma_f32_32x32x16_bf16(pa0, vf[0][0], o[0], 0, 0, 0);
    o[1] = __builtin_amdgcn_mfma_f32_32x32x16_bf16(pa0, vf[1][0], o[1], 0, 0, 0);
    o[0] = __builtin_amdgcn_mfma_f32_32x32x16_bf16(pa1, vf[0][1], o[0], 0, 0, 0);
    o[1] = __builtin_amdgcn_mfma_f32_32x32x16_bf16(pa1, vf[1][1], o[1], 0, 0, 0);
}

__device__ __forceinline__ void pv_sub2(f32x16* oa, f32x16* ob, const LAS unsigned char* buf, int sub, const bf16x8& a0, const bf16x8& a1, const bf16x8& b0, const bf16x8& b1, int lane) {
    const int h = lane >> 5, g16 = (lane >> 4) & 1, q4 = (lane & 15) >> 2, p4 = lane & 3;
    const LAS unsigned char* vb = buf + 8192 + (32 * sub + 4 * h + q4) * 64 + (16 * g16 + 4 * p4) * 2;
#pragma unroll
    for (int dt = 0; dt < 2; ++dt) {
#pragma unroll
        for (int s2 = 0; s2 < 2; ++s2) {
            const v4i16 lo = __builtin_amdgcn_ds_read_tr16_b64_v4i16((LAS v4i16*)(vb + dt * 4096 + s2 * 1024));
            const v4i16 hi = __builtin_amdgcn_ds_read_tr16_b64_v4i16((LAS v4i16*)(vb + dt * 4096 + s2 * 1024 + 512));
            const bf16x8 vf = (bf16x8){lo[0], lo[1], lo[2], lo[3], hi[0], hi[1], hi[2], hi[3]};
            oa[dt] = __builtin_amdgcn_mfma_f32_32x32x16_bf16(s2 == 0 ? a0 : a1, vf, oa[dt], 0, 0, 0);
            ob[dt] = __builtin_amdgcn_mfma_f32_32x32x16_bf16(s2 == 0 ? b0 : b1, vf, ob[dt], 0, 0, 0);
        }
    }
}

struct BandArgs {
    const bf16_t* Hb;
    int cq, ck, cv;
    int rate, cls, f0, maxd;
    const float* bias;
    float M;
    float sinkterm;
    bf16_t* OA; float* DA;
    bf16_t* Y; int ycol;
    int hd; size_t brow;
};
constexpr int B_TAB = 98304, B_WSCR = 106496;
template <int MODE>
__device__ __forceinline__ void banded_unit(LAS unsigned char* lds, const BandArgs& P) {
    const int tid = opq(threadIdx.x), lane = tid & 63, w = __builtin_amdgcn_readfirstlane(tid >> 6), h = lane >> 5;
    LAS float* sb = (LAS float*)(lds + L_SB);
    LAS float* tbl = (LAS float*)(lds + B_TAB);
    const int KPREV = ((P.maxd + 63) >> 6) << 6;
    const int t0 = (KPREV - P.f0) > 0 ? ((KPREV - P.f0) >> 6) : 0;
    const int srow = tid >> 3, sch = tid & 7;
    StageRegs sr[6];
#pragma unroll
    for (int i = 0; i < 6; ++i) {
        int kf = P.f0 - KPREV + 64 * i + srow; kf = kf < 0 ? 0 : kf;
        const bf16_t* rp = P.Hb + ((size_t)kf * P.rate + P.cls) * HP;
        stage_load(sr[i], rp + P.ck, rp + P.cv, true, sch);
    }
    const int fq0 = P.f0 + 32 * w;
    bf16x8 qf[4];
    {
        const size_t tq = (size_t)(fq0 + (lane & 31)) * P.rate + P.cls;
        const bf16_t* qp = P.Hb + tq * HP + P.cq + 8 * h;
#pragma unroll
        for (int s = 0; s < 4; ++s) qf[s] = *(const bf16x8*)(qp + 16 * s);
    }
    if (tid < 32) sb[tid] = (P.bias[tid * 16] - P.M) * LOG2E;
    __syncthreads();
    const int DMAXI = P.maxd + 62, TS = P.maxd + 125, TSP = (TS + 7) & ~3;
    for (int e = tid; e < 4 * TSP; e += 512) {
        const int sh = e / TSP, j = e - sh * TSP + sh, dist = DMAXI - j;
        tbl[e] = (j < TS && dist >= 0 && dist <= P.maxd) ? sb[t5_bucket(dist * P.rate)] : -1e30f;
    }
    f32x16 o[2]; o[0] = (f32x16){}; o[1] = (f32x16){};
    float den = 0.f;
#pragma unroll
    for (int i = 0; i < 6; ++i) stage_write(lds + i * KVB, sr[i], srow, sch);
    asm volatile("" : "+v"(qf[0]), "+v"(qf[1]), "+v"(qf[2]), "+v"(qf[3]));
    __syncthreads();
#pragma unroll 1
    for (int t = t0; t < 6; ++t) {
        const LAS unsigned char* buf = lds + t * KVB;
        const int kf0 = P.f0 - KPREV + 64 * t;
#pragma unroll
        for (int sub = 0; sub < 2; ++sub) {
            const int kfs = kf0 + 32 * sub;
            if (kfs <= fq0 + 31 && kfs + 31 >= fq0 - P.maxd) {
                const int jb = DMAXI - ((fq0 - kfs) + (lane & 31) - 4 * h);
                f32x16 acc = load_tab16(tbl, TSP, jb);
                qk_sub<0, 4>(acc, buf, sub, qf, lane);
                den += exp_sum16(acc);
                bf16x8 pa0, pa1; pack_p(acc, pa0, pa1);
                pv_sub(o, buf, sub, pa0, pa1, lane);
            }
        }
    }
    float dtot = den + __shfl_xor(den, 32);
    if (MODE == 1) dtot += P.sinkterm;
    LAS float* ws_ = (LAS float*)(lds + B_WSCR) + w * 64;
    if (h == 0) ws_[lane] = dtot;
    if (MODE == 0 && h == 0) {
        const size_t tq = (size_t)(fq0 + lane) * P.rate + P.cls;
        P.DA[(P.brow + tq) * 4 + P.hd] = dtot;
    }
    asm volatile("s_waitcnt lgkmcnt(0)" ::: "memory");
#pragma unroll
    for (int r = 0; r < 16; ++r) {
        const int qi = crow(r, h);
        const float inv = __builtin_amdgcn_rcpf(ws_[qi]);
        const size_t row = P.brow + (size_t)(fq0 + qi) * P.rate + P.cls;
#pragma unroll
        for (int dt = 0; dt < 2; ++dt) {
            const int d = 32 * dt + (lane & 31);
            const float val = o[dt][r] * inv;
            if (MODE == 0) P.OA[row * 256 + P.hd * 64 + d] = f2bf(val);
            else P.Y[row * DM + P.ycol + d] = f2bf(val * bf2f(P.Hb[(row - P.brow) * HP + C_SILU + P.ycol + d]));
        }
    }
}

__device__ __forceinline__ void diff_p1(const LAS float* tp, const LAS unsigned char* buf, int sub, const bf16x8* qf, int lane, bf16x8& pa0, bf16x8& pa1, bf16x8& pb0, bf16x8& pb1) {
    const f32x4 t0 = *(const LAS f32x4*)(tp), t1 = *(const LAS f32x4*)(tp + 8), t2 = *(const LAS f32x4*)(tp + 16), t3 = *(const LAS f32x4*)(tp + 24);
    const f32x16 T = (f32x16){t0[0], t0[1], t0[2], t0[3], t1[0], t1[1], t1[2], t1[3], t2[0], t2[1], t2[2], t2[3], t3[0], t3[1], t3[2], t3[3]};
    const int key = 32 * sub + (lane & 31), h = lane >> 5;
    const LAS unsigned char* kp = buf + key * 128;
    const bf16x8 k0 = *(const LAS bf16x8*)(kp + (((0 + h) ^ (key & 7)) << 4)), k1 = *(const LAS bf16x8*)(kp + (((2 + h) ^ (key & 7)) << 4));
    const bf16x8 k2 = *(const LAS bf16x8*)(kp + (((4 + h) ^ (key & 7)) << 4)), k3 = *(const LAS bf16x8*)(kp + (((6 + h) ^ (key & 7)) << 4));
    f32x16 a1 = __builtin_amdgcn_mfma_f32_32x32x16_bf16(k0, qf[0], T, 0, 0, 0);
    f32x16 a2 = __builtin_amdgcn_mfma_f32_32x32x16_bf16(k2, qf[2], T, 0, 0, 0);
    a1 = __builtin_amdgcn_mfma_f32_32x32x16_bf16(k1, qf[1], a1, 0, 0, 0);
    a2 = __builtin_amdgcn_mfma_f32_32x32x16_bf16(k3, qf[3], a2, 0, 0, 0);
#pragma unroll
    for (int r = 0; r < 16; ++r) { a1[r] = __builtin_amdgcn_exp2f(a1[r]); a2[r] = __builtin_amdgcn_exp2f(a2[r]); }
    pack_p(a1, pa0, pa1); pack_p(a2, pb0, pb1);
}
__device__ __forceinline__ void diff_p2(const LAS unsigned char* buf, int sub, int lane, const bf16x8& pa0, const bf16x8& pa1, const bf16x8& pb0, const bf16x8& pb1, f32x16& dn1, f32x16& dn2, f32x16* o1, f32x16* o2) {
    const bf16x8 ones = (bf16x8){0x3F80, 0x3F80, 0x3F80, 0x3F80, 0x3F80, 0x3F80, 0x3F80, 0x3F80};
    dn1 = __builtin_amdgcn_mfma_f32_32x32x16_bf16(pa0, ones, dn1, 0, 0, 0);
    dn2 = __builtin_amdgcn_mfma_f32_32x32x16_bf16(pb0, ones, dn2, 0, 0, 0);
    dn1 = __builtin_amdgcn_mfma_f32_32x32x16_bf16(pa1, ones, dn1, 0, 0, 0);
    dn2 = __builtin_amdgcn_mfma_f32_32x32x16_bf16(pb1, ones, dn2, 0, 0, 0);
    pv_sub2(o1, o2, buf, sub, pa0, pa1, pb0, pb1, lane);
}

struct DiffArgs {
    const bf16_t* Hb; int hd, qb; size_t brow;
    const float* bias; float M; float lam, lambda_init; const float* subln;
    bf16_t* Y;
};
constexpr int D_SB = 49152, D_TAB = 49664;
__device__ __forceinline__ void diff_unit(LAS unsigned char* lds, const DiffArgs& P) {
    const int tid = opq(threadIdx.x), lane = tid & 63, w = __builtin_amdgcn_readfirstlane(tid >> 6), h = lane >> 5;
    LAS float* sb = (LAS float*)(lds + D_SB);
    LAS float* tbl = (LAS float*)(lds + D_TAB);
    constexpr int DTOP = 1574, TS = DTOP + 63, TSP = (TS + 7) & ~3;
    __syncthreads();
    if (tid < 32) sb[tid] = (P.bias[tid * 16] - P.M) * LOG2E;
    __syncthreads();
    for (int e = tid; e < 4 * TSP; e += 512) {
        const int sh = e / TSP, j = e - sh * TSP + sh, dist = DTOP - j;
        tbl[e] = (j < TS && dist >= 0) ? sb[t5_bucket(dist)] : -1e30f;
    }
    LAS float* farc = tbl + 4 * TSP;
    LAS float* deadr = farc + 32;
    if (tid < 32) { farc[tid] = sb[31]; deadr[tid] = -1e30f; }
    const int q0w = P.qb * 256 + 32 * w;
    const int cq = C_CQ + 64 * P.hd, ck = C_CK + 64 * P.hd, cv = C_CV + 64 * P.hd;
    bf16x8 qf[4];
    {
        const bf16_t* qp = P.Hb + (size_t)(q0w + (lane & 31)) * HP + cq + 8 * h;
#pragma unroll
        for (int s = 0; s < 4; ++s) qf[s] = *(const bf16x8*)(qp + 16 * s);
        asm volatile("" : "+v"(qf[0]), "+v"(qf[1]), "+v"(qf[2]), "+v"(qf[3]));
    }
    const int ntl = 4 * (P.qb + 1);
    const int srow = tid >> 3, sch = tid & 7;
    f32x16 o1[2], o2[2]; o1[0] = (f32x16){}; o1[1] = (f32x16){}; o2[0] = (f32x16){}; o2[1] = (f32x16){};
    f32x16 dn1 = (f32x16){}, dn2 = (f32x16){};
    StageRegs sr;
    {
        const bf16_t* rp = P.Hb + (size_t)srow * HP;
        stage_load(sr, rp + ck, rp + cv, true, sch);
        stage_write(lds, sr, srow, sch);
    }
    __syncthreads();
#define DIFF_TP(KS) ({ const int ks_ = (KS); const int jb_ = DTOP - ((q0w - ks_) + (lane & 31) - 4 * h), sh_ = jb_ & 3; \
        const LAS float* tp_ = tbl + sh_ * TSP + (jb_ - sh_); tp_ = (q0w - ks_ - 31 >= 1513) ? farc : tp_; tp_ = (ks_ > q0w + 31) ? deadr : tp_; tp_; })
#define DIFF_STAGE_LOAD(t) do { const int tn_ = (t) + 1 < ntl ? (t) + 1 : (t); const bf16_t* rp_ = P.Hb + (size_t)(64 * tn_ + srow) * HP; stage_load(sr, rp_ + ck, rp_ + cv, true, sch); } while (0)
    if (w < 4) {
        int cur = 0;
        for (int t = 0; t < ntl; ++t) {
            LAS unsigned char* buf = lds + cur * KVB;
            const int nxt = cur == 2 ? 0 : cur + 1;
            DIFF_STAGE_LOAD(t);
            bf16x8 pa0, pa1, pb0, pb1;
            diff_p1(DIFF_TP(64 * t), buf, 0, qf, lane, pa0, pa1, pb0, pb1);
            diff_p2(buf, 0, lane, pa0, pa1, pb0, pb1, dn1, dn2, o1, o2);
            diff_p1(DIFF_TP(64 * t + 32), buf, 1, qf, lane, pa0, pa1, pb0, pb1);
            diff_p2(buf, 1, lane, pa0, pa1, pb0, pb1, dn1, dn2, o1, o2);
            stage_write(lds + nxt * KVB, sr, srow, sch);
            __syncthreads();
            cur = nxt;
        }
    } else {
        const bf16x8 zero8 = (bf16x8){0, 0, 0, 0, 0, 0, 0, 0};
        bf16x8 qa0 = zero8, qa1 = zero8, qb0 = zero8, qb1 = zero8;
        int cur = 0, prv = 0;
        __builtin_amdgcn_s_setprio(1);
        for (int t = 0; t < ntl; ++t) {
            LAS unsigned char* buf = lds + cur * KVB;
            const int nxt = cur == 2 ? 0 : cur + 1;
            DIFF_STAGE_LOAD(t);
            diff_p2(lds + prv * KVB, 1, lane, qa0, qa1, qb0, qb1, dn1, dn2, o1, o2);
            bf16x8 pa0, pa1, pb0, pb1;
            diff_p1(DIFF_TP(64 * t), buf, 0, qf, lane, pa0, pa1, pb0, pb1);
            diff_p2(buf, 0, lane, pa0, pa1, pb0, pb1, dn1, dn2, o1, o2);
            diff_p1(DIFF_TP(64 * t + 32), buf, 1, qf, lane, qa0, qa1, qb0, qb1);
            stage_write(lds + nxt * KVB, sr, srow, sch);
            __syncthreads();
            prv = cur; cur = nxt;
        }
        diff_p2(lds + prv * KVB, 1, lane, qa0, qa1, qb0, qb1, dn1, dn2, o1, o2);
        __builtin_amdgcn_s_setprio(0);
    }
    __syncthreads();
#undef DIFF_TP
#undef DIFF_STAGE_LOAD
    const float g0 = P.subln[lane & 31] * (1.f - P.lambda_init), g1 = P.subln[32 + (lane & 31)] * (1.f - P.lambda_init);
    const int ycol = 512 + 64 * P.hd;
#pragma unroll
    for (int r = 0; r < 16; ++r) {
        const int qi = crow(r, h);
        const float i1 = __builtin_amdgcn_rcpf(dn1[r]), i2 = P.lam * __builtin_amdgcn_rcpf(dn2[r]);
        const float a0 = o1[0][r] * i1 - o2[0][r] * i2, a1 = o1[1][r] * i1 - o2[1][r] * i2;
        float ss = a0 * a0 + a1 * a1;
        ss += __shfl_xor(ss, 1); ss += __shfl_xor(ss, 2); ss += __shfl_xor(ss, 4); ss += __shfl_xor(ss, 8); ss += __shfl_xor(ss, 16);
        const float rs = rsqrtf(ss * (1.f / 64.f) + 1e-6f);
        const size_t trow = (size_t)(q0w + qi);
        const bf16_t* sp = P.Hb + trow * HP + C_SILU + ycol;
        bf16_t* yp = P.Y + (P.brow + trow) * DM + ycol;
        yp[lane & 31] = f2bf(a0 * rs * g0 * bf2f(sp[lane & 31]));
        yp[32 + (lane & 31)] = f2bf(a1 * rs * g1 * bf2f(sp[32 + (lane & 31)]));
    }
}
struct CmpArgs {
    const bf16_t* Hb;
    int col;
    int rt;
    const float* pos;
    const bf16_t* W1T;
    const float* b1;
    const bf16_t* W2T;
    const float* b2;
    const float* gain;
    bf16_t* OUT;
};
__device__ __forceinline__ void cmp_unit(LAS unsigned char* lds, const CmpArgs& P) {
    const int tid = opq(threadIdx.x), lane = tid & 63, w = __builtin_amdgcn_readfirstlane(tid >> 6), h = lane >> 5;
    LAS unsigned char* hidl = lds + L_KV;
    LAS float* ssx = (LAS float*)(lds + L_KV + 32768 - 512);
    LAS unsigned char* abuf = lds + L_TAB;
    f32x16 acc = (f32x16){};
    const bf16_t* w1p = P.W1T + (size_t)w * (8 * 16 * 64 * 8) + lane * 8;
    u32x4 araw[2]; f32x4 apos[2][2];
#define CMP_ALOAD(ch) do { _Pragma("unroll") for (int q_ = 0; q_ < 2; ++q_) { const int p_ = tid + 512 * q_, row_ = p_ >> 5, kc_ = p_ & 31; \
        int ir_ = 32 * P.rt + row_; if (ir_ > 510) ir_ = 510; const int tok_ = 4 * (ch) + (kc_ >> 3), d_ = 8 * (kc_ & 7); \
        araw[q_] = *(const u32x4*)(P.Hb + (size_t)(16 * ir_ + tok_) * HP + P.col + d_); \
        apos[q_][0] = *(const f32x4*)(P.pos + tok_ * 64 + d_); apos[q_][1] = *(const f32x4*)(P.pos + tok_ * 64 + d_ + 4); } } while (0)
#define CMP_AWRITE(bufi) do { _Pragma("unroll") for (int q_ = 0; q_ < 2; ++q_) { const int p_ = tid + 512 * q_, row_ = p_ >> 5, kc_ = p_ & 31; u32x4 aw_; \
        aw_.x = cvtpk(__uint_as_float(araw[q_].x << 16) + apos[q_][0][0], __uint_as_float(araw[q_].x & 0xffff0000u) + apos[q_][0][1]); \
        aw_.y = cvtpk(__uint_as_float(araw[q_].y << 16) + apos[q_][0][2], __uint_as_float(araw[q_].y & 0xffff0000u) + apos[q_][0][3]); \
        aw_.z = cvtpk(__uint_as_float(araw[q_].z << 16) + apos[q_][1][0], __uint_as_float(araw[q_].z & 0xffff0000u) + apos[q_][1][1]); \
        aw_.w = cvtpk(__uint_as_float(araw[q_].w << 16) + apos[q_][1][2], __uint_as_float(araw[q_].w & 0xffff0000u) + apos[q_][1][3]); \
        *(LAS u32x4*)(abuf + (bufi) * 16896 + row_ * 528 + kc_ * 16) = aw_; } } while (0)
    CMP_ALOAD(0); CMP_AWRITE(0);
    __syncthreads();
    for (int ch = 0; ch < 8; ++ch) {
        const int cn = ch + 1 < 8 ? ch + 1 : ch;
        CMP_ALOAD(cn);
        const LAS unsigned char* ab = abuf + (ch & 1) * 16896 + (lane & 31) * 528 + 16 * h;
        bf16x8 bfr[16];
#pragma unroll
        for (int ks = 0; ks < 16; ++ks) bfr[ks] = *(const bf16x8*)(w1p + (ch * 16 + ks) * 512);
#pragma unroll
        for (int ks = 0; ks < 16; ++ks) {
            const bf16x8 af = *(const LAS bf16x8*)(ab + 32 * ks);
            acc = __builtin_amdgcn_mfma_f32_32x32x16_bf16(af, bfr[ks], acc, 0, 0, 0);
        }
        CMP_AWRITE((ch + 1) & 1);
        __syncthreads();
    }
#undef CMP_ALOAD
#undef CMP_AWRITE
    {
        const int j = 32 * w + (lane & 31); const float bb = P.b1[j];
#pragma unroll
        for (int r = 0; r < 16; ++r) {
            const float x = acc[r] + bb;
            const float u = 0.7978845608028654f * (x + 0.044715f * x * x * x);
            const float th = 1.f - 2.f / (1.f + __expf(2.f * u));
            const float gl = 0.5f * x * (1.f + th);
            *(LAS bf16_t*)(hidl + crow(r, h) * 528 + j * 2) = f2bf(gl);
        }
    }
    __syncthreads();
    float outv[16]; float ssp[16];
    if (w < 2) {
        f32x16 a2 = (f32x16){};
        const bf16_t* w2p = P.W2T + (size_t)(32 * w + (lane & 31)) * 256 + 8 * h;
#pragma unroll
        for (int ks = 0; ks < 16; ++ks) {
            const bf16x8 af = *(const LAS bf16x8*)(hidl + (lane & 31) * 528 + (16 * ks + 8 * h) * 2);
            const bf16x8 bfr = *(const bf16x8*)(w2p + 16 * ks);
            a2 = __builtin_amdgcn_mfma_f32_32x32x16_bf16(af, bfr, a2, 0, 0, 0);
        }
        const float bb = P.b2[32 * w + (lane & 31)];
#pragma unroll
        for (int r = 0; r < 16; ++r) {
            outv[r] = a2[r] + bb;
            float ss = outv[r] * outv[r];
            ss += __shfl_xor(ss, 1); ss += __shfl_xor(ss, 2); ss += __shfl_xor(ss, 4); ss += __shfl_xor(ss, 8); ss += __shfl_xor(ss, 16);
            ssp[r] = ss;
            if ((lane & 31) == 0) ssx[w * 32 + crow(r, h)] = ss;
        }
    }
    __syncthreads();
    if (w < 2) {
        const int d = 32 * w + (lane & 31);
        const float gn = P.gain ? P.gain[d] : 1.f;
#pragma unroll
        for (int r = 0; r < 16; ++r) {
            const int row = 32 * P.rt + crow(r, h);
            float v = outv[r];
            if (P.gain) { const float tot = ssx[crow(r, h)] + ssx[32 + crow(r, h)]; v = v * rsqrtf(tot * (1.f / 64.f) + 1e-6f) * gn; }
            if (row <= 510) P.OUT[(size_t)row * 64 + d] = f2bf(v);
        }
    }
    __syncthreads();
}

struct NsaArgs {
    const bf16_t* Hb; size_t brow; int qb;
    const bf16_t* KC; const bf16_t* VC;
    const float* bias;
    const float* Mv;
    bf16_t* Y; unsigned* cdone;
    float* scr;
};
constexpr int GTOP = 2015, GTS = 2519, WTOP = 549, WTS = 588, DEAD = 4 * GTS + 4 * WTS;
__device__ __forceinline__ void nsa_unit(LAS unsigned char* lds, const NsaArgs& P) {
    const int tid = opq(threadIdx.x), lane = tid & 63, w = __builtin_amdgcn_readfirstlane(tid >> 6), hh = lane >> 5;
    const int n = lane & 31, q8 = n >> 2, hd = n & 3;
    LAS float* tg = (LAS float*)(lds + L_TAB);
    LAS float* tw = tg + 4 * GTS;
    LAS float* dead = tg + DEAD;
    LAS float* impw = (LAS float*)(lds + L_IMP) + w * 1024;
    LAS unsigned* selw = (LAS unsigned*)(lds + L_SEL) + w * 32;
    LAS unsigned* uni = (LAS unsigned*)(lds + L_SEL) + 256;
    LAS float* ws_ = (LAS float*)(lds + L_WSCR) + w * 256;
    LAS float* sbh = (LAS float*)(lds + L_SB);
    if (tid < 128) sbh[tid] = (P.bias[(tid & 31) * 16 + (tid >> 5)] - P.Mv[tid >> 5]) * LOG2E;
    __syncthreads();
    for (int e = tid; e < 4 * GTS; e += 512) { const int hq = e / GTS, j = e % GTS, dist = GTOP - j;
        tg[e] = dist >= 0 ? sbh[hq * 32 + t5_bucket(dist)] : -1e30f; }
    for (int e = tid; e < 4 * WTS; e += 512) { const int hq = e / WTS, j = e % WTS, dist = WTOP - j;
        tw[e] = (dist >= 0 && dist <= 511) ? sbh[hq * 32 + t5_bucket(dist)] : -1e30f; }
    if (tid < 64) dead[tid] = -1e30f;
    for (int e = lane; e < 1024; e += 64) impw[e] = 0.f;
    if (tid < 4) uni[tid] = 0u;
    const float cfar = sbh[hd * 32 + 31];
    const int tq = 64 * P.qb + 8 * w + q8;
    const int twmin = 64 * P.qb + 8 * w, twmax = twmin + 7;
    bf16x8 qf[4];
    {
        const bf16_t* qp = P.Hb + (size_t)tq * HP + C_DQ + 64 * hd + 8 * hh;
#pragma unroll
        for (int s = 0; s < 4; ++s) qf[s] = *(const bf16x8*)(qp + 16 * s);
        asm volatile("" : "+v"(qf[0]), "+v"(qf[1]), "+v"(qf[2]), "+v"(qf[3]));
    }
    {
        const bf16_t* gp = P.Hb + (size_t)tq * HP + C_GT + 3 * hd;
        if (hh == 0) { ws_[n] = bf2f(gp[0]); ws_[32 + n] = bf2f(gp[1]); ws_[64 + n] = bf2f(gp[2]); }
    }
    const int srow = tid >> 3, sch = tid & 7;
    StageRegs sr;
    f32x16 o[2], outv[2];
    float den = 0.f;
    o[0] = (f32x16){}; o[1] = (f32x16){};
    {
        const int kt0 = P.qb >= 8 ? P.qb - 8 : 0, nkt = P.qb - kt0 + 1;
        {
            const bf16_t* rp = P.Hb + (size_t)(64 * kt0 + srow) * HP;
            stage_load(sr, rp + C_KW, rp + C_VW, true, sch);
            stage_write(lds + L_KV, sr, srow, sch);
        }
        __syncthreads();
        for (int t = 0; t < nkt; ++t) {
            LAS unsigned char* buf = lds + L_KV + (t & 1) * KVB;
            if (t + 1 < nkt) { const bf16_t* rp = P.Hb + (size_t)(64 * (kt0 + t + 1) + srow) * HP; stage_load(sr, rp + C_KW, rp + C_VW, true, sch); }
#pragma unroll
            for (int sub = 0; sub < 2; ++sub) {
                const int kb = 64 * (kt0 + t) + 32 * sub;
                if (kb <= twmax && kb + 31 >= twmin - 511) {
                    f32x16 acc;
                    const LAS float* tb = tw + hd * WTS + (WTOP - (tq - kb - 4 * hh));
#pragma unroll
                    for (int r = 0; r < 16; ++r) acc[r] = tb[(r & 3) + 8 * (r >> 2)];
                    qk_sub<0, 4>(acc, buf, sub, qf, lane);
#pragma unroll
                    for (int r = 0; r < 1; ++r) den += exp_sum16(acc);
                    bf16x8 pa0, pa1; pack_p(acc, pa0, pa1);
                    pv_sub(o, buf, sub, pa0, pa1, lane);
                }
            }
            if (t + 1 < nkt) stage_write(lds + L_KV + ((t + 1) & 1) * KVB, sr, srow, sch);
            __syncthreads();
        }
    }
    {
        const float dt = den + __shfl_xor(den, 32);
        if (hh == 0) ws_[128 + n] = __builtin_amdgcn_rcpf(dt);
        asm volatile("s_waitcnt lgkmcnt(0)" ::: "memory");
#pragma unroll
        for (int r = 0; r < 16; ++r) { const int nn = crow(r, hh); const float gi = ws_[64 + nn] * ws_[128 + nn]; outv[0][r] = o[0][r] * gi; outv[1][r] = o[1][r] * gi; }
    }
    if (opq(threadIdx.x) == 128) {
        unsigned sp = 0;
        while (__hip_atomic_load(P.cdone, __ATOMIC_RELAXED, __HIP_MEMORY_SCOPE_AGENT) < 64u) { __builtin_amdgcn_s_sleep(2); if (++sp > (1u << 24)) break; }
        __builtin_amdgcn_fence(__ATOMIC_ACQUIRE, "agent"); asm volatile("s_waitcnt vmcnt(0)" ::: "memory");
    }
    __syncthreads();
    const int tlast = 64 * P.qb + 63;
    const int ntc = tlast >= 31 ? (((tlast - 31) >> 4) >> 6) + 1 : 0;
    float invden = 0.f; den = 0.f;
    o[0] = (f32x16){}; o[1] = (f32x16){};
    for (int pass = 0; pass < 2; ++pass) {
        if (ntc > 0) {
            __syncthreads();
            stage_load(sr, P.KC + (size_t)srow * 64, P.VC + (size_t)srow * 64, true, sch);
            stage_write(lds + L_KV, sr, srow, sch);
            __syncthreads();
            for (int t = 0; t < ntc; ++t) {
                LAS unsigned char* buf = lds + L_KV + (t & 1) * KVB;
                if (t + 1 < ntc) stage_load(sr, P.KC + (size_t)(64 * (t + 1) + srow) * 64, P.VC + (size_t)(64 * (t + 1) + srow) * 64, true, sch);
#pragma unroll
                for (int sub = 0; sub < 2; ++sub) {
                    const int cb = 64 * t + 32 * sub;
                    if (16 * cb + 31 <= twmax) {
                        f32x16 acc;
                        const int dmin = twmin - 16 * (cb + 31) - 31;
                        if (dmin >= 1513) acc = splat16(cfar);
                        else {
                            const LAS float* tb = tg + hd * GTS + (GTOP - (tq - 31 - 16 * cb - 64 * hh));
#pragma unroll
                            for (int r = 0; r < 16; ++r) acc[r] = tb[16 * ((r & 3) + 8 * (r >> 2))];
                        }
                        qk_sub<0, 4>(acc, buf, sub, qf, lane);
#pragma unroll
                        for (int r = 0; r < 16; ++r) acc[r] = __builtin_amdgcn_exp2f(acc[r]);
                        if (pass == 0) {
#pragma unroll
                            for (int r = 0; r < 16; ++r) { den += acc[r]; asm volatile("" : "+v"(den)); }
                        } else {
#pragma unroll
                            for (int r = 0; r < 16; ++r) acc[r] *= invden;
#pragma unroll
                            for (int g = 0; g < 4; ++g) {
                                float G = (acc[4 * g] + acc[4 * g + 1]) + (acc[4 * g + 2] + acc[4 * g + 3]), C = acc[4 * g + 3];
                                G += __shfl_xor(G, 1); G += __shfl_xor(G, 2); C += __shfl_xor(C, 1); C += __shfl_xor(C, 2);
                                if (hd == 0) {
                                    const int j = (cb >> 2) + 2 * g + hh;
                                    __hip_atomic_fetch_add(impw + q8 * 128 + j, G, __ATOMIC_RELAXED, __HIP_MEMORY_SCOPE_WORKGROUP);
                                    if (j + 1 < 128) __hip_atomic_fetch_add(impw + q8 * 128 + j + 1, C, __ATOMIC_RELAXED, __HIP_MEMORY_SCOPE_WORKGROUP);
                                }
                            }
                            bf16x8 pa0, pa1; pack_p(acc, pa0, pa1);
                            pv_sub(o, buf, sub, pa0, pa1, lane);
                        }
                    }
                }
                if (t + 1 < ntc) stage_write(lds + L_KV + ((t + 1) & 1) * KVB, sr, srow, sch);
                __syncthreads();
            }
        }
        if (pass == 0) { const float dt = den + __shfl_xor(den, 32); invden = dt > 0.f ? 1.f / dt : 0.f; }
    }
    asm volatile("s_waitcnt lgkmcnt(0)" ::: "memory");
#pragma unroll
    for (int r = 0; r < 16; ++r) { const float g0 = ws_[crow(r, hh)]; outv[0][r] += o[0][r] * g0; outv[1][r] += o[1][r] * g0; }
    {
        float* sp = P.scr + tid;
#pragma unroll
        for (int r = 0; r < 16; ++r) { sp[r * 512] = outv[0][r]; sp[(16 + r) * 512] = outv[1][r]; }
    }
    {
        const int qsel = lane >> 3, sb = lane & 7;
        unsigned key[16];
#pragma unroll
        for (int i4 = 0; i4 < 4; ++i4) {
            const f32x4 v = *(const LAS f32x4*)(impw + qsel * 128 + sb * 16 + 4 * i4);
#pragma unroll
            for (int e = 0; e < 4; ++e) {
                const int j = sb * 16 + 4 * i4 + e;
                const bool forced = (j == 0) | (j == P.qb) | (j == P.qb - 1);
                key[4 * i4 + e] = forced ? 0xFFFFFFFFu : (j <= P.qb ? __float_as_uint(v[e]) + 1u : 0u);
            }
        }
        unsigned T = 0u;
        for (int bit = 31; bit >= 0; --bit) {
            const unsigned cand = T | (1u << bit);
            int cnt = 0;
#pragma unroll
            for (int i = 0; i < 16; ++i) cnt += key[i] >= cand ? 1 : 0;
            cnt += __shfl_xor(cnt, 1); cnt += __shfl_xor(cnt, 2); cnt += __shfl_xor(cnt, 4);
            if (cnt >= 16) T = cand;
        }
        int cgt = 0, ceq = 0;
#pragma unroll
        for (int i = 0; i < 16; ++i) { cgt += key[i] > T ? 1 : 0; ceq += key[i] == T ? 1 : 0; }
        int cg = cgt; cg += __shfl_xor(cg, 1); cg += __shfl_xor(cg, 2); cg += __shfl_xor(cg, 4);
        int pre = 0;
#pragma unroll
        for (int k = 0; k < 8; ++k) { const int v = __shfl(ceq, (lane & ~7) + k); if (k < sb) pre += v; }
        int need = 16 - cg - pre;
        unsigned bits = 0u;
#pragma unroll
        for (int i = 0; i < 16; ++i) {
            const int j = sb * 16 + i;
            bool s_ = key[i] > T;
            if (key[i] == T) { if (need > 0) { s_ = true; } --need; }
            if (s_ && j <= P.qb) bits |= 1u << i;
        }
        const unsigned other = __shfl_xor(bits, 1);
        const unsigned word = (sb & 1) ? ((bits << 16) | other) : (bits | (other << 16));
        if ((sb & 1) == 0) { selw[qsel * 4 + (sb >> 1)] = word; __hip_atomic_fetch_or(uni + (sb >> 1), word, __ATOMIC_RELAXED, __HIP_MEMORY_SCOPE_WORKGROUP); }
    }
    __syncthreads();
    unsigned lm0 = selw[q8 * 4 + 0], lm1 = selw[q8 * 4 + 1], lm2 = selw[q8 * 4 + 2], lm3 = selw[q8 * 4 + 3];
    unsigned wm0 = 0, wm1 = 0, wm2 = 0, wm3 = 0;
#pragma unroll
    for (int k = 0; k < 8; ++k) { wm0 |= selw[k * 4 + 0]; wm1 |= selw[k * 4 + 1]; wm2 |= selw[k * 4 + 2]; wm3 |= selw[k * 4 + 3]; }
    wm0 = __builtin_amdgcn_readfirstlane(wm0); wm1 = __builtin_amdgcn_readfirstlane(wm1); wm2 = __builtin_amdgcn_readfirstlane(wm2); wm3 = __builtin_amdgcn_readfirstlane(wm3);
    const unsigned um0 = __builtin_amdgcn_readfirstlane(uni[0]), um1 = __builtin_amdgcn_readfirstlane(uni[1]), um2 = __builtin_amdgcn_readfirstlane(uni[2]), um3 = __builtin_amdgcn_readfirstlane(uni[3]);
#define NSA_WORD(a0, a1, a2, a3, j) ((j) < 32 ? (a0) : ((j) < 64 ? (a1) : ((j) < 96 ? (a2) : (a3))))
#define NSA_NEXT(j, res) do { int _j = (j); res = 128; while (_j < 128) { const unsigned _w = NSA_WORD(um0, um1, um2, um3, _j) >> (_j & 31); if (_w) { res = _j + __builtin_ctz(_w); break; } _j = (_j | 31) + 1; } } while (0)
    o[0] = (f32x16){}; o[1] = (f32x16){}; den = 0.f;
#define NSA_SLC_COMPUTE(JJ, BUF) do { \
        if ((NSA_WORD(wm0, wm1, wm2, wm3, (JJ)) >> ((JJ) & 31)) & 1u) { \
            const bool lsel = (NSA_WORD(lm0, lm1, lm2, lm3, (JJ)) >> ((JJ) & 31)) & 1u; \
            _Pragma("unroll") for (int sub = 0; sub < 2; ++sub) { \
                const int kb = 64 * (JJ) + 32 * sub; \
                if (kb <= twmax) { \
                    f32x16 acc; \
                    if (twmin - kb - 31 >= 1513) acc = splat16(lsel ? cfar : -1e30f); \
                    else { const LAS float* tb = lsel ? tg + hd * GTS + (GTOP - (tq - kb - 4 * hh)) : dead; \
                        _Pragma("unroll") for (int r = 0; r < 16; ++r) acc[r] = tb[(r & 3) + 8 * (r >> 2)]; } \
                    qk_sub<0, 4>(acc, (BUF), sub, qf, lane); \
                    den += exp_sum16(acc); \
                    bf16x8 pa0, pa1; pack_p(acc, pa0, pa1); \
                    pv_sub(o, (BUF), sub, pa0, pa1, lane); \
                } } } } while (0)
#define NSA_SLC_LOAD(JJ, SR) do { const bf16_t* rp_ = P.Hb + (size_t)(64 * (JJ) + srow) * HP; stage_load(SR, rp_ + C_KS, rp_ + C_VS, true, sch); } while (0)
    {
        LAS unsigned char* pb0 = lds + L_KV; LAS unsigned char* pb1 = lds + L_IMP;
        StageRegs a0, a1, b0, b1;
#define NSA_PAIR(prev, ra, rb) do { ra = 128; if ((prev) < 128) { NSA_NEXT((prev) + 1, ra); } rb = 128; if (ra < 128) { NSA_NEXT(ra + 1, rb); } } while (0)
#define NSA_SLC_LOADC(JJ, SR) do { const int jc_ = (JJ) < 128 ? (JJ) : 0; NSA_SLC_LOAD(jc_, SR); } while (0)
        int ca, cb_, n1a, n1b, n2a, n2b, n3a, n3b;
        NSA_NEXT(0, ca); cb_ = 128; if (ca < 128) { NSA_NEXT(ca + 1, cb_); }
        NSA_PAIR(cb_, n1a, n1b); NSA_PAIR(n1b, n2a, n2b);
        NSA_SLC_LOADC(ca, b0); NSA_SLC_LOADC(cb_, b1);
        NSA_SLC_LOADC(n1a, a0); NSA_SLC_LOADC(n1b, a1);
        stage_write(pb0, b0, srow, sch); stage_write(pb0 + KVB, b1, srow, sch);
        NSA_SLC_LOADC(n2a, b0); NSA_SLC_LOADC(n2b, b1);
        __syncthreads();
        for (;;) {
            NSA_SLC_COMPUTE(ca, pb0);
            if (cb_ < 128) NSA_SLC_COMPUTE(cb_, pb0 + KVB);
            stage_write(pb1, a0, srow, sch); stage_write(pb1 + KVB, a1, srow, sch);
            NSA_PAIR(n2b, n3a, n3b);
            NSA_SLC_LOADC(n3a, a0); NSA_SLC_LOADC(n3b, a1);
            __syncthreads();
            if (n1a >= 128) break;
            NSA_SLC_COMPUTE(n1a, pb1);
            if (n1b < 128) NSA_SLC_COMPUTE(n1b, pb1 + KVB);
            stage_write(pb0, b0, srow, sch); stage_write(pb0 + KVB, b1, srow, sch);
            int n4a, n4b; NSA_PAIR(n3b, n4a, n4b);
            NSA_SLC_LOADC(n4a, b0); NSA_SLC_LOADC(n4b, b1);
            __syncthreads();
            if (n2a >= 128) break;
            ca = n2a; cb_ = n2b; n1a = n3a; n1b = n3b; n2a = n4a; n2b = n4b;
        }
#undef NSA_PAIR
#undef NSA_SLC_LOADC
    }
#undef NSA_SLC_COMPUTE
#undef NSA_SLC_LOAD
    {
        const float dt = den + __shfl_xor(den, 32);
        if (hh == 0) ws_[96 + n] = 1.f / dt;
        asm volatile("s_waitcnt lgkmcnt(0)" ::: "memory");
        const float* sp = P.scr + tid;
#pragma unroll
        for (int r = 0; r < 16; ++r) { const float gi = ws_[32 + crow(r, hh)] * ws_[96 + crow(r, hh)]; outv[0][r] = sp[r * 512] + o[0][r] * gi; outv[1][r] = sp[(16 + r) * 512] + o[1][r] * gi; }
    }
    {
#pragma unroll
        for (int r = 0; r < 16; ++r) {
            const int nn = crow(r, hh);
            const size_t trow = (size_t)(64 * P.qb + 8 * w + (nn >> 2));
            const int ycol = 768 + 64 * (nn & 3);
            const bf16_t* sp = P.Hb + trow * HP + C_SILU + ycol;
            bf16_t* yp = P.Y + (P.brow + trow) * DM + ycol;
            yp[n] = f2bf(outv[0][r] * bf2f(sp[n]));
            yp[32 + n] = f2bf(outv[1][r] * bf2f(sp[32 + n]));
        }
    }
    __syncthreads();
#undef NSA_WORD
#undef NSA_NEXT
}
}

#define XB_TMO      128
#define XB_XCNT(j)  (256  + 64 * (j))
#define XB_XSUB(j)  (1280 + 64 * (j))
#define XB_XGEN(j)  (2304 + 64 * (j))
#define XB_TOP      3328
#define XB_TOPGEN   3392
#define XCD_BAR_WORDS 3456
#define XB_SPIN_CAP (1u << 22)
__device__ __forceinline__ unsigned xb_ld(unsigned* p)              { return __hip_atomic_load(p, __ATOMIC_RELAXED, __HIP_MEMORY_SCOPE_AGENT); }
__device__ __forceinline__ unsigned xb_add(unsigned* p, unsigned v) { return __hip_atomic_fetch_add(p, v, __ATOMIC_RELAXED, __HIP_MEMORY_SCOPE_AGENT); }
__device__ __forceinline__ unsigned xb_xcc_id() { return (unsigned)__builtin_amdgcn_s_getreg((3 << 11) | 20) & 0xFu; }
#define XB_SPIN(cond, bar) do { unsigned _sp = 0; while (cond) { __builtin_amdgcn_s_sleep(1); \
    if ((++_sp & 255u) == 0u) { if (xb_ld(&(bar)[XB_TMO])) break; if (_sp > XB_SPIN_CAP) { atomicAdd(&(bar)[XB_TMO], 1u); break; } } } } while (0)
struct XcdBarrier { unsigned* bar; unsigned x; volatile LAS unsigned* st; };
__device__ __forceinline__ XcdBarrier xcd_barrier_post(unsigned* bar, volatile LAS unsigned* st) {
    XcdBarrier b; b.bar = bar; b.x = xb_xcc_id(); b.st = st;
    if (threadIdx.x == 0) (void)xb_add(&bar[XB_XCNT(b.x)], 1u);
    return b;
}
__device__ __forceinline__ void xcd_barrier_complete(unsigned* bar, unsigned x, unsigned& nloc, unsigned& nx) {
    const unsigned G = gridDim.x * gridDim.y * gridDim.z;
    unsigned sum, cnt, mine, sp = 0u;
    for (;;) {
        sum = 0u; cnt = 0u; mine = 0u;
#pragma unroll
        for (unsigned j = 0; j < 16; ++j) { const unsigned c = xb_ld(&bar[XB_XCNT(j)]); sum += c; cnt += (c > 0u) ? 1u : 0u; mine = (j == x) ? c : mine; }
        if (sum == G) break;
        __builtin_amdgcn_s_sleep(1);
        if ((++sp & 255u) == 0u) { if (xb_ld(&bar[XB_TMO])) break; if (sp > XB_SPIN_CAP) { atomicAdd(&bar[XB_TMO], 1u); break; } }
    }
    nloc = mine > 0u ? mine : 1u; nx = cnt > 0u ? cnt : 1u;
}
__device__ __forceinline__ void xcd_barrier(const XcdBarrier& b) {
    asm volatile("s_waitcnt vmcnt(0)" ::: "memory");
    __syncthreads();
    if (threadIdx.x == 0) {
        unsigned* bar = b.bar;
        __builtin_amdgcn_s_waitcnt(0);
        unsigned nloc = b.st[0], nx = b.st[1];
        if (nloc == 0u) { xcd_barrier_complete(bar, b.x, nloc, nx); b.st[0] = nloc; b.st[1] = nx; }
        const unsigned old = xb_add(&bar[XB_XSUB(b.x)], 1u);
        const unsigned gen = old / nloc;
        if (old + 1u == (gen + 1u) * nloc) {
            __builtin_amdgcn_fence(__ATOMIC_RELEASE, "agent");
            asm volatile("s_waitcnt vmcnt(0)" ::: "memory");
            const unsigned og = xb_add(&bar[XB_TOP], 1u);
            const unsigned tg = og / nx;
            if (og + 1u == (tg + 1u) * nx) xb_add(&bar[XB_TOPGEN], 1u);
            else XB_SPIN(xb_ld(&bar[XB_TOPGEN]) == tg, bar);
            __builtin_amdgcn_fence(__ATOMIC_ACQUIRE, "agent");
            xb_add(&bar[XB_XGEN(b.x)], 1u);
            asm volatile("s_waitcnt vmcnt(0)" ::: "memory");
        } else {
            XB_SPIN(xb_ld(&bar[XB_XGEN(b.x)]) == gen, bar);
            __builtin_amdgcn_fence(__ATOMIC_ACQUIRE, "agent");
            asm volatile("s_waitcnt vmcnt(0)" ::: "memory");
        }
    }
    __syncthreads();
}

constexpr int NT = 512, LDS_BYTES = 147456, MISC_OFF = 131072 + 320;
#ifndef R_C
#define R_C 1
#endif
#ifndef R_D
#define R_D 1
#endif
#ifndef R_AB
#define R_AB 1
#endif
#ifndef R_G1
#define R_G1 1
#endif
constexpr size_t MiB = 1u << 20;
constexpr size_t WS_CTL = 0, CTL_ZERO_BYTES = 65536;
constexpr size_t WS_NSCR = 184 * MiB;
constexpr size_t WS_H = 2 * MiB, WS_XN = 124 * MiB, WS_T0 = 158 * MiB, WS_IMP = 208 * MiB, WS_SEL = 217 * MiB, WS_HID = 218 * MiB, WS_KC = 221 * MiB, WS_VC = 222 * MiB, WS_WIN = 224 * MiB, WS_WOUT = 240 * MiB, WS_MX = 1 * MiB, WS_DA = 245 * MiB, WS_CW1 = 246 * MiB, WS_CW2 = 250 * MiB, WS_RSS = 251 * MiB;

struct Args { const float* in[15]; float* out; unsigned char* ws; };

__global__ void __launch_bounds__(NT, 2) mega_fwd(Args args) {
    extern __shared__ __attribute__((aligned(16))) unsigned char lds[];
    const int tid = threadIdx.x, lane = tid & 63, wid = tid >> 6;
    const int G = gridDim.x, bid = blockIdx.x;
    volatile LAS unsigned* MISC = (volatile LAS unsigned*)((LAS unsigned char*)lds + MISC_OFF);
    if (tid < 32) MISC[tid] = 0u;
    __syncthreads();
    unsigned char* ws = args.ws;
    XcdBarrier bar = xcd_barrier_post((unsigned*)(ws + WS_CTL) + 4096, MISC + 8);
    const float* x = args.in[0]; const float* tab = args.in[1]; const float* norm_w = args.in[2];
    const float* w_in = args.in[3]; const float* w_out = args.in[4]; const float* qk_gain = args.in[5];
    const float* qk_gain_diff = args.in[6]; const float* sinks = args.in[7]; const float* diff_lambda = args.in[8];
    const float* diff_subln = args.in[9]; const float* cmp_pos = args.in[10]; const float* cmp_w1 = args.in[11];
    const float* cmp_b1 = args.in[12]; const float* cmp_w2 = args.in[13]; const float* cmp_b2 = args.in[14];
    float* out = args.out;
    bf16_t* H = (bf16_t*)(ws + WS_H);
    bf16_t* XN = (bf16_t*)(ws + WS_XN); bf16_t* Y = XN;
    float* T0 = (float*)(ws + WS_T0);
    float* OC = T0; float* OS_ = T0 + (size_t)MROWS * 256; float* OW = T0 + (size_t)MROWS * 512; float* CT = T0;
    float* IMP = (float*)(ws + WS_IMP); unsigned* SEL = (unsigned*)(ws + WS_SEL); float* HID = (float*)(ws + WS_HID);
    float* KC = (float*)(ws + WS_KC); float* VC = (float*)(ws + WS_VC);
    const int GT = G * NT, GW = G * 8;
    bf16_t* WinT = (bf16_t*)(ws + WS_WIN); bf16_t* WoutT = (bf16_t*)(ws + WS_WOUT);
#define GRID_BAR() do { XcdBarrier b2_ = bar; asm volatile("" : "+s"(b2_.x)); xcd_barrier(b2_); } while (0)
    {
        LAS float* scr = (LAS float*)((LAS unsigned char*)lds + wid * 16384);
        const int gw0 = bid * 8 + wid;
        constexpr int I_IN = 16 * 120, I_OUT = 16 * 32, I_C1 = 32 * 8, I_C2 = 4 * 2, I_L = I_IN + I_OUT + 2 * I_C1 + 2 * I_C2, NITEMS = 2 * I_L;
        bf16_t* CW1T = (bf16_t*)(ws + WS_CW1); bf16_t* CW2T = (bf16_t*)(ws + WS_CW2);
        for (int it = gw0; it < NITEMS; it += GW) {
            const int l = it / I_L; int r = it % I_L;
            if (r < I_IN) { p0_transpose_item<0>(w_in + (size_t)l * DM * PW, WinT + (size_t)l * HP * DM, scr, r, lane); continue; } r -= I_IN;
            if (r < I_OUT) { p0_transpose_item<1>(w_out + (size_t)l * DM * DM, WoutT + (size_t)l * DM * DM, scr, r, lane); continue; } r -= I_OUT;
            if (r < 2 * I_C1) { const int kv = r / I_C1; p0_transpose_item<2>(cmp_w1 + (size_t)(l * 2 + kv) * 2048 * 256, CW1T + (size_t)(l * 2 + kv) * 256 * 2048, scr, r % I_C1, lane, 2048, 256); continue; } r -= 2 * I_C1;
            { const int kv = r / I_C2; p0_transpose_item<1>(cmp_w2 + (size_t)(l * 2 + kv) * 256 * 64, CW2T + (size_t)(l * 2 + kv) * 64 * 256, scr, r % I_C2, lane, 256, 64); }
        }
        if (bid == 1 && tid < 256) { bf16_t* KCb = (bf16_t*)(ws + WS_KC); KCb[(size_t)(tid >> 6) * 512 * 64 + 511 * 64 + (tid & 63)] = 0; }
        for (int w = gw0; w < MROWS; w += GW) k_rmsnorm(w, lane, x, norm_w, XN);
        for (int v = bid * NT + tid; v < MROWS; v += GT) ((unsigned long long*)(ws + WS_RSS))[v] = 0ull;
        if (bid == 0 && wid == 0) {
            float* MX = (float*)(ws + WS_MX);
            for (int l = 0; l < 2; ++l) {
                float mg[8];
#pragma unroll
                for (int i = 0; i < 8; ++i) { float v = fabsf(qk_gain[l * 512 + i * 64 + lane]);
#pragma unroll
                    for (int o = 1; o < 64; o <<= 1) v = fmaxf(v, __shfl_xor(v, o));
                    mg[i] = v; }
                float md0 = lane < 32 ? fabsf(qk_gain_diff[l * 64 + lane]) : 0.f, md1 = lane < 32 ? fabsf(qk_gain_diff[l * 64 + 32 + lane]) : 0.f;
#pragma unroll
                for (int o = 1; o < 64; o <<= 1) { md0 = fmaxf(md0, __shfl_xor(md0, o)); md1 = fmaxf(md1, __shfl_xor(md1, o)); }
                for (int gh = 0; gh < 16; ++gh) {
                    float mb = lane < 32 ? fabsf(tab[lane * 16 + gh]) : 0.f;
#pragma unroll
                    for (int o = 1; o < 64; o <<= 1) mb = fmaxf(mb, __shfl_xor(mb, o));
                    const int grp = gh >> 2, hh = gh & 3; float Mv;
                    if (grp == 0) Mv = 8.f * mg[0] * mg[1] + mb;
                    else if (grp == 1) Mv = fmaxf(8.f * mg[2] * mg[3] + mb, sinks[l * 4 + hh]);
                    else if (grp == 2) Mv = 5.656854249f * md0 * md1 + mb;
                    else Mv = 8.f * mg[4] * fmaxf(mg[5], fmaxf(mg[6], mg[7])) + mb;
                    if (lane == 0) MX[l * 16 + gh] = Mv;
                }
                float s1 = lane < 32 ? diff_lambda[l * 128 + lane] * diff_lambda[l * 128 + 32 + lane] : 0.f;
                float s2 = lane < 32 ? diff_lambda[l * 128 + 64 + lane] * diff_lambda[l * 128 + 96 + lane] : 0.f;
#pragma unroll
                for (int o = 1; o < 64; o <<= 1) { s1 += __shfl_xor(s1, o); s2 += __shfl_xor(s2, o); }
                const float lambda_init = 0.8f - 0.6f * expf(-0.3f * (float)l);
                if (lane == 0) { MX[32 + l] = expf(s1) - expf(s2) + lambda_init; MX[34 + l] = lambda_init; }
            }
        }
    }
    GRID_BAR();
#pragma unroll 1
    for (int l = 0; l < 2; ++l) {
        const float* xprev = l == 0 ? x : out;
        { pg8::Gemm g{XN, WinT + (size_t)l * HP * DM, MROWS, HP, DM}; pg8::StaticOrder So; So.init(MROWS, HP, G, bid);
          pg8::EpiProj E{H, qk_gain + l * 512, qk_gain_diff + l * 64, l == 0 ? nullptr : (const float*)(ws + WS_RSS)};
          for (int rep = 0; rep < R_G1; ++rep) pg8::gemm_phase<pg8::EpiProj, pg8::StaticOrder, true, true>((LAS unsigned char*)lds, g, So, E); }
        GRID_BAR();
        {
            const float* MX = (const float*)(ws + WS_MX);
            bf16_t* OA = (bf16_t*)(ws + WS_T0); float* DA = (float*)(ws + WS_DA);
            bf16_t* KCb = (bf16_t*)(ws + WS_KC);
            const bf16_t* CW1T = (const bf16_t*)(ws + WS_CW1); const bf16_t* CW2T = (const bf16_t*)(ws + WS_CW2);
            LAS unsigned* qw = (LAS unsigned*)((LAS unsigned char*)lds + att::L_Q);
            unsigned* qctr = (unsigned*)(ws + WS_CTL) + 8192 + 128 * l;
            unsigned* cdone = qctr + 64;
            constexpr int B0 = 64, B1 = B0 + 160 * R_C, B2 = B1 + 256 * R_D, B3 = B2 + 96 * R_C, B4 = B3 + 768 * R_AB, NUV = B4 + 256 * R_AB;
            for (;;) {
                if (opq(threadIdx.x) == 0) *qw = atomicAdd(qctr, 1u);
                __syncthreads();
                const int uv = (int)*qw;
                __syncthreads();
                if (uv >= NUV) break;
                int u;
                if (uv < B0) u = uv; else if (uv < B1) u = 64 + (uv - B0) / R_C; else if (uv < B2) u = 224 + (uv - B1) / R_D; else if (uv < B3) u = 480 + (uv - B2) / R_C;
                else if (uv < B4) u = 576 + (uv - B3) / R_AB; else u = 1344 + (uv - B4) / R_AB;
                if (u < 64) {
                    const int kv = u >> 5, b = (u >> 4) & 1, rt = u & 15;
                    att::CmpArgs P; P.Hb = H + (size_t)b * S * HP; P.col = kv == 0 ? C_KC : C_VC; P.rt = rt;
                    P.pos = cmp_pos + (size_t)(l * 2 + kv) * 2048; P.W1T = CW1T + (size_t)(l * 2 + kv) * 256 * 2048; P.b1 = cmp_b1 + (l * 2 + kv) * 256;
                    P.W2T = CW2T + (size_t)(l * 2 + kv) * 64 * 256; P.b2 = cmp_b2 + (l * 2 + kv) * 64; P.gain = kv == 0 ? qk_gain + l * 512 + 5 * 64 : nullptr;
                    P.OUT = KCb + (size_t)(kv * NB + b) * 512 * 64;
                    att::cmp_unit((LAS unsigned char*)lds, P);
                    asm volatile("s_waitcnt vmcnt(0)" ::: "memory");
                    __syncthreads();
                    if (opq(threadIdx.x) == 64) { __builtin_amdgcn_fence(__ATOMIC_RELEASE, "agent"); asm volatile("s_waitcnt vmcnt(0)" ::: "memory");
                        __hip_atomic_fetch_add(cdone, 1u, __ATOMIC_RELAXED, __HIP_MEMORY_SCOPE_AGENT); }
                    __syncthreads();
                } else if ((u >= 64 && u < 224) || (u >= 480 && u < 576)) {
                    int qb, bh;
                    if (u < 224) { qb = 31 - ((u - 64) >> 3); bh = (u - 64) & 7; } else { qb = 11 - ((u - 480) >> 3); bh = (u - 480) & 7; }
                    const int b = bh >> 2, hd = bh & 3;
                    att::DiffArgs P; P.Hb = H + (size_t)b * S * HP; P.hd = hd; P.qb = qb; P.brow = (size_t)b * S;
                    P.bias = tab + 8 + hd; P.M = MX[l * 16 + 8 + hd]; P.lam = MX[32 + l]; P.lambda_init = MX[34 + l]; P.subln = diff_subln + l * 64; P.Y = Y;
                    att::diff_unit((LAS unsigned char*)lds, P);
                } else if (u < 480) {
                    const int idx = u - 224, qb64 = 127 - (idx >> 1), b = idx & 1;
                    att::NsaArgs P; P.Hb = H + (size_t)b * S * HP; P.brow = (size_t)b * S; P.qb = qb64;
                    P.KC = KCb + (size_t)(0 * NB + b) * 512 * 64; P.VC = KCb + (size_t)(1 * NB + b) * 512 * 64;
                    P.bias = tab + 12; P.Mv = MX + l * 16 + 12; P.Y = Y; P.cdone = cdone; P.scr = (float*)(ws + WS_NSCR) + (size_t)bid * 16384;
                    att::nsa_unit((LAS unsigned char*)lds, P);
                } else if (u < 1344) {
                    const int v = u - 576, cfg = v >> 8, b = (v >> 7) & 1, hd = (v >> 5) & 3, ti = v & 31;
                    const int rate = cfg == 0 ? 1 : (cfg == 1 ? 4 : 16), tpc = 32 / rate;
                    att::BandArgs P; P.Hb = H + (size_t)b * S * HP; P.cq = C_AQ + 64 * hd; P.ck = C_AK + 64 * hd; P.cv = C_AV + 64 * hd;
                    P.rate = rate; P.cls = ti / tpc; P.f0 = (ti % tpc) * 256; P.maxd = 128; P.bias = tab + hd; P.M = MX[l * 16 + hd]; P.sinkterm = 0.f;
                    P.OA = OA + (size_t)cfg * MROWS * 256; P.DA = DA + (size_t)cfg * MROWS * 4; P.Y = nullptr; P.ycol = 0; P.hd = hd; P.brow = (size_t)b * S;
                    att::banded_unit<0>((LAS unsigned char*)lds, P);
                } else {
                    const int v = u - 1344, b = (v >> 7) & 1, hd = (v >> 5) & 3, ti = v & 31;
                    att::BandArgs P; P.Hb = H + (size_t)b * S * HP; P.cq = C_BQ + 64 * hd; P.ck = C_BK + 64 * (hd >> 1); P.cv = C_BV + 64 * (hd >> 1);
                    P.rate = 1; P.cls = 0; P.f0 = ti * 256; P.maxd = 127; P.bias = tab + 4 + hd; P.M = MX[l * 16 + 4 + hd];
                    P.sinkterm = __expf(sinks[l * 4 + hd] - P.M);
                    P.OA = nullptr; P.DA = nullptr; P.Y = Y; P.ycol = 256 + 64 * hd; P.hd = hd; P.brow = (size_t)b * S;
                    att::banded_unit<1>((LAS unsigned char*)lds, P);
                }
            }
        }
        GRID_BAR();
        {
            const bf16_t* OA = (const bf16_t*)(ws + WS_T0); const float* DA = (const float*)(ws + WS_DA);
            for (int v = (bid * NT + opq(threadIdx.x)); v < MROWS * 32; v += GT) {
                const int row = v >> 5, hd = (v >> 3) & 3, c8 = v & 7;
                float acc8[8] = {0.f, 0.f, 0.f, 0.f, 0.f, 0.f, 0.f, 0.f}; float dsum = 0.f;
#pragma unroll
                for (int cfg = 0; cfg < 3; ++cfg) {
                    const float dn = DA[((size_t)cfg * MROWS + row) * 4 + hd]; dsum += dn;
                    const uint4 r4 = *(const uint4*)(OA + ((size_t)cfg * MROWS + row) * 256 + hd * 64 + c8 * 8);
                    acc8[0] += dn * __uint_as_float(r4.x << 16); acc8[1] += dn * __uint_as_float(r4.x & 0xffff0000u);
                    acc8[2] += dn * __uint_as_float(r4.y << 16); acc8[3] += dn * __uint_as_float(r4.y & 0xffff0000u);
                    acc8[4] += dn * __uint_as_float(r4.z << 16); acc8[5] += dn * __uint_as_float(r4.z & 0xffff0000u);
                    acc8[6] += dn * __uint_as_float(r4.w << 16); acc8[7] += dn * __uint_as_float(r4.w & 0xffff0000u);
                }
                const float inv = 1.f / dsum;
                const uint4 s4 = *(const uint4*)(H + (size_t)row * HP + C_SILU + hd * 64 + c8 * 8);
                uint4 o4;
                o4.x = (unsigned)f2bf(acc8[0] * inv * __uint_as_float(s4.x << 16)) | ((unsigned)f2bf(acc8[1] * inv * __uint_as_float(s4.x & 0xffff0000u)) << 16);
                o4.y = (unsigned)f2bf(acc8[2] * inv * __uint_as_float(s4.y << 16)) | ((unsigned)f2bf(acc8[3] * inv * __uint_as_float(s4.y & 0xffff0000u)) << 16);
                o4.z = (unsigned)f2bf(acc8[4] * inv * __uint_as_float(s4.z << 16)) | ((unsigned)f2bf(acc8[5] * inv * __uint_as_float(s4.z & 0xffff0000u)) << 16);
                o4.w = (unsigned)f2bf(acc8[6] * inv * __uint_as_float(s4.w << 16)) | ((unsigned)f2bf(acc8[7] * inv * __uint_as_float(s4.w & 0xffff0000u)) << 16);
                *(uint4*)(Y + (size_t)row * DM + hd * 64 + c8 * 8) = o4;
            }
        }
        GRID_BAR();
        { pg8::Gemm g{Y, WoutT + (size_t)l * DM * DM, MROWS, DM, DM}; pg8::StaticOrder So; So.init(MROWS, DM, G, bid);
          pg8::EpiOut E{xprev, out, (LAS float*)((LAS unsigned char*)lds + 132096), l == 0 ? XN : nullptr, norm_w + DM, (float*)(ws + WS_RSS)};
          pg8::gemm_phase<pg8::EpiOut, pg8::StaticOrder, true, true>((LAS unsigned char*)lds, g, So, E); }
        if (l == 0) GRID_BAR();
    }
}

extern "C" void kernel_launch(void* const* d_in, const int* in_sizes, int n_in, void* d_out, int out_size, void* d_ws, size_t ws_size, hipStream_t stream) {
    static int grid = 0;
    if (grid == 0) {
        int dev = 0, cus = 0;
        (void)hipGetDevice(&dev);
        (void)hipDeviceGetAttribute(&cus, hipDeviceAttributeMultiprocessorCount, dev);
        (void)hipFuncSetAttribute((const void*)mega_fwd, hipFuncAttributeMaxDynamicSharedMemorySize, LDS_BYTES);
        grid = cus > 0 ? cus : 256;
    }
    (void)hipMemsetAsync((char*)d_ws + WS_CTL, 0, CTL_ZERO_BYTES, stream);
    Args a{};
    for (int i = 0; i < 15; ++i) a.in[i] = (const float*)d_in[i];
    a.out = (float*)d_out; a.ws = (unsigned char*)d_ws;
    hipLaunchKernelGGL(mega_fwd, dim3(grid), dim3(NT), LDS_BYTES, stream, a);
}
```

```cpp
#include <hip/hip_runtime.h>
#include <stdint.h>
#include <math.h>

typedef unsigned short bf16_t;
__device__ __forceinline__ float bf2f(bf16_t v) { return __uint_as_float((unsigned)v << 16); }
__device__ __forceinline__ bf16_t f2bf(float f) { unsigned u = __float_as_uint(f); return (bf16_t)((u + 0x7fffu + ((u >> 16) & 1u)) >> 16); }

constexpr int NB = 2, S = 8192, DM = 1024, MROWS = NB * S, PW = 3724, HP = 3840;
constexpr int C_AQ = 0, C_AK = 256, C_AV = 512, C_BQ = 768, C_BK = 1024, C_BV = 1152, C_CQ = 1280, C_CK = 1536, C_CV = 1792,
              C_DQ = 2048, C_KC = 2304, C_VC = 2368, C_KS = 2432, C_VS = 2496, C_KW = 2560, C_VW = 2624, C_GT = 2688, C_SILU = 2816;
constexpr float EPS = 1e-6f;
__device__ __forceinline__ int opq(int v) { asm volatile("" : "+v"(v)); return v; }

__device__ __forceinline__ int t5_bucket(int n) {
    if (n < 16) return n < 0 ? 0 : n;
    int b = 16;
    b += (n >= 22); b += (n >= 30); b += (n >= 40); b += (n >= 54); b += (n >= 73); b += (n >= 99); b += (n >= 134); b += (n >= 182);
    b += (n >= 246); b += (n >= 332); b += (n >= 450); b += (n >= 609); b += (n >= 825); b += (n >= 1117); b += (n >= 1513);
    return b;
}

__device__ __forceinline__ void k_rmsnorm(const int wave, const int lane, const float* __restrict__ x, const float* __restrict__ g, bf16_t* __restrict__ xn) {
    if (wave >= MROWS) return;
    const float4* xr = (const float4*)(x + (size_t)wave * DM);
    float4 v[4]; float ss = 0.f;
#pragma unroll
    for (int j = 0; j < 4; ++j) { v[j] = xr[lane + 64 * j]; ss += (v[j].x * v[j].x + v[j].y * v[j].y) + (v[j].z * v[j].z + v[j].w * v[j].w); }
#pragma unroll
    for (int o = 1; o < 64; o <<= 1) ss += __shfl_xor(ss, o);
    const float rstd = rsqrtf(ss * (1.f / DM) + EPS);
#pragma unroll
    for (int j = 0; j < 4; ++j) {
        const float4 gg = ((const float4*)g)[lane + 64 * j];
        uint2 o; o.x = (unsigned)f2bf(v[j].x * rstd * gg.x) | ((unsigned)f2bf(v[j].y * rstd * gg.y) << 16);
        o.y = (unsigned)f2bf(v[j].z * rstd * gg.z) | ((unsigned)f2bf(v[j].w * rstd * gg.w) << 16);
        ((uint2*)(xn + (size_t)wave * DM))[lane + 64 * j] = o;
    }
}

template <int D>
__device__ __forceinline__ float dot_row(const float* q, const bf16_t* kr) {
    float s = 0.f;
#pragma unroll
    for (int c = 0; c < D / 8; ++c) {
        const uint4 r = *(const uint4*)(kr + 8 * c);
        s += q[8 * c + 0] * __uint_as_float(r.x << 16) + q[8 * c + 1] * __uint_as_float(r.x & 0xffff0000u);
        s += q[8 * c + 2] * __uint_as_float(r.y << 16) + q[8 * c + 3] * __uint_as_float(r.y & 0xffff0000u);
        s += q[8 * c + 4] * __uint_as_float(r.z << 16) + q[8 * c + 5] * __uint_as_float(r.z & 0xffff0000u);
        s += q[8 * c + 6] * __uint_as_float(r.w << 16) + q[8 * c + 7] * __uint_as_float(r.w & 0xffff0000u);
        if (c & 1) asm volatile("" ::: "memory");
    }
    return s;
}
__device__ __forceinline__ void os_step(float s, const bf16_t* vr, float& m, float& den, float* o) {
    const float mn = fmaxf(m, s), sc = __expf(m - mn), p = __expf(s - mn);
    den = den * sc + p; m = mn;
#pragma unroll
    for (int c = 0; c < 8; ++c) {
        const uint4 r = *(const uint4*)(vr + 8 * c);
        o[8 * c + 0] = o[8 * c + 0] * sc + p * __uint_as_float(r.x << 16); o[8 * c + 1] = o[8 * c + 1] * sc + p * __uint_as_float(r.x & 0xffff0000u);
        o[8 * c + 2] = o[8 * c + 2] * sc + p * __uint_as_float(r.y << 16); o[8 * c + 3] = o[8 * c + 3] * sc + p * __uint_as_float(r.y & 0xffff0000u);
        o[8 * c + 4] = o[8 * c + 4] * sc + p * __uint_as_float(r.z << 16); o[8 * c + 5] = o[8 * c + 5] * sc + p * __uint_as_float(r.z & 0xffff0000u);
        o[8 * c + 6] = o[8 * c + 6] * sc + p * __uint_as_float(r.w << 16); o[8 * c + 7] = o[8 * c + 7] * sc + p * __uint_as_float(r.w & 0xffff0000u);
        if (c & 1) asm volatile("" ::: "memory");
    }
}
template <int D>
__device__ __forceinline__ void load_q(float* q, const bf16_t* p) {
#pragma unroll
    for (int c = 0; c < D / 8; ++c) {
        const uint4 r = *(const uint4*)(p + 8 * c);
        q[8 * c + 0] = __uint_as_float(r.x << 16); q[8 * c + 1] = __uint_as_float(r.x & 0xffff0000u);
        q[8 * c + 2] = __uint_as_float(r.y << 16); q[8 * c + 3] = __uint_as_float(r.y & 0xffff0000u);
        q[8 * c + 4] = __uint_as_float(r.z << 16); q[8 * c + 5] = __uint_as_float(r.z & 0xffff0000u);
        q[8 * c + 6] = __uint_as_float(r.w << 16); q[8 * c + 7] = __uint_as_float(r.w & 0xffff0000u);
    }
}

#define LAS __attribute__((address_space(3)))
namespace pg8 {
#define PG8_LAS __attribute__((address_space(3)))
typedef unsigned short bf16_t;
typedef short bf16x8 __attribute__((ext_vector_type(8)));
typedef float f32x4 __attribute__((ext_vector_type(4)));
typedef unsigned u32x4 __attribute__((ext_vector_type(4)));
constexpr int BM = 256, BK = 64, HALF = 128, HTB = HALF * BK * 2  , STAGE_BYTES = 8 * HTB, NXCD = 8, WGM = 8;

__host__ __device__ __forceinline__ int lds_byte(int r, int c) { const int st = (r >> 4) * 2 + (c >> 5), rr = r & 15, cc = c & 31, ob = rr * 64 + cc * 2; return st * 1024 + (ob ^ (((ob >> 9) & 1) << 5)); }
__host__ __device__ __forceinline__ void stage_rc(int b, int& R, int& C) { const int st = b / 1024, sb = b % 1024, swz = sb ^ (((sb >> 9) & 1) << 5); R = (st >> 1) * 16 + swz / 64; C = (st & 1) * 32 + (swz % 64) / 2; }
__host__ __device__ __forceinline__ int perm32(int rho) { const int n = rho >> 4, i = rho & 15; return 8 * (i >> 2) + 4 * n + (i & 3); }

struct Unit { int pm, pn; };
struct Gemm { const bf16_t* A; const bf16_t* Bt; int M, N, K; };

struct StaticOrder {
    int nM, nN, nwg, G, c;
    __host__ __device__ void init(int M, int N, int G_, int c_) { nM = M / BM; nN = N / BM; nwg = nM * nN; G = G_; c = c_; }
    __host__ __device__ bool next(int i, Unit& u) const {
        const long L = (long)i * G + c; if (L >= nwg) return false;
        int wgid = (int)L; { const int q = nwg / NXCD, r = nwg % NXCD, xcd = wgid % NXCD, off = wgid / NXCD; wgid = (xcd < r ? xcd * (q + 1) : r * (q + 1) + (xcd - r) * q) + off; }
        const int nig = WGM * nN, gid = wgid / nig, fm = gid * WGM, gsz = (nM - fm) < WGM ? (nM - fm) : WGM;
        u.pm = fm + ((wgid % nig) % gsz); u.pn = (wgid % nig) / gsz; return true;
    }
    __device__ __forceinline__ void a_ready(const Unit&) const {}
    __device__ __forceinline__ void done(const Unit&) const {}
};

__device__ __forceinline__ unsigned cvt_pk_bf16(float lo, float hi) { unsigned r; asm volatile("v_cvt_pk_bf16_f32 %0, %1, %2" : "=v"(r) : "v"(lo), "v"(hi)); return r; }
template <class Epi, class Sched, bool ALIGN_EPI = false, bool SP2 = false>
__device__ __forceinline__ void gemm_phase(PG8_LAS unsigned char* lds, const Gemm g, const Sched& S, const Epi& E) {
    const int tid = opq(threadIdx.x), wid = __builtin_amdgcn_readfirstlane(tid >> 6), lane = tid & 63, wr = wid >> 2, wc = wid & 3, fr = lane & 15, fq = lane >> 4;
    const int K = g.K, nt = K / BK;
    unsigned voffA[2], voffB[2];
#pragma unroll
    for (int i = 0; i < 2; ++i) { int R, C; stage_rc(tid * 16 + i * 8192, R, C); const int Rb = Epi::PERM ? ((R & ~31) + perm32(R & 31)) : R;
        voffA[i] = (unsigned)(R * K + C) * 2u; voffB[i] = (unsigned)(Rb * K + C) * 2u; }
    const size_t kstep = (size_t)(BK * 2);
    const size_t hstep = (size_t)HALF * K * 2;
    const size_t tstep = 2 * hstep;
    const unsigned ldsw = (unsigned)wid * 1024u;
    const int aoff = lds_byte(wr * 64 + fr, fq * 8), boff = lds_byte(wc * 32 + fr, fq * 8);
#define PG8_SA(b, h) (((b) * 2 + (h)) * HTB)
#define PG8_SB(b, h) ((4 + (b) * 2 + (h)) * HTB)
#define PG8_STAGE(bufoff, gbase, voff) do { _Pragma("unroll") for (int _i = 0; _i < 2; ++_i) \
        __builtin_amdgcn_global_load_lds((const unsigned*)((const char*)(gbase) + (voff)[_i]), (PG8_LAS unsigned*)(lds + (bufoff) + ldsw + _i * 8192), 16, 0, 0); } while (0)
#define PG8_LDA(dst, b, h) do { _Pragma("unroll") for (int m = 0; m < 4; ++m) _Pragma("unroll") for (int k = 0; k < 2; ++k) dst[m][k] = *(const PG8_LAS bf16x8*)(lds + PG8_SA(b, h) + aoff + m * 2048 + k * 1024); } while (0)
#define PG8_LDB(dst, b, h) do { _Pragma("unroll") for (int n = 0; n < 2; ++n) _Pragma("unroll") for (int k = 0; k < 2; ++k) dst[n][k] = *(const PG8_LAS bf16x8*)(lds + PG8_SB(b, h) + boff + n * 2048 + k * 1024); } while (0)
#define PG8_MMA(ai, bj, At, Bt) do { __builtin_amdgcn_s_setprio(1); _Pragma("unroll") for (int m = 0; m < 4; ++m) _Pragma("unroll") for (int n = 0; n < 2; ++n) _Pragma("unroll") for (int k = 0; k < 2; ++k) \
        acc[ai][bj][m][n] = __builtin_amdgcn_mfma_f32_16x16x32_bf16(Bt[n][k], At[m][k], acc[ai][bj][m][n], 0, 0, 0); __builtin_amdgcn_s_setprio(0); } while (0)
#define PG8_WAIT_V(n) asm volatile("s_waitcnt vmcnt(" #n ")" ::: "memory")
#define PG8_WAIT_L(n) asm volatile("s_waitcnt lgkmcnt(" #n ")" ::: "memory")
#define PG8_BAR __builtin_amdgcn_s_barrier()
#define PG8_SCHED __builtin_amdgcn_sched_barrier(0)
    Unit cur, nxt; int ui = 0;
    if (!S.next(0, cur)) return;
    f32x4 acc[2][2][4][2];
#pragma unroll
    for (int a = 0; a < 2; ++a)
#pragma unroll
        for (int b = 0; b < 2; ++b)
#pragma unroll
            for (int m = 0; m < 4; ++m)
#pragma unroll
                for (int n = 0; n < 2; ++n) acc[a][b][m][n] = (f32x4){0.f, 0.f, 0.f, 0.f};
    bf16x8 At[4][2], B0[2][2], B1[2][2];
    const char* cA = (const char*)g.A + (size_t)cur.pm * tstep; const char* cB = (const char*)g.Bt + (size_t)cur.pn * tstep;
    S.a_ready(cur);
    if constexpr (SP2) {
        PG8_STAGE(PG8_SB(0, 0), cB, voffB); PG8_STAGE(PG8_SB(0, 1), cB + hstep, voffB); PG8_STAGE(PG8_SA(0, 0), cA, voffA); PG8_STAGE(PG8_SA(0, 1), cA + hstep, voffA);
        if (wr == 1) PG8_BAR;
        PG8_WAIT_V(2); PG8_BAR;
        PG8_STAGE(PG8_SB(1, 0), cB + kstep, voffB); PG8_STAGE(PG8_SA(1, 0), cA + kstep, voffA); PG8_STAGE(PG8_SB(1, 1), cB + hstep + kstep, voffB);
        PG8_WAIT_V(6); PG8_BAR;
    } else {
        PG8_STAGE(PG8_SB(0, 0), cB, voffB); PG8_STAGE(PG8_SA(0, 0), cA, voffA); PG8_STAGE(PG8_SB(0, 1), cB + hstep, voffB); PG8_STAGE(PG8_SA(0, 1), cA + hstep, voffA);
        if (wr == 1) PG8_BAR;
        PG8_WAIT_V(4); PG8_BAR;
        PG8_STAGE(PG8_SB(1, 0), cB + kstep, voffB); PG8_STAGE(PG8_SA(1, 0), cA + kstep, voffA); PG8_STAGE(PG8_SB(1, 1), cB + hstep + kstep, voffB);
        PG8_WAIT_V(6); PG8_BAR;
    }
    for (;;) {
        const bool has_next = S.next(ui + 1, nxt);
        const char* nA = has_next ? (const char*)g.A + (size_t)nxt.pm * tstep : cA; const char* nB = has_next ? (const char*)g.Bt + (size_t)nxt.pn * tstep : cB;
        for (int t = 0; t < nt; t += 2) {
            const bool last = (t == nt - 2);
            const char* a1 = cA + (size_t)(t + 1) * kstep;
            const char* a2 = last ? nA : cA + (size_t)(t + 2) * kstep; const char* b2 = last ? nB : cB + (size_t)(t + 2) * kstep;
            const char* a3 = a2 + kstep; const char* b3 = b2 + kstep;
            if (last && has_next) S.a_ready(nxt);
            if constexpr (SP2) {
            PG8_LDB(B0, 0, 0); PG8_LDB(B1, 0, 1); PG8_SCHED; PG8_LDA(At, 0, 0); PG8_STAGE(PG8_SA(1, 1), a1 + hstep, voffA);
            PG8_WAIT_V(8); PG8_WAIT_L(0); PG8_BAR; PG8_MMA(0, 0, At, B0); PG8_MMA(0, 1, At, B1); PG8_BAR; PG8_SCHED;
            PG8_LDA(At, 0, 1); PG8_STAGE(PG8_SB(0, 0), b2, voffB); PG8_STAGE(PG8_SB(0, 1), b2 + hstep, voffB); PG8_STAGE(PG8_SA(0, 0), a2, voffA);
            PG8_WAIT_V(8); PG8_WAIT_L(0); PG8_BAR; PG8_MMA(1, 0, At, B0); PG8_MMA(1, 1, At, B1); PG8_BAR; PG8_SCHED;
            PG8_LDB(B0, 1, 0); PG8_LDB(B1, 1, 1); PG8_SCHED; PG8_LDA(At, 1, 0); PG8_STAGE(PG8_SA(0, 1), a2 + hstep, voffA);
            PG8_WAIT_V(8); PG8_WAIT_L(0); PG8_BAR; PG8_MMA(0, 0, At, B0); PG8_MMA(0, 1, At, B1); PG8_BAR; PG8_SCHED;
            PG8_LDA(At, 1, 1); PG8_STAGE(PG8_SB(1, 0), b3, voffB); PG8_STAGE(PG8_SB(1, 1), b3 + hstep, voffB); PG8_STAGE(PG8_SA(1, 0), a3, voffA);
            PG8_WAIT_V(8); PG8_WAIT_L(0); PG8_BAR; PG8_MMA(1, 0, At, B0); PG8_MMA(1, 1, At, B1); PG8_BAR; PG8_SCHED;
            } else {
            PG8_LDB(B0, 0, 0); PG8_SCHED; PG8_LDA(At, 0, 0); PG8_STAGE(PG8_SA(1, 1), a1 + hstep, voffA);
            PG8_WAIT_L(8); PG8_BAR; PG8_WAIT_L(0); PG8_MMA(0, 0, At, B0); PG8_BAR; PG8_SCHED;
            PG8_LDB(B1, 0, 1); PG8_STAGE(PG8_SB(0, 0), b2, voffB);
            PG8_BAR; PG8_WAIT_L(0); PG8_MMA(0, 1, At, B1); PG8_BAR;
            PG8_LDA(At, 0, 1); PG8_STAGE(PG8_SA(0, 0), a2, voffA);
            PG8_BAR; PG8_WAIT_L(0); PG8_MMA(1, 0, At, B0); PG8_BAR; PG8_SCHED;
            PG8_STAGE(PG8_SB(0, 1), b2 + hstep, voffB);
            PG8_WAIT_V(6); PG8_BAR; PG8_MMA(1, 1, At, B1); PG8_BAR;
            PG8_LDB(B0, 1, 0); PG8_SCHED; PG8_LDA(At, 1, 0); PG8_STAGE(PG8_SA(0, 1), a2 + hstep, voffA);
            PG8_WAIT_L(8); PG8_BAR; PG8_WAIT_L(0); PG8_MMA(0, 0, At, B0); PG8_BAR; PG8_SCHED;
            PG8_LDB(B1, 1, 1); PG8_STAGE(PG8_SB(1, 0), b3, voffB);
            PG8_BAR; PG8_WAIT_L(0); PG8_MMA(0, 1, At, B1); PG8_BAR;
            PG8_LDA(At, 1, 1); PG8_STAGE(PG8_SA(1, 0), a3, voffA);
            PG8_BAR; PG8_WAIT_L(0); PG8_MMA(1, 0, At, B0); PG8_BAR; PG8_SCHED;
            PG8_STAGE(PG8_SB(1, 1), b3 + hstep, voffB);
            PG8_WAIT_V(6); PG8_BAR; PG8_MMA(1, 1, At, B1); PG8_BAR;
            }
        }
        if constexpr (ALIGN_EPI) { if (wr == 0) PG8_BAR; }
        if constexpr (!Epi::AFTER_DRAIN) { E(acc, cur, wr, wc, fr, fq); S.done(cur); }
        if (!has_next) break;
#pragma unroll
        for (int a = 0; a < 2; ++a)
#pragma unroll
            for (int b = 0; b < 2; ++b)
#pragma unroll
                for (int m = 0; m < 4; ++m)
#pragma unroll
                    for (int n = 0; n < 2; ++n) acc[a][b][m][n] = (f32x4){0.f, 0.f, 0.f, 0.f};
        cur = nxt; cA = nA; cB = nB; ++ui;
        if constexpr (ALIGN_EPI) { if (wr == 1) PG8_BAR; }
    }
    PG8_WAIT_V(0);
    if constexpr (!ALIGN_EPI) { if (wr == 0) PG8_BAR; }
    PG8_BAR;
    if constexpr (Epi::AFTER_DRAIN) { E.fused(acc, cur, wr, wc, fr, fq, lds, wid, lane); S.done(cur); }
#undef PG8_SA
#undef PG8_SB
#undef PG8_STAGE
#undef PG8_LDA
#undef PG8_LDB
#undef PG8_MMA
#undef PG8_WAIT_V
#undef PG8_WAIT_L
#undef PG8_BAR
#undef PG8_SCHED
}
}

namespace pg8 {
struct EpiProj {
    static constexpr bool PERM = true, AFTER_DRAIN = false;
    bf16_t* H; const float* g; const float* gd;
    const float* rowss;
    __device__ __forceinline__ void operator()(const f32x4 (&acc)[2][2][4][2], const Unit& u, int wr, int wc, int fr, int fq) const {
        const int pn = u.pn;
        int mode = 0; const float* gain = nullptr;
        const float qs = (pn == 0 || pn == 3 || pn == 8) ? 0.125f * 1.4426950408889634f : (pn == 5 ? 0.17677669529663687f * 1.4426950408889634f : 1.f);
        if (pn == 0) { mode = 1; gain = g; } else if (pn == 1) { mode = 1; gain = g + 64; } else if (pn == 3) { mode = 1; gain = g + 128; }
        else if (pn == 4) { if (wc < 2) { mode = 1; gain = g + 192; } }
        else if (pn == 5) { mode = 2; gain = gd; } else if (pn == 6) { mode = 2; gain = gd + 32; }
        else if (pn == 8) { mode = 1; gain = g + 256; }
        else if (pn == 9) { if (wc == 2) { mode = 1; gain = g + 384; } }
        else if (pn == 10) { if (wc == 0) { mode = 1; gain = g + 448; } else if (wc == 2) mode = 4; }
        else if (pn >= 11) mode = 3;
        f32x4 gv[2][2];
#pragma unroll
        for (int bj = 0; bj < 2; ++bj)
#pragma unroll
            for (int n = 0; n < 2; ++n) gv[bj][n] = (f32x4){1.f, 1.f, 1.f, 1.f};
        if (mode == 1) {
#pragma unroll
            for (int bj = 0; bj < 2; ++bj)
#pragma unroll
                for (int n = 0; n < 2; ++n) gv[bj][n] = *(const f32x4*)(gain + 32 * bj + 8 * fq + 4 * n);
        } else if (mode == 2) {
#pragma unroll
            for (int bj = 0; bj < 2; ++bj)
#pragma unroll
                for (int n = 0; n < 2; ++n) gv[bj][n] = *(const f32x4*)(gain + 8 * fq + 4 * n);
        }
        const int col0 = pn * BM + 64 * wc + 8 * fq;
#pragma unroll
        for (int ai = 0; ai < 2; ++ai)
#pragma unroll
            for (int m = 0; m < 4; ++m) {
                const int row = u.pm * BM + ai * HALF + wr * 64 + m * 16 + fr;
                f32x4 v[2][2];
                const float rsc = rowss ? rsqrtf((float)((const unsigned long long*)rowss)[row] * (1.f / (1048576.f * 1024.f)) + 1e-6f) : 1.f;
#pragma unroll
                for (int bj = 0; bj < 2; ++bj)
#pragma unroll
                    for (int n = 0; n < 2; ++n) v[bj][n] = acc[ai][bj][m][n] * rsc;
                if (mode == 1 || mode == 2) {
                    float s0 = 0.f, s1 = 0.f;
#pragma unroll
                    for (int n = 0; n < 2; ++n) {
                        s0 += v[0][n][0] * v[0][n][0] + v[0][n][1] * v[0][n][1] + v[0][n][2] * v[0][n][2] + v[0][n][3] * v[0][n][3];
                        s1 += v[1][n][0] * v[1][n][0] + v[1][n][1] * v[1][n][1] + v[1][n][2] * v[1][n][2] + v[1][n][3] * v[1][n][3];
                    }
                    s0 += __shfl_xor(s0, 16); s0 += __shfl_xor(s0, 32);
                    s1 += __shfl_xor(s1, 16); s1 += __shfl_xor(s1, 32);
                    float r0, r1;
                    if (mode == 1) { r0 = r1 = rsqrtf((s0 + s1) * (1.f / 64.f) + 1e-6f) * qs; }
                    else { r0 = rsqrtf(s0 * (1.f / 32.f) + 1e-6f) * qs; r1 = rsqrtf(s1 * (1.f / 32.f) + 1e-6f) * qs; }
#pragma unroll
                    for (int n = 0; n < 2; ++n) { v[0][n] = v[0][n] * r0 * gv[0][n]; v[1][n] = v[1][n] * r1 * gv[1][n]; }
                } else if (mode == 3) {
#pragma unroll
                    for (int bj = 0; bj < 2; ++bj)
#pragma unroll
                        for (int n = 0; n < 2; ++n)
#pragma unroll
                            for (int e = 0; e < 4; ++e) { const float x = v[bj][n][e]; v[bj][n][e] = x * __builtin_amdgcn_rcpf(1.f + __expf(-x)); }
                } else if (mode == 4) {
#pragma unroll
                    for (int bj = 0; bj < 2; ++bj)
#pragma unroll
                        for (int n = 0; n < 2; ++n)
#pragma unroll
                            for (int e = 0; e < 4; ++e) { const float x = v[bj][n][e]; v[bj][n][e] = __builtin_amdgcn_rcpf(1.f + __expf(-x)); }
                }
                bf16_t* rowp = H + (size_t)row * 3840 + col0;
#pragma unroll
                for (int bj = 0; bj < 2; ++bj) {
                    u32x4 w; w.x = cvt_pk_bf16(v[bj][0][0], v[bj][0][1]); w.y = cvt_pk_bf16(v[bj][0][2], v[bj][0][3]);
                    w.z = cvt_pk_bf16(v[bj][1][0], v[bj][1][1]); w.w = cvt_pk_bf16(v[bj][1][2], v[bj][1][3]);
                    *(u32x4*)(rowp + 32 * bj) = w;
                }
            }
    }
};
struct EpiOut {
    static constexpr bool PERM = false, AFTER_DRAIN = false;
    const float* xprev; float* out;
    PG8_LAS float* exch;
    bf16_t* xn; const float* gnext; float* rowss;
    __device__ __forceinline__ void operator()(const f32x4 (&acc)[2][2][4][2], const Unit& u, int wr, int wc, int fr, int fq) const {
        const int col0 = u.pn * BM + wc * 32 + 4 * fq;
        f32x4 gn[2][2];
#pragma unroll
        for (int bj = 0; bj < 2; ++bj)
#pragma unroll
            for (int n = 0; n < 2; ++n) gn[bj][n] = xn ? *(const f32x4*)(gnext + col0 + bj * HALF + n * 16) : (f32x4){0.f, 0.f, 0.f, 0.f};
#pragma unroll
        for (int ai = 0; ai < 2; ++ai)
#pragma unroll
            for (int m = 0; m < 4; ++m) {
                const int row = u.pm * BM + ai * HALF + wr * 64 + m * 16 + fr;
                const size_t off = (size_t)row * 1024 + col0;
                float ss = 0.f;
#pragma unroll
                for (int bj = 0; bj < 2; ++bj)
#pragma unroll
                    for (int n = 0; n < 2; ++n) {
                        const f32x4 b = *(const f32x4*)(xprev + off + bj * HALF + n * 16);
                        const f32x4 v = b + acc[ai][bj][m][n];
                        *(f32x4*)(out + off + bj * HALF + n * 16) = v;
                        if (xn) {
                            ss += (v[0] * v[0] + v[1] * v[1]) + (v[2] * v[2] + v[3] * v[3]);
                            const f32x4 w = v * gn[bj][n];
                            uint2 o; o.x = cvt_pk_bf16(w[0], w[1]); o.y = cvt_pk_bf16(w[2], w[3]);
                            *(uint2*)(xn + off + bj * HALF + n * 16) = o;
                        }
                    }
                if (xn) {
                    ss += __shfl_xor(ss, 16); ss += __shfl_xor(ss, 32);
                    if (fq == 0) exch[(ai * HALF + wr * 64 + m * 16 + fr) * 4 + wc] = ss;
                }
            }
        if (xn) {
            asm volatile("s_waitcnt lgkmcnt(0)" ::: "memory"); __builtin_amdgcn_s_barrier(); asm volatile("" ::: "memory");
            if (wc == 0) {
                const int lane = fq * 16 + fr;
#pragma unroll
                for (int k = 0; k < 2; ++k) {
                    const int rl = k * HALF + wr * 64 + lane;
                    const f32x4 p = *(const PG8_LAS f32x4*)(exch + rl * 4);
                    const float tot = (p[0] + p[1]) + (p[2] + p[3]);
                    atomicAdd((unsigned long long*)rowss + (u.pm * BM + rl), (unsigned long long)(tot * 1048576.f + 0.5f));
                }
            }
        }
    }
};
}

template <int MODE>
__device__ __forceinline__ void p0_transpose_item(const float* __restrict__ W, bf16_t* __restrict__ WT, LAS float* scr, int item, int lane, int KR = 1024, int NC = 1024) {
    const int NSRC = MODE == 0 ? 3724 : NC, NG = MODE == 0 ? 120 : NC / 32;
    const int kb = item / NG, nb = item % NG, k0 = 64 * kb, hc0 = 32 * nb;
    const int hc = hc0 + (lane & 31);
    int src = hc;
    if (MODE == 0) src = hc < 2700 ? hc : (hc < 2816 ? -1 : hc - 116);
#pragma unroll 8
    for (int i = 0; i < 32; ++i) { const int kk = 2 * i + (lane >> 5); scr[kk * 33 + (lane & 31)] = src >= 0 ? W[(size_t)(k0 + kk) * NSRC + src] : 0.f; }
    asm volatile("s_waitcnt lgkmcnt(0)" ::: "memory");
    const int c = lane & 7;
#pragma unroll
    for (int j = 0; j < 4; ++j) {
        const int n = (lane >> 3) + 8 * j; const LAS float* s = scr + (8 * c) * 33 + n;
        const int hcn = hc0 + n;
        int drow = hcn;
        if (MODE == 0) drow = (hcn & ~255) + ((hcn >> 5) & 1) * 128 + ((hcn >> 6) & 3) * 32 + (hcn & 31);
        uint4 o; o.x = (unsigned)f2bf(s[0]) | ((unsigned)f2bf(s[33]) << 16); o.y = (unsigned)f2bf(s[66]) | ((unsigned)f2bf(s[99]) << 16);
        o.z = (unsigned)f2bf(s[132]) | ((unsigned)f2bf(s[165]) << 16); o.w = (unsigned)f2bf(s[198]) | ((unsigned)f2bf(s[231]) << 16);
        if (MODE == 2) { const int k = k0 + 8 * c; *(uint4*)(WT + ((size_t)((((drow >> 5) * 8 + (k >> 8)) * 16 + ((k >> 4) & 15)) * 64 + ((k >> 3) & 1) * 32 + (drow & 31))) * 8) = o; }
        else *(uint4*)(WT + (size_t)drow * KR + k0 + 8 * c) = o;
    }
    asm volatile("s_waitcnt lgkmcnt(0)" ::: "memory");
}

namespace att {
typedef short bf16x8 __attribute__((ext_vector_type(8)));
typedef short v4i16 __attribute__((ext_vector_type(4)));
typedef float f32x16 __attribute__((ext_vector_type(16)));
typedef float f32x2_t __attribute__((ext_vector_type(2)));
typedef __bf16 bf16x2_t __attribute__((ext_vector_type(2)));
typedef unsigned u32x4 __attribute__((ext_vector_type(4)));
typedef float f32x4 __attribute__((ext_vector_type(4)));
__device__ __forceinline__ unsigned cvtpk(float lo, float hi) { f32x2_t v = {lo, hi}; bf16x2_t b = __builtin_convertvector(v, bf16x2_t); return __builtin_bit_cast(unsigned, b); }
__device__ __forceinline__ int crow(int r, int h) { return (r & 3) + 8 * (r >> 2) + 4 * h; }
constexpr float LOG2E = 1.4426950408889634f;
constexpr int L_KV = 0, KVB = 16384  , L_TAB = 32768  , L_WSCR = 83968  , L_IMP = 92160  , L_Q = 124928, L_SEL = 125184  , L_SB = 126464  ;

struct StageRegs { u32x4 k, v; };
__device__ __forceinline__ void stage_load(StageRegs& sr, const bf16_t* kp, const bf16_t* vp, bool valid, int ch) {
    sr.k = (u32x4){0u, 0u, 0u, 0u}; sr.v = sr.k;
    if (valid) { sr.k = *(const u32x4*)(kp + ch * 8); sr.v = *(const u32x4*)(vp + ch * 8); }
}
__device__ __forceinline__ void stage_write(LAS unsigned char* buf, const StageRegs& sr, int row, int ch) {
    *(LAS u32x4*)(buf + row * 128 + ((ch ^ (row & 7)) << 4)) = sr.k;
    *(LAS u32x4*)(buf + 8192 + (ch >> 2) * 4096 + row * 64 + (ch & 3) * 16) = sr.v;
}
__device__ __forceinline__ f32x16 load_tab16(const LAS float* tbl, int TSP, int jb) {
    const int sh = jb & 3; const LAS float* tp = tbl + sh * TSP + (jb - sh);
    const f32x4 t0 = *(const LAS f32x4*)(tp), t1 = *(const LAS f32x4*)(tp + 8), t2 = *(const LAS f32x4*)(tp + 16), t3 = *(const LAS f32x4*)(tp + 24);
    return (f32x16){t0[0], t0[1], t0[2], t0[3], t1[0], t1[1], t1[2], t1[3], t2[0], t2[1], t2[2], t2[3], t3[0], t3[1], t3[2], t3[3]};
}
__device__ __forceinline__ float exp_sum16(f32x16& acc) {
    float sa = 0.f, sb = 0.f;
#pragma unroll
    for (int r = 0; r < 16; r += 2) {
        acc[r] = __builtin_amdgcn_exp2f(acc[r]); acc[r + 1] = __builtin_amdgcn_exp2f(acc[r + 1]);
        sa += acc[r]; asm volatile("" : "+v"(sa)); sb += acc[r + 1]; asm volatile("" : "+v"(sb));
    }
    return sa + sb;
}
__device__ __forceinline__ f32x16 splat16(float v) { return (f32x16){v, v, v, v, v, v, v, v, v, v, v, v, v, v, v, v}; }
template <int S0, int S1>
__device__ __forceinline__ void qk_sub(f32x16& acc, const LAS unsigned char* buf, int sub, const bf16x8* qf, int lane) {
    const int key = 32 * sub + (lane & 31), h = lane >> 5;
    bf16x8 kf[S1 - S0];
#pragma unroll
    for (int s = S0; s < S1; ++s) kf[s - S0] = *(const LAS bf16x8*)(buf + key * 128 + (((2 * s + h) ^ (key & 7)) << 4));
    __builtin_amdgcn_sched_barrier(0);
#pragma unroll
    for (int s = S0; s < S1; ++s) acc = __builtin_amdgcn_mfma_f32_32x32x16_bf16(kf[s - S0], qf[s], acc, 0, 0, 0);
}
__device__ __forceinline__ void pack_p(const f32x16& p, bf16x8& pa0, bf16x8& pa1) {
    u32x4 w0, w1;
    w0.x = cvtpk(p[0], p[1]); w0.y = cvtpk(p[2], p[3]); w0.z = cvtpk(p[4], p[5]); w0.w = cvtpk(p[6], p[7]);
    w1.x = cvtpk(p[8], p[9]); w1.y = cvtpk(p[10], p[11]); w1.z = cvtpk(p[12], p[13]); w1.w = cvtpk(p[14], p[15]);
    pa0 = __builtin_bit_cast(bf16x8, w0); pa1 = __builtin_bit_cast(bf16x8, w1);
}
__device__ __forceinline__ void pv_sub(f32x16* o, const LAS unsigned char* buf, int sub, const bf16x8& pa0, const bf16x8& pa1, int lane) {
    const int h = lane >> 5, g16 = (lane >> 4) & 1, q4 = (lane & 15) >> 2, p4 = lane & 3;
    const LAS unsigned char* vb = buf + 8192 + (32 * sub + 4 * h + q4) * 64 + (16 * g16 + 4 * p4) * 2;
    bf16x8 vf[2][2];
#pragma unroll
    for (int dt = 0; dt < 2; ++dt) {
#pragma unroll
        for (int s2 = 0; s2 < 2; ++s2) {
            const v4i16 lo = __builtin_amdgcn_ds_read_tr16_b64_v4i16((LAS v4i16*)(vb + dt * 4096 + s2 * 1024));
            const v4i16 hi = __builtin_amdgcn_ds_read_tr16_b64_v4i16((LAS v4i16*)(vb + dt * 4096 + s2 * 1024 + 512));
            vf[dt][s2] = (bf16x8){lo[0], lo[1], lo[2], lo[3], hi[0], hi[1], hi[2], hi[3]};
        }
    }
    __builtin_amdgcn_sched_barrier(0);
    o[0] = __builtin_amdgcn_mfma_f32_32x32x16_bf16(pa0, vf[0][0], o[0], 0, 0, 0);
    o[1] = __builtin_amdgcn_mfma_f32_32x32x16_bf16(pa0, vf[1][0], o[1], 0, 0, 0);
    o[0] = __builtin_amdgcn_mfma_f32_32x32x16_bf16(pa1, vf[0][1], o[0], 0, 0, 0);
    o[1] = __builtin_amdgcn_mfma_f32_32x32x16_bf16(pa1, vf[1][1], o[1], 0, 0, 0);
}

__device__ __forceinline__ void pv_sub2(f32x16* oa, f32x16* ob, const LAS unsigned char* buf, int sub, const bf16x8& a0, const bf16x8& a1, const bf16x8& b0, const bf16x8& b1, int lane) {
    const int h = lane >> 5, g16 = (lane >> 4) & 1, q4 = (lane & 15) >> 2, p4 = lane & 3;
    const LAS unsigned char* vb = buf + 8192 + (32 * sub + 4 * h + q4) * 64 + (16 * g16 + 4 * p4) * 2;
#pragma unroll
    for (int dt = 0; dt < 2; ++dt) {
#pragma unroll
        for (int s2 = 0; s2 < 2; ++s2) {
            const v4i16 lo = __builtin_amdgcn_ds_read_tr16_b64_v4i16((LAS v4i16*)(vb + dt * 4096 + s2 * 1024));
            const v4i16 hi = __builtin_amdgcn_ds_read_tr16_b64_v4i16((LAS v4i16*)(vb + dt * 4096 + s2 * 1024 + 512));
            const bf16x8 vf = (bf16x8){lo[0], lo[1], lo[2], lo[3], hi[0], hi[1], hi[2], hi[3]};
            oa[dt] = __builtin_amdgcn_mfma_f32_32x32x16_bf16(s2 == 0 ? a0 : a1, vf, oa[dt], 0, 0, 0);
            ob[dt] = __builtin_amdgcn_mfma_f32_32x32x16_bf16(s2 == 0 ? b0 : b1, vf, ob[dt], 0, 0, 0);
        }
    }
}

struct BandArgs {
    const bf16_t* Hb;
    int cq, ck, cv;
    int rate, cls, f0, maxd;
    const float* bias;
    float M;
    float sinkterm;
    bf16_t* OA; float* DA;
    bf16_t* Y; int ycol;
    int hd; size_t brow;
};
constexpr int B_TAB = 98304, B_WSCR = 106496;
template <int MODE>
__device__ __forceinline__ void banded_unit(LAS unsigned char* lds, const BandArgs& P) {
    const int tid = opq(threadIdx.x), lane = tid & 63, w = __builtin_amdgcn_readfirstlane(tid >> 6), h = lane >> 5;
    LAS float* sb = (LAS float*)(lds + L_SB);
    LAS float* tbl = (LAS float*)(lds + B_TAB);
    const int KPREV = ((P.maxd + 63) >> 6) << 6;
    const int t0 = (KPREV - P.f0) > 0 ? ((KPREV - P.f0) >> 6) : 0;
    const int srow = tid >> 3, sch = tid & 7;
    StageRegs sr[6];
#pragma unroll
    for (int i = 0; i < 6; ++i) {
        int kf = P.f0 - KPREV + 64 * i + srow; kf = kf < 0 ? 0 : kf;
        const bf16_t* rp = P.Hb + ((size_t)kf * P.rate + P.cls) * HP;
        stage_load(sr[i], rp + P.ck, rp + P.cv, true, sch);
    }
    const int fq0 = P.f0 + 32 * w;
    bf16x8 qf[4];
    {
        const size_t tq = (size_t)(fq0 + (lane & 31)) * P.rate + P.cls;
        const bf16_t* qp = P.Hb + tq * HP + P.cq + 8 * h;
#pragma unroll
        for (int s = 0; s < 4; ++s) qf[s] = *(const bf16x8*)(qp + 16 * s);
    }
    if (tid < 32) sb[tid] = (P.bias[tid * 16] - P.M) * LOG2E;
    __syncthreads();
    const int DMAXI = P.maxd + 62, TS = P.maxd + 125, TSP = (TS + 7) & ~3;
    for (int e = tid; e < 4 * TSP; e += 512) {
        const int sh = e / TSP, j = e - sh * TSP + sh, dist = DMAXI - j;
        tbl[e] = (j < TS && dist >= 0 && dist <= P.maxd) ? sb[t5_bucket(dist * P.rate)] : -1e30f;
    }
    f32x16 o[2]; o[0] = (f32x16){}; o[1] = (f32x16){};
    float den = 0.f;
#pragma unroll
    for (int i = 0; i < 6; ++i) stage_write(lds + i * KVB, sr[i], srow, sch);
    asm volatile("" : "+v"(qf[0]), "+v"(qf[1]), "+v"(qf[2]), "+v"(qf[3]));
    __syncthreads();
#pragma unroll 1
    for (int t = t0; t < 6; ++t) {
        const LAS unsigned char* buf = lds + t * KVB;
        const int kf0 = P.f0 - KPREV + 64 * t;
#pragma unroll
        for (int sub = 0; sub < 2; ++sub) {
            const int kfs = kf0 + 32 * sub;
            if (kfs <= fq0 + 31 && kfs + 31 >= fq0 - P.maxd) {
                const int jb = DMAXI - ((fq0 - kfs) + (lane & 31) - 4 * h);
                f32x16 acc = load_tab16(tbl, TSP, jb);
                qk_sub<0, 4>(acc, buf, sub, qf, lane);
                den += exp_sum16(acc);
                bf16x8 pa0, pa1; pack_p(acc, pa0, pa1);
                pv_sub(o, buf, sub, pa0, pa1, lane);
            }
        }
    }
    float dtot = den + __shfl_xor(den, 32);
    if (MODE == 1) dtot += P.sinkterm;
    LAS float* ws_ = (LAS float*)(lds + B_WSCR) + w * 64;
    if (h == 0) ws_[lane] = dtot;
    if (MODE == 0 && h == 0) {
        const size_t tq = (size_t)(fq0 + lane) * P.rate + P.cls;
        P.DA[(P.brow + tq) * 4 + P.hd] = dtot;
    }
    asm volatile("s_waitcnt lgkmcnt(0)" ::: "memory");
#pragma unroll
    for (int r = 0; r < 16; ++r) {
        const int qi = crow(r, h);
        const float inv = __builtin_amdgcn_rcpf(ws_[qi]);
        const size_t row = P.brow + (size_t)(fq0 + qi) * P.rate + P.cls;
#pragma unroll
        for (int dt = 0; dt < 2; ++dt) {
            const int d = 32 * dt + (lane & 31);
            const float val = o[dt][r] * inv;
            if (MODE == 0) P.OA[row * 256 + P.hd * 64 + d] = f2bf(val);
            else P.Y[row * DM + P.ycol + d] = f2bf(val * bf2f(P.Hb[(row - P.brow) * HP + C_SILU + P.ycol + d]));
        }
    }
}

__device__ __forceinline__ void diff_p1(const LAS float* tp, const LAS unsigned char* buf, int sub, const bf16x8* qf, int lane, bf16x8& pa0, bf16x8& pa1, bf16x8& pb0, bf16x8& pb1) {
    const f32x4 t0 = *(const LAS f32x4*)(tp), t1 = *(const LAS f32x4*)(tp + 8), t2 = *(const LAS f32x4*)(tp + 16), t3 = *(const LAS f32x4*)(tp + 24);
    const f32x16 T = (f32x16){t0[0], t0[1], t0[2], t0[3], t1[0], t1[1], t1[2], t1[3], t2[0], t2[1], t2[2], t2[3], t3[0], t3[1], t3[2], t3[3]};
    const int key = 32 * sub + (lane & 31), h = lane >> 5;
    const LAS unsigned char* kp = buf + key * 128;
    const bf16x8 k0 = *(const LAS bf16x8*)(kp + (((0 + h) ^ (key & 7)) << 4)), k1 = *(const LAS bf16x8*)(kp + (((2 + h) ^ (key & 7)) << 4));
    const bf16x8 k2 = *(const LAS bf16x8*)(kp + (((4 + h) ^ (key & 7)) << 4)), k3 = *(const LAS bf16x8*)(kp + (((6 + h) ^ (key & 7)) << 4));
    f32x16 a1 = __builtin_amdgcn_mfma_f32_32x32x16_bf16(k0, qf[0], T, 0, 0, 0);
    f32x16 a2 = __builtin_amdgcn_mfma_f32_32x32x16_bf16(k2, qf[2], T, 0, 0, 0);
    a1 = __builtin_amdgcn_mfma_f32_32x32x16_bf16(k1, qf[1], a1, 0, 0, 0);
    a2 = __builtin_amdgcn_mfma_f32_32x32x16_bf16(k3, qf[3], a2, 0, 0, 0);
#pragma unroll
    for (int r = 0; r < 16; ++r) { a1[r] = __builtin_amdgcn_exp2f(a1[r]); a2[r] = __builtin_amdgcn_exp2f(a2[r]); }
    pack_p(a1, pa0, pa1); pack_p(a2, pb0, pb1);
}
__device__ __forceinline__ void diff_p2(const LAS unsigned char* buf, int sub, int lane, const bf16x8& pa0, const bf16x8& pa1, const bf16x8& pb0, const bf16x8& pb1, f32x16& dn1, f32x16& dn2, f32x16* o1, f32x16* o2) {
    const bf16x8 ones = (bf16x8){0x3F80, 0x3F80, 0x3F80, 0x3F80, 0x3F80, 0x3F80, 0x3F80, 0x3F80};
    const int h = lane >> 5, g16 = (lane >> 4) & 1, q4 = (lane & 15) >> 2, p4 = lane & 3;
    const LAS unsigned char* vb = buf + 8192 + (32 * sub + 4 * h + q4) * 64 + (16 * g16 + 4 * p4) * 2;
    bf16x8 vf[2][2];
#pragma unroll
    for (int dt = 0; dt < 2; ++dt) {
#pragma unroll
        for (int s2 = 0; s2 < 2; ++s2) {
            const v4i16 lo = __builtin_amdgcn_ds_read_tr16_b64_v4i16((LAS v4i16*)(vb + dt * 4096 + s2 * 1024));
            const v4i16 hi = __builtin_amdgcn_ds_read_tr16_b64_v4i16((LAS v4i16*)(vb + dt * 4096 + s2 * 1024 + 512));
            vf[dt][s2] = (bf16x8){lo[0], lo[1], lo[2], lo[3], hi[0], hi[1], hi[2], hi[3]};
        }
    }
    __builtin_amdgcn_sched_barrier(0);
    dn1 = __builtin_amdgcn_mfma_f32_32x32x16_bf16(pa0, ones, dn1, 0, 0, 0);
    dn2 = __builtin_amdgcn_mfma_f32_32x32x16_bf16(pb0, ones, dn2, 0, 0, 0);
    dn1 = __builtin_amdgcn_mfma_f32_32x32x16_bf16(pa1, ones, dn1, 0, 0, 0);
    dn2 = __builtin_amdgcn_mfma_f32_32x32x16_bf16(pb1, ones, dn2, 0, 0, 0);
    o1[0] = __builtin_amdgcn_mfma_f32_32x32x16_bf16(pa0, vf[0][0], o1[0], 0, 0, 0);
    o2[0] = __builtin_amdgcn_mfma_f32_32x32x16_bf16(pb0, vf[0][0], o2[0], 0, 0, 0);
    o1[1] = __builtin_amdgcn_mfma_f32_32x32x16_bf16(pa0, vf[1][0], o1[1], 0, 0, 0);
    o2[1] = __builtin_amdgcn_mfma_f32_32x32x16_bf16(pb0, vf[1][0], o2[1], 0, 0, 0);
    o1[0] = __builtin_amdgcn_mfma_f32_32x32x16_bf16(pa1, vf[0][1], o1[0], 0, 0, 0);
    o2[0] = __builtin_amdgcn_mfma_f32_32x32x16_bf16(pb1, vf[0][1], o2[0], 0, 0, 0);
    o1[1] = __builtin_amdgcn_mfma_f32_32x32x16_bf16(pa1, vf[1][1], o1[1], 0, 0, 0);
    o2[1] = __builtin_amdgcn_mfma_f32_32x32x16_bf16(pb1, vf[1][1], o2[1], 0, 0, 0);
}

struct DiffArgs {
    const bf16_t* Hb; int hd, qb; size_t brow;
    const float* bias; float M; float lam, lambda_init; const float* subln;
    bf16_t* Y;
};
constexpr int D_SB = 49152, D_TAB = 49664;
__device__ __forceinline__ void diff_unit(LAS unsigned char* lds, const DiffArgs& P) {
    const int tid = opq(threadIdx.x), lane = tid & 63, w = __builtin_amdgcn_readfirstlane(tid >> 6), h = lane >> 5;
    LAS float* sb = (LAS float*)(lds + D_SB);
    LAS float* tbl = (LAS float*)(lds + D_TAB);
    constexpr int DTOP = 1574, TS = DTOP + 63, TSP = (TS + 7) & ~3;
    __syncthreads();
    if (tid < 32) sb[tid] = (P.bias[tid * 16] - P.M) * LOG2E;
    __syncthreads();
    for (int e = tid; e < 4 * TSP; e += 512) {
        const int sh = e / TSP, j = e - sh * TSP + sh, dist = DTOP - j;
        tbl[e] = (j < TS && dist >= 0) ? sb[t5_bucket(dist)] : -1e30f;
    }
    LAS float* farc = tbl + 4 * TSP;
    LAS float* deadr = farc + 32;
    if (tid < 32) { farc[tid] = sb[31]; deadr[tid] = -1e30f; }
    const int q0w = P.qb * 256 + 32 * w;
    const int cq = C_CQ + 64 * P.hd, ck = C_CK + 64 * P.hd, cv = C_CV + 64 * P.hd;
    bf16x8 qf[4];
    {
        const bf16_t* qp = P.Hb + (size_t)(q0w + (lane & 31)) * HP + cq + 8 * h;
#pragma unroll
        for (int s = 0; s < 4; ++s) qf[s] = *(const bf16x8*)(qp + 16 * s);
        asm volatile("" : "+v"(qf[0]), "+v"(qf[1]), "+v"(qf[2]), "+v"(qf[3]));
    }
    const int ntl = 4 * (P.qb + 1);
    const int srow = tid >> 3, sch = tid & 7;
    f32x16 o1[2], o2[2]; o1[0] = (f32x16){}; o1[1] = (f32x16){}; o2[0] = (f32x16){}; o2[1] = (f32x16){};
    f32x16 dn1 = (f32x16){}, dn2 = (f32x16){};
    StageRegs sr;
    {
        const bf16_t* rp = P.Hb + (size_t)srow * HP;
        stage_load(sr, rp + ck, rp + cv, true, sch);
        stage_write(lds, sr, srow, sch);
    }
    __syncthreads();
#define DIFF_TP(KS) ({ const int ks_ = (KS); const int jb_ = DTOP - ((q0w - ks_) + (lane & 31) - 4 * h), sh_ = jb_ & 3; \
        const LAS float* tp_ = tbl + sh_ * TSP + (jb_ - sh_); tp_ = (q0w - ks_ - 31 >= 1513) ? farc : tp_; tp_ = (ks_ > q0w + 31) ? deadr : tp_; tp_; })
#define DIFF_STAGE_LOAD(t) do { const int tn_ = (t) + 1 < ntl ? (t) + 1 : (t); const bf16_t* rp_ = P.Hb + (size_t)(64 * tn_ + srow) * HP; stage_load(sr, rp_ + ck, rp_ + cv, true, sch); } while (0)
    if (w < 4) {
        int cur = 0;
        for (int t = 0; t < ntl; ++t) {
            LAS unsigned char* buf = lds + cur * KVB;
            const int nxt = cur == 2 ? 0 : cur + 1;
            DIFF_STAGE_LOAD(t);
            bf16x8 pa0, pa1, pb0, pb1;
            diff_p1(DIFF_TP(64 * t), buf, 0, qf, lane, pa0, pa1, pb0, pb1);
            diff_p2(buf, 0, lane, pa0, pa1, pb0, pb1, dn1, dn2, o1, o2);
            diff_p1(DIFF_TP(64 * t + 32), buf, 1, qf, lane, pa0, pa1, pb0, pb1);
            diff_p2(buf, 1, lane, pa0, pa1, pb0, pb1, dn1, dn2, o1, o2);
            stage_write(lds + nxt * KVB, sr, srow, sch);
            __syncthreads();
            cur = nxt;
        }
    } else {
        const bf16x8 zero8 = (bf16x8){0, 0, 0, 0, 0, 0, 0, 0};
        bf16x8 qa0 = zero8, qa1 = zero8, qb0 = zero8, qb1 = zero8;
        int cur = 0, prv = 0;
        __builtin_amdgcn_s_setprio(1);
        for (int t = 0; t < ntl; ++t) {
            LAS unsigned char* buf = lds + cur * KVB;
            const int nxt = cur == 2 ? 0 : cur + 1;
            DIFF_STAGE_LOAD(t);
            diff_p2(lds + prv * KVB, 1, lane, qa0, qa1, qb0, qb1, dn1, dn2, o1, o2);
            bf16x8 pa0, pa1, pb0, pb1;
            diff_p1(DIFF_TP(64 * t), buf, 0, qf, lane, pa0, pa1, pb0, pb1);
            diff_p2(buf, 0, lane, pa0, pa1, pb0, pb1, dn1, dn2, o1, o2);
            diff_p1(DIFF_TP(64 * t + 32), buf, 1, qf, lane, qa0, qa1, qb0, qb1);
            stage_write(lds + nxt * KVB, sr, srow, sch);
            __syncthreads();
            prv = cur; cur = nxt;
        }
        diff_p2(lds + prv * KVB, 1, lane, qa0, qa1, qb0, qb1, dn1, dn2, o1, o2);
        __builtin_amdgcn_s_setprio(0);
    }
    __syncthreads();
#undef DIFF_TP
#undef DIFF_STAGE_LOAD
    const float g0 = P.subln[lane & 31] * (1.f - P.lambda_init), g1 = P.subln[32 + (lane & 31)] * (1.f - P.lambda_init);
    const int ycol = 512 + 64 * P.hd;
#pragma unroll
    for (int r = 0; r < 16; ++r) {
        const int qi = crow(r, h);
        const float i1 = __builtin_amdgcn_rcpf(dn1[r]), i2 = P.lam * __builtin_amdgcn_rcpf(dn2[r]);
        const float a0 = o1[0][r] * i1 - o2[0][r] * i2, a1 = o1[1][r] * i1 - o2[1][r] * i2;
        float ss = a0 * a0 + a1 * a1;
        ss += __shfl_xor(ss, 1); ss += __shfl_xor(ss, 2); ss += __shfl_xor(ss, 4); ss += __shfl_xor(ss, 8); ss += __shfl_xor(ss, 16);
        const float rs = rsqrtf(ss * (1.f / 64.f) + 1e-6f);
        const size_t trow = (size_t)(q0w + qi);
        const bf16_t* sp = P.Hb + trow * HP + C_SILU + ycol;
        bf16_t* yp = P.Y + (P.brow + trow) * DM + ycol;
        yp[lane & 31] = f2bf(a0 * rs * g0 * bf2f(sp[lane & 31]));
        yp[32 + (lane & 31)] = f2bf(a1 * rs * g1 * bf2f(sp[32 + (lane & 31)]));
    }
}
struct CmpArgs {
    const bf16_t* Hb;
    int col;
    int rt;
    const float* pos;
    const bf16_t* W1T;
    const float* b1;
    const bf16_t* W2T;
    const float* b2;
    const float* gain;
    bf16_t* OUT;
};
__device__ __forceinline__ void cmp_unit(LAS unsigned char* lds, const CmpArgs& P) {
    const int tid = opq(threadIdx.x), lane = tid & 63, w = __builtin_amdgcn_readfirstlane(tid >> 6), h = lane >> 5;
    LAS unsigned char* hidl = lds + L_KV;
    LAS float* ssx = (LAS float*)(lds + L_KV + 32768 - 512);
    LAS unsigned char* abuf = lds + L_TAB;
    f32x16 acc = (f32x16){};
    const bf16_t* w1p = P.W1T + (size_t)w * (8 * 16 * 64 * 8) + lane * 8;
    u32x4 araw[2]; f32x4 apos[2][2];
#define CMP_ALOAD(ch) do { _Pragma("unroll") for (int q_ = 0; q_ < 2; ++q_) { const int p_ = tid + 512 * q_, row_ = p_ >> 5, kc_ = p_ & 31; \
        int ir_ = 32 * P.rt + row_; if (ir_ > 510) ir_ = 510; const int tok_ = 4 * (ch) + (kc_ >> 3), d_ = 8 * (kc_ & 7); \
        araw[q_] = *(const u32x4*)(P.Hb + (size_t)(16 * ir_ + tok_) * HP + P.col + d_); \
        apos[q_][0] = *(const f32x4*)(P.pos + tok_ * 64 + d_); apos[q_][1] = *(const f32x4*)(P.pos + tok_ * 64 + d_ + 4); } } while (0)
#define CMP_AWRITE(bufi) do { _Pragma("unroll") for (int q_ = 0; q_ < 2; ++q_) { const int p_ = tid + 512 * q_, row_ = p_ >> 5, kc_ = p_ & 31; u32x4 aw_; \
        aw_.x = cvtpk(__uint_as_float(araw[q_].x << 16) + apos[q_][0][0], __uint_as_float(araw[q_].x & 0xffff0000u) + apos[q_][0][1]); \
        aw_.y = cvtpk(__uint_as_float(araw[q_].y << 16) + apos[q_][0][2], __uint_as_float(araw[q_].y & 0xffff0000u) + apos[q_][0][3]); \
        aw_.z = cvtpk(__uint_as_float(araw[q_].z << 16) + apos[q_][1][0], __uint_as_float(araw[q_].z & 0xffff0000u) + apos[q_][1][1]); \
        aw_.w = cvtpk(__uint_as_float(araw[q_].w << 16) + apos[q_][1][2], __uint_as_float(araw[q_].w & 0xffff0000u) + apos[q_][1][3]); \
        *(LAS u32x4*)(abuf + (bufi) * 16896 + row_ * 528 + kc_ * 16) = aw_; } } while (0)
    CMP_ALOAD(0); CMP_AWRITE(0);
    __syncthreads();
    for (int ch = 0; ch < 8; ++ch) {
        const int cn = ch + 1 < 8 ? ch + 1 : ch;
        CMP_ALOAD(cn);
        const LAS unsigned char* ab = abuf + (ch & 1) * 16896 + (lane & 31) * 528 + 16 * h;
        bf16x8 bfr[16];
#pragma unroll
        for (int ks = 0; ks < 16; ++ks) bfr[ks] = *(const bf16x8*)(w1p + (ch * 16 + ks) * 512);
#pragma unroll
        for (int ks = 0; ks < 16; ++ks) {
            const bf16x8 af = *(const LAS bf16x8*)(ab + 32 * ks);
            acc = __builtin_amdgcn_mfma_f32_32x32x16_bf16(af, bfr[ks], acc, 0, 0, 0);
        }
        CMP_AWRITE((ch + 1) & 1);
        __syncthreads();
    }
#undef CMP_ALOAD
#undef CMP_AWRITE
    {
        const int j = 32 * w + (lane & 31); const float bb = P.b1[j];
#pragma unroll
        for (int r = 0; r < 16; ++r) {
            const float x = acc[r] + bb;
            const float u = 0.7978845608028654f * (x + 0.044715f * x * x * x);
            const float th = 1.f - 2.f / (1.f + __expf(2.f * u));
            const float gl = 0.5f * x * (1.f + th);
            *(LAS bf16_t*)(hidl + crow(r, h) * 528 + j * 2) = f2bf(gl);
        }
    }
    __syncthreads();
    float outv[16]; float ssp[16];
    if (w < 2) {
        f32x16 a2 = (f32x16){};
        const bf16_t* w2p = P.W2T + (size_t)(32 * w + (lane & 31)) * 256 + 8 * h;
#pragma unroll
        for (int ks = 0; ks < 16; ++ks) {
            const bf16x8 af = *(const LAS bf16x8*)(hidl + (lane & 31) * 528 + (16 * ks + 8 * h) * 2);
            const bf16x8 bfr = *(const bf16x8*)(w2p + 16 * ks);
            a2 = __builtin_amdgcn_mfma_f32_32x32x16_bf16(af, bfr, a2, 0, 0, 0);
        }
        const float bb = P.b2[32 * w + (lane & 31)];
#pragma unroll
        for (int r = 0; r < 16; ++r) {
            outv[r] = a2[r] + bb;
            float ss = outv[r] * outv[r];
            ss += __shfl_xor(ss, 1); ss += __shfl_xor(ss, 2); ss += __shfl_xor(ss, 4); ss += __shfl_xor(ss, 8); ss += __shfl_xor(ss, 16);
            ssp[r] = ss;
            if ((lane & 31) == 0) ssx[w * 32 + crow(r, h)] = ss;
        }
    }
    __syncthreads();
    if (w < 2) {
        const int d = 32 * w + (lane & 31);
        const float gn = P.gain ? P.gain[d] : 1.f;
#pragma unroll
        for (int r = 0; r < 16; ++r) {
            const int row = 32 * P.rt + crow(r, h);
            float v = outv[r];
            if (P.gain) { const float tot = ssx[crow(r, h)] + ssx[32 + crow(r, h)]; v = v * rsqrtf(tot * (1.f / 64.f) + 1e-6f) * gn; }
            if (row <= 510) P.OUT[(size_t)row * 64 + d] = f2bf(v);
        }
    }
    __syncthreads();
}

struct NsaArgs {
    const bf16_t* Hb; size_t brow; int qb;
    const bf16_t* KC; const bf16_t* VC;
    const float* bias;
    const float* Mv;
    bf16_t* Y; unsigned* cdone;
    float* scr;
};
constexpr int GTOP = 2015, GTS = 2519, WTOP = 549, WTS = 588, DEAD = 4 * GTS + 4 * WTS;
__device__ __forceinline__ void nsa_unit(LAS unsigned char* lds, const NsaArgs& P) {
    const int tid = opq(threadIdx.x), lane = tid & 63, w = __builtin_amdgcn_readfirstlane(tid >> 6), hh = lane >> 5;
    const int n = lane & 31, q8 = n >> 2, hd = n & 3;
    LAS float* tg = (LAS float*)(lds + L_TAB);
    LAS float* tw = tg + 4 * GTS;
    LAS float* dead = tg + DEAD;
    LAS float* impw = (LAS float*)(lds + L_IMP) + w * 1024;
    LAS unsigned* selw = (LAS unsigned*)(lds + L_SEL) + w * 32;
    LAS unsigned* uni = (LAS unsigned*)(lds + L_SEL) + 256;
    LAS float* ws_ = (LAS float*)(lds + L_WSCR) + w * 256;
    LAS float* sbh = (LAS float*)(lds + L_SB);
    if (tid < 128) sbh[tid] = (P.bias[(tid & 31) * 16 + (tid >> 5)] - P.Mv[tid >> 5]) * LOG2E;
    __syncthreads();
    for (int e = tid; e < 4 * GTS; e += 512) { const int hq = e / GTS, j = e % GTS, dist = GTOP - j;
        tg[e] = dist >= 0 ? sbh[hq * 32 + t5_bucket(dist)] : -1e30f; }
    for (int e = tid; e < 4 * WTS; e += 512) { const int hq = e / WTS, j = e % WTS, dist = WTOP - j;
        tw[e] = (dist >= 0 && dist <= 511) ? sbh[hq * 32 + t5_bucket(dist)] : -1e30f; }
    if (tid < 64) dead[tid] = -1e30f;
    for (int e = lane; e < 1024; e += 64) impw[e] = 0.f;
    if (tid < 4) uni[tid] = 0u;
    const float cfar = sbh[hd * 32 + 31];
    const int tq = 64 * P.qb + 8 * w + q8;
    const int twmin = 64 * P.qb + 8 * w, twmax = twmin + 7;
    bf16x8 qf[4];
    {
        const bf16_t* qp = P.Hb + (size_t)tq * HP + C_DQ + 64 * hd + 8 * hh;
#pragma unroll
        for (int s = 0; s < 4; ++s) qf[s] = *(const bf16x8*)(qp + 16 * s);
        asm volatile("" : "+v"(qf[0]), "+v"(qf[1]), "+v"(qf[2]), "+v"(qf[3]));
    }
    {
        const bf16_t* gp = P.Hb + (size_t)tq * HP + C_GT + 3 * hd;
        if (hh == 0) { ws_[n] = bf2f(gp[0]); ws_[32 + n] = bf2f(gp[1]); ws_[64 + n] = bf2f(gp[2]); }
    }
    const int srow = tid >> 3, sch = tid & 7;
    StageRegs sr;
    f32x16 o[2], outv[2];
    float den = 0.f;
    o[0] = (f32x16){}; o[1] = (f32x16){};
    {
        const int kt0 = P.qb >= 8 ? P.qb - 8 : 0, nkt = P.qb - kt0 + 1;
        {
            const bf16_t* rp = P.Hb + (size_t)(64 * kt0 + srow) * HP;
            stage_load(sr, rp + C_KW, rp + C_VW, true, sch);
            stage_write(lds + L_KV, sr, srow, sch);
        }
        __syncthreads();
        for (int t = 0; t < nkt; ++t) {
            LAS unsigned char* buf = lds + L_KV + (t & 1) * KVB;
            if (t + 1 < nkt) { const bf16_t* rp = P.Hb + (size_t)(64 * (kt0 + t + 1) + srow) * HP; stage_load(sr, rp + C_KW, rp + C_VW, true, sch); }
#pragma unroll
            for (int sub = 0; sub < 2; ++sub) {
                const int kb = 64 * (kt0 + t) + 32 * sub;
                if (kb <= twmax && kb + 31 >= twmin - 511) {
                    f32x16 acc;
                    const LAS float* tb = tw + hd * WTS + (WTOP - (tq - kb - 4 * hh));
#pragma unroll
                    for (int r = 0; r < 16; ++r) acc[r] = tb[(r & 3) + 8 * (r >> 2)];
                    qk_sub<0, 4>(acc, buf, sub, qf, lane);
#pragma unroll
                    for (int r = 0; r < 1; ++r) den += exp_sum16(acc);
                    bf16x8 pa0, pa1; pack_p(acc, pa0, pa1);
                    pv_sub(o, buf, sub, pa0, pa1, lane);
                }
            }
            if (t + 1 < nkt) stage_write(lds + L_KV + ((t + 1) & 1) * KVB, sr, srow, sch);
            __syncthreads();
        }
    }
    {
        const float dt = den + __shfl_xor(den, 32);
        if (hh == 0) ws_[128 + n] = __builtin_amdgcn_rcpf(dt);
        asm volatile("s_waitcnt lgkmcnt(0)" ::: "memory");
#pragma unroll
        for (int r = 0; r < 16; ++r) { const int nn = crow(r, hh); const float gi = ws_[64 + nn] * ws_[128 + nn]; outv[0][r] = o[0][r] * gi; outv[1][r] = o[1][r] * gi; }
    }
    if (opq(threadIdx.x) == 128) {
        unsigned sp = 0;
        while (__hip_atomic_load(P.cdone, __ATOMIC_RELAXED, __HIP_MEMORY_SCOPE_AGENT) < 64u) { __builtin_amdgcn_s_sleep(2); if (++sp > (1u << 24)) break; }
        __builtin_amdgcn_fence(__ATOMIC_ACQUIRE, "agent"); asm volatile("s_waitcnt vmcnt(0)" ::: "memory");
    }
    __syncthreads();
    const int tlast = 64 * P.qb + 63;
    const int ntc = tlast >= 31 ? (((tlast - 31) >> 4) >> 6) + 1 : 0;
    float invden = 0.f; den = 0.f;
    o[0] = (f32x16){}; o[1] = (f32x16){};
    for (int pass = 0; pass < 2; ++pass) {
        if (ntc > 0) {
            __syncthreads();
            stage_load(sr, P.KC + (size_t)srow * 64, P.VC + (size_t)srow * 64, true, sch);
            stage_write(lds + L_KV, sr, srow, sch);
            __syncthreads();
            for (int t = 0; t < ntc; ++t) {
                LAS unsigned char* buf = lds + L_KV + (t & 1) * KVB;
                if (t + 1 < ntc) stage_load(sr, P.KC + (size_t)(64 * (t + 1) + srow) * 64, P.VC + (size_t)(64 * (t + 1) + srow) * 64, true, sch);
#pragma unroll
                for (int sub = 0; sub < 2; ++sub) {
                    const int cb = 64 * t + 32 * sub;
                    if (16 * cb + 31 <= twmax) {
                        f32x16 acc;
                        const int dmin = twmin - 16 * (cb + 31) - 31;
                        if (dmin >= 1513) acc = splat16(cfar);
                        else {
                            const LAS float* tb = tg + hd * GTS + (GTOP - (tq - 31 - 16 * cb - 64 * hh));
#pragma unroll
                            for (int r = 0; r < 16; ++r) acc[r] = tb[16 * ((r & 3) + 8 * (r >> 2))];
                        }
                        qk_sub<0, 4>(acc, buf, sub, qf, lane);
#pragma unroll
                        for (int r = 0; r < 16; ++r) acc[r] = __builtin_amdgcn_exp2f(acc[r]);
                        if (pass == 0) {
#pragma unroll
                            for (int r = 0; r < 16; ++r) { den += acc[r]; asm volatile("" : "+v"(den)); }
                        } else {
#pragma unroll
                            for (int r = 0; r < 16; ++r) acc[r] *= invden;
#pragma unroll
                            for (int g = 0; g < 4; ++g) {
                                float G = (acc[4 * g] + acc[4 * g + 1]) + (acc[4 * g + 2] + acc[4 * g + 3]), C = acc[4 * g + 3];
                                G += __shfl_xor(G, 1); G += __shfl_xor(G, 2); C += __shfl_xor(C, 1); C += __shfl_xor(C, 2);
                                if (hd == 0) {
                                    const int j = (cb >> 2) + 2 * g + hh;
                                    __hip_atomic_fetch_add(impw + q8 * 128 + j, G, __ATOMIC_RELAXED, __HIP_MEMORY_SCOPE_WORKGROUP);
                                    if (j + 1 < 128) __hip_atomic_fetch_add(impw + q8 * 128 + j + 1, C, __ATOMIC_RELAXED, __HIP_MEMORY_SCOPE_WORKGROUP);
                                }
                            }
                            bf16x8 pa0, pa1; pack_p(acc, pa0, pa1);
                            pv_sub(o, buf, sub, pa0, pa1, lane);
                        }
                    }
                }
                if (t + 1 < ntc) stage_write(lds + L_KV + ((t + 1) & 1) * KVB, sr, srow, sch);
                __syncthreads();
            }
        }
        if (pass == 0) { const float dt = den + __shfl_xor(den, 32); invden = dt > 0.f ? 1.f / dt : 0.f; }
    }
    asm volatile("s_waitcnt lgkmcnt(0)" ::: "memory");
#pragma unroll
    for (int r = 0; r < 16; ++r) { const float g0 = ws_[crow(r, hh)]; outv[0][r] += o[0][r] * g0; outv[1][r] += o[1][r] * g0; }
    {
        float* sp = P.scr + tid;
#pragma unroll
        for (int r = 0; r < 16; ++r) { sp[r * 512] = outv[0][r]; sp[(16 + r) * 512] = outv[1][r]; }
    }
    {
        const int qsel = lane >> 3, sb = lane & 7;
        unsigned key[16];
#pragma unroll
        for (int i4 = 0; i4 < 4; ++i4) {
            const f32x4 v = *(const LAS f32x4*)(impw + qsel * 128 + sb * 16 + 4 * i4);
#pragma unroll
            for (int e = 0; e < 4; ++e) {
                const int j = sb * 16 + 4 * i4 + e;
                const bool forced = (j == 0) | (j == P.qb) | (j == P.qb - 1);
                key[4 * i4 + e] = forced ? 0xFFFFFFFFu : (j <= P.qb ? __float_as_uint(v[e]) + 1u : 0u);
            }
        }
        unsigned T = 0u;
        for (int bit = 31; bit >= 0; --bit) {
            const unsigned cand = T | (1u << bit);
            int cnt = 0;
#pragma unroll
            for (int i = 0; i < 16; ++i) cnt += key[i] >= cand ? 1 : 0;
            cnt += __shfl_xor(cnt, 1); cnt += __shfl_xor(cnt, 2); cnt += __shfl_xor(cnt, 4);
            if (cnt >= 16) T = cand;
        }
        int cgt = 0, ceq = 0;
#pragma unroll
        for (int i = 0; i < 16; ++i) { cgt += key[i] > T ? 1 : 0; ceq += key[i] == T ? 1 : 0; }
        int cg = cgt; cg += __shfl_xor(cg, 1); cg += __shfl_xor(cg, 2); cg += __shfl_xor(cg, 4);
        int pre = 0;
#pragma unroll
        for (int k = 0; k < 8; ++k) { const int v = __shfl(ceq, (lane & ~7) + k); if (k < sb) pre += v; }
        int need = 16 - cg - pre;
        unsigned bits = 0u;
#pragma unroll
        for (int i = 0; i < 16; ++i) {
            const int j = sb * 16 + i;
            bool s_ = key[i] > T;
            if (key[i] == T) { if (need > 0) { s_ = true; } --need; }
            if (s_ && j <= P.qb) bits |= 1u << i;
        }
        const unsigned other = __shfl_xor(bits, 1);
        const unsigned word = (sb & 1) ? ((bits << 16) | other) : (bits | (other << 16));
        if ((sb & 1) == 0) { selw[qsel * 4 + (sb >> 1)] = word; __hip_atomic_fetch_or(uni + (sb >> 1), word, __ATOMIC_RELAXED, __HIP_MEMORY_SCOPE_WORKGROUP); }
    }
    __syncthreads();
    unsigned lm0 = selw[q8 * 4 + 0], lm1 = selw[q8 * 4 + 1], lm2 = selw[q8 * 4 + 2], lm3 = selw[q8 * 4 + 3];
    unsigned wm0 = 0, wm1 = 0, wm2 = 0, wm3 = 0;
#pragma unroll
    for (int k = 0; k < 8; ++k) { wm0 |= selw[k * 4 + 0]; wm1 |= selw[k * 4 + 1]; wm2 |= selw[k * 4 + 2]; wm3 |= selw[k * 4 + 3]; }
    wm0 = __builtin_amdgcn_readfirstlane(wm0); wm1 = __builtin_amdgcn_readfirstlane(wm1); wm2 = __builtin_amdgcn_readfirstlane(wm2); wm3 = __builtin_amdgcn_readfirstlane(wm3);
    const unsigned um0 = __builtin_amdgcn_readfirstlane(uni[0]), um1 = __builtin_amdgcn_readfirstlane(uni[1]), um2 = __builtin_amdgcn_readfirstlane(uni[2]), um3 = __builtin_amdgcn_readfirstlane(uni[3]);
#define NSA_WORD(a0, a1, a2, a3, j) ((j) < 32 ? (a0) : ((j) < 64 ? (a1) : ((j) < 96 ? (a2) : (a3))))
#define NSA_NEXT(j, res) do { int _j = (j); res = 128; while (_j < 128) { const unsigned _w = NSA_WORD(um0, um1, um2, um3, _j) >> (_j & 31); if (_w) { res = _j + __builtin_ctz(_w); break; } _j = (_j | 31) + 1; } } while (0)
    o[0] = (f32x16){}; o[1] = (f32x16){}; den = 0.f;
#define NSA_SLC_COMPUTE(JJ, BUF) do { \
        if ((NSA_WORD(wm0, wm1, wm2, wm3, (JJ)) >> ((JJ) & 31)) & 1u) { \
            const bool lsel = (NSA_WORD(lm0, lm1, lm2, lm3, (JJ)) >> ((JJ) & 31)) & 1u; \
            _Pragma("unroll") for (int sub = 0; sub < 2; ++sub) { \
                const int kb = 64 * (JJ) + 32 * sub; \
                if (kb <= twmax) { \
                    f32x16 acc; \
                    if (twmin - kb - 31 >= 1513) acc = splat16(lsel ? cfar : -1e30f); \
                    else { const LAS float* tb = lsel ? tg + hd * GTS + (GTOP - (tq - kb - 4 * hh)) : dead; \
                        _Pragma("unroll") for (int r = 0; r < 16; ++r) acc[r] = tb[(r & 3) + 8 * (r >> 2)]; } \
                    qk_sub<0, 4>(acc, (BUF), sub, qf, lane); \
                    den += exp_sum16(acc); \
                    bf16x8 pa0, pa1; pack_p(acc, pa0, pa1); \
                    pv_sub(o, (BUF), sub, pa0, pa1, lane); \
                } } } } while (0)
#define NSA_SLC_LOAD(JJ, SR) do { const bf16_t* rp_ = P.Hb + (size_t)(64 * (JJ) + srow) * HP; stage_load(SR, rp_ + C_KS, rp_ + C_VS, true, sch); } while (0)
    {
        LAS unsigned char* pb0 = lds + L_KV; LAS unsigned char* pb1 = lds + L_IMP;
        StageRegs a0, a1, b0, b1;
#define NSA_PAIR(prev, ra, rb) do { ra = 128; if ((prev) < 128) { NSA_NEXT((prev) + 1, ra); } rb = 128; if (ra < 128) { NSA_NEXT(ra + 1, rb); } } while (0)
#define NSA_SLC_LOADC(JJ, SR) do { const int jc_ = (JJ) < 128 ? (JJ) : 0; NSA_SLC_LOAD(jc_, SR); } while (0)
        int ca, cb_, n1a, n1b, n2a, n2b, n3a, n3b;
        NSA_NEXT(0, ca); cb_ = 128; if (ca < 128) { NSA_NEXT(ca + 1, cb_); }
        NSA_PAIR(cb_, n1a, n1b); NSA_PAIR(n1b, n2a, n2b);
        NSA_SLC_LOADC(ca, b0); NSA_SLC_LOADC(cb_, b1);
        NSA_SLC_LOADC(n1a, a0); NSA_SLC_LOADC(n1b, a1);
        stage_write(pb0, b0, srow, sch); stage_write(pb0 + KVB, b1, srow, sch);
        NSA_SLC_LOADC(n2a, b0); NSA_SLC_LOADC(n2b, b1);
        __syncthreads();
        for (;;) {
            NSA_SLC_COMPUTE(ca, pb0);
            if (cb_ < 128) NSA_SLC_COMPUTE(cb_, pb0 + KVB);
            stage_write(pb1, a0, srow, sch); stage_write(pb1 + KVB, a1, srow, sch);
            NSA_PAIR(n2b, n3a, n3b);
            NSA_SLC_LOADC(n3a, a0); NSA_SLC_LOADC(n3b, a1);
            __syncthreads();
            if (n1a >= 128) break;
            NSA_SLC_COMPUTE(n1a, pb1);
            if (n1b < 128) NSA_SLC_COMPUTE(n1b, pb1 + KVB);
            stage_write(pb0, b0, srow, sch); stage_write(pb0 + KVB, b1, srow, sch);
            int n4a, n4b; NSA_PAIR(n3b, n4a, n4b);
            NSA_SLC_LOADC(n4a, b0); NSA_SLC_LOADC(n4b, b1);
            __syncthreads();
            if (n2a >= 128) break;
            ca = n2a; cb_ = n2b; n1a = n3a; n1b = n3b; n2a = n4a; n2b = n4b;
        }
#undef NSA_PAIR
#undef NSA_SLC_LOADC
    }
#undef NSA_SLC_COMPUTE
#undef NSA_SLC_LOAD
    {
        const float dt = den + __shfl_xor(den, 32);
        if (hh == 0) ws_[96 + n] = 1.f / dt;
        asm volatile("s_waitcnt lgkmcnt(0)" ::: "memory");
        const float* sp = P.scr + tid;
#pragma unroll
        for (int r = 0; r < 16; ++r) { const float gi = ws_[32 + crow(r, hh)] * ws_[96 + crow(r, hh)]; outv[0][r] = sp[r * 512] + o[0][r] * gi; outv[1][r] = sp[(16 + r) * 512] + o[1][r] * gi; }
    }
    {
#pragma unroll
        for (int r = 0; r < 16; ++r) {
            const int nn = crow(r, hh);
            const size_t trow = (size_t)(64 * P.qb + 8 * w + (nn >> 2));
            const int ycol = 768 + 64 * (nn & 3);
            const bf16_t* sp = P.Hb + trow * HP + C_SILU + ycol;
            bf16_t* yp = P.Y + (P.brow + trow) * DM + ycol;
            yp[n] = f2bf(outv[0][r] * bf2f(sp[n]));
            yp[32 + n] = f2bf(outv[1][r] * bf2f(sp[32 + n]));
        }
    }
    __syncthreads();
#undef NSA_WORD
#undef NSA_NEXT
}
}

#define XB_TMO      128
#define XB_XCNT(j)  (256  + 64 * (j))
#define XB_XSUB(j)  (1280 + 64 * (j))
#define XB_XGEN(j)  (2304 + 64 * (j))
#define XB_TOP      3328
#define XB_TOPGEN   3392
#define XCD_BAR_WORDS 3456
#define XB_SPIN_CAP (1u << 22)
__device__ __forceinline__ unsigned xb_ld(unsigned* p)              { return __hip_atomic_load(p, __ATOMIC_RELAXED, __HIP_MEMORY_SCOPE_AGENT); }
__device__ __forceinline__ unsigned xb_add(unsigned* p, unsigned v) { return __hip_atomic_fetch_add(p, v, __ATOMIC_RELAXED, __HIP_MEMORY_SCOPE_AGENT); }
__device__ __forceinline__ unsigned xb_xcc_id() { return (unsigned)__builtin_amdgcn_s_getreg((3 << 11) | 20) & 0xFu; }
#define XB_SPIN(cond, bar) do { unsigned _sp = 0; while (cond) { __builtin_amdgcn_s_sleep(1); \
    if ((++_sp & 255u) == 0u) { if (xb_ld(&(bar)[XB_TMO])) break; if (_sp > XB_SPIN_CAP) { atomicAdd(&(bar)[XB_TMO], 1u); break; } } } } while (0)
struct XcdBarrier { unsigned* bar; unsigned x; volatile LAS unsigned* st; };
__device__ __forceinline__ XcdBarrier xcd_barrier_post(unsigned* bar, volatile LAS unsigned* st) {
    XcdBarrier b; b.bar = bar; b.x = xb_xcc_id(); b.st = st;
    if (threadIdx.x == 0) (void)xb_add(&bar[XB_XCNT(b.x)], 1u);
    return b;
}
__device__ __forceinline__ void xcd_barrier_complete(unsigned* bar, unsigned x, unsigned& nloc, unsigned& nx) {
    const unsigned G = gridDim.x * gridDim.y * gridDim.z;
    unsigned sum, cnt, mine, sp = 0u;
    for (;;) {
        sum = 0u; cnt = 0u; mine = 0u;
#pragma unroll
        for (unsigned j = 0; j < 16; ++j) { const unsigned c = xb_ld(&bar[XB_XCNT(j)]); sum += c; cnt += (c > 0u) ? 1u : 0u; mine = (j == x) ? c : mine; }
        if (sum == G) break;
        __builtin_amdgcn_s_sleep(1);
        if ((++sp & 255u) == 0u) { if (xb_ld(&bar[XB_TMO])) break; if (sp > XB_SPIN_CAP) { atomicAdd(&bar[XB_TMO], 1u); break; } }
    }
    nloc = mine > 0u ? mine : 1u; nx = cnt > 0u ? cnt : 1u;
}
__device__ __forceinline__ void xcd_barrier(const XcdBarrier& b) {
    asm volatile("s_waitcnt vmcnt(0)" ::: "memory");
    __syncthreads();
    if (threadIdx.x == 0) {
        unsigned* bar = b.bar;
        __builtin_amdgcn_s_waitcnt(0);
        unsigned nloc = b.st[0], nx = b.st[1];
        if (nloc == 0u) { xcd_barrier_complete(bar, b.x, nloc, nx); b.st[0] = nloc; b.st[1] = nx; }
        const unsigned old = xb_add(&bar[XB_XSUB(b.x)], 1u);
        const unsigned gen = old / nloc;
        if (old + 1u == (gen + 1u) * nloc) {
            __builtin_amdgcn_fence(__ATOMIC_RELEASE, "agent");
            asm volatile("s_waitcnt vmcnt(0)" ::: "memory");
            const unsigned og = xb_add(&bar[XB_TOP], 1u);
            const unsigned tg = og / nx;
            if (og + 1u == (tg + 1u) * nx) xb_add(&bar[XB_TOPGEN], 1u);
            else XB_SPIN(xb_ld(&bar[XB_TOPGEN]) == tg, bar);
            __builtin_amdgcn_fence(__ATOMIC_ACQUIRE, "agent");
            xb_add(&bar[XB_XGEN(b.x)], 1u);
            asm volatile("s_waitcnt vmcnt(0)" ::: "memory");
        } else {
            XB_SPIN(xb_ld(&bar[XB_XGEN(b.x)]) == gen, bar);
            __builtin_amdgcn_fence(__ATOMIC_ACQUIRE, "agent");
            asm volatile("s_waitcnt vmcnt(0)" ::: "memory");
        }
    }
    __syncthreads();
}

constexpr int NT = 512, LDS_BYTES = 147456, MISC_OFF = 131072 + 320;
#ifndef R_C
#define R_C 1
#endif
#ifndef R_D
#define R_D 1
#endif
#ifndef R_AB
#define R_AB 1
#endif
#ifndef R_G1
#define R_G1 1
#endif
constexpr size_t MiB = 1u << 20;
constexpr size_t WS_CTL = 0, CTL_ZERO_BYTES = 65536;
constexpr size_t WS_NSCR = 184 * MiB;
constexpr size_t WS_H = 2 * MiB, WS_XN = 124 * MiB, WS_T0 = 158 * MiB, WS_IMP = 208 * MiB, WS_SEL = 217 * MiB, WS_HID = 218 * MiB, WS_KC = 221 * MiB, WS_VC = 222 * MiB, WS_WIN = 224 * MiB, WS_WOUT = 240 * MiB, WS_MX = 1 * MiB, WS_DA = 245 * MiB, WS_CW1 = 246 * MiB, WS_CW2 = 250 * MiB, WS_RSS = 251 * MiB;

struct Args { const float* in[15]; float* out; unsigned char* ws; };

__global__ void __launch_bounds__(NT, 2) mega_fwd(Args args) {
    extern __shared__ __attribute__((aligned(16))) unsigned char lds[];
    const int tid = threadIdx.x, lane = tid & 63, wid = tid >> 6;
    const int G = gridDim.x, bid = blockIdx.x;
    volatile LAS unsigned* MISC = (volatile LAS unsigned*)((LAS unsigned char*)lds + MISC_OFF);
    if (tid < 32) MISC[tid] = 0u;
    __syncthreads();
    unsigned char* ws = args.ws;
    XcdBarrier bar = xcd_barrier_post((unsigned*)(ws + WS_CTL) + 4096, MISC + 8);
    const float* x = args.in[0]; const float* tab = args.in[1]; const float* norm_w = args.in[2];
    const float* w_in = args.in[3]; const float* w_out = args.in[4]; const float* qk_gain = args.in[5];
    const float* qk_gain_diff = args.in[6]; const float* sinks = args.in[7]; const float* diff_lambda = args.in[8];
    const float* diff_subln = args.in[9]; const float* cmp_pos = args.in[10]; const float* cmp_w1 = args.in[11];
    const float* cmp_b1 = args.in[12]; const float* cmp_w2 = args.in[13]; const float* cmp_b2 = args.in[14];
    float* out = args.out;
    bf16_t* H = (bf16_t*)(ws + WS_H);
    bf16_t* XN = (bf16_t*)(ws + WS_XN); bf16_t* Y = XN;
    float* T0 = (float*)(ws + WS_T0);
    float* OC = T0; float* OS_ = T0 + (size_t)MROWS * 256; float* OW = T0 + (size_t)MROWS * 512; float* CT = T0;
    float* IMP = (float*)(ws + WS_IMP); unsigned* SEL = (unsigned*)(ws + WS_SEL); float* HID = (float*)(ws + WS_HID);
    float* KC = (float*)(ws + WS_KC); float* VC = (float*)(ws + WS_VC);
    const int GT = G * NT, GW = G * 8;
    bf16_t* WinT = (bf16_t*)(ws + WS_WIN); bf16_t* WoutT = (bf16_t*)(ws + WS_WOUT);
#define GRID_BAR() do { XcdBarrier b2_ = bar; asm volatile("" : "+s"(b2_.x)); xcd_barrier(b2_); } while (0)
    {
        LAS float* scr = (LAS float*)((LAS unsigned char*)lds + wid * 16384);
        const int gw0 = bid * 8 + wid;
        constexpr int I_IN = 16 * 120, I_OUT = 16 * 32, I_C1 = 32 * 8, I_C2 = 4 * 2, I_L = I_IN + I_OUT + 2 * I_C1 + 2 * I_C2, NITEMS = 2 * I_L;
        bf16_t* CW1T = (bf16_t*)(ws + WS_CW1); bf16_t* CW2T = (bf16_t*)(ws + WS_CW2);
        for (int it = gw0; it < NITEMS; it += GW) {
            const int l = it / I_L; int r = it % I_L;
            if (r < I_IN) { p0_transpose_item<0>(w_in + (size_t)l * DM * PW, WinT + (size_t)l * HP * DM, scr, r, lane); continue; } r -= I_IN;
            if (r < I_OUT) { p0_transpose_item<1>(w_out + (size_t)l * DM * DM, WoutT + (size_t)l * DM * DM, scr, r, lane); continue; } r -= I_OUT;
            if (r < 2 * I_C1) { const int kv = r / I_C1; p0_transpose_item<2>(cmp_w1 + (size_t)(l * 2 + kv) * 2048 * 256, CW1T + (size_t)(l * 2 + kv) * 256 * 2048, scr, r % I_C1, lane, 2048, 256); continue; } r -= 2 * I_C1;
            { const int kv = r / I_C2; p0_transpose_item<1>(cmp_w2 + (size_t)(l * 2 + kv) * 256 * 64, CW2T + (size_t)(l * 2 + kv) * 64 * 256, scr, r % I_C2, lane, 256, 64); }
        }
        if (bid == 1 && tid < 256) { bf16_t* KCb = (bf16_t*)(ws + WS_KC); KCb[(size_t)(tid >> 6) * 512 * 64 + 511 * 64 + (tid & 63)] = 0; }
        for (int w = gw0; w < MROWS; w += GW) k_rmsnorm(w, lane, x, norm_w, XN);
        for (int v = bid * NT + tid; v < MROWS; v += GT) ((unsigned long long*)(ws + WS_RSS))[v] = 0ull;
        if (bid == 0 && wid == 0) {
            float* MX = (float*)(ws + WS_MX);
            for (int l = 0; l < 2; ++l) {
                float mg[8];
#pragma unroll
                for (int i = 0; i < 8; ++i) { float v = fabsf(qk_gain[l * 512 + i * 64 + lane]);
#pragma unroll
                    for (int o = 1; o < 64; o <<= 1) v = fmaxf(v, __shfl_xor(v, o));
                    mg[i] = v; }
                float md0 = lane < 32 ? fabsf(qk_gain_diff[l * 64 + lane]) : 0.f, md1 = lane < 32 ? fabsf(qk_gain_diff[l * 64 + 32 + lane]) : 0.f;
#pragma unroll
                for (int o = 1; o < 64; o <<= 1) { md0 = fmaxf(md0, __shfl_xor(md0, o)); md1 = fmaxf(md1, __shfl_xor(md1, o)); }
                for (int gh = 0; gh < 16; ++gh) {
                    float mb = lane < 32 ? fabsf(tab[lane * 16 + gh]) : 0.f;
#pragma unroll
                    for (int o = 1; o < 64; o <<= 1) mb = fmaxf(mb, __shfl_xor(mb, o));
                    const int grp = gh >> 2, hh = gh & 3; float Mv;
                    if (grp == 0) Mv = 8.f * mg[0] * mg[1] + mb;
                    else if (grp == 1) Mv = fmaxf(8.f * mg[2] * mg[3] + mb, sinks[l * 4 + hh]);
                    else if (grp == 2) Mv = 5.656854249f * md0 * md1 + mb;
                    else Mv = 8.f * mg[4] * fmaxf(mg[5], fmaxf(mg[6], mg[7])) + mb;
                    if (lane == 0) MX[l * 16 + gh] = Mv;
                }
                float s1 = lane < 32 ? diff_lambda[l * 128 + lane] * diff_lambda[l * 128 + 32 + lane] : 0.f;
                float s2 = lane < 32 ? diff_lambda[l * 128 + 64 + lane] * diff_lambda[l * 128 + 96 + lane] : 0.f;
#pragma unroll
                for (int o = 1; o < 64; o <<= 1) { s1 += __shfl_xor(s1, o); s2 += __shfl_xor(s2, o); }
                const float lambda_init = 0.8f - 0.6f * expf(-0.3f * (float)l);
                if (lane == 0) { MX[32 + l] = expf(s1) - expf(s2) + lambda_init; MX[34 + l] = lambda_init; }
            }
        }
    }
    GRID_BAR();
#pragma unroll 1
    for (int l = 0; l < 2; ++l) {
        const float* xprev = l == 0 ? x : out;
        { pg8::Gemm g{XN, WinT + (size_t)l * HP * DM, MROWS, HP, DM}; pg8::StaticOrder So; So.init(MROWS, HP, G, bid);
          pg8::EpiProj E{H, qk_gain + l * 512, qk_gain_diff + l * 64, l == 0 ? nullptr : (const float*)(ws + WS_RSS)};
          for (int rep = 0; rep < R_G1; ++rep) pg8::gemm_phase<pg8::EpiProj, pg8::StaticOrder, true, true>((LAS unsigned char*)lds, g, So, E); }
        GRID_BAR();
        {
            const float* MX = (const float*)(ws + WS_MX);
            bf16_t* OA = (bf16_t*)(ws + WS_T0); float* DA = (float*)(ws + WS_DA);
            bf16_t* KCb = (bf16_t*)(ws + WS_KC);
            const bf16_t* CW1T = (const bf16_t*)(ws + WS_CW1); const bf16_t* CW2T = (const bf16_t*)(ws + WS_CW2);
            LAS unsigned* qw = (LAS unsigned*)((LAS unsigned char*)lds + att::L_Q);
            unsigned* qctr = (unsigned*)(ws + WS_CTL) + 8192 + 128 * l;
            unsigned* cdone = qctr + 64;
            constexpr int B0 = 64, B1 = B0 + 160 * R_C, B2 = B1 + 256 * R_D, B3 = B2 + 96 * R_C, B4 = B3 + 768 * R_AB, NUV = B4 + 256 * R_AB;
            for (;;) {
                if (opq(threadIdx.x) == 0) *qw = atomicAdd(qctr, 1u);
                __syncthreads();
                const int uv = (int)*qw;
                __syncthreads();
                if (uv >= NUV) break;
                int u;
                if (uv < B0) u = uv; else if (uv < B1) u = 64 + (uv - B0) / R_C; else if (uv < B2) u = 224 + (uv - B1) / R_D; else if (uv < B3) u = 480 + (uv - B2) / R_C;
                else if (uv < B4) u = 576 + (uv - B3) / R_AB; else u = 1344 + (uv - B4) / R_AB;
                if (u < 64) {
                    const int kv = u >> 5, b = (u >> 4) & 1, rt = u & 15;
                    att::CmpArgs P; P.Hb = H + (size_t)b * S * HP; P.col = kv == 0 ? C_KC : C_VC; P.rt = rt;
                    P.pos = cmp_pos + (size_t)(l * 2 + kv) * 2048; P.W1T = CW1T + (size_t)(l * 2 + kv) * 256 * 2048; P.b1 = cmp_b1 + (l * 2 + kv) * 256;
                    P.W2T = CW2T + (size_t)(l * 2 + kv) * 64 * 256; P.b2 = cmp_b2 + (l * 2 + kv) * 64; P.gain = kv == 0 ? qk_gain + l * 512 + 5 * 64 : nullptr;
                    P.OUT = KCb + (size_t)(kv * NB + b) * 512 * 64;
                    att::cmp_unit((LAS unsigned char*)lds, P);
                    asm volatile("s_waitcnt vmcnt(0)" ::: "memory");
                    __syncthreads();
                    if (opq(threadIdx.x) == 64) { __builtin_amdgcn_fence(__ATOMIC_RELEASE, "agent"); asm volatile("s_waitcnt vmcnt(0)" ::: "memory");
                        __hip_atomic_fetch_add(cdone, 1u, __ATOMIC_RELAXED, __HIP_MEMORY_SCOPE_AGENT); }
                    __syncthreads();
                } else if ((u >= 64 && u < 224) || (u >= 480 && u < 576)) {
                    int qb, bh;
                    if (u < 224) { qb = 31 - ((u - 64) >> 3); bh = (u - 64) & 7; } else { qb = 11 - ((u - 480) >> 3); bh = (u - 480) & 7; }
                    const int b = bh >> 2, hd = bh & 3;
                    att::DiffArgs P; P.Hb = H + (size_t)b * S * HP; P.hd = hd; P.qb = qb; P.brow = (size_t)b * S;
                    P.bias = tab + 8 + hd; P.M = MX[l * 16 + 8 + hd]; P.lam = MX[32 + l]; P.lambda_init = MX[34 + l]; P.subln = diff_subln + l * 64; P.Y = Y;
                    att::diff_unit((LAS unsigned char*)lds, P);
                } else if (u < 480) {
                    const int idx = u - 224, qb64 = 127 - (idx >> 1), b = idx & 1;
                    att::NsaArgs P; P.Hb = H + (size_t)b * S * HP; P.brow = (size_t)b * S; P.qb = qb64;
                    P.KC = KCb + (size_t)(0 * NB + b) * 512 * 64; P.VC = KCb + (size_t)(1 * NB + b) * 512 * 64;
                    P.bias = tab + 12; P.Mv = MX + l * 16 + 12; P.Y = Y; P.cdone = cdone; P.scr = (float*)(ws + WS_NSCR) + (size_t)bid * 16384;
                    att::nsa_unit((LAS unsigned char*)lds, P);
                } else if (u < 1344) {
                    const int v = u - 576, cfg = v >> 8, b = (v >> 7) & 1, hd = (v >> 5) & 3, ti = v & 31;
                    const int rate = cfg == 0 ? 1 : (cfg == 1 ? 4 : 16), tpc = 32 / rate;
                    att::BandArgs P; P.Hb = H + (size_t)b * S * HP; P.cq = C_AQ + 64 * hd; P.ck = C_AK + 64 * hd; P.cv = C_AV + 64 * hd;
                    P.rate = rate; P.cls = ti / tpc; P.f0 = (ti % tpc) * 256; P.maxd = 128; P.bias = tab + hd; P.M = MX[l * 16 + hd]; P.sinkterm = 0.f;
                    P.OA = OA + (size_t)cfg * MROWS * 256; P.DA = DA + (size_t)cfg * MROWS * 4; P.Y = nullptr; P.ycol = 0; P.hd = hd; P.brow = (size_t)b * S;
                    att::banded_unit<0>((LAS unsigned char*)lds, P);
                } else {
                    const int v = u - 1344, b = (v >> 7) & 1, hd = (v >> 5) & 3, ti = v & 31;
                    att::BandArgs P; P.Hb = H + (size_t)b * S * HP; P.cq = C_BQ + 64 * hd; P.ck = C_BK + 64 * (hd >> 1); P.cv = C_BV + 64 * (hd >> 1);
                    P.rate = 1; P.cls = 0; P.f0 = ti * 256; P.maxd = 127; P.bias = tab + 4 + hd; P.M = MX[l * 16 + 4 + hd];
                    P.sinkterm = __expf(sinks[l * 4 + hd] - P.M);
                    P.OA = nullptr; P.DA = nullptr; P.Y = Y; P.ycol = 256 + 64 * hd; P.hd = hd; P.brow = (size_t)b * S;
                    att::banded_unit<1>((LAS unsigned char*)lds, P);
                }
            }
        }
        GRID_BAR();
        {
            const bf16_t* OA = (const bf16_t*)(ws + WS_T0); const float* DA = (const float*)(ws + WS_DA);
            for (int v = (bid * NT + opq(threadIdx.x)); v < MROWS * 32; v += GT) {
                const int row = v >> 5, hd = (v >> 3) & 3, c8 = v & 7;
                float acc8[8] = {0.f, 0.f, 0.f, 0.f, 0.f, 0.f, 0.f, 0.f}; float dsum = 0.f;
#pragma unroll
                for (int cfg = 0; cfg < 3; ++cfg) {
                    const float dn = DA[((size_t)cfg * MROWS + row) * 4 + hd]; dsum += dn;
                    const uint4 r4 = *(const uint4*)(OA + ((size_t)cfg * MROWS + row) * 256 + hd * 64 + c8 * 8);
                    acc8[0] += dn * __uint_as_float(r4.x << 16); acc8[1] += dn * __uint_as_float(r4.x & 0xffff0000u);
                    acc8[2] += dn * __uint_as_float(r4.y << 16); acc8[3] += dn * __uint_as_float(r4.y & 0xffff0000u);
                    acc8[4] += dn * __uint_as_float(r4.z << 16); acc8[5] += dn * __uint_as_float(r4.z & 0xffff0000u);
                    acc8[6] += dn * __uint_as_float(r4.w << 16); acc8[7] += dn * __uint_as_float(r4.w & 0xffff0000u);
                }
                const float inv = 1.f / dsum;
                const uint4 s4 = *(const uint4*)(H + (size_t)row * HP + C_SILU + hd * 64 + c8 * 8);
                uint4 o4;
                o4.x = (unsigned)f2bf(acc8[0] * inv * __uint_as_float(s4.x << 16)) | ((unsigned)f2bf(acc8[1] * inv * __uint_as_float(s4.x & 0xffff0000u)) << 16);
                o4.y = (unsigned)f2bf(acc8[2] * inv * __uint_as_float(s4.y << 16)) | ((unsigned)f2bf(acc8[3] * inv * __uint_as_float(s4.y & 0xffff0000u)) << 16);
                o4.z = (unsigned)f2bf(acc8[4] * inv * __uint_as_float(s4.z << 16)) | ((unsigned)f2bf(acc8[5] * inv * __uint_as_float(s4.z & 0xffff0000u)) << 16);
                o4.w = (unsigned)f2bf(acc8[6] * inv * __uint_as_float(s4.w << 16)) | ((unsigned)f2bf(acc8[7] * inv * __uint_as_float(s4.w & 0xffff0000u)) << 16);
                *(uint4*)(Y + (size_t)row * DM + hd * 64 + c8 * 8) = o4;
            }
        }
        GRID_BAR();
        { pg8::Gemm g{Y, WoutT + (size_t)l * DM * DM, MROWS, DM, DM}; pg8::StaticOrder So; So.init(MROWS, DM, G, bid);
          pg8::EpiOut E{xprev, out, (LAS float*)((LAS unsigned char*)lds + 132096), l == 0 ? XN : nullptr, norm_w + DM, (float*)(ws + WS_RSS)};
          pg8::gemm_phase<pg8::EpiOut, pg8::StaticOrder, true, true>((LAS unsigned char*)lds, g, So, E); }
        if (l == 0) GRID_BAR();
    }
}

extern "C" void kernel_launch(void* const* d_in, const int* in_sizes, int n_in, void* d_out, int out_size, void* d_ws, size_t ws_size, hipStream_t stream) {
    static int grid = 0;
    if (grid == 0) {
        int dev = 0, cus = 0;
        (void)hipGetDevice(&dev);
        (void)hipDeviceGetAttribute(&cus, hipDeviceAttributeMultiprocessorCount, dev);
        (void)hipFuncSetAttribute((const void*)mega_fwd, hipFuncAttributeMaxDynamicSharedMemorySize, LDS_BYTES);
        grid = cus > 0 ? cus : 256;
    }
    (void)hipMemsetAsync((char*)d_ws + WS_CTL, 0, CTL_ZERO_BYTES, stream);
    Args a{};
    for (int i = 0; i < 15; ++i) a.in[i] = (const float*)d_in[i];
    a.out = (float*)d_out; a.ws = (unsigned char*)d_ws;
    hipLaunchKernelGGL(mega_fwd, dim3(grid), dim3(NT), LDS_BYTES, stream, a);
}
```

```cpp
#include <hip/hip_runtime.h>
#include <stdint.h>
#include <math.h>

typedef unsigned short bf16_t;
__device__ __forceinline__ float bf2f(bf16_t v) { return __uint_as_float((unsigned)v << 16); }
__device__ __forceinline__ bf16_t f2bf(float f) { unsigned u = __float_as_uint(f); return (bf16_t)((u + 0x7fffu + ((u >> 16) & 1u)) >> 16); }

constexpr int NB = 2, S = 8192, DM = 1024, MROWS = NB * S, PW = 3724, HP = 3840;
constexpr int C_AQ = 0, C_AK = 256, C_AV = 512, C_BQ = 768, C_BK = 1024, C_BV = 1152, C_CQ = 1280, C_CK = 1536, C_CV = 1792,
              C_DQ = 2048, C_KC = 2304, C_VC = 2368, C_KS = 2432, C_VS = 2496, C_KW = 2560, C_VW = 2624, C_GT = 2688, C_SILU = 2816;
constexpr float EPS = 1e-6f;
__device__ __forceinline__ int opq(int v) { asm volatile("" : "+v"(v)); return v; }

__device__ __forceinline__ int t5_bucket(int n) {
    if (n < 16) return n < 0 ? 0 : n;
    int b = 16;
    b += (n >= 22); b += (n >= 30); b += (n >= 40); b += (n >= 54); b += (n >= 73); b += (n >= 99); b += (n >= 134); b += (n >= 182);
    b += (n >= 246); b += (n >= 332); b += (n >= 450); b += (n >= 609); b += (n >= 825); b += (n >= 1117); b += (n >= 1513);
    return b;
}

__device__ __forceinline__ void k_rmsnorm(const int wave, const int lane, const float* __restrict__ x, const float* __restrict__ g, bf16_t* __restrict__ xn) {
    if (wave >= MROWS) return;
    const float4* xr = (const float4*)(x + (size_t)wave * DM);
    float4 v[4]; float ss = 0.f;
#pragma unroll
    for (int j = 0; j < 4; ++j) { v[j] = xr[lane + 64 * j]; ss += (v[j].x * v[j].x + v[j].y * v[j].y) + (v[j].z * v[j].z + v[j].w * v[j].w); }
#pragma unroll
    for (int o = 1; o < 64; o <<= 1) ss += __shfl_xor(ss, o);
    const float rstd = rsqrtf(ss * (1.f / DM) + EPS);
#pragma unroll
    for (int j = 0; j < 4; ++j) {
        uint2 o; o.x = (unsigned)f2bf(v[j].x * rstd) | ((unsigned)f2bf(v[j].y * rstd) << 16);
        o.y = (unsigned)f2bf(v[j].z * rstd) | ((unsigned)f2bf(v[j].w * rstd) << 16);
        ((uint2*)(xn + (size_t)wave * DM))[lane + 64 * j] = o;
    }
}

template <int D>
__device__ __forceinline__ float dot_row(const float* q, const bf16_t* kr) {
    float s = 0.f;
#pragma unroll
    for (int c = 0; c < D / 8; ++c) {
        const uint4 r = *(const uint4*)(kr + 8 * c);
        s += q[8 * c + 0] * __uint_as_float(r.x << 16) + q[8 * c + 1] * __uint_as_float(r.x & 0xffff0000u);
        s += q[8 * c + 2] * __uint_as_float(r.y << 16) + q[8 * c + 3] * __uint_as_float(r.y & 0xffff0000u);
        s += q[8 * c + 4] * __uint_as_float(r.z << 16) + q[8 * c + 5] * __uint_as_float(r.z & 0xffff0000u);
        s += q[8 * c + 6] * __uint_as_float(r.w << 16) + q[8 * c + 7] * __uint_as_float(r.w & 0xffff0000u);
        if (c & 1) asm volatile("" ::: "memory");
    }
    return s;
}
__device__ __forceinline__ void os_step(float s, const bf16_t* vr, float& m, float& den, float* o) {
    const float mn = fmaxf(m, s), sc = __expf(m - mn), p = __expf(s - mn);
    den = den * sc + p; m = mn;
#pragma unroll
    for (int c = 0; c < 8; ++c) {
        const uint4 r = *(const uint4*)(vr + 8 * c);
        o[8 * c + 0] = o[8 * c + 0] * sc + p * __uint_as_float(r.x << 16); o[8 * c + 1] = o[8 * c + 1] * sc + p * __uint_as_float(r.x & 0xffff0000u);
        o[8 * c + 2] = o[8 * c + 2] * sc + p * __uint_as_float(r.y << 16); o[8 * c + 3] = o[8 * c + 3] * sc + p * __uint_as_float(r.y & 0xffff0000u);
        o[8 * c + 4] = o[8 * c + 4] * sc + p * __uint_as_float(r.z << 16); o[8 * c + 5] = o[8 * c + 5] * sc + p * __uint_as_float(r.z & 0xffff0000u);
        o[8 * c + 6] = o[8 * c + 6] * sc + p * __uint_as_float(r.w << 16); o[8 * c + 7] = o[8 * c + 7] * sc + p * __uint_as_float(r.w & 0xffff0000u);
        if (c & 1) asm volatile("" ::: "memory");
    }
}
template <int D>
__device__ __forceinline__ void load_q(float* q, const bf16_t* p) {
#pragma unroll
    for (int c = 0; c < D / 8; ++c) {
        const uint4 r = *(const uint4*)(p + 8 * c);
        q[8 * c + 0] = __uint_as_float(r.x << 16); q[8 * c + 1] = __uint_as_float(r.x & 0xffff0000u);
        q[8 * c + 2] = __uint_as_float(r.y << 16); q[8 * c + 3] = __uint_as_float(r.y & 0xffff0000u);
        q[8 * c + 4] = __uint_as_float(r.z << 16); q[8 * c + 5] = __uint_as_float(r.z & 0xffff0000u);
        q[8 * c + 6] = __uint_as_float(r.w << 16); q[8 * c + 7] = __uint_as_float(r.w & 0xffff0000u);
    }
}

#define LAS __attribute__((address_space(3)))
namespace pg8 {
#define PG8_LAS __attribute__((address_space(3)))
typedef unsigned short bf16_t;
typedef short bf16x8 __attribute__((ext_vector_type(8)));
typedef float f32x4 __attribute__((ext_vector_type(4)));
typedef unsigned u32x4 __attribute__((ext_vector_type(4)));
constexpr int BM = 256, BK = 64, HALF = 128, HTB = HALF * BK * 2  , STAGE_BYTES = 8 * HTB, NXCD = 8, WGM = 8;

__host__ __device__ __forceinline__ int lds_byte(int r, int c) { const int st = (r >> 4) * 2 + (c >> 5), rr = r & 15, cc = c & 31, ob = rr * 64 + cc * 2; return st * 1024 + (ob ^ (((ob >> 9) & 1) << 5)); }
__host__ __device__ __forceinline__ void stage_rc(int b, int& R, int& C) { const int st = b / 1024, sb = b % 1024, swz = sb ^ (((sb >> 9) & 1) << 5); R = (st >> 1) * 16 + swz / 64; C = (st & 1) * 32 + (swz % 64) / 2; }
__host__ __device__ __forceinline__ int perm32(int rho) { const int n = rho >> 4, i = rho & 15; return 8 * (i >> 2) + 4 * n + (i & 3); }

struct Unit { int pm, pn; };
struct Gemm { const bf16_t* A; const bf16_t* Bt; int M, N, K; };

struct StaticOrder {
    int nM, nN, nwg, G, c;
    __host__ __device__ void init(int M, int N, int G_, int c_) { nM = M / BM; nN = N / BM; nwg = nM * nN; G = G_; c = c_; }
    __host__ __device__ bool next(int i, Unit& u) const {
        const long L = (long)i * G + c; if (L >= nwg) return false;
        int wgid = (int)L; { const int q = nwg / NXCD, r = nwg % NXCD, xcd = wgid % NXCD, off = wgid / NXCD; wgid = (xcd < r ? xcd * (q + 1) : r * (q + 1) + (xcd - r) * q) + off; }
        const int nig = WGM * nN, gid = wgid / nig, fm = gid * WGM, gsz = (nM - fm) < WGM ? (nM - fm) : WGM;
        u.pm = fm + ((wgid % nig) % gsz); u.pn = (wgid % nig) / gsz; return true;
    }
    __device__ __forceinline__ void a_ready(const Unit&) const {}
    __device__ __forceinline__ void done(const Unit&) const {}
};

__device__ __forceinline__ unsigned cvt_pk_bf16(float lo, float hi) { unsigned r; asm volatile("v_cvt_pk_bf16_f32 %0, %1, %2" : "=v"(r) : "v"(lo), "v"(hi)); return r; }
template <class Epi, class Sched, bool ALIGN_EPI = false, bool SP2 = false>
__device__ __forceinline__ void gemm_phase(PG8_LAS unsigned char* lds, const Gemm g, const Sched& S, const Epi& E) {
    const int tid = opq(threadIdx.x), wid = __builtin_amdgcn_readfirstlane(tid >> 6), lane = tid & 63, wr = wid >> 2, wc = wid & 3, fr = lane & 15, fq = lane >> 4;
    const int K = g.K, nt = K / BK;
    unsigned voffA[2], voffB[2];
#pragma unroll
    for (int i = 0; i < 2; ++i) { int R, C; stage_rc(tid * 16 + i * 8192, R, C); const int Rb = Epi::PERM ? ((R & ~31) + perm32(R & 31)) : R;
        voffA[i] = (unsigned)(R * K + C) * 2u; voffB[i] = (unsigned)(Rb * K + C) * 2u; }
    const size_t kstep = (size_t)(BK * 2);
    const size_t hstep = (size_t)HALF * K * 2;
    const size_t tstep = 2 * hstep;
    const unsigned ldsw = (unsigned)wid * 1024u;
    const int aoff = lds_byte(wr * 64 + fr, fq * 8), boff = lds_byte(wc * 32 + fr, fq * 8);
#define PG8_SA(b, h) (((b) * 2 + (h)) * HTB)
#define PG8_SB(b, h) ((4 + (b) * 2 + (h)) * HTB)
#define PG8_STAGE(bufoff, gbase, voff) do { _Pragma("unroll") for (int _i = 0; _i < 2; ++_i) \
        __builtin_amdgcn_global_load_lds((const unsigned*)((const char*)(gbase) + (voff)[_i]), (PG8_LAS unsigned*)(lds + (bufoff) + ldsw + _i * 8192), 16, 0, 0); } while (0)
#define PG8_LDA(dst, b, h) do { _Pragma("unroll") for (int m = 0; m < 4; ++m) _Pragma("unroll") for (int k = 0; k < 2; ++k) dst[m][k] = *(const PG8_LAS bf16x8*)(lds + PG8_SA(b, h) + aoff + m * 2048 + k * 1024); } while (0)
#define PG8_LDB(dst, b, h) do { _Pragma("unroll") for (int n = 0; n < 2; ++n) _Pragma("unroll") for (int k = 0; k < 2; ++k) dst[n][k] = *(const PG8_LAS bf16x8*)(lds + PG8_SB(b, h) + boff + n * 2048 + k * 1024); } while (0)
#define PG8_MMA(ai, bj, At, Bt) do { __builtin_amdgcn_s_setprio(1); _Pragma("unroll") for (int m = 0; m < 4; ++m) _Pragma("unroll") for (int n = 0; n < 2; ++n) _Pragma("unroll") for (int k = 0; k < 2; ++k) \
        acc[ai][bj][m][n] = __builtin_amdgcn_mfma_f32_16x16x32_bf16(Bt[n][k], At[m][k], acc[ai][bj][m][n], 0, 0, 0); __builtin_amdgcn_s_setprio(0); } while (0)
#define PG8_WAIT_V(n) asm volatile("s_waitcnt vmcnt(" #n ")" ::: "memory")
#define PG8_WAIT_L(n) asm volatile("s_waitcnt lgkmcnt(" #n ")" ::: "memory")
#define PG8_BAR __builtin_amdgcn_s_barrier()
#define PG8_SCHED __builtin_amdgcn_sched_barrier(0)
    Unit cur, nxt; int ui = 0;
    if (!S.next(0, cur)) return;
    f32x4 acc[2][2][4][2];
#pragma unroll
    for (int a = 0; a < 2; ++a)
#pragma unroll
        for (int b = 0; b < 2; ++b)
#pragma unroll
            for (int m = 0; m < 4; ++m)
#pragma unroll
                for (int n = 0; n < 2; ++n) acc[a][b][m][n] = (f32x4){0.f, 0.f, 0.f, 0.f};
    bf16x8 At[4][2], B0[2][2], B1[2][2];
    const char* cA = (const char*)g.A + (size_t)cur.pm * tstep; const char* cB = (const char*)g.Bt + (size_t)cur.pn * tstep;
    S.a_ready(cur);
    if constexpr (SP2) {
        PG8_STAGE(PG8_SB(0, 0), cB, voffB); PG8_STAGE(PG8_SB(0, 1), cB + hstep, voffB); PG8_STAGE(PG8_SA(0, 0), cA, voffA); PG8_STAGE(PG8_SA(0, 1), cA + hstep, voffA);
        if (wr == 1) PG8_BAR;
        PG8_WAIT_V(2); PG8_BAR;
        PG8_STAGE(PG8_SB(1, 0), cB + kstep, voffB); PG8_STAGE(PG8_SA(1, 0), cA + kstep, voffA); PG8_STAGE(PG8_SB(1, 1), cB + hstep + kstep, voffB);
        PG8_WAIT_V(6); PG8_BAR;
    } else {
        PG8_STAGE(PG8_SB(0, 0), cB, voffB); PG8_STAGE(PG8_SA(0, 0), cA, voffA); PG8_STAGE(PG8_SB(0, 1), cB + hstep, voffB); PG8_STAGE(PG8_SA(0, 1), cA + hstep, voffA);
        if (wr == 1) PG8_BAR;
        PG8_WAIT_V(4); PG8_BAR;
        PG8_STAGE(PG8_SB(1, 0), cB + kstep, voffB); PG8_STAGE(PG8_SA(1, 0), cA + kstep, voffA); PG8_STAGE(PG8_SB(1, 1), cB + hstep + kstep, voffB);
        PG8_WAIT_V(6); PG8_BAR;
    }
    for (;;) {
        const bool has_next = S.next(ui + 1, nxt);
        const char* nA = has_next ? (const char*)g.A + (size_t)nxt.pm * tstep : cA; const char* nB = has_next ? (const char*)g.Bt + (size_t)nxt.pn * tstep : cB;
        for (int t = 0; t < nt; t += 2) {
            const bool last = (t == nt - 2);
            const char* a1 = cA + (size_t)(t + 1) * kstep;
            const char* a2 = last ? nA : cA + (size_t)(t + 2) * kstep; const char* b2 = last ? nB : cB + (size_t)(t + 2) * kstep;
            const char* a3 = a2 + kstep; const char* b3 = b2 + kstep;
            if (last && has_next) S.a_ready(nxt);
            if constexpr (SP2) {
            PG8_LDB(B0, 0, 0); PG8_LDB(B1, 0, 1); PG8_SCHED; PG8_LDA(At, 0, 0); PG8_STAGE(PG8_SA(1, 1), a1 + hstep, voffA);
            PG8_WAIT_V(8); PG8_WAIT_L(0); PG8_BAR; PG8_MMA(0, 0, At, B0); PG8_MMA(0, 1, At, B1); PG8_BAR; PG8_SCHED;
            PG8_LDA(At, 0, 1); PG8_STAGE(PG8_SB(0, 0), b2, voffB); PG8_STAGE(PG8_SB(0, 1), b2 + hstep, voffB); PG8_STAGE(PG8_SA(0, 0), a2, voffA);
            PG8_WAIT_V(8); PG8_WAIT_L(0); PG8_BAR; PG8_MMA(1, 0, At, B0); PG8_MMA(1, 1, At, B1); PG8_BAR; PG8_SCHED;
            PG8_LDB(B0, 1, 0); PG8_LDB(B1, 1, 1); PG8_SCHED; PG8_LDA(At, 1, 0); PG8_STAGE(PG8_SA(0, 1), a2 + hstep, voffA);
            PG8_WAIT_V(8); PG8_WAIT_L(0); PG8_BAR; PG8_MMA(0, 0, At, B0); PG8_MMA(0, 1, At, B1); PG8_BAR; PG8_SCHED;
            PG8_LDA(At, 1, 1); PG8_STAGE(PG8_SB(1, 0), b3, voffB); PG8_STAGE(PG8_SB(1, 1), b3 + hstep, voffB); PG8_STAGE(PG8_SA(1, 0), a3, voffA);
            PG8_WAIT_V(8); PG8_WAIT_L(0); PG8_BAR; PG8_MMA(1, 0, At, B0); PG8_MMA(1, 1, At, B1); PG8_BAR; PG8_SCHED;
            } else {
            PG8_LDB(B0, 0, 0); PG8_SCHED; PG8_LDA(At, 0, 0); PG8_STAGE(PG8_SA(1, 1), a1 + hstep, voffA);
            PG8_WAIT_L(8); PG8_BAR; PG8_WAIT_L(0); PG8_MMA(0, 0, At, B0); PG8_BAR; PG8_SCHED;
            PG8_LDB(B1, 0, 1); PG8_STAGE(PG8_SB(0, 0), b2, voffB);
            PG8_BAR; PG8_WAIT_L(0); PG8_MMA(0, 1, At, B1); PG8_BAR;
            PG8_LDA(At, 0, 1); PG8_STAGE(PG8_SA(0, 0), a2, voffA);
            PG8_BAR; PG8_WAIT_L(0); PG8_MMA(1, 0, At, B0); PG8_BAR; PG8_SCHED;
            PG8_STAGE(PG8_SB(0, 1), b2 + hstep, voffB);
            PG8_WAIT_V(6); PG8_BAR; PG8_MMA(1, 1, At, B1); PG8_BAR;
            PG8_LDB(B0, 1, 0); PG8_SCHED; PG8_LDA(At, 1, 0); PG8_STAGE(PG8_SA(0, 1), a2 + hstep, voffA);
            PG8_WAIT_L(8); PG8_BAR; PG8_WAIT_L(0); PG8_MMA(0, 0, At, B0); PG8_BAR; PG8_SCHED;
            PG8_LDB(B1, 1, 1); PG8_STAGE(PG8_SB(1, 0), b3, voffB);
            PG8_BAR; PG8_WAIT_L(0); PG8_MMA(0, 1, At, B1); PG8_BAR;
            PG8_LDA(At, 1, 1); PG8_STAGE(PG8_SA(1, 0), a3, voffA);
            PG8_BAR; PG8_WAIT_L(0); PG8_MMA(1, 0, At, B0); PG8_BAR; PG8_SCHED;
            PG8_STAGE(PG8_SB(1, 1), b3 + hstep, voffB);
            PG8_WAIT_V(6); PG8_BAR; PG8_MMA(1, 1, At, B1); PG8_BAR;
            }
        }
        if constexpr (ALIGN_EPI) { if (wr == 0) PG8_BAR; }
        if constexpr (!Epi::AFTER_DRAIN) { E(acc, cur, wr, wc, fr, fq); S.done(cur); }
        if (!has_next) break;
#pragma unroll
        for (int a = 0; a < 2; ++a)
#pragma unroll
            for (int b = 0; b < 2; ++b)
#pragma unroll
                for (int m = 0; m < 4; ++m)
#pragma unroll
                    for (int n = 0; n < 2; ++n) acc[a][b][m][n] = (f32x4){0.f, 0.f, 0.f, 0.f};
        cur = nxt; cA = nA; cB = nB; ++ui;
        if constexpr (ALIGN_EPI) { if (wr == 1) PG8_BAR; }
    }
    PG8_WAIT_V(0);
    if constexpr (!ALIGN_EPI) { if (wr == 0) PG8_BAR; }
    PG8_BAR;
    if constexpr (Epi::AFTER_DRAIN) { E.fused(acc, cur, wr, wc, fr, fq, lds, wid, lane); S.done(cur); }
#undef PG8_SA
#undef PG8_SB
#undef PG8_STAGE
#undef PG8_LDA
#undef PG8_LDB
#undef PG8_MMA
#undef PG8_WAIT_V
#undef PG8_WAIT_L
#undef PG8_BAR
#undef PG8_SCHED
}
}

namespace pg8 {
struct EpiProj {
    static constexpr bool PERM = true, AFTER_DRAIN = false;
    bf16_t* H; const float* g; const float* gd;
    const float* rowss;
    __device__ __forceinline__ void operator()(const f32x4 (&acc)[2][2][4][2], const Unit& u, int wr, int wc, int fr, int fq) const {
        const int pn = u.pn;
        int mode = 0; const float* gain = nullptr;
        const float qs = (pn == 0 || pn == 3 || pn == 8) ? 0.125f * 1.4426950408889634f : (pn == 5 ? 0.17677669529663687f * 1.4426950408889634f : 1.f);
        if (pn == 0) { mode = 1; gain = g; } else if (pn == 1) { mode = 1; gain = g + 64; } else if (pn == 3) { mode = 1; gain = g + 128; }
        else if (pn == 4) { if (wc < 2) { mode = 1; gain = g + 192; } }
        else if (pn == 5) { mode = 2; gain = gd; } else if (pn == 6) { mode = 2; gain = gd + 32; }
        else if (pn == 8) { mode = 1; gain = g + 256; }
        else if (pn == 9) { if (wc == 2) { mode = 1; gain = g + 384; } }
        else if (pn == 10) { if (wc == 0) { mode = 1; gain = g + 448; } else if (wc == 2) mode = 4; }
        else if (pn >= 11) mode = 3;
        f32x4 gv[2][2];
#pragma unroll
        for (int bj = 0; bj < 2; ++bj)
#pragma unroll
            for (int n = 0; n < 2; ++n) gv[bj][n] = (f32x4){1.f, 1.f, 1.f, 1.f};
        if (mode == 1) {
#pragma unroll
            for (int bj = 0; bj < 2; ++bj)
#pragma unroll
                for (int n = 0; n < 2; ++n) gv[bj][n] = *(const f32x4*)(gain + 32 * bj + 8 * fq + 4 * n);
        } else if (mode == 2) {
#pragma unroll
            for (int bj = 0; bj < 2; ++bj)
#pragma unroll
                for (int n = 0; n < 2; ++n) gv[bj][n] = *(const f32x4*)(gain + 8 * fq + 4 * n);
        }
        const int col0 = pn * BM + 64 * wc + 8 * fq;
#pragma unroll
        for (int ai = 0; ai < 2; ++ai)
#pragma unroll
            for (int m = 0; m < 4; ++m) {
                const int row = u.pm * BM + ai * HALF + wr * 64 + m * 16 + fr;
                f32x4 v[2][2];
                const float rsc = rowss ? rsqrtf((float)((const unsigned long long*)rowss)[row] * (1.f / (1048576.f * 1024.f)) + 1e-6f) : 1.f;
#pragma unroll
                for (int bj = 0; bj < 2; ++bj)
#pragma unroll
                    for (int n = 0; n < 2; ++n) v[bj][n] = acc[ai][bj][m][n] * rsc;
                if (mode == 1 || mode == 2) {
                    float s0 = 0.f, s1 = 0.f;
#pragma unroll
                    for (int n = 0; n < 2; ++n) {
                        s0 += v[0][n][0] * v[0][n][0] + v[0][n][1] * v[0][n][1] + v[0][n][2] * v[0][n][2] + v[0][n][3] * v[0][n][3];
                        s1 += v[1][n][0] * v[1][n][0] + v[1][n][1] * v[1][n][1] + v[1][n][2] * v[1][n][2] + v[1][n][3] * v[1][n][3];
                    }
                    s0 += __shfl_xor(s0, 16); s0 += __shfl_xor(s0, 32);
                    s1 += __shfl_xor(s1, 16); s1 += __shfl_xor(s1, 32);
                    float r0, r1;
                    if (mode == 1) { r0 = r1 = rsqrtf((s0 + s1) * (1.f / 64.f) + 1e-6f) * qs; }
                    else { r0 = rsqrtf(s0 * (1.f / 32.f) + 1e-6f) * qs; r1 = rsqrtf(s1 * (1.f / 32.f) + 1e-6f) * qs; }
#pragma unroll
                    for (int n = 0; n < 2; ++n) { v[0][n] = v[0][n] * r0 * gv[0][n]; v[1][n] = v[1][n] * r1 * gv[1][n]; }
                } else if (mode == 3) {
#pragma unroll
                    for (int bj = 0; bj < 2; ++bj)
#pragma unroll
                        for (int n = 0; n < 2; ++n)
#pragma unroll
                            for (int e = 0; e < 4; ++e) { const float x = v[bj][n][e]; v[bj][n][e] = x * __builtin_amdgcn_rcpf(1.f + __expf(-x)); }
                } else if (mode == 4) {
#pragma unroll
                    for (int bj = 0; bj < 2; ++bj)
#pragma unroll
                        for (int n = 0; n < 2; ++n)
#pragma unroll
                            for (int e = 0; e < 4; ++e) { const float x = v[bj][n][e]; v[bj][n][e] = __builtin_amdgcn_rcpf(1.f + __expf(-x)); }
                }
                bf16_t* rowp = H + (size_t)row * 3840 + col0;
#pragma unroll
                for (int bj = 0; bj < 2; ++bj) {
                    u32x4 w; w.x = cvt_pk_bf16(v[bj][0][0], v[bj][0][1]); w.y = cvt_pk_bf16(v[bj][0][2], v[bj][0][3]);
                    w.z = cvt_pk_bf16(v[bj][1][0], v[bj][1][1]); w.w = cvt_pk_bf16(v[bj][1][2], v[bj][1][3]);
                    *(u32x4*)(rowp + 32 * bj) = w;
                }
            }
    }
};
struct EpiOut {
    static constexpr bool PERM = false, AFTER_DRAIN = false;
    const float* xprev32;
    const bf16_t* xprev16;
    float* out;
    PG8_LAS float* exch;
    bf16_t* x1b; float* rowss;
    __device__ __forceinline__ void operator()(const f32x4 (&acc)[2][2][4][2], const Unit& u, int wr, int wc, int fr, int fq) const {
        const int col0 = u.pn * BM + wc * 32 + 4 * fq;
        const bool first = xprev32 != nullptr;
#pragma unroll
        for (int ai = 0; ai < 2; ++ai)
#pragma unroll
            for (int m = 0; m < 4; ++m) {
                const int row = u.pm * BM + ai * HALF + wr * 64 + m * 16 + fr;
                const size_t off = (size_t)row * 1024 + col0;
                float ss = 0.f;
#pragma unroll
                for (int bj = 0; bj < 2; ++bj)
#pragma unroll
                    for (int n = 0; n < 2; ++n) {
                        if (first) {
                            const f32x4 b = *(const f32x4*)(xprev32 + off + bj * HALF + n * 16);
                            const f32x4 v = b + acc[ai][bj][m][n];
                            ss += (v[0] * v[0] + v[1] * v[1]) + (v[2] * v[2] + v[3] * v[3]);
                            uint2 o; o.x = cvt_pk_bf16(v[0], v[1]); o.y = cvt_pk_bf16(v[2], v[3]);
                            *(uint2*)(x1b + off + bj * HALF + n * 16) = o;
                        } else {
                            const uint2 r = *(const uint2*)(xprev16 + off + bj * HALF + n * 16);
                            const f32x4 b = (f32x4){__uint_as_float(r.x << 16), __uint_as_float(r.x & 0xffff0000u), __uint_as_float(r.y << 16), __uint_as_float(r.y & 0xffff0000u)};
                            *(f32x4*)(out + off + bj * HALF + n * 16) = b + acc[ai][bj][m][n];
                        }
                    }
                if (first) {
                    ss += __shfl_xor(ss, 16); ss += __shfl_xor(ss, 32);
                    if (fq == 0) exch[(ai * HALF + wr * 64 + m * 16 + fr) * 4 + wc] = ss;
                }
            }
        if (first) {
            asm volatile("s_waitcnt lgkmcnt(0)" ::: "memory"); __builtin_amdgcn_s_barrier(); asm volatile("" ::: "memory");
            if (wc == 0) {
                const int lane = fq * 16 + fr;
#pragma unroll
                for (int k = 0; k < 2; ++k) {
                    const int rl = k * HALF + wr * 64 + lane;
                    const f32x4 p = *(const PG8_LAS f32x4*)(exch + rl * 4);
                    const float tot = (p[0] + p[1]) + (p[2] + p[3]);
                    atomicAdd((unsigned long long*)rowss + (u.pm * BM + rl), (unsigned long long)(tot * 1048576.f + 0.5f));
                }
            }
        }
    }
};
}

template <int MODE>
__device__ __forceinline__ void p0_transpose_item(const float* __restrict__ W, bf16_t* __restrict__ WT, LAS float* scr, int item, int lane, int KR = 1024, int NC = 1024, const float* __restrict__ gk = nullptr) {
    const int NSRC = MODE == 0 ? 3724 : NC, NG = MODE == 0 ? 120 : NC / 32;
    const int kb = item / NG, nb = item % NG, k0 = 64 * kb, hc0 = 32 * nb;
    const int hc = hc0 + (lane & 31);
    int src = hc;
    if (MODE == 0) src = hc < 2700 ? hc : (hc < 2816 ? -1 : hc - 116);
#pragma unroll 8
    for (int i = 0; i < 32; ++i) { const int kk = 2 * i + (lane >> 5); float wv = src >= 0 ? W[(size_t)(k0 + kk) * NSRC + src] : 0.f; if (MODE == 0) wv *= gk[k0 + kk]; scr[kk * 33 + (lane & 31)] = wv; }
    asm volatile("s_waitcnt lgkmcnt(0)" ::: "memory");
    const int c = lane & 7;
#pragma unroll
    for (int j = 0; j < 4; ++j) {
        const int n = (lane >> 3) + 8 * j; const LAS float* s = scr + (8 * c) * 33 + n;
        const int hcn = hc0 + n;
        int drow = hcn;
        if (MODE == 0) drow = (hcn & ~255) + ((hcn >> 5) & 1) * 128 + ((hcn >> 6) & 3) * 32 + (hcn & 31);
        uint4 o; o.x = (unsigned)f2bf(s[0]) | ((unsigned)f2bf(s[33]) << 16); o.y = (unsigned)f2bf(s[66]) | ((unsigned)f2bf(s[99]) << 16);
        o.z = (unsigned)f2bf(s[132]) | ((unsigned)f2bf(s[165]) << 16); o.w = (unsigned)f2bf(s[198]) | ((unsigned)f2bf(s[231]) << 16);
        if (MODE == 2) { const int k = k0 + 8 * c; *(uint4*)(WT + ((size_t)((((drow >> 5) * 8 + (k >> 8)) * 16 + ((k >> 4) & 15)) * 64 + ((k >> 3) & 1) * 32 + (drow & 31))) * 8) = o; }
        else *(uint4*)(WT + (size_t)drow * KR + k0 + 8 * c) = o;
    }
    asm volatile("s_waitcnt lgkmcnt(0)" ::: "memory");
}

namespace att {
typedef short bf16x8 __attribute__((ext_vector_type(8)));
typedef short v4i16 __attribute__((ext_vector_type(4)));
typedef float f32x16 __attribute__((ext_vector_type(16)));
typedef float f32x2_t __attribute__((ext_vector_type(2)));
typedef __bf16 bf16x2_t __attribute__((ext_vector_type(2)));
typedef unsigned u32x4 __attribute__((ext_vector_type(4)));
typedef float f32x4 __attribute__((ext_vector_type(4)));
__device__ __forceinline__ unsigned cvtpk(float lo, float hi) { f32x2_t v = {lo, hi}; bf16x2_t b = __builtin_convertvector(v, bf16x2_t); return __builtin_bit_cast(unsigned, b); }
__device__ __forceinline__ int crow(int r, int h) { return (r & 3) + 8 * (r >> 2) + 4 * h; }
constexpr float LOG2E = 1.4426950408889634f;
constexpr int L_KV = 0, KVB = 16384  , L_TAB = 32768  , L_WSCR = 83968  , L_IMP = 92160  , L_Q = 124928, L_SEL = 125184  , L_SB = 126464  ;

struct StageRegs { u32x4 k, v; };
__device__ __forceinline__ void stage_load(StageRegs& sr, const bf16_t* kp, const bf16_t* vp, bool valid, int ch) {
    sr.k = (u32x4){0u, 0u, 0u, 0u}; sr.v = sr.k;
    if (valid) { sr.k = *(const u32x4*)(kp + ch * 8); sr.v = *(const u32x4*)(vp + ch * 8); }
}
__device__ __forceinline__ void stage_write(LAS unsigned char* buf, const StageRegs& sr, int row, int ch) {
    *(LAS u32x4*)(buf + row * 128 + ((ch ^ (row & 7)) << 4)) = sr.k;
    *(LAS u32x4*)(buf + 8192 + (ch >> 2) * 4096 + row * 64 + (ch & 3) * 16) = sr.v;
}
__device__ __forceinline__ f32x16 load_tab16(const LAS float* tbl, int TSP, int jb) {
    const int sh = jb & 3; const LAS float* tp = tbl + sh * TSP + (jb - sh);
    const f32x4 t0 = *(const LAS f32x4*)(tp), t1 = *(const LAS f32x4*)(tp + 8), t2 = *(const LAS f32x4*)(tp + 16), t3 = *(const LAS f32x4*)(tp + 24);
    return (f32x16){t0[0], t0[1], t0[2], t0[3], t1[0], t1[1], t1[2], t1[3], t2[0], t2[1], t2[2], t2[3], t3[0], t3[1], t3[2], t3[3]};
}
__device__ __forceinline__ float exp_sum16(f32x16& acc) {
    float sa = 0.f, sb = 0.f;
#pragma unroll
    for (int r = 0; r < 16; r += 2) {
        acc[r] = __builtin_amdgcn_exp2f(acc[r]); acc[r + 1] = __builtin_amdgcn_exp2f(acc[r + 1]);
        sa += acc[r]; asm volatile("" : "+v"(sa)); sb += acc[r + 1]; asm volatile("" : "+v"(sb));
    }
    return sa + sb;
}
__device__ __forceinline__ f32x16 splat16(float v) { return (f32x16){v, v, v, v, v, v, v, v, v, v, v, v, v, v, v, v}; }
template <int S0, int S1>
__device__ __forceinline__ void qk_sub(f32x16& acc, const LAS unsigned char* buf, int sub, const bf16x8* qf, int lane) {
    const int key = 32 * sub + (lane & 31), h = lane >> 5;
    bf16x8 kf[S1 - S0];
#pragma unroll
    for (int s = S0; s < S1; ++s) kf[s - S0] = *(const LAS bf16x8*)(buf + key * 128 + (((2 * s + h) ^ (key & 7)) << 4));
    __builtin_amdgcn_sched_barrier(0);
#pragma unroll
    for (int s = S0; s < S1; ++s) acc = __builtin_amdgcn_mfma_f32_32x32x16_bf16(kf[s - S0], qf[s], acc, 0, 0, 0);
}
__device__ __forceinline__ void pack_p(const f32x16& p, bf16x8& pa0, bf16x8& pa1) {
    u32x4 w0, w1;
    w0.x = cvtpk(p[0], p[1]); w0.y = cvtpk(p[2], p[3]); w0.z = cvtpk(p[4], p[5]); w0.w = cvtpk(p[6], p[7]);
    w1.x = cvtpk(p[8], p[9]); w1.y = cvtpk(p[10], p[11]); w1.z = cvtpk(p[12], p[13]); w1.w = cvtpk(p[14], p[15]);
    pa0 = __builtin_bit_cast(bf16x8, w0); pa1 = __builtin_bit_cast(bf16x8, w1);
}
__device__ __forceinline__ void pv_sub(f32x16* o, const LAS unsigned char* buf, int sub, const bf16x8& pa0, const bf16x8& pa1, int lane) {
    const int h = lane >> 5, g16 = (lane >> 4) & 1, q4 = (lane & 15) >> 2, p4 = lane & 3;
    const LAS unsigned char* vb = buf + 8192 + (32 * sub + 4 * h + q4) * 64 + (16 * g16 + 4 * p4) * 2;
    bf16x8 vf[2][2];
#pragma unroll
    for (int dt = 0; dt < 2; ++dt) {
#pragma unroll
        for (int s2 = 0; s2 < 2; ++s2) {
            const v4i16 lo = __builtin_amdgcn_ds_read_tr16_b64_v4i16((LAS v4i16*)(vb + dt * 4096 + s2 * 1024));
            const v4i16 hi = __builtin_amdgcn_ds_read_tr16_b64_v4i16((LAS v4i16*)(vb + dt * 4096 + s2 * 1024 + 512));
            vf[dt][s2] = (bf16x8){lo[0], lo[1], lo[2], lo[3], hi[0], hi[1], hi[2], hi[3]};
        }
    }
    __builtin_amdgcn_sched_barrier(0);
    o[0] = __builtin_amdgcn_mfma_f32_32x32x16_bf16(pa0, vf[0][0], o[0], 0, 0, 0);
    o[1] = __builtin_amdgcn_mfma_f32_32x32x16_bf16(pa0, vf[1][0], o[1], 0, 0, 0);
    o[0] = __builtin_amdgcn_mfma_f32_32x32x16_bf16(pa1, vf[0][1], o[0], 0, 0, 0);
    o[1] = __builtin_amdgcn_mfma_f32_32x32x16_bf16(pa1, vf[1][1], o[1], 0, 0, 0);
}

__device__ __forceinline__ void pv_sub2(f32x16* oa, f32x16* ob, const LAS unsigned char* buf, int sub, const bf16x8& a0, const bf16x8& a1, const bf16x8& b0, const bf16x8& b1, int lane) {
    const int h = lane >> 5, g16 = (lane >> 4) & 1, q4 = (lane & 15) >> 2, p4 = lane & 3;
    const LAS unsigned char* vb = buf + 8192 + (32 * sub + 4 * h + q4) * 64 + (16 * g16 + 4 * p4) * 2;
#pragma unroll
    for (int dt = 0; dt < 2; ++dt) {
#pragma unroll
        for (int s2 = 0; s2 < 2; ++s2) {
            const v4i16 lo = __builtin_amdgcn_ds_read_tr16_b64_v4i16((LAS v4i16*)(vb + dt * 4096 + s2 * 1024));
            const v4i16 hi = __builtin_amdgcn_ds_read_tr16_b64_v4i16((LAS v4i16*)(vb + dt * 4096 + s2 * 1024 + 512));
            const bf16x8 vf = (bf16x8){lo[0], lo[1], lo[2], lo[3], hi[0], hi[1], hi[2], hi[3]};
            oa[dt] = __builtin_amdgcn_mfma_f32_32x32x16_bf16(s2 == 0 ? a0 : a1, vf, oa[dt], 0, 0, 0);
            ob[dt] = __builtin_amdgcn_mfma_f32_32x32x16_bf16(s2 == 0 ? b0 : b1, vf, ob[dt], 0, 0, 0);
        }
    }
}

struct BandArgs {
    const bf16_t* Hb;
    int cq, ck, cv;
    int rate, cls, f0, maxd;
    const float* bias;
    float M;
    float sinkterm;
    bf16_t* OA; float* DA;
    bf16_t* Y; int ycol;
    int hd; size_t brow;
};
constexpr int B_TAB = 98304, B_WSCR = 106496;
template <int MODE>
__device__ __forceinline__ void banded_unit(LAS unsigned char* lds, const BandArgs& P) {
    const int tid = opq(threadIdx.x), lane = tid & 63, w = __builtin_amdgcn_readfirstlane(tid >> 6), h = lane >> 5;
    LAS float* sb = (LAS float*)(lds + L_SB);
    LAS float* tbl = (LAS float*)(lds + B_TAB);
    const int KPREV = ((P.maxd + 63) >> 6) << 6;
    const int t0 = (KPREV - P.f0) > 0 ? ((KPREV - P.f0) >> 6) : 0;
    const int srow = tid >> 3, sch = tid & 7;
    StageRegs sr[6];
#pragma unroll
    for (int i = 0; i < 6; ++i) {
        int kf = P.f0 - KPREV + 64 * i + srow; kf = kf < 0 ? 0 : kf;
        const bf16_t* rp = P.Hb + ((size_t)kf * P.rate + P.cls) * HP;
        stage_load(sr[i], rp + P.ck, rp + P.cv, true, sch);
    }
    const int fq0 = P.f0 + 32 * w;
    bf16x8 qf[4];
    {
        const size_t tq = (size_t)(fq0 + (lane & 31)) * P.rate + P.cls;
        const bf16_t* qp = P.Hb + tq * HP + P.cq + 8 * h;
#pragma unroll
        for (int s = 0; s < 4; ++s) qf[s] = *(const bf16x8*)(qp + 16 * s);
    }
    if (tid < 32) sb[tid] = (P.bias[tid * 16] - P.M) * LOG2E;
    __syncthreads();
    const int DMAXI = P.maxd + 62, TS = P.maxd + 125, TSP = (TS + 7) & ~3;
    for (int e = tid; e < 4 * TSP; e += 512) {
        const int sh = e / TSP, j = e - sh * TSP + sh, dist = DMAXI - j;
        tbl[e] = (j < TS && dist >= 0 && dist <= P.maxd) ? sb[t5_bucket(dist * P.rate)] : -1e30f;
    }
    f32x16 o[2]; o[0] = (f32x16){}; o[1] = (f32x16){};
    float den = 0.f;
#pragma unroll
    for (int i = 0; i < 6; ++i) stage_write(lds + i * KVB, sr[i], srow, sch);
    asm volatile("" : "+v"(qf[0]), "+v"(qf[1]), "+v"(qf[2]), "+v"(qf[3]));
    __syncthreads();
#pragma unroll 1
    for (int t = t0; t < 6; ++t) {
        const LAS unsigned char* buf = lds + t * KVB;
        const int kf0 = P.f0 - KPREV + 64 * t;
#pragma unroll
        for (int sub = 0; sub < 2; ++sub) {
            const int kfs = kf0 + 32 * sub;
            if (kfs <= fq0 + 31 && kfs + 31 >= fq0 - P.maxd) {
                const int jb = DMAXI - ((fq0 - kfs) + (lane & 31) - 4 * h);
                f32x16 acc = load_tab16(tbl, TSP, jb);
                qk_sub<0, 4>(acc, buf, sub, qf, lane);
                den += exp_sum16(acc);
                bf16x8 pa0, pa1; pack_p(acc, pa0, pa1);
                pv_sub(o, buf, sub, pa0, pa1, lane);
            }
        }
    }
    float dtot = den + __shfl_xor(den, 32);
    if (MODE == 1) dtot += P.sinkterm;
    LAS float* ws_ = (LAS float*)(lds + B_WSCR) + w * 64;
    if (h == 0) ws_[lane] = dtot;
    if (MODE == 0 && h == 0) {
        const size_t tq = (size_t)(fq0 + lane) * P.rate + P.cls;
        P.DA[(P.brow + tq) * 4 + P.hd] = dtot;
    }
    asm volatile("s_waitcnt lgkmcnt(0)" ::: "memory");
#pragma unroll
    for (int r = 0; r < 16; ++r) {
        const int qi = crow(r, h);
        const float inv = __builtin_amdgcn_rcpf(ws_[qi]);
        const size_t row = P.brow + (size_t)(fq0 + qi) * P.rate + P.cls;
#pragma unroll
        for (int dt = 0; dt < 2; ++dt) {
            const int d = 32 * dt + (lane & 31);
            const float val = o[dt][r] * inv;
            if (MODE == 0) P.OA[row * 256 + P.hd * 64 + d] = f2bf(val);
            else P.Y[row * DM + P.ycol + d] = f2bf(val * bf2f(P.Hb[(row - P.brow) * HP + C_SILU + P.ycol + d]));
        }
    }
}

__device__ __forceinline__ void diff_p1(const LAS float* tp, const LAS unsigned char* buf, int sub, const bf16x8* qf, int lane, bf16x8& pa0, bf16x8& pa1, bf16x8& pb0, bf16x8& pb1) {
    const f32x4 t0 = *(const LAS f32x4*)(tp), t1 = *(const LAS f32x4*)(tp + 8), t2 = *(const LAS f32x4*)(tp + 16), t3 = *(const LAS f32x4*)(tp + 24);
    const f32x16 T = (f32x16){t0[0], t0[1], t0[2], t0[3], t1[0], t1[1], t1[2], t1[3], t2[0], t2[1], t2[2], t2[3], t3[0], t3[1], t3[2], t3[3]};
    const int key = 32 * sub + (lane & 31), h = lane >> 5;
    const LAS unsigned char* kp = buf + key * 128;
    const bf16x8 k0 = *(const LAS bf16x8*)(kp + (((0 + h) ^ (key & 7)) << 4)), k1 = *(const LAS bf16x8*)(kp + (((2 + h) ^ (key & 7)) << 4));
    const bf16x8 k2 = *(const LAS bf16x8*)(kp + (((4 + h) ^ (key & 7)) << 4)), k3 = *(const LAS bf16x8*)(kp + (((6 + h) ^ (key & 7)) << 4));
    f32x16 a1 = __builtin_amdgcn_mfma_f32_32x32x16_bf16(k0, qf[0], T, 0, 0, 0);
    f32x16 a2 = __builtin_amdgcn_mfma_f32_32x32x16_bf16(k2, qf[2], T, 0, 0, 0);
    a1 = __builtin_amdgcn_mfma_f32_32x32x16_bf16(k1, qf[1], a1, 0, 0, 0);
    a2 = __builtin_amdgcn_mfma_f32_32x32x16_bf16(k3, qf[3], a2, 0, 0, 0);
#pragma unroll
    for (int r = 0; r < 16; ++r) { a1[r] = __builtin_amdgcn_exp2f(a1[r]); a2[r] = __builtin_amdgcn_exp2f(a2[r]); }
    pack_p(a1, pa0, pa1); pack_p(a2, pb0, pb1);
}
__device__ __forceinline__ void diff_p2(const LAS unsigned char* buf, int sub, int lane, const bf16x8& pa0, const bf16x8& pa1, const bf16x8& pb0, const bf16x8& pb1, f32x16& dn1, f32x16& dn2, f32x16* o1, f32x16* o2) {
    const bf16x8 ones = (bf16x8){0x3F80, 0x3F80, 0x3F80, 0x3F80, 0x3F80, 0x3F80, 0x3F80, 0x3F80};
    const int h = lane >> 5, g16 = (lane >> 4) & 1, q4 = (lane & 15) >> 2, p4 = lane & 3;
    const LAS unsigned char* vb = buf + 8192 + (32 * sub + 4 * h + q4) * 64 + (16 * g16 + 4 * p4) * 2;
    bf16x8 vf[2][2];
#pragma unroll
    for (int dt = 0; dt < 2; ++dt) {
#pragma unroll
        for (int s2 = 0; s2 < 2; ++s2) {
            const v4i16 lo = __builtin_amdgcn_ds_read_tr16_b64_v4i16((LAS v4i16*)(vb + dt * 4096 + s2 * 1024));
            const v4i16 hi = __builtin_amdgcn_ds_read_tr16_b64_v4i16((LAS v4i16*)(vb + dt * 4096 + s2 * 1024 + 512));
            vf[dt][s2] = (bf16x8){lo[0], lo[1], lo[2], lo[3], hi[0], hi[1], hi[2], hi[3]};
        }
    }
    __builtin_amdgcn_sched_barrier(0);
    dn1 = __builtin_amdgcn_mfma_f32_32x32x16_bf16(pa0, ones, dn1, 0, 0, 0);
    dn2 = __builtin_amdgcn_mfma_f32_32x32x16_bf16(pb0, ones, dn2, 0, 0, 0);
    dn1 = __builtin_amdgcn_mfma_f32_32x32x16_bf16(pa1, ones, dn1, 0, 0, 0);
    dn2 = __builtin_amdgcn_mfma_f32_32x32x16_bf16(pb1, ones, dn2, 0, 0, 0);
    o1[0] = __builtin_amdgcn_mfma_f32_32x32x16_bf16(pa0, vf[0][0], o1[0], 0, 0, 0);
    o2[0] = __builtin_amdgcn_mfma_f32_32x32x16_bf16(pb0, vf[0][0], o2[0], 0, 0, 0);
    o1[1] = __builtin_amdgcn_mfma_f32_32x32x16_bf16(pa0, vf[1][0], o1[1], 0, 0, 0);
    o2[1] = __builtin_amdgcn_mfma_f32_32x32x16_bf16(pb0, vf[1][0], o2[1], 0, 0, 0);
    o1[0] = __builtin_amdgcn_mfma_f32_32x32x16_bf16(pa1, vf[0][1], o1[0], 0, 0, 0);
    o2[0] = __builtin_amdgcn_mfma_f32_32x32x16_bf16(pb1, vf[0][1], o2[0], 0, 0, 0);
    o1[1] = __builtin_amdgcn_mfma_f32_32x32x16_bf16(pa1, vf[1][1], o1[1], 0, 0, 0);
    o2[1] = __builtin_amdgcn_mfma_f32_32x32x16_bf16(pb1, vf[1][1], o2[1], 0, 0, 0);
}

struct DiffArgs {
    const bf16_t* Hb; int hd, qb; size_t brow;
    const float* bias; float M; float lam, lambda_init; const float* subln;
    bf16_t* Y;
};
constexpr int D_SB = 49152, D_TAB = 49664;
__device__ __forceinline__ void diff_unit(LAS unsigned char* lds, const DiffArgs& P) {
    const int tid = opq(threadIdx.x), lane = tid & 63, w = __builtin_amdgcn_readfirstlane(tid >> 6), h = lane >> 5;
    LAS float* sb = (LAS float*)(lds + D_SB);
    LAS float* tbl = (LAS float*)(lds + D_TAB);
    constexpr int DTOP = 1574, TS = DTOP + 63, TSP = (TS + 7) & ~3;
    __syncthreads();
    if (tid < 32) sb[tid] = (P.bias[tid * 16] - P.M) * LOG2E;
    __syncthreads();
    for (int e = tid; e < 4 * TSP; e += 512) {
        const int sh = e / TSP, j = e - sh * TSP + sh, dist = DTOP - j;
        tbl[e] = (j < TS && dist >= 0) ? sb[t5_bucket(dist)] : -1e30f;
    }
    LAS float* farc = tbl + 4 * TSP;
    LAS float* deadr = farc + 32;
    if (tid < 32) { farc[tid] = sb[31]; deadr[tid] = -1e30f; }
    const int q0w = P.qb * 256 + 32 * w;
    const int cq = C_CQ + 64 * P.hd, ck = C_CK + 64 * P.hd, cv = C_CV + 64 * P.hd;
    bf16x8 qf[4];
    {
        const bf16_t* qp = P.Hb + (size_t)(q0w + (lane & 31)) * HP + cq + 8 * h;
#pragma unroll
        for (int s = 0; s < 4; ++s) qf[s] = *(const bf16x8*)(qp + 16 * s);
        asm volatile("" : "+v"(qf[0]), "+v"(qf[1]), "+v"(qf[2]), "+v"(qf[3]));
    }
    const int ntl = 4 * (P.qb + 1);
    const int srow = tid >> 3, sch = tid & 7;
    f32x16 o1[2], o2[2]; o1[0] = (f32x16){}; o1[1] = (f32x16){}; o2[0] = (f32x16){}; o2[1] = (f32x16){};
    f32x16 dn1 = (f32x16){}, dn2 = (f32x16){};
    StageRegs sr;
    {
        const bf16_t* rp = P.Hb + (size_t)srow * HP;
        stage_load(sr, rp + ck, rp + cv, true, sch);
        stage_write(lds, sr, srow, sch);
    }
    __syncthreads();
#define DIFF_TP(KS) ({ const int ks_ = (KS); const int jb_ = DTOP - ((q0w - ks_) + (lane & 31) - 4 * h), sh_ = jb_ & 3; \
        const LAS float* tp_ = tbl + sh_ * TSP + (jb_ - sh_); tp_ = (q0w - ks_ - 31 >= 1513) ? farc : tp_; tp_ = (ks_ > q0w + 31) ? deadr : tp_; tp_; })
#define DIFF_STAGE_LOAD(t) do { const int tn_ = (t) + 1 < ntl ? (t) + 1 : (t); const bf16_t* rp_ = P.Hb + (size_t)(64 * tn_ + srow) * HP; stage_load(sr, rp_ + ck, rp_ + cv, true, sch); } while (0)
    if (w < 4) {
        int cur = 0;
        for (int t = 0; t < ntl; ++t) {
            LAS unsigned char* buf = lds + cur * KVB;
            const int nxt = cur == 2 ? 0 : cur + 1;
            DIFF_STAGE_LOAD(t);
            bf16x8 pa0, pa1, pb0, pb1;
            diff_p1(DIFF_TP(64 * t), buf, 0, qf, lane, pa0, pa1, pb0, pb1);
            diff_p2(buf, 0, lane, pa0, pa1, pb0, pb1, dn1, dn2, o1, o2);
            diff_p1(DIFF_TP(64 * t + 32), buf, 1, qf, lane, pa0, pa1, pb0, pb1);
            diff_p2(buf, 1, lane, pa0, pa1, pb0, pb1, dn1, dn2, o1, o2);
            stage_write(lds + nxt * KVB, sr, srow, sch);
            __syncthreads();
            cur = nxt;
        }
    } else {
        const bf16x8 zero8 = (bf16x8){0, 0, 0, 0, 0, 0, 0, 0};
        bf16x8 qa0 = zero8, qa1 = zero8, qb0 = zero8, qb1 = zero8;
        int cur = 0, prv = 0;
        __builtin_amdgcn_s_setprio(1);
        for (int t = 0; t < ntl; ++t) {
            LAS unsigned char* buf = lds + cur * KVB;
            const int nxt = cur == 2 ? 0 : cur + 1;
            DIFF_STAGE_LOAD(t);
            diff_p2(lds + prv * KVB, 1, lane, qa0, qa1, qb0, qb1, dn1, dn2, o1, o2);
            bf16x8 pa0, pa1, pb0, pb1;
            diff_p1(DIFF_TP(64 * t), buf, 0, qf, lane, pa0, pa1, pb0, pb1);
            diff_p2(buf, 0, lane, pa0, pa1, pb0, pb1, dn1, dn2, o1, o2);
            diff_p1(DIFF_TP(64 * t + 32), buf, 1, qf, lane, qa0, qa1, qb0, qb1);
            stage_write(lds + nxt * KVB, sr, srow, sch);
            __syncthreads();
            prv = cur; cur = nxt;
        }
        diff_p2(lds + prv * KVB, 1, lane, qa0, qa1, qb0, qb1, dn1, dn2, o1, o2);
        __builtin_amdgcn_s_setprio(0);
    }
    __syncthreads();
#undef DIFF_TP
#undef DIFF_STAGE_LOAD
    const float g0 = P.subln[lane & 31] * (1.f - P.lambda_init), g1 = P.subln[32 + (lane & 31)] * (1.f - P.lambda_init);
    const int ycol = 512 + 64 * P.hd;
#pragma unroll
    for (int r = 0; r < 16; ++r) {
        const int qi = crow(r, h);
        const float i1 = __builtin_amdgcn_rcpf(dn1[r]), i2 = P.lam * __builtin_amdgcn_rcpf(dn2[r]);
        const float a0 = o1[0][r] * i1 - o2[0][r] * i2, a1 = o1[1][r] * i1 - o2[1][r] * i2;
        float ss = a0 * a0 + a1 * a1;
        ss += __shfl_xor(ss, 1); ss += __shfl_xor(ss, 2); ss += __shfl_xor(ss, 4); ss += __shfl_xor(ss, 8); ss += __shfl_xor(ss, 16);
        const float rs = rsqrtf(ss * (1.f / 64.f) + 1e-6f);
        const size_t trow = (size_t)(q0w + qi);
        const bf16_t* sp = P.Hb + trow * HP + C_SILU + ycol;
        bf16_t* yp = P.Y + (P.brow + trow) * DM + ycol;
        yp[lane & 31] = f2bf(a0 * rs * g0 * bf2f(sp[lane & 31]));
        yp[32 + (lane & 31)] = f2bf(a1 * rs * g1 * bf2f(sp[32 + (lane & 31)]));
    }
}
struct CmpArgs {
    const bf16_t* Hb;
    int col;
    int rt;
    const float* pos;
    const bf16_t* W1T;
    const float* b1;
    const bf16_t* W2T;
    const float* b2;
    const float* gain;
    bf16_t* OUT;
};
__device__ __forceinline__ void cmp_unit(LAS unsigned char* lds, const CmpArgs& P) {
    const int tid = opq(threadIdx.x), lane = tid & 63, w = __builtin_amdgcn_readfirstlane(tid >> 6), h = lane >> 5;
    LAS unsigned char* hidl = lds + L_KV;
    LAS float* ssx = (LAS float*)(lds + L_KV + 32768 - 512);
    LAS unsigned char* abuf = lds + L_TAB;
    f32x16 acc = (f32x16){};
    const bf16_t* w1p = P.W1T + (size_t)w * (8 * 16 * 64 * 8) + lane * 8;
    u32x4 araw[2]; f32x4 apos[2][2];
#define CMP_ALOAD(ch) do { _Pragma("unroll") for (int q_ = 0; q_ < 2; ++q_) { const int p_ = tid + 512 * q_, row_ = p_ >> 5, kc_ = p_ & 31; \
        int ir_ = 32 * P.rt + row_; if (ir_ > 510) ir_ = 510; const int tok_ = 4 * (ch) + (kc_ >> 3), d_ = 8 * (kc_ & 7); \
        araw[q_] = *(const u32x4*)(P.Hb + (size_t)(16 * ir_ + tok_) * HP + P.col + d_); \
        apos[q_][0] = *(const f32x4*)(P.pos + tok_ * 64 + d_); apos[q_][1] = *(const f32x4*)(P.pos + tok_ * 64 + d_ + 4); } } while (0)
#define CMP_AWRITE(bufi) do { _Pragma("unroll") for (int q_ = 0; q_ < 2; ++q_) { const int p_ = tid + 512 * q_, row_ = p_ >> 5, kc_ = p_ & 31; u32x4 aw_; \
        aw_.x = cvtpk(__uint_as_float(araw[q_].x << 16) + apos[q_][0][0], __uint_as_float(araw[q_].x & 0xffff0000u) + apos[q_][0][1]); \
        aw_.y = cvtpk(__uint_as_float(araw[q_].y << 16) + apos[q_][0][2], __uint_as_float(araw[q_].y & 0xffff0000u) + apos[q_][0][3]); \
        aw_.z = cvtpk(__uint_as_float(araw[q_].z << 16) + apos[q_][1][0], __uint_as_float(araw[q_].z & 0xffff0000u) + apos[q_][1][1]); \
        aw_.w = cvtpk(__uint_as_float(araw[q_].w << 16) + apos[q_][1][2], __uint_as_float(araw[q_].w & 0xffff0000u) + apos[q_][1][3]); \
        *(LAS u32x4*)(abuf + (bufi) * 16896 + row_ * 528 + kc_ * 16) = aw_; } } while (0)
    CMP_ALOAD(0); CMP_AWRITE(0);
    __syncthreads();
    for (int ch = 0; ch < 8; ++ch) {
        const int cn = ch + 1 < 8 ? ch + 1 : ch;
        CMP_ALOAD(cn);
        const LAS unsigned char* ab = abuf + (ch & 1) * 16896 + (lane & 31) * 528 + 16 * h;
        bf16x8 bfr[16];
#pragma unroll
        for (int ks = 0; ks < 16; ++ks) bfr[ks] = *(const bf16x8*)(w1p + (ch * 16 + ks) * 512);
#pragma unroll
        for (int ks = 0; ks < 16; ++ks) {
            const bf16x8 af = *(const LAS bf16x8*)(ab + 32 * ks);
            acc = __builtin_amdgcn_mfma_f32_32x32x16_bf16(af, bfr[ks], acc, 0, 0, 0);
        }
        CMP_AWRITE((ch + 1) & 1);
        __syncthreads();
    }
#undef CMP_ALOAD
#undef CMP_AWRITE
    {
        const int j = 32 * w + (lane & 31); const float bb = P.b1[j];
#pragma unroll
        for (int r = 0; r < 16; ++r) {
            const float x = acc[r] + bb;
            const float u = 0.7978845608028654f * (x + 0.044715f * x * x * x);
            const float th = 1.f - 2.f / (1.f + __expf(2.f * u));
            const float gl = 0.5f * x * (1.f + th);
            *(LAS bf16_t*)(hidl + crow(r, h) * 528 + j * 2) = f2bf(gl);
        }
    }
    __syncthreads();
    float outv[16]; float ssp[16];
    if (w < 2) {
        f32x16 a2 = (f32x16){};
        const bf16_t* w2p = P.W2T + (size_t)(32 * w + (lane & 31)) * 256 + 8 * h;
#pragma unroll
        for (int ks = 0; ks < 16; ++ks) {
            const bf16x8 af = *(const LAS bf16x8*)(hidl + (lane & 31) * 528 + (16 * ks + 8 * h) * 2);
            const bf16x8 bfr = *(const bf16x8*)(w2p + 16 * ks);
            a2 = __builtin_amdgcn_mfma_f32_32x32x16_bf16(af, bfr, a2, 0, 0, 0);
        }
        const float bb = P.b2[32 * w + (lane & 31)];
#pragma unroll
        for (int r = 0; r < 16; ++r) {
            outv[r] = a2[r] + bb;
            float ss = outv[r] * outv[r];
            ss += __shfl_xor(ss, 1); ss += __shfl_xor(ss, 2); ss += __shfl_xor(ss, 4); ss += __shfl_xor(ss, 8); ss += __shfl_xor(ss, 16);
            ssp[r] = ss;
            if ((lane & 31) == 0) ssx[w * 32 + crow(r, h)] = ss;
        }
    }
    __syncthreads();
    if (w < 2) {
        const int d = 32 * w + (lane & 31);
        const float gn = P.gain ? P.gain[d] : 1.f;
#pragma unroll
        for (int r = 0; r < 16; ++r) {
            const int row = 32 * P.rt + crow(r, h);
            float v = outv[r];
            if (P.gain) { const float tot = ssx[crow(r, h)] + ssx[32 + crow(r, h)]; v = v * rsqrtf(tot * (1.f / 64.f) + 1e-6f) * gn; }
            if (row <= 510) P.OUT[(size_t)row * 64 + d] = f2bf(v);
        }
    }
    __syncthreads();
}

struct NsaArgs {
    const bf16_t* Hb; size_t brow; int qb;
    const bf16_t* KC; const bf16_t* VC;
    const float* bias;
    const float* Mv;
    bf16_t* Y; unsigned* cdone;
    float* scr;
};
constexpr int GTOP = 2015, GTS = 2519, WTOP = 549, WTS = 588, DEAD = 4 * GTS + 4 * WTS;
__device__ __forceinline__ void nsa_unit(LAS unsigned char* lds, const NsaArgs& P) {
    const int tid = opq(threadIdx.x), lane = tid & 63, w = __builtin_amdgcn_readfirstlane(tid >> 6), hh = lane >> 5;
    const int n = lane & 31, q8 = n >> 2, hd = n & 3;
    LAS float* tg = (LAS float*)(lds + L_TAB);
    LAS float* tw = tg + 4 * GTS;
    LAS float* dead = tg + DEAD;
    LAS float* impw = (LAS float*)(lds + L_IMP) + w * 1024;
    LAS unsigned* selw = (LAS unsigned*)(lds + L_SEL) + w * 32;
    LAS unsigned* uni = (LAS unsigned*)(lds + L_SEL) + 256;
    LAS float* ws_ = (LAS float*)(lds + L_WSCR) + w * 256;
    LAS float* sbh = (LAS float*)(lds + L_SB);
    if (tid < 128) sbh[tid] = (P.bias[(tid & 31) * 16 + (tid >> 5)] - P.Mv[tid >> 5]) * LOG2E;
    __syncthreads();
    for (int e = tid; e < 4 * GTS; e += 512) { const int hq = e / GTS, j = e % GTS, dist = GTOP - j;
        tg[e] = dist >= 0 ? sbh[hq * 32 + t5_bucket(dist)] : -1e30f; }
    for (int e = tid; e < 4 * WTS; e += 512) { const int hq = e / WTS, j = e % WTS, dist = WTOP - j;
        tw[e] = (dist >= 0 && dist <= 511) ? sbh[hq * 32 + t5_bucket(dist)] : -1e30f; }
    if (tid < 64) dead[tid] = -1e30f;
    for (int e = lane; e < 1024; e += 64) impw[e] = 0.f;
    if (tid < 4) uni[tid] = 0u;
    const float cfar = sbh[hd * 32 + 31];
    const int tq = 64 * P.qb + 8 * w + q8;
    const int twmin = 64 * P.qb + 8 * w, twmax = twmin + 7;
    bf16x8 qf[4];
    {
        const bf16_t* qp = P.Hb + (size_t)tq * HP + C_DQ + 64 * hd + 8 * hh;
#pragma unroll
        for (int s = 0; s < 4; ++s) qf[s] = *(const bf16x8*)(qp + 16 * s);
        asm volatile("" : "+v"(qf[0]), "+v"(qf[1]), "+v"(qf[2]), "+v"(qf[3]));
    }
    {
        const bf16_t* gp = P.Hb + (size_t)tq * HP + C_GT + 3 * hd;
        if (hh == 0) { ws_[n] = bf2f(gp[0]); ws_[32 + n] = bf2f(gp[1]); ws_[64 + n] = bf2f(gp[2]); }
    }
    const int srow = tid >> 3, sch = tid & 7;
    StageRegs sr;
    f32x16 o[2], outv[2];
    float den = 0.f;
    o[0] = (f32x16){}; o[1] = (f32x16){};
    {
        const int kt0 = P.qb >= 8 ? P.qb - 8 : 0, nkt = P.qb - kt0 + 1;
        {
            const bf16_t* rp = P.Hb + (size_t)(64 * kt0 + srow) * HP;
            stage_load(sr, rp + C_KW, rp + C_VW, true, sch);
            stage_write(lds + L_KV, sr, srow, sch);
        }
        __syncthreads();
        for (int t = 0; t < nkt; ++t) {
            LAS unsigned char* buf = lds + L_KV + (t & 1) * KVB;
            if (t + 1 < nkt) { const bf16_t* rp = P.Hb + (size_t)(64 * (kt0 + t + 1) + srow) * HP; stage_load(sr, rp + C_KW, rp + C_VW, true, sch); }
#pragma unroll
            for (int sub = 0; sub < 2; ++sub) {
                const int kb = 64 * (kt0 + t) + 32 * sub;
                if (kb <= twmax && kb + 31 >= twmin - 511) {
                    f32x16 acc;
                    const LAS float* tb = tw + hd * WTS + (WTOP - (tq - kb - 4 * hh));
#pragma unroll
                    for (int r = 0; r < 16; ++r) acc[r] = tb[(r & 3) + 8 * (r >> 2)];
                    qk_sub<0, 4>(acc, buf, sub, qf, lane);
#pragma unroll
                    for (int r = 0; r < 1; ++r) den += exp_sum16(acc);
                    bf16x8 pa0, pa1; pack_p(acc, pa0, pa1);
                    pv_sub(o, buf, sub, pa0, pa1, lane);
                }
            }
            if (t + 1 < nkt) stage_write(lds + L_KV + ((t + 1) & 1) * KVB, sr, srow, sch);
            __syncthreads();
        }
    }
    {
        const float dt = den + __shfl_xor(den, 32);
        if (hh == 0) ws_[128 + n] = __builtin_amdgcn_rcpf(dt);
        asm volatile("s_waitcnt lgkmcnt(0)" ::: "memory");
#pragma unroll
        for (int r = 0; r < 16; ++r) { const int nn = crow(r, hh); const float gi = ws_[64 + nn] * ws_[128 + nn]; outv[0][r] = o[0][r] * gi; outv[1][r] = o[1][r] * gi; }
    }
    if (opq(threadIdx.x) == 128) {
        unsigned sp = 0;
        while (__hip_atomic_load(P.cdone, __ATOMIC_RELAXED, __HIP_MEMORY_SCOPE_AGENT) < 64u) { __builtin_amdgcn_s_sleep(2); if (++sp > (1u << 24)) break; }
        __builtin_amdgcn_fence(__ATOMIC_ACQUIRE, "agent"); asm volatile("s_waitcnt vmcnt(0)" ::: "memory");
    }
    __syncthreads();
    const int tlast = 64 * P.qb + 63;
    const int ntc = tlast >= 31 ? (((tlast - 31) >> 4) >> 6) + 1 : 0;
    float invden = 0.f; den = 0.f;
    o[0] = (f32x16){}; o[1] = (f32x16){};
    for (int pass = 0; pass < 2; ++pass) {
        if (ntc > 0) {
            __syncthreads();
            stage_load(sr, P.KC + (size_t)srow * 64, P.VC + (size_t)srow * 64, true, sch);
            stage_write(lds + L_KV, sr, srow, sch);
            __syncthreads();
            for (int t = 0; t < ntc; ++t) {
                LAS unsigned char* buf = lds + L_KV + (t & 1) * KVB;
                if (t + 1 < ntc) stage_load(sr, P.KC + (size_t)(64 * (t + 1) + srow) * 64, P.VC + (size_t)(64 * (t + 1) + srow) * 64, true, sch);
#pragma unroll
                for (int sub = 0; sub < 2; ++sub) {
                    const int cb = 64 * t + 32 * sub;
                    if (16 * cb + 31 <= twmax) {
                        f32x16 acc;
                        const int dmin = twmin - 16 * (cb + 31) - 31;
                        if (dmin >= 1513) acc = splat16(cfar);
                        else {
                            const LAS float* tb = tg + hd * GTS + (GTOP - (tq - 31 - 16 * cb - 64 * hh));
#pragma unroll
                            for (int r = 0; r < 16; ++r) acc[r] = tb[16 * ((r & 3) + 8 * (r >> 2))];
                        }
                        qk_sub<0, 4>(acc, buf, sub, qf, lane);
#pragma unroll
                        for (int r = 0; r < 16; ++r) acc[r] = __builtin_amdgcn_exp2f(acc[r]);
                        if (pass == 0) {
#pragma unroll
                            for (int r = 0; r < 16; ++r) { den += acc[r]; asm volatile("" : "+v"(den)); }
                        } else {
#pragma unroll
                            for (int r = 0; r < 16; ++r) acc[r] *= invden;
#pragma unroll
                            for (int g = 0; g < 4; ++g) {
                                float G = (acc[4 * g] + acc[4 * g + 1]) + (acc[4 * g + 2] + acc[4 * g + 3]), C = acc[4 * g + 3];
                                G += __shfl_xor(G, 1); G += __shfl_xor(G, 2); C += __shfl_xor(C, 1); C += __shfl_xor(C, 2);
                                if (hd == 0) {
                                    const int j = (cb >> 2) + 2 * g + hh;
                                    __hip_atomic_fetch_add(impw + q8 * 128 + j, G, __ATOMIC_RELAXED, __HIP_MEMORY_SCOPE_WORKGROUP);
                                    if (j + 1 < 128) __hip_atomic_fetch_add(impw + q8 * 128 + j + 1, C, __ATOMIC_RELAXED, __HIP_MEMORY_SCOPE_WORKGROUP);
                                }
                            }
                            bf16x8 pa0, pa1; pack_p(acc, pa0, pa1);
                            pv_sub(o, buf, sub, pa0, pa1, lane);
                        }
                    }
                }
                if (t + 1 < ntc) stage_write(lds + L_KV + ((t + 1) & 1) * KVB, sr, srow, sch);
                __syncthreads();
            }
        }
        if (pass == 0) { const float dt = den + __shfl_xor(den, 32); invden = dt > 0.f ? 1.f / dt : 0.f; }
    }
    asm volatile("s_waitcnt lgkmcnt(0)" ::: "memory");
#pragma unroll
    for (int r = 0; r < 16; ++r) { const float g0 = ws_[crow(r, hh)]; outv[0][r] += o[0][r] * g0; outv[1][r] += o[1][r] * g0; }
    {
        float* sp = P.scr + tid;
#pragma unroll
        for (int r = 0; r < 16; ++r) { sp[r * 512] = outv[0][r]; sp[(16 + r) * 512] = outv[1][r]; }
    }
    {
        const int qsel = lane >> 3, sb = lane & 7;
        unsigned key[16];
#pragma unroll
        for (int i4 = 0; i4 < 4; ++i4) {
            const f32x4 v = *(const LAS f32x4*)(impw + qsel * 128 + sb * 16 + 4 * i4);
#pragma unroll
            for (int e = 0; e < 4; ++e) {
                const int j = sb * 16 + 4 * i4 + e;
                const bool forced = (j == 0) | (j == P.qb) | (j == P.qb - 1);
                key[4 * i4 + e] = forced ? 0xFFFFFFFFu : (j <= P.qb ? __float_as_uint(v[e]) + 1u : 0u);
            }
        }
        unsigned T = 0u;
        for (int bit = 31; bit >= 0; --bit) {
            const unsigned cand = T | (1u << bit);
            int cnt = 0;
#pragma unroll
            for (int i = 0; i < 16; ++i) cnt += key[i] >= cand ? 1 : 0;
            cnt += __shfl_xor(cnt, 1); cnt += __shfl_xor(cnt, 2); cnt += __shfl_xor(cnt, 4);
            if (cnt >= 16) T = cand;
        }
        int cgt = 0, ceq = 0;
#pragma unroll
        for (int i = 0; i < 16; ++i) { cgt += key[i] > T ? 1 : 0; ceq += key[i] == T ? 1 : 0; }
        int cg = cgt; cg += __shfl_xor(cg, 1); cg += __shfl_xor(cg, 2); cg += __shfl_xor(cg, 4);
        int pre = 0;
#pragma unroll
        for (int k = 0; k < 8; ++k) { const int v = __shfl(ceq, (lane & ~7) + k); if (k < sb) pre += v; }
        int need = 16 - cg - pre;
        unsigned bits = 0u;
#pragma unroll
        for (int i = 0; i < 16; ++i) {
            const int j = sb * 16 + i;
            bool s_ = key[i] > T;
            if (key[i] == T) { if (need > 0) { s_ = true; } --need; }
            if (s_ && j <= P.qb) bits |= 1u << i;
        }
        const unsigned other = __shfl_xor(bits, 1);
        const unsigned word = (sb & 1) ? ((bits << 16) | other) : (bits | (other << 16));
        if ((sb & 1) == 0) { selw[qsel * 4 + (sb >> 1)] = word; __hip_atomic_fetch_or(uni + (sb >> 1), word, __ATOMIC_RELAXED, __HIP_MEMORY_SCOPE_WORKGROUP); }
    }
    __syncthreads();
    unsigned lm0 = selw[q8 * 4 + 0], lm1 = selw[q8 * 4 + 1], lm2 = selw[q8 * 4 + 2], lm3 = selw[q8 * 4 + 3];
    unsigned wm0 = 0, wm1 = 0, wm2 = 0, wm3 = 0;
#pragma unroll
    for (int k = 0; k < 8; ++k) { wm0 |= selw[k * 4 + 0]; wm1 |= selw[k * 4 + 1]; wm2 |= selw[k * 4 + 2]; wm3 |= selw[k * 4 + 3]; }
    wm0 = __builtin_amdgcn_readfirstlane(wm0); wm1 = __builtin_amdgcn_readfirstlane(wm1); wm2 = __builtin_amdgcn_readfirstlane(wm2); wm3 = __builtin_amdgcn_readfirstlane(wm3);
    const unsigned um0 = __builtin_amdgcn_readfirstlane(uni[0]), um1 = __builtin_amdgcn_readfirstlane(uni[1]), um2 = __builtin_amdgcn_readfirstlane(uni[2]), um3 = __builtin_amdgcn_readfirstlane(uni[3]);
#define NSA_WORD(a0, a1, a2, a3, j) ((j) < 32 ? (a0) : ((j) < 64 ? (a1) : ((j) < 96 ? (a2) : (a3))))
#define NSA_NEXT(j, res) do { int _j = (j); res = 128; while (_j < 128) { const unsigned _w = NSA_WORD(um0, um1, um2, um3, _j) >> (_j & 31); if (_w) { res = _j + __builtin_ctz(_w); break; } _j = (_j | 31) + 1; } } while (0)
    o[0] = (f32x16){}; o[1] = (f32x16){}; den = 0.f;
#define NSA_SLC_COMPUTE(JJ, BUF) do { \
        if ((NSA_WORD(wm0, wm1, wm2, wm3, (JJ)) >> ((JJ) & 31)) & 1u) { \
            const bool lsel = (NSA_WORD(lm0, lm1, lm2, lm3, (JJ)) >> ((JJ) & 31)) & 1u; \
            _Pragma("unroll") for (int sub = 0; sub < 2; ++sub) { \
                const int kb = 64 * (JJ) + 32 * sub; \
                if (kb <= twmax) { \
                    f32x16 acc; \
                    if (twmin - kb - 31 >= 1513) acc = splat16(lsel ? cfar : -1e30f); \
                    else { const LAS float* tb = lsel ? tg + hd * GTS + (GTOP - (tq - kb - 4 * hh)) : dead; \
                        _Pragma("unroll") for (int r = 0; r < 16; ++r) acc[r] = tb[(r & 3) + 8 * (r >> 2)]; } \
                    qk_sub<0, 4>(acc, (BUF), sub, qf, lane); \
                    den += exp_sum16(acc); \
                    bf16x8 pa0, pa1; pack_p(acc, pa0, pa1); \
                    pv_sub(o, (BUF), sub, pa0, pa1, lane); \
                } } } } while (0)
#define NSA_SLC_LOAD(JJ, SR) do { const bf16_t* rp_ = P.Hb + (size_t)(64 * (JJ) + srow) * HP; stage_load(SR, rp_ + C_KS, rp_ + C_VS, true, sch); } while (0)
    {
        LAS unsigned char* pb0 = lds + L_KV; LAS unsigned char* pb1 = lds + L_IMP;
        StageRegs a0, a1, b0, b1;
#define NSA_PAIR(prev, ra, rb) do { ra = 128; if ((prev) < 128) { NSA_NEXT((prev) + 1, ra); } rb = 128; if (ra < 128) { NSA_NEXT(ra + 1, rb); } } while (0)
#define NSA_SLC_LOADC(JJ, SR) do { const int jc_ = (JJ) < 128 ? (JJ) : 0; NSA_SLC_LOAD(jc_, SR); } while (0)
        int ca, cb_, n1a, n1b, n2a, n2b, n3a, n3b;
        NSA_NEXT(0, ca); cb_ = 128; if (ca < 128) { NSA_NEXT(ca + 1, cb_); }
        NSA_PAIR(cb_, n1a, n1b); NSA_PAIR(n1b, n2a, n2b);
        NSA_SLC_LOADC(ca, b0); NSA_SLC_LOADC(cb_, b1);
        NSA_SLC_LOADC(n1a, a0); NSA_SLC_LOADC(n1b, a1);
        stage_write(pb0, b0, srow, sch); stage_write(pb0 + KVB, b1, srow, sch);
        NSA_SLC_LOADC(n2a, b0); NSA_SLC_LOADC(n2b, b1);
        __syncthreads();
        for (;;) {
            NSA_SLC_COMPUTE(ca, pb0);
            if (cb_ < 128) NSA_SLC_COMPUTE(cb_, pb0 + KVB);
            stage_write(pb1, a0, srow, sch); stage_write(pb1 + KVB, a1, srow, sch);
            NSA_PAIR(n2b, n3a, n3b);
            NSA_SLC_LOADC(n3a, a0); NSA_SLC_LOADC(n3b, a1);
            __syncthreads();
            if (n1a >= 128) break;
            NSA_SLC_COMPUTE(n1a, pb1);
            if (n1b < 128) NSA_SLC_COMPUTE(n1b, pb1 + KVB);
            stage_write(pb0, b0, srow, sch); stage_write(pb0 + KVB, b1, srow, sch);
            int n4a, n4b; NSA_PAIR(n3b, n4a, n4b);
            NSA_SLC_LOADC(n4a, b0); NSA_SLC_LOADC(n4b, b1);
            __syncthreads();
            if (n2a >= 128) break;
            ca = n2a; cb_ = n2b; n1a = n3a; n1b = n3b; n2a = n4a; n2b = n4b;
        }
#undef NSA_PAIR
#undef NSA_SLC_LOADC
    }
#undef NSA_SLC_COMPUTE
#undef NSA_SLC_LOAD
    {
        const float dt = den + __shfl_xor(den, 32);
        if (hh == 0) ws_[96 + n] = 1.f / dt;
        asm volatile("s_waitcnt lgkmcnt(0)" ::: "memory");
        const float* sp = P.scr + tid;
#pragma unroll
        for (int r = 0; r < 16; ++r) { const float gi = ws_[32 + crow(r, hh)] * ws_[96 + crow(r, hh)]; outv[0][r] = sp[r * 512] + o[0][r] * gi; outv[1][r] = sp[(16 + r) * 512] + o[1][r] * gi; }
    }
    {
#pragma unroll
        for (int r = 0; r < 16; ++r) {
            const int nn = crow(r, hh);
            const size_t trow = (size_t)(64 * P.qb + 8 * w + (nn >> 2));
            const int ycol = 768 + 64 * (nn & 3);
            const bf16_t* sp = P.Hb + trow * HP + C_SILU + ycol;
            bf16_t* yp = P.Y + (P.brow + trow) * DM + ycol;
            yp[n] = f2bf(outv[0][r] * bf2f(sp[n]));
            yp[32 + n] = f2bf(outv[1][r] * bf2f(sp[32 + n]));
        }
    }
    __syncthreads();
#undef NSA_WORD
#undef NSA_NEXT
}
}

#define XB_TMO      128
#define XB_XCNT(j)  (256  + 64 * (j))
#define XB_XSUB(j)  (1280 + 64 * (j))
#define XB_XGEN(j)  (2304 + 64 * (j))
#define XB_TOP      3328
#define XB_TOPGEN   3392
#define XCD_BAR_WORDS 3456
#define XB_SPIN_CAP (1u << 22)
__device__ __forceinline__ unsigned xb_ld(unsigned* p)              { return __hip_atomic_load(p, __ATOMIC_RELAXED, __HIP_MEMORY_SCOPE_AGENT); }
__device__ __forceinline__ unsigned xb_add(unsigned* p, unsigned v) { return __hip_atomic_fetch_add(p, v, __ATOMIC_RELAXED, __HIP_MEMORY_SCOPE_AGENT); }
__device__ __forceinline__ unsigned xb_xcc_id() { return (unsigned)__builtin_amdgcn_s_getreg((3 << 11) | 20) & 0xFu; }
#define XB_SPIN(cond, bar) do { unsigned _sp = 0; while (cond) { __builtin_amdgcn_s_sleep(1); \
    if ((++_sp & 255u) == 0u) { if (xb_ld(&(bar)[XB_TMO])) break; if (_sp > XB_SPIN_CAP) { atomicAdd(&(bar)[XB_TMO], 1u); break; } } } } while (0)
struct XcdBarrier { unsigned* bar; unsigned x; volatile LAS unsigned* st; };
__device__ __forceinline__ XcdBarrier xcd_barrier_post(unsigned* bar, volatile LAS unsigned* st) {
    XcdBarrier b; b.bar = bar; b.x = xb_xcc_id(); b.st = st;
    if (threadIdx.x == 0) (void)xb_add(&bar[XB_XCNT(b.x)], 1u);
    return b;
}
__device__ __forceinline__ void xcd_barrier_complete(unsigned* bar, unsigned x, unsigned& nloc, unsigned& nx) {
    const unsigned G = gridDim.x * gridDim.y * gridDim.z;
    unsigned sum, cnt, mine, sp = 0u;
    for (;;) {
        sum = 0u; cnt = 0u; mine = 0u;
#pragma unroll
        for (unsigned j = 0; j < 16; ++j) { const unsigned c = xb_ld(&bar[XB_XCNT(j)]); sum += c; cnt += (c > 0u) ? 1u : 0u; mine = (j == x) ? c : mine; }
        if (sum == G) break;
        __builtin_amdgcn_s_sleep(1);
        if ((++sp & 255u) == 0u) { if (xb_ld(&bar[XB_TMO])) break; if (sp > XB_SPIN_CAP) { atomicAdd(&bar[XB_TMO], 1u); break; } }
    }
    nloc = mine > 0u ? mine : 1u; nx = cnt > 0u ? cnt : 1u;
}
__device__ __forceinline__ void xcd_barrier(const XcdBarrier& b) {
    asm volatile("s_waitcnt vmcnt(0)" ::: "memory");
    __syncthreads();
    if (threadIdx.x == 0) {
        unsigned* bar = b.bar;
        __builtin_amdgcn_s_waitcnt(0);
        unsigned nloc = b.st[0], nx = b.st[1];
        if (nloc == 0u) { xcd_barrier_complete(bar, b.x, nloc, nx); b.st[0] = nloc; b.st[1] = nx; }
        const unsigned old = xb_add(&bar[XB_XSUB(b.x)], 1u);
        const unsigned gen = old / nloc;
        if (old + 1u == (gen + 1u) * nloc) {
            __builtin_amdgcn_fence(__ATOMIC_RELEASE, "agent");
            asm volatile("s_waitcnt vmcnt(0)" ::: "memory");
            const unsigned og = xb_add(&bar[XB_TOP], 1u);
            const unsigned tg = og / nx;
            if (og + 1u == (tg + 1u) * nx) xb_add(&bar[XB_TOPGEN], 1u);
            else XB_SPIN(xb_ld(&bar[XB_TOPGEN]) == tg, bar);
            __builtin_amdgcn_fence(__ATOMIC_ACQUIRE, "agent");
            xb_add(&bar[XB_XGEN(b.x)], 1u);
            asm volatile("s_waitcnt vmcnt(0)" ::: "memory");
        } else {
            XB_SPIN(xb_ld(&bar[XB_XGEN(b.x)]) == gen, bar);
            __builtin_amdgcn_fence(__ATOMIC_ACQUIRE, "agent");
            asm volatile("s_waitcnt vmcnt(0)" ::: "memory");
        }
    }
    __syncthreads();
}

constexpr int NT = 512, LDS_BYTES = 147456, MISC_OFF = 131072 + 320;
#ifndef R_C
#define R_C 1
#endif
#ifndef R_D
#define R_D 1
#endif
#ifndef R_AB
#define R_AB 1
#endif
#ifndef R_G1
#define R_G1 1
#endif
constexpr size_t MiB = 1u << 20;
constexpr size_t WS_CTL = 0, CTL_ZERO_BYTES = 65536;
constexpr size_t WS_X1B = 158 * MiB;
constexpr size_t OUT_OA = 0, OUT_NSCR = 24 * MiB;
constexpr size_t WS_H = 2 * MiB, WS_XN = 124 * MiB, WS_T0 = 158 * MiB, WS_IMP = 208 * MiB, WS_SEL = 217 * MiB, WS_HID = 218 * MiB, WS_KC = 221 * MiB, WS_VC = 222 * MiB, WS_WIN = 224 * MiB, WS_WOUT = 240 * MiB, WS_MX = 1 * MiB, WS_DA = 245 * MiB, WS_CW1 = 246 * MiB, WS_CW2 = 250 * MiB, WS_RSS = 251 * MiB;

struct Args { const float* in[15]; float* out; unsigned char* ws; };

__global__ void __launch_bounds__(NT, 2) mega_fwd(Args args) {
    extern __shared__ __attribute__((aligned(16))) unsigned char lds[];
    const int tid = threadIdx.x, lane = tid & 63, wid = tid >> 6;
    const int G = gridDim.x, bid = blockIdx.x;
    volatile LAS unsigned* MISC = (volatile LAS unsigned*)((LAS unsigned char*)lds + MISC_OFF);
    if (tid < 32) MISC[tid] = 0u;
    __syncthreads();
    unsigned char* ws = args.ws;
    XcdBarrier bar = xcd_barrier_post((unsigned*)(ws + WS_CTL) + 4096, MISC + 8);
    const float* x = args.in[0]; const float* tab = args.in[1]; const float* norm_w = args.in[2];
    const float* w_in = args.in[3]; const float* w_out = args.in[4]; const float* qk_gain = args.in[5];
    const float* qk_gain_diff = args.in[6]; const float* sinks = args.in[7]; const float* diff_lambda = args.in[8];
    const float* diff_subln = args.in[9]; const float* cmp_pos = args.in[10]; const float* cmp_w1 = args.in[11];
    const float* cmp_b1 = args.in[12]; const float* cmp_w2 = args.in[13]; const float* cmp_b2 = args.in[14];
    float* out = args.out;
    bf16_t* H = (bf16_t*)(ws + WS_H);
    bf16_t* XN = (bf16_t*)(ws + WS_XN); bf16_t* Y = XN;
    float* T0 = (float*)(ws + WS_T0);
    float* OC = T0; float* OS_ = T0 + (size_t)MROWS * 256; float* OW = T0 + (size_t)MROWS * 512; float* CT = T0;
    float* IMP = (float*)(ws + WS_IMP); unsigned* SEL = (unsigned*)(ws + WS_SEL); float* HID = (float*)(ws + WS_HID);
    float* KC = (float*)(ws + WS_KC); float* VC = (float*)(ws + WS_VC);
    const int GT = G * NT, GW = G * 8;
    bf16_t* WinT = (bf16_t*)(ws + WS_WIN); bf16_t* WoutT = (bf16_t*)(ws + WS_WOUT);
#define GRID_BAR() do { XcdBarrier b2_ = bar; asm volatile("" : "+s"(b2_.x)); xcd_barrier(b2_); } while (0)
    {
        LAS float* scr = (LAS float*)((LAS unsigned char*)lds + wid * 16384);
        const int gw0 = bid * 8 + wid;
        constexpr int I_IN = 16 * 120, I_OUT = 16 * 32, I_C1 = 32 * 8, I_C2 = 4 * 2, I_L = I_IN + I_OUT + 2 * I_C1 + 2 * I_C2, NITEMS = 2 * I_L;
        bf16_t* CW1T = (bf16_t*)(ws + WS_CW1); bf16_t* CW2T = (bf16_t*)(ws + WS_CW2);
        for (int it = gw0; it < NITEMS; it += GW) {
            const int l = it / I_L; int r = it % I_L;
            if (r < I_IN) { p0_transpose_item<0>(w_in + (size_t)l * DM * PW, WinT + (size_t)l * HP * DM, scr, r, lane, 1024, 1024, norm_w + l * DM); continue; } r -= I_IN;
            if (r < I_OUT) { p0_transpose_item<1>(w_out + (size_t)l * DM * DM, WoutT + (size_t)l * DM * DM, scr, r, lane); continue; } r -= I_OUT;
            if (r < 2 * I_C1) { const int kv = r / I_C1; p0_transpose_item<2>(cmp_w1 + (size_t)(l * 2 + kv) * 2048 * 256, CW1T + (size_t)(l * 2 + kv) * 256 * 2048, scr, r % I_C1, lane, 2048, 256); continue; } r -= 2 * I_C1;
            { const int kv = r / I_C2; p0_transpose_item<1>(cmp_w2 + (size_t)(l * 2 + kv) * 256 * 64, CW2T + (size_t)(l * 2 + kv) * 64 * 256, scr, r % I_C2, lane, 256, 64); }
        }
        if (bid == 1 && tid < 256) { bf16_t* KCb = (bf16_t*)(ws + WS_KC); KCb[(size_t)(tid >> 6) * 512 * 64 + 511 * 64 + (tid & 63)] = 0; }
        for (int w = gw0; w < MROWS; w += GW) k_rmsnorm(w, lane, x, norm_w, XN);
        for (int v = bid * NT + tid; v < MROWS; v += GT) ((unsigned long long*)(ws + WS_RSS))[v] = 0ull;
        if (bid == 0 && wid == 0) {
            float* MX = (float*)(ws + WS_MX);
            for (int l = 0; l < 2; ++l) {
                float mg[8];
#pragma unroll
                for (int i = 0; i < 8; ++i) { float v = fabsf(qk_gain[l * 512 + i * 64 + lane]);
#pragma unroll
                    for (int o = 1; o < 64; o <<= 1) v = fmaxf(v, __shfl_xor(v, o));
                    mg[i] = v; }
                float md0 = lane < 32 ? fabsf(qk_gain_diff[l * 64 + lane]) : 0.f, md1 = lane < 32 ? fabsf(qk_gain_diff[l * 64 + 32 + lane]) : 0.f;
#pragma unroll
                for (int o = 1; o < 64; o <<= 1) { md0 = fmaxf(md0, __shfl_xor(md0, o)); md1 = fmaxf(md1, __shfl_xor(md1, o)); }
                for (int gh = 0; gh < 16; ++gh) {
                    float mb = lane < 32 ? fabsf(tab[lane * 16 + gh]) : 0.f;
#pragma unroll
                    for (int o = 1; o < 64; o <<= 1) mb = fmaxf(mb, __shfl_xor(mb, o));
                    const int grp = gh >> 2, hh = gh & 3; float Mv;
                    if (grp == 0) Mv = 8.f * mg[0] * mg[1] + mb;
                    else if (grp == 1) Mv = fmaxf(8.f * mg[2] * mg[3] + mb, sinks[l * 4 + hh]);
                    else if (grp == 2) Mv = 5.656854249f * md0 * md1 + mb;
                    else Mv = 8.f * mg[4] * fmaxf(mg[5], fmaxf(mg[6], mg[7])) + mb;
                    if (lane == 0) MX[l * 16 + gh] = Mv;
                }
                float s1 = lane < 32 ? diff_lambda[l * 128 + lane] * diff_lambda[l * 128 + 32 + lane] : 0.f;
                float s2 = lane < 32 ? diff_lambda[l * 128 + 64 + lane] * diff_lambda[l * 128 + 96 + lane] : 0.f;
#pragma unroll
                for (int o = 1; o < 64; o <<= 1) { s1 += __shfl_xor(s1, o); s2 += __shfl_xor(s2, o); }
                const float lambda_init = 0.8f - 0.6f * expf(-0.3f * (float)l);
                if (lane == 0) { MX[32 + l] = expf(s1) - expf(s2) + lambda_init; MX[34 + l] = lambda_init; }
            }
        }
    }
    GRID_BAR();
#pragma unroll 1
    for (int l = 0; l < 2; ++l) {
        bf16_t* X1B = (bf16_t*)(ws + WS_X1B);
        { pg8::Gemm g{l == 0 ? XN : X1B, WinT + (size_t)l * HP * DM, MROWS, HP, DM}; pg8::StaticOrder So; So.init(MROWS, HP, G, bid);
          pg8::EpiProj E{H, qk_gain + l * 512, qk_gain_diff + l * 64, l == 0 ? nullptr : (const float*)(ws + WS_RSS)};
          for (int rep = 0; rep < R_G1; ++rep) pg8::gemm_phase<pg8::EpiProj, pg8::StaticOrder, true, true>((LAS unsigned char*)lds, g, So, E); }
        GRID_BAR();
        {
            const float* MX = (const float*)(ws + WS_MX);
            bf16_t* OA = (bf16_t*)((unsigned char*)out + OUT_OA); float* DA = (float*)(ws + WS_DA);
            bf16_t* KCb = (bf16_t*)(ws + WS_KC);
            const bf16_t* CW1T = (const bf16_t*)(ws + WS_CW1); const bf16_t* CW2T = (const bf16_t*)(ws + WS_CW2);
            LAS unsigned* qw = (LAS unsigned*)((LAS unsigned char*)lds + att::L_Q);
            unsigned* qctr = (unsigned*)(ws + WS_CTL) + 8192 + 128 * l;
            unsigned* cdone = qctr + 64;
            constexpr int B0 = 64, B1 = B0 + 160 * R_C, B2 = B1 + 256 * R_D, B3 = B2 + 96 * R_C, B4 = B3 + 768 * R_AB, NUV = B4 + 256 * R_AB;
            for (;;) {
                if (opq(threadIdx.x) == 0) *qw = atomicAdd(qctr, 1u);
                __syncthreads();
                const int uv = (int)*qw;
                __syncthreads();
                if (uv >= NUV) break;
                int u;
                if (uv < B0) u = uv; else if (uv < B1) u = 64 + (uv - B0) / R_C; else if (uv < B2) u = 224 + (uv - B1) / R_D; else if (uv < B3) u = 480 + (uv - B2) / R_C;
                else if (uv < B4) u = 576 + (uv - B3) / R_AB; else u = 1344 + (uv - B4) / R_AB;
                if (u < 64) {
                    const int kv = u >> 5, b = (u >> 4) & 1, rt = u & 15;
                    att::CmpArgs P; P.Hb = H + (size_t)b * S * HP; P.col = kv == 0 ? C_KC : C_VC; P.rt = rt;
                    P.pos = cmp_pos + (size_t)(l * 2 + kv) * 2048; P.W1T = CW1T + (size_t)(l * 2 + kv) * 256 * 2048; P.b1 = cmp_b1 + (l * 2 + kv) * 256;
                    P.W2T = CW2T + (size_t)(l * 2 + kv) * 64 * 256; P.b2 = cmp_b2 + (l * 2 + kv) * 64; P.gain = kv == 0 ? qk_gain + l * 512 + 5 * 64 : nullptr;
                    P.OUT = KCb + (size_t)(kv * NB + b) * 512 * 64;
                    att::cmp_unit((LAS unsigned char*)lds, P);
                    asm volatile("s_waitcnt vmcnt(0)" ::: "memory");
                    __syncthreads();
                    if (opq(threadIdx.x) == 64) { __builtin_amdgcn_fence(__ATOMIC_RELEASE, "agent"); asm volatile("s_waitcnt vmcnt(0)" ::: "memory");
                        __hip_atomic_fetch_add(cdone, 1u, __ATOMIC_RELAXED, __HIP_MEMORY_SCOPE_AGENT); }
                    __syncthreads();
                } else if ((u >= 64 && u < 224) || (u >= 480 && u < 576)) {
                    int qb, bh;
                    if (u < 224) { qb = 31 - ((u - 64) >> 3); bh = (u - 64) & 7; } else { qb = 11 - ((u - 480) >> 3); bh = (u - 480) & 7; }
                    const int b = bh >> 2, hd = bh & 3;
                    att::DiffArgs P; P.Hb = H + (size_t)b * S * HP; P.hd = hd; P.qb = qb; P.brow = (size_t)b * S;
                    P.bias = tab + 8 + hd; P.M = MX[l * 16 + 8 + hd]; P.lam = MX[32 + l]; P.lambda_init = MX[34 + l]; P.subln = diff_subln + l * 64; P.Y = Y;
                    att::diff_unit((LAS unsigned char*)lds, P);
                } else if (u < 480) {
                    const int idx = u - 224, qb64 = 127 - (idx >> 1), b = idx & 1;
                    att::NsaArgs P; P.Hb = H + (size_t)b * S * HP; P.brow = (size_t)b * S; P.qb = qb64;
                    P.KC = KCb + (size_t)(0 * NB + b) * 512 * 64; P.VC = KCb + (size_t)(1 * NB + b) * 512 * 64;
                    P.bias = tab + 12; P.Mv = MX + l * 16 + 12; P.Y = Y; P.cdone = cdone; P.scr = (float*)((unsigned char*)out + OUT_NSCR) + (size_t)bid * 16384;
                    att::nsa_unit((LAS unsigned char*)lds, P);
                } else if (u < 1344) {
                    const int v = u - 576, cfg = v >> 8, b = (v >> 7) & 1, hd = (v >> 5) & 3, ti = v & 31;
                    const int rate = cfg == 0 ? 1 : (cfg == 1 ? 4 : 16), tpc = 32 / rate;
                    att::BandArgs P; P.Hb = H + (size_t)b * S * HP; P.cq = C_AQ + 64 * hd; P.ck = C_AK + 64 * hd; P.cv = C_AV + 64 * hd;
                    P.rate = rate; P.cls = ti / tpc; P.f0 = (ti % tpc) * 256; P.maxd = 128; P.bias = tab + hd; P.M = MX[l * 16 + hd]; P.sinkterm = 0.f;
                    P.OA = OA + (size_t)cfg * MROWS * 256; P.DA = DA + (size_t)cfg * MROWS * 4; P.Y = nullptr; P.ycol = 0; P.hd = hd; P.brow = (size_t)b * S;
                    att::banded_unit<0>((LAS unsigned char*)lds, P);
                } else {
                    const int v = u - 1344, b = (v >> 7) & 1, hd = (v >> 5) & 3, ti = v & 31;
                    att::BandArgs P; P.Hb = H + (size_t)b * S * HP; P.cq = C_BQ + 64 * hd; P.ck = C_BK + 64 * (hd >> 1); P.cv = C_BV + 64 * (hd >> 1);
                    P.rate = 1; P.cls = 0; P.f0 = ti * 256; P.maxd = 127; P.bias = tab + 4 + hd; P.M = MX[l * 16 + 4 + hd];
                    P.sinkterm = __expf(sinks[l * 4 + hd] - P.M);
                    P.OA = nullptr; P.DA = nullptr; P.Y = Y; P.ycol = 256 + 64 * hd; P.hd = hd; P.brow = (size_t)b * S;
                    att::banded_unit<1>((LAS unsigned char*)lds, P);
                }
            }
        }
        GRID_BAR();
        {
            const bf16_t* OA = (const bf16_t*)((unsigned char*)out + OUT_OA); const float* DA = (const float*)(ws + WS_DA);
            for (int v = (bid * NT + opq(threadIdx.x)); v < MROWS * 32; v += GT) {
                const int row = v >> 5, hd = (v >> 3) & 3, c8 = v & 7;
                float acc8[8] = {0.f, 0.f, 0.f, 0.f, 0.f, 0.f, 0.f, 0.f}; float dsum = 0.f;
#pragma unroll
                for (int cfg = 0; cfg < 3; ++cfg) {
                    const float dn = DA[((size_t)cfg * MROWS + row) * 4 + hd]; dsum += dn;
                    const uint4 r4 = *(const uint4*)(OA + ((size_t)cfg * MROWS + row) * 256 + hd * 64 + c8 * 8);
                    acc8[0] += dn * __uint_as_float(r4.x << 16); acc8[1] += dn * __uint_as_float(r4.x & 0xffff0000u);
                    acc8[2] += dn * __uint_as_float(r4.y << 16); acc8[3] += dn * __uint_as_float(r4.y & 0xffff0000u);
                    acc8[4] += dn * __uint_as_float(r4.z << 16); acc8[5] += dn * __uint_as_float(r4.z & 0xffff0000u);
                    acc8[6] += dn * __uint_as_float(r4.w << 16); acc8[7] += dn * __uint_as_float(r4.w & 0xffff0000u);
                }
                const float inv = 1.f / dsum;
                const uint4 s4 = *(const uint4*)(H + (size_t)row * HP + C_SILU + hd * 64 + c8 * 8);
                uint4 o4;
                o4.x = (unsigned)f2bf(acc8[0] * inv * __uint_as_float(s4.x << 16)) | ((unsigned)f2bf(acc8[1] * inv * __uint_as_float(s4.x & 0xffff0000u)) << 16);
                o4.y = (unsigned)f2bf(acc8[2] * inv * __uint_as_float(s4.y << 16)) | ((unsigned)f2bf(acc8[3] * inv * __uint_as_float(s4.y & 0xffff0000u)) << 16);
                o4.z = (unsigned)f2bf(acc8[4] * inv * __uint_as_float(s4.z << 16)) | ((unsigned)f2bf(acc8[5] * inv * __uint_as_float(s4.z & 0xffff0000u)) << 16);
                o4.w = (unsigned)f2bf(acc8[6] * inv * __uint_as_float(s4.w << 16)) | ((unsigned)f2bf(acc8[7] * inv * __uint_as_float(s4.w & 0xffff0000u)) << 16);
                *(uint4*)(Y + (size_t)row * DM + hd * 64 + c8 * 8) = o4;
            }
        }
        GRID_BAR();
        { pg8::Gemm g{Y, WoutT + (size_t)l * DM * DM, MROWS, DM, DM}; pg8::StaticOrder So; So.init(MROWS, DM, G, bid);
          pg8::EpiOut E{l == 0 ? x : nullptr, X1B, out, (LAS float*)((LAS unsigned char*)lds + 132096), X1B, (float*)(ws + WS_RSS)};
          pg8::gemm_phase<pg8::EpiOut, pg8::StaticOrder, true, true>((LAS unsigned char*)lds, g, So, E); }
        if (l == 0) GRID_BAR();
    }
}

extern "C" void kernel_launch(void* const* d_in, const int* in_sizes, int n_in, void* d_out, int out_size, void* d_ws, size_t ws_size, hipStream_t stream) {
    static int grid = 0;
    if (grid == 0) {
        int dev = 0, cus = 0;
        (void)hipGetDevice(&dev);
        (void)hipDeviceGetAttribute(&cus, hipDeviceAttributeMultiprocessorCount, dev);
        (void)hipFuncSetAttribute((const void*)mega_fwd, hipFuncAttributeMaxDynamicSharedMemorySize, LDS_BYTES);
        grid = cus > 0 ? cus : 256;
    }
    (void)hipMemsetAsync((char*)d_ws + WS_CTL, 0, CTL_ZERO_BYTES, stream);
    Args a{};
    for (int i = 0; i < 15; ++i) a.in[i] = (const float*)d_in[i];
    a.out = (float*)d_out; a.ws = (unsigned char*)d_ws;
    hipLaunchKernelGGL(mega_fwd, dim3(grid), dim3(NT), LDS_BYTES, stream, a);
}
```

```cpp
#include <hip/hip_runtime.h>
#include <stdint.h>
#include <math.h>

typedef unsigned short bf16_t;
__device__ __forceinline__ float bf2f(bf16_t v) { return __uint_as_float((unsigned)v << 16); }
__device__ __forceinline__ bf16_t f2bf(float f) { unsigned u = __float_as_uint(f); return (bf16_t)((u + 0x7fffu + ((u >> 16) & 1u)) >> 16); }

constexpr int NB = 2, S = 8192, DM = 1024, MROWS = NB * S, PW = 3724, HP = 3840;
constexpr int C_AQ = 0, C_AK = 256, C_AV = 512, C_BQ = 768, C_BK = 1024, C_BV = 1152, C_CQ = 1280, C_CK = 1536, C_CV = 1792,
              C_DQ = 2048, C_KC = 2304, C_VC = 2368, C_KS = 2432, C_VS = 2496, C_KW = 2560, C_VW = 2624, C_GT = 2688, C_SILU = 2816;
constexpr float EPS = 1e-6f;
__device__ __forceinline__ int opq(int v) { asm volatile("" : "+v"(v)); return v; }

__device__ __forceinline__ int t5_bucket(int n) {
    if (n < 16) return n < 0 ? 0 : n;
    int b = 16;
    b += (n >= 22); b += (n >= 30); b += (n >= 40); b += (n >= 54); b += (n >= 73); b += (n >= 99); b += (n >= 134); b += (n >= 182);
    b += (n >= 246); b += (n >= 332); b += (n >= 450); b += (n >= 609); b += (n >= 825); b += (n >= 1117); b += (n >= 1513);
    return b;
}

__device__ __forceinline__ void k_rmsnorm(const int wave, const int lane, const float* __restrict__ x, const float* __restrict__ g, bf16_t* __restrict__ xn) {
    if (wave >= MROWS) return;
    const float4* xr = (const float4*)(x + (size_t)wave * DM);
    float4 v[4]; float ss = 0.f;
#pragma unroll
    for (int j = 0; j < 4; ++j) { v[j] = xr[lane + 64 * j]; ss += (v[j].x * v[j].x + v[j].y * v[j].y) + (v[j].z * v[j].z + v[j].w * v[j].w); }
#pragma unroll
    for (int o = 1; o < 64; o <<= 1) ss += __shfl_xor(ss, o);
    const float rstd = rsqrtf(ss * (1.f / DM) + EPS);
#pragma unroll
    for (int j = 0; j < 4; ++j) {
        uint2 o; o.x = (unsigned)f2bf(v[j].x * rstd) | ((unsigned)f2bf(v[j].y * rstd) << 16);
        o.y = (unsigned)f2bf(v[j].z * rstd) | ((unsigned)f2bf(v[j].w * rstd) << 16);
        ((uint2*)(xn + (size_t)wave * DM))[lane + 64 * j] = o;
    }
}

template <int D>
__device__ __forceinline__ float dot_row(const float* q, const bf16_t* kr) {
    float s = 0.f;
#pragma unroll
    for (int c = 0; c < D / 8; ++c) {
        const uint4 r = *(const uint4*)(kr + 8 * c);
        s += q[8 * c + 0] * __uint_as_float(r.x << 16) + q[8 * c + 1] * __uint_as_float(r.x & 0xffff0000u);
        s += q[8 * c + 2] * __uint_as_float(r.y << 16) + q[8 * c + 3] * __uint_as_float(r.y & 0xffff0000u);
        s += q[8 * c + 4] * __uint_as_float(r.z << 16) + q[8 * c + 5] * __uint_as_float(r.z & 0xffff0000u);
        s += q[8 * c + 6] * __uint_as_float(r.w << 16) + q[8 * c + 7] * __uint_as_float(r.w & 0xffff0000u);
        if (c & 1) asm volatile("" ::: "memory");
    }
    return s;
}
__device__ __forceinline__ void os_step(float s, const bf16_t* vr, float& m, float& den, float* o) {
    const float mn = fmaxf(m, s), sc = __expf(m - mn), p = __expf(s - mn);
    den = den * sc + p; m = mn;
#pragma unroll
    for (int c = 0; c < 8; ++c) {
        const uint4 r = *(const uint4*)(vr + 8 * c);
        o[8 * c + 0] = o[8 * c + 0] * sc + p * __uint_as_float(r.x << 16); o[8 * c + 1] = o[8 * c + 1] * sc + p * __uint_as_float(r.x & 0xffff0000u);
        o[8 * c + 2] = o[8 * c + 2] * sc + p * __uint_as_float(r.y << 16); o[8 * c + 3] = o[8 * c + 3] * sc + p * __uint_as_float(r.y & 0xffff0000u);
        o[8 * c + 4] = o[8 * c + 4] * sc + p * __uint_as_float(r.z << 16); o[8 * c + 5] = o[8 * c + 5] * sc + p * __uint_as_float(r.z & 0xffff0000u);
        o[8 * c + 6] = o[8 * c + 6] * sc + p * __uint_as_float(r.w << 16); o[8 * c + 7] = o[8 * c + 7] * sc + p * __uint_as_float(r.w & 0xffff0000u);
        if (c & 1) asm volatile("" ::: "memory");
    }
}
template <int D>
__device__ __forceinline__ void load_q(float* q, const bf16_t* p) {
#pragma unroll
    for (int c = 0; c < D / 8; ++c) {
        const uint4 r = *(const uint4*)(p + 8 * c);
        q[8 * c + 0] = __uint_as_float(r.x << 16); q[8 * c + 1] = __uint_as_float(r.x & 0xffff0000u);
        q[8 * c + 2] = __uint_as_float(r.y << 16); q[8 * c + 3] = __uint_as_float(r.y & 0xffff0000u);
        q[8 * c + 4] = __uint_as_float(r.z << 16); q[8 * c + 5] = __uint_as_float(r.z & 0xffff0000u);
        q[8 * c + 6] = __uint_as_float(r.w << 16); q[8 * c + 7] = __uint_as_float(r.w & 0xffff0000u);
    }
}

#define LAS __attribute__((address_space(3)))
namespace pg8 {
#define PG8_LAS __attribute__((address_space(3)))
typedef unsigned short bf16_t;
typedef short bf16x8 __attribute__((ext_vector_type(8)));
typedef float f32x4 __attribute__((ext_vector_type(4)));
typedef unsigned u32x4 __attribute__((ext_vector_type(4)));
constexpr int BM = 256, BK = 64, HALF = 128, HTB = HALF * BK * 2  , STAGE_BYTES = 8 * HTB, NXCD = 8, WGM = 8;

__host__ __device__ __forceinline__ int lds_byte(int r, int c) { const int st = (r >> 4) * 2 + (c >> 5), rr = r & 15, cc = c & 31, ob = rr * 64 + cc * 2; return st * 1024 + (ob ^ (((ob >> 9) & 1) << 5)); }
__host__ __device__ __forceinline__ void stage_rc(int b, int& R, int& C) { const int st = b / 1024, sb = b % 1024, swz = sb ^ (((sb >> 9) & 1) << 5); R = (st >> 1) * 16 + swz / 64; C = (st & 1) * 32 + (swz % 64) / 2; }
__host__ __device__ __forceinline__ int perm32(int rho) { const int n = rho >> 4, i = rho & 15; return 8 * (i >> 2) + 4 * n + (i & 3); }

struct Unit { int pm, pn; };
struct Gemm { const bf16_t* A; const bf16_t* Bt; int M, N, K; };

struct StaticOrder {
    int nM, nN, nwg, G, c;
    __host__ __device__ void init(int M, int N, int G_, int c_) { nM = M / BM; nN = N / BM; nwg = nM * nN; G = G_; c = c_; }
    __host__ __device__ bool next(int i, Unit& u) const {
        const long L = (long)i * G + c; if (L >= nwg) return false;
        int wgid = (int)L; { const int q = nwg / NXCD, r = nwg % NXCD, xcd = wgid % NXCD, off = wgid / NXCD; wgid = (xcd < r ? xcd * (q + 1) : r * (q + 1) + (xcd - r) * q) + off; }
        const int nig = WGM * nN, gid = wgid / nig, fm = gid * WGM, gsz = (nM - fm) < WGM ? (nM - fm) : WGM;
        u.pm = fm + ((wgid % nig) % gsz); u.pn = (wgid % nig) / gsz; return true;
    }
    __device__ __forceinline__ void a_ready(const Unit&) const {}
    __device__ __forceinline__ void done(const Unit&) const {}
};

__device__ __forceinline__ unsigned cvt_pk_bf16(float lo, float hi) { unsigned r; asm volatile("v_cvt_pk_bf16_f32 %0, %1, %2" : "=v"(r) : "v"(lo), "v"(hi)); return r; }
template <class Epi, class Sched, bool ALIGN_EPI = false, bool SP2 = false>
__device__ __forceinline__ void gemm_phase(PG8_LAS unsigned char* lds, const Gemm g, const Sched& S, const Epi& E) {
    const int tid = opq(threadIdx.x), wid = __builtin_amdgcn_readfirstlane(tid >> 6), lane = tid & 63, wr = wid >> 2, wc = wid & 3, fr = lane & 15, fq = lane >> 4;
    const int K = g.K, nt = K / BK;
    unsigned voffA[2], voffB[2];
#pragma unroll
    for (int i = 0; i < 2; ++i) { int R, C; stage_rc(tid * 16 + i * 8192, R, C); const int Rb = Epi::PERM ? ((R & ~31) + perm32(R & 31)) : R;
        voffA[i] = (unsigned)(R * K + C) * 2u; voffB[i] = (unsigned)(Rb * K + C) * 2u; }
    const size_t kstep = (size_t)(BK * 2);
    const size_t hstep = (size_t)HALF * K * 2;
    const size_t tstep = 2 * hstep;
    const unsigned ldsw = (unsigned)wid * 1024u;
    const int aoff = lds_byte(wr * 64 + fr, fq * 8), boff = lds_byte(wc * 32 + fr, fq * 8);
#define PG8_SA(b, h) (((b) * 2 + (h)) * HTB)
#define PG8_SB(b, h) ((4 + (b) * 2 + (h)) * HTB)
#define PG8_STAGE(bufoff, gbase, voff) do { _Pragma("unroll") for (int _i = 0; _i < 2; ++_i) \
        __builtin_amdgcn_global_load_lds((const unsigned*)((const char*)(gbase) + (voff)[_i]), (PG8_LAS unsigned*)(lds + (bufoff) + ldsw + _i * 8192), 16, 0, 0); } while (0)
#define PG8_LDA(dst, b, h) do { _Pragma("unroll") for (int m = 0; m < 4; ++m) _Pragma("unroll") for (int k = 0; k < 2; ++k) dst[m][k] = *(const PG8_LAS bf16x8*)(lds + PG8_SA(b, h) + aoff + m * 2048 + k * 1024); } while (0)
#define PG8_LDB(dst, b, h) do { _Pragma("unroll") for (int n = 0; n < 2; ++n) _Pragma("unroll") for (int k = 0; k < 2; ++k) dst[n][k] = *(const PG8_LAS bf16x8*)(lds + PG8_SB(b, h) + boff + n * 2048 + k * 1024); } while (0)
#define PG8_MMA(ai, bj, At, Bt) do { __builtin_amdgcn_s_setprio(1); _Pragma("unroll") for (int m = 0; m < 4; ++m) _Pragma("unroll") for (int n = 0; n < 2; ++n) _Pragma("unroll") for (int k = 0; k < 2; ++k) \
        acc[ai][bj][m][n] = __builtin_amdgcn_mfma_f32_16x16x32_bf16(Bt[n][k], At[m][k], acc[ai][bj][m][n], 0, 0, 0); __builtin_amdgcn_s_setprio(0); } while (0)
#define PG8_WAIT_V(n) asm volatile("s_waitcnt vmcnt(" #n ")" ::: "memory")
#define PG8_WAIT_L(n) asm volatile("s_waitcnt lgkmcnt(" #n ")" ::: "memory")
#define PG8_BAR __builtin_amdgcn_s_barrier()
#define PG8_SCHED __builtin_amdgcn_sched_barrier(0)
    Unit cur, nxt; int ui = 0;
    if (!S.next(0, cur)) return;
    f32x4 acc[2][2][4][2];
#pragma unroll
    for (int a = 0; a < 2; ++a)
#pragma unroll
        for (int b = 0; b < 2; ++b)
#pragma unroll
            for (int m = 0; m < 4; ++m)
#pragma unroll
                for (int n = 0; n < 2; ++n) acc[a][b][m][n] = (f32x4){0.f, 0.f, 0.f, 0.f};
    bf16x8 At[4][2], B0[2][2], B1[2][2];
    const char* cA = (const char*)g.A + (size_t)cur.pm * tstep; const char* cB = (const char*)g.Bt + (size_t)cur.pn * tstep;
    S.a_ready(cur);
    if constexpr (SP2) {
        PG8_STAGE(PG8_SB(0, 0), cB, voffB); PG8_STAGE(PG8_SB(0, 1), cB + hstep, voffB); PG8_STAGE(PG8_SA(0, 0), cA, voffA); PG8_STAGE(PG8_SA(0, 1), cA + hstep, voffA);
        if (wr == 1) PG8_BAR;
        PG8_WAIT_V(2); PG8_BAR;
        PG8_STAGE(PG8_SB(1, 0), cB + kstep, voffB); PG8_STAGE(PG8_SA(1, 0), cA + kstep, voffA); PG8_STAGE(PG8_SB(1, 1), cB + hstep + kstep, voffB);
        PG8_WAIT_V(6); PG8_BAR;
    } else {
        PG8_STAGE(PG8_SB(0, 0), cB, voffB); PG8_STAGE(PG8_SA(0, 0), cA, voffA); PG8_STAGE(PG8_SB(0, 1), cB + hstep, voffB); PG8_STAGE(PG8_SA(0, 1), cA + hstep, voffA);
        if (wr == 1) PG8_BAR;
        PG8_WAIT_V(4); PG8_BAR;
        PG8_STAGE(PG8_SB(1, 0), cB + kstep, voffB); PG8_STAGE(PG8_SA(1, 0), cA + kstep, voffA); PG8_STAGE(PG8_SB(1, 1), cB + hstep + kstep, voffB);
        PG8_WAIT_V(6); PG8_BAR;
    }
    for (;;) {
        const bool has_next = S.next(ui + 1, nxt);
        const char* nA = has_next ? (const char*)g.A + (size_t)nxt.pm * tstep : cA; const char* nB = has_next ? (const char*)g.Bt + (size_t)nxt.pn * tstep : cB;
        for (int t = 0; t < nt; t += 2) {
            const bool last = (t == nt - 2);
            const char* a1 = cA + (size_t)(t + 1) * kstep;
            const char* a2 = last ? nA : cA + (size_t)(t + 2) * kstep; const char* b2 = last ? nB : cB + (size_t)(t + 2) * kstep;
            const char* a3 = a2 + kstep; const char* b3 = b2 + kstep;
            if (last && has_next) S.a_ready(nxt);
            if constexpr (SP2) {
            PG8_LDB(B0, 0, 0); PG8_LDB(B1, 0, 1); PG8_SCHED; PG8_LDA(At, 0, 0); PG8_STAGE(PG8_SA(1, 1), a1 + hstep, voffA);
            PG8_WAIT_V(8); PG8_WAIT_L(0); PG8_BAR; PG8_MMA(0, 0, At, B0); PG8_MMA(0, 1, At, B1); PG8_BAR; PG8_SCHED;
            PG8_LDA(At, 0, 1); PG8_STAGE(PG8_SB(0, 0), b2, voffB); PG8_STAGE(PG8_SB(0, 1), b2 + hstep, voffB); PG8_STAGE(PG8_SA(0, 0), a2, voffA);
            PG8_WAIT_V(8); PG8_WAIT_L(0); PG8_BAR; PG8_MMA(1, 0, At, B0); PG8_MMA(1, 1, At, B1); PG8_BAR; PG8_SCHED;
            PG8_LDB(B0, 1, 0); PG8_LDB(B1, 1, 1); PG8_SCHED; PG8_LDA(At, 1, 0); PG8_STAGE(PG8_SA(0, 1), a2 + hstep, voffA);
            PG8_WAIT_V(8); PG8_WAIT_L(0); PG8_BAR; PG8_MMA(0, 0, At, B0); PG8_MMA(0, 1, At, B1); PG8_BAR; PG8_SCHED;
            PG8_LDA(At, 1, 1); PG8_STAGE(PG8_SB(1, 0), b3, voffB); PG8_STAGE(PG8_SB(1, 1), b3 + hstep, voffB); PG8_STAGE(PG8_SA(1, 0), a3, voffA);
            PG8_WAIT_V(8); PG8_WAIT_L(0); PG8_BAR; PG8_MMA(1, 0, At, B0); PG8_MMA(1, 1, At, B1); PG8_BAR; PG8_SCHED;
            } else {
            PG8_LDB(B0, 0, 0); PG8_SCHED; PG8_LDA(At, 0, 0); PG8_STAGE(PG8_SA(1, 1), a1 + hstep, voffA);
            PG8_WAIT_L(8); PG8_BAR; PG8_WAIT_L(0); PG8_MMA(0, 0, At, B0); PG8_BAR; PG8_SCHED;
            PG8_LDB(B1, 0, 1); PG8_STAGE(PG8_SB(0, 0), b2, voffB);
            PG8_BAR; PG8_WAIT_L(0); PG8_MMA(0, 1, At, B1); PG8_BAR;
            PG8_LDA(At, 0, 1); PG8_STAGE(PG8_SA(0, 0), a2, voffA);
            PG8_BAR; PG8_WAIT_L(0); PG8_MMA(1, 0, At, B0); PG8_BAR; PG8_SCHED;
            PG8_STAGE(PG8_SB(0, 1), b2 + hstep, voffB);
            PG8_WAIT_V(6); PG8_BAR; PG8_MMA(1, 1, At, B1); PG8_BAR;
            PG8_LDB(B0, 1, 0); PG8_SCHED; PG8_LDA(At, 1, 0); PG8_STAGE(PG8_SA(0, 1), a2 + hstep, voffA);
            PG8_WAIT_L(8); PG8_BAR; PG8_WAIT_L(0); PG8_MMA(0, 0, At, B0); PG8_BAR; PG8_SCHED;
            PG8_LDB(B1, 1, 1); PG8_STAGE(PG8_SB(1, 0), b3, voffB);
            PG8_BAR; PG8_WAIT_L(0); PG8_MMA(0, 1, At, B1); PG8_BAR;
            PG8_LDA(At, 1, 1); PG8_STAGE(PG8_SA(1, 0), a3, voffA);
            PG8_BAR; PG8_WAIT_L(0); PG8_MMA(1, 0, At, B0); PG8_BAR; PG8_SCHED;
            PG8_STAGE(PG8_SB(1, 1), b3 + hstep, voffB);
            PG8_WAIT_V(6); PG8_BAR; PG8_MMA(1, 1, At, B1); PG8_BAR;
            }
        }
        if constexpr (ALIGN_EPI) { if (wr == 0) PG8_BAR; }
        if constexpr (!Epi::AFTER_DRAIN) { E(acc, cur, wr, wc, fr, fq); S.done(cur); }
        if (!has_next) break;
#pragma unroll
        for (int a = 0; a < 2; ++a)
#pragma unroll
            for (int b = 0; b < 2; ++b)
#pragma unroll
                for (int m = 0; m < 4; ++m)
#pragma unroll
                    for (int n = 0; n < 2; ++n) acc[a][b][m][n] = (f32x4){0.f, 0.f, 0.f, 0.f};
        cur = nxt; cA = nA; cB = nB; ++ui;
        if constexpr (ALIGN_EPI) { if (wr == 1) PG8_BAR; }
    }
    PG8_WAIT_V(0);
    if constexpr (!ALIGN_EPI) { if (wr == 0) PG8_BAR; }
    PG8_BAR;
    if constexpr (Epi::AFTER_DRAIN) { E.fused(acc, cur, wr, wc, fr, fq, lds, wid, lane); S.done(cur); }
#undef PG8_SA
#undef PG8_SB
#undef PG8_STAGE
#undef PG8_LDA
#undef PG8_LDB
#undef PG8_MMA
#undef PG8_WAIT_V
#undef PG8_WAIT_L
#undef PG8_BAR
#undef PG8_SCHED
}
}

namespace pg8 {
struct EpiProj {
    static constexpr bool PERM = true, AFTER_DRAIN = false;
    bf16_t* H; const float* g; const float* gd;
    const float* rowss;
    __device__ __forceinline__ void operator()(const f32x4 (&acc)[2][2][4][2], const Unit& u, int wr, int wc, int fr, int fq) const {
        const int pn = u.pn;
        int mode = 0; const float* gain = nullptr;
        const float qs = (pn == 0 || pn == 3 || pn == 8) ? 0.125f * 1.4426950408889634f : (pn == 5 ? 0.17677669529663687f * 1.4426950408889634f : 1.f);
        if (pn == 0) { mode = 1; gain = g; } else if (pn == 1) { mode = 1; gain = g + 64; } else if (pn == 3) { mode = 1; gain = g + 128; }
        else if (pn == 4) { if (wc < 2) { mode = 1; gain = g + 192; } }
        else if (pn == 5) { mode = 2; gain = gd; } else if (pn == 6) { mode = 2; gain = gd + 32; }
        else if (pn == 8) { mode = 1; gain = g + 256; }
        else if (pn == 9) { if (wc == 2) { mode = 1; gain = g + 384; } }
        else if (pn == 10) { if (wc == 0) { mode = 1; gain = g + 448; } else if (wc == 2) mode = 4; }
        else if (pn >= 11) mode = 3;
        f32x4 gv[2][2];
#pragma unroll
        for (int bj = 0; bj < 2; ++bj)
#pragma unroll
            for (int n = 0; n < 2; ++n) gv[bj][n] = (f32x4){1.f, 1.f, 1.f, 1.f};
        if (mode == 1) {
#pragma unroll
            for (int bj = 0; bj < 2; ++bj)
#pragma unroll
                for (int n = 0; n < 2; ++n) gv[bj][n] = *(const f32x4*)(gain + 32 * bj + 8 * fq + 4 * n);
        } else if (mode == 2) {
#pragma unroll
            for (int bj = 0; bj < 2; ++bj)
#pragma unroll
                for (int n = 0; n < 2; ++n) gv[bj][n] = *(const f32x4*)(gain + 8 * fq + 4 * n);
        }
        const int col0 = pn * BM + 64 * wc + 8 * fq;
#pragma unroll
        for (int ai = 0; ai < 2; ++ai)
#pragma unroll
            for (int m = 0; m < 4; ++m) {
                const int row = u.pm * BM + ai * HALF + wr * 64 + m * 16 + fr;
                f32x4 v[2][2];
                const float rsc = rowss ? rsqrtf((float)((const unsigned long long*)rowss)[row] * (1.f / (1048576.f * 1024.f)) + 1e-6f) : 1.f;
#pragma unroll
                for (int bj = 0; bj < 2; ++bj)
#pragma unroll
                    for (int n = 0; n < 2; ++n) v[bj][n] = acc[ai][bj][m][n] * rsc;
                if (mode == 1 || mode == 2) {
                    float s0 = 0.f, s1 = 0.f;
#pragma unroll
                    for (int n = 0; n < 2; ++n) {
                        s0 += v[0][n][0] * v[0][n][0] + v[0][n][1] * v[0][n][1] + v[0][n][2] * v[0][n][2] + v[0][n][3] * v[0][n][3];
                        s1 += v[1][n][0] * v[1][n][0] + v[1][n][1] * v[1][n][1] + v[1][n][2] * v[1][n][2] + v[1][n][3] * v[1][n][3];
                    }
                    s0 += __shfl_xor(s0, 16); s0 += __shfl_xor(s0, 32);
                    s1 += __shfl_xor(s1, 16); s1 += __shfl_xor(s1, 32);
                    float r0, r1;
                    if (mode == 1) { r0 = r1 = rsqrtf((s0 + s1) * (1.f / 64.f) + 1e-6f) * qs; }
                    else { r0 = rsqrtf(s0 * (1.f / 32.f) + 1e-6f) * qs; r1 = rsqrtf(s1 * (1.f / 32.f) + 1e-6f) * qs; }
#pragma unroll
                    for (int n = 0; n < 2; ++n) { v[0][n] = v[0][n] * r0 * gv[0][n]; v[1][n] = v[1][n] * r1 * gv[1][n]; }
                } else if (mode == 3) {
#pragma unroll
                    for (int bj = 0; bj < 2; ++bj)
#pragma unroll
                        for (int n = 0; n < 2; ++n)
#pragma unroll
                            for (int e = 0; e < 4; ++e) { const float x = v[bj][n][e]; v[bj][n][e] = x * __builtin_amdgcn_rcpf(1.f + __expf(-x)); }
                } else if (mode == 4) {
#pragma unroll
                    for (int bj = 0; bj < 2; ++bj)
#pragma unroll
                        for (int n = 0; n < 2; ++n)
#pragma unroll
                            for (int e = 0; e < 4; ++e) { const float x = v[bj][n][e]; v[bj][n][e] = __builtin_amdgcn_rcpf(1.f + __expf(-x)); }
                }
                bf16_t* rowp = H + (size_t)row * 3840 + col0;
#pragma unroll
                for (int bj = 0; bj < 2; ++bj) {
                    u32x4 w; w.x = cvt_pk_bf16(v[bj][0][0], v[bj][0][1]); w.y = cvt_pk_bf16(v[bj][0][2], v[bj][0][3]);
                    w.z = cvt_pk_bf16(v[bj][1][0], v[bj][1][1]); w.w = cvt_pk_bf16(v[bj][1][2], v[bj][1][3]);
                    *(u32x4*)(rowp + 32 * bj) = w;
                }
            }
    }
};
struct EpiOut {
    static constexpr bool PERM = false, AFTER_DRAIN = false;
    const float* xprev32;
    const bf16_t* xprev16;
    float* out;
    PG8_LAS float* exch;
    bf16_t* x1b; float* rowss;
    __device__ __forceinline__ void operator()(const f32x4 (&acc)[2][2][4][2], const Unit& u, int wr, int wc, int fr, int fq) const {
        const int col0 = u.pn * BM + wc * 32 + 4 * fq;
        const bool first = xprev32 != nullptr;
#pragma unroll
        for (int ai = 0; ai < 2; ++ai)
#pragma unroll
            for (int m = 0; m < 4; ++m) {
                const int row = u.pm * BM + ai * HALF + wr * 64 + m * 16 + fr;
                const size_t off = (size_t)row * 1024 + col0;
                float ss = 0.f;
#pragma unroll
                for (int bj = 0; bj < 2; ++bj)
#pragma unroll
                    for (int n = 0; n < 2; ++n) {
                        if (first) {
                            const f32x4 b = *(const f32x4*)(xprev32 + off + bj * HALF + n * 16);
                            const f32x4 v = b + acc[ai][bj][m][n];
                            ss += (v[0] * v[0] + v[1] * v[1]) + (v[2] * v[2] + v[3] * v[3]);
                            uint2 o; o.x = cvt_pk_bf16(v[0], v[1]); o.y = cvt_pk_bf16(v[2], v[3]);
                            *(uint2*)(x1b + off + bj * HALF + n * 16) = o;
                        } else {
                            const uint2 r = *(const uint2*)(xprev16 + off + bj * HALF + n * 16);
                            const f32x4 b = (f32x4){__uint_as_float(r.x << 16), __uint_as_float(r.x & 0xffff0000u), __uint_as_float(r.y << 16), __uint_as_float(r.y & 0xffff0000u)};
                            *(f32x4*)(out + off + bj * HALF + n * 16) = b + acc[ai][bj][m][n];
                        }
                    }
                if (first) {
                    ss += __shfl_xor(ss, 16); ss += __shfl_xor(ss, 32);
                    if (fq == 0) exch[(ai * HALF + wr * 64 + m * 16 + fr) * 4 + wc] = ss;
                }
            }
        if (first) {
            asm volatile("s_waitcnt lgkmcnt(0)" ::: "memory"); __builtin_amdgcn_s_barrier(); asm volatile("" ::: "memory");
            if (wc == 0) {
                const int lane = fq * 16 + fr;
#pragma unroll
                for (int k = 0; k < 2; ++k) {
                    const int rl = k * HALF + wr * 64 + lane;
                    const f32x4 p = *(const PG8_LAS f32x4*)(exch + rl * 4);
                    const float tot = (p[0] + p[1]) + (p[2] + p[3]);
                    atomicAdd((unsigned long long*)rowss + (u.pm * BM + rl), (unsigned long long)(tot * 1048576.f + 0.5f));
                }
            }
        }
    }
};
}

template <int MODE>
__device__ __forceinline__ void p0_transpose_item(const float* __restrict__ W, bf16_t* __restrict__ WT, LAS float* scr, int item, int lane, int KR = 1024, int NC = 1024, const float* __restrict__ gk = nullptr) {
    const int NSRC = MODE == 0 ? 3724 : NC, NG = MODE == 0 ? 120 : NC / 32;
    const int kb = item / NG, nb = item % NG, k0 = 64 * kb, hc0 = 32 * nb;
    const int hc = hc0 + (lane & 31);
    int src = hc;
    if (MODE == 0) src = hc < 2700 ? hc : (hc < 2816 ? -1 : hc - 116);
    float wv[32];
#pragma unroll
    for (int i = 0; i < 32; ++i) { const int kk = 2 * i + (lane >> 5); wv[i] = src >= 0 ? W[(size_t)(k0 + kk) * NSRC + src] : 0.f; }
#pragma unroll
    for (int i = 0; i < 32; ++i) { const int kk = 2 * i + (lane >> 5); scr[kk * 33 + (lane & 31)] = MODE == 0 ? wv[i] * gk[k0 + kk] : wv[i]; }
    asm volatile("s_waitcnt lgkmcnt(0)" ::: "memory");
    const int c = lane & 7;
#pragma unroll
    for (int j = 0; j < 4; ++j) {
        const int n = (lane >> 3) + 8 * j; const LAS float* s = scr + (8 * c) * 33 + n;
        const int hcn = hc0 + n;
        int drow = hcn;
        if (MODE == 0) drow = (hcn & ~255) + ((hcn >> 5) & 1) * 128 + ((hcn >> 6) & 3) * 32 + (hcn & 31);
        uint4 o; o.x = (unsigned)f2bf(s[0]) | ((unsigned)f2bf(s[33]) << 16); o.y = (unsigned)f2bf(s[66]) | ((unsigned)f2bf(s[99]) << 16);
        o.z = (unsigned)f2bf(s[132]) | ((unsigned)f2bf(s[165]) << 16); o.w = (unsigned)f2bf(s[198]) | ((unsigned)f2bf(s[231]) << 16);
        if (MODE == 2) { const int k = k0 + 8 * c; *(uint4*)(WT + ((size_t)((((drow >> 5) * 8 + (k >> 8)) * 16 + ((k >> 4) & 15)) * 64 + ((k >> 3) & 1) * 32 + (drow & 31))) * 8) = o; }
        else *(uint4*)(WT + (size_t)drow * KR + k0 + 8 * c) = o;
    }
    asm volatile("s_waitcnt lgkmcnt(0)" ::: "memory");
}

namespace att {
typedef short bf16x8 __attribute__((ext_vector_type(8)));
typedef short v4i16 __attribute__((ext_vector_type(4)));
typedef float f32x16 __attribute__((ext_vector_type(16)));
typedef float f32x2_t __attribute__((ext_vector_type(2)));
typedef __bf16 bf16x2_t __attribute__((ext_vector_type(2)));
typedef unsigned u32x4 __attribute__((ext_vector_type(4)));
typedef float f32x4 __attribute__((ext_vector_type(4)));
__device__ __forceinline__ unsigned cvtpk(float lo, float hi) { f32x2_t v = {lo, hi}; bf16x2_t b = __builtin_convertvector(v, bf16x2_t); return __builtin_bit_cast(unsigned, b); }
__device__ __forceinline__ int crow(int r, int h) { return (r & 3) + 8 * (r >> 2) + 4 * h; }
constexpr float LOG2E = 1.4426950408889634f;
constexpr int L_KV = 0, KVB = 16384  , L_TAB = 32768  , L_WSCR = 83968  , L_IMP = 92160  , L_Q = 124928, L_SEL = 125184  , L_SB = 126464  ;

struct StageRegs { u32x4 k, v; };
__device__ __forceinline__ void stage_load(StageRegs& sr, const bf16_t* kp, const bf16_t* vp, bool valid, int ch) {
    sr.k = (u32x4){0u, 0u, 0u, 0u}; sr.v = sr.k;
    if (valid) { sr.k = *(const u32x4*)(kp + ch * 8); sr.v = *(const u32x4*)(vp + ch * 8); }
}
__device__ __forceinline__ void stage_write(LAS unsigned char* buf, const StageRegs& sr, int row, int ch) {
    *(LAS u32x4*)(buf + row * 128 + ((ch ^ (row & 7)) << 4)) = sr.k;
    *(LAS u32x4*)(buf + 8192 + (ch >> 2) * 4096 + row * 64 + (ch & 3) * 16) = sr.v;
}
__device__ __forceinline__ f32x16 load_tab16(const LAS float* tbl, int TSP, int jb) {
    const int sh = jb & 3; const LAS float* tp = tbl + sh * TSP + (jb - sh);
    const f32x4 t0 = *(const LAS f32x4*)(tp), t1 = *(const LAS f32x4*)(tp + 8), t2 = *(const LAS f32x4*)(tp + 16), t3 = *(const LAS f32x4*)(tp + 24);
    return (f32x16){t0[0], t0[1], t0[2], t0[3], t1[0], t1[1], t1[2], t1[3], t2[0], t2[1], t2[2], t2[3], t3[0], t3[1], t3[2], t3[3]};
}
__device__ __forceinline__ float exp_sum16(f32x16& acc) {
    float sa = 0.f, sb = 0.f;
#pragma unroll
    for (int r = 0; r < 16; r += 2) {
        acc[r] = __builtin_amdgcn_exp2f(acc[r]); acc[r + 1] = __builtin_amdgcn_exp2f(acc[r + 1]);
        sa += acc[r]; asm volatile("" : "+v"(sa)); sb += acc[r + 1]; asm volatile("" : "+v"(sb));
    }
    return sa + sb;
}
__device__ __forceinline__ f32x16 splat16(float v) { return (f32x16){v, v, v, v, v, v, v, v, v, v, v, v, v, v, v, v}; }
template <int S0, int S1>
__device__ __forceinline__ void qk_sub(f32x16& acc, const LAS unsigned char* buf, int sub, const bf16x8* qf, int lane) {
    const int key = 32 * sub + (lane & 31), h = lane >> 5;
    bf16x8 kf[S1 - S0];
#pragma unroll
    for (int s = S0; s < S1; ++s) kf[s - S0] = *(const LAS bf16x8*)(buf + key * 128 + (((2 * s + h) ^ (key & 7)) << 4));
    __builtin_amdgcn_sched_barrier(0);
#pragma unroll
    for (int s = S0; s < S1; ++s) acc = __builtin_amdgcn_mfma_f32_32x32x16_bf16(kf[s - S0], qf[s], acc, 0, 0, 0);
}
__device__ __forceinline__ void pack_p(const f32x16& p, bf16x8& pa0, bf16x8& pa1) {
    u32x4 w0, w1;
    w0.x = cvtpk(p[0], p[1]); w0.y = cvtpk(p[2], p[3]); w0.z = cvtpk(p[4], p[5]); w0.w = cvtpk(p[6], p[7]);
    w1.x = cvtpk(p[8], p[9]); w1.y = cvtpk(p[10], p[11]); w1.z = cvtpk(p[12], p[13]); w1.w = cvtpk(p[14], p[15]);
    pa0 = __builtin_bit_cast(bf16x8, w0); pa1 = __builtin_bit_cast(bf16x8, w1);
}
__device__ __forceinline__ void pv_sub(f32x16* o, const LAS unsigned char* buf, int sub, const bf16x8& pa0, const bf16x8& pa1, int lane) {
    const int h = lane >> 5, g16 = (lane >> 4) & 1, q4 = (lane & 15) >> 2, p4 = lane & 3;
    const LAS unsigned char* vb = buf + 8192 + (32 * sub + 4 * h + q4) * 64 + (16 * g16 + 4 * p4) * 2;
    bf16x8 vf[2][2];
#pragma unroll
    for (int dt = 0; dt < 2; ++dt) {
#pragma unroll
        for (int s2 = 0; s2 < 2; ++s2) {
            const v4i16 lo = __builtin_amdgcn_ds_read_tr16_b64_v4i16((LAS v4i16*)(vb + dt * 4096 + s2 * 1024));
            const v4i16 hi = __builtin_amdgcn_ds_read_tr16_b64_v4i16((LAS v4i16*)(vb + dt * 4096 + s2 * 1024 + 512));
            vf[dt][s2] = (bf16x8){lo[0], lo[1], lo[2], lo[3], hi[0], hi[1], hi[2], hi[3]};
        }
    }
    __builtin_amdgcn_sched_barrier(0);
    o[0] = __builtin_amdgcn_mfma_f32_32x32x16_bf16(pa0, vf[0][0], o[0], 0, 0, 0);
    o[1] = __builtin_amdgcn_mfma_f32_32x32x16_bf16(pa0, vf[1][0], o[1], 0, 0, 0);
    o[0] = __builtin_amdgcn_mfma_f32_32x32x16_bf16(pa1, vf[0][1], o[0], 0, 0, 0);
    o[1] = __builtin_amdgcn_mfma_f32_32x32x16_bf16(pa1, vf[1][1], o[1], 0, 0, 0);
}

__device__ __forceinline__ void pv_sub2(f32x16* oa, f32x16* ob, const LAS unsigned char* buf, int sub, const bf16x8& a0, const bf16x8& a1, const bf16x8& b0, const bf16x8& b1, int lane) {
    const int h = lane >> 5, g16 = (lane >> 4) & 1, q4 = (lane & 15) >> 2, p4 = lane & 3;
    const LAS unsigned char* vb = buf + 8192 + (32 * sub + 4 * h + q4) * 64 + (16 * g16 + 4 * p4) * 2;
#pragma unroll
    for (int dt = 0; dt < 2; ++dt) {
#pragma unroll
        for (int s2 = 0; s2 < 2; ++s2) {
            const v4i16 lo = __builtin_amdgcn_ds_read_tr16_b64_v4i16((LAS v4i16*)(vb + dt * 4096 + s2 * 1024));
            const v4i16 hi = __builtin_amdgcn_ds_read_tr16_b64_v4i16((LAS v4i16*)(vb + dt * 4096 + s2 * 1024 + 512));
            const bf16x8 vf = (bf16x8){lo[0], lo[1], lo[2], lo[3], hi[0], hi[1], hi[2], hi[3]};
            oa[dt] = __builtin_amdgcn_mfma_f32_32x32x16_bf16(s2 == 0 ? a0 : a1, vf, oa[dt], 0, 0, 0);
            ob[dt] = __builtin_amdgcn_mfma_f32_32x32x16_bf16(s2 == 0 ? b0 : b1, vf, ob[dt], 0, 0, 0);
        }
    }
}

struct BandArgs {
    const bf16_t* Hb;
    int cq, ck, cv;
    int rate, cls, f0, maxd;
    const float* bias;
    float M;
    float sinkterm;
    bf16_t* OA; float* DA;
    bf16_t* Y; int ycol;
    int hd; size_t brow;
};
constexpr int B_TAB = 98304, B_WSCR = 106496;
template <int MODE>
__device__ __forceinline__ void banded_unit(LAS unsigned char* lds, const BandArgs& P) {
    const int tid = opq(threadIdx.x), lane = tid & 63, w = __builtin_amdgcn_readfirstlane(tid >> 6), h = lane >> 5;
    LAS float* sb = (LAS float*)(lds + L_SB);
    LAS float* tbl = (LAS float*)(lds + B_TAB);
    const int KPREV = ((P.maxd + 63) >> 6) << 6;
    const int t0 = (KPREV - P.f0) > 0 ? ((KPREV - P.f0) >> 6) : 0;
    const int srow = tid >> 3, sch = tid & 7;
    StageRegs sr[6];
#pragma unroll
    for (int i = 0; i < 6; ++i) {
        int kf = P.f0 - KPREV + 64 * i + srow; kf = kf < 0 ? 0 : kf;
        const bf16_t* rp = P.Hb + ((size_t)kf * P.rate + P.cls) * HP;
        stage_load(sr[i], rp + P.ck, rp + P.cv, true, sch);
    }
    const int fq0 = P.f0 + 32 * w;
    bf16x8 qf[4];
    {
        const size_t tq = (size_t)(fq0 + (lane & 31)) * P.rate + P.cls;
        const bf16_t* qp = P.Hb + tq * HP + P.cq + 8 * h;
#pragma unroll
        for (int s = 0; s < 4; ++s) qf[s] = *(const bf16x8*)(qp + 16 * s);
    }
    if (tid < 32) sb[tid] = (P.bias[tid * 16] - P.M) * LOG2E;
    __syncthreads();
    const int DMAXI = P.maxd + 62, TS = P.maxd + 125, TSP = (TS + 7) & ~3;
    for (int e = tid; e < 4 * TSP; e += 512) {
        const int sh = e / TSP, j = e - sh * TSP + sh, dist = DMAXI - j;
        tbl[e] = (j < TS && dist >= 0 && dist <= P.maxd) ? sb[t5_bucket(dist * P.rate)] : -1e30f;
    }
    f32x16 o[2]; o[0] = (f32x16){}; o[1] = (f32x16){};
    float den = 0.f;
#pragma unroll
    for (int i = 0; i < 6; ++i) stage_write(lds + i * KVB, sr[i], srow, sch);
    asm volatile("" : "+v"(qf[0]), "+v"(qf[1]), "+v"(qf[2]), "+v"(qf[3]));
    __syncthreads();
#pragma unroll 1
    for (int t = t0; t < 6; ++t) {
        const LAS unsigned char* buf = lds + t * KVB;
        const int kf0 = P.f0 - KPREV + 64 * t;
#pragma unroll
        for (int sub = 0; sub < 2; ++sub) {
            const int kfs = kf0 + 32 * sub;
            if (kfs <= fq0 + 31 && kfs + 31 >= fq0 - P.maxd) {
                const int jb = DMAXI - ((fq0 - kfs) + (lane & 31) - 4 * h);
                f32x16 acc = load_tab16(tbl, TSP, jb);
                qk_sub<0, 4>(acc, buf, sub, qf, lane);
                den += exp_sum16(acc);
                bf16x8 pa0, pa1; pack_p(acc, pa0, pa1);
                pv_sub(o, buf, sub, pa0, pa1, lane);
            }
        }
    }
    float dtot = den + __shfl_xor(den, 32);
    if (MODE == 1) dtot += P.sinkterm;
    LAS float* ws_ = (LAS float*)(lds + B_WSCR) + w * 64;
    if (h == 0) ws_[lane] = dtot;
    if (MODE == 0 && h == 0) {
        const size_t tq = (size_t)(fq0 + lane) * P.rate + P.cls;
        P.DA[(P.brow + tq) * 4 + P.hd] = dtot;
    }
    asm volatile("s_waitcnt lgkmcnt(0)" ::: "memory");
#pragma unroll
    for (int r = 0; r < 16; ++r) {
        const int qi = crow(r, h);
        const float inv = __builtin_amdgcn_rcpf(ws_[qi]);
        const size_t row = P.brow + (size_t)(fq0 + qi) * P.rate + P.cls;
#pragma unroll
        for (int dt = 0; dt < 2; ++dt) {
            const int d = 32 * dt + (lane & 31);
            const float val = o[dt][r] * inv;
            if (MODE == 0) P.OA[row * 256 + P.hd * 64 + d] = f2bf(val);
            else P.Y[row * DM + P.ycol + d] = f2bf(val * bf2f(P.Hb[(row - P.brow) * HP + C_SILU + P.ycol + d]));
        }
    }
}

__device__ __forceinline__ void diff_p1(const LAS float* tp, const LAS unsigned char* buf, int sub, const bf16x8* qf, int lane, bf16x8& pa0, bf16x8& pa1, bf16x8& pb0, bf16x8& pb1) {
    const f32x4 t0 = *(const LAS f32x4*)(tp), t1 = *(const LAS f32x4*)(tp + 8), t2 = *(const LAS f32x4*)(tp + 16), t3 = *(const LAS f32x4*)(tp + 24);
    const f32x16 T = (f32x16){t0[0], t0[1], t0[2], t0[3], t1[0], t1[1], t1[2], t1[3], t2[0], t2[1], t2[2], t2[3], t3[0], t3[1], t3[2], t3[3]};
    const int key = 32 * sub + (lane & 31), h = lane >> 5;
    const LAS unsigned char* kp = buf + key * 128;
    const bf16x8 k0 = *(const LAS bf16x8*)(kp + (((0 + h) ^ (key & 7)) << 4)), k1 = *(const LAS bf16x8*)(kp + (((2 + h) ^ (key & 7)) << 4));
    const bf16x8 k2 = *(const LAS bf16x8*)(kp + (((4 + h) ^ (key & 7)) << 4)), k3 = *(const LAS bf16x8*)(kp + (((6 + h) ^ (key & 7)) << 4));
    f32x16 a1 = __builtin_amdgcn_mfma_f32_32x32x16_bf16(k0, qf[0], T, 0, 0, 0);
    f32x16 a2 = __builtin_amdgcn_mfma_f32_32x32x16_bf16(k2, qf[2], T, 0, 0, 0);
    a1 = __builtin_amdgcn_mfma_f32_32x32x16_bf16(k1, qf[1], a1, 0, 0, 0);
    a2 = __builtin_amdgcn_mfma_f32_32x32x16_bf16(k3, qf[3], a2, 0, 0, 0);
#pragma unroll
    for (int r = 0; r < 16; ++r) { a1[r] = __builtin_amdgcn_exp2f(a1[r]); a2[r] = __builtin_amdgcn_exp2f(a2[r]); }
    pack_p(a1, pa0, pa1); pack_p(a2, pb0, pb1);
}
__device__ __forceinline__ void diff_p2(const LAS unsigned char* buf, int sub, int lane, const bf16x8& pa0, const bf16x8& pa1, const bf16x8& pb0, const bf16x8& pb1, f32x16& dn1, f32x16& dn2, f32x16* o1, f32x16* o2) {
    const bf16x8 ones = (bf16x8){0x3F80, 0x3F80, 0x3F80, 0x3F80, 0x3F80, 0x3F80, 0x3F80, 0x3F80};
    const int h = lane >> 5, g16 = (lane >> 4) & 1, q4 = (lane & 15) >> 2, p4 = lane & 3;
    const LAS unsigned char* vb = buf + 8192 + (32 * sub + 4 * h + q4) * 64 + (16 * g16 + 4 * p4) * 2;
    bf16x8 vf[2][2];
#pragma unroll
    for (int dt = 0; dt < 2; ++dt) {
#pragma unroll
        for (int s2 = 0; s2 < 2; ++s2) {
            const v4i16 lo = __builtin_amdgcn_ds_read_tr16_b64_v4i16((LAS v4i16*)(vb + dt * 4096 + s2 * 1024));
            const v4i16 hi = __builtin_amdgcn_ds_read_tr16_b64_v4i16((LAS v4i16*)(vb + dt * 4096 + s2 * 1024 + 512));
            vf[dt][s2] = (bf16x8){lo[0], lo[1], lo[2], lo[3], hi[0], hi[1], hi[2], hi[3]};
        }
    }
    __builtin_amdgcn_sched_barrier(0);
    dn1 = __builtin_amdgcn_mfma_f32_32x32x16_bf16(pa0, ones, dn1, 0, 0, 0);
    dn2 = __builtin_amdgcn_mfma_f32_32x32x16_bf16(pb0, ones, dn2, 0, 0, 0);
    dn1 = __builtin_amdgcn_mfma_f32_32x32x16_bf16(pa1, ones, dn1, 0, 0, 0);
    dn2 = __builtin_amdgcn_mfma_f32_32x32x16_bf16(pb1, ones, dn2, 0, 0, 0);
    o1[0] = __builtin_amdgcn_mfma_f32_32x32x16_bf16(pa0, vf[0][0], o1[0], 0, 0, 0);
    o2[0] = __builtin_amdgcn_mfma_f32_32x32x16_bf16(pb0, vf[0][0], o2[0], 0, 0, 0);
    o1[1] = __builtin_amdgcn_mfma_f32_32x32x16_bf16(pa0, vf[1][0], o1[1], 0, 0, 0);
    o2[1] = __builtin_amdgcn_mfma_f32_32x32x16_bf16(pb0, vf[1][0], o2[1], 0, 0, 0);
    o1[0] = __builtin_amdgcn_mfma_f32_32x32x16_bf16(pa1, vf[0][1], o1[0], 0, 0, 0);
    o2[0] = __builtin_amdgcn_mfma_f32_32x32x16_bf16(pb1, vf[0][1], o2[0], 0, 0, 0);
    o1[1] = __builtin_amdgcn_mfma_f32_32x32x16_bf16(pa1, vf[1][1], o1[1], 0, 0, 0);
    o2[1] = __builtin_amdgcn_mfma_f32_32x32x16_bf16(pb1, vf[1][1], o2[1], 0, 0, 0);
}

struct DiffArgs {
    const bf16_t* Hb; int hd, qb; size_t brow;
    const float* bias; float M; float lam, lambda_init; const float* subln;
    bf16_t* Y;
};
constexpr int D_SB = 49152, D_TAB = 49664;
__device__ __forceinline__ void diff_unit(LAS unsigned char* lds, const DiffArgs& P) {
    const int tid = opq(threadIdx.x), lane = tid & 63, w = __builtin_amdgcn_readfirstlane(tid >> 6), h = lane >> 5;
    LAS float* sb = (LAS float*)(lds + D_SB);
    LAS float* tbl = (LAS float*)(lds + D_TAB);
    constexpr int DTOP = 1574, TS = DTOP + 63, TSP = (TS + 7) & ~3;
    __syncthreads();
    if (tid < 32) sb[tid] = (P.bias[tid * 16] - P.M) * LOG2E;
    __syncthreads();
    for (int e = tid; e < 4 * TSP; e += 512) {
        const int sh = e / TSP, j = e - sh * TSP + sh, dist = DTOP - j;
        tbl[e] = (j < TS && dist >= 0) ? sb[t5_bucket(dist)] : -1e30f;
    }
    LAS float* farc = tbl + 4 * TSP;
    LAS float* deadr = farc + 32;
    if (tid < 32) { farc[tid] = sb[31]; deadr[tid] = -1e30f; }
    const int q0w = P.qb * 256 + 32 * w;
    const int cq = C_CQ + 64 * P.hd, ck = C_CK + 64 * P.hd, cv = C_CV + 64 * P.hd;
    bf16x8 qf[4];
    {
        const bf16_t* qp = P.Hb + (size_t)(q0w + (lane & 31)) * HP + cq + 8 * h;
#pragma unroll
        for (int s = 0; s < 4; ++s) qf[s] = *(const bf16x8*)(qp + 16 * s);
        asm volatile("" : "+v"(qf[0]), "+v"(qf[1]), "+v"(qf[2]), "+v"(qf[3]));
    }
    const int ntl = 4 * (P.qb + 1);
    const int srow = tid >> 3, sch = tid & 7;
    f32x16 o1[2], o2[2]; o1[0] = (f32x16){}; o1[1] = (f32x16){}; o2[0] = (f32x16){}; o2[1] = (f32x16){};
    f32x16 dn1 = (f32x16){}, dn2 = (f32x16){};
    StageRegs sr;
    {
        const bf16_t* rp = P.Hb + (size_t)srow * HP;
        stage_load(sr, rp + ck, rp + cv, true, sch);
        stage_write(lds, sr, srow, sch);
    }
    __syncthreads();
#define DIFF_TP(KS) ({ const int ks_ = (KS); const int jb_ = DTOP - ((q0w - ks_) + (lane & 31) - 4 * h), sh_ = jb_ & 3; \
        const LAS float* tp_ = tbl + sh_ * TSP + (jb_ - sh_); tp_ = (q0w - ks_ - 31 >= 1513) ? farc : tp_; tp_ = (ks_ > q0w + 31) ? deadr : tp_; tp_; })
#define DIFF_STAGE_LOAD(t) do { const int tn_ = (t) + 1 < ntl ? (t) + 1 : (t); const bf16_t* rp_ = P.Hb + (size_t)(64 * tn_ + srow) * HP; stage_load(sr, rp_ + ck, rp_ + cv, true, sch); } while (0)
    if (w < 4) {
        int cur = 0;
        for (int t = 0; t < ntl; ++t) {
            LAS unsigned char* buf = lds + cur * KVB;
            const int nxt = cur == 2 ? 0 : cur + 1;
            DIFF_STAGE_LOAD(t);
            bf16x8 pa0, pa1, pb0, pb1;
            diff_p1(DIFF_TP(64 * t), buf, 0, qf, lane, pa0, pa1, pb0, pb1);
            diff_p2(buf, 0, lane, pa0, pa1, pb0, pb1, dn1, dn2, o1, o2);
            diff_p1(DIFF_TP(64 * t + 32), buf, 1, qf, lane, pa0, pa1, pb0, pb1);
            diff_p2(buf, 1, lane, pa0, pa1, pb0, pb1, dn1, dn2, o1, o2);
            stage_write(lds + nxt * KVB, sr, srow, sch);
            __syncthreads();
            cur = nxt;
        }
    } else {
        const bf16x8 zero8 = (bf16x8){0, 0, 0, 0, 0, 0, 0, 0};
        bf16x8 qa0 = zero8, qa1 = zero8, qb0 = zero8, qb1 = zero8;
        int cur = 0, prv = 0;
        __builtin_amdgcn_s_setprio(1);
        for (int t = 0; t < ntl; ++t) {
            LAS unsigned char* buf = lds + cur * KVB;
            const int nxt = cur == 2 ? 0 : cur + 1;
            DIFF_STAGE_LOAD(t);
            diff_p2(lds + prv * KVB, 1, lane, qa0, qa1, qb0, qb1, dn1, dn2, o1, o2);
            bf16x8 pa0, pa1, pb0, pb1;
            diff_p1(DIFF_TP(64 * t), buf, 0, qf, lane, pa0, pa1, pb0, pb1);
            diff_p2(buf, 0, lane, pa0, pa1, pb0, pb1, dn1, dn2, o1, o2);
            diff_p1(DIFF_TP(64 * t + 32), buf, 1, qf, lane, qa0, qa1, qb0, qb1);
            stage_write(lds + nxt * KVB, sr, srow, sch);
            __syncthreads();
            prv = cur; cur = nxt;
        }
        diff_p2(lds + prv * KVB, 1, lane, qa0, qa1, qb0, qb1, dn1, dn2, o1, o2);
        __builtin_amdgcn_s_setprio(0);
    }
    __syncthreads();
#undef DIFF_TP
#undef DIFF_STAGE_LOAD
    const float g0 = P.subln[lane & 31] * (1.f - P.lambda_init), g1 = P.subln[32 + (lane & 31)] * (1.f - P.lambda_init);
    const int ycol = 512 + 64 * P.hd;
#pragma unroll
    for (int r = 0; r < 16; ++r) {
        const int qi = crow(r, h);
        const float i1 = __builtin_amdgcn_rcpf(dn1[r]), i2 = P.lam * __builtin_amdgcn_rcpf(dn2[r]);
        const float a0 = o1[0][r] * i1 - o2[0][r] * i2, a1 = o1[1][r] * i1 - o2[1][r] * i2;
        float ss = a0 * a0 + a1 * a1;
        ss += __shfl_xor(ss, 1); ss += __shfl_xor(ss, 2); ss += __shfl_xor(ss, 4); ss += __shfl_xor(ss, 8); ss += __shfl_xor(ss, 16);
        const float rs = rsqrtf(ss * (1.f / 64.f) + 1e-6f);
        const size_t trow = (size_t)(q0w + qi);
        const bf16_t* sp = P.Hb + trow * HP + C_SILU + ycol;
        bf16_t* yp = P.Y + (P.brow + trow) * DM + ycol;
        yp[lane & 31] = f2bf(a0 * rs * g0 * bf2f(sp[lane & 31]));
        yp[32 + (lane & 31)] = f2bf(a1 * rs * g1 * bf2f(sp[32 + (lane & 31)]));
    }
}
struct CmpArgs {
    const bf16_t* Hb;
    int col;
    int rt;
    const float* pos;
    const bf16_t* W1T;
    const float* b1;
    const bf16_t* W2T;
    const float* b2;
    const float* gain;
    bf16_t* OUT;
};
__device__ __forceinline__ void cmp_unit(LAS unsigned char* lds, const CmpArgs& P) {
    const int tid = opq(threadIdx.x), lane = tid & 63, w = __builtin_amdgcn_readfirstlane(tid >> 6), h = lane >> 5;
    LAS unsigned char* hidl = lds + L_KV;
    LAS float* ssx = (LAS float*)(lds + L_KV + 32768 - 512);
    LAS unsigned char* abuf = lds + L_TAB;
    f32x16 acc = (f32x16){};
    const bf16_t* w1p = P.W1T + (size_t)w * (8 * 16 * 64 * 8) + lane * 8;
    u32x4 araw[2]; f32x4 apos[2][2];
#define CMP_ALOAD(ch) do { _Pragma("unroll") for (int q_ = 0; q_ < 2; ++q_) { const int p_ = tid + 512 * q_, row_ = p_ >> 5, kc_ = p_ & 31; \
        int ir_ = 32 * P.rt + row_; if (ir_ > 510) ir_ = 510; const int tok_ = 4 * (ch) + (kc_ >> 3), d_ = 8 * (kc_ & 7); \
        araw[q_] = *(const u32x4*)(P.Hb + (size_t)(16 * ir_ + tok_) * HP + P.col + d_); \
        apos[q_][0] = *(const f32x4*)(P.pos + tok_ * 64 + d_); apos[q_][1] = *(const f32x4*)(P.pos + tok_ * 64 + d_ + 4); } } while (0)
#define CMP_AWRITE(bufi) do { _Pragma("unroll") for (int q_ = 0; q_ < 2; ++q_) { const int p_ = tid + 512 * q_, row_ = p_ >> 5, kc_ = p_ & 31; u32x4 aw_; \
        aw_.x = cvtpk(__uint_as_float(araw[q_].x << 16) + apos[q_][0][0], __uint_as_float(araw[q_].x & 0xffff0000u) + apos[q_][0][1]); \
        aw_.y = cvtpk(__uint_as_float(araw[q_].y << 16) + apos[q_][0][2], __uint_as_float(araw[q_].y & 0xffff0000u) + apos[q_][0][3]); \
        aw_.z = cvtpk(__uint_as_float(araw[q_].z << 16) + apos[q_][1][0], __uint_as_float(araw[q_].z & 0xffff0000u) + apos[q_][1][1]); \
        aw_.w = cvtpk(__uint_as_float(araw[q_].w << 16) + apos[q_][1][2], __uint_as_float(araw[q_].w & 0xffff0000u) + apos[q_][1][3]); \
        *(LAS u32x4*)(abuf + (bufi) * 16896 + row_ * 528 + kc_ * 16) = aw_; } } while (0)
    CMP_ALOAD(0); CMP_AWRITE(0);
    __syncthreads();
    for (int ch = 0; ch < 8; ++ch) {
        const int cn = ch + 1 < 8 ? ch + 1 : ch;
        CMP_ALOAD(cn);
        const LAS unsigned char* ab = abuf + (ch & 1) * 16896 + (lane & 31) * 528 + 16 * h;
        bf16x8 bfr[16];
#pragma unroll
        for (int ks = 0; ks < 16; ++ks) bfr[ks] = *(const bf16x8*)(w1p + (ch * 16 + ks) * 512);
#pragma unroll
        for (int ks = 0; ks < 16; ++ks) {
            const bf16x8 af = *(const LAS bf16x8*)(ab + 32 * ks);
            acc = __builtin_amdgcn_mfma_f32_32x32x16_bf16(af, bfr[ks], acc, 0, 0, 0);
        }
        CMP_AWRITE((ch + 1) & 1);
        __syncthreads();
    }
#undef CMP_ALOAD
#undef CMP_AWRITE
    {
        const int j = 32 * w + (lane & 31); const float bb = P.b1[j];
#pragma unroll
        for (int r = 0; r < 16; ++r) {
            const float x = acc[r] + bb;
            const float u = 0.7978845608028654f * (x + 0.044715f * x * x * x);
            const float th = 1.f - 2.f / (1.f + __expf(2.f * u));
            const float gl = 0.5f * x * (1.f + th);
            *(LAS bf16_t*)(hidl + crow(r, h) * 528 + j * 2) = f2bf(gl);
        }
    }
    __syncthreads();
    float outv[16]; float ssp[16];
    if (w < 2) {
        f32x16 a2 = (f32x16){};
        const bf16_t* w2p = P.W2T + (size_t)(32 * w + (lane & 31)) * 256 + 8 * h;
#pragma unroll
        for (int ks = 0; ks < 16; ++ks) {
            const bf16x8 af = *(const LAS bf16x8*)(hidl + (lane & 31) * 528 + (16 * ks + 8 * h) * 2);
            const bf16x8 bfr = *(const bf16x8*)(w2p + 16 * ks);
            a2 = __builtin_amdgcn_mfma_f32_32x32x16_bf16(af, bfr, a2, 0, 0, 0);
        }
        const float bb = P.b2[32 * w + (lane & 31)];
#pragma unroll
        for (int r = 0; r < 16; ++r) {
            outv[r] = a2[r] + bb;
            float ss = outv[r] * outv[r];
            ss += __shfl_xor(ss, 1); ss += __shfl_xor(ss, 2); ss += __shfl_xor(ss, 4); ss += __shfl_xor(ss, 8); ss += __shfl_xor(ss, 16);
            ssp[r] = ss;
            if ((lane & 31) == 0) ssx[w * 32 + crow(r, h)] = ss;
        }
    }
    __syncthreads();
    if (w < 2) {
        const int d = 32 * w + (lane & 31);
        const float gn = P.gain ? P.gain[d] : 1.f;
#pragma unroll
        for (int r = 0; r < 16; ++r) {
            const int row = 32 * P.rt + crow(r, h);
            float v = outv[r];
            if (P.gain) { const float tot = ssx[crow(r, h)] + ssx[32 + crow(r, h)]; v = v * rsqrtf(tot * (1.f / 64.f) + 1e-6f) * gn; }
            if (row <= 510) P.OUT[(size_t)row * 64 + d] = f2bf(v);
        }
    }
    __syncthreads();
}

struct NsaArgs {
    const bf16_t* Hb; size_t brow; int qb;
    const bf16_t* KC; const bf16_t* VC;
    const float* bias;
    const float* Mv;
    bf16_t* Y; unsigned* cdone;
    float* scr;
};
constexpr int GTOP = 2015, GTS = 2519, WTOP = 549, WTS = 588, DEAD = 4 * GTS + 4 * WTS;
__device__ __forceinline__ void nsa_unit(LAS unsigned char* lds, const NsaArgs& P) {
    const int tid = opq(threadIdx.x), lane = tid & 63, w = __builtin_amdgcn_readfirstlane(tid >> 6), hh = lane >> 5;
    const int n = lane & 31, q8 = n >> 2, hd = n & 3;
    LAS float* tg = (LAS float*)(lds + L_TAB);
    LAS float* tw = tg + 4 * GTS;
    LAS float* dead = tg + DEAD;
    LAS float* impw = (LAS float*)(lds + L_IMP) + w * 1024;
    LAS unsigned* selw = (LAS unsigned*)(lds + L_SEL) + w * 32;
    LAS unsigned* uni = (LAS unsigned*)(lds + L_SEL) + 256;
    LAS float* ws_ = (LAS float*)(lds + L_WSCR) + w * 256;
    LAS float* sbh = (LAS float*)(lds + L_SB);
    if (tid < 128) sbh[tid] = (P.bias[(tid & 31) * 16 + (tid >> 5)] - P.Mv[tid >> 5]) * LOG2E;
    __syncthreads();
    for (int e = tid; e < 4 * GTS; e += 512) { const int hq = e / GTS, j = e % GTS, dist = GTOP - j;
        tg[e] = dist >= 0 ? sbh[hq * 32 + t5_bucket(dist)] : -1e30f; }
    for (int e = tid; e < 4 * WTS; e += 512) { const int hq = e / WTS, j = e % WTS, dist = WTOP - j;
        tw[e] = (dist >= 0 && dist <= 511) ? sbh[hq * 32 + t5_bucket(dist)] : -1e30f; }
    if (tid < 64) dead[tid] = -1e30f;
    for (int e = lane; e < 1024; e += 64) impw[e] = 0.f;
    if (tid < 4) uni[tid] = 0u;
    const float cfar = sbh[hd * 32 + 31];
    const int tq = 64 * P.qb + 8 * w + q8;
    const int twmin = 64 * P.qb + 8 * w, twmax = twmin + 7;
    bf16x8 qf[4];
    {
        const bf16_t* qp = P.Hb + (size_t)tq * HP + C_DQ + 64 * hd + 8 * hh;
#pragma unroll
        for (int s = 0; s < 4; ++s) qf[s] = *(const bf16x8*)(qp + 16 * s);
        asm volatile("" : "+v"(qf[0]), "+v"(qf[1]), "+v"(qf[2]), "+v"(qf[3]));
    }
    {
        const bf16_t* gp = P.Hb + (size_t)tq * HP + C_GT + 3 * hd;
        if (hh == 0) { ws_[n] = bf2f(gp[0]); ws_[32 + n] = bf2f(gp[1]); ws_[64 + n] = bf2f(gp[2]); }
    }
    const int srow = tid >> 3, sch = tid & 7;
    StageRegs sr;
    f32x16 o[2], outv[2];
    float den = 0.f;
    o[0] = (f32x16){}; o[1] = (f32x16){};
    {
        const int kt0 = P.qb >= 8 ? P.qb - 8 : 0, nkt = P.qb - kt0 + 1;
        {
            const bf16_t* rp = P.Hb + (size_t)(64 * kt0 + srow) * HP;
            stage_load(sr, rp + C_KW, rp + C_VW, true, sch);
            stage_write(lds + L_KV, sr, srow, sch);
        }
        __syncthreads();
        for (int t = 0; t < nkt; ++t) {
            LAS unsigned char* buf = lds + L_KV + (t & 1) * KVB;
            if (t + 1 < nkt) { const bf16_t* rp = P.Hb + (size_t)(64 * (kt0 + t + 1) + srow) * HP; stage_load(sr, rp + C_KW, rp + C_VW, true, sch); }
#pragma unroll
            for (int sub = 0; sub < 2; ++sub) {
                const int kb = 64 * (kt0 + t) + 32 * sub;
                if (kb <= twmax && kb + 31 >= twmin - 511) {
                    f32x16 acc;
                    const LAS float* tb = tw + hd * WTS + (WTOP - (tq - kb - 4 * hh));
#pragma unroll
                    for (int r = 0; r < 16; ++r) acc[r] = tb[(r & 3) + 8 * (r >> 2)];
                    qk_sub<0, 4>(acc, buf, sub, qf, lane);
#pragma unroll
                    for (int r = 0; r < 1; ++r) den += exp_sum16(acc);
                    bf16x8 pa0, pa1; pack_p(acc, pa0, pa1);
                    pv_sub(o, buf, sub, pa0, pa1, lane);
                }
            }
            if (t + 1 < nkt) stage_write(lds + L_KV + ((t + 1) & 1) * KVB, sr, srow, sch);
            __syncthreads();
        }
    }
    {
        const float dt = den + __shfl_xor(den, 32);
        if (hh == 0) ws_[128 + n] = __builtin_amdgcn_rcpf(dt);
        asm volatile("s_waitcnt lgkmcnt(0)" ::: "memory");
#pragma unroll
        for (int r = 0; r < 16; ++r) { const int nn = crow(r, hh); const float gi = ws_[64 + nn] * ws_[128 + nn]; outv[0][r] = o[0][r] * gi; outv[1][r] = o[1][r] * gi; }
    }
    if (opq(threadIdx.x) == 128) {
        unsigned sp = 0;
        while (__hip_atomic_load(P.cdone, __ATOMIC_RELAXED, __HIP_MEMORY_SCOPE_AGENT) < 64u) { __builtin_amdgcn_s_sleep(2); if (++sp > (1u << 24)) break; }
        __builtin_amdgcn_fence(__ATOMIC_ACQUIRE, "agent"); asm volatile("s_waitcnt vmcnt(0)" ::: "memory");
    }
    __syncthreads();
    const int tlast = 64 * P.qb + 63;
    const int ntc = tlast >= 31 ? (((tlast - 31) >> 4) >> 6) + 1 : 0;
    float invden = 0.f; den = 0.f;
    o[0] = (f32x16){}; o[1] = (f32x16){};
    for (int pass = 0; pass < 2; ++pass) {
        if (ntc > 0) {
            __syncthreads();
            stage_load(sr, P.KC + (size_t)srow * 64, P.VC + (size_t)srow * 64, true, sch);
            stage_write(lds + L_KV, sr, srow, sch);
            __syncthreads();
            for (int t = 0; t < ntc; ++t) {
                LAS unsigned char* buf = lds + L_KV + (t & 1) * KVB;
                if (t + 1 < ntc) stage_load(sr, P.KC + (size_t)(64 * (t + 1) + srow) * 64, P.VC + (size_t)(64 * (t + 1) + srow) * 64, true, sch);
#pragma unroll
                for (int sub = 0; sub < 2; ++sub) {
                    const int cb = 64 * t + 32 * sub;
                    if (16 * cb + 31 <= twmax) {
                        f32x16 acc;
                        const int dmin = twmin - 16 * (cb + 31) - 31;
                        if (dmin >= 1513) acc = splat16(cfar);
                        else {
                            const LAS float* tb = tg + hd * GTS + (GTOP - (tq - 31 - 16 * cb - 64 * hh));
#pragma unroll
                            for (int r = 0; r < 16; ++r) acc[r] = tb[16 * ((r & 3) + 8 * (r >> 2))];
                        }
                        qk_sub<0, 4>(acc, buf, sub, qf, lane);
#pragma unroll
                        for (int r = 0; r < 16; ++r) acc[r] = __builtin_amdgcn_exp2f(acc[r]);
                        if (pass == 0) {
#pragma unroll
                            for (int r = 0; r < 16; ++r) { den += acc[r]; asm volatile("" : "+v"(den)); }
                        } else {
#pragma unroll
                            for (int r = 0; r < 16; ++r) acc[r] *= invden;
#pragma unroll
                            for (int g = 0; g < 4; ++g) {
                                float G = (acc[4 * g] + acc[4 * g + 1]) + (acc[4 * g + 2] + acc[4 * g + 3]), C = acc[4 * g + 3];
                                G += __shfl_xor(G, 1); G += __shfl_xor(G, 2); C += __shfl_xor(C, 1); C += __shfl_xor(C, 2);
                                if (hd == 0) {
                                    const int j = (cb >> 2) + 2 * g + hh;
                                    __hip_atomic_fetch_add(impw + q8 * 128 + j, G, __ATOMIC_RELAXED, __HIP_MEMORY_SCOPE_WORKGROUP);
                                    if (j + 1 < 128) __hip_atomic_fetch_add(impw + q8 * 128 + j + 1, C, __ATOMIC_RELAXED, __HIP_MEMORY_SCOPE_WORKGROUP);
                                }
                            }
                            bf16x8 pa0, pa1; pack_p(acc, pa0, pa1);
                            pv_sub(o, buf, sub, pa0, pa1, lane);
                        }
                    }
                }
                if (t + 1 < ntc) stage_write(lds + L_KV + ((t + 1) & 1) * KVB, sr, srow, sch);
                __syncthreads();
            }
        }
        if (pass == 0) { const float dt = den + __shfl_xor(den, 32); invden = dt > 0.f ? 1.f / dt : 0.f; }
    }
    asm volatile("s_waitcnt lgkmcnt(0)" ::: "memory");
#pragma unroll
    for (int r = 0; r < 16; ++r) { const float g0 = ws_[crow(r, hh)]; outv[0][r] += o[0][r] * g0; outv[1][r] += o[1][r] * g0; }
    {
        float* sp = P.scr + tid;
#pragma unroll
        for (int r = 0; r < 16; ++r) { sp[r * 512] = outv[0][r]; sp[(16 + r) * 512] = outv[1][r]; }
    }
    {
        const int qsel = lane >> 3, sb = lane & 7;
        unsigned key[16];
#pragma unroll
        for (int i4 = 0; i4 < 4; ++i4) {
            const f32x4 v = *(const LAS f32x4*)(impw + qsel * 128 + sb * 16 + 4 * i4);
#pragma unroll
            for (int e = 0; e < 4; ++e) {
                const int j = sb * 16 + 4 * i4 + e;
                const bool forced = (j == 0) | (j == P.qb) | (j == P.qb - 1);
                key[4 * i4 + e] = forced ? 0xFFFFFFFFu : (j <= P.qb ? __float_as_uint(v[e]) + 1u : 0u);
            }
        }
        unsigned T = 0u;
        for (int bit = 31; bit >= 0; --bit) {
            const unsigned cand = T | (1u << bit);
            int cnt = 0;
#pragma unroll
            for (int i = 0; i < 16; ++i) cnt += key[i] >= cand ? 1 : 0;
            cnt += __shfl_xor(cnt, 1); cnt += __shfl_xor(cnt, 2); cnt += __shfl_xor(cnt, 4);
            if (cnt >= 16) T = cand;
        }
        int cgt = 0, ceq = 0;
#pragma unroll
        for (int i = 0; i < 16; ++i) { cgt += key[i] > T ? 1 : 0; ceq += key[i] == T ? 1 : 0; }
        int cg = cgt; cg += __shfl_xor(cg, 1); cg += __shfl_xor(cg, 2); cg += __shfl_xor(cg, 4);
        int pre = 0;
#pragma unroll
        for (int k = 0; k < 8; ++k) { const int v = __shfl(ceq, (lane & ~7) + k); if (k < sb) pre += v; }
        int need = 16 - cg - pre;
        unsigned bits = 0u;
#pragma unroll
        for (int i = 0; i < 16; ++i) {
            const int j = sb * 16 + i;
            bool s_ = key[i] > T;
            if (key[i] == T) { if (need > 0) { s_ = true; } --need; }
            if (s_ && j <= P.qb) bits |= 1u << i;
        }
        const unsigned other = __shfl_xor(bits, 1);
        const unsigned word = (sb & 1) ? ((bits << 16) | other) : (bits | (other << 16));
        if ((sb & 1) == 0) { selw[qsel * 4 + (sb >> 1)] = word; __hip_atomic_fetch_or(uni + (sb >> 1), word, __ATOMIC_RELAXED, __HIP_MEMORY_SCOPE_WORKGROUP); }
    }
    __syncthreads();
    unsigned lm0 = selw[q8 * 4 + 0], lm1 = selw[q8 * 4 + 1], lm2 = selw[q8 * 4 + 2], lm3 = selw[q8 * 4 + 3];
    unsigned wm0 = 0, wm1 = 0, wm2 = 0, wm3 = 0;
#pragma unroll
    for (int k = 0; k < 8; ++k) { wm0 |= selw[k * 4 + 0]; wm1 |= selw[k * 4 + 1]; wm2 |= selw[k * 4 + 2]; wm3 |= selw[k * 4 + 3]; }
    wm0 = __builtin_amdgcn_readfirstlane(wm0); wm1 = __builtin_amdgcn_readfirstlane(wm1); wm2 = __builtin_amdgcn_readfirstlane(wm2); wm3 = __builtin_amdgcn_readfirstlane(wm3);
    const unsigned um0 = __builtin_amdgcn_readfirstlane(uni[0]), um1 = __builtin_amdgcn_readfirstlane(uni[1]), um2 = __builtin_amdgcn_readfirstlane(uni[2]), um3 = __builtin_amdgcn_readfirstlane(uni[3]);
#define NSA_WORD(a0, a1, a2, a3, j) ((j) < 32 ? (a0) : ((j) < 64 ? (a1) : ((j) < 96 ? (a2) : (a3))))
#define NSA_NEXT(j, res) do { int _j = (j); res = 128; while (_j < 128) { const unsigned _w = NSA_WORD(um0, um1, um2, um3, _j) >> (_j & 31); if (_w) { res = _j + __builtin_ctz(_w); break; } _j = (_j | 31) + 1; } } while (0)
    o[0] = (f32x16){}; o[1] = (f32x16){}; den = 0.f;
#define NSA_SLC_COMPUTE(JJ, BUF) do { \
        if ((NSA_WORD(wm0, wm1, wm2, wm3, (JJ)) >> ((JJ) & 31)) & 1u) { \
            const bool lsel = (NSA_WORD(lm0, lm1, lm2, lm3, (JJ)) >> ((JJ) & 31)) & 1u; \
            _Pragma("unroll") for (int sub = 0; sub < 2; ++sub) { \
                const int kb = 64 * (JJ) + 32 * sub; \
                if (kb <= twmax) { \
                    f32x16 acc; \
                    if (twmin - kb - 31 >= 1513) acc = splat16(lsel ? cfar : -1e30f); \
                    else { const LAS float* tb = lsel ? tg + hd * GTS + (GTOP - (tq - kb - 4 * hh)) : dead; \
                        _Pragma("unroll") for (int r = 0; r < 16; ++r) acc[r] = tb[(r & 3) + 8 * (r >> 2)]; } \
                    qk_sub<0, 4>(acc, (BUF), sub, qf, lane); \
                    den += exp_sum16(acc); \
                    bf16x8 pa0, pa1; pack_p(acc, pa0, pa1); \
                    pv_sub(o, (BUF), sub, pa0, pa1, lane); \
                } } } } while (0)
#define NSA_SLC_LOAD(JJ, SR) do { const bf16_t* rp_ = P.Hb + (size_t)(64 * (JJ) + srow) * HP; stage_load(SR, rp_ + C_KS, rp_ + C_VS, true, sch); } while (0)
    {
        LAS unsigned char* pb0 = lds + L_KV; LAS unsigned char* pb1 = lds + L_IMP;
        StageRegs a0, a1, b0, b1;
#define NSA_PAIR(prev, ra, rb) do { ra = 128; if ((prev) < 128) { NSA_NEXT((prev) + 1, ra); } rb = 128; if (ra < 128) { NSA_NEXT(ra + 1, rb); } } while (0)
#define NSA_SLC_LOADC(JJ, SR) do { const int jc_ = (JJ) < 128 ? (JJ) : 0; NSA_SLC_LOAD(jc_, SR); } while (0)
        int ca, cb_, n1a, n1b, n2a, n2b, n3a, n3b;
        NSA_NEXT(0, ca); cb_ = 128; if (ca < 128) { NSA_NEXT(ca + 1, cb_); }
        NSA_PAIR(cb_, n1a, n1b); NSA_PAIR(n1b, n2a, n2b);
        NSA_SLC_LOADC(ca, b0); NSA_SLC_LOADC(cb_, b1);
        NSA_SLC_LOADC(n1a, a0); NSA_SLC_LOADC(n1b, a1);
        stage_write(pb0, b0, srow, sch); stage_write(pb0 + KVB, b1, srow, sch);
        NSA_SLC_LOADC(n2a, b0); NSA_SLC_LOADC(n2b, b1);
        __syncthreads();
        for (;;) {
            NSA_SLC_COMPUTE(ca, pb0);
            if (cb_ < 128) NSA_SLC_COMPUTE(cb_, pb0 + KVB);
            stage_write(pb1, a0, srow, sch); stage_write(pb1 + KVB, a1, srow, sch);
            NSA_PAIR(n2b, n3a, n3b);
            NSA_SLC_LOADC(n3a, a0); NSA_SLC_LOADC(n3b, a1);
            __syncthreads();
            if (n1a >= 128) break;
            NSA_SLC_COMPUTE(n1a, pb1);
            if (n1b < 128) NSA_SLC_COMPUTE(n1b, pb1 + KVB);
            stage_write(pb0, b0, srow, sch); stage_write(pb0 + KVB, b1, srow, sch);
            int n4a, n4b; NSA_PAIR(n3b, n4a, n4b);
            NSA_SLC_LOADC(n4a, b0); NSA_SLC_LOADC(n4b, b1);
            __syncthreads();
            if (n2a >= 128) break;
            ca = n2a; cb_ = n2b; n1a = n3a; n1b = n3b; n2a = n4a; n2b = n4b;
        }
#undef NSA_PAIR
#undef NSA_SLC_LOADC
    }
#undef NSA_SLC_COMPUTE
#undef NSA_SLC_LOAD
    {
        const float dt = den + __shfl_xor(den, 32);
        if (hh == 0) ws_[96 + n] = 1.f / dt;
        asm volatile("s_waitcnt lgkmcnt(0)" ::: "memory");
        const float* sp = P.scr + tid;
#pragma unroll
        for (int r = 0; r < 16; ++r) { const float gi = ws_[32 + crow(r, hh)] * ws_[96 + crow(r, hh)]; outv[0][r] = sp[r * 512] + o[0][r] * gi; outv[1][r] = sp[(16 + r) * 512] + o[1][r] * gi; }
    }
    {
#pragma unroll
        for (int r = 0; r < 16; ++r) {
            const int nn = crow(r, hh);
            const size_t trow = (size_t)(64 * P.qb + 8 * w + (nn >> 2));
            const int ycol = 768 + 64 * (nn & 3);
            const bf16_t* sp = P.Hb + trow * HP + C_SILU + ycol;
            bf16_t* yp = P.Y + (P.brow + trow) * DM + ycol;
            yp[n] = f2bf(outv[0][r] * bf2f(sp[n]));
            yp[32 + n] = f2bf(outv[1][r] * bf2f(sp[32 + n]));
        }
    }
    __syncthreads();
#undef NSA_WORD
#undef NSA_NEXT
}
}

#define XB_TMO      128
#define XB_XCNT(j)  (256  + 64 * (j))
#define XB_XSUB(j)  (1280 + 64 * (j))
#define XB_XGEN(j)  (2304 + 64 * (j))
#define XB_TOP      3328
#define XB_TOPGEN   3392
#define XCD_BAR_WORDS 3456
#define XB_SPIN_CAP (1u << 22)
__device__ __forceinline__ unsigned xb_ld(unsigned* p)              { return __hip_atomic_load(p, __ATOMIC_RELAXED, __HIP_MEMORY_SCOPE_AGENT); }
__device__ __forceinline__ unsigned xb_add(unsigned* p, unsigned v) { return __hip_atomic_fetch_add(p, v, __ATOMIC_RELAXED, __HIP_MEMORY_SCOPE_AGENT); }
__device__ __forceinline__ unsigned xb_xcc_id() { return (unsigned)__builtin_amdgcn_s_getreg((3 << 11) | 20) & 0xFu; }
#define XB_SPIN(cond, bar) do { unsigned _sp = 0; while (cond) { __builtin_amdgcn_s_sleep(1); \
    if ((++_sp & 255u) == 0u) { if (xb_ld(&(bar)[XB_TMO])) break; if (_sp > XB_SPIN_CAP) { atomicAdd(&(bar)[XB_TMO], 1u); break; } } } } while (0)
struct XcdBarrier { unsigned* bar; unsigned x; volatile LAS unsigned* st; };
__device__ __forceinline__ XcdBarrier xcd_barrier_post(unsigned* bar, volatile LAS unsigned* st) {
    XcdBarrier b; b.bar = bar; b.x = xb_xcc_id(); b.st = st;
    if (threadIdx.x == 0) (void)xb_add(&bar[XB_XCNT(b.x)], 1u);
    return b;
}
__device__ __forceinline__ void xcd_barrier_complete(unsigned* bar, unsigned x, unsigned& nloc, unsigned& nx) {
    const unsigned G = gridDim.x * gridDim.y * gridDim.z;
    unsigned sum, cnt, mine, sp = 0u;
    for (;;) {
        sum = 0u; cnt = 0u; mine = 0u;
#pragma unroll
        for (unsigned j = 0; j < 16; ++j) { const unsigned c = xb_ld(&bar[XB_XCNT(j)]); sum += c; cnt += (c > 0u) ? 1u : 0u; mine = (j == x) ? c : mine; }
        if (sum == G) break;
        __builtin_amdgcn_s_sleep(1);
        if ((++sp & 255u) == 0u) { if (xb_ld(&bar[XB_TMO])) break; if (sp > XB_SPIN_CAP) { atomicAdd(&bar[XB_TMO], 1u); break; } }
    }
    nloc = mine > 0u ? mine : 1u; nx = cnt > 0u ? cnt : 1u;
}
__device__ __forceinline__ void xcd_barrier(const XcdBarrier& b) {
    asm volatile("s_waitcnt vmcnt(0)" ::: "memory");
    __syncthreads();
    if (threadIdx.x == 0) {
        unsigned* bar = b.bar;
        __builtin_amdgcn_s_waitcnt(0);
        unsigned nloc = b.st[0], nx = b.st[1];
        if (nloc == 0u) { xcd_barrier_complete(bar, b.x, nloc, nx); b.st[0] = nloc; b.st[1] = nx; }
        const unsigned old = xb_add(&bar[XB_XSUB(b.x)], 1u);
        const unsigned gen = old / nloc;
        if (old + 1u == (gen + 1u) * nloc) {
            __builtin_amdgcn_fence(__ATOMIC_RELEASE, "agent");
            asm volatile("s_waitcnt vmcnt(0)" ::: "memory");
            const unsigned og = xb_add(&bar[XB_TOP], 1u);
            const unsigned tg = og / nx;
            if (og + 1u == (tg + 1u) * nx) xb_add(&bar[XB_TOPGEN], 1u);
            else XB_SPIN(xb_ld(&bar[XB_TOPGEN]) == tg, bar);
            __builtin_amdgcn_fence(__ATOMIC_ACQUIRE, "agent");
            xb_add(&bar[XB_XGEN(b.x)], 1u);
            asm volatile("s_waitcnt vmcnt(0)" ::: "memory");
        } else {
            XB_SPIN(xb_ld(&bar[XB_XGEN(b.x)]) == gen, bar);
            __builtin_amdgcn_fence(__ATOMIC_ACQUIRE, "agent");
            asm volatile("s_waitcnt vmcnt(0)" ::: "memory");
        }
    }
    __syncthreads();
}

constexpr int NT = 512, LDS_BYTES = 147456, MISC_OFF = 131072 + 320;
#ifndef R_C
#define R_C 1
#endif
#ifndef R_D
#define R_D 1
#endif
#ifndef R_AB
#define R_AB 1
#endif
#ifndef R_G1
#define R_G1 1
#endif
constexpr size_t MiB = 1u << 20;
constexpr size_t WS_CTL = 0, CTL_ZERO_BYTES = 65536;
constexpr size_t WS_X1B = 158 * MiB;
constexpr size_t OUT_OA = 0, OUT_NSCR = 24 * MiB;
constexpr size_t WS_H = 2 * MiB, WS_XN = 124 * MiB, WS_T0 = 158 * MiB, WS_IMP = 208 * MiB, WS_SEL = 217 * MiB, WS_HID = 218 * MiB, WS_KC = 221 * MiB, WS_VC = 222 * MiB, WS_WIN = 224 * MiB, WS_WOUT = 240 * MiB, WS_MX = 1 * MiB, WS_DA = 245 * MiB, WS_CW1 = 246 * MiB, WS_CW2 = 250 * MiB, WS_RSS = 251 * MiB;

struct Args { const float* in[15]; float* out; unsigned char* ws; };

__global__ void __launch_bounds__(NT, 2) mega_fwd(Args args) {
    extern __shared__ __attribute__((aligned(16))) unsigned char lds[];
    const int tid = threadIdx.x, lane = tid & 63, wid = tid >> 6;
    const int G = gridDim.x, bid = blockIdx.x;
    volatile LAS unsigned* MISC = (volatile LAS unsigned*)((LAS unsigned char*)lds + MISC_OFF);
    if (tid < 32) MISC[tid] = 0u;
    __syncthreads();
    unsigned char* ws = args.ws;
    XcdBarrier bar = xcd_barrier_post((unsigned*)(ws + WS_CTL) + 4096, MISC + 8);
    const float* x = args.in[0]; const float* tab = args.in[1]; const float* norm_w = args.in[2];
    const float* w_in = args.in[3]; const float* w_out = args.in[4]; const float* qk_gain = args.in[5];
    const float* qk_gain_diff = args.in[6]; const float* sinks = args.in[7]; const float* diff_lambda = args.in[8];
    const float* diff_subln = args.in[9]; const float* cmp_pos = args.in[10]; const float* cmp_w1 = args.in[11];
    const float* cmp_b1 = args.in[12]; const float* cmp_w2 = args.in[13]; const float* cmp_b2 = args.in[14];
    float* out = args.out;
    bf16_t* H = (bf16_t*)(ws + WS_H);
    bf16_t* XN = (bf16_t*)(ws + WS_XN); bf16_t* Y = XN;
    float* T0 = (float*)(ws + WS_T0);
    float* OC = T0; float* OS_ = T0 + (size_t)MROWS * 256; float* OW = T0 + (size_t)MROWS * 512; float* CT = T0;
    float* IMP = (float*)(ws + WS_IMP); unsigned* SEL = (unsigned*)(ws + WS_SEL); float* HID = (float*)(ws + WS_HID);
    float* KC = (float*)(ws + WS_KC); float* VC = (float*)(ws + WS_VC);
    const int GT = G * NT, GW = G * 8;
    bf16_t* WinT = (bf16_t*)(ws + WS_WIN); bf16_t* WoutT = (bf16_t*)(ws + WS_WOUT);
#define GRID_BAR() do { XcdBarrier b2_ = bar; asm volatile("" : "+s"(b2_.x)); xcd_barrier(b2_); } while (0)
    {
        LAS float* scr = (LAS float*)((LAS unsigned char*)lds + wid * 16384);
        const int gw0 = bid * 8 + wid;
        constexpr int I_IN = 16 * 120, I_OUT = 16 * 32, I_C1 = 32 * 8, I_C2 = 4 * 2, I_L = I_IN + I_OUT + 2 * I_C1 + 2 * I_C2, NITEMS = 2 * I_L;
        bf16_t* CW1T = (bf16_t*)(ws + WS_CW1); bf16_t* CW2T = (bf16_t*)(ws + WS_CW2);
        for (int it = gw0; it < NITEMS; it += GW) {
            const int l = it / I_L; int r = it % I_L;
            if (r < I_IN) { p0_transpose_item<0>(w_in + (size_t)l * DM * PW, WinT + (size_t)l * HP * DM, scr, r, lane, 1024, 1024, norm_w + l * DM); continue; } r -= I_IN;
            if (r < I_OUT) { p0_transpose_item<1>(w_out + (size_t)l * DM * DM, WoutT + (size_t)l * DM * DM, scr, r, lane); continue; } r -= I_OUT;
            if (r < 2 * I_C1) { const int kv = r / I_C1; p0_transpose_item<2>(cmp_w1 + (size_t)(l * 2 + kv) * 2048 * 256, CW1T + (size_t)(l * 2 + kv) * 256 * 2048, scr, r % I_C1, lane, 2048, 256); continue; } r -= 2 * I_C1;
            { const int kv = r / I_C2; p0_transpose_item<1>(cmp_w2 + (size_t)(l * 2 + kv) * 256 * 64, CW2T + (size_t)(l * 2 + kv) * 64 * 256, scr, r % I_C2, lane, 256, 64); }
        }
        if (bid == 1 && tid < 256) { bf16_t* KCb = (bf16_t*)(ws + WS_KC); KCb[(size_t)(tid >> 6) * 512 * 64 + 511 * 64 + (tid & 63)] = 0; }
        for (int w = gw0; w < MROWS; w += GW) k_rmsnorm(w, lane, x, norm_w, XN);
        for (int v = bid * NT + tid; v < MROWS; v += GT) ((unsigned long long*)(ws + WS_RSS))[v] = 0ull;
        if (bid == 0 && wid == 0) {
            float* MX = (float*)(ws + WS_MX);
            for (int l = 0; l < 2; ++l) {
                float mg[8];
#pragma unroll
                for (int i = 0; i < 8; ++i) { float v = fabsf(qk_gain[l * 512 + i * 64 + lane]);
#pragma unroll
                    for (int o = 1; o < 64; o <<= 1) v = fmaxf(v, __shfl_xor(v, o));
                    mg[i] = v; }
                float md0 = lane < 32 ? fabsf(qk_gain_diff[l * 64 + lane]) : 0.f, md1 = lane < 32 ? fabsf(qk_gain_diff[l * 64 + 32 + lane]) : 0.f;
#pragma unroll
                for (int o = 1; o < 64; o <<= 1) { md0 = fmaxf(md0, __shfl_xor(md0, o)); md1 = fmaxf(md1, __shfl_xor(md1, o)); }
                for (int gh = 0; gh < 16; ++gh) {
                    float mb = lane < 32 ? fabsf(tab[lane * 16 + gh]) : 0.f;
#pragma unroll
                    for (int o = 1; o < 64; o <<= 1) mb = fmaxf(mb, __shfl_xor(mb, o));
                    const int grp = gh >> 2, hh = gh & 3; float Mv;
                    if (grp == 0) Mv = 8.f * mg[0] * mg[1] + mb;
                    else if (grp == 1) Mv = fmaxf(8.f * mg[2] * mg[3] + mb, sinks[l * 4 + hh]);
                    else if (grp == 2) Mv = 5.656854249f * md0 * md1 + mb;
                    else Mv = 8.f * mg[4] * fmaxf(mg[5], fmaxf(mg[6], mg[7])) + mb;
                    if (lane == 0) MX[l * 16 + gh] = Mv;
                }
                float s1 = lane < 32 ? diff_lambda[l * 128 + lane] * diff_lambda[l * 128 + 32 + lane] : 0.f;
                float s2 = lane < 32 ? diff_lambda[l * 128 + 64 + lane] * diff_lambda[l * 128 + 96 + lane] : 0.f;
#pragma unroll
                for (int o = 1; o < 64; o <<= 1) { s1 += __shfl_xor(s1, o); s2 += __shfl_xor(s2, o); }
                const float lambda_init = 0.8f - 0.6f * expf(-0.3f * (float)l);
                if (lane == 0) { MX[32 + l] = expf(s1) - expf(s2) + lambda_init; MX[34 + l] = lambda_init; }
            }
        }
    }
    GRID_BAR();
#pragma unroll 1
    for (int l = 0; l < 2; ++l) {
        bf16_t* X1B = (bf16_t*)(ws + WS_X1B);
        { pg8::Gemm g{l == 0 ? XN : X1B, WinT + (size_t)l * HP * DM, MROWS, HP, DM}; pg8::StaticOrder So; So.init(MROWS, HP, G, bid);
          pg8::EpiProj E{H, qk_gain + l * 512, qk_gain_diff + l * 64, l == 0 ? nullptr : (const float*)(ws + WS_RSS)};
          for (int rep = 0; rep < R_G1; ++rep) pg8::gemm_phase<pg8::EpiProj, pg8::StaticOrder, true, true>((LAS unsigned char*)lds, g, So, E); }
        GRID_BAR();
        {
            const float* MX = (const float*)(ws + WS_MX);
            bf16_t* OA = (bf16_t*)((unsigned char*)out + OUT_OA); float* DA = (float*)(ws + WS_DA);
            bf16_t* KCb = (bf16_t*)(ws + WS_KC);
            const bf16_t* CW1T = (const bf16_t*)(ws + WS_CW1); const bf16_t* CW2T = (const bf16_t*)(ws + WS_CW2);
            LAS unsigned* qw = (LAS unsigned*)((LAS unsigned char*)lds + att::L_Q);
            unsigned* qctr = (unsigned*)(ws + WS_CTL) + 8192 + 128 * l;
            unsigned* cdone = qctr + 64;
            constexpr int B0 = 64, B1 = B0 + 160 * R_C, B2 = B1 + 256 * R_D, B3 = B2 + 96 * R_C, B4 = B3 + 768 * R_AB, NUV = B4 + 256 * R_AB;
            for (;;) {
                if (opq(threadIdx.x) == 0) *qw = atomicAdd(qctr, 1u);
                __syncthreads();
                const int uv = (int)*qw;
                __syncthreads();
                if (uv >= NUV) break;
                int u;
                if (uv < B0) u = uv; else if (uv < B1) u = 64 + (uv - B0) / R_C; else if (uv < B2) u = 224 + (uv - B1) / R_D; else if (uv < B3) u = 480 + (uv - B2) / R_C;
                else if (uv < B4) u = 576 + (uv - B3) / R_AB; else u = 1344 + (uv - B4) / R_AB;
                if (u < 64) {
                    const int kv = u >> 5, b = (u >> 4) & 1, rt = u & 15;
                    att::CmpArgs P; P.Hb = H + (size_t)b * S * HP; P.col = kv == 0 ? C_KC : C_VC; P.rt = rt;
                    P.pos = cmp_pos + (size_t)(l * 2 + kv) * 2048; P.W1T = CW1T + (size_t)(l * 2 + kv) * 256 * 2048; P.b1 = cmp_b1 + (l * 2 + kv) * 256;
                    P.W2T = CW2T + (size_t)(l * 2 + kv) * 64 * 256; P.b2 = cmp_b2 + (l * 2 + kv) * 64; P.gain = kv == 0 ? qk_gain + l * 512 + 5 * 64 : nullptr;
                    P.OUT = KCb + (size_t)(kv * NB + b) * 512 * 64;
                    att::cmp_unit((LAS unsigned char*)lds, P);
                    asm volatile("s_waitcnt vmcnt(0)" ::: "memory");
                    __syncthreads();
                    if (opq(threadIdx.x) == 64) { __builtin_amdgcn_fence(__ATOMIC_RELEASE, "agent"); asm volatile("s_waitcnt vmcnt(0)" ::: "memory");
                        __hip_atomic_fetch_add(cdone, 1u, __ATOMIC_RELAXED, __HIP_MEMORY_SCOPE_AGENT); }
                    __syncthreads();
                } else if ((u >= 64 && u < 224) || (u >= 480 && u < 576)) {
                    int qb, bh;
                    if (u < 224) { qb = 31 - ((u - 64) >> 3); bh = (u - 64) & 7; } else { qb = 11 - ((u - 480) >> 3); bh = (u - 480) & 7; }
                    const int b = bh >> 2, hd = bh & 3;
                    att::DiffArgs P; P.Hb = H + (size_t)b * S * HP; P.hd = hd; P.qb = qb; P.brow = (size_t)b * S;
                    P.bias = tab + 8 + hd; P.M = MX[l * 16 + 8 + hd]; P.lam = MX[32 + l]; P.lambda_init = MX[34 + l]; P.subln = diff_subln + l * 64; P.Y = Y;
                    att::diff_unit((LAS unsigned char*)lds, P);
                } else if (u < 480) {
                    const int idx = u - 224, qb64 = 127 - (idx >> 1), b = idx & 1;
                    att::NsaArgs P; P.Hb = H + (size_t)b * S * HP; P.brow = (size_t)b * S; P.qb = qb64;
                    P.KC = KCb + (size_t)(0 * NB + b) * 512 * 64; P.VC = KCb + (size_t)(1 * NB + b) * 512 * 64;
                    P.bias = tab + 12; P.Mv = MX + l * 16 + 12; P.Y = Y; P.cdone = cdone; P.scr = (float*)((unsigned char*)out + OUT_NSCR) + (size_t)bid * 16384;
                    att::nsa_unit((LAS unsigned char*)lds, P);
                } else if (u < 1344) {
                    const int v = u - 576, cfg = v >> 8, b = (v >> 7) & 1, hd = (v >> 5) & 3, ti = v & 31;
                    const int rate = cfg == 0 ? 1 : (cfg == 1 ? 4 : 16), tpc = 32 / rate;
                    att::BandArgs P; P.Hb = H + (size_t)b * S * HP; P.cq = C_AQ + 64 * hd; P.ck = C_AK + 64 * hd; P.cv = C_AV + 64 * hd;
                    P.rate = rate; P.cls = ti / tpc; P.f0 = (ti % tpc) * 256; P.maxd = 128; P.bias = tab + hd; P.M = MX[l * 16 + hd]; P.sinkterm = 0.f;
                    P.OA = OA + (size_t)cfg * MROWS * 256; P.DA = DA + (size_t)cfg * MROWS * 4; P.Y = nullptr; P.ycol = 0; P.hd = hd; P.brow = (size_t)b * S;
                    att::banded_unit<0>((LAS unsigned char*)lds, P);
                } else {
                    const int v = u - 1344, b = (v >> 7) & 1, hd = (v >> 5) & 3, ti = v & 31;
                    att::BandArgs P; P.Hb = H + (size_t)b * S * HP; P.cq = C_BQ + 64 * hd; P.ck = C_BK + 64 * (hd >> 1); P.cv = C_BV + 64 * (hd >> 1);
                    P.rate = 1; P.cls = 0; P.f0 = ti * 256; P.maxd = 127; P.bias = tab + 4 + hd; P.M = MX[l * 16 + 4 + hd];
                    P.sinkterm = __expf(sinks[l * 4 + hd] - P.M);
                    P.OA = nullptr; P.DA = nullptr; P.Y = Y; P.ycol = 256 + 64 * hd; P.hd = hd; P.brow = (size_t)b * S;
                    att::banded_unit<1>((LAS unsigned char*)lds, P);
                }
            }
        }
        GRID_BAR();
        {
            const bf16_t* OA = (const bf16_t*)((unsigned char*)out + OUT_OA); const float* DA = (const float*)(ws + WS_DA);
            for (int v = (bid * NT + opq(threadIdx.x)); v < MROWS * 32; v += GT) {
                const int row = v >> 5, hd = (v >> 3) & 3, c8 = v & 7;
                float acc8[8] = {0.f, 0.f, 0.f, 0.f, 0.f, 0.f, 0.f, 0.f}; float dsum = 0.f;
#pragma unroll
                for (int cfg = 0; cfg < 3; ++cfg) {
                    const float dn = DA[((size_t)cfg * MROWS + row) * 4 + hd]; dsum += dn;
                    const uint4 r4 = *(const uint4*)(OA + ((size_t)cfg * MROWS + row) * 256 + hd * 64 + c8 * 8);
                    acc8[0] += dn * __uint_as_float(r4.x << 16); acc8[1] += dn * __uint_as_float(r4.x & 0xffff0000u);
                    acc8[2] += dn * __uint_as_float(r4.y << 16); acc8[3] += dn * __uint_as_float(r4.y & 0xffff0000u);
                    acc8[4] += dn * __uint_as_float(r4.z << 16); acc8[5] += dn * __uint_as_float(r4.z & 0xffff0000u);
                    acc8[6] += dn * __uint_as_float(r4.w << 16); acc8[7] += dn * __uint_as_float(r4.w & 0xffff0000u);
                }
                const float inv = 1.f / dsum;
                const uint4 s4 = *(const uint4*)(H + (size_t)row * HP + C_SILU + hd * 64 + c8 * 8);
                uint4 o4;
                o4.x = (unsigned)f2bf(acc8[0] * inv * __uint_as_float(s4.x << 16)) | ((unsigned)f2bf(acc8[1] * inv * __uint_as_float(s4.x & 0xffff0000u)) << 16);
                o4.y = (unsigned)f2bf(acc8[2] * inv * __uint_as_float(s4.y << 16)) | ((unsigned)f2bf(acc8[3] * inv * __uint_as_float(s4.y & 0xffff0000u)) << 16);
                o4.z = (unsigned)f2bf(acc8[4] * inv * __uint_as_float(s4.z << 16)) | ((unsigned)f2bf(acc8[5] * inv * __uint_as_float(s4.z & 0xffff0000u)) << 16);
                o4.w = (unsigned)f2bf(acc8[6] * inv * __uint_as_float(s4.w << 16)) | ((unsigned)f2bf(acc8[7] * inv * __uint_as_float(s4.w & 0xffff0000u)) << 16);
                *(uint4*)(Y + (size_t)row * DM + hd * 64 + c8 * 8) = o4;
            }
        }
        GRID_BAR();
        { pg8::Gemm g{Y, WoutT + (size_t)l * DM * DM, MROWS, DM, DM}; pg8::StaticOrder So; So.init(MROWS, DM, G, bid);
          pg8::EpiOut E{l == 0 ? x : nullptr, X1B, out, (LAS float*)((LAS unsigned char*)lds + 132096), X1B, (float*)(ws + WS_RSS)};
          pg8::gemm_phase<pg8::EpiOut, pg8::StaticOrder, true, true>((LAS unsigned char*)lds, g, So, E); }
        if (l == 0) GRID_BAR();
    }
}

extern "C" void kernel_launch(void* const* d_in, const int* in_sizes, int n_in, void* d_out, int out_size, void* d_ws, size_t ws_size, hipStream_t stream) {
    static int grid = 0;
    if (grid == 0) {
        int dev = 0, cus = 0;
        (void)hipGetDevice(&dev);
        (void)hipDeviceGetAttribute(&cus, hipDeviceAttributeMultiprocessorCount, dev);
        (void)hipFuncSetAttribute((const void*)mega_fwd, hipFuncAttributeMaxDynamicSharedMemorySize, LDS_BYTES);
        grid = cus > 0 ? cus : 256;
    }
    (void)hipMemsetAsync((char*)d_ws + WS_CTL, 0, CTL_ZERO_BYTES, stream);
    Args a{};
    for (int i = 0; i < 15; ++i) a.in[i] = (const float*)d_in[i];
    a.out = (float*)d_out; a.ws = (unsigned char*)d_ws;
    hipLaunchKernelGGL(mega_fwd, dim3(grid), dim3(NT), LDS_BYTES, stream, a);
}
```

```cpp
#include <hip/hip_runtime.h>
#include <stdint.h>
#include <math.h>

typedef unsigned short bf16_t;
__device__ __forceinline__ float bf2f(bf16_t v) { return __uint_as_float((unsigned)v << 16); }
__device__ __forceinline__ bf16_t f2bf(float f) { unsigned u = __float_as_uint(f); return (bf16_t)((u + 0x7fffu + ((u >> 16) & 1u)) >> 16); }

constexpr int NB = 2, S = 8192, DM = 1024, MROWS = NB * S, PW = 3724, HP = 3840;
constexpr int C_AQ = 0, C_AK = 256, C_AV = 512, C_BQ = 768, C_BK = 1024, C_BV = 1152, C_CQ = 1280, C_CK = 1536, C_CV = 1792,
              C_DQ = 2048, C_KC = 2304, C_VC = 2368, C_KS = 2432, C_VS = 2496, C_KW = 2560, C_VW = 2624, C_GT = 2688, C_SILU = 2816;
constexpr float EPS = 1e-6f;
__device__ __forceinline__ int opq(int v) { asm volatile("" : "+v"(v)); return v; }

__device__ __forceinline__ int t5_bucket(int n) {
    if (n < 16) return n < 0 ? 0 : n;
    int b = 16;
    b += (n >= 22); b += (n >= 30); b += (n >= 40); b += (n >= 54); b += (n >= 73); b += (n >= 99); b += (n >= 134); b += (n >= 182);
    b += (n >= 246); b += (n >= 332); b += (n >= 450); b += (n >= 609); b += (n >= 825); b += (n >= 1117); b += (n >= 1513);
    return b;
}

template <int R>
__device__ __forceinline__ void k_rmsnorm(const int row0, const int stride, const int lane, const float* __restrict__ x, bf16_t* __restrict__ xn) {
    float4 v[R][4]; float ss[R];
#pragma unroll
    for (int r = 0; r < R; ++r) {
        const int row = row0 + r * stride < MROWS ? row0 + r * stride : MROWS - 1;
        const float4* xr = (const float4*)(x + (size_t)row * DM);
#pragma unroll
        for (int j = 0; j < 4; ++j) v[r][j] = xr[lane + 64 * j];
    }
#pragma unroll
    for (int r = 0; r < R; ++r) {
        ss[r] = 0.f;
#pragma unroll
        for (int j = 0; j < 4; ++j) ss[r] += (v[r][j].x * v[r][j].x + v[r][j].y * v[r][j].y) + (v[r][j].z * v[r][j].z + v[r][j].w * v[r][j].w);
    }
#pragma unroll
    for (int o = 1; o < 64; o <<= 1) {
#pragma unroll
        for (int r = 0; r < R; ++r) ss[r] += __shfl_xor(ss[r], o);
    }
#pragma unroll
    for (int r = 0; r < R; ++r) {
        const int row = row0 + r * stride;
        if (row >= MROWS) break;
        const float rstd = rsqrtf(ss[r] * (1.f / DM) + EPS);
#pragma unroll
        for (int j = 0; j < 4; ++j) {
            uint2 o; o.x = (unsigned)f2bf(v[r][j].x * rstd) | ((unsigned)f2bf(v[r][j].y * rstd) << 16);
            o.y = (unsigned)f2bf(v[r][j].z * rstd) | ((unsigned)f2bf(v[r][j].w * rstd) << 16);
            ((uint2*)(xn + (size_t)row * DM))[lane + 64 * j] = o;
        }
    }
}

template <int D>
__device__ __forceinline__ float dot_row(const float* q, const bf16_t* kr) {
    float s = 0.f;
#pragma unroll
    for (int c = 0; c < D / 8; ++c) {
        const uint4 r = *(const uint4*)(kr + 8 * c);
        s += q[8 * c + 0] * __uint_as_float(r.x << 16) + q[8 * c + 1] * __uint_as_float(r.x & 0xffff0000u);
        s += q[8 * c + 2] * __uint_as_float(r.y << 16) + q[8 * c + 3] * __uint_as_float(r.y & 0xffff0000u);
        s += q[8 * c + 4] * __uint_as_float(r.z << 16) + q[8 * c + 5] * __uint_as_float(r.z & 0xffff0000u);
        s += q[8 * c + 6] * __uint_as_float(r.w << 16) + q[8 * c + 7] * __uint_as_float(r.w & 0xffff0000u);
        if (c & 1) asm volatile("" ::: "memory");
    }
    return s;
}
__device__ __forceinline__ void os_step(float s, const bf16_t* vr, float& m, float& den, float* o) {
    const float mn = fmaxf(m, s), sc = __expf(m - mn), p = __expf(s - mn);
    den = den * sc + p; m = mn;
#pragma unroll
    for (int c = 0; c < 8; ++c) {
        const uint4 r = *(const uint4*)(vr + 8 * c);
        o[8 * c + 0] = o[8 * c + 0] * sc + p * __uint_as_float(r.x << 16); o[8 * c + 1] = o[8 * c + 1] * sc + p * __uint_as_float(r.x & 0xffff0000u);
        o[8 * c + 2] = o[8 * c + 2] * sc + p * __uint_as_float(r.y << 16); o[8 * c + 3] = o[8 * c + 3] * sc + p * __uint_as_float(r.y & 0xffff0000u);
        o[8 * c + 4] = o[8 * c + 4] * sc + p * __uint_as_float(r.z << 16); o[8 * c + 5] = o[8 * c + 5] * sc + p * __uint_as_float(r.z & 0xffff0000u);
        o[8 * c + 6] = o[8 * c + 6] * sc + p * __uint_as_float(r.w << 16); o[8 * c + 7] = o[8 * c + 7] * sc + p * __uint_as_float(r.w & 0xffff0000u);
        if (c & 1) asm volatile("" ::: "memory");
    }
}
template <int D>
__device__ __forceinline__ void load_q(float* q, const bf16_t* p) {
#pragma unroll
    for (int c = 0; c < D / 8; ++c) {
        const uint4 r = *(const uint4*)(p + 8 * c);
        q[8 * c + 0] = __uint_as_float(r.x << 16); q[8 * c + 1] = __uint_as_float(r.x & 0xffff0000u);
        q[8 * c + 2] = __uint_as_float(r.y << 16); q[8 * c + 3] = __uint_as_float(r.y & 0xffff0000u);
        q[8 * c + 4] = __uint_as_float(r.z << 16); q[8 * c + 5] = __uint_as_float(r.z & 0xffff0000u);
        q[8 * c + 6] = __uint_as_float(r.w << 16); q[8 * c + 7] = __uint_as_float(r.w & 0xffff0000u);
    }
}

#define LAS __attribute__((address_space(3)))
namespace pg8 {
#define PG8_LAS __attribute__((address_space(3)))
typedef unsigned short bf16_t;
typedef short bf16x8 __attribute__((ext_vector_type(8)));
typedef float f32x4 __attribute__((ext_vector_type(4)));
typedef unsigned u32x4 __attribute__((ext_vector_type(4)));
constexpr int BM = 256, BK = 64, HALF = 128, HTB = HALF * BK * 2  , STAGE_BYTES = 8 * HTB, NXCD = 8, WGM = 8;

__host__ __device__ __forceinline__ int lds_byte(int r, int c) { const int st = (r >> 4) * 2 + (c >> 5), rr = r & 15, cc = c & 31, ob = rr * 64 + cc * 2; return st * 1024 + (ob ^ (((ob >> 9) & 1) << 5)); }
__host__ __device__ __forceinline__ void stage_rc(int b, int& R, int& C) { const int st = b / 1024, sb = b % 1024, swz = sb ^ (((sb >> 9) & 1) << 5); R = (st >> 1) * 16 + swz / 64; C = (st & 1) * 32 + (swz % 64) / 2; }
__host__ __device__ __forceinline__ int perm32(int rho) { const int n = rho >> 4, i = rho & 15; return 8 * (i >> 2) + 4 * n + (i & 3); }

struct Unit { int pm, pn; };
struct Gemm { const bf16_t* A; const bf16_t* Bt; int M, N, K; };

struct StaticOrder {
    int nM, nN, nwg, G, c;
    __host__ __device__ void init(int M, int N, int G_, int c_) { nM = M / BM; nN = N / BM; nwg = nM * nN; G = G_; c = c_; }
    __host__ __device__ bool next(int i, Unit& u) const {
        const long L = (long)i * G + c; if (L >= nwg) return false;
        int wgid = (int)L; { const int q = nwg / NXCD, r = nwg % NXCD, xcd = wgid % NXCD, off = wgid / NXCD; wgid = (xcd < r ? xcd * (q + 1) : r * (q + 1) + (xcd - r) * q) + off; }
        const int nig = WGM * nN, gid = wgid / nig, fm = gid * WGM, gsz = (nM - fm) < WGM ? (nM - fm) : WGM;
        u.pm = fm + ((wgid % nig) % gsz); u.pn = (wgid % nig) / gsz; return true;
    }
    __device__ __forceinline__ void a_ready(const Unit&) const {}
    __device__ __forceinline__ void done(const Unit&) const {}
};

__device__ __forceinline__ unsigned cvt_pk_bf16(float lo, float hi) { unsigned r; asm volatile("v_cvt_pk_bf16_f32 %0, %1, %2" : "=v"(r) : "v"(lo), "v"(hi)); return r; }
template <class Epi, class Sched, bool ALIGN_EPI = false, bool SP2 = false>
__device__ __forceinline__ void gemm_phase(PG8_LAS unsigned char* lds, const Gemm g, const Sched& S, const Epi& E) {
    const int tid = opq(threadIdx.x), wid = __builtin_amdgcn_readfirstlane(tid >> 6), lane = tid & 63, wr = wid >> 2, wc = wid & 3, fr = lane & 15, fq = lane >> 4;
    const int K = g.K, nt = K / BK;
    unsigned voffA[2], voffB[2];
#pragma unroll
    for (int i = 0; i < 2; ++i) { int R, C; stage_rc(tid * 16 + i * 8192, R, C); const int Rb = Epi::PERM ? ((R & ~31) + perm32(R & 31)) : R;
        voffA[i] = (unsigned)(R * K + C) * 2u; voffB[i] = (unsigned)(Rb * K + C) * 2u; }
    const size_t kstep = (size_t)(BK * 2);
    const size_t hstep = (size_t)HALF * K * 2;
    const size_t tstep = 2 * hstep;
    const unsigned ldsw = (unsigned)wid * 1024u;
    const int aoff = lds_byte(wr * 64 + fr, fq * 8), boff = lds_byte(wc * 32 + fr, fq * 8);
#define PG8_SA(b, h) (((b) * 2 + (h)) * HTB)
#define PG8_SB(b, h) ((4 + (b) * 2 + (h)) * HTB)
#define PG8_STAGE(bufoff, gbase, voff) do { _Pragma("unroll") for (int _i = 0; _i < 2; ++_i) \
        __builtin_amdgcn_global_load_lds((const unsigned*)((const char*)(gbase) + (voff)[_i]), (PG8_LAS unsigned*)(lds + (bufoff) + ldsw + _i * 8192), 16, 0, 0); } while (0)
#define PG8_LDA(dst, b, h) do { _Pragma("unroll") for (int m = 0; m < 4; ++m) _Pragma("unroll") for (int k = 0; k < 2; ++k) dst[m][k] = *(const PG8_LAS bf16x8*)(lds + PG8_SA(b, h) + aoff + m * 2048 + k * 1024); } while (0)
#define PG8_LDB(dst, b, h) do { _Pragma("unroll") for (int n = 0; n < 2; ++n) _Pragma("unroll") for (int k = 0; k < 2; ++k) dst[n][k] = *(const PG8_LAS bf16x8*)(lds + PG8_SB(b, h) + boff + n * 2048 + k * 1024); } while (0)
#define PG8_MMA(ai, bj, At, Bt) do { __builtin_amdgcn_s_setprio(1); _Pragma("unroll") for (int m = 0; m < 4; ++m) _Pragma("unroll") for (int n = 0; n < 2; ++n) _Pragma("unroll") for (int k = 0; k < 2; ++k) \
        acc[ai][bj][m][n] = __builtin_amdgcn_mfma_f32_16x16x32_bf16(Bt[n][k], At[m][k], acc[ai][bj][m][n], 0, 0, 0); __builtin_amdgcn_s_setprio(0); } while (0)
#define PG8_WAIT_V(n) asm volatile("s_waitcnt vmcnt(" #n ")" ::: "memory")
#define PG8_WAIT_L(n) asm volatile("s_waitcnt lgkmcnt(" #n ")" ::: "memory")
#define PG8_BAR __builtin_amdgcn_s_barrier()
#define PG8_SCHED __builtin_amdgcn_sched_barrier(0)
    Unit cur, nxt; int ui = 0;
    if (!S.next(0, cur)) return;
    f32x4 acc[2][2][4][2];
#pragma unroll
    for (int a = 0; a < 2; ++a)
#pragma unroll
        for (int b = 0; b < 2; ++b)
#pragma unroll
            for (int m = 0; m < 4; ++m)
#pragma unroll
                for (int n = 0; n < 2; ++n) acc[a][b][m][n] = (f32x4){0.f, 0.f, 0.f, 0.f};
    bf16x8 At[4][2], B0[2][2], B1[2][2];
    const char* cA = (const char*)g.A + (size_t)cur.pm * tstep; const char* cB = (const char*)g.Bt + (size_t)cur.pn * tstep;
    S.a_ready(cur);
    if constexpr (SP2) {
        PG8_STAGE(PG8_SB(0, 0), cB, voffB); PG8_STAGE(PG8_SB(0, 1), cB + hstep, voffB); PG8_STAGE(PG8_SA(0, 0), cA, voffA); PG8_STAGE(PG8_SA(0, 1), cA + hstep, voffA);
        if (wr == 1) PG8_BAR;
        PG8_WAIT_V(2); PG8_BAR;
        PG8_STAGE(PG8_SB(1, 0), cB + kstep, voffB); PG8_STAGE(PG8_SA(1, 0), cA + kstep, voffA); PG8_STAGE(PG8_SB(1, 1), cB + hstep + kstep, voffB);
        PG8_WAIT_V(6); PG8_BAR;
    } else {
        PG8_STAGE(PG8_SB(0, 0), cB, voffB); PG8_STAGE(PG8_SA(0, 0), cA, voffA); PG8_STAGE(PG8_SB(0, 1), cB + hstep, voffB); PG8_STAGE(PG8_SA(0, 1), cA + hstep, voffA);
        if (wr == 1) PG8_BAR;
        PG8_WAIT_V(4); PG8_BAR;
        PG8_STAGE(PG8_SB(1, 0), cB + kstep, voffB); PG8_STAGE(PG8_SA(1, 0), cA + kstep, voffA); PG8_STAGE(PG8_SB(1, 1), cB + hstep + kstep, voffB);
        PG8_WAIT_V(6); PG8_BAR;
    }
    for (;;) {
        const bool has_next = S.next(ui + 1, nxt);
        const char* nA = has_next ? (const char*)g.A + (size_t)nxt.pm * tstep : cA; const char* nB = has_next ? (const char*)g.Bt + (size_t)nxt.pn * tstep : cB;
        for (int t = 0; t < nt; t += 2) {
            const bool last = (t == nt - 2);
            const char* a1 = cA + (size_t)(t + 1) * kstep;
            const char* a2 = last ? nA : cA + (size_t)(t + 2) * kstep; const char* b2 = last ? nB : cB + (size_t)(t + 2) * kstep;
            const char* a3 = a2 + kstep; const char* b3 = b2 + kstep;
            if (last && has_next) S.a_ready(nxt);
            if constexpr (SP2) {
            PG8_LDB(B0, 0, 0); PG8_LDB(B1, 0, 1); PG8_SCHED; PG8_LDA(At, 0, 0); PG8_STAGE(PG8_SA(1, 1), a1 + hstep, voffA);
            PG8_WAIT_V(8); PG8_WAIT_L(0); PG8_BAR; PG8_MMA(0, 0, At, B0); PG8_MMA(0, 1, At, B1); PG8_BAR; PG8_SCHED;
            PG8_LDA(At, 0, 1); PG8_STAGE(PG8_SB(0, 0), b2, voffB); PG8_STAGE(PG8_SB(0, 1), b2 + hstep, voffB); PG8_STAGE(PG8_SA(0, 0), a2, voffA);
            PG8_WAIT_V(8); PG8_WAIT_L(0); PG8_BAR; PG8_MMA(1, 0, At, B0); PG8_MMA(1, 1, At, B1); PG8_BAR; PG8_SCHED;
            PG8_LDB(B0, 1, 0); PG8_LDB(B1, 1, 1); PG8_SCHED; PG8_LDA(At, 1, 0); PG8_STAGE(PG8_SA(0, 1), a2 + hstep, voffA);
            PG8_WAIT_V(8); PG8_WAIT_L(0); PG8_BAR; PG8_MMA(0, 0, At, B0); PG8_MMA(0, 1, At, B1); PG8_BAR; PG8_SCHED;
            PG8_LDA(At, 1, 1); PG8_STAGE(PG8_SB(1, 0), b3, voffB); PG8_STAGE(PG8_SB(1, 1), b3 + hstep, voffB); PG8_STAGE(PG8_SA(1, 0), a3, voffA);
            PG8_WAIT_V(8); PG8_WAIT_L(0); PG8_BAR; PG8_MMA(1, 0, At, B0); PG8_MMA(1, 1, At, B1); PG8_BAR; PG8_SCHED;
            } else {
            PG8_LDB(B0, 0, 0); PG8_SCHED; PG8_LDA(At, 0, 0); PG8_STAGE(PG8_SA(1, 1), a1 + hstep, voffA);
            PG8_WAIT_L(8); PG8_BAR; PG8_WAIT_L(0); PG8_MMA(0, 0, At, B0); PG8_BAR; PG8_SCHED;
            PG8_LDB(B1, 0, 1); PG8_STAGE(PG8_SB(0, 0), b2, voffB);
            PG8_BAR; PG8_WAIT_L(0); PG8_MMA(0, 1, At, B1); PG8_BAR;
            PG8_LDA(At, 0, 1); PG8_STAGE(PG8_SA(0, 0), a2, voffA);
            PG8_BAR; PG8_WAIT_L(0); PG8_MMA(1, 0, At, B0); PG8_BAR; PG8_SCHED;
            PG8_STAGE(PG8_SB(0, 1), b2 + hstep, voffB);
            PG8_WAIT_V(6); PG8_BAR; PG8_MMA(1, 1, At, B1); PG8_BAR;
            PG8_LDB(B0, 1, 0); PG8_SCHED; PG8_LDA(At, 1, 0); PG8_STAGE(PG8_SA(0, 1), a2 + hstep, voffA);
            PG8_WAIT_L(8); PG8_BAR; PG8_WAIT_L(0); PG8_MMA(0, 0, At, B0); PG8_BAR; PG8_SCHED;
            PG8_LDB(B1, 1, 1); PG8_STAGE(PG8_SB(1, 0), b3, voffB);
            PG8_BAR; PG8_WAIT_L(0); PG8_MMA(0, 1, At, B1); PG8_BAR;
            PG8_LDA(At, 1, 1); PG8_STAGE(PG8_SA(1, 0), a3, voffA);
            PG8_BAR; PG8_WAIT_L(0); PG8_MMA(1, 0, At, B0); PG8_BAR; PG8_SCHED;
            PG8_STAGE(PG8_SB(1, 1), b3 + hstep, voffB);
            PG8_WAIT_V(6); PG8_BAR; PG8_MMA(1, 1, At, B1); PG8_BAR;
            }
        }
        if constexpr (ALIGN_EPI) { if (wr == 0) PG8_BAR; }
        if constexpr (!Epi::AFTER_DRAIN) { E(acc, cur, wr, wc, fr, fq); S.done(cur); }
        if (!has_next) break;
#pragma unroll
        for (int a = 0; a < 2; ++a)
#pragma unroll
            for (int b = 0; b < 2; ++b)
#pragma unroll
                for (int m = 0; m < 4; ++m)
#pragma unroll
                    for (int n = 0; n < 2; ++n) acc[a][b][m][n] = (f32x4){0.f, 0.f, 0.f, 0.f};
        cur = nxt; cA = nA; cB = nB; ++ui;
        if constexpr (ALIGN_EPI) { if (wr == 1) PG8_BAR; }
    }
    PG8_WAIT_V(0);
    if constexpr (!ALIGN_EPI) { if (wr == 0) PG8_BAR; }
    PG8_BAR;
    if constexpr (Epi::AFTER_DRAIN) { E.fused(acc, cur, wr, wc, fr, fq, lds, wid, lane); S.done(cur); }
#undef PG8_SA
#undef PG8_SB
#undef PG8_STAGE
#undef PG8_LDA
#undef PG8_LDB
#undef PG8_MMA
#undef PG8_WAIT_V
#undef PG8_WAIT_L
#undef PG8_BAR
#undef PG8_SCHED
}
}

namespace pg8 {
struct EpiProj {
    static constexpr bool PERM = true, AFTER_DRAIN = false;
    bf16_t* H; const float* g; const float* gd;
    const float* rowss;
    __device__ __forceinline__ void operator()(const f32x4 (&acc)[2][2][4][2], const Unit& u, int wr, int wc, int fr, int fq) const {
        const int pn = u.pn;
        int mode = 0; const float* gain = nullptr;
        const float qs = (pn == 0 || pn == 3 || pn == 8) ? 0.125f * 1.4426950408889634f : (pn == 5 ? 0.17677669529663687f * 1.4426950408889634f : 1.f);
        if (pn == 0) { mode = 1; gain = g; } else if (pn == 1) { mode = 1; gain = g + 64; } else if (pn == 3) { mode = 1; gain = g + 128; }
        else if (pn == 4) { if (wc < 2) { mode = 1; gain = g + 192; } }
        else if (pn == 5) { mode = 2; gain = gd; } else if (pn == 6) { mode = 2; gain = gd + 32; }
        else if (pn == 8) { mode = 1; gain = g + 256; }
        else if (pn == 9) { if (wc == 2) { mode = 1; gain = g + 384; } }
        else if (pn == 10) { if (wc == 0) { mode = 1; gain = g + 448; } else if (wc == 2) mode = 4; }
        else if (pn >= 11) mode = 3;
        f32x4 gv[2][2];
#pragma unroll
        for (int bj = 0; bj < 2; ++bj)
#pragma unroll
            for (int n = 0; n < 2; ++n) gv[bj][n] = (f32x4){1.f, 1.f, 1.f, 1.f};
        if (mode == 1) {
#pragma unroll
            for (int bj = 0; bj < 2; ++bj)
#pragma unroll
                for (int n = 0; n < 2; ++n) gv[bj][n] = *(const f32x4*)(gain + 32 * bj + 8 * fq + 4 * n);
        } else if (mode == 2) {
#pragma unroll
            for (int bj = 0; bj < 2; ++bj)
#pragma unroll
                for (int n = 0; n < 2; ++n) gv[bj][n] = *(const f32x4*)(gain + 8 * fq + 4 * n);
        }
        const int col0 = pn * BM + 64 * wc + 8 * fq;
#pragma unroll
        for (int ai = 0; ai < 2; ++ai)
#pragma unroll
            for (int m = 0; m < 4; ++m) {
                const int row = u.pm * BM + ai * HALF + wr * 64 + m * 16 + fr;
                f32x4 v[2][2];
                const float rsc = rowss ? rsqrtf((float)((const unsigned long long*)rowss)[row] * (1.f / (1048576.f * 1024.f)) + 1e-6f) : 1.f;
#pragma unroll
                for (int bj = 0; bj < 2; ++bj)
#pragma unroll
                    for (int n = 0; n < 2; ++n) v[bj][n] = acc[ai][bj][m][n] * rsc;
                if (mode == 1 || mode == 2) {
                    float s0 = 0.f, s1 = 0.f;
#pragma unroll
                    for (int n = 0; n < 2; ++n) {
                        s0 += v[0][n][0] * v[0][n][0] + v[0][n][1] * v[0][n][1] + v[0][n][2] * v[0][n][2] + v[0][n][3] * v[0][n][3];
                        s1 += v[1][n][0] * v[1][n][0] + v[1][n][1] * v[1][n][1] + v[1][n][2] * v[1][n][2] + v[1][n][3] * v[1][n][3];
                    }
                    s0 += __shfl_xor(s0, 16); s0 += __shfl_xor(s0, 32);
                    s1 += __shfl_xor(s1, 16); s1 += __shfl_xor(s1, 32);
                    float r0, r1;
                    if (mode == 1) { r0 = r1 = rsqrtf((s0 + s1) * (1.f / 64.f) + 1e-6f) * qs; }
                    else { r0 = rsqrtf(s0 * (1.f / 32.f) + 1e-6f) * qs; r1 = rsqrtf(s1 * (1.f / 32.f) + 1e-6f) * qs; }
#pragma unroll
                    for (int n = 0; n < 2; ++n) { v[0][n] = v[0][n] * r0 * gv[0][n]; v[1][n] = v[1][n] * r1 * gv[1][n]; }
                } else if (mode == 3) {
#pragma unroll
                    for (int bj = 0; bj < 2; ++bj)
#pragma unroll
                        for (int n = 0; n < 2; ++n)
#pragma unroll
                            for (int e = 0; e < 4; ++e) { const float x = v[bj][n][e]; v[bj][n][e] = x * __builtin_amdgcn_rcpf(1.f + __expf(-x)); }
                } else if (mode == 4) {
#pragma unroll
                    for (int bj = 0; bj < 2; ++bj)
#pragma unroll
                        for (int n = 0; n < 2; ++n)
#pragma unroll
                            for (int e = 0; e < 4; ++e) { const float x = v[bj][n][e]; v[bj][n][e] = __builtin_amdgcn_rcpf(1.f + __expf(-x)); }
                }
                bf16_t* rowp = H + (size_t)row * 3840 + col0;
#pragma unroll
                for (int bj = 0; bj < 2; ++bj) {
                    u32x4 w; w.x = cvt_pk_bf16(v[bj][0][0], v[bj][0][1]); w.y = cvt_pk_bf16(v[bj][0][2], v[bj][0][3]);
                    w.z = cvt_pk_bf16(v[bj][1][0], v[bj][1][1]); w.w = cvt_pk_bf16(v[bj][1][2], v[bj][1][3]);
                    *(u32x4*)(rowp + 32 * bj) = w;
                }
            }
    }
};
struct EpiOut {
    static constexpr bool PERM = false, AFTER_DRAIN = false;
    const float* xprev32;
    const bf16_t* xprev16;
    float* out;
    PG8_LAS float* exch;
    bf16_t* x1b; float* rowss;
    __device__ __forceinline__ void operator()(const f32x4 (&acc)[2][2][4][2], const Unit& u, int wr, int wc, int fr, int fq) const {
        const int col0 = u.pn * BM + wc * 32 + 4 * fq;
        const bool first = xprev32 != nullptr;
#pragma unroll
        for (int ai = 0; ai < 2; ++ai)
#pragma unroll
            for (int m = 0; m < 4; ++m) {
                const int row = u.pm * BM + ai * HALF + wr * 64 + m * 16 + fr;
                const size_t off = (size_t)row * 1024 + col0;
                float ss = 0.f;
#pragma unroll
                for (int bj = 0; bj < 2; ++bj)
#pragma unroll
                    for (int n = 0; n < 2; ++n) {
                        if (first) {
                            const f32x4 b = *(const f32x4*)(xprev32 + off + bj * HALF + n * 16);
                            const f32x4 v = b + acc[ai][bj][m][n];
                            ss += (v[0] * v[0] + v[1] * v[1]) + (v[2] * v[2] + v[3] * v[3]);
                            uint2 o; o.x = cvt_pk_bf16(v[0], v[1]); o.y = cvt_pk_bf16(v[2], v[3]);
                            *(uint2*)(x1b + off + bj * HALF + n * 16) = o;
                        } else {
                            const uint2 r = *(const uint2*)(xprev16 + off + bj * HALF + n * 16);
                            const f32x4 b = (f32x4){__uint_as_float(r.x << 16), __uint_as_float(r.x & 0xffff0000u), __uint_as_float(r.y << 16), __uint_as_float(r.y & 0xffff0000u)};
                            *(f32x4*)(out + off + bj * HALF + n * 16) = b + acc[ai][bj][m][n];
                        }
                    }
                if (first) {
                    ss += __shfl_xor(ss, 16); ss += __shfl_xor(ss, 32);
                    if (fq == 0) exch[(ai * HALF + wr * 64 + m * 16 + fr) * 4 + wc] = ss;
                }
            }
        if (first) {
            asm volatile("s_waitcnt lgkmcnt(0)" ::: "memory"); __builtin_amdgcn_s_barrier(); asm volatile("" ::: "memory");
            if (wc == 0) {
                const int lane = fq * 16 + fr;
#pragma unroll
                for (int k = 0; k < 2; ++k) {
                    const int rl = k * HALF + wr * 64 + lane;
                    const f32x4 p = *(const PG8_LAS f32x4*)(exch + rl * 4);
                    const float tot = (p[0] + p[1]) + (p[2] + p[3]);
                    atomicAdd((unsigned long long*)rowss + (u.pm * BM + rl), (unsigned long long)(tot * 1048576.f + 0.5f));
                }
            }
        }
    }
};
}

template <int MODE>
__device__ __forceinline__ void p0_transpose_item(const float* __restrict__ W, bf16_t* __restrict__ WT, LAS float* scr, int item, int lane, int KR = 1024, int NC = 1024, const float* __restrict__ gk = nullptr) {
    const int NSRC = MODE == 0 ? 3724 : NC, NG = MODE == 0 ? 120 : NC / 32;
    const int kb = item / NG, nb = item % NG, k0 = 64 * kb, hc0 = 32 * nb;
    const int hc = hc0 + (lane & 31);
    int src = hc;
    if (MODE == 0) src = hc < 2700 ? hc : (hc < 2816 ? -1 : hc - 116);
    float wv[32];
#pragma unroll
    for (int i = 0; i < 32; ++i) { const int kk = 2 * i + (lane >> 5); wv[i] = src >= 0 ? W[(size_t)(k0 + kk) * NSRC + src] : 0.f; }
#pragma unroll
    for (int i = 0; i < 32; ++i) { const int kk = 2 * i + (lane >> 5); scr[kk * 33 + (lane & 31)] = MODE == 0 ? wv[i] * gk[k0 + kk] : wv[i]; }
    asm volatile("s_waitcnt lgkmcnt(0)" ::: "memory");
    const int c = lane & 7;
#pragma unroll
    for (int j = 0; j < 4; ++j) {
        const int n = (lane >> 3) + 8 * j; const LAS float* s = scr + (8 * c) * 33 + n;
        const int hcn = hc0 + n;
        int drow = hcn;
        if (MODE == 0) drow = (hcn & ~255) + ((hcn >> 5) & 1) * 128 + ((hcn >> 6) & 3) * 32 + (hcn & 31);
        uint4 o; o.x = (unsigned)f2bf(s[0]) | ((unsigned)f2bf(s[33]) << 16); o.y = (unsigned)f2bf(s[66]) | ((unsigned)f2bf(s[99]) << 16);
        o.z = (unsigned)f2bf(s[132]) | ((unsigned)f2bf(s[165]) << 16); o.w = (unsigned)f2bf(s[198]) | ((unsigned)f2bf(s[231]) << 16);
        if (MODE == 2) { const int k = k0 + 8 * c; *(uint4*)(WT + ((size_t)((((drow >> 5) * 8 + (k >> 8)) * 16 + ((k >> 4) & 15)) * 64 + ((k >> 3) & 1) * 32 + (drow & 31))) * 8) = o; }
        else *(uint4*)(WT + (size_t)drow * KR + k0 + 8 * c) = o;
    }
    asm volatile("s_waitcnt lgkmcnt(0)" ::: "memory");
}

namespace att {
typedef short bf16x8 __attribute__((ext_vector_type(8)));
typedef short v4i16 __attribute__((ext_vector_type(4)));
typedef float f32x16 __attribute__((ext_vector_type(16)));
typedef float f32x2_t __attribute__((ext_vector_type(2)));
typedef __bf16 bf16x2_t __attribute__((ext_vector_type(2)));
typedef unsigned u32x4 __attribute__((ext_vector_type(4)));
typedef float f32x4 __attribute__((ext_vector_type(4)));
__device__ __forceinline__ unsigned cvtpk(float lo, float hi) { f32x2_t v = {lo, hi}; bf16x2_t b = __builtin_convertvector(v, bf16x2_t); return __builtin_bit_cast(unsigned, b); }
__device__ __forceinline__ int crow(int r, int h) { return (r & 3) + 8 * (r >> 2) + 4 * h; }
constexpr float LOG2E = 1.4426950408889634f;
constexpr int L_KV = 0, KVB = 16384  , L_TAB = 32768  , L_WSCR = 83968  , L_IMP = 92160  , L_Q = 124928, L_SEL = 125184  , L_SB = 126464  ;

struct StageRegs { u32x4 k, v; };
__device__ __forceinline__ void stage_load(StageRegs& sr, const bf16_t* kp, const bf16_t* vp, bool valid, int ch) {
    sr.k = (u32x4){0u, 0u, 0u, 0u}; sr.v = sr.k;
    if (valid) { sr.k = *(const u32x4*)(kp + ch * 8); sr.v = *(const u32x4*)(vp + ch * 8); }
}
__device__ __forceinline__ void stage_write(LAS unsigned char* buf, const StageRegs& sr, int row, int ch) {
    *(LAS u32x4*)(buf + row * 128 + ((ch ^ (row & 7)) << 4)) = sr.k;
    *(LAS u32x4*)(buf + 8192 + (ch >> 2) * 4096 + row * 64 + (ch & 3) * 16) = sr.v;
}
__device__ __forceinline__ f32x16 load_tab16(const LAS float* tbl, int TSP, int jb) {
    const int sh = jb & 3; const LAS float* tp = tbl + sh * TSP + (jb - sh);
    const f32x4 t0 = *(const LAS f32x4*)(tp), t1 = *(const LAS f32x4*)(tp + 8), t2 = *(const LAS f32x4*)(tp + 16), t3 = *(const LAS f32x4*)(tp + 24);
    return (f32x16){t0[0], t0[1], t0[2], t0[3], t1[0], t1[1], t1[2], t1[3], t2[0], t2[1], t2[2], t2[3], t3[0], t3[1], t3[2], t3[3]};
}
__device__ __forceinline__ float exp_sum16(f32x16& acc) {
    float sa = 0.f, sb = 0.f;
#pragma unroll
    for (int r = 0; r < 16; r += 2) {
        acc[r] = __builtin_amdgcn_exp2f(acc[r]); acc[r + 1] = __builtin_amdgcn_exp2f(acc[r + 1]);
        sa += acc[r]; asm volatile("" : "+v"(sa)); sb += acc[r + 1]; asm volatile("" : "+v"(sb));
    }
    return sa + sb;
}
__device__ __forceinline__ f32x16 splat16(float v) { return (f32x16){v, v, v, v, v, v, v, v, v, v, v, v, v, v, v, v}; }
template <int S0, int S1>
__device__ __forceinline__ void qk_sub(f32x16& acc, const LAS unsigned char* buf, int sub, const bf16x8* qf, int lane) {
    const int key = 32 * sub + (lane & 31), h = lane >> 5;
    bf16x8 kf[S1 - S0];
#pragma unroll
    for (int s = S0; s < S1; ++s) kf[s - S0] = *(const LAS bf16x8*)(buf + key * 128 + (((2 * s + h) ^ (key & 7)) << 4));
    __builtin_amdgcn_sched_barrier(0);
#pragma unroll
    for (int s = S0; s < S1; ++s) acc = __builtin_amdgcn_mfma_f32_32x32x16_bf16(kf[s - S0], qf[s], acc, 0, 0, 0);
}
__device__ __forceinline__ void pack_p(const f32x16& p, bf16x8& pa0, bf16x8& pa1) {
    u32x4 w0, w1;
    w0.x = cvtpk(p[0], p[1]); w0.y = cvtpk(p[2], p[3]); w0.z = cvtpk(p[4], p[5]); w0.w = cvtpk(p[6], p[7]);
    w1.x = cvtpk(p[8], p[9]); w1.y = cvtpk(p[10], p[11]); w1.z = cvtpk(p[12], p[13]); w1.w = cvtpk(p[14], p[15]);
    pa0 = __builtin_bit_cast(bf16x8, w0); pa1 = __builtin_bit_cast(bf16x8, w1);
}
__device__ __forceinline__ void pv_sub(f32x16* o, const LAS unsigned char* buf, int sub, const bf16x8& pa0, const bf16x8& pa1, int lane) {
    const int h = lane >> 5, g16 = (lane >> 4) & 1, q4 = (lane & 15) >> 2, p4 = lane & 3;
    const LAS unsigned char* vb = buf + 8192 + (32 * sub + 4 * h + q4) * 64 + (16 * g16 + 4 * p4) * 2;
    bf16x8 vf[2][2];
#pragma unroll
    for (int dt = 0; dt < 2; ++dt) {
#pragma unroll
        for (int s2 = 0; s2 < 2; ++s2) {
            const v4i16 lo = __builtin_amdgcn_ds_read_tr16_b64_v4i16((LAS v4i16*)(vb + dt * 4096 + s2 * 1024));
            const v4i16 hi = __builtin_amdgcn_ds_read_tr16_b64_v4i16((LAS v4i16*)(vb + dt * 4096 + s2 * 1024 + 512));
            vf[dt][s2] = (bf16x8){lo[0], lo[1], lo[2], lo[3], hi[0], hi[1], hi[2], hi[3]};
        }
    }
    __builtin_amdgcn_sched_barrier(0);
    o[0] = __builtin_amdgcn_mfma_f32_32x32x16_bf16(pa0, vf[0][0], o[0], 0, 0, 0);
    o[1] = __builtin_amdgcn_mfma_f32_32x32x16_bf16(pa0, vf[1][0], o[1], 0, 0, 0);
    o[0] = __builtin_amdgcn_mfma_f32_32x32x16_bf16(pa1, vf[0][1], o[0], 0, 0, 0);
    o[1] = __builtin_amdgcn_mfma_f32_32x32x16_bf16(pa1, vf[1][1], o[1], 0, 0, 0);
}

__device__ __forceinline__ void pv_sub2(f32x16* oa, f32x16* ob, const LAS unsigned char* buf, int sub, const bf16x8& a0, const bf16x8& a1, const bf16x8& b0, const bf16x8& b1, int lane) {
    const int h = lane >> 5, g16 = (lane >> 4) & 1, q4 = (lane & 15) >> 2, p4 = lane & 3;
    const LAS unsigned char* vb = buf + 8192 + (32 * sub + 4 * h + q4) * 64 + (16 * g16 + 4 * p4) * 2;
#pragma unroll
    for (int dt = 0; dt < 2; ++dt) {
#pragma unroll
        for (int s2 = 0; s2 < 2; ++s2) {
            const v4i16 lo = __builtin_amdgcn_ds_read_tr16_b64_v4i16((LAS v4i16*)(vb + dt * 4096 + s2 * 1024));
            const v4i16 hi = __builtin_amdgcn_ds_read_tr16_b64_v4i16((LAS v4i16*)(vb + dt * 4096 + s2 * 1024 + 512));
            const bf16x8 vf = (bf16x8){lo[0], lo[1], lo[2], lo[3], hi[0], hi[1], hi[2], hi[3]};
            oa[dt] = __builtin_amdgcn_mfma_f32_32x32x16_bf16(s2 == 0 ? a0 : a1, vf, oa[dt], 0, 0, 0);
            ob[dt] = __builtin_amdgcn_mfma_f32_32x32x16_bf16(s2 == 0 ? b0 : b1, vf, ob[dt], 0, 0, 0);
        }
    }
}

struct BandArgs {
    const bf16_t* Hb;
    int cq, ck, cv;
    int rate, cls, f0, maxd;
    const float* bias;
    float M;
    float sinkterm;
    bf16_t* OA; float* DA;
    bf16_t* Y; int ycol;
    int hd; size_t brow;
};
constexpr int B_TAB = 98304, B_WSCR = 106496;
template <int MODE>
__device__ __forceinline__ void banded_unit(LAS unsigned char* lds, const BandArgs& P) {
    const int tid = opq(threadIdx.x), lane = tid & 63, w = __builtin_amdgcn_readfirstlane(tid >> 6), h = lane >> 5;
    LAS float* sb = (LAS float*)(lds + L_SB);
    LAS float* tbl = (LAS float*)(lds + B_TAB);
    const int KPREV = ((P.maxd + 63) >> 6) << 6;
    const int t0 = (KPREV - P.f0) > 0 ? ((KPREV - P.f0) >> 6) : 0;
    const int srow = tid >> 3, sch = tid & 7;
    StageRegs sr[6];
#pragma unroll
    for (int i = 0; i < 6; ++i) {
        int kf = P.f0 - KPREV + 64 * i + srow; kf = kf < 0 ? 0 : kf;
        const bf16_t* rp = P.Hb + ((size_t)kf * P.rate + P.cls) * HP;
        stage_load(sr[i], rp + P.ck, rp + P.cv, true, sch);
    }
    const int fq0 = P.f0 + 32 * w;
    bf16x8 qf[4];
    {
        const size_t tq = (size_t)(fq0 + (lane & 31)) * P.rate + P.cls;
        const bf16_t* qp = P.Hb + tq * HP + P.cq + 8 * h;
#pragma unroll
        for (int s = 0; s < 4; ++s) qf[s] = *(const bf16x8*)(qp + 16 * s);
    }
    if (tid < 32) sb[tid] = (P.bias[tid * 16] - P.M) * LOG2E;
    __syncthreads();
    const int DMAXI = P.maxd + 62, TS = P.maxd + 125, TSP = (TS + 7) & ~3;
    for (int e = tid; e < 4 * TSP; e += 512) {
        const int sh = e / TSP, j = e - sh * TSP + sh, dist = DMAXI - j;
        tbl[e] = (j < TS && dist >= 0 && dist <= P.maxd) ? sb[t5_bucket(dist * P.rate)] : -1e30f;
    }
    f32x16 o[2]; o[0] = (f32x16){}; o[1] = (f32x16){};
    float den = 0.f;
#pragma unroll
    for (int i = 0; i < 6; ++i) stage_write(lds + i * KVB, sr[i], srow, sch);
    asm volatile("" : "+v"(qf[0]), "+v"(qf[1]), "+v"(qf[2]), "+v"(qf[3]));
    __syncthreads();
#pragma unroll 1
    for (int t = t0; t < 6; ++t) {
        const LAS unsigned char* buf = lds + t * KVB;
        const int kf0 = P.f0 - KPREV + 64 * t;
#pragma unroll
        for (int sub = 0; sub < 2; ++sub) {
            const int kfs = kf0 + 32 * sub;
            if (kfs <= fq0 + 31 && kfs + 31 >= fq0 - P.maxd) {
                const int jb = DMAXI - ((fq0 - kfs) + (lane & 31) - 4 * h);
                f32x16 acc = load_tab16(tbl, TSP, jb);
                qk_sub<0, 4>(acc, buf, sub, qf, lane);
                den += exp_sum16(acc);
                bf16x8 pa0, pa1; pack_p(acc, pa0, pa1);
                pv_sub(o, buf, sub, pa0, pa1, lane);
            }
        }
    }
    float dtot = den + __shfl_xor(den, 32);
    if (MODE == 1) dtot += P.sinkterm;
    LAS float* ws_ = (LAS float*)(lds + B_WSCR) + w * 64;
    if (h == 0) ws_[lane] = dtot;
    if (MODE == 0 && h == 0) {
        const size_t tq = (size_t)(fq0 + lane) * P.rate + P.cls;
        P.DA[(P.brow + tq) * 4 + P.hd] = dtot;
    }
    asm volatile("s_waitcnt lgkmcnt(0)" ::: "memory");
#pragma unroll
    for (int r = 0; r < 16; ++r) {
        const int qi = crow(r, h);
        const float inv = __builtin_amdgcn_rcpf(ws_[qi]);
        const size_t row = P.brow + (size_t)(fq0 + qi) * P.rate + P.cls;
#pragma unroll
        for (int dt = 0; dt < 2; ++dt) {
            const int d = 32 * dt + (lane & 31);
            const float val = o[dt][r] * inv;
            if (MODE == 0) P.OA[row * 256 + P.hd * 64 + d] = f2bf(val);
            else P.Y[row * DM + P.ycol + d] = f2bf(val * bf2f(P.Hb[(row - P.brow) * HP + C_SILU + P.ycol + d]));
        }
    }
}

__device__ __forceinline__ void diff_p1(const LAS float* tp, const LAS unsigned char* buf, int sub, const bf16x8* qf, int lane, bf16x8& pa0, bf16x8& pa1, bf16x8& pb0, bf16x8& pb1) {
    const f32x4 t0 = *(const LAS f32x4*)(tp), t1 = *(const LAS f32x4*)(tp + 8), t2 = *(const LAS f32x4*)(tp + 16), t3 = *(const LAS f32x4*)(tp + 24);
    const f32x16 T = (f32x16){t0[0], t0[1], t0[2], t0[3], t1[0], t1[1], t1[2], t1[3], t2[0], t2[1], t2[2], t2[3], t3[0], t3[1], t3[2], t3[3]};
    const int key = 32 * sub + (lane & 31), h = lane >> 5;
    const LAS unsigned char* kp = buf + key * 128;
    const bf16x8 k0 = *(const LAS bf16x8*)(kp + (((0 + h) ^ (key & 7)) << 4)), k1 = *(const LAS bf16x8*)(kp + (((2 + h) ^ (key & 7)) << 4));
    const bf16x8 k2 = *(const LAS bf16x8*)(kp + (((4 + h) ^ (key & 7)) << 4)), k3 = *(const LAS bf16x8*)(kp + (((6 + h) ^ (key & 7)) << 4));
    f32x16 a1 = __builtin_amdgcn_mfma_f32_32x32x16_bf16(k0, qf[0], T, 0, 0, 0);
    f32x16 a2 = __builtin_amdgcn_mfma_f32_32x32x16_bf16(k2, qf[2], T, 0, 0, 0);
    a1 = __builtin_amdgcn_mfma_f32_32x32x16_bf16(k1, qf[1], a1, 0, 0, 0);
    a2 = __builtin_amdgcn_mfma_f32_32x32x16_bf16(k3, qf[3], a2, 0, 0, 0);
#pragma unroll
    for (int r = 0; r < 16; ++r) { a1[r] = __builtin_amdgcn_exp2f(a1[r]); a2[r] = __builtin_amdgcn_exp2f(a2[r]); }
    pack_p(a1, pa0, pa1); pack_p(a2, pb0, pb1);
}
__device__ __forceinline__ void diff_p2(const LAS unsigned char* buf, int sub, int lane, const bf16x8& pa0, const bf16x8& pa1, const bf16x8& pb0, const bf16x8& pb1, f32x16& dn1, f32x16& dn2, f32x16* o1, f32x16* o2) {
    const bf16x8 ones = (bf16x8){0x3F80, 0x3F80, 0x3F80, 0x3F80, 0x3F80, 0x3F80, 0x3F80, 0x3F80};
    const int h = lane >> 5, g16 = (lane >> 4) & 1, q4 = (lane & 15) >> 2, p4 = lane & 3;
    const LAS unsigned char* vb = buf + 8192 + (32 * sub + 4 * h + q4) * 64 + (16 * g16 + 4 * p4) * 2;
    bf16x8 vf[2][2];
#pragma unroll
    for (int dt = 0; dt < 2; ++dt) {
#pragma unroll
        for (int s2 = 0; s2 < 2; ++s2) {
            const v4i16 lo = __builtin_amdgcn_ds_read_tr16_b64_v4i16((LAS v4i16*)(vb + dt * 4096 + s2 * 1024));
            const v4i16 hi = __builtin_amdgcn_ds_read_tr16_b64_v4i16((LAS v4i16*)(vb + dt * 4096 + s2 * 1024 + 512));
            vf[dt][s2] = (bf16x8){lo[0], lo[1], lo[2], lo[3], hi[0], hi[1], hi[2], hi[3]};
        }
    }
    __builtin_amdgcn_sched_barrier(0);
    dn1 = __builtin_amdgcn_mfma_f32_32x32x16_bf16(pa0, ones, dn1, 0, 0, 0);
    dn2 = __builtin_amdgcn_mfma_f32_32x32x16_bf16(pb0, ones, dn2, 0, 0, 0);
    dn1 = __builtin_amdgcn_mfma_f32_32x32x16_bf16(pa1, ones, dn1, 0, 0, 0);
    dn2 = __builtin_amdgcn_mfma_f32_32x32x16_bf16(pb1, ones, dn2, 0, 0, 0);
    o1[0] = __builtin_amdgcn_mfma_f32_32x32x16_bf16(pa0, vf[0][0], o1[0], 0, 0, 0);
    o2[0] = __builtin_amdgcn_mfma_f32_32x32x16_bf16(pb0, vf[0][0], o2[0], 0, 0, 0);
    o1[1] = __builtin_amdgcn_mfma_f32_32x32x16_bf16(pa0, vf[1][0], o1[1], 0, 0, 0);
    o2[1] = __builtin_amdgcn_mfma_f32_32x32x16_bf16(pb0, vf[1][0], o2[1], 0, 0, 0);
    o1[0] = __builtin_amdgcn_mfma_f32_32x32x16_bf16(pa1, vf[0][1], o1[0], 0, 0, 0);
    o2[0] = __builtin_amdgcn_mfma_f32_32x32x16_bf16(pb1, vf[0][1], o2[0], 0, 0, 0);
    o1[1] = __builtin_amdgcn_mfma_f32_32x32x16_bf16(pa1, vf[1][1], o1[1], 0, 0, 0);
    o2[1] = __builtin_amdgcn_mfma_f32_32x32x16_bf16(pb1, vf[1][1], o2[1], 0, 0, 0);
}

struct DiffArgs {
    const bf16_t* Hb; int hd, qb; size_t brow;
    const float* bias; float M; float lam, lambda_init; const float* subln;
    bf16_t* Y;
};
constexpr int D_SB = 49152, D_TAB = 49664;
__device__ __forceinline__ void diff_unit(LAS unsigned char* lds, const DiffArgs& P) {
    const int tid = opq(threadIdx.x), lane = tid & 63, w = __builtin_amdgcn_readfirstlane(tid >> 6), h = lane >> 5;
    LAS float* sb = (LAS float*)(lds + D_SB);
    LAS float* tbl = (LAS float*)(lds + D_TAB);
    constexpr int DTOP = 1574, TS = DTOP + 63, TSP = (TS + 7) & ~3;
    __syncthreads();
    if (tid < 32) sb[tid] = (P.bias[tid * 16] - P.M) * LOG2E;
    __syncthreads();
    for (int e = tid; e < 4 * TSP; e += 512) {
        const int sh = e / TSP, j = e - sh * TSP + sh, dist = DTOP - j;
        tbl[e] = (j < TS && dist >= 0) ? sb[t5_bucket(dist)] : -1e30f;
    }
    LAS float* farc = tbl + 4 * TSP;
    LAS float* deadr = farc + 32;
    if (tid < 32) { farc[tid] = sb[31]; deadr[tid] = -1e30f; }
    const int q0w = P.qb * 256 + 32 * w;
    const int cq = C_CQ + 64 * P.hd, ck = C_CK + 64 * P.hd, cv = C_CV + 64 * P.hd;
    bf16x8 qf[4];
    {
        const bf16_t* qp = P.Hb + (size_t)(q0w + (lane & 31)) * HP + cq + 8 * h;
#pragma unroll
        for (int s = 0; s < 4; ++s) qf[s] = *(const bf16x8*)(qp + 16 * s);
        asm volatile("" : "+v"(qf[0]), "+v"(qf[1]), "+v"(qf[2]), "+v"(qf[3]));
    }
    const int ntl = 4 * (P.qb + 1);
    const int srow = tid >> 3, sch = tid & 7;
    f32x16 o1[2], o2[2]; o1[0] = (f32x16){}; o1[1] = (f32x16){}; o2[0] = (f32x16){}; o2[1] = (f32x16){};
    f32x16 dn1 = (f32x16){}, dn2 = (f32x16){};
    StageRegs sr;
    {
        const bf16_t* rp = P.Hb + (size_t)srow * HP;
        stage_load(sr, rp + ck, rp + cv, true, sch);
        stage_write(lds, sr, srow, sch);
    }
    __syncthreads();
#define DIFF_TP(KS) ({ const int ks_ = (KS); const int jb_ = DTOP - ((q0w - ks_) + (lane & 31) - 4 * h), sh_ = jb_ & 3; \
        const LAS float* tp_ = tbl + sh_ * TSP + (jb_ - sh_); tp_ = (q0w - ks_ - 31 >= 1513) ? farc : tp_; tp_ = (ks_ > q0w + 31) ? deadr : tp_; tp_; })
#define DIFF_STAGE_LOAD(t) do { const int tn_ = (t) + 1 < ntl ? (t) + 1 : (t); const bf16_t* rp_ = P.Hb + (size_t)(64 * tn_ + srow) * HP; stage_load(sr, rp_ + ck, rp_ + cv, true, sch); } while (0)
    if (w < 4) {
        int cur = 0;
        for (int t = 0; t < ntl; ++t) {
            LAS unsigned char* buf = lds + cur * KVB;
            const int nxt = cur == 2 ? 0 : cur + 1;
            DIFF_STAGE_LOAD(t);
            bf16x8 pa0, pa1, pb0, pb1;
            diff_p1(DIFF_TP(64 * t), buf, 0, qf, lane, pa0, pa1, pb0, pb1);
            diff_p2(buf, 0, lane, pa0, pa1, pb0, pb1, dn1, dn2, o1, o2);
            diff_p1(DIFF_TP(64 * t + 32), buf, 1, qf, lane, pa0, pa1, pb0, pb1);
            diff_p2(buf, 1, lane, pa0, pa1, pb0, pb1, dn1, dn2, o1, o2);
            stage_write(lds + nxt * KVB, sr, srow, sch);
            __syncthreads();
            cur = nxt;
        }
    } else {
        const bf16x8 zero8 = (bf16x8){0, 0, 0, 0, 0, 0, 0, 0};
        bf16x8 qa0 = zero8, qa1 = zero8, qb0 = zero8, qb1 = zero8;
        int cur = 0, prv = 0;
        __builtin_amdgcn_s_setprio(1);
        for (int t = 0; t < ntl; ++t) {
            LAS unsigned char* buf = lds + cur * KVB;
            const int nxt = cur == 2 ? 0 : cur + 1;
            DIFF_STAGE_LOAD(t);
            diff_p2(lds + prv * KVB, 1, lane, qa0, qa1, qb0, qb1, dn1, dn2, o1, o2);
            bf16x8 pa0, pa1, pb0, pb1;
            diff_p1(DIFF_TP(64 * t), buf, 0, qf, lane, pa0, pa1, pb0, pb1);
            diff_p2(buf, 0, lane, pa0, pa1, pb0, pb1, dn1, dn2, o1, o2);
            diff_p1(DIFF_TP(64 * t + 32), buf, 1, qf, lane, qa0, qa1, qb0, qb1);
            stage_write(lds + nxt * KVB, sr, srow, sch);
            __syncthreads();
            prv = cur; cur = nxt;
        }
        diff_p2(lds + prv * KVB, 1, lane, qa0, qa1, qb0, qb1, dn1, dn2, o1, o2);
        __builtin_amdgcn_s_setprio(0);
    }
    __syncthreads();
#undef DIFF_TP
#undef DIFF_STAGE_LOAD
    const float g0 = P.subln[lane & 31] * (1.f - P.lambda_init), g1 = P.subln[32 + (lane & 31)] * (1.f - P.lambda_init);
    const int ycol = 512 + 64 * P.hd;
#pragma unroll
    for (int r = 0; r < 16; ++r) {
        const int qi = crow(r, h);
        const float i1 = __builtin_amdgcn_rcpf(dn1[r]), i2 = P.lam * __builtin_amdgcn_rcpf(dn2[r]);
        const float a0 = o1[0][r] * i1 - o2[0][r] * i2, a1 = o1[1][r] * i1 - o2[1][r] * i2;
        float ss = a0 * a0 + a1 * a1;
        ss += __shfl_xor(ss, 1); ss += __shfl_xor(ss, 2); ss += __shfl_xor(ss, 4); ss += __shfl_xor(ss, 8); ss += __shfl_xor(ss, 16);
        const float rs = rsqrtf(ss * (1.f / 64.f) + 1e-6f);
        const size_t trow = (size_t)(q0w + qi);
        const bf16_t* sp = P.Hb + trow * HP + C_SILU + ycol;
        bf16_t* yp = P.Y + (P.brow + trow) * DM + ycol;
        yp[lane & 31] = f2bf(a0 * rs * g0 * bf2f(sp[lane & 31]));
        yp[32 + (lane & 31)] = f2bf(a1 * rs * g1 * bf2f(sp[32 + (lane & 31)]));
    }
}
struct CmpArgs {
    const bf16_t* Hb;
    int col;
    int rt;
    const float* pos;
    const bf16_t* W1T;
    const float* b1;
    const bf16_t* W2T;
    const float* b2;
    const float* gain;
    bf16_t* OUT;
};
__device__ __forceinline__ void cmp_unit(LAS unsigned char* lds, const CmpArgs& P) {
    const int tid = opq(threadIdx.x), lane = tid & 63, w = __builtin_amdgcn_readfirstlane(tid >> 6), h = lane >> 5;
    LAS unsigned char* hidl = lds + L_KV;
    LAS float* ssx = (LAS float*)(lds + L_KV + 32768 - 512);
    LAS unsigned char* abuf = lds + L_TAB;
    f32x16 acc = (f32x16){};
    const bf16_t* w1p = P.W1T + (size_t)w * (8 * 16 * 64 * 8) + lane * 8;
    u32x4 araw[2]; f32x4 apos[2][2];
#define CMP_ALOAD(ch) do { _Pragma("unroll") for (int q_ = 0; q_ < 2; ++q_) { const int p_ = tid + 512 * q_, row_ = p_ >> 5, kc_ = p_ & 31; \
        int ir_ = 32 * P.rt + row_; if (ir_ > 510) ir_ = 510; const int tok_ = 4 * (ch) + (kc_ >> 3), d_ = 8 * (kc_ & 7); \
        araw[q_] = *(const u32x4*)(P.Hb + (size_t)(16 * ir_ + tok_) * HP + P.col + d_); \
        apos[q_][0] = *(const f32x4*)(P.pos + tok_ * 64 + d_); apos[q_][1] = *(const f32x4*)(P.pos + tok_ * 64 + d_ + 4); } } while (0)
#define CMP_AWRITE(bufi) do { _Pragma("unroll") for (int q_ = 0; q_ < 2; ++q_) { const int p_ = tid + 512 * q_, row_ = p_ >> 5, kc_ = p_ & 31; u32x4 aw_; \
        aw_.x = cvtpk(__uint_as_float(araw[q_].x << 16) + apos[q_][0][0], __uint_as_float(araw[q_].x & 0xffff0000u) + apos[q_][0][1]); \
        aw_.y = cvtpk(__uint_as_float(araw[q_].y << 16) + apos[q_][0][2], __uint_as_float(araw[q_].y & 0xffff0000u) + apos[q_][0][3]); \
        aw_.z = cvtpk(__uint_as_float(araw[q_].z << 16) + apos[q_][1][0], __uint_as_float(araw[q_].z & 0xffff0000u) + apos[q_][1][1]); \
        aw_.w = cvtpk(__uint_as_float(araw[q_].w << 16) + apos[q_][1][2], __uint_as_float(araw[q_].w & 0xffff0000u) + apos[q_][1][3]); \
        *(LAS u32x4*)(abuf + (bufi) * 16896 + row_ * 528 + kc_ * 16) = aw_; } } while (0)
    CMP_ALOAD(0); CMP_AWRITE(0);
    __syncthreads();
    for (int ch = 0; ch < 8; ++ch) {
        const int cn = ch + 1 < 8 ? ch + 1 : ch;
        CMP_ALOAD(cn);
        const LAS unsigned char* ab = abuf + (ch & 1) * 16896 + (lane & 31) * 528 + 16 * h;
        bf16x8 bfr[16];
#pragma unroll
        for (int ks = 0; ks < 16; ++ks) bfr[ks] = *(const bf16x8*)(w1p + (ch * 16 + ks) * 512);
#pragma unroll
        for (int ks = 0; ks < 16; ++ks) {
            const bf16x8 af = *(const LAS bf16x8*)(ab + 32 * ks);
            acc = __builtin_amdgcn_mfma_f32_32x32x16_bf16(af, bfr[ks], acc, 0, 0, 0);
        }
        CMP_AWRITE((ch + 1) & 1);
        __syncthreads();
    }
#undef CMP_ALOAD
#undef CMP_AWRITE
    {
        const int j = 32 * w + (lane & 31); const float bb = P.b1[j];
#pragma unroll
        for (int r = 0; r < 16; ++r) {
            const float x = acc[r] + bb;
            const float u = 0.7978845608028654f * (x + 0.044715f * x * x * x);
            const float th = 1.f - 2.f / (1.f + __expf(2.f * u));
            const float gl = 0.5f * x * (1.f + th);
            *(LAS bf16_t*)(hidl + crow(r, h) * 528 + j * 2) = f2bf(gl);
        }
    }
    __syncthreads();
    float outv[16]; float ssp[16];
    if (w < 2) {
        f32x16 a2 = (f32x16){};
        const bf16_t* w2p = P.W2T + (size_t)(32 * w + (lane & 31)) * 256 + 8 * h;
#pragma unroll
        for (int ks = 0; ks < 16; ++ks) {
            const bf16x8 af = *(const LAS bf16x8*)(hidl + (lane & 31) * 528 + (16 * ks + 8 * h) * 2);
            const bf16x8 bfr = *(const bf16x8*)(w2p + 16 * ks);
            a2 = __builtin_amdgcn_mfma_f32_32x32x16_bf16(af, bfr, a2, 0, 0, 0);
        }
        const float bb = P.b2[32 * w + (lane & 31)];
#pragma unroll
        for (int r = 0; r < 16; ++r) {
            outv[r] = a2[r] + bb;
            float ss = outv[r] * outv[r];
            ss += __shfl_xor(ss, 1); ss += __shfl_xor(ss, 2); ss += __shfl_xor(ss, 4); ss += __shfl_xor(ss, 8); ss += __shfl_xor(ss, 16);
            ssp[r] = ss;
            if ((lane & 31) == 0) ssx[w * 32 + crow(r, h)] = ss;
        }
    }
    __syncthreads();
    if (w < 2) {
        const int d = 32 * w + (lane & 31);
        const float gn = P.gain ? P.gain[d] : 1.f;
#pragma unroll
        for (int r = 0; r < 16; ++r) {
            const int row = 32 * P.rt + crow(r, h);
            float v = outv[r];
            if (P.gain) { const float tot = ssx[crow(r, h)] + ssx[32 + crow(r, h)]; v = v * rsqrtf(tot * (1.f / 64.f) + 1e-6f) * gn; }
            if (row <= 510) P.OUT[(size_t)row * 64 + d] = f2bf(v);
        }
    }
    __syncthreads();
}

struct NsaArgs {
    const bf16_t* Hb; size_t brow; int qb;
    const bf16_t* KC; const bf16_t* VC;
    const float* bias;
    const float* Mv;
    bf16_t* Y; unsigned* cdone;
    float* scr;
};
constexpr int GTOP = 2015, GTS = 2519, WTOP = 549, WTS = 588, DEAD = 4 * GTS + 4 * WTS;
__device__ __forceinline__ void nsa_unit(LAS unsigned char* lds, const NsaArgs& P) {
    const int tid = opq(threadIdx.x), lane = tid & 63, w = __builtin_amdgcn_readfirstlane(tid >> 6), hh = lane >> 5;
    const int n = lane & 31, q8 = n >> 2, hd = n & 3;
    LAS float* tg = (LAS float*)(lds + L_TAB);
    LAS float* tw = tg + 4 * GTS;
    LAS float* dead = tg + DEAD;
    LAS float* impw = (LAS float*)(lds + L_IMP) + w * 1024;
    LAS unsigned* selw = (LAS unsigned*)(lds + L_SEL) + w * 32;
    LAS unsigned* uni = (LAS unsigned*)(lds + L_SEL) + 256;
    LAS float* ws_ = (LAS float*)(lds + L_WSCR) + w * 256;
    LAS float* sbh = (LAS float*)(lds + L_SB);
    if (tid < 128) sbh[tid] = (P.bias[(tid & 31) * 16 + (tid >> 5)] - P.Mv[tid >> 5]) * LOG2E;
    __syncthreads();
    for (int e = tid; e < 4 * GTS; e += 512) { const int hq = e / GTS, j = e % GTS, dist = GTOP - j;
        tg[e] = dist >= 0 ? sbh[hq * 32 + t5_bucket(dist)] : -1e30f; }
    for (int e = tid; e < 4 * WTS; e += 512) { const int hq = e / WTS, j = e % WTS, dist = WTOP - j;
        tw[e] = (dist >= 0 && dist <= 511) ? sbh[hq * 32 + t5_bucket(dist)] : -1e30f; }
    if (tid < 64) dead[tid] = -1e30f;
    for (int e = lane; e < 1024; e += 64) impw[e] = 0.f;
    if (tid < 4) uni[tid] = 0u;
    const float cfar = sbh[hd * 32 + 31];
    const int tq = 64 * P.qb + 8 * w + q8;
    const int twmin = 64 * P.qb + 8 * w, twmax = twmin + 7;
    bf16x8 qf[4];
    {
        const bf16_t* qp = P.Hb + (size_t)tq * HP + C_DQ + 64 * hd + 8 * hh;
#pragma unroll
        for (int s = 0; s < 4; ++s) qf[s] = *(const bf16x8*)(qp + 16 * s);
        asm volatile("" : "+v"(qf[0]), "+v"(qf[1]), "+v"(qf[2]), "+v"(qf[3]));
    }
    {
        const bf16_t* gp = P.Hb + (size_t)tq * HP + C_GT + 3 * hd;
        if (hh == 0) { ws_[n] = bf2f(gp[0]); ws_[32 + n] = bf2f(gp[1]); ws_[64 + n] = bf2f(gp[2]); }
    }
    const int srow = tid >> 3, sch = tid & 7;
    StageRegs sr;
    f32x16 o[2], outv[2];
    float den = 0.f;
    o[0] = (f32x16){}; o[1] = (f32x16){};
    {
        const int kt0 = P.qb >= 8 ? P.qb - 8 : 0, nkt = P.qb - kt0 + 1;
        {
            const bf16_t* rp = P.Hb + (size_t)(64 * kt0 + srow) * HP;
            stage_load(sr, rp + C_KW, rp + C_VW, true, sch);
            stage_write(lds + L_KV, sr, srow, sch);
        }
        __syncthreads();
        for (int t = 0; t < nkt; ++t) {
            LAS unsigned char* buf = lds + L_KV + (t & 1) * KVB;
            if (t + 1 < nkt) { const bf16_t* rp = P.Hb + (size_t)(64 * (kt0 + t + 1) + srow) * HP; stage_load(sr, rp + C_KW, rp + C_VW, true, sch); }
#pragma unroll
            for (int sub = 0; sub < 2; ++sub) {
                const int kb = 64 * (kt0 + t) + 32 * sub;
                if (kb <= twmax && kb + 31 >= twmin - 511) {
                    f32x16 acc;
                    const LAS float* tb = tw + hd * WTS + (WTOP - (tq - kb - 4 * hh));
#pragma unroll
                    for (int r = 0; r < 16; ++r) acc[r] = tb[(r & 3) + 8 * (r >> 2)];
                    qk_sub<0, 4>(acc, buf, sub, qf, lane);
#pragma unroll
                    for (int r = 0; r < 1; ++r) den += exp_sum16(acc);
                    bf16x8 pa0, pa1; pack_p(acc, pa0, pa1);
                    pv_sub(o, buf, sub, pa0, pa1, lane);
                }
            }
            if (t + 1 < nkt) stage_write(lds + L_KV + ((t + 1) & 1) * KVB, sr, srow, sch);
            __syncthreads();
        }
    }
    {
        const float dt = den + __shfl_xor(den, 32);
        if (hh == 0) ws_[128 + n] = __builtin_amdgcn_rcpf(dt);
        asm volatile("s_waitcnt lgkmcnt(0)" ::: "memory");
#pragma unroll
        for (int r = 0; r < 16; ++r) { const int nn = crow(r, hh); const float gi = ws_[64 + nn] * ws_[128 + nn]; outv[0][r] = o[0][r] * gi; outv[1][r] = o[1][r] * gi; }
    }
    if (opq(threadIdx.x) == 128) {
        unsigned sp = 0;
        while (__hip_atomic_load(P.cdone, __ATOMIC_RELAXED, __HIP_MEMORY_SCOPE_AGENT) < 64u) { __builtin_amdgcn_s_sleep(2); if (++sp > (1u << 24)) break; }
        __builtin_amdgcn_fence(__ATOMIC_ACQUIRE, "agent"); asm volatile("s_waitcnt vmcnt(0)" ::: "memory");
    }
    __syncthreads();
    const int tlast = 64 * P.qb + 63;
    const int ntc = tlast >= 31 ? (((tlast - 31) >> 4) >> 6) + 1 : 0;
    float invden = 0.f; den = 0.f;
    o[0] = (f32x16){}; o[1] = (f32x16){};
    for (int pass = 0; pass < 2; ++pass) {
        if (ntc > 0) {
            __syncthreads();
            stage_load(sr, P.KC + (size_t)srow * 64, P.VC + (size_t)srow * 64, true, sch);
            stage_write(lds + L_KV, sr, srow, sch);
            __syncthreads();
            for (int t = 0; t < ntc; ++t) {
                LAS unsigned char* buf = lds + L_KV + (t & 1) * KVB;
                if (t + 1 < ntc) stage_load(sr, P.KC + (size_t)(64 * (t + 1) + srow) * 64, P.VC + (size_t)(64 * (t + 1) + srow) * 64, true, sch);
#pragma unroll
                for (int sub = 0; sub < 2; ++sub) {
                    const int cb = 64 * t + 32 * sub;
                    if (16 * cb + 31 <= twmax) {
                        f32x16 acc;
                        const int dmin = twmin - 16 * (cb + 31) - 31;
                        if (dmin >= 1513) acc = splat16(cfar);
                        else {
                            const LAS float* tb = tg + hd * GTS + (GTOP - (tq - 31 - 16 * cb - 64 * hh));
#pragma unroll
                            for (int r = 0; r < 16; ++r) acc[r] = tb[16 * ((r & 3) + 8 * (r >> 2))];
                        }
                        qk_sub<0, 4>(acc, buf, sub, qf, lane);
#pragma unroll
                        for (int r = 0; r < 16; ++r) acc[r] = __builtin_amdgcn_exp2f(acc[r]);
                        if (pass == 0) {
#pragma unroll
                            for (int r = 0; r < 16; ++r) { den += acc[r]; asm volatile("" : "+v"(den)); }
                        } else {
#pragma unroll
                            for (int r = 0; r < 16; ++r) acc[r] *= invden;
#pragma unroll
                            for (int g = 0; g < 4; ++g) {
                                float G = (acc[4 * g] + acc[4 * g + 1]) + (acc[4 * g + 2] + acc[4 * g + 3]), C = acc[4 * g + 3];
                                G += __shfl_xor(G, 1); G += __shfl_xor(G, 2); C += __shfl_xor(C, 1); C += __shfl_xor(C, 2);
                                if (hd == 0) {
                                    const int j = (cb >> 2) + 2 * g + hh;
                                    __hip_atomic_fetch_add(impw + q8 * 128 + j, G, __ATOMIC_RELAXED, __HIP_MEMORY_SCOPE_WORKGROUP);
                                    if (j + 1 < 128) __hip_atomic_fetch_add(impw + q8 * 128 + j + 1, C, __ATOMIC_RELAXED, __HIP_MEMORY_SCOPE_WORKGROUP);
                                }
                            }
                            bf16x8 pa0, pa1; pack_p(acc, pa0, pa1);
                            pv_sub(o, buf, sub, pa0, pa1, lane);
                        }
                    }
                }
                if (t + 1 < ntc) stage_write(lds + L_KV + ((t + 1) & 1) * KVB, sr, srow, sch);
                __syncthreads();
            }
        }
        if (pass == 0) { const float dt = den + __shfl_xor(den, 32); invden = dt > 0.f ? 1.f / dt : 0.f; }
    }
    asm volatile("s_waitcnt lgkmcnt(0)" ::: "memory");
#pragma unroll
    for (int r = 0; r < 16; ++r) { const float g0 = ws_[crow(r, hh)]; outv[0][r] += o[0][r] * g0; outv[1][r] += o[1][r] * g0; }
    {
        float* sp = P.scr + tid;
#pragma unroll
        for (int r = 0; r < 16; ++r) { sp[r * 512] = outv[0][r]; sp[(16 + r) * 512] = outv[1][r]; }
    }
    {
        const int qsel = lane >> 3, sb = lane & 7;
        unsigned key[16];
#pragma unroll
        for (int i4 = 0; i4 < 4; ++i4) {
            const f32x4 v = *(const LAS f32x4*)(impw + qsel * 128 + sb * 16 + 4 * i4);
#pragma unroll
            for (int e = 0; e < 4; ++e) {
                const int j = sb * 16 + 4 * i4 + e;
                const bool forced = (j == 0) | (j == P.qb) | (j == P.qb - 1);
                key[4 * i4 + e] = forced ? 0xFFFFFFFFu : (j <= P.qb ? __float_as_uint(v[e]) + 1u : 0u);
            }
        }
        unsigned T = 0u;
        for (int bit = 31; bit >= 0; --bit) {
            const unsigned cand = T | (1u << bit);
            int cnt = 0;
#pragma unroll
            for (int i = 0; i < 16; ++i) cnt += key[i] >= cand ? 1 : 0;
            cnt += __shfl_xor(cnt, 1); cnt += __shfl_xor(cnt, 2); cnt += __shfl_xor(cnt, 4);
            if (cnt >= 16) T = cand;
        }
        int cgt = 0, ceq = 0;
#pragma unroll
        for (int i = 0; i < 16; ++i) { cgt += key[i] > T ? 1 : 0; ceq += key[i] == T ? 1 : 0; }
        int cg = cgt; cg += __shfl_xor(cg, 1); cg += __shfl_xor(cg, 2); cg += __shfl_xor(cg, 4);
        int pre = 0;
#pragma unroll
        for (int k = 0; k < 8; ++k) { const int v = __shfl(ceq, (lane & ~7) + k); if (k < sb) pre += v; }
        int need = 16 - cg - pre;
        unsigned bits = 0u;
#pragma unroll
        for (int i = 0; i < 16; ++i) {
            const int j = sb * 16 + i;
            bool s_ = key[i] > T;
            if (key[i] == T) { if (need > 0) { s_ = true; } --need; }
            if (s_ && j <= P.qb) bits |= 1u << i;
        }
        const unsigned other = __shfl_xor(bits, 1);
        const unsigned word = (sb & 1) ? ((bits << 16) | other) : (bits | (other << 16));
        if ((sb & 1) == 0) { selw[qsel * 4 + (sb >> 1)] = word; __hip_atomic_fetch_or(uni + (sb >> 1), word, __ATOMIC_RELAXED, __HIP_MEMORY_SCOPE_WORKGROUP); }
    }
    __syncthreads();
    unsigned lm0 = selw[q8 * 4 + 0], lm1 = selw[q8 * 4 + 1], lm2 = selw[q8 * 4 + 2], lm3 = selw[q8 * 4 + 3];
    unsigned wm0 = 0, wm1 = 0, wm2 = 0, wm3 = 0;
#pragma unroll
    for (int k = 0; k < 8; ++k) { wm0 |= selw[k * 4 + 0]; wm1 |= selw[k * 4 + 1]; wm2 |= selw[k * 4 + 2]; wm3 |= selw[k * 4 + 3]; }
    wm0 = __builtin_amdgcn_readfirstlane(wm0); wm1 = __builtin_amdgcn_readfirstlane(wm1); wm2 = __builtin_amdgcn_readfirstlane(wm2); wm3 = __builtin_amdgcn_readfirstlane(wm3);
    const unsigned um0 = __builtin_amdgcn_readfirstlane(uni[0]), um1 = __builtin_amdgcn_readfirstlane(uni[1]), um2 = __builtin_amdgcn_readfirstlane(uni[2]), um3 = __builtin_amdgcn_readfirstlane(uni[3]);
#define NSA_WORD(a0, a1, a2, a3, j) ((j) < 32 ? (a0) : ((j) < 64 ? (a1) : ((j) < 96 ? (a2) : (a3))))
#define NSA_NEXT(j, res) do { int _j = (j); res = 128; while (_j < 128) { const unsigned _w = NSA_WORD(um0, um1, um2, um3, _j) >> (_j & 31); if (_w) { res = _j + __builtin_ctz(_w); break; } _j = (_j | 31) + 1; } } while (0)
    o[0] = (f32x16){}; o[1] = (f32x16){}; den = 0.f;
#define NSA_SLC_COMPUTE(JJ, BUF) do { \
        if ((NSA_WORD(wm0, wm1, wm2, wm3, (JJ)) >> ((JJ) & 31)) & 1u) { \
            const bool lsel = (NSA_WORD(lm0, lm1, lm2, lm3, (JJ)) >> ((JJ) & 31)) & 1u; \
            _Pragma("unroll") for (int sub = 0; sub < 2; ++sub) { \
                const int kb = 64 * (JJ) + 32 * sub; \
                if (kb <= twmax) { \
                    f32x16 acc; \
                    if (twmin - kb - 31 >= 1513) acc = splat16(lsel ? cfar : -1e30f); \
                    else { const LAS float* tb = lsel ? tg + hd * GTS + (GTOP - (tq - kb - 4 * hh)) : dead; \
                        _Pragma("unroll") for (int r = 0; r < 16; ++r) acc[r] = tb[(r & 3) + 8 * (r >> 2)]; } \
                    qk_sub<0, 4>(acc, (BUF), sub, qf, lane); \
                    den += exp_sum16(acc); \
                    bf16x8 pa0, pa1; pack_p(acc, pa0, pa1); \
                    pv_sub(o, (BUF), sub, pa0, pa1, lane); \
                } } } } while (0)
#define NSA_SLC_LOAD(JJ, SR) do { const bf16_t* rp_ = P.Hb + (size_t)(64 * (JJ) + srow) * HP; stage_load(SR, rp_ + C_KS, rp_ + C_VS, true, sch); } while (0)
    {
        LAS unsigned char* pb0 = lds + L_KV; LAS unsigned char* pb1 = lds + L_IMP;
        StageRegs a0, a1, b0, b1;
#define NSA_PAIR(prev, ra, rb) do { ra = 128; if ((prev) < 128) { NSA_NEXT((prev) + 1, ra); } rb = 128; if (ra < 128) { NSA_NEXT(ra + 1, rb); } } while (0)
#define NSA_SLC_LOADC(JJ, SR) do { const int jc_ = (JJ) < 128 ? (JJ) : 0; NSA_SLC_LOAD(jc_, SR); } while (0)
        int ca, cb_, n1a, n1b, n2a, n2b, n3a, n3b;
        NSA_NEXT(0, ca); cb_ = 128; if (ca < 128) { NSA_NEXT(ca + 1, cb_); }
        NSA_PAIR(cb_, n1a, n1b); NSA_PAIR(n1b, n2a, n2b);
        NSA_SLC_LOADC(ca, b0); NSA_SLC_LOADC(cb_, b1);
        NSA_SLC_LOADC(n1a, a0); NSA_SLC_LOADC(n1b, a1);
        stage_write(pb0, b0, srow, sch); stage_write(pb0 + KVB, b1, srow, sch);
        NSA_SLC_LOADC(n2a, b0); NSA_SLC_LOADC(n2b, b1);
        __syncthreads();
        for (;;) {
            NSA_SLC_COMPUTE(ca, pb0);
            if (cb_ < 128) NSA_SLC_COMPUTE(cb_, pb0 + KVB);
            stage_write(pb1, a0, srow, sch); stage_write(pb1 + KVB, a1, srow, sch);
            NSA_PAIR(n2b, n3a, n3b);
            NSA_SLC_LOADC(n3a, a0); NSA_SLC_LOADC(n3b, a1);
            __syncthreads();
            if (n1a >= 128) break;
            NSA_SLC_COMPUTE(n1a, pb1);
            if (n1b < 128) NSA_SLC_COMPUTE(n1b, pb1 + KVB);
            stage_write(pb0, b0, srow, sch); stage_write(pb0 + KVB, b1, srow, sch);
            int n4a, n4b; NSA_PAIR(n3b, n4a, n4b);
            NSA_SLC_LOADC(n4a, b0); NSA_SLC_LOADC(n4b, b1);
            __syncthreads();
            if (n2a >= 128) break;
            ca = n2a; cb_ = n2b; n1a = n3a; n1b = n3b; n2a = n4a; n2b = n4b;
        }
#undef NSA_PAIR
#undef NSA_SLC_LOADC
    }
#undef NSA_SLC_COMPUTE
#undef NSA_SLC_LOAD
    {
        const float dt = den + __shfl_xor(den, 32);
        if (hh == 0) ws_[96 + n] = 1.f / dt;
        asm volatile("s_waitcnt lgkmcnt(0)" ::: "memory");
        const float* sp = P.scr + tid;
#pragma unroll
        for (int r = 0; r < 16; ++r) { const float gi = ws_[32 + crow(r, hh)] * ws_[96 + crow(r, hh)]; outv[0][r] = sp[r * 512] + o[0][r] * gi; outv[1][r] = sp[(16 + r) * 512] + o[1][r] * gi; }
    }
    {
#pragma unroll
        for (int r = 0; r < 16; ++r) {
            const int nn = crow(r, hh);
            const size_t trow = (size_t)(64 * P.qb + 8 * w + (nn >> 2));
            const int ycol = 768 + 64 * (nn & 3);
            const bf16_t* sp = P.Hb + trow * HP + C_SILU + ycol;
            bf16_t* yp = P.Y + (P.brow + trow) * DM + ycol;
            yp[n] = f2bf(outv[0][r] * bf2f(sp[n]));
            yp[32 + n] = f2bf(outv[1][r] * bf2f(sp[32 + n]));
        }
    }
    __syncthreads();
#undef NSA_WORD
#undef NSA_NEXT
}
}

#define XB_TMO      128
#define XB_XCNT(j)  (256  + 64 * (j))
#define XB_XSUB(j)  (1280 + 64 * (j))
#define XB_XGEN(j)  (2304 + 64 * (j))
#define XB_TOP      3328
#define XB_TOPGEN   3392
#define XCD_BAR_WORDS 3456
#define XB_SPIN_CAP (1u << 22)
__device__ __forceinline__ unsigned xb_ld(unsigned* p)              { return __hip_atomic_load(p, __ATOMIC_RELAXED, __HIP_MEMORY_SCOPE_AGENT); }
__device__ __forceinline__ unsigned xb_add(unsigned* p, unsigned v) { return __hip_atomic_fetch_add(p, v, __ATOMIC_RELAXED, __HIP_MEMORY_SCOPE_AGENT); }
__device__ __forceinline__ unsigned xb_xcc_id() { return (unsigned)__builtin_amdgcn_s_getreg((3 << 11) | 20) & 0xFu; }
#define XB_SPIN(cond, bar) do { unsigned _sp = 0; while (cond) { __builtin_amdgcn_s_sleep(1); \
    if ((++_sp & 255u) == 0u) { if (xb_ld(&(bar)[XB_TMO])) break; if (_sp > XB_SPIN_CAP) { atomicAdd(&(bar)[XB_TMO], 1u); break; } } } } while (0)
struct XcdBarrier { unsigned* bar; unsigned x; volatile LAS unsigned* st; };
__device__ __forceinline__ XcdBarrier xcd_barrier_post(unsigned* bar, volatile LAS unsigned* st) {
    XcdBarrier b; b.bar = bar; b.x = xb_xcc_id(); b.st = st;
    if (threadIdx.x == 0) (void)xb_add(&bar[XB_XCNT(b.x)], 1u);
    return b;
}
__device__ __forceinline__ void xcd_barrier_complete(unsigned* bar, unsigned x, unsigned& nloc, unsigned& nx) {
    const unsigned G = gridDim.x * gridDim.y * gridDim.z;
    unsigned sum, cnt, mine, sp = 0u;
    for (;;) {
        sum = 0u; cnt = 0u; mine = 0u;
#pragma unroll
        for (unsigned j = 0; j < 16; ++j) { const unsigned c = xb_ld(&bar[XB_XCNT(j)]); sum += c; cnt += (c > 0u) ? 1u : 0u; mine = (j == x) ? c : mine; }
        if (sum == G) break;
        __builtin_amdgcn_s_sleep(1);
        if ((++sp & 255u) == 0u) { if (xb_ld(&bar[XB_TMO])) break; if (sp > XB_SPIN_CAP) { atomicAdd(&bar[XB_TMO], 1u); break; } }
    }
    nloc = mine > 0u ? mine : 1u; nx = cnt > 0u ? cnt : 1u;
}
__device__ __forceinline__ void xcd_barrier(const XcdBarrier& b) {
    asm volatile("s_waitcnt vmcnt(0)" ::: "memory");
    __syncthreads();
    if (threadIdx.x == 0) {
        unsigned* bar = b.bar;
        __builtin_amdgcn_s_waitcnt(0);
        unsigned nloc = b.st[0], nx = b.st[1];
        if (nloc == 0u) { xcd_barrier_complete(bar, b.x, nloc, nx); b.st[0] = nloc; b.st[1] = nx; }
        const unsigned old = xb_add(&bar[XB_XSUB(b.x)], 1u);
        const unsigned gen = old / nloc;
        if (old + 1u == (gen + 1u) * nloc) {
            __builtin_amdgcn_fence(__ATOMIC_RELEASE, "agent");
            asm volatile("s_waitcnt vmcnt(0)" ::: "memory");
            const unsigned og = xb_add(&bar[XB_TOP], 1u);
            const unsigned tg = og / nx;
            if (og + 1u == (tg + 1u) * nx) xb_add(&bar[XB_TOPGEN], 1u);
            else XB_SPIN(xb_ld(&bar[XB_TOPGEN]) == tg, bar);
            __builtin_amdgcn_fence(__ATOMIC_ACQUIRE, "agent");
            xb_add(&bar[XB_XGEN(b.x)], 1u);
            asm volatile("s_waitcnt vmcnt(0)" ::: "memory");
        } else {
            XB_SPIN(xb_ld(&bar[XB_XGEN(b.x)]) == gen, bar);
            __builtin_amdgcn_fence(__ATOMIC_ACQUIRE, "agent");
            asm volatile("s_waitcnt vmcnt(0)" ::: "memory");
        }
    }
    __syncthreads();
}

constexpr int NT = 512, LDS_BYTES = 147456, MISC_OFF = 131072 + 320;
#ifndef R_C
#define R_C 1
#endif
#ifndef R_D
#define R_D 1
#endif
#ifndef R_AB
#define R_AB 1
#endif
#ifndef R_G1
#define R_G1 1
#endif
constexpr size_t MiB = 1u << 20;
constexpr size_t WS_CTL = 0, CTL_ZERO_BYTES = 65536;
constexpr size_t WS_X1B = 158 * MiB;
constexpr size_t OUT_OA = 0, OUT_NSCR = 24 * MiB;
constexpr size_t WS_H = 2 * MiB, WS_XN = 124 * MiB, WS_T0 = 158 * MiB, WS_IMP = 208 * MiB, WS_SEL = 217 * MiB, WS_HID = 218 * MiB, WS_KC = 221 * MiB, WS_VC = 222 * MiB, WS_WIN = 224 * MiB, WS_WOUT = 240 * MiB, WS_MX = 1 * MiB, WS_DA = 245 * MiB, WS_CW1 = 246 * MiB, WS_CW2 = 250 * MiB, WS_RSS = 251 * MiB;

struct Args { const float* in[15]; float* out; unsigned char* ws; };

__global__ void __launch_bounds__(NT, 2) mega_fwd(Args args) {
    extern __shared__ __attribute__((aligned(16))) unsigned char lds[];
    const int tid = threadIdx.x, lane = tid & 63, wid = tid >> 6;
    const int G = gridDim.x, bid = blockIdx.x;
    volatile LAS unsigned* MISC = (volatile LAS unsigned*)((LAS unsigned char*)lds + MISC_OFF);
    if (tid < 32) MISC[tid] = 0u;
    __syncthreads();
    unsigned char* ws = args.ws;
    XcdBarrier bar = xcd_barrier_post((unsigned*)(ws + WS_CTL) + 4096, MISC + 8);
    const float* x = args.in[0]; const float* tab = args.in[1]; const float* norm_w = args.in[2];
    const float* w_in = args.in[3]; const float* w_out = args.in[4]; const float* qk_gain = args.in[5];
    const float* qk_gain_diff = args.in[6]; const float* sinks = args.in[7]; const float* diff_lambda = args.in[8];
    const float* diff_subln = args.in[9]; const float* cmp_pos = args.in[10]; const float* cmp_w1 = args.in[11];
    const float* cmp_b1 = args.in[12]; const float* cmp_w2 = args.in[13]; const float* cmp_b2 = args.in[14];
    float* out = args.out;
    bf16_t* H = (bf16_t*)(ws + WS_H);
    bf16_t* XN = (bf16_t*)(ws + WS_XN); bf16_t* Y = XN;
    float* T0 = (float*)(ws + WS_T0);
    float* OC = T0; float* OS_ = T0 + (size_t)MROWS * 256; float* OW = T0 + (size_t)MROWS * 512; float* CT = T0;
    float* IMP = (float*)(ws + WS_IMP); unsigned* SEL = (unsigned*)(ws + WS_SEL); float* HID = (float*)(ws + WS_HID);
    float* KC = (float*)(ws + WS_KC); float* VC = (float*)(ws + WS_VC);
    const int GT = G * NT, GW = G * 8;
    bf16_t* WinT = (bf16_t*)(ws + WS_WIN); bf16_t* WoutT = (bf16_t*)(ws + WS_WOUT);
#define GRID_BAR() do { XcdBarrier b2_ = bar; asm volatile("" : "+s"(b2_.x)); xcd_barrier(b2_); } while (0)
    {
        LAS float* scr = (LAS float*)((LAS unsigned char*)lds + wid * 16384);
        const int gw0 = bid * 8 + wid;
        constexpr int I_IN = 16 * 120, I_OUT = 16 * 32, I_C1 = 32 * 8, I_C2 = 4 * 2, I_L = I_IN + I_OUT + 2 * I_C1 + 2 * I_C2, NITEMS = 2 * I_L;
        bf16_t* CW1T = (bf16_t*)(ws + WS_CW1); bf16_t* CW2T = (bf16_t*)(ws + WS_CW2);
        for (int it = gw0; it < NITEMS; it += GW) {
            const int l = it / I_L; int r = it % I_L;
            if (r < I_IN) { p0_transpose_item<0>(w_in + (size_t)l * DM * PW, WinT + (size_t)l * HP * DM, scr, r, lane, 1024, 1024, norm_w + l * DM); continue; } r -= I_IN;
            if (r < I_OUT) { p0_transpose_item<1>(w_out + (size_t)l * DM * DM, WoutT + (size_t)l * DM * DM, scr, r, lane); continue; } r -= I_OUT;
            if (r < 2 * I_C1) { const int kv = r / I_C1; p0_transpose_item<2>(cmp_w1 + (size_t)(l * 2 + kv) * 2048 * 256, CW1T + (size_t)(l * 2 + kv) * 256 * 2048, scr, r % I_C1, lane, 2048, 256); continue; } r -= 2 * I_C1;
            { const int kv = r / I_C2; p0_transpose_item<1>(cmp_w2 + (size_t)(l * 2 + kv) * 256 * 64, CW2T + (size_t)(l * 2 + kv) * 64 * 256, scr, r % I_C2, lane, 256, 64); }
        }
        if (bid == 1 && tid < 256) { bf16_t* KCb = (bf16_t*)(ws + WS_KC); KCb[(size_t)(tid >> 6) * 512 * 64 + 511 * 64 + (tid & 63)] = 0; }
        for (int w = gw0; w < MROWS; w += 4 * GW) k_rmsnorm<4>(w, GW, lane, x, XN);
        for (int v = bid * NT + tid; v < MROWS; v += GT) ((unsigned long long*)(ws + WS_RSS))[v] = 0ull;
        if (bid < 4) {
            float* MX = (float*)(ws + WS_MX);
            const int idx = bid * 8 + wid, l = idx >> 4, gh = idx & 15;
            float red[11];
#pragma unroll
            for (int i = 0; i < 8; ++i) red[i] = fabsf(qk_gain[l * 512 + i * 64 + lane]);
            red[8] = lane < 32 ? fabsf(qk_gain_diff[l * 64 + lane]) : 0.f; red[9] = lane < 32 ? fabsf(qk_gain_diff[l * 64 + 32 + lane]) : 0.f;
            red[10] = lane < 32 ? fabsf(tab[lane * 16 + gh]) : 0.f;
            float s1 = lane < 32 ? diff_lambda[l * 128 + lane] * diff_lambda[l * 128 + 32 + lane] : 0.f;
            float s2 = lane < 32 ? diff_lambda[l * 128 + 64 + lane] * diff_lambda[l * 128 + 96 + lane] : 0.f;
            const float snk = sinks[l * 4 + (gh & 3)];
#pragma unroll
            for (int o = 1; o < 64; o <<= 1) {
#pragma unroll
                for (int i = 0; i < 11; ++i) red[i] = fmaxf(red[i], __shfl_xor(red[i], o));
                s1 += __shfl_xor(s1, o); s2 += __shfl_xor(s2, o);
            }
            const int grp = gh >> 2; const float mb = red[10]; float Mv;
            if (grp == 0) Mv = 8.f * red[0] * red[1] + mb;
            else if (grp == 1) Mv = fmaxf(8.f * red[2] * red[3] + mb, snk);
            else if (grp == 2) Mv = 5.656854249f * red[8] * red[9] + mb;
            else Mv = 8.f * red[4] * fmaxf(red[5], fmaxf(red[6], red[7])) + mb;
            if (lane == 0) MX[l * 16 + gh] = Mv;
            if (gh == 0 && lane == 0) { const float lambda_init = 0.8f - 0.6f * expf(-0.3f * (float)l); MX[32 + l] = expf(s1) - expf(s2) + lambda_init; MX[34 + l] = lambda_init; }
        }
    }
    GRID_BAR();
#pragma unroll 1
    for (int l = 0; l < 2; ++l) {
        bf16_t* X1B = (bf16_t*)(ws + WS_X1B);
        { pg8::Gemm g{l == 0 ? XN : X1B, WinT + (size_t)l * HP * DM, MROWS, HP, DM}; pg8::StaticOrder So; So.init(MROWS, HP, G, bid);
          pg8::EpiProj E{H, qk_gain + l * 512, qk_gain_diff + l * 64, l == 0 ? nullptr : (const float*)(ws + WS_RSS)};
          for (int rep = 0; rep < R_G1; ++rep) pg8::gemm_phase<pg8::EpiProj, pg8::StaticOrder, true, true>((LAS unsigned char*)lds, g, So, E); }
        GRID_BAR();
        {
            const float* MX = (const float*)(ws + WS_MX);
            bf16_t* OA = (bf16_t*)((unsigned char*)out + OUT_OA); float* DA = (float*)(ws + WS_DA);
            bf16_t* KCb = (bf16_t*)(ws + WS_KC);
            const bf16_t* CW1T = (const bf16_t*)(ws + WS_CW1); const bf16_t* CW2T = (const bf16_t*)(ws + WS_CW2);
            LAS unsigned* qw = (LAS unsigned*)((LAS unsigned char*)lds + att::L_Q);
            unsigned* qctr = (unsigned*)(ws + WS_CTL) + 8192 + 128 * l;
            unsigned* cdone = qctr + 64;
            constexpr int B0 = 64, B1 = B0 + 160 * R_C, B2 = B1 + 256 * R_D, B3 = B2 + 96 * R_C, B4 = B3 + 768 * R_AB, NUV = B4 + 256 * R_AB;
            for (;;) {
                if (opq(threadIdx.x) == 0) *qw = atomicAdd(qctr, 1u);
                __syncthreads();
                const int uv = (int)*qw;
                __syncthreads();
                if (uv >= NUV) break;
                int u;
                if (uv < B0) u = uv; else if (uv < B1) u = 64 + (uv - B0) / R_C; else if (uv < B2) u = 224 + (uv - B1) / R_D; else if (uv < B3) u = 480 + (uv - B2) / R_C;
                else if (uv < B4) u = 576 + (uv - B3) / R_AB; else u = 1344 + (uv - B4) / R_AB;
                if (u < 64) {
                    const int kv = u >> 5, b = (u >> 4) & 1, rt = u & 15;
                    att::CmpArgs P; P.Hb = H + (size_t)b * S * HP; P.col = kv == 0 ? C_KC : C_VC; P.rt = rt;
                    P.pos = cmp_pos + (size_t)(l * 2 + kv) * 2048; P.W1T = CW1T + (size_t)(l * 2 + kv) * 256 * 2048; P.b1 = cmp_b1 + (l * 2 + kv) * 256;
                    P.W2T = CW2T + (size_t)(l * 2 + kv) * 64 * 256; P.b2 = cmp_b2 + (l * 2 + kv) * 64; P.gain = kv == 0 ? qk_gain + l * 512 + 5 * 64 : nullptr;
                    P.OUT = KCb + (size_t)(kv * NB + b) * 512 * 64;
                    att::cmp_unit((LAS unsigned char*)lds, P);
                    asm volatile("s_waitcnt vmcnt(0)" ::: "memory");
                    __syncthreads();
                    if (opq(threadIdx.x) == 64) { __builtin_amdgcn_fence(__ATOMIC_RELEASE, "agent"); asm volatile("s_waitcnt vmcnt(0)" ::: "memory");
                        __hip_atomic_fetch_add(cdone, 1u, __ATOMIC_RELAXED, __HIP_MEMORY_SCOPE_AGENT); }
                    __syncthreads();
                } else if ((u >= 64 && u < 224) || (u >= 480 && u < 576)) {
                    int qb, bh;
                    if (u < 224) { qb = 31 - ((u - 64) >> 3); bh = (u - 64) & 7; } else { qb = 11 - ((u - 480) >> 3); bh = (u - 480) & 7; }
                    const int b = bh >> 2, hd = bh & 3;
                    att::DiffArgs P; P.Hb = H + (size_t)b * S * HP; P.hd = hd; P.qb = qb; P.brow = (size_t)b * S;
                    P.bias = tab + 8 + hd; P.M = MX[l * 16 + 8 + hd]; P.lam = MX[32 + l]; P.lambda_init = MX[34 + l]; P.subln = diff_subln + l * 64; P.Y = Y;
                    att::diff_unit((LAS unsigned char*)lds, P);
                } else if (u < 480) {
                    const int idx = u - 224, qb64 = 127 - (idx >> 1), b = idx & 1;
                    att::NsaArgs P; P.Hb = H + (size_t)b * S * HP; P.brow = (size_t)b * S; P.qb = qb64;
                    P.KC = KCb + (size_t)(0 * NB + b) * 512 * 64; P.VC = KCb + (size_t)(1 * NB + b) * 512 * 64;
                    P.bias = tab + 12; P.Mv = MX + l * 16 + 12; P.Y = Y; P.cdone = cdone; P.scr = (float*)((unsigned char*)out + OUT_NSCR) + (size_t)bid * 16384;
                    att::nsa_unit((LAS unsigned char*)lds, P);
                } else if (u < 1344) {
                    const int v = u - 576, cfg = v >> 8, b = (v >> 7) & 1, hd = (v >> 5) & 3, ti = v & 31;
                    const int rate = cfg == 0 ? 1 : (cfg == 1 ? 4 : 16), tpc = 32 / rate;
                    att::BandArgs P; P.Hb = H + (size_t)b * S * HP; P.cq = C_AQ + 64 * hd; P.ck = C_AK + 64 * hd; P.cv = C_AV + 64 * hd;
                    P.rate = rate; P.cls = ti / tpc; P.f0 = (ti % tpc) * 256; P.maxd = 128; P.bias = tab + hd; P.M = MX[l * 16 + hd]; P.sinkterm = 0.f;
                    P.OA = OA + (size_t)cfg * MROWS * 256; P.DA = DA + (size_t)cfg * MROWS * 4; P.Y = nullptr; P.ycol = 0; P.hd = hd; P.brow = (size_t)b * S;
                    att::banded_unit<0>((LAS unsigned char*)lds, P);
                } else {
                    const int v = u - 1344, b = (v >> 7) & 1, hd = (v >> 5) & 3, ti = v & 31;
                    att::BandArgs P; P.Hb = H + (size_t)b * S * HP; P.cq = C_BQ + 64 * hd; P.ck = C_BK + 64 * (hd >> 1); P.cv = C_BV + 64 * (hd >> 1);
                    P.rate = 1; P.cls = 0; P.f0 = ti * 256; P.maxd = 127; P.bias = tab + 4 + hd; P.M = MX[l * 16 + 4 + hd];
                    P.sinkterm = __expf(sinks[l * 4 + hd] - P.M);
                    P.OA = nullptr; P.DA = nullptr; P.Y = Y; P.ycol = 256 + 64 * hd; P.hd = hd; P.brow = (size_t)b * S;
                    att::banded_unit<1>((LAS unsigned char*)lds, P);
                }
            }
        }
        GRID_BAR();
        {
            const bf16_t* OA = (const bf16_t*)((unsigned char*)out + OUT_OA); const float* DA = (const float*)(ws + WS_DA);
            for (int v = (bid * NT + opq(threadIdx.x)); v < MROWS * 32; v += GT) {
                const int row = v >> 5, hd = (v >> 3) & 3, c8 = v & 7;
                float acc8[8] = {0.f, 0.f, 0.f, 0.f, 0.f, 0.f, 0.f, 0.f}; float dsum = 0.f;
#pragma unroll
                for (int cfg = 0; cfg < 3; ++cfg) {
                    const float dn = DA[((size_t)cfg * MROWS + row) * 4 + hd]; dsum += dn;
                    const uint4 r4 = *(const uint4*)(OA + ((size_t)cfg * MROWS + row) * 256 + hd * 64 + c8 * 8);
                    acc8[0] += dn * __uint_as_float(r4.x << 16); acc8[1] += dn * __uint_as_float(r4.x & 0xffff0000u);
                    acc8[2] += dn * __uint_as_float(r4.y << 16); acc8[3] += dn * __uint_as_float(r4.y & 0xffff0000u);
                    acc8[4] += dn * __uint_as_float(r4.z << 16); acc8[5] += dn * __uint_as_float(r4.z & 0xffff0000u);
                    acc8[6] += dn * __uint_as_float(r4.w << 16); acc8[7] += dn * __uint_as_float(r4.w & 0xffff0000u);
                }
                const float inv = 1.f / dsum;
                const uint4 s4 = *(const uint4*)(H + (size_t)row * HP + C_SILU + hd * 64 + c8 * 8);
                uint4 o4;
                o4.x = (unsigned)f2bf(acc8[0] * inv * __uint_as_float(s4.x << 16)) | ((unsigned)f2bf(acc8[1] * inv * __uint_as_float(s4.x & 0xffff0000u)) << 16);
                o4.y = (unsigned)f2bf(acc8[2] * inv * __uint_as_float(s4.y << 16)) | ((unsigned)f2bf(acc8[3] * inv * __uint_as_float(s4.y & 0xffff0000u)) << 16);
                o4.z = (unsigned)f2bf(acc8[4] * inv * __uint_as_float(s4.z << 16)) | ((unsigned)f2bf(acc8[5] * inv * __uint_as_float(s4.z & 0xffff0000u)) << 16);
                o4.w = (unsigned)f2bf(acc8[6] * inv * __uint_as_float(s4.w << 16)) | ((unsigned)f2bf(acc8[7] * inv * __uint_as_float(s4.w & 0xffff0000u)) << 16);
                *(uint4*)(Y + (size_t)row * DM + hd * 64 + c8 * 8) = o4;
            }
        }
        GRID_BAR();
        { pg8::Gemm g{Y, WoutT + (size_t)l * DM * DM, MROWS, DM, DM}; pg8::StaticOrder So; So.init(MROWS, DM, G, bid);
          pg8::EpiOut E{l == 0 ? x : nullptr, X1B, out, (LAS float*)((LAS unsigned char*)lds + 132096), X1B, (float*)(ws + WS_RSS)};
          pg8::gemm_phase<pg8::EpiOut, pg8::StaticOrder, true, true>((LAS unsigned char*)lds, g, So, E); }
        if (l == 0) GRID_BAR();
    }
}

extern "C" void kernel_launch(void* const* d_in, const int* in_sizes, int n_in, void* d_out, int out_size, void* d_ws, size_t ws_size, hipStream_t stream) {
    static int grid = 0;
    if (grid == 0) {
        int dev = 0, cus = 0;
        (void)hipGetDevice(&dev);
        (void)hipDeviceGetAttribute(&cus, hipDeviceAttributeMultiprocessorCount, dev);
        (void)hipFuncSetAttribute((const void*)mega_fwd, hipFuncAttributeMaxDynamicSharedMemorySize, LDS_BYTES);
        grid = cus > 0 ? cus : 256;
    }
    (void)hipMemsetAsync((char*)d_ws + WS_CTL, 0, CTL_ZERO_BYTES, stream);
    Args a{};
    for (int i = 0; i < 15; ++i) a.in[i] = (const float*)d_in[i];
    a.out = (float*)d_out; a.ws = (unsigned char*)d_ws;
    hipLaunchKernelGGL(mega_fwd, dim3(grid), dim3(NT), LDS_BYTES, stream, a);
}
```

```cpp
#include <hip/hip_runtime.h>
#include <stdint.h>
#include <math.h>

typedef unsigned short bf16_t;
__device__ __forceinline__ float bf2f(bf16_t v) { return __uint_as_float((unsigned)v << 16); }
__device__ __forceinline__ bf16_t f2bf(float f) { unsigned u = __float_as_uint(f); return (bf16_t)((u + 0x7fffu + ((u >> 16) & 1u)) >> 16); }

constexpr int NB = 2, S = 8192, DM = 1024, MROWS = NB * S, PW = 3724, HP = 3840;
constexpr int C_AQ = 0, C_AK = 256, C_AV = 512, C_BQ = 768, C_BK = 1024, C_BV = 1152, C_CQ = 1280, C_CK = 1536, C_CV = 1792,
              C_DQ = 2048, C_KC = 2304, C_VC = 2368, C_KS = 2432, C_VS = 2496, C_KW = 2560, C_VW = 2624, C_GT = 2688, C_SILU = 2816;
constexpr float EPS = 1e-6f;
__device__ __forceinline__ int opq(int v) { asm volatile("" : "+v"(v)); return v; }

__device__ __forceinline__ int t5_bucket(int n) {
    if (n < 16) return n < 0 ? 0 : n;
    int b = 16;
    b += (n >= 22); b += (n >= 30); b += (n >= 40); b += (n >= 54); b += (n >= 73); b += (n >= 99); b += (n >= 134); b += (n >= 182);
    b += (n >= 246); b += (n >= 332); b += (n >= 450); b += (n >= 609); b += (n >= 825); b += (n >= 1117); b += (n >= 1513);
    return b;
}

template <int R>
__device__ __forceinline__ void k_rmsnorm(const int row0, const int stride, const int lane, const float* __restrict__ x, bf16_t* __restrict__ xn) {
    float4 v[R][4]; float ss[R];
#pragma unroll
    for (int r = 0; r < R; ++r) {
        const int row = row0 + r * stride < MROWS ? row0 + r * stride : MROWS - 1;
        const float4* xr = (const float4*)(x + (size_t)row * DM);
#pragma unroll
        for (int j = 0; j < 4; ++j) v[r][j] = xr[lane + 64 * j];
    }
#pragma unroll
    for (int r = 0; r < R; ++r) {
        ss[r] = 0.f;
#pragma unroll
        for (int j = 0; j < 4; ++j) ss[r] += (v[r][j].x * v[r][j].x + v[r][j].y * v[r][j].y) + (v[r][j].z * v[r][j].z + v[r][j].w * v[r][j].w);
    }
#pragma unroll
    for (int o = 1; o < 64; o <<= 1) {
#pragma unroll
        for (int r = 0; r < R; ++r) ss[r] += __shfl_xor(ss[r], o);
    }
#pragma unroll
    for (int r = 0; r < R; ++r) {
        const int row = row0 + r * stride;
        if (row >= MROWS) break;
        const float rstd = rsqrtf(ss[r] * (1.f / DM) + EPS);
#pragma unroll
        for (int j = 0; j < 4; ++j) {
            uint2 o; o.x = (unsigned)f2bf(v[r][j].x * rstd) | ((unsigned)f2bf(v[r][j].y * rstd) << 16);
            o.y = (unsigned)f2bf(v[r][j].z * rstd) | ((unsigned)f2bf(v[r][j].w * rstd) << 16);
            ((uint2*)(xn + (size_t)row * DM))[lane + 64 * j] = o;
        }
    }
}

template <int D>
__device__ __forceinline__ float dot_row(const float* q, const bf16_t* kr) {
    float s = 0.f;
#pragma unroll
    for (int c = 0; c < D / 8; ++c) {
        const uint4 r = *(const uint4*)(kr + 8 * c);
        s += q[8 * c + 0] * __uint_as_float(r.x << 16) + q[8 * c + 1] * __uint_as_float(r.x & 0xffff0000u);
        s += q[8 * c + 2] * __uint_as_float(r.y << 16) + q[8 * c + 3] * __uint_as_float(r.y & 0xffff0000u);
        s += q[8 * c + 4] * __uint_as_float(r.z << 16) + q[8 * c + 5] * __uint_as_float(r.z & 0xffff0000u);
        s += q[8 * c + 6] * __uint_as_float(r.w << 16) + q[8 * c + 7] * __uint_as_float(r.w & 0xffff0000u);
        if (c & 1) asm volatile("" ::: "memory");
    }
    return s;
}
__device__ __forceinline__ void os_step(float s, const bf16_t* vr, float& m, float& den, float* o) {
    const float mn = fmaxf(m, s), sc = __expf(m - mn), p = __expf(s - mn);
    den = den * sc + p; m = mn;
#pragma unroll
    for (int c = 0; c < 8; ++c) {
        const uint4 r = *(const uint4*)(vr + 8 * c);
        o[8 * c + 0] = o[8 * c + 0] * sc + p * __uint_as_float(r.x << 16); o[8 * c + 1] = o[8 * c + 1] * sc + p * __uint_as_float(r.x & 0xffff0000u);
        o[8 * c + 2] = o[8 * c + 2] * sc + p * __uint_as_float(r.y << 16); o[8 * c + 3] = o[8 * c + 3] * sc + p * __uint_as_float(r.y & 0xffff0000u);
        o[8 * c + 4] = o[8 * c + 4] * sc + p * __uint_as_float(r.z << 16); o[8 * c + 5] = o[8 * c + 5] * sc + p * __uint_as_float(r.z & 0xffff0000u);
        o[8 * c + 6] = o[8 * c + 6] * sc + p * __uint_as_float(r.w << 16); o[8 * c + 7] = o[8 * c + 7] * sc + p * __uint_as_float(r.w & 0xffff0000u);
        if (c & 1) asm volatile("" ::: "memory");
    }
}
template <int D>
__device__ __forceinline__ void load_q(float* q, const bf16_t* p) {
#pragma unroll
    for (int c = 0; c < D / 8; ++c) {
        const uint4 r = *(const uint4*)(p + 8 * c);
        q[8 * c + 0] = __uint_as_float(r.x << 16); q[8 * c + 1] = __uint_as_float(r.x & 0xffff0000u);
        q[8 * c + 2] = __uint_as_float(r.y << 16); q[8 * c + 3] = __uint_as_float(r.y & 0xffff0000u);
        q[8 * c + 4] = __uint_as_float(r.z << 16); q[8 * c + 5] = __uint_as_float(r.z & 0xffff0000u);
        q[8 * c + 6] = __uint_as_float(r.w << 16); q[8 * c + 7] = __uint_as_float(r.w & 0xffff0000u);
    }
}

#define LAS __attribute__((address_space(3)))
namespace pg8 {
#define PG8_LAS __attribute__((address_space(3)))
typedef unsigned short bf16_t;
typedef short bf16x8 __attribute__((ext_vector_type(8)));
typedef float f32x4 __attribute__((ext_vector_type(4)));
typedef unsigned u32x4 __attribute__((ext_vector_type(4)));
constexpr int BM = 256, BK = 64, HALF = 128, HTB = HALF * BK * 2  , STAGE_BYTES = 8 * HTB, NXCD = 8, WGM = 8;

__host__ __device__ __forceinline__ int lds_byte(int r, int c) { const int st = (r >> 4) * 2 + (c >> 5), rr = r & 15, cc = c & 31, ob = rr * 64 + cc * 2; return st * 1024 + (ob ^ (((ob >> 9) & 1) << 5)); }
__host__ __device__ __forceinline__ void stage_rc(int b, int& R, int& C) { const int st = b / 1024, sb = b % 1024, swz = sb ^ (((sb >> 9) & 1) << 5); R = (st >> 1) * 16 + swz / 64; C = (st & 1) * 32 + (swz % 64) / 2; }
__host__ __device__ __forceinline__ int perm32(int rho) { const int n = rho >> 4, i = rho & 15; return 8 * (i >> 2) + 4 * n + (i & 3); }

struct Unit { int pm, pn; };
struct Gemm { const bf16_t* A; const bf16_t* Bt; int M, N, K; };

struct StaticOrder {
    int nM, nN, nwg, G, c;
    __host__ __device__ void init(int M, int N, int G_, int c_) { nM = M / BM; nN = N / BM; nwg = nM * nN; G = G_; c = c_; }
    __host__ __device__ bool next(int i, Unit& u) const {
        const long L = (long)i * G + c; if (L >= nwg) return false;
        int wgid = (int)L; { const int q = nwg / NXCD, r = nwg % NXCD, xcd = wgid % NXCD, off = wgid / NXCD; wgid = (xcd < r ? xcd * (q + 1) : r * (q + 1) + (xcd - r) * q) + off; }
        const int nig = WGM * nN, gid = wgid / nig, fm = gid * WGM, gsz = (nM - fm) < WGM ? (nM - fm) : WGM;
        u.pm = fm + ((wgid % nig) % gsz); u.pn = (wgid % nig) / gsz; return true;
    }
    __device__ __forceinline__ void a_ready(const Unit&) const {}
    __device__ __forceinline__ void done(const Unit&) const {}
};

__device__ __forceinline__ unsigned cvt_pk_bf16(float lo, float hi) { unsigned r; asm volatile("v_cvt_pk_bf16_f32 %0, %1, %2" : "=v"(r) : "v"(lo), "v"(hi)); return r; }
template <class Epi, class Sched, bool ALIGN_EPI = false, bool SP2 = false>
__device__ __forceinline__ void gemm_phase(PG8_LAS unsigned char* lds, const Gemm g, const Sched& S, const Epi& E) {
    const int tid = opq(threadIdx.x), wid = __builtin_amdgcn_readfirstlane(tid >> 6), lane = tid & 63, wr = wid >> 2, wc = wid & 3, fr = lane & 15, fq = lane >> 4;
    const int K = g.K, nt = K / BK;
    unsigned voffA[2], voffB[2];
#pragma unroll
    for (int i = 0; i < 2; ++i) { int R, C; stage_rc(tid * 16 + i * 8192, R, C); const int Rb = Epi::PERM ? ((R & ~31) + perm32(R & 31)) : R;
        voffA[i] = (unsigned)(R * K + C) * 2u; voffB[i] = (unsigned)(Rb * K + C) * 2u; }
    const size_t kstep = (size_t)(BK * 2);
    const size_t hstep = (size_t)HALF * K * 2;
    const size_t tstep = 2 * hstep;
    const unsigned ldsw = (unsigned)wid * 1024u;
    const int aoff = lds_byte(wr * 64 + fr, fq * 8), boff = lds_byte(wc * 32 + fr, fq * 8);
#define PG8_SA(b, h) (((b) * 2 + (h)) * HTB)
#define PG8_SB(b, h) ((4 + (b) * 2 + (h)) * HTB)
#define PG8_STAGE(bufoff, gbase, voff) do { _Pragma("unroll") for (int _i = 0; _i < 2; ++_i) \
        __builtin_amdgcn_global_load_lds((const unsigned*)((const char*)(gbase) + (voff)[_i]), (PG8_LAS unsigned*)(lds + (bufoff) + ldsw + _i * 8192), 16, 0, 0); } while (0)
#define PG8_LDA(dst, b, h) do { _Pragma("unroll") for (int m = 0; m < 4; ++m) _Pragma("unroll") for (int k = 0; k < 2; ++k) dst[m][k] = *(const PG8_LAS bf16x8*)(lds + PG8_SA(b, h) + aoff + m * 2048 + k * 1024); } while (0)
#define PG8_LDB(dst, b, h) do { _Pragma("unroll") for (int n = 0; n < 2; ++n) _Pragma("unroll") for (int k = 0; k < 2; ++k) dst[n][k] = *(const PG8_LAS bf16x8*)(lds + PG8_SB(b, h) + boff + n * 2048 + k * 1024); } while (0)
#define PG8_MMA(ai, bj, At, Bt) do { __builtin_amdgcn_s_setprio(1); _Pragma("unroll") for (int m = 0; m < 4; ++m) _Pragma("unroll") for (int n = 0; n < 2; ++n) _Pragma("unroll") for (int k = 0; k < 2; ++k) \
        acc[ai][bj][m][n] = __builtin_amdgcn_mfma_f32_16x16x32_bf16(Bt[n][k], At[m][k], acc[ai][bj][m][n], 0, 0, 0); __builtin_amdgcn_s_setprio(0); } while (0)
#define PG8_WAIT_V(n) asm volatile("s_waitcnt vmcnt(" #n ")" ::: "memory")
#define PG8_WAIT_L(n) asm volatile("s_waitcnt lgkmcnt(" #n ")" ::: "memory")
#define PG8_BAR __builtin_amdgcn_s_barrier()
#define PG8_SCHED __builtin_amdgcn_sched_barrier(0)
    Unit cur, nxt; int ui = 0;
    if (!S.next(0, cur)) return;
    f32x4 acc[2][2][4][2];
#pragma unroll
    for (int a = 0; a < 2; ++a)
#pragma unroll
        for (int b = 0; b < 2; ++b)
#pragma unroll
            for (int m = 0; m < 4; ++m)
#pragma unroll
                for (int n = 0; n < 2; ++n) acc[a][b][m][n] = (f32x4){0.f, 0.f, 0.f, 0.f};
    bf16x8 At[4][2], B0[2][2], B1[2][2];
    const char* cA = (const char*)g.A + (size_t)cur.pm * tstep; const char* cB = (const char*)g.Bt + (size_t)cur.pn * tstep;
    S.a_ready(cur);
    if constexpr (SP2) {
        PG8_STAGE(PG8_SB(0, 0), cB, voffB); PG8_STAGE(PG8_SB(0, 1), cB + hstep, voffB); PG8_STAGE(PG8_SA(0, 0), cA, voffA); PG8_STAGE(PG8_SA(0, 1), cA + hstep, voffA);
        if (wr == 1) PG8_BAR;
        PG8_WAIT_V(2); PG8_BAR;
        PG8_STAGE(PG8_SB(1, 0), cB + kstep, voffB); PG8_STAGE(PG8_SA(1, 0), cA + kstep, voffA); PG8_STAGE(PG8_SB(1, 1), cB + hstep + kstep, voffB);
        PG8_WAIT_V(6); PG8_BAR;
    } else {
        PG8_STAGE(PG8_SB(0, 0), cB, voffB); PG8_STAGE(PG8_SA(0, 0), cA, voffA); PG8_STAGE(PG8_SB(0, 1), cB + hstep, voffB); PG8_STAGE(PG8_SA(0, 1), cA + hstep, voffA);
        if (wr == 1) PG8_BAR;
        PG8_WAIT_V(4); PG8_BAR;
        PG8_STAGE(PG8_SB(1, 0), cB + kstep, voffB); PG8_STAGE(PG8_SA(1, 0), cA + kstep, voffA); PG8_STAGE(PG8_SB(1, 1), cB + hstep + kstep, voffB);
        PG8_WAIT_V(6); PG8_BAR;
    }
    for (;;) {
        const bool has_next = S.next(ui + 1, nxt);
        const char* nA = has_next ? (const char*)g.A + (size_t)nxt.pm * tstep : cA; const char* nB = has_next ? (const char*)g.Bt + (size_t)nxt.pn * tstep : cB;
        for (int t = 0; t < nt; t += 2) {
            const bool last = (t == nt - 2);
            const char* a1 = cA + (size_t)(t + 1) * kstep;
            const char* a2 = last ? nA : cA + (size_t)(t + 2) * kstep; const char* b2 = last ? nB : cB + (size_t)(t + 2) * kstep;
            const char* a3 = a2 + kstep; const char* b3 = b2 + kstep;
            if (last && has_next) S.a_ready(nxt);
            if constexpr (SP2) {
            PG8_LDB(B0, 0, 0); PG8_LDB(B1, 0, 1); PG8_SCHED; PG8_LDA(At, 0, 0); PG8_STAGE(PG8_SA(1, 1), a1 + hstep, voffA);
            PG8_WAIT_V(8); PG8_WAIT_L(0); PG8_BAR; PG8_MMA(0, 0, At, B0); PG8_MMA(0, 1, At, B1); PG8_BAR; PG8_SCHED;
            PG8_LDA(At, 0, 1); PG8_STAGE(PG8_SB(0, 0), b2, voffB); PG8_STAGE(PG8_SB(0, 1), b2 + hstep, voffB); PG8_STAGE(PG8_SA(0, 0), a2, voffA);
            PG8_WAIT_V(8); PG8_WAIT_L(0); PG8_BAR; PG8_MMA(1, 0, At, B0); PG8_MMA(1, 1, At, B1); PG8_BAR; PG8_SCHED;
            PG8_LDB(B0, 1, 0); PG8_LDB(B1, 1, 1); PG8_SCHED; PG8_LDA(At, 1, 0); PG8_STAGE(PG8_SA(0, 1), a2 + hstep, voffA);
            PG8_WAIT_V(8); PG8_WAIT_L(0); PG8_BAR; PG8_MMA(0, 0, At, B0); PG8_MMA(0, 1, At, B1); PG8_BAR; PG8_SCHED;
            PG8_LDA(At, 1, 1); PG8_STAGE(PG8_SB(1, 0), b3, voffB); PG8_STAGE(PG8_SB(1, 1), b3 + hstep, voffB); PG8_STAGE(PG8_SA(1, 0), a3, voffA);
            PG8_WAIT_V(8); PG8_WAIT_L(0); PG8_BAR; PG8_MMA(1, 0, At, B0); PG8_MMA(1, 1, At, B1); PG8_BAR; PG8_SCHED;
            } else {
            PG8_LDB(B0, 0, 0); PG8_SCHED; PG8_LDA(At, 0, 0); PG8_STAGE(PG8_SA(1, 1), a1 + hstep, voffA);
            PG8_WAIT_L(8); PG8_BAR; PG8_WAIT_L(0); PG8_MMA(0, 0, At, B0); PG8_BAR; PG8_SCHED;
            PG8_LDB(B1, 0, 1); PG8_STAGE(PG8_SB(0, 0), b2, voffB);
            PG8_BAR; PG8_WAIT_L(0); PG8_MMA(0, 1, At, B1); PG8_BAR;
            PG8_LDA(At, 0, 1); PG8_STAGE(PG8_SA(0, 0), a2, voffA);
            PG8_BAR; PG8_WAIT_L(0); PG8_MMA(1, 0, At, B0); PG8_BAR; PG8_SCHED;
            PG8_STAGE(PG8_SB(0, 1), b2 + hstep, voffB);
            PG8_WAIT_V(6); PG8_BAR; PG8_MMA(1, 1, At, B1); PG8_BAR;
            PG8_LDB(B0, 1, 0); PG8_SCHED; PG8_LDA(At, 1, 0); PG8_STAGE(PG8_SA(0, 1), a2 + hstep, voffA);
            PG8_WAIT_L(8); PG8_BAR; PG8_WAIT_L(0); PG8_MMA(0, 0, At, B0); PG8_BAR; PG8_SCHED;
            PG8_LDB(B1, 1, 1); PG8_STAGE(PG8_SB(1, 0), b3, voffB);
            PG8_BAR; PG8_WAIT_L(0); PG8_MMA(0, 1, At, B1); PG8_BAR;
            PG8_LDA(At, 1, 1); PG8_STAGE(PG8_SA(1, 0), a3, voffA);
            PG8_BAR; PG8_WAIT_L(0); PG8_MMA(1, 0, At, B0); PG8_BAR; PG8_SCHED;
            PG8_STAGE(PG8_SB(1, 1), b3 + hstep, voffB);
            PG8_WAIT_V(6); PG8_BAR; PG8_MMA(1, 1, At, B1); PG8_BAR;
            }
        }
        if constexpr (ALIGN_EPI) { if (wr == 0) PG8_BAR; }
        if constexpr (!Epi::AFTER_DRAIN) { E(acc, cur, wr, wc, fr, fq); S.done(cur); }
        if (!has_next) break;
#pragma unroll
        for (int a = 0; a < 2; ++a)
#pragma unroll
            for (int b = 0; b < 2; ++b)
#pragma unroll
                for (int m = 0; m < 4; ++m)
#pragma unroll
                    for (int n = 0; n < 2; ++n) acc[a][b][m][n] = (f32x4){0.f, 0.f, 0.f, 0.f};
        cur = nxt; cA = nA; cB = nB; ++ui;
        if constexpr (ALIGN_EPI) { if (wr == 1) PG8_BAR; }
    }
    PG8_WAIT_V(0);
    if constexpr (!ALIGN_EPI) { if (wr == 0) PG8_BAR; }
    PG8_BAR;
    if constexpr (Epi::AFTER_DRAIN) { E.fused(acc, cur, wr, wc, fr, fq, lds, wid, lane); S.done(cur); }
#undef PG8_SA
#undef PG8_SB
#undef PG8_STAGE
#undef PG8_LDA
#undef PG8_LDB
#undef PG8_MMA
#undef PG8_WAIT_V
#undef PG8_WAIT_L
#undef PG8_BAR
#undef PG8_SCHED
}
}

namespace pg8 {
struct EpiProj {
    static constexpr bool PERM = true, AFTER_DRAIN = false;
    bf16_t* H; const float* g; const float* gd;
    const float* rowss;
    __device__ __forceinline__ void operator()(const f32x4 (&acc)[2][2][4][2], const Unit& u, int wr, int wc, int fr, int fq) const {
        const int pn = u.pn;
        int mode = 0; const float* gain = nullptr;
        const float qs = (pn == 0 || pn == 3 || pn == 8) ? 0.125f * 1.4426950408889634f : (pn == 5 ? 0.17677669529663687f * 1.4426950408889634f : 1.f);
        if (pn == 0) { mode = 1; gain = g; } else if (pn == 1) { mode = 1; gain = g + 64; } else if (pn == 3) { mode = 1; gain = g + 128; }
        else if (pn == 4) { if (wc < 2) { mode = 1; gain = g + 192; } }
        else if (pn == 5) { mode = 2; gain = gd; } else if (pn == 6) { mode = 2; gain = gd + 32; }
        else if (pn == 8) { mode = 1; gain = g + 256; }
        else if (pn == 9) { if (wc == 2) { mode = 1; gain = g + 384; } }
        else if (pn == 10) { if (wc == 0) { mode = 1; gain = g + 448; } else if (wc == 2) mode = 4; }
        else if (pn >= 11) mode = 3;
        f32x4 gv[2][2];
#pragma unroll
        for (int bj = 0; bj < 2; ++bj)
#pragma unroll
            for (int n = 0; n < 2; ++n) gv[bj][n] = (f32x4){1.f, 1.f, 1.f, 1.f};
        if (mode == 1) {
#pragma unroll
            for (int bj = 0; bj < 2; ++bj)
#pragma unroll
                for (int n = 0; n < 2; ++n) gv[bj][n] = *(const f32x4*)(gain + 32 * bj + 8 * fq + 4 * n);
        } else if (mode == 2) {
#pragma unroll
            for (int bj = 0; bj < 2; ++bj)
#pragma unroll
                for (int n = 0; n < 2; ++n) gv[bj][n] = *(const f32x4*)(gain + 8 * fq + 4 * n);
        }
        const int col0 = pn * BM + 64 * wc + 8 * fq;
#pragma unroll
        for (int ai = 0; ai < 2; ++ai)
#pragma unroll
            for (int m = 0; m < 4; ++m) {
                const int row = u.pm * BM + ai * HALF + wr * 64 + m * 16 + fr;
                f32x4 v[2][2];
                const float rsc = rowss ? rsqrtf((float)((const unsigned long long*)rowss)[row] * (1.f / (1048576.f * 1024.f)) + 1e-6f) : 1.f;
#pragma unroll
                for (int bj = 0; bj < 2; ++bj)
#pragma unroll
                    for (int n = 0; n < 2; ++n) v[bj][n] = acc[ai][bj][m][n] * rsc;
                if (mode == 1 || mode == 2) {
                    float s0 = 0.f, s1 = 0.f;
#pragma unroll
                    for (int n = 0; n < 2; ++n) {
                        s0 += v[0][n][0] * v[0][n][0] + v[0][n][1] * v[0][n][1] + v[0][n][2] * v[0][n][2] + v[0][n][3] * v[0][n][3];
                        s1 += v[1][n][0] * v[1][n][0] + v[1][n][1] * v[1][n][1] + v[1][n][2] * v[1][n][2] + v[1][n][3] * v[1][n][3];
                    }
                    s0 += __shfl_xor(s0, 16); s0 += __shfl_xor(s0, 32);
                    s1 += __shfl_xor(s1, 16); s1 += __shfl_xor(s1, 32);
                    float r0, r1;
                    if (mode == 1) { r0 = r1 = rsqrtf((s0 + s1) * (1.f / 64.f) + 1e-6f) * qs; }
                    else { r0 = rsqrtf(s0 * (1.f / 32.f) + 1e-6f) * qs; r1 = rsqrtf(s1 * (1.f / 32.f) + 1e-6f) * qs; }
#pragma unroll
                    for (int n = 0; n < 2; ++n) { v[0][n] = v[0][n] * r0 * gv[0][n]; v[1][n] = v[1][n] * r1 * gv[1][n]; }
                } else if (mode == 3) {
#pragma unroll
                    for (int bj = 0; bj < 2; ++bj)
#pragma unroll
                        for (int n = 0; n < 2; ++n)
#pragma unroll
                            for (int e = 0; e < 4; ++e) { const float x = v[bj][n][e]; v[bj][n][e] = x * __builtin_amdgcn_rcpf(1.f + __expf(-x)); }
                } else if (mode == 4) {
#pragma unroll
                    for (int bj = 0; bj < 2; ++bj)
#pragma unroll
                        for (int n = 0; n < 2; ++n)
#pragma unroll
                            for (int e = 0; e < 4; ++e) { const float x = v[bj][n][e]; v[bj][n][e] = __builtin_amdgcn_rcpf(1.f + __expf(-x)); }
                }
                bf16_t* rowp = H + (size_t)row * 3840 + col0;
#pragma unroll
                for (int bj = 0; bj < 2; ++bj) {
                    u32x4 w; w.x = cvt_pk_bf16(v[bj][0][0], v[bj][0][1]); w.y = cvt_pk_bf16(v[bj][0][2], v[bj][0][3]);
                    w.z = cvt_pk_bf16(v[bj][1][0], v[bj][1][1]); w.w = cvt_pk_bf16(v[bj][1][2], v[bj][1][3]);
                    *(u32x4*)(rowp + 32 * bj) = w;
                }
            }
    }
};
struct EpiOut {
    static constexpr bool PERM = false, AFTER_DRAIN = false;
    const float* xprev32;
    const bf16_t* xprev16;
    float* out;
    PG8_LAS float* exch;
    bf16_t* x1b; float* rowss;
    __device__ __forceinline__ void operator()(const f32x4 (&acc)[2][2][4][2], const Unit& u, int wr, int wc, int fr, int fq) const {
        const int col0 = u.pn * BM + wc * 32 + 4 * fq;
        const bool first = xprev32 != nullptr;
#pragma unroll
        for (int ai = 0; ai < 2; ++ai)
#pragma unroll
            for (int m = 0; m < 4; ++m) {
                const int row = u.pm * BM + ai * HALF + wr * 64 + m * 16 + fr;
                const size_t off = (size_t)row * 1024 + col0;
                float ss = 0.f;
#pragma unroll
                for (int bj = 0; bj < 2; ++bj)
#pragma unroll
                    for (int n = 0; n < 2; ++n) {
                        if (first) {
                            const f32x4 b = *(const f32x4*)(xprev32 + off + bj * HALF + n * 16);
                            const f32x4 v = b + acc[ai][bj][m][n];
                            ss += (v[0] * v[0] + v[1] * v[1]) + (v[2] * v[2] + v[3] * v[3]);
                            uint2 o; o.x = cvt_pk_bf16(v[0], v[1]); o.y = cvt_pk_bf16(v[2], v[3]);
                            *(uint2*)(x1b + off + bj * HALF + n * 16) = o;
                        } else {
                            const uint2 r = *(const uint2*)(xprev16 + off + bj * HALF + n * 16);
                            const f32x4 b = (f32x4){__uint_as_float(r.x << 16), __uint_as_float(r.x & 0xffff0000u), __uint_as_float(r.y << 16), __uint_as_float(r.y & 0xffff0000u)};
                            *(f32x4*)(out + off + bj * HALF + n * 16) = b + acc[ai][bj][m][n];
                        }
                    }
                if (first) {
                    ss += __shfl_xor(ss, 16); ss += __shfl_xor(ss, 32);
                    if (fq == 0) exch[(ai * HALF + wr * 64 + m * 16 + fr) * 4 + wc] = ss;
                }
            }
        if (first) {
            asm volatile("s_waitcnt lgkmcnt(0)" ::: "memory"); __builtin_amdgcn_s_barrier(); asm volatile("" ::: "memory");
            if (wc == 0) {
                const int lane = fq * 16 + fr;
#pragma unroll
                for (int k = 0; k < 2; ++k) {
                    const int rl = k * HALF + wr * 64 + lane;
                    const f32x4 p = *(const PG8_LAS f32x4*)(exch + rl * 4);
                    const float tot = (p[0] + p[1]) + (p[2] + p[3]);
                    atomicAdd((unsigned long long*)rowss + (u.pm * BM + rl), (unsigned long long)(tot * 1048576.f + 0.5f));
                }
            }
        }
    }
};
}

template <int MODE>
__device__ __forceinline__ void p0_transpose_item(const float* __restrict__ W, bf16_t* __restrict__ WT, LAS float* scr, int item, int lane, int KR = 1024, int NC = 1024, const float* __restrict__ gk = nullptr) {
    const int NSRC = MODE == 0 ? 3724 : NC, NG = MODE == 0 ? 120 : NC / 32;
    const int kb = item / NG, nb = item % NG, k0 = 64 * kb, hc0 = 32 * nb;
    const int hc = hc0 + (lane & 31);
    int src = hc;
    if (MODE == 0) src = hc < 2700 ? hc : (hc < 2816 ? -1 : hc - 116);
    float wv[32];
#pragma unroll
    for (int i = 0; i < 32; ++i) { const int kk = 2 * i + (lane >> 5); wv[i] = src >= 0 ? W[(size_t)(k0 + kk) * NSRC + src] : 0.f; }
#pragma unroll
    for (int i = 0; i < 32; ++i) { const int kk = 2 * i + (lane >> 5); scr[kk * 33 + (lane & 31)] = MODE == 0 ? wv[i] * gk[k0 + kk] : wv[i]; }
    asm volatile("s_waitcnt lgkmcnt(0)" ::: "memory");
    const int c = lane & 7;
#pragma unroll
    for (int j = 0; j < 4; ++j) {
        const int n = (lane >> 3) + 8 * j; const LAS float* s = scr + (8 * c) * 33 + n;
        const int hcn = hc0 + n;
        int drow = hcn;
        if (MODE == 0) drow = (hcn & ~255) + ((hcn >> 5) & 1) * 128 + ((hcn >> 6) & 3) * 32 + (hcn & 31);
        uint4 o; o.x = (unsigned)f2bf(s[0]) | ((unsigned)f2bf(s[33]) << 16); o.y = (unsigned)f2bf(s[66]) | ((unsigned)f2bf(s[99]) << 16);
        o.z = (unsigned)f2bf(s[132]) | ((unsigned)f2bf(s[165]) << 16); o.w = (unsigned)f2bf(s[198]) | ((unsigned)f2bf(s[231]) << 16);
        if (MODE == 2) { const int k = k0 + 8 * c; *(uint4*)(WT + ((size_t)((((drow >> 5) * 8 + (k >> 8)) * 16 + ((k >> 4) & 15)) * 64 + ((k >> 3) & 1) * 32 + (drow & 31))) * 8) = o; }
        else *(uint4*)(WT + (size_t)drow * KR + k0 + 8 * c) = o;
    }
    asm volatile("s_waitcnt lgkmcnt(0)" ::: "memory");
}

namespace att {
typedef short bf16x8 __attribute__((ext_vector_type(8)));
typedef short v4i16 __attribute__((ext_vector_type(4)));
typedef float f32x16 __attribute__((ext_vector_type(16)));
typedef float f32x2_t __attribute__((ext_vector_type(2)));
typedef __bf16 bf16x2_t __attribute__((ext_vector_type(2)));
typedef unsigned u32x4 __attribute__((ext_vector_type(4)));
typedef float f32x4 __attribute__((ext_vector_type(4)));
__device__ __forceinline__ unsigned cvtpk(float lo, float hi) { f32x2_t v = {lo, hi}; bf16x2_t b = __builtin_convertvector(v, bf16x2_t); return __builtin_bit_cast(unsigned, b); }
__device__ __forceinline__ int crow(int r, int h) { return (r & 3) + 8 * (r >> 2) + 4 * h; }
template <int CTRL> __device__ __forceinline__ int dpp_i(int v) { return __builtin_amdgcn_update_dpp(0, v, CTRL, 0xF, 0xF, true); }
template <int CTRL> __device__ __forceinline__ float dpp_f(float v) { return __int_as_float(dpp_i<CTRL>(__float_as_int(v))); }
constexpr int DPP_XOR1 = 0xB1, DPP_XOR2 = 0x4E, DPP_HMIRROR = 0x141;
constexpr float LOG2E = 1.4426950408889634f;
constexpr int L_KV = 0, KVB = 16384  , L_TAB = 32768  , L_WSCR = 83968  , L_IMP = 92160  , L_Q = 124928, L_SEL = 125184  , L_SB = 126464  ;

struct StageRegs { u32x4 k, v; };
__device__ __forceinline__ void stage_load(StageRegs& sr, const bf16_t* kp, const bf16_t* vp, bool valid, int ch) {
    sr.k = (u32x4){0u, 0u, 0u, 0u}; sr.v = sr.k;
    if (valid) { sr.k = *(const u32x4*)(kp + ch * 8); sr.v = *(const u32x4*)(vp + ch * 8); }
}
__device__ __forceinline__ void stage_write(LAS unsigned char* buf, const StageRegs& sr, int row, int ch) {
    *(LAS u32x4*)(buf + row * 128 + ((ch ^ (row & 7)) << 4)) = sr.k;
    *(LAS u32x4*)(buf + 8192 + (ch >> 2) * 4096 + row * 64 + (ch & 3) * 16) = sr.v;
}
__device__ __forceinline__ f32x16 load_tab16(const LAS float* tbl, int TSP, int jb) {
    const int sh = jb & 3; const LAS float* tp = tbl + sh * TSP + (jb - sh);
    const f32x4 t0 = *(const LAS f32x4*)(tp), t1 = *(const LAS f32x4*)(tp + 8), t2 = *(const LAS f32x4*)(tp + 16), t3 = *(const LAS f32x4*)(tp + 24);
    return (f32x16){t0[0], t0[1], t0[2], t0[3], t1[0], t1[1], t1[2], t1[3], t2[0], t2[1], t2[2], t2[3], t3[0], t3[1], t3[2], t3[3]};
}
__device__ __forceinline__ float exp_sum16(f32x16& acc) {
    float sa = 0.f, sb = 0.f;
#pragma unroll
    for (int r = 0; r < 16; r += 2) {
        acc[r] = __builtin_amdgcn_exp2f(acc[r]); acc[r + 1] = __builtin_amdgcn_exp2f(acc[r + 1]);
        sa += acc[r]; asm volatile("" : "+v"(sa)); sb += acc[r + 1]; asm volatile("" : "+v"(sb));
    }
    return sa + sb;
}
__device__ __forceinline__ f32x16 splat16(float v) { return (f32x16){v, v, v, v, v, v, v, v, v, v, v, v, v, v, v, v}; }
template <int S0, int S1>
__device__ __forceinline__ void qk_sub(f32x16& acc, const LAS unsigned char* buf, int sub, const bf16x8* qf, int lane) {
    const int key = 32 * sub + (lane & 31), h = lane >> 5;
    bf16x8 kf[S1 - S0];
#pragma unroll
    for (int s = S0; s < S1; ++s) kf[s - S0] = *(const LAS bf16x8*)(buf + key * 128 + (((2 * s + h) ^ (key & 7)) << 4));
    __builtin_amdgcn_sched_barrier(0);
#pragma unroll
    for (int s = S0; s < S1; ++s) acc = __builtin_amdgcn_mfma_f32_32x32x16_bf16(kf[s - S0], qf[s], acc, 0, 0, 0);
}
__device__ __forceinline__ void pack_p(const f32x16& p, bf16x8& pa0, bf16x8& pa1) {
    u32x4 w0, w1;
    w0.x = cvtpk(p[0], p[1]); w0.y = cvtpk(p[2], p[3]); w0.z = cvtpk(p[4], p[5]); w0.w = cvtpk(p[6], p[7]);
    w1.x = cvtpk(p[8], p[9]); w1.y = cvtpk(p[10], p[11]); w1.z = cvtpk(p[12], p[13]); w1.w = cvtpk(p[14], p[15]);
    pa0 = __builtin_bit_cast(bf16x8, w0); pa1 = __builtin_bit_cast(bf16x8, w1);
}
__device__ __forceinline__ void pv_sub(f32x16* o, const LAS unsigned char* buf, int sub, const bf16x8& pa0, const bf16x8& pa1, int lane) {
    const int h = lane >> 5, g16 = (lane >> 4) & 1, q4 = (lane & 15) >> 2, p4 = lane & 3;
    const LAS unsigned char* vb = buf + 8192 + (32 * sub + 4 * h + q4) * 64 + (16 * g16 + 4 * p4) * 2;
    bf16x8 vf[2][2];
#pragma unroll
    for (int dt = 0; dt < 2; ++dt) {
#pragma unroll
        for (int s2 = 0; s2 < 2; ++s2) {
            const v4i16 lo = __builtin_amdgcn_ds_read_tr16_b64_v4i16((LAS v4i16*)(vb + dt * 4096 + s2 * 1024));
            const v4i16 hi = __builtin_amdgcn_ds_read_tr16_b64_v4i16((LAS v4i16*)(vb + dt * 4096 + s2 * 1024 + 512));
            vf[dt][s2] = (bf16x8){lo[0], lo[1], lo[2], lo[3], hi[0], hi[1], hi[2], hi[3]};
        }
    }
    __builtin_amdgcn_sched_barrier(0);
    o[0] = __builtin_amdgcn_mfma_f32_32x32x16_bf16(pa0, vf[0][0], o[0], 0, 0, 0);
    o[1] = __builtin_amdgcn_mfma_f32_32x32x16_bf16(pa0, vf[1][0], o[1], 0, 0, 0);
    o[0] = __builtin_amdgcn_mfma_f32_32x32x16_bf16(pa1, vf[0][1], o[0], 0, 0, 0);
    o[1] = __builtin_amdgcn_mfma_f32_32x32x16_bf16(pa1, vf[1][1], o[1], 0, 0, 0);
}

__device__ __forceinline__ void pv_sub2(f32x16* oa, f32x16* ob, const LAS unsigned char* buf, int sub, const bf16x8& a0, const bf16x8& a1, const bf16x8& b0, const bf16x8& b1, int lane) {
    const int h = lane >> 5, g16 = (lane >> 4) & 1, q4 = (lane & 15) >> 2, p4 = lane & 3;
    const LAS unsigned char* vb = buf + 8192 + (32 * sub + 4 * h + q4) * 64 + (16 * g16 + 4 * p4) * 2;
#pragma unroll
    for (int dt = 0; dt < 2; ++dt) {
#pragma unroll
        for (int s2 = 0; s2 < 2; ++s2) {
            const v4i16 lo = __builtin_amdgcn_ds_read_tr16_b64_v4i16((LAS v4i16*)(vb + dt * 4096 + s2 * 1024));
            const v4i16 hi = __builtin_amdgcn_ds_read_tr16_b64_v4i16((LAS v4i16*)(vb + dt * 4096 + s2 * 1024 + 512));
            const bf16x8 vf = (bf16x8){lo[0], lo[1], lo[2], lo[3], hi[0], hi[1], hi[2], hi[3]};
            oa[dt] = __builtin_amdgcn_mfma_f32_32x32x16_bf16(s2 == 0 ? a0 : a1, vf, oa[dt], 0, 0, 0);
            ob[dt] = __builtin_amdgcn_mfma_f32_32x32x16_bf16(s2 == 0 ? b0 : b1, vf, ob[dt], 0, 0, 0);
        }
    }
}

struct BandArgs {
    const bf16_t* Hb;
    int cq, ck, cv;
    int rate, cls, f0, maxd;
    const float* bias;
    float M;
    float sinkterm;
    bf16_t* OA; float* DA;
    bf16_t* Y; int ycol;
    int hd; size_t brow;
};
constexpr int B_TAB = 98304, B_WSCR = 106496;
template <int MODE>
__device__ __forceinline__ void banded_unit(LAS unsigned char* lds, const BandArgs& P) {
    const int tid = opq(threadIdx.x), lane = tid & 63, w = __builtin_amdgcn_readfirstlane(tid >> 6), h = lane >> 5;
    LAS float* sb = (LAS float*)(lds + L_SB);
    LAS float* tbl = (LAS float*)(lds + B_TAB);
    const int KPREV = ((P.maxd + 63) >> 6) << 6;
    const int t0 = (KPREV - P.f0) > 0 ? ((KPREV - P.f0) >> 6) : 0;
    const int srow = tid >> 3, sch = tid & 7;
    StageRegs sr[6];
#pragma unroll
    for (int i = 0; i < 6; ++i) {
        int kf = P.f0 - KPREV + 64 * i + srow; kf = kf < 0 ? 0 : kf;
        const bf16_t* rp = P.Hb + ((size_t)kf * P.rate + P.cls) * HP;
        stage_load(sr[i], rp + P.ck, rp + P.cv, true, sch);
    }
    const int fq0 = P.f0 + 32 * w;
    bf16x8 qf[4];
    {
        const size_t tq = (size_t)(fq0 + (lane & 31)) * P.rate + P.cls;
        const bf16_t* qp = P.Hb + tq * HP + P.cq + 8 * h;
#pragma unroll
        for (int s = 0; s < 4; ++s) qf[s] = *(const bf16x8*)(qp + 16 * s);
    }
    if (tid < 32) sb[tid] = (P.bias[tid * 16] - P.M) * LOG2E;
    __syncthreads();
    const int DMAXI = P.maxd + 62, TS = P.maxd + 125, TSP = (TS + 7) & ~3;
    for (int e = tid; e < 4 * TSP; e += 512) {
        const int sh = e / TSP, j = e - sh * TSP + sh, dist = DMAXI - j;
        tbl[e] = (j < TS && dist >= 0 && dist <= P.maxd) ? sb[t5_bucket(dist * P.rate)] : -1e30f;
    }
    f32x16 o[2]; o[0] = (f32x16){}; o[1] = (f32x16){};
    float den = 0.f;
#pragma unroll
    for (int i = 0; i < 6; ++i) stage_write(lds + i * KVB, sr[i], srow, sch);
    asm volatile("" : "+v"(qf[0]), "+v"(qf[1]), "+v"(qf[2]), "+v"(qf[3]));
    __syncthreads();
#pragma unroll 1
    for (int t = t0; t < 6; ++t) {
        const LAS unsigned char* buf = lds + t * KVB;
        const int kf0 = P.f0 - KPREV + 64 * t;
#pragma unroll
        for (int sub = 0; sub < 2; ++sub) {
            const int kfs = kf0 + 32 * sub;
            if (kfs <= fq0 + 31 && kfs + 31 >= fq0 - P.maxd) {
                const int jb = DMAXI - ((fq0 - kfs) + (lane & 31) - 4 * h);
                f32x16 acc = load_tab16(tbl, TSP, jb);
                qk_sub<0, 4>(acc, buf, sub, qf, lane);
                den += exp_sum16(acc);
                bf16x8 pa0, pa1; pack_p(acc, pa0, pa1);
                pv_sub(o, buf, sub, pa0, pa1, lane);
            }
        }
    }
    float dtot = den + __shfl_xor(den, 32);
    if (MODE == 1) dtot += P.sinkterm;
    LAS float* ws_ = (LAS float*)(lds + B_WSCR) + w * 64;
    if (h == 0) ws_[lane] = dtot;
    if (MODE == 0 && h == 0) {
        const size_t tq = (size_t)(fq0 + lane) * P.rate + P.cls;
        P.DA[(P.brow + tq) * 4 + P.hd] = dtot;
    }
    asm volatile("s_waitcnt lgkmcnt(0)" ::: "memory");
#pragma unroll
    for (int r = 0; r < 16; ++r) {
        const int qi = crow(r, h);
        const float inv = __builtin_amdgcn_rcpf(ws_[qi]);
        const size_t row = P.brow + (size_t)(fq0 + qi) * P.rate + P.cls;
#pragma unroll
        for (int dt = 0; dt < 2; ++dt) {
            const int d = 32 * dt + (lane & 31);
            const float val = o[dt][r] * inv;
            if (MODE == 0) P.OA[row * 256 + P.hd * 64 + d] = f2bf(val);
            else P.Y[row * DM + P.ycol + d] = f2bf(val * bf2f(P.Hb[(row - P.brow) * HP + C_SILU + P.ycol + d]));
        }
    }
}

__device__ __forceinline__ void diff_p1(const LAS float* tp, const LAS unsigned char* buf, int sub, const bf16x8* qf, int lane, bf16x8& pa0, bf16x8& pa1, bf16x8& pb0, bf16x8& pb1) {
    const f32x4 t0 = *(const LAS f32x4*)(tp), t1 = *(const LAS f32x4*)(tp + 8), t2 = *(const LAS f32x4*)(tp + 16), t3 = *(const LAS f32x4*)(tp + 24);
    const f32x16 T = (f32x16){t0[0], t0[1], t0[2], t0[3], t1[0], t1[1], t1[2], t1[3], t2[0], t2[1], t2[2], t2[3], t3[0], t3[1], t3[2], t3[3]};
    const int key = 32 * sub + (lane & 31), h = lane >> 5;
    const LAS unsigned char* kp = buf + key * 128;
    const bf16x8 k0 = *(const LAS bf16x8*)(kp + (((0 + h) ^ (key & 7)) << 4)), k1 = *(const LAS bf16x8*)(kp + (((2 + h) ^ (key & 7)) << 4));
    const bf16x8 k2 = *(const LAS bf16x8*)(kp + (((4 + h) ^ (key & 7)) << 4)), k3 = *(const LAS bf16x8*)(kp + (((6 + h) ^ (key & 7)) << 4));
    f32x16 a1 = __builtin_amdgcn_mfma_f32_32x32x16_bf16(k0, qf[0], T, 0, 0, 0);
    f32x16 a2 = __builtin_amdgcn_mfma_f32_32x32x16_bf16(k2, qf[2], T, 0, 0, 0);
    a1 = __builtin_amdgcn_mfma_f32_32x32x16_bf16(k1, qf[1], a1, 0, 0, 0);
    a2 = __builtin_amdgcn_mfma_f32_32x32x16_bf16(k3, qf[3], a2, 0, 0, 0);
#pragma unroll
    for (int r = 0; r < 16; ++r) { a1[r] = __builtin_amdgcn_exp2f(a1[r]); a2[r] = __builtin_amdgcn_exp2f(a2[r]); }
    pack_p(a1, pa0, pa1); pack_p(a2, pb0, pb1);
}
__device__ __forceinline__ void diff_p2(const LAS unsigned char* buf, int sub, int lane, const bf16x8& pa0, const bf16x8& pa1, const bf16x8& pb0, const bf16x8& pb1, f32x16& dn1, f32x16& dn2, f32x16* o1, f32x16* o2) {
    const bf16x8 ones = (bf16x8){0x3F80, 0x3F80, 0x3F80, 0x3F80, 0x3F80, 0x3F80, 0x3F80, 0x3F80};
    const int h = lane >> 5, g16 = (lane >> 4) & 1, q4 = (lane & 15) >> 2, p4 = lane & 3;
    const LAS unsigned char* vb = buf + 8192 + (32 * sub + 4 * h + q4) * 64 + (16 * g16 + 4 * p4) * 2;
    bf16x8 vf[2][2];
#pragma unroll
    for (int dt = 0; dt < 2; ++dt) {
#pragma unroll
        for (int s2 = 0; s2 < 2; ++s2) {
            const v4i16 lo = __builtin_amdgcn_ds_read_tr16_b64_v4i16((LAS v4i16*)(vb + dt * 4096 + s2 * 1024));
            const v4i16 hi = __builtin_amdgcn_ds_read_tr16_b64_v4i16((LAS v4i16*)(vb + dt * 4096 + s2 * 1024 + 512));
            vf[dt][s2] = (bf16x8){lo[0], lo[1], lo[2], lo[3], hi[0], hi[1], hi[2], hi[3]};
        }
    }
    __builtin_amdgcn_sched_barrier(0);
    dn1 = __builtin_amdgcn_mfma_f32_32x32x16_bf16(pa0, ones, dn1, 0, 0, 0);
    dn2 = __builtin_amdgcn_mfma_f32_32x32x16_bf16(pb0, ones, dn2, 0, 0, 0);
    dn1 = __builtin_amdgcn_mfma_f32_32x32x16_bf16(pa1, ones, dn1, 0, 0, 0);
    dn2 = __builtin_amdgcn_mfma_f32_32x32x16_bf16(pb1, ones, dn2, 0, 0, 0);
    o1[0] = __builtin_amdgcn_mfma_f32_32x32x16_bf16(pa0, vf[0][0], o1[0], 0, 0, 0);
    o2[0] = __builtin_amdgcn_mfma_f32_32x32x16_bf16(pb0, vf[0][0], o2[0], 0, 0, 0);
    o1[1] = __builtin_amdgcn_mfma_f32_32x32x16_bf16(pa0, vf[1][0], o1[1], 0, 0, 0);
    o2[1] = __builtin_amdgcn_mfma_f32_32x32x16_bf16(pb0, vf[1][0], o2[1], 0, 0, 0);
    o1[0] = __builtin_amdgcn_mfma_f32_32x32x16_bf16(pa1, vf[0][1], o1[0], 0, 0, 0);
    o2[0] = __builtin_amdgcn_mfma_f32_32x32x16_bf16(pb1, vf[0][1], o2[0], 0, 0, 0);
    o1[1] = __builtin_amdgcn_mfma_f32_32x32x16_bf16(pa1, vf[1][1], o1[1], 0, 0, 0);
    o2[1] = __builtin_amdgcn_mfma_f32_32x32x16_bf16(pb1, vf[1][1], o2[1], 0, 0, 0);
}

struct DiffArgs {
    const bf16_t* Hb; int hd, qb; size_t brow;
    const float* bias; float M; float lam, lambda_init; const float* subln;
    bf16_t* Y;
};
constexpr int D_SB = 49152, D_TAB = 49664;
__device__ __forceinline__ void diff_unit(LAS unsigned char* lds, const DiffArgs& P) {
    const int tid = opq(threadIdx.x), lane = tid & 63, w = __builtin_amdgcn_readfirstlane(tid >> 6), h = lane >> 5;
    LAS float* sb = (LAS float*)(lds + D_SB);
    LAS float* tbl = (LAS float*)(lds + D_TAB);
    constexpr int DTOP = 1574, TS = DTOP + 63, TSP = (TS + 7) & ~3;
    __syncthreads();
    if (tid < 32) sb[tid] = (P.bias[tid * 16] - P.M) * LOG2E;
    __syncthreads();
    for (int e = tid; e < 4 * TSP; e += 512) {
        const int sh = e / TSP, j = e - sh * TSP + sh, dist = DTOP - j;
        tbl[e] = (j < TS && dist >= 0) ? sb[t5_bucket(dist)] : -1e30f;
    }
    LAS float* farc = tbl + 4 * TSP;
    LAS float* deadr = farc + 32;
    if (tid < 32) { farc[tid] = sb[31]; deadr[tid] = -1e30f; }
    const int q0w = P.qb * 256 + 32 * w;
    const int cq = C_CQ + 64 * P.hd, ck = C_CK + 64 * P.hd, cv = C_CV + 64 * P.hd;
    bf16x8 qf[4];
    {
        const bf16_t* qp = P.Hb + (size_t)(q0w + (lane & 31)) * HP + cq + 8 * h;
#pragma unroll
        for (int s = 0; s < 4; ++s) qf[s] = *(const bf16x8*)(qp + 16 * s);
        asm volatile("" : "+v"(qf[0]), "+v"(qf[1]), "+v"(qf[2]), "+v"(qf[3]));
    }
    const int ntl = 4 * (P.qb + 1);
    const int srow = tid >> 3, sch = tid & 7;
    f32x16 o1[2], o2[2]; o1[0] = (f32x16){}; o1[1] = (f32x16){}; o2[0] = (f32x16){}; o2[1] = (f32x16){};
    f32x16 dn1 = (f32x16){}, dn2 = (f32x16){};
    StageRegs sr;
    {
        const bf16_t* rp = P.Hb + (size_t)srow * HP;
        stage_load(sr, rp + ck, rp + cv, true, sch);
        stage_write(lds, sr, srow, sch);
    }
    __syncthreads();
#define DIFF_TP(KS) ({ const int ks_ = (KS); const int jb_ = DTOP - ((q0w - ks_) + (lane & 31) - 4 * h), sh_ = jb_ & 3; \
        const LAS float* tp_ = tbl + sh_ * TSP + (jb_ - sh_); tp_ = (q0w - ks_ - 31 >= 1513) ? farc : tp_; tp_ = (ks_ > q0w + 31) ? deadr : tp_; tp_; })
#define DIFF_STAGE_LOAD(t) do { const int tn_ = (t) + 1 < ntl ? (t) + 1 : (t); const bf16_t* rp_ = P.Hb + (size_t)(64 * tn_ + srow) * HP; stage_load(sr, rp_ + ck, rp_ + cv, true, sch); } while (0)
    if (w < 4) {
        int cur = 0;
        for (int t = 0; t < ntl; ++t) {
            LAS unsigned char* buf = lds + cur * KVB;
            const int nxt = cur == 2 ? 0 : cur + 1;
            DIFF_STAGE_LOAD(t);
            bf16x8 pa0, pa1, pb0, pb1;
            diff_p1(DIFF_TP(64 * t), buf, 0, qf, lane, pa0, pa1, pb0, pb1);
            diff_p2(buf, 0, lane, pa0, pa1, pb0, pb1, dn1, dn2, o1, o2);
            diff_p1(DIFF_TP(64 * t + 32), buf, 1, qf, lane, pa0, pa1, pb0, pb1);
            diff_p2(buf, 1, lane, pa0, pa1, pb0, pb1, dn1, dn2, o1, o2);
            stage_write(lds + nxt * KVB, sr, srow, sch);
            __syncthreads();
            cur = nxt;
        }
    } else {
        const bf16x8 zero8 = (bf16x8){0, 0, 0, 0, 0, 0, 0, 0};
        bf16x8 qa0 = zero8, qa1 = zero8, qb0 = zero8, qb1 = zero8;
        int cur = 0, prv = 0;
        __builtin_amdgcn_s_setprio(1);
        for (int t = 0; t < ntl; ++t) {
            LAS unsigned char* buf = lds + cur * KVB;
            const int nxt = cur == 2 ? 0 : cur + 1;
            DIFF_STAGE_LOAD(t);
            diff_p2(lds + prv * KVB, 1, lane, qa0, qa1, qb0, qb1, dn1, dn2, o1, o2);
            bf16x8 pa0, pa1, pb0, pb1;
            diff_p1(DIFF_TP(64 * t), buf, 0, qf, lane, pa0, pa1, pb0, pb1);
            diff_p2(buf, 0, lane, pa0, pa1, pb0, pb1, dn1, dn2, o1, o2);
            diff_p1(DIFF_TP(64 * t + 32), buf, 1, qf, lane, qa0, qa1, qb0, qb1);
            stage_write(lds + nxt * KVB, sr, srow, sch);
            __syncthreads();
            prv = cur; cur = nxt;
        }
        diff_p2(lds + prv * KVB, 1, lane, qa0, qa1, qb0, qb1, dn1, dn2, o1, o2);
        __builtin_amdgcn_s_setprio(0);
    }
    __syncthreads();
#undef DIFF_TP
#undef DIFF_STAGE_LOAD
    const float g0 = P.subln[lane & 31] * (1.f - P.lambda_init), g1 = P.subln[32 + (lane & 31)] * (1.f - P.lambda_init);
    const int ycol = 512 + 64 * P.hd;
#pragma unroll
    for (int r = 0; r < 16; ++r) {
        const int qi = crow(r, h);
        const float i1 = __builtin_amdgcn_rcpf(dn1[r]), i2 = P.lam * __builtin_amdgcn_rcpf(dn2[r]);
        const float a0 = o1[0][r] * i1 - o2[0][r] * i2, a1 = o1[1][r] * i1 - o2[1][r] * i2;
        float ss = a0 * a0 + a1 * a1;
        ss += __shfl_xor(ss, 1); ss += __shfl_xor(ss, 2); ss += __shfl_xor(ss, 4); ss += __shfl_xor(ss, 8); ss += __shfl_xor(ss, 16);
        const float rs = rsqrtf(ss * (1.f / 64.f) + 1e-6f);
        const size_t trow = (size_t)(q0w + qi);
        const bf16_t* sp = P.Hb + trow * HP + C_SILU + ycol;
        bf16_t* yp = P.Y + (P.brow + trow) * DM + ycol;
        yp[lane & 31] = f2bf(a0 * rs * g0 * bf2f(sp[lane & 31]));
        yp[32 + (lane & 31)] = f2bf(a1 * rs * g1 * bf2f(sp[32 + (lane & 31)]));
    }
}
struct CmpArgs {
    const bf16_t* Hb;
    int col;
    int rt;
    const float* pos;
    const bf16_t* W1T;
    const float* b1;
    const bf16_t* W2T;
    const float* b2;
    const float* gain;
    bf16_t* OUT;
};
__device__ __forceinline__ void cmp_unit(LAS unsigned char* lds, const CmpArgs& P) {
    const int tid = opq(threadIdx.x), lane = tid & 63, w = __builtin_amdgcn_readfirstlane(tid >> 6), h = lane >> 5;
    LAS unsigned char* hidl = lds + L_KV;
    LAS float* ssx = (LAS float*)(lds + L_KV + 32768 - 512);
    LAS unsigned char* abuf = lds + L_TAB;
    f32x16 acc = (f32x16){};
    const bf16_t* w1p = P.W1T + (size_t)w * (8 * 16 * 64 * 8) + lane * 8;
    u32x4 araw[2]; f32x4 apos[2][2];
#define CMP_ALOAD(ch) do { _Pragma("unroll") for (int q_ = 0; q_ < 2; ++q_) { const int p_ = tid + 512 * q_, row_ = p_ >> 5, kc_ = p_ & 31; \
        int ir_ = 32 * P.rt + row_; if (ir_ > 510) ir_ = 510; const int tok_ = 4 * (ch) + (kc_ >> 3), d_ = 8 * (kc_ & 7); \
        araw[q_] = *(const u32x4*)(P.Hb + (size_t)(16 * ir_ + tok_) * HP + P.col + d_); \
        apos[q_][0] = *(const f32x4*)(P.pos + tok_ * 64 + d_); apos[q_][1] = *(const f32x4*)(P.pos + tok_ * 64 + d_ + 4); } } while (0)
#define CMP_AWRITE(bufi) do { _Pragma("unroll") for (int q_ = 0; q_ < 2; ++q_) { const int p_ = tid + 512 * q_, row_ = p_ >> 5, kc_ = p_ & 31; u32x4 aw_; \
        aw_.x = cvtpk(__uint_as_float(araw[q_].x << 16) + apos[q_][0][0], __uint_as_float(araw[q_].x & 0xffff0000u) + apos[q_][0][1]); \
        aw_.y = cvtpk(__uint_as_float(araw[q_].y << 16) + apos[q_][0][2], __uint_as_float(araw[q_].y & 0xffff0000u) + apos[q_][0][3]); \
        aw_.z = cvtpk(__uint_as_float(araw[q_].z << 16) + apos[q_][1][0], __uint_as_float(araw[q_].z & 0xffff0000u) + apos[q_][1][1]); \
        aw_.w = cvtpk(__uint_as_float(araw[q_].w << 16) + apos[q_][1][2], __uint_as_float(araw[q_].w & 0xffff0000u) + apos[q_][1][3]); \
        *(LAS u32x4*)(abuf + (bufi) * 16896 + row_ * 528 + kc_ * 16) = aw_; } } while (0)
    CMP_ALOAD(0); CMP_AWRITE(0);
    __syncthreads();
    for (int ch = 0; ch < 8; ++ch) {
        const int cn = ch + 1 < 8 ? ch + 1 : ch;
        CMP_ALOAD(cn);
        const LAS unsigned char* ab = abuf + (ch & 1) * 16896 + (lane & 31) * 528 + 16 * h;
        bf16x8 bfr[16];
#pragma unroll
        for (int ks = 0; ks < 16; ++ks) bfr[ks] = *(const bf16x8*)(w1p + (ch * 16 + ks) * 512);
#pragma unroll
        for (int ks = 0; ks < 16; ++ks) {
            const bf16x8 af = *(const LAS bf16x8*)(ab + 32 * ks);
            acc = __builtin_amdgcn_mfma_f32_32x32x16_bf16(af, bfr[ks], acc, 0, 0, 0);
        }
        CMP_AWRITE((ch + 1) & 1);
        __syncthreads();
    }
#undef CMP_ALOAD
#undef CMP_AWRITE
    {
        const int j = 32 * w + (lane & 31); const float bb = P.b1[j];
#pragma unroll
        for (int r = 0; r < 16; ++r) {
            const float x = acc[r] + bb;
            const float u = 0.7978845608028654f * (x + 0.044715f * x * x * x);
            const float th = 1.f - 2.f / (1.f + __expf(2.f * u));
            const float gl = 0.5f * x * (1.f + th);
            *(LAS bf16_t*)(hidl + crow(r, h) * 528 + j * 2) = f2bf(gl);
        }
    }
    __syncthreads();
    float outv[16]; float ssp[16];
    if (w < 2) {
        f32x16 a2 = (f32x16){};
        const bf16_t* w2p = P.W2T + (size_t)(32 * w + (lane & 31)) * 256 + 8 * h;
#pragma unroll
        for (int ks = 0; ks < 16; ++ks) {
            const bf16x8 af = *(const LAS bf16x8*)(hidl + (lane & 31) * 528 + (16 * ks + 8 * h) * 2);
            const bf16x8 bfr = *(const bf16x8*)(w2p + 16 * ks);
            a2 = __builtin_amdgcn_mfma_f32_32x32x16_bf16(af, bfr, a2, 0, 0, 0);
        }
        const float bb = P.b2[32 * w + (lane & 31)];
#pragma unroll
        for (int r = 0; r < 16; ++r) {
            outv[r] = a2[r] + bb;
            float ss = outv[r] * outv[r];
            ss += __shfl_xor(ss, 1); ss += __shfl_xor(ss, 2); ss += __shfl_xor(ss, 4); ss += __shfl_xor(ss, 8); ss += __shfl_xor(ss, 16);
            ssp[r] = ss;
            if ((lane & 31) == 0) ssx[w * 32 + crow(r, h)] = ss;
        }
    }
    __syncthreads();
    if (w < 2) {
        const int d = 32 * w + (lane & 31);
        const float gn = P.gain ? P.gain[d] : 1.f;
#pragma unroll
        for (int r = 0; r < 16; ++r) {
            const int row = 32 * P.rt + crow(r, h);
            float v = outv[r];
            if (P.gain) { const float tot = ssx[crow(r, h)] + ssx[32 + crow(r, h)]; v = v * rsqrtf(tot * (1.f / 64.f) + 1e-6f) * gn; }
            if (row <= 510) P.OUT[(size_t)row * 64 + d] = f2bf(v);
        }
    }
    __syncthreads();
}

struct NsaArgs {
    const bf16_t* Hb; size_t brow; int qb;
    const bf16_t* KC; const bf16_t* VC;
    const float* bias;
    const float* Mv;
    bf16_t* Y; unsigned* cdone;
    float* scr;
};
constexpr int GTOP = 2015, GTS = 2519, WTOP = 549, WTS = 588, DEAD = 4 * GTS + 4 * WTS;
__device__ __forceinline__ void nsa_unit(LAS unsigned char* lds, const NsaArgs& P) {
    const int tid = opq(threadIdx.x), lane = tid & 63, w = __builtin_amdgcn_readfirstlane(tid >> 6), hh = lane >> 5;
    const int n = lane & 31, q8 = n >> 2, hd = n & 3;
    LAS float* tg = (LAS float*)(lds + L_TAB);
    LAS float* tw = tg + 4 * GTS;
    LAS float* dead = tg + DEAD;
    LAS float* impw = (LAS float*)(lds + L_IMP) + w * 1024;
    LAS unsigned* selw = (LAS unsigned*)(lds + L_SEL) + w * 32;
    LAS unsigned* uni = (LAS unsigned*)(lds + L_SEL) + 256;
    LAS float* ws_ = (LAS float*)(lds + L_WSCR) + w * 256;
    LAS float* sbh = (LAS float*)(lds + L_SB);
    if (tid < 128) sbh[tid] = (P.bias[(tid & 31) * 16 + (tid >> 5)] - P.Mv[tid >> 5]) * LOG2E;
    __syncthreads();
    for (int e = tid; e < 4 * GTS; e += 512) { const int hq = e / GTS, j = e % GTS, dist = GTOP - j;
        tg[e] = dist >= 0 ? sbh[hq * 32 + t5_bucket(dist)] : -1e30f; }
    for (int e = tid; e < 4 * WTS; e += 512) { const int hq = e / WTS, j = e % WTS, dist = WTOP - j;
        tw[e] = (dist >= 0 && dist <= 511) ? sbh[hq * 32 + t5_bucket(dist)] : -1e30f; }
    if (tid < 64) dead[tid] = -1e30f;
    if (tid < 4) uni[tid] = 0u;
    const float cfar = sbh[hd * 32 + 31];
    const int tq = 64 * P.qb + 8 * w + q8;
    const int twmin = 64 * P.qb + 8 * w, twmax = twmin + 7;
    bf16x8 qf[4];
    {
        const bf16_t* qp = P.Hb + (size_t)tq * HP + C_DQ + 64 * hd + 8 * hh;
#pragma unroll
        for (int s = 0; s < 4; ++s) qf[s] = *(const bf16x8*)(qp + 16 * s);
        asm volatile("" : "+v"(qf[0]), "+v"(qf[1]), "+v"(qf[2]), "+v"(qf[3]));
    }
    {
        const bf16_t* gp = P.Hb + (size_t)tq * HP + C_GT + 3 * hd;
        if (hh == 0) { ws_[n] = bf2f(gp[0]); ws_[32 + n] = bf2f(gp[1]); ws_[64 + n] = bf2f(gp[2]); }
    }
    const int srow = tid >> 3, sch = tid & 7;
    StageRegs sr;
    f32x16 o[2], outv[2];
    float den = 0.f;
    o[0] = (f32x16){}; o[1] = (f32x16){};
    {
        const int kt0 = P.qb >= 8 ? P.qb - 8 : 0, nkt = P.qb - kt0 + 1;
        {
            const bf16_t* rp = P.Hb + (size_t)(64 * kt0 + srow) * HP;
            stage_load(sr, rp + C_KW, rp + C_VW, true, sch);
            stage_write(lds + L_KV, sr, srow, sch);
        }
        __syncthreads();
        for (int t = 0; t < nkt; ++t) {
            LAS unsigned char* buf = lds + L_KV + (t & 1) * KVB;
            if (t + 1 < nkt) { const bf16_t* rp = P.Hb + (size_t)(64 * (kt0 + t + 1) + srow) * HP; stage_load(sr, rp + C_KW, rp + C_VW, true, sch); }
#pragma unroll
            for (int sub = 0; sub < 2; ++sub) {
                const int kb = 64 * (kt0 + t) + 32 * sub;
                if (kb <= twmax && kb + 31 >= twmin - 511) {
                    f32x16 acc;
                    const LAS float* tb = tw + hd * WTS + (WTOP - (tq - kb - 4 * hh));
#pragma unroll
                    for (int r = 0; r < 16; ++r) acc[r] = tb[(r & 3) + 8 * (r >> 2)];
                    qk_sub<0, 4>(acc, buf, sub, qf, lane);
#pragma unroll
                    for (int r = 0; r < 1; ++r) den += exp_sum16(acc);
                    bf16x8 pa0, pa1; pack_p(acc, pa0, pa1);
                    pv_sub(o, buf, sub, pa0, pa1, lane);
                }
            }
            if (t + 1 < nkt) stage_write(lds + L_KV + ((t + 1) & 1) * KVB, sr, srow, sch);
            __syncthreads();
        }
    }
    {
        const float dt = den + __shfl_xor(den, 32);
        if (hh == 0) ws_[128 + n] = __builtin_amdgcn_rcpf(dt);
        asm volatile("s_waitcnt lgkmcnt(0)" ::: "memory");
#pragma unroll
        for (int r = 0; r < 16; ++r) { const int nn = crow(r, hh); const float gi = ws_[64 + nn] * ws_[128 + nn]; outv[0][r] = o[0][r] * gi; outv[1][r] = o[1][r] * gi; }
    }
    if (opq(threadIdx.x) == 128) {
        unsigned sp = 0;
        while (__hip_atomic_load(P.cdone, __ATOMIC_RELAXED, __HIP_MEMORY_SCOPE_AGENT) < 64u) { __builtin_amdgcn_s_sleep(2); if (++sp > (1u << 24)) break; }
        __builtin_amdgcn_fence(__ATOMIC_ACQUIRE, "agent"); asm volatile("s_waitcnt vmcnt(0)" ::: "memory");
    }
    __syncthreads();
    const int tlast = 64 * P.qb + 63;
    const int ntc = tlast >= 31 ? (((tlast - 31) >> 4) >> 6) + 1 : 0;
    float invden = 0.f; den = 0.f;
    o[0] = (f32x16){}; o[1] = (f32x16){};
    if (ntc > 0) {
        u32x4 kreg[8];
#pragma unroll
        for (int t = 0; t < 8; ++t) { const int tt = t < ntc ? t : 0; kreg[t] = *(const u32x4*)(P.KC + (size_t)(64 * tt + srow) * 64 + sch * 8); }
#pragma unroll
        for (int t = 0; t < 8; ++t) *(LAS u32x4*)(lds + (t < 4 ? L_KV + t * 8192 : L_IMP + (t - 4) * 8192) + srow * 128 + ((sch ^ (srow & 7)) << 4)) = kreg[t];
        __syncthreads();
#pragma unroll 1
        for (int t = 0; t < ntc; ++t) {
            const LAS unsigned char* buf = lds + (t < 4 ? L_KV + t * 8192 : L_IMP + (t - 4) * 8192);
#pragma unroll
            for (int sub = 0; sub < 2; ++sub) {
                const int cb = 64 * t + 32 * sub;
                if (16 * cb + 31 <= twmax) {
                    f32x16 acc;
                    const int dmin = twmin - 16 * (cb + 31) - 31;
                    if (dmin >= 1513) acc = splat16(cfar);
                    else {
                        const LAS float* tb = tg + hd * GTS + (GTOP - (tq - 31 - 16 * cb - 64 * hh));
#pragma unroll
                        for (int r = 0; r < 16; ++r) acc[r] = tb[16 * ((r & 3) + 8 * (r >> 2))];
                    }
                    qk_sub<0, 4>(acc, buf, sub, qf, lane);
                    den += exp_sum16(acc);
                }
            }
        }
        __syncthreads();
    }
    { const float dt = den + __shfl_xor(den, 32); invden = dt > 0.f ? 1.f / dt : 0.f; }
    for (int e = lane; e < 1024; e += 64) impw[e] = 0.f;
    {
        if (ntc > 0) {
            __syncthreads();
            stage_load(sr, P.KC + (size_t)srow * 64, P.VC + (size_t)srow * 64, true, sch);
            stage_write(lds + L_KV, sr, srow, sch);
            __syncthreads();
            for (int t = 0; t < ntc; ++t) {
                LAS unsigned char* buf = lds + L_KV + (t & 1) * KVB;
                if (t + 1 < ntc) stage_load(sr, P.KC + (size_t)(64 * (t + 1) + srow) * 64, P.VC + (size_t)(64 * (t + 1) + srow) * 64, true, sch);
#pragma unroll
                for (int sub = 0; sub < 2; ++sub) {
                    const int cb = 64 * t + 32 * sub;
                    if (16 * cb + 31 <= twmax) {
                        f32x16 acc;
                        const int dmin = twmin - 16 * (cb + 31) - 31;
                        if (dmin >= 1513) acc = splat16(cfar);
                        else {
                            const LAS float* tb = tg + hd * GTS + (GTOP - (tq - 31 - 16 * cb - 64 * hh));
#pragma unroll
                            for (int r = 0; r < 16; ++r) acc[r] = tb[16 * ((r & 3) + 8 * (r >> 2))];
                        }
                        qk_sub<0, 4>(acc, buf, sub, qf, lane);
#pragma unroll
                        for (int r = 0; r < 16; ++r) acc[r] = __builtin_amdgcn_exp2f(acc[r]) * invden;
#pragma unroll
                        for (int g = 0; g < 4; ++g) {
                            float G = (acc[4 * g] + acc[4 * g + 1]) + (acc[4 * g + 2] + acc[4 * g + 3]), C = acc[4 * g + 3];
                            G += dpp_f<DPP_XOR1>(G); G += dpp_f<DPP_XOR2>(G); C += dpp_f<DPP_XOR1>(C); C += dpp_f<DPP_XOR2>(C);
                            if (hd == 0) {
                                const int j = (cb >> 2) + 2 * g + hh;
                                __hip_atomic_fetch_add(impw + q8 * 128 + j, G, __ATOMIC_RELAXED, __HIP_MEMORY_SCOPE_WORKGROUP);
                                if (j + 1 < 128) __hip_atomic_fetch_add(impw + q8 * 128 + j + 1, C, __ATOMIC_RELAXED, __HIP_MEMORY_SCOPE_WORKGROUP);
                            }
                        }
                        bf16x8 pa0, pa1; pack_p(acc, pa0, pa1);
                        pv_sub(o, buf, sub, pa0, pa1, lane);
                    }
                }
                if (t + 1 < ntc) stage_write(lds + L_KV + ((t + 1) & 1) * KVB, sr, srow, sch);
                __syncthreads();
            }
        }
    }
    asm volatile("s_waitcnt lgkmcnt(0)" ::: "memory");
#pragma unroll
    for (int r = 0; r < 16; ++r) { const float g0 = ws_[crow(r, hh)]; outv[0][r] += o[0][r] * g0; outv[1][r] += o[1][r] * g0; }
    {
        float* sp = P.scr + tid;
#pragma unroll
        for (int r = 0; r < 16; ++r) { sp[r * 512] = outv[0][r]; sp[(16 + r) * 512] = outv[1][r]; }
    }
    {
        const int qsel = lane >> 3, sb = lane & 7;
        unsigned key[16];
#pragma unroll
        for (int i4 = 0; i4 < 4; ++i4) {
            const f32x4 v = *(const LAS f32x4*)(impw + qsel * 128 + sb * 16 + 4 * i4);
#pragma unroll
            for (int e = 0; e < 4; ++e) {
                const int j = sb * 16 + 4 * i4 + e;
                const bool forced = (j == 0) | (j == P.qb) | (j == P.qb - 1);
                key[4 * i4 + e] = forced ? 0xFFFFFFFFu : (j <= P.qb ? __float_as_uint(v[e]) + 1u : 0u);
            }
        }
        unsigned T = 0u;
        for (int bit = 31; bit >= 0; --bit) {
            const unsigned cand = T | (1u << bit);
            int cnt = 0;
#pragma unroll
            for (int i = 0; i < 16; ++i) cnt += key[i] >= cand ? 1 : 0;
            cnt += dpp_i<DPP_XOR1>(cnt); cnt += dpp_i<DPP_XOR2>(cnt); cnt += dpp_i<DPP_HMIRROR>(cnt);
            if (cnt >= 16) T = cand;
        }
        int cgt = 0, ceq = 0;
#pragma unroll
        for (int i = 0; i < 16; ++i) { cgt += key[i] > T ? 1 : 0; ceq += key[i] == T ? 1 : 0; }
        int cg = cgt; cg += dpp_i<DPP_XOR1>(cg); cg += dpp_i<DPP_XOR2>(cg); cg += dpp_i<DPP_HMIRROR>(cg);
        int pre = 0;
#pragma unroll
        for (int k = 0; k < 8; ++k) { const int v = __shfl(ceq, (lane & ~7) + k); if (k < sb) pre += v; }
        int need = 16 - cg - pre;
        unsigned bits = 0u;
#pragma unroll
        for (int i = 0; i < 16; ++i) {
            const int j = sb * 16 + i;
            bool s_ = key[i] > T;
            if (key[i] == T) { if (need > 0) { s_ = true; } --need; }
            if (s_ && j <= P.qb) bits |= 1u << i;
        }
        const unsigned other = __shfl_xor(bits, 1);
        const unsigned word = (sb & 1) ? ((bits << 16) | other) : (bits | (other << 16));
        if ((sb & 1) == 0) { selw[qsel * 4 + (sb >> 1)] = word; __hip_atomic_fetch_or(uni + (sb >> 1), word, __ATOMIC_RELAXED, __HIP_MEMORY_SCOPE_WORKGROUP); }
    }
    __syncthreads();
    unsigned lm0 = selw[q8 * 4 + 0], lm1 = selw[q8 * 4 + 1], lm2 = selw[q8 * 4 + 2], lm3 = selw[q8 * 4 + 3];
    unsigned wm0 = 0, wm1 = 0, wm2 = 0, wm3 = 0;
#pragma unroll
    for (int k = 0; k < 8; ++k) { wm0 |= selw[k * 4 + 0]; wm1 |= selw[k * 4 + 1]; wm2 |= selw[k * 4 + 2]; wm3 |= selw[k * 4 + 3]; }
    wm0 = __builtin_amdgcn_readfirstlane(wm0); wm1 = __builtin_amdgcn_readfirstlane(wm1); wm2 = __builtin_amdgcn_readfirstlane(wm2); wm3 = __builtin_amdgcn_readfirstlane(wm3);
    const unsigned um0 = __builtin_amdgcn_readfirstlane(uni[0]), um1 = __builtin_amdgcn_readfirstlane(uni[1]), um2 = __builtin_amdgcn_readfirstlane(uni[2]), um3 = __builtin_amdgcn_readfirstlane(uni[3]);
#define NSA_WORD(a0, a1, a2, a3, j) ((j) < 32 ? (a0) : ((j) < 64 ? (a1) : ((j) < 96 ? (a2) : (a3))))
#define NSA_NEXT(j, res) do { int _j = (j); res = 128; while (_j < 128) { const unsigned _w = NSA_WORD(um0, um1, um2, um3, _j) >> (_j & 31); if (_w) { res = _j + __builtin_ctz(_w); break; } _j = (_j | 31) + 1; } } while (0)
    o[0] = (f32x16){}; o[1] = (f32x16){}; den = 0.f;
#define NSA_SLC_COMPUTE(JJ, BUF) do { \
        if ((NSA_WORD(wm0, wm1, wm2, wm3, (JJ)) >> ((JJ) & 31)) & 1u) { \
            const bool lsel = (NSA_WORD(lm0, lm1, lm2, lm3, (JJ)) >> ((JJ) & 31)) & 1u; \
            _Pragma("unroll") for (int sub = 0; sub < 2; ++sub) { \
                const int kb = 64 * (JJ) + 32 * sub; \
                if (kb <= twmax) { \
                    f32x16 acc; \
                    if (twmin - kb - 31 >= 1513) acc = splat16(lsel ? cfar : -1e30f); \
                    else { const LAS float* tb = lsel ? tg + hd * GTS + (GTOP - (tq - kb - 4 * hh)) : dead; \
                        _Pragma("unroll") for (int r = 0; r < 16; ++r) acc[r] = tb[(r & 3) + 8 * (r >> 2)]; } \
                    qk_sub<0, 4>(acc, (BUF), sub, qf, lane); \
                    den += exp_sum16(acc); \
                    bf16x8 pa0, pa1; pack_p(acc, pa0, pa1); \
                    pv_sub(o, (BUF), sub, pa0, pa1, lane); \
                } } } } while (0)
#define NSA_SLC_LOAD(JJ, SR) do { const bf16_t* rp_ = P.Hb + (size_t)(64 * (JJ) + srow) * HP; stage_load(SR, rp_ + C_KS, rp_ + C_VS, true, sch); } while (0)
    {
        LAS unsigned char* pb0 = lds + L_KV; LAS unsigned char* pb1 = lds + L_IMP;
        StageRegs a0, a1, b0, b1;
#define NSA_PAIR(prev, ra, rb) do { ra = 128; if ((prev) < 128) { NSA_NEXT((prev) + 1, ra); } rb = 128; if (ra < 128) { NSA_NEXT(ra + 1, rb); } } while (0)
#define NSA_SLC_LOADC(JJ, SR) do { const int jc_ = (JJ) < 128 ? (JJ) : 0; NSA_SLC_LOAD(jc_, SR); } while (0)
        int ca, cb_, n1a, n1b, n2a, n2b, n3a, n3b;
        NSA_NEXT(0, ca); cb_ = 128; if (ca < 128) { NSA_NEXT(ca + 1, cb_); }
        NSA_PAIR(cb_, n1a, n1b); NSA_PAIR(n1b, n2a, n2b);
        NSA_SLC_LOADC(ca, b0); NSA_SLC_LOADC(cb_, b1);
        NSA_SLC_LOADC(n1a, a0); NSA_SLC_LOADC(n1b, a1);
        stage_write(pb0, b0, srow, sch); stage_write(pb0 + KVB, b1, srow, sch);
        NSA_SLC_LOADC(n2a, b0); NSA_SLC_LOADC(n2b, b1);
        __syncthreads();
        for (;;) {
            NSA_SLC_COMPUTE(ca, pb0);
            if (cb_ < 128) NSA_SLC_COMPUTE(cb_, pb0 + KVB);
            stage_write(pb1, a0, srow, sch); stage_write(pb1 + KVB, a1, srow, sch);
            NSA_PAIR(n2b, n3a, n3b);
            NSA_SLC_LOADC(n3a, a0); NSA_SLC_LOADC(n3b, a1);
            __syncthreads();
            if (n1a >= 128) break;
            NSA_SLC_COMPUTE(n1a, pb1);
            if (n1b < 128) NSA_SLC_COMPUTE(n1b, pb1 + KVB);
            stage_write(pb0, b0, srow, sch); stage_write(pb0 + KVB, b1, srow, sch);
            int n4a, n4b; NSA_PAIR(n3b, n4a, n4b);
            NSA_SLC_LOADC(n4a, b0); NSA_SLC_LOADC(n4b, b1);
            __syncthreads();
            if (n2a >= 128) break;
            ca = n2a; cb_ = n2b; n1a = n3a; n1b = n3b; n2a = n4a; n2b = n4b;
        }
#undef NSA_PAIR
#undef NSA_SLC_LOADC
    }
#undef NSA_SLC_COMPUTE
#undef NSA_SLC_LOAD
    {
        const float dt = den + __shfl_xor(den, 32);
        if (hh == 0) ws_[96 + n] = 1.f / dt;
        asm volatile("s_waitcnt lgkmcnt(0)" ::: "memory");
        const float* sp = P.scr + tid;
#pragma unroll
        for (int r = 0; r < 16; ++r) { const float gi = ws_[32 + crow(r, hh)] * ws_[96 + crow(r, hh)]; outv[0][r] = sp[r * 512] + o[0][r] * gi; outv[1][r] = sp[(16 + r) * 512] + o[1][r] * gi; }
    }
    {
#pragma unroll
        for (int r = 0; r < 16; ++r) {
            const int nn = crow(r, hh);
            const size_t trow = (size_t)(64 * P.qb + 8 * w + (nn >> 2));
            const int ycol = 768 + 64 * (nn & 3);
            const bf16_t* sp = P.Hb + trow * HP + C_SILU + ycol;
            bf16_t* yp = P.Y + (P.brow + trow) * DM + ycol;
            yp[n] = f2bf(outv[0][r] * bf2f(sp[n]));
            yp[32 + n] = f2bf(outv[1][r] * bf2f(sp[32 + n]));
        }
    }
    __syncthreads();
#undef NSA_WORD
#undef NSA_NEXT
}
}

#define XB_TMO      128
#define XB_XCNT(j)  (256  + 64 * (j))
#define XB_XSUB(j)  (1280 + 64 * (j))
#define XB_XGEN(j)  (2304 + 64 * (j))
#define XB_TOP      3328
#define XB_TOPGEN   3392
#define XCD_BAR_WORDS 3456
#define XB_SPIN_CAP (1u << 22)
__device__ __forceinline__ unsigned xb_ld(unsigned* p)              { return __hip_atomic_load(p, __ATOMIC_RELAXED, __HIP_MEMORY_SCOPE_AGENT); }
__device__ __forceinline__ unsigned xb_add(unsigned* p, unsigned v) { return __hip_atomic_fetch_add(p, v, __ATOMIC_RELAXED, __HIP_MEMORY_SCOPE_AGENT); }
__device__ __forceinline__ unsigned xb_xcc_id() { return (unsigned)__builtin_amdgcn_s_getreg((3 << 11) | 20) & 0xFu; }
#define XB_SPIN(cond, bar) do { unsigned _sp = 0; while (cond) { __builtin_amdgcn_s_sleep(1); \
    if ((++_sp & 255u) == 0u) { if (xb_ld(&(bar)[XB_TMO])) break; if (_sp > XB_SPIN_CAP) { atomicAdd(&(bar)[XB_TMO], 1u); break; } } } } while (0)
struct XcdBarrier { unsigned* bar; unsigned x; volatile LAS unsigned* st; };
__device__ __forceinline__ XcdBarrier xcd_barrier_post(unsigned* bar, volatile LAS unsigned* st) {
    XcdBarrier b; b.bar = bar; b.x = xb_xcc_id(); b.st = st;
    if (threadIdx.x == 0) (void)xb_add(&bar[XB_XCNT(b.x)], 1u);
    return b;
}
__device__ __forceinline__ void xcd_barrier_complete(unsigned* bar, unsigned x, unsigned& nloc, unsigned& nx) {
    const unsigned G = gridDim.x * gridDim.y * gridDim.z;
    unsigned sum, cnt, mine, sp = 0u;
    for (;;) {
        sum = 0u; cnt = 0u; mine = 0u;
#pragma unroll
        for (unsigned j = 0; j < 16; ++j) { const unsigned c = xb_ld(&bar[XB_XCNT(j)]); sum += c; cnt += (c > 0u) ? 1u : 0u; mine = (j == x) ? c : mine; }
        if (sum == G) break;
        __builtin_amdgcn_s_sleep(1);
        if ((++sp & 255u) == 0u) { if (xb_ld(&bar[XB_TMO])) break; if (sp > XB_SPIN_CAP) { atomicAdd(&bar[XB_TMO], 1u); break; } }
    }
    nloc = mine > 0u ? mine : 1u; nx = cnt > 0u ? cnt : 1u;
}
__device__ __forceinline__ void xcd_barrier(const XcdBarrier& b) {
    asm volatile("s_waitcnt vmcnt(0)" ::: "memory");
    __syncthreads();
    if (threadIdx.x == 0) {
        unsigned* bar = b.bar;
        __builtin_amdgcn_s_waitcnt(0);
        unsigned nloc = b.st[0], nx = b.st[1];
        if (nloc == 0u) { xcd_barrier_complete(bar, b.x, nloc, nx); b.st[0] = nloc; b.st[1] = nx; }
        const unsigned old = xb_add(&bar[XB_XSUB(b.x)], 1u);
        const unsigned gen = old / nloc;
        if (old + 1u == (gen + 1u) * nloc) {
            __builtin_amdgcn_fence(__ATOMIC_RELEASE, "agent");
            asm volatile("s_waitcnt vmcnt(0)" ::: "memory");
            const unsigned og = xb_add(&bar[XB_TOP], 1u);
            const unsigned tg = og / nx;
            if (og + 1u == (tg + 1u) * nx) xb_add(&bar[XB_TOPGEN], 1u);
            else XB_SPIN(xb_ld(&bar[XB_TOPGEN]) == tg, bar);
            __builtin_amdgcn_fence(__ATOMIC_ACQUIRE, "agent");
            xb_add(&bar[XB_XGEN(b.x)], 1u);
            asm volatile("s_waitcnt vmcnt(0)" ::: "memory");
        } else {
            XB_SPIN(xb_ld(&bar[XB_XGEN(b.x)]) == gen, bar);
            __builtin_amdgcn_fence(__ATOMIC_ACQUIRE, "agent");
            asm volatile("s_waitcnt vmcnt(0)" ::: "memory");
        }
    }
    __syncthreads();
}

constexpr int NT = 512, LDS_BYTES = 147456, MISC_OFF = 131072 + 320;
#ifndef R_C
#define R_C 1
#endif
#ifndef R_D
#define R_D 1
#endif
#ifndef R_AB
#define R_AB 1
#endif
#ifndef R_G1
#define R_G1 1
#endif
constexpr size_t MiB = 1u << 20;
constexpr size_t WS_CTL = 0, CTL_ZERO_BYTES = 65536;
constexpr size_t WS_X1B = 158 * MiB;
constexpr size_t OUT_OA = 0, OUT_NSCR = 24 * MiB;
constexpr size_t WS_H = 2 * MiB, WS_XN = 124 * MiB, WS_T0 = 158 * MiB, WS_IMP = 208 * MiB, WS_SEL = 217 * MiB, WS_HID = 218 * MiB, WS_KC = 221 * MiB, WS_VC = 222 * MiB, WS_WIN = 224 * MiB, WS_WOUT = 240 * MiB, WS_MX = 1 * MiB, WS_DA = 245 * MiB, WS_CW1 = 246 * MiB, WS_CW2 = 250 * MiB, WS_RSS = 251 * MiB;

struct Args { const float* in[15]; float* out; unsigned char* ws; };

__global__ void __launch_bounds__(NT, 2) mega_fwd(Args args) {
    extern __shared__ __attribute__((aligned(16))) unsigned char lds[];
    const int tid = threadIdx.x, lane = tid & 63, wid = tid >> 6;
    const int G = gridDim.x, bid = blockIdx.x;
    volatile LAS unsigned* MISC = (volatile LAS unsigned*)((LAS unsigned char*)lds + MISC_OFF);
    if (tid < 32) MISC[tid] = 0u;
    __syncthreads();
    unsigned char* ws = args.ws;
    XcdBarrier bar = xcd_barrier_post((unsigned*)(ws + WS_CTL) + 4096, MISC + 8);
    const float* x = args.in[0]; const float* tab = args.in[1]; const float* norm_w = args.in[2];
    const float* w_in = args.in[3]; const float* w_out = args.in[4]; const float* qk_gain = args.in[5];
    const float* qk_gain_diff = args.in[6]; const float* sinks = args.in[7]; const float* diff_lambda = args.in[8];
    const float* diff_subln = args.in[9]; const float* cmp_pos = args.in[10]; const float* cmp_w1 = args.in[11];
    const float* cmp_b1 = args.in[12]; const float* cmp_w2 = args.in[13]; const float* cmp_b2 = args.in[14];
    float* out = args.out;
    bf16_t* H = (bf16_t*)(ws + WS_H);
    bf16_t* XN = (bf16_t*)(ws + WS_XN); bf16_t* Y = XN;
    float* T0 = (float*)(ws + WS_T0);
    float* OC = T0; float* OS_ = T0 + (size_t)MROWS * 256; float* OW = T0 + (size_t)MROWS * 512; float* CT = T0;
    float* IMP = (float*)(ws + WS_IMP); unsigned* SEL = (unsigned*)(ws + WS_SEL); float* HID = (float*)(ws + WS_HID);
    float* KC = (float*)(ws + WS_KC); float* VC = (float*)(ws + WS_VC);
    const int GT = G * NT, GW = G * 8;
    bf16_t* WinT = (bf16_t*)(ws + WS_WIN); bf16_t* WoutT = (bf16_t*)(ws + WS_WOUT);
#define GRID_BAR() do { XcdBarrier b2_ = bar; asm volatile("" : "+s"(b2_.x)); xcd_barrier(b2_); } while (0)
    {
        LAS float* scr = (LAS float*)((LAS unsigned char*)lds + wid * 16384);
        const int gw0 = bid * 8 + wid;
        constexpr int I_IN = 16 * 120, I_OUT = 16 * 32, I_C1 = 32 * 8, I_C2 = 4 * 2, I_L = I_IN + I_OUT + 2 * I_C1 + 2 * I_C2, NITEMS = 2 * I_L;
        bf16_t* CW1T = (bf16_t*)(ws + WS_CW1); bf16_t* CW2T = (bf16_t*)(ws + WS_CW2);
        for (int it = gw0; it < NITEMS; it += GW) {
            const int l = it / I_L; int r = it % I_L;
            if (r < I_IN) { p0_transpose_item<0>(w_in + (size_t)l * DM * PW, WinT + (size_t)l * HP * DM, scr, r, lane, 1024, 1024, norm_w + l * DM); continue; } r -= I_IN;
            if (r < I_OUT) { p0_transpose_item<1>(w_out + (size_t)l * DM * DM, WoutT + (size_t)l * DM * DM, scr, r, lane); continue; } r -= I_OUT;
            if (r < 2 * I_C1) { const int kv = r / I_C1; p0_transpose_item<2>(cmp_w1 + (size_t)(l * 2 + kv) * 2048 * 256, CW1T + (size_t)(l * 2 + kv) * 256 * 2048, scr, r % I_C1, lane, 2048, 256); continue; } r -= 2 * I_C1;
            { const int kv = r / I_C2; p0_transpose_item<1>(cmp_w2 + (size_t)(l * 2 + kv) * 256 * 64, CW2T + (size_t)(l * 2 + kv) * 64 * 256, scr, r % I_C2, lane, 256, 64); }
        }
        if (bid == 1 && tid < 256) { bf16_t* KCb = (bf16_t*)(ws + WS_KC); KCb[(size_t)(tid >> 6) * 512 * 64 + 511 * 64 + (tid & 63)] = 0; }
        for (int w = gw0; w < MROWS; w += 4 * GW) k_rmsnorm<4>(w, GW, lane, x, XN);
        for (int v = bid * NT + tid; v < MROWS; v += GT) ((unsigned long long*)(ws + WS_RSS))[v] = 0ull;
        if (bid < 4) {
            float* MX = (float*)(ws + WS_MX);
            const int idx = bid * 8 + wid, l = idx >> 4, gh = idx & 15;
            float red[11];
#pragma unroll
            for (int i = 0; i < 8; ++i) red[i] = fabsf(qk_gain[l * 512 + i * 64 + lane]);
            red[8] = lane < 32 ? fabsf(qk_gain_diff[l * 64 + lane]) : 0.f; red[9] = lane < 32 ? fabsf(qk_gain_diff[l * 64 + 32 + lane]) : 0.f;
            red[10] = lane < 32 ? fabsf(tab[lane * 16 + gh]) : 0.f;
            float s1 = lane < 32 ? diff_lambda[l * 128 + lane] * diff_lambda[l * 128 + 32 + lane] : 0.f;
            float s2 = lane < 32 ? diff_lambda[l * 128 + 64 + lane] * diff_lambda[l * 128 + 96 + lane] : 0.f;
            const float snk = sinks[l * 4 + (gh & 3)];
#pragma unroll
            for (int o = 1; o < 64; o <<= 1) {
#pragma unroll
                for (int i = 0; i < 11; ++i) red[i] = fmaxf(red[i], __shfl_xor(red[i], o));
                s1 += __shfl_xor(s1, o); s2 += __shfl_xor(s2, o);
            }
            const int grp = gh >> 2; const float mb = red[10]; float Mv;
            if (grp == 0) Mv = 8.f * red[0] * red[1] + mb;
            else if (grp == 1) Mv = fmaxf(8.f * red[2] * red[3] + mb, snk);
            else if (grp == 2) Mv = 5.656854249f * red[8] * red[9] + mb;
            else Mv = 8.f * red[4] * fmaxf(red[5], fmaxf(red[6], red[7])) + mb;
            if (lane == 0) MX[l * 16 + gh] = Mv;
            if (gh == 0 && lane == 0) { const float lambda_init = 0.8f - 0.6f * expf(-0.3f * (float)l); MX[32 + l] = expf(s1) - expf(s2) + lambda_init; MX[34 + l] = lambda_init; }
        }
    }
    GRID_BAR();
#pragma unroll 1
    for (int l = 0; l < 2; ++l) {
        bf16_t* X1B = (bf16_t*)(ws + WS_X1B);
        { pg8::Gemm g{l == 0 ? XN : X1B, WinT + (size_t)l * HP * DM, MROWS, HP, DM}; pg8::StaticOrder So; So.init(MROWS, HP, G, bid);
          pg8::EpiProj E{H, qk_gain + l * 512, qk_gain_diff + l * 64, l == 0 ? nullptr : (const float*)(ws + WS_RSS)};
          for (int rep = 0; rep < R_G1; ++rep) pg8::gemm_phase<pg8::EpiProj, pg8::StaticOrder, true, true>((LAS unsigned char*)lds, g, So, E); }
        GRID_BAR();
        {
            const float* MX = (const float*)(ws + WS_MX);
            bf16_t* OA = (bf16_t*)((unsigned char*)out + OUT_OA); float* DA = (float*)(ws + WS_DA);
            bf16_t* KCb = (bf16_t*)(ws + WS_KC);
            const bf16_t* CW1T = (const bf16_t*)(ws + WS_CW1); const bf16_t* CW2T = (const bf16_t*)(ws + WS_CW2);
            LAS unsigned* qw = (LAS unsigned*)((LAS unsigned char*)lds + att::L_Q);
            unsigned* qctr = (unsigned*)(ws + WS_CTL) + 8192 + 128 * l;
            unsigned* cdone = qctr + 64;
            constexpr int B0 = 64, B1 = B0 + 160 * R_C, B2 = B1 + 256 * R_D, B3 = B2 + 96 * R_C, B4 = B3 + 768 * R_AB, NUV = B4 + 256 * R_AB;
            for (;;) {
                if (opq(threadIdx.x) == 0) *qw = atomicAdd(qctr, 1u);
                __syncthreads();
                const int uv = (int)*qw;
                __syncthreads();
                if (uv >= NUV) break;
                int u;
                if (uv < B0) u = uv; else if (uv < B1) u = 64 + (uv - B0) / R_C; else if (uv < B2) u = 224 + (uv - B1) / R_D; else if (uv < B3) u = 480 + (uv - B2) / R_C;
                else if (uv < B4) u = 576 + (uv - B3) / R_AB; else u = 1344 + (uv - B4) / R_AB;
                if (u < 64) {
                    const int kv = u >> 5, b = (u >> 4) & 1, rt = u & 15;
                    att::CmpArgs P; P.Hb = H + (size_t)b * S * HP; P.col = kv == 0 ? C_KC : C_VC; P.rt = rt;
                    P.pos = cmp_pos + (size_t)(l * 2 + kv) * 2048; P.W1T = CW1T + (size_t)(l * 2 + kv) * 256 * 2048; P.b1 = cmp_b1 + (l * 2 + kv) * 256;
                    P.W2T = CW2T + (size_t)(l * 2 + kv) * 64 * 256; P.b2 = cmp_b2 + (l * 2 + kv) * 64; P.gain = kv == 0 ? qk_gain + l * 512 + 5 * 64 : nullptr;
                    P.OUT = KCb + (size_t)(kv * NB + b) * 512 * 64;
                    att::cmp_unit((LAS unsigned char*)lds, P);
                    asm volatile("s_waitcnt vmcnt(0)" ::: "memory");
                    __syncthreads();
                    if (opq(threadIdx.x) == 64) { __builtin_amdgcn_fence(__ATOMIC_RELEASE, "agent"); asm volatile("s_waitcnt vmcnt(0)" ::: "memory");
                        __hip_atomic_fetch_add(cdone, 1u, __ATOMIC_RELAXED, __HIP_MEMORY_SCOPE_AGENT); }
                    __syncthreads();
                } else if ((u >= 64 && u < 224) || (u >= 480 && u < 576)) {
                    int qb, bh;
                    if (u < 224) { qb = 31 - ((u - 64) >> 3); bh = (u - 64) & 7; } else { qb = 11 - ((u - 480) >> 3); bh = (u - 480) & 7; }
                    const int b = bh >> 2, hd = bh & 3;
                    att::DiffArgs P; P.Hb = H + (size_t)b * S * HP; P.hd = hd; P.qb = qb; P.brow = (size_t)b * S;
                    P.bias = tab + 8 + hd; P.M = MX[l * 16 + 8 + hd]; P.lam = MX[32 + l]; P.lambda_init = MX[34 + l]; P.subln = diff_subln + l * 64; P.Y = Y;
                    att::diff_unit((LAS unsigned char*)lds, P);
                } else if (u < 480) {
                    const int idx = u - 224, qb64 = 127 - (idx >> 1), b = idx & 1;
                    att::NsaArgs P; P.Hb = H + (size_t)b * S * HP; P.brow = (size_t)b * S; P.qb = qb64;
                    P.KC = KCb + (size_t)(0 * NB + b) * 512 * 64; P.VC = KCb + (size_t)(1 * NB + b) * 512 * 64;
                    P.bias = tab + 12; P.Mv = MX + l * 16 + 12; P.Y = Y; P.cdone = cdone; P.scr = (float*)((unsigned char*)out + OUT_NSCR) + (size_t)bid * 16384;
                    att::nsa_unit((LAS unsigned char*)lds, P);
                } else if (u < 1344) {
                    const int v = u - 576, cfg = v >> 8, b = (v >> 7) & 1, hd = (v >> 5) & 3, ti = v & 31;
                    const int rate = cfg == 0 ? 1 : (cfg == 1 ? 4 : 16), tpc = 32 / rate;
                    att::BandArgs P; P.Hb = H + (size_t)b * S * HP; P.cq = C_AQ + 64 * hd; P.ck = C_AK + 64 * hd; P.cv = C_AV + 64 * hd;
                    P.rate = rate; P.cls = ti / tpc; P.f0 = (ti % tpc) * 256; P.maxd = 128; P.bias = tab + hd; P.M = MX[l * 16 + hd]; P.sinkterm = 0.f;
                    P.OA = OA + (size_t)cfg * MROWS * 256; P.DA = DA + (size_t)cfg * MROWS * 4; P.Y = nullptr; P.ycol = 0; P.hd = hd; P.brow = (size_t)b * S;
                    att::banded_unit<0>((LAS unsigned char*)lds, P);
                } else {
                    const int v = u - 1344, b = (v >> 7) & 1, hd = (v >> 5) & 3, ti = v & 31;
                    att::BandArgs P; P.Hb = H + (size_t)b * S * HP; P.cq = C_BQ + 64 * hd; P.ck = C_BK + 64 * (hd >> 1); P.cv = C_BV + 64 * (hd >> 1);
                    P.rate = 1; P.cls = 0; P.f0 = ti * 256; P.maxd = 127; P.bias = tab + 4 + hd; P.M = MX[l * 16 + 4 + hd];
                    P.sinkterm = __expf(sinks[l * 4 + hd] - P.M);
                    P.OA = nullptr; P.DA = nullptr; P.Y = Y; P.ycol = 256 + 64 * hd; P.hd = hd; P.brow = (size_t)b * S;
                    att::banded_unit<1>((LAS unsigned char*)lds, P);
                }
            }
        }
        GRID_BAR();
        {
            const bf16_t* OA = (const bf16_t*)((unsigned char*)out + OUT_OA); const float* DA = (const float*)(ws + WS_DA);
            for (int v = (bid * NT + opq(threadIdx.x)); v < MROWS * 32; v += GT) {
                const int row = v >> 5, hd = (v >> 3) & 3, c8 = v & 7;
                float acc8[8] = {0.f, 0.f, 0.f, 0.f, 0.f, 0.f, 0.f, 0.f}; float dsum = 0.f;
#pragma unroll
                for (int cfg = 0; cfg < 3; ++cfg) {
                    const float dn = DA[((size_t)cfg * MROWS + row) * 4 + hd]; dsum += dn;
                    const uint4 r4 = *(const uint4*)(OA + ((size_t)cfg * MROWS + row) * 256 + hd * 64 + c8 * 8);
                    acc8[0] += dn * __uint_as_float(r4.x << 16); acc8[1] += dn * __uint_as_float(r4.x & 0xffff0000u);
                    acc8[2] += dn * __uint_as_float(r4.y << 16); acc8[3] += dn * __uint_as_float(r4.y & 0xffff0000u);
                    acc8[4] += dn * __uint_as_float(r4.z << 16); acc8[5] += dn * __uint_as_float(r4.z & 0xffff0000u);
                    acc8[6] += dn * __uint_as_float(r4.w << 16); acc8[7] += dn * __uint_as_float(r4.w & 0xffff0000u);
                }
                const float inv = 1.f / dsum;
                const uint4 s4 = *(const uint4*)(H + (size_t)row * HP + C_SILU + hd * 64 + c8 * 8);
                uint4 o4;
                o4.x = (unsigned)f2bf(acc8[0] * inv * __uint_as_float(s4.x << 16)) | ((unsigned)f2bf(acc8[1] * inv * __uint_as_float(s4.x & 0xffff0000u)) << 16);
                o4.y = (unsigned)f2bf(acc8[2] * inv * __uint_as_float(s4.y << 16)) | ((unsigned)f2bf(acc8[3] * inv * __uint_as_float(s4.y & 0xffff0000u)) << 16);
                o4.z = (unsigned)f2bf(acc8[4] * inv * __uint_as_float(s4.z << 16)) | ((unsigned)f2bf(acc8[5] * inv * __uint_as_float(s4.z & 0xffff0000u)) << 16);
                o4.w = (unsigned)f2bf(acc8[6] * inv * __uint_as_float(s4.w << 16)) | ((unsigned)f2bf(acc8[7] * inv * __uint_as_float(s4.w & 0xffff0000u)) << 16);
                *(uint4*)(Y + (size_t)row * DM + hd * 64 + c8 * 8) = o4;
            }
        }
        GRID_BAR();
        { pg8::Gemm g{Y, WoutT + (size_t)l * DM * DM, MROWS, DM, DM}; pg8::StaticOrder So; So.init(MROWS, DM, G, bid);
          pg8::EpiOut E{l == 0 ? x : nullptr, X1B, out, (LAS float*)((LAS unsigned char*)lds + 132096), X1B, (float*)(ws + WS_RSS)};
          pg8::gemm_phase<pg8::EpiOut, pg8::StaticOrder, true, true>((LAS unsigned char*)lds, g, So, E); }
        if (l == 0) GRID_BAR();
    }
}

extern "C" void kernel_launch(void* const* d_in, const int* in_sizes, int n_in, void* d_out, int out_size, void* d_ws, size_t ws_size, hipStream_t stream) {
    static int grid = 0;
    if (grid == 0) {
        int dev = 0, cus = 0;
        (void)hipGetDevice(&dev);
        (void)hipDeviceGetAttribute(&cus, hipDeviceAttributeMultiprocessorCount, dev);
        (void)hipFuncSetAttribute((const void*)mega_fwd, hipFuncAttributeMaxDynamicSharedMemorySize, LDS_BYTES);
        grid = cus > 0 ? cus : 256;
    }
    (void)hipMemsetAsync((char*)d_ws + WS_CTL, 0, CTL_ZERO_BYTES, stream);
    Args a{};
    for (int i = 0; i < 15; ++i) a.in[i] = (const float*)d_in[i];
    a.out = (float*)d_out; a.ws = (unsigned char*)d_ws;
    hipLaunchKernelGGL(mega_fwd, dim3(grid), dim3(NT), LDS_BYTES, stream, a);
}
```

```cpp
#include <hip/hip_runtime.h>
#include <stdint.h>
#include <math.h>

typedef unsigned short bf16_t;
__device__ __forceinline__ float bf2f(bf16_t v) { return __uint_as_float((unsigned)v << 16); }
__device__ __forceinline__ bf16_t f2bf(float f) { unsigned u = __float_as_uint(f); return (bf16_t)((u + 0x7fffu + ((u >> 16) & 1u)) >> 16); }

constexpr int NB = 2, S = 8192, DM = 1024, MROWS = NB * S, PW = 3724, HP = 3840;
constexpr int C_AQ = 0, C_AK = 256, C_AV = 512, C_BQ = 768, C_BK = 1024, C_BV = 1152, C_CQ = 1280, C_CK = 1536, C_CV = 1792,
              C_DQ = 2048, C_KC = 2304, C_VC = 2368, C_KS = 2432, C_VS = 2496, C_KW = 2560, C_VW = 2624, C_GT = 2688, C_SILU = 2816;
constexpr float EPS = 1e-6f;
__device__ __forceinline__ int opq(int v) { asm volatile("" : "+v"(v)); return v; }

__device__ __forceinline__ int t5_bucket(int n) {
    if (n < 16) return n < 0 ? 0 : n;
    int b = 16;
    b += (n >= 22); b += (n >= 30); b += (n >= 40); b += (n >= 54); b += (n >= 73); b += (n >= 99); b += (n >= 134); b += (n >= 182);
    b += (n >= 246); b += (n >= 332); b += (n >= 450); b += (n >= 609); b += (n >= 825); b += (n >= 1117); b += (n >= 1513);
    return b;
}

template <int R>
__device__ __forceinline__ void k_rmsnorm(const int row0, const int stride, const int lane, const float* __restrict__ x, bf16_t* __restrict__ xn) {
    float4 v[R][4]; float ss[R];
#pragma unroll
    for (int r = 0; r < R; ++r) {
        const int row = row0 + r * stride < MROWS ? row0 + r * stride : MROWS - 1;
        const float4* xr = (const float4*)(x + (size_t)row * DM);
#pragma unroll
        for (int j = 0; j < 4; ++j) v[r][j] = xr[lane + 64 * j];
    }
#pragma unroll
    for (int r = 0; r < R; ++r) {
        ss[r] = 0.f;
#pragma unroll
        for (int j = 0; j < 4; ++j) ss[r] += (v[r][j].x * v[r][j].x + v[r][j].y * v[r][j].y) + (v[r][j].z * v[r][j].z + v[r][j].w * v[r][j].w);
    }
#pragma unroll
    for (int o = 1; o < 64; o <<= 1) {
#pragma unroll
        for (int r = 0; r < R; ++r) ss[r] += __shfl_xor(ss[r], o);
    }
#pragma unroll
    for (int r = 0; r < R; ++r) {
        const int row = row0 + r * stride;
        if (row >= MROWS) break;
        const float rstd = rsqrtf(ss[r] * (1.f / DM) + EPS);
#pragma unroll
        for (int j = 0; j < 4; ++j) {
            uint2 o; o.x = (unsigned)f2bf(v[r][j].x * rstd) | ((unsigned)f2bf(v[r][j].y * rstd) << 16);
            o.y = (unsigned)f2bf(v[r][j].z * rstd) | ((unsigned)f2bf(v[r][j].w * rstd) << 16);
            ((uint2*)(xn + (size_t)row * DM))[lane + 64 * j] = o;
        }
    }
}

template <int D>
__device__ __forceinline__ float dot_row(const float* q, const bf16_t* kr) {
    float s = 0.f;
#pragma unroll
    for (int c = 0; c < D / 8; ++c) {
        const uint4 r = *(const uint4*)(kr + 8 * c);
        s += q[8 * c + 0] * __uint_as_float(r.x << 16) + q[8 * c + 1] * __uint_as_float(r.x & 0xffff0000u);
        s += q[8 * c + 2] * __uint_as_float(r.y << 16) + q[8 * c + 3] * __uint_as_float(r.y & 0xffff0000u);
        s += q[8 * c + 4] * __uint_as_float(r.z << 16) + q[8 * c + 5] * __uint_as_float(r.z & 0xffff0000u);
        s += q[8 * c + 6] * __uint_as_float(r.w << 16) + q[8 * c + 7] * __uint_as_float(r.w & 0xffff0000u);
        if (c & 1) asm volatile("" ::: "memory");
    }
    return s;
}
__device__ __forceinline__ void os_step(float s, const bf16_t* vr, float& m, float& den, float* o) {
    const float mn = fmaxf(m, s), sc = __expf(m - mn), p = __expf(s - mn);
    den = den * sc + p; m = mn;
#pragma unroll
    for (int c = 0; c < 8; ++c) {
        const uint4 r = *(const uint4*)(vr + 8 * c);
        o[8 * c + 0] = o[8 * c + 0] * sc + p * __uint_as_float(r.x << 16); o[8 * c + 1] = o[8 * c + 1] * sc + p * __uint_as_float(r.x & 0xffff0000u);
        o[8 * c + 2] = o[8 * c + 2] * sc + p * __uint_as_float(r.y << 16); o[8 * c + 3] = o[8 * c + 3] * sc + p * __uint_as_float(r.y & 0xffff0000u);
        o[8 * c + 4] = o[8 * c + 4] * sc + p * __uint_as_float(r.z << 16); o[8 * c + 5] = o[8 * c + 5] * sc + p * __uint_as_float(r.z & 0xffff0000u);
        o[8 * c + 6] = o[8 * c + 6] * sc + p * __uint_as_float(r.w << 16); o[8 * c + 7] = o[8 * c + 7] * sc + p * __uint_as_float(r.w & 0xffff0000u);
        if (c & 1) asm volatile("" ::: "memory");
    }
}
template <int D>
__device__ __forceinline__ void load_q(float* q, const bf16_t* p) {
#pragma unroll
    for (int c = 0; c < D / 8; ++c) {
        const uint4 r = *(const uint4*)(p + 8 * c);
        q[8 * c + 0] = __uint_as_float(r.x << 16); q[8 * c + 1] = __uint_as_float(r.x & 0xffff0000u);
        q[8 * c + 2] = __uint_as_float(r.y << 16); q[8 * c + 3] = __uint_as_float(r.y & 0xffff0000u);
        q[8 * c + 4] = __uint_as_float(r.z << 16); q[8 * c + 5] = __uint_as_float(r.z & 0xffff0000u);
        q[8 * c + 6] = __uint_as_float(r.w << 16); q[8 * c + 7] = __uint_as_float(r.w & 0xffff0000u);
    }
}

#define LAS __attribute__((address_space(3)))
namespace pg8 {
#define PG8_LAS __attribute__((address_space(3)))
typedef unsigned short bf16_t;
typedef short bf16x8 __attribute__((ext_vector_type(8)));
typedef float f32x4 __attribute__((ext_vector_type(4)));
typedef unsigned u32x4 __attribute__((ext_vector_type(4)));
constexpr int BM = 256, BK = 64, HALF = 128, HTB = HALF * BK * 2  , STAGE_BYTES = 8 * HTB, NXCD = 8, WGM = 8;

__host__ __device__ __forceinline__ int lds_byte(int r, int c) { const int st = (r >> 4) * 2 + (c >> 5), rr = r & 15, cc = c & 31, ob = rr * 64 + cc * 2; return st * 1024 + (ob ^ (((ob >> 9) & 1) << 5)); }
__host__ __device__ __forceinline__ void stage_rc(int b, int& R, int& C) { const int st = b / 1024, sb = b % 1024, swz = sb ^ (((sb >> 9) & 1) << 5); R = (st >> 1) * 16 + swz / 64; C = (st & 1) * 32 + (swz % 64) / 2; }
__host__ __device__ __forceinline__ int perm32(int rho) { const int n = rho >> 4, i = rho & 15; return 8 * (i >> 2) + 4 * n + (i & 3); }

struct Unit { int pm, pn; };
struct Gemm { const bf16_t* A; const bf16_t* Bt; int M, N, K; };

struct StaticOrder {
    int nM, nN, nwg, G, c;
    __host__ __device__ void init(int M, int N, int G_, int c_) { nM = M / BM; nN = N / BM; nwg = nM * nN; G = G_; c = c_; }
    __host__ __device__ bool next(int i, Unit& u) const {
        const long L = (long)i * G + c; if (L >= nwg) return false;
        int wgid = (int)L; { const int q = nwg / NXCD, r = nwg % NXCD, xcd = wgid % NXCD, off = wgid / NXCD; wgid = (xcd < r ? xcd * (q + 1) : r * (q + 1) + (xcd - r) * q) + off; }
        const int nig = WGM * nN, gid = wgid / nig, fm = gid * WGM, gsz = (nM - fm) < WGM ? (nM - fm) : WGM;
        u.pm = fm + ((wgid % nig) % gsz); u.pn = (wgid % nig) / gsz; return true;
    }
    __device__ __forceinline__ void a_ready(const Unit&) const {}
    __device__ __forceinline__ void done(const Unit&) const {}
};

__device__ __forceinline__ unsigned cvt_pk_bf16(float lo, float hi) { unsigned r; asm volatile("v_cvt_pk_bf16_f32 %0, %1, %2" : "=v"(r) : "v"(lo), "v"(hi)); return r; }
template <class Epi, class Sched, bool ALIGN_EPI = false, bool SP2 = false>
__device__ __forceinline__ void gemm_phase(PG8_LAS unsigned char* lds, const Gemm g, const Sched& S, const Epi& E) {
    const int tid = opq(threadIdx.x), wid = __builtin_amdgcn_readfirstlane(tid >> 6), lane = tid & 63, wr = wid >> 2, wc = wid & 3, fr = lane & 15, fq = lane >> 4;
    const int K = g.K, nt = K / BK;
    unsigned voffA[2], voffB[2];
#pragma unroll
    for (int i = 0; i < 2; ++i) { int R, C; stage_rc(tid * 16 + i * 8192, R, C); const int Rb = Epi::PERM ? ((R & ~31) + perm32(R & 31)) : R;
        voffA[i] = (unsigned)(R * K + C) * 2u; voffB[i] = (unsigned)(Rb * K + C) * 2u; }
    const size_t kstep = (size_t)(BK * 2);
    const size_t hstep = (size_t)HALF * K * 2;
    const size_t tstep = 2 * hstep;
    const unsigned ldsw = (unsigned)wid * 1024u;
    const int aoff = lds_byte(wr * 64 + fr, fq * 8), boff = lds_byte(wc * 32 + fr, fq * 8);
#define PG8_SA(b, h) (((b) * 2 + (h)) * HTB)
#define PG8_SB(b, h) ((4 + (b) * 2 + (h)) * HTB)
#define PG8_STAGE(bufoff, gbase, voff) do { _Pragma("unroll") for (int _i = 0; _i < 2; ++_i) \
        __builtin_amdgcn_global_load_lds((const unsigned*)((const char*)(gbase) + (voff)[_i]), (PG8_LAS unsigned*)(lds + (bufoff) + ldsw + _i * 8192), 16, 0, 0); } while (0)
#define PG8_LDA(dst, b, h) do { _Pragma("unroll") for (int m = 0; m < 4; ++m) _Pragma("unroll") for (int k = 0; k < 2; ++k) dst[m][k] = *(const PG8_LAS bf16x8*)(lds + PG8_SA(b, h) + aoff + m * 2048 + k * 1024); } while (0)
#define PG8_LDB(dst, b, h) do { _Pragma("unroll") for (int n = 0; n < 2; ++n) _Pragma("unroll") for (int k = 0; k < 2; ++k) dst[n][k] = *(const PG8_LAS bf16x8*)(lds + PG8_SB(b, h) + boff + n * 2048 + k * 1024); } while (0)
#define PG8_MMA(ai, bj, At, Bt) do { __builtin_amdgcn_s_setprio(1); _Pragma("unroll") for (int m = 0; m < 4; ++m) _Pragma("unroll") for (int n = 0; n < 2; ++n) _Pragma("unroll") for (int k = 0; k < 2; ++k) \
        acc[ai][bj][m][n] = __builtin_amdgcn_mfma_f32_16x16x32_bf16(Bt[n][k], At[m][k], acc[ai][bj][m][n], 0, 0, 0); __builtin_amdgcn_s_setprio(0); } while (0)
#define PG8_WAIT_V(n) asm volatile("s_waitcnt vmcnt(" #n ")" ::: "memory")
#define PG8_WAIT_L(n) asm volatile("s_waitcnt lgkmcnt(" #n ")" ::: "memory")
#define PG8_BAR __builtin_amdgcn_s_barrier()
#define PG8_SCHED __builtin_amdgcn_sched_barrier(0)
    Unit cur, nxt; int ui = 0;
    if (!S.next(0, cur)) return;
    f32x4 acc[2][2][4][2];
#pragma unroll
    for (int a = 0; a < 2; ++a)
#pragma unroll
        for (int b = 0; b < 2; ++b)
#pragma unroll
            for (int m = 0; m < 4; ++m)
#pragma unroll
                for (int n = 0; n < 2; ++n) acc[a][b][m][n] = (f32x4){0.f, 0.f, 0.f, 0.f};
    bf16x8 At[4][2], B0[2][2], B1[2][2];
    const char* cA = (const char*)g.A + (size_t)cur.pm * tstep; const char* cB = (const char*)g.Bt + (size_t)cur.pn * tstep;
    S.a_ready(cur);
    if constexpr (SP2) {
        PG8_STAGE(PG8_SB(0, 0), cB, voffB); PG8_STAGE(PG8_SB(0, 1), cB + hstep, voffB); PG8_STAGE(PG8_SA(0, 0), cA, voffA); PG8_STAGE(PG8_SA(0, 1), cA + hstep, voffA);
        if (wr == 1) PG8_BAR;
        PG8_WAIT_V(2); PG8_BAR;
        PG8_STAGE(PG8_SB(1, 0), cB + kstep, voffB); PG8_STAGE(PG8_SA(1, 0), cA + kstep, voffA); PG8_STAGE(PG8_SB(1, 1), cB + hstep + kstep, voffB);
        PG8_WAIT_V(6); PG8_BAR;
    } else {
        PG8_STAGE(PG8_SB(0, 0), cB, voffB); PG8_STAGE(PG8_SA(0, 0), cA, voffA); PG8_STAGE(PG8_SB(0, 1), cB + hstep, voffB); PG8_STAGE(PG8_SA(0, 1), cA + hstep, voffA);
        if (wr == 1) PG8_BAR;
        PG8_WAIT_V(4); PG8_BAR;
        PG8_STAGE(PG8_SB(1, 0), cB + kstep, voffB); PG8_STAGE(PG8_SA(1, 0), cA + kstep, voffA); PG8_STAGE(PG8_SB(1, 1), cB + hstep + kstep, voffB);
        PG8_WAIT_V(6); PG8_BAR;
    }
    for (;;) {
        const bool has_next = S.next(ui + 1, nxt);
        const char* nA = has_next ? (const char*)g.A + (size_t)nxt.pm * tstep : cA; const char* nB = has_next ? (const char*)g.Bt + (size_t)nxt.pn * tstep : cB;
        for (int t = 0; t < nt; t += 2) {
            const bool last = (t == nt - 2);
            const char* a1 = cA + (size_t)(t + 1) * kstep;
            const char* a2 = last ? nA : cA + (size_t)(t + 2) * kstep; const char* b2 = last ? nB : cB + (size_t)(t + 2) * kstep;
            const char* a3 = a2 + kstep; const char* b3 = b2 + kstep;
            if (last && has_next) S.a_ready(nxt);
            if constexpr (SP2) {
            PG8_LDB(B0, 0, 0); PG8_LDB(B1, 0, 1); PG8_SCHED; PG8_LDA(At, 0, 0); PG8_STAGE(PG8_SA(1, 1), a1 + hstep, voffA);
            PG8_WAIT_V(8); PG8_WAIT_L(0); PG8_BAR; PG8_MMA(0, 0, At, B0); PG8_MMA(0, 1, At, B1); PG8_BAR; PG8_SCHED;
            PG8_LDA(At, 0, 1); PG8_STAGE(PG8_SB(0, 0), b2, voffB); PG8_STAGE(PG8_SB(0, 1), b2 + hstep, voffB); PG8_STAGE(PG8_SA(0, 0), a2, voffA);
            PG8_WAIT_V(8); PG8_WAIT_L(0); PG8_BAR; PG8_MMA(1, 0, At, B0); PG8_MMA(1, 1, At, B1); PG8_BAR; PG8_SCHED;
            PG8_LDB(B0, 1, 0); PG8_LDB(B1, 1, 1); PG8_SCHED; PG8_LDA(At, 1, 0); PG8_STAGE(PG8_SA(0, 1), a2 + hstep, voffA);
            PG8_WAIT_V(8); PG8_WAIT_L(0); PG8_BAR; PG8_MMA(0, 0, At, B0); PG8_MMA(0, 1, At, B1); PG8_BAR; PG8_SCHED;
            PG8_LDA(At, 1, 1); PG8_STAGE(PG8_SB(1, 0), b3, voffB); PG8_STAGE(PG8_SB(1, 1), b3 + hstep, voffB); PG8_STAGE(PG8_SA(1, 0), a3, voffA);
            PG8_WAIT_V(8); PG8_WAIT_L(0); PG8_BAR; PG8_MMA(1, 0, At, B0); PG8_MMA(1, 1, At, B1); PG8_BAR; PG8_SCHED;
            } else {
            PG8_LDB(B0, 0, 0); PG8_SCHED; PG8_LDA(At, 0, 0); PG8_STAGE(PG8_SA(1, 1), a1 + hstep, voffA);
            PG8_WAIT_L(8); PG8_BAR; PG8_WAIT_L(0); PG8_MMA(0, 0, At, B0); PG8_BAR; PG8_SCHED;
            PG8_LDB(B1, 0, 1); PG8_STAGE(PG8_SB(0, 0), b2, voffB);
            PG8_BAR; PG8_WAIT_L(0); PG8_MMA(0, 1, At, B1); PG8_BAR;
            PG8_LDA(At, 0, 1); PG8_STAGE(PG8_SA(0, 0), a2, voffA);
            PG8_BAR; PG8_WAIT_L(0); PG8_MMA(1, 0, At, B0); PG8_BAR; PG8_SCHED;
            PG8_STAGE(PG8_SB(0, 1), b2 + hstep, voffB);
            PG8_WAIT_V(6); PG8_BAR; PG8_MMA(1, 1, At, B1); PG8_BAR;
            PG8_LDB(B0, 1, 0); PG8_SCHED; PG8_LDA(At, 1, 0); PG8_STAGE(PG8_SA(0, 1), a2 + hstep, voffA);
            PG8_WAIT_L(8); PG8_BAR; PG8_WAIT_L(0); PG8_MMA(0, 0, At, B0); PG8_BAR; PG8_SCHED;
            PG8_LDB(B1, 1, 1); PG8_STAGE(PG8_SB(1, 0), b3, voffB);
            PG8_BAR; PG8_WAIT_L(0); PG8_MMA(0, 1, At, B1); PG8_BAR;
            PG8_LDA(At, 1, 1); PG8_STAGE(PG8_SA(1, 0), a3, voffA);
            PG8_BAR; PG8_WAIT_L(0); PG8_MMA(1, 0, At, B0); PG8_BAR; PG8_SCHED;
            PG8_STAGE(PG8_SB(1, 1), b3 + hstep, voffB);
            PG8_WAIT_V(6); PG8_BAR; PG8_MMA(1, 1, At, B1); PG8_BAR;
            }
        }
        if constexpr (ALIGN_EPI) { if (wr == 0) PG8_BAR; }
        if constexpr (!Epi::AFTER_DRAIN) { E(acc, cur, wr, wc, fr, fq); S.done(cur); }
        if (!has_next) break;
#pragma unroll
        for (int a = 0; a < 2; ++a)
#pragma unroll
            for (int b = 0; b < 2; ++b)
#pragma unroll
                for (int m = 0; m < 4; ++m)
#pragma unroll
                    for (int n = 0; n < 2; ++n) acc[a][b][m][n] = (f32x4){0.f, 0.f, 0.f, 0.f};
        cur = nxt; cA = nA; cB = nB; ++ui;
        if constexpr (ALIGN_EPI) { if (wr == 1) PG8_BAR; }
    }
    PG8_WAIT_V(0);
    if constexpr (!ALIGN_EPI) { if (wr == 0) PG8_BAR; }
    PG8_BAR;
    if constexpr (Epi::AFTER_DRAIN) { E.fused(acc, cur, wr, wc, fr, fq, lds, wid, lane); S.done(cur); }
#undef PG8_SA
#undef PG8_SB
#undef PG8_STAGE
#undef PG8_LDA
#undef PG8_LDB
#undef PG8_MMA
#undef PG8_WAIT_V
#undef PG8_WAIT_L
#undef PG8_BAR
#undef PG8_SCHED
}
}

namespace pg8 {
struct EpiProj {
    static constexpr bool PERM = true, AFTER_DRAIN = false;
    bf16_t* H; const float* g; const float* gd;
    const float* rowss;
    __device__ __forceinline__ void operator()(const f32x4 (&acc)[2][2][4][2], const Unit& u, int wr, int wc, int fr, int fq) const {
        const int pn = u.pn;
        int mode = 0; const float* gain = nullptr;
        const float qs = (pn == 0 || pn == 3 || pn == 8) ? 0.125f * 1.4426950408889634f : (pn == 5 ? 0.17677669529663687f * 1.4426950408889634f : 1.f);
        if (pn == 0) { mode = 1; gain = g; } else if (pn == 1) { mode = 1; gain = g + 64; } else if (pn == 3) { mode = 1; gain = g + 128; }
        else if (pn == 4) { if (wc < 2) { mode = 1; gain = g + 192; } }
        else if (pn == 5) { mode = 2; gain = gd; } else if (pn == 6) { mode = 2; gain = gd + 32; }
        else if (pn == 8) { mode = 1; gain = g + 256; }
        else if (pn == 9) { if (wc == 2) { mode = 1; gain = g + 384; } }
        else if (pn == 10) { if (wc == 0) { mode = 1; gain = g + 448; } else if (wc == 2) mode = 4; }
        else if (pn >= 11) mode = 3;
        f32x4 gv[2][2];
#pragma unroll
        for (int bj = 0; bj < 2; ++bj)
#pragma unroll
            for (int n = 0; n < 2; ++n) gv[bj][n] = (f32x4){1.f, 1.f, 1.f, 1.f};
        if (mode == 1) {
#pragma unroll
            for (int bj = 0; bj < 2; ++bj)
#pragma unroll
                for (int n = 0; n < 2; ++n) gv[bj][n] = *(const f32x4*)(gain + 32 * bj + 8 * fq + 4 * n);
        } else if (mode == 2) {
#pragma unroll
            for (int bj = 0; bj < 2; ++bj)
#pragma unroll
                for (int n = 0; n < 2; ++n) gv[bj][n] = *(const f32x4*)(gain + 8 * fq + 4 * n);
        }
        const int col0 = pn * BM + 64 * wc + 8 * fq;
#pragma unroll
        for (int ai = 0; ai < 2; ++ai)
#pragma unroll
            for (int m = 0; m < 4; ++m) {
                const int row = u.pm * BM + ai * HALF + wr * 64 + m * 16 + fr;
                f32x4 v[2][2];
                const float rsc = rowss ? rsqrtf((float)((const unsigned long long*)rowss)[row] * (1.f / (1048576.f * 1024.f)) + 1e-6f) : 1.f;
#pragma unroll
                for (int bj = 0; bj < 2; ++bj)
#pragma unroll
                    for (int n = 0; n < 2; ++n) v[bj][n] = acc[ai][bj][m][n] * rsc;
                if (mode == 1 || mode == 2) {
                    float s0 = 0.f, s1 = 0.f;
#pragma unroll
                    for (int n = 0; n < 2; ++n) {
                        s0 += v[0][n][0] * v[0][n][0] + v[0][n][1] * v[0][n][1] + v[0][n][2] * v[0][n][2] + v[0][n][3] * v[0][n][3];
                        s1 += v[1][n][0] * v[1][n][0] + v[1][n][1] * v[1][n][1] + v[1][n][2] * v[1][n][2] + v[1][n][3] * v[1][n][3];
                    }
                    s0 += __shfl_xor(s0, 16); s0 += __shfl_xor(s0, 32);
                    s1 += __shfl_xor(s1, 16); s1 += __shfl_xor(s1, 32);
                    float r0, r1;
                    if (mode == 1) { r0 = r1 = rsqrtf((s0 + s1) * (1.f / 64.f) + 1e-6f) * qs; }
                    else { r0 = rsqrtf(s0 * (1.f / 32.f) + 1e-6f) * qs; r1 = rsqrtf(s1 * (1.f / 32.f) + 1e-6f) * qs; }
#pragma unroll
                    for (int n = 0; n < 2; ++n) { v[0][n] = v[0][n] * r0 * gv[0][n]; v[1][n] = v[1][n] * r1 * gv[1][n]; }
                } else if (mode == 3) {
#pragma unroll
                    for (int bj = 0; bj < 2; ++bj)
#pragma unroll
                        for (int n = 0; n < 2; ++n)
#pragma unroll
                            for (int e = 0; e < 4; ++e) { const float x = v[bj][n][e]; v[bj][n][e] = x * __builtin_amdgcn_rcpf(1.f + __expf(-x)); }
                } else if (mode == 4) {
#pragma unroll
                    for (int bj = 0; bj < 2; ++bj)
#pragma unroll
                        for (int n = 0; n < 2; ++n)
#pragma unroll
                            for (int e = 0; e < 4; ++e) { const float x = v[bj][n][e]; v[bj][n][e] = __builtin_amdgcn_rcpf(1.f + __expf(-x)); }
                }
                bf16_t* rowp = H + (size_t)row * 3840 + col0;
#pragma unroll
                for (int bj = 0; bj < 2; ++bj) {
                    u32x4 w; w.x = cvt_pk_bf16(v[bj][0][0], v[bj][0][1]); w.y = cvt_pk_bf16(v[bj][0][2], v[bj][0][3]);
                    w.z = cvt_pk_bf16(v[bj][1][0], v[bj][1][1]); w.w = cvt_pk_bf16(v[bj][1][2], v[bj][1][3]);
                    *(u32x4*)(rowp + 32 * bj) = w;
                }
            }
    }
};
struct EpiOut {
    static constexpr bool PERM = false, AFTER_DRAIN = false;
    const float* xprev32;
    const bf16_t* xprev16;
    float* out;
    PG8_LAS float* exch;
    bf16_t* x1b; float* rowss;
    __device__ __forceinline__ void operator()(const f32x4 (&acc)[2][2][4][2], const Unit& u, int wr, int wc, int fr, int fq) const {
        const int col0 = u.pn * BM + wc * 32 + 4 * fq;
        const bool first = xprev32 != nullptr;
#pragma unroll
        for (int ai = 0; ai < 2; ++ai)
#pragma unroll
            for (int m = 0; m < 4; ++m) {
                const int row = u.pm * BM + ai * HALF + wr * 64 + m * 16 + fr;
                const size_t off = (size_t)row * 1024 + col0;
                float ss = 0.f;
#pragma unroll
                for (int bj = 0; bj < 2; ++bj)
#pragma unroll
                    for (int n = 0; n < 2; ++n) {
                        if (first) {
                            const f32x4 b = *(const f32x4*)(xprev32 + off + bj * HALF + n * 16);
                            const f32x4 v = b + acc[ai][bj][m][n];
                            ss += (v[0] * v[0] + v[1] * v[1]) + (v[2] * v[2] + v[3] * v[3]);
                            uint2 o; o.x = cvt_pk_bf16(v[0], v[1]); o.y = cvt_pk_bf16(v[2], v[3]);
                            *(uint2*)(x1b + off + bj * HALF + n * 16) = o;
                        } else {
                            const uint2 r = *(const uint2*)(xprev16 + off + bj * HALF + n * 16);
                            const f32x4 b = (f32x4){__uint_as_float(r.x << 16), __uint_as_float(r.x & 0xffff0000u), __uint_as_float(r.y << 16), __uint_as_float(r.y & 0xffff0000u)};
                            *(f32x4*)(out + off + bj * HALF + n * 16) = b + acc[ai][bj][m][n];
                        }
                    }
                if (first) {
                    ss += __shfl_xor(ss, 16); ss += __shfl_xor(ss, 32);
                    if (fq == 0) exch[(ai * HALF + wr * 64 + m * 16 + fr) * 4 + wc] = ss;
                }
            }
        if (first) {
            asm volatile("s_waitcnt lgkmcnt(0)" ::: "memory"); __builtin_amdgcn_s_barrier(); asm volatile("" ::: "memory");
            if (wc == 0) {
                const int lane = fq * 16 + fr;
#pragma unroll
                for (int k = 0; k < 2; ++k) {
                    const int rl = k * HALF + wr * 64 + lane;
                    const f32x4 p = *(const PG8_LAS f32x4*)(exch + rl * 4);
                    const float tot = (p[0] + p[1]) + (p[2] + p[3]);
                    atomicAdd((unsigned long long*)rowss + (u.pm * BM + rl), (unsigned long long)(tot * 1048576.f + 0.5f));
                }
            }
        }
    }
};
}

template <int MODE>
__device__ __forceinline__ void p0_transpose_item(const float* __restrict__ W, bf16_t* __restrict__ WT, LAS float* scr, int item, int lane, int KR = 1024, int NC = 1024, const float* __restrict__ gk = nullptr) {
    const int NSRC = MODE == 0 ? 3724 : NC, NG = MODE == 0 ? 120 : NC / 32;
    const int kb = item / NG, nb = item % NG, k0 = 64 * kb, hc0 = 32 * nb;
    const int hc = hc0 + (lane & 31);
    int src = hc;
    if (MODE == 0) src = hc < 2700 ? hc : (hc < 2816 ? -1 : hc - 116);
    float wv[32];
#pragma unroll
    for (int i = 0; i < 32; ++i) { const int kk = 2 * i + (lane >> 5); wv[i] = src >= 0 ? W[(size_t)(k0 + kk) * NSRC + src] : 0.f; }
#pragma unroll
    for (int i = 0; i < 32; ++i) { const int kk = 2 * i + (lane >> 5); scr[kk * 33 + (lane & 31)] = MODE == 0 ? wv[i] * gk[k0 + kk] : wv[i]; }
    asm volatile("s_waitcnt lgkmcnt(0)" ::: "memory");
    const int c = lane & 7;
#pragma unroll
    for (int j = 0; j < 4; ++j) {
        const int n = (lane >> 3) + 8 * j; const LAS float* s = scr + (8 * c) * 33 + n;
        const int hcn = hc0 + n;
        int drow = hcn;
        if (MODE == 0) drow = (hcn & ~255) + ((hcn >> 5) & 1) * 128 + ((hcn >> 6) & 3) * 32 + (hcn & 31);
        uint4 o; o.x = (unsigned)f2bf(s[0]) | ((unsigned)f2bf(s[33]) << 16); o.y = (unsigned)f2bf(s[66]) | ((unsigned)f2bf(s[99]) << 16);
        o.z = (unsigned)f2bf(s[132]) | ((unsigned)f2bf(s[165]) << 16); o.w = (unsigned)f2bf(s[198]) | ((unsigned)f2bf(s[231]) << 16);
        if (MODE == 2) { const int k = k0 + 8 * c; *(uint4*)(WT + ((size_t)((((drow >> 5) * 8 + (k >> 8)) * 16 + ((k >> 4) & 15)) * 64 + ((k >> 3) & 1) * 32 + (drow & 31))) * 8) = o; }
        else *(uint4*)(WT + (size_t)drow * KR + k0 + 8 * c) = o;
    }
    asm volatile("s_waitcnt lgkmcnt(0)" ::: "memory");
}

namespace att {
typedef short bf16x8 __attribute__((ext_vector_type(8)));
typedef short v4i16 __attribute__((ext_vector_type(4)));
typedef float f32x16 __attribute__((ext_vector_type(16)));
typedef float f32x2_t __attribute__((ext_vector_type(2)));
typedef __bf16 bf16x2_t __attribute__((ext_vector_type(2)));
typedef unsigned u32x4 __attribute__((ext_vector_type(4)));
typedef float f32x4 __attribute__((ext_vector_type(4)));
__device__ __forceinline__ unsigned cvtpk(float lo, float hi) { f32x2_t v = {lo, hi}; bf16x2_t b = __builtin_convertvector(v, bf16x2_t); return __builtin_bit_cast(unsigned, b); }
__device__ __forceinline__ int crow(int r, int h) { return (r & 3) + 8 * (r >> 2) + 4 * h; }
template <int CTRL> __device__ __forceinline__ int dpp_i(int v) { return __builtin_amdgcn_update_dpp(0, v, CTRL, 0xF, 0xF, true); }
template <int CTRL> __device__ __forceinline__ float dpp_f(float v) { return __int_as_float(dpp_i<CTRL>(__float_as_int(v))); }
constexpr int DPP_XOR1 = 0xB1, DPP_XOR2 = 0x4E, DPP_HMIRROR = 0x141;
constexpr float LOG2E = 1.4426950408889634f;
constexpr int L_KV = 0, KVB = 16384  , L_TAB = 32768  , L_WSCR = 83968  , L_IMP = 92160  , L_Q = 124928, L_SEL = 125184  , L_SB = 126464  ;

struct StageRegs { u32x4 k, v; };
__device__ __forceinline__ void stage_load(StageRegs& sr, const bf16_t* kp, const bf16_t* vp, bool valid, int ch) {
    sr.k = (u32x4){0u, 0u, 0u, 0u}; sr.v = sr.k;
    if (valid) { sr.k = *(const u32x4*)(kp + ch * 8); sr.v = *(const u32x4*)(vp + ch * 8); }
}
__device__ __forceinline__ void stage_write(LAS unsigned char* buf, const StageRegs& sr, int row, int ch) {
    *(LAS u32x4*)(buf + row * 128 + ((ch ^ (row & 7)) << 4)) = sr.k;
    *(LAS u32x4*)(buf + 8192 + (ch >> 2) * 4096 + row * 64 + (ch & 3) * 16) = sr.v;
}
__device__ __forceinline__ f32x16 load_tab16(const LAS float* tbl, int TSP, int jb) {
    const int sh = jb & 3; const LAS float* tp = tbl + sh * TSP + (jb - sh);
    const f32x4 t0 = *(const LAS f32x4*)(tp), t1 = *(const LAS f32x4*)(tp + 8), t2 = *(const LAS f32x4*)(tp + 16), t3 = *(const LAS f32x4*)(tp + 24);
    return (f32x16){t0[0], t0[1], t0[2], t0[3], t1[0], t1[1], t1[2], t1[3], t2[0], t2[1], t2[2], t2[3], t3[0], t3[1], t3[2], t3[3]};
}
__device__ __forceinline__ float exp_sum16(f32x16& acc) {
    float sa = 0.f, sb = 0.f;
#pragma unroll
    for (int r = 0; r < 16; r += 2) {
        acc[r] = __builtin_amdgcn_exp2f(acc[r]); acc[r + 1] = __builtin_amdgcn_exp2f(acc[r + 1]);
        sa += acc[r]; asm volatile("" : "+v"(sa)); sb += acc[r + 1]; asm volatile("" : "+v"(sb));
    }
    return sa + sb;
}
__device__ __forceinline__ f32x16 splat16(float v) { return (f32x16){v, v, v, v, v, v, v, v, v, v, v, v, v, v, v, v}; }
template <int S0, int S1>
__device__ __forceinline__ void qk_sub(f32x16& acc, const LAS unsigned char* buf, int sub, const bf16x8* qf, int lane) {
    const int key = 32 * sub + (lane & 31), h = lane >> 5;
    bf16x8 kf[S1 - S0];
#pragma unroll
    for (int s = S0; s < S1; ++s) kf[s - S0] = *(const LAS bf16x8*)(buf + key * 128 + (((2 * s + h) ^ (key & 7)) << 4));
    __builtin_amdgcn_sched_barrier(0);
#pragma unroll
    for (int s = S0; s < S1; ++s) acc = __builtin_amdgcn_mfma_f32_32x32x16_bf16(kf[s - S0], qf[s], acc, 0, 0, 0);
}
__device__ __forceinline__ void pack_p(const f32x16& p, bf16x8& pa0, bf16x8& pa1) {
    u32x4 w0, w1;
    w0.x = cvtpk(p[0], p[1]); w0.y = cvtpk(p[2], p[3]); w0.z = cvtpk(p[4], p[5]); w0.w = cvtpk(p[6], p[7]);
    w1.x = cvtpk(p[8], p[9]); w1.y = cvtpk(p[10], p[11]); w1.z = cvtpk(p[12], p[13]); w1.w = cvtpk(p[14], p[15]);
    pa0 = __builtin_bit_cast(bf16x8, w0); pa1 = __builtin_bit_cast(bf16x8, w1);
}
__device__ __forceinline__ void pv_sub(f32x16* o, const LAS unsigned char* buf, int sub, const bf16x8& pa0, const bf16x8& pa1, int lane) {
    const int h = lane >> 5, g16 = (lane >> 4) & 1, q4 = (lane & 15) >> 2, p4 = lane & 3;
    const LAS unsigned char* vb = buf + 8192 + (32 * sub + 4 * h + q4) * 64 + (16 * g16 + 4 * p4) * 2;
    bf16x8 vf[2][2];
#pragma unroll
    for (int dt = 0; dt < 2; ++dt) {
#pragma unroll
        for (int s2 = 0; s2 < 2; ++s2) {
            const v4i16 lo = __builtin_amdgcn_ds_read_tr16_b64_v4i16((LAS v4i16*)(vb + dt * 4096 + s2 * 1024));
            const v4i16 hi = __builtin_amdgcn_ds_read_tr16_b64_v4i16((LAS v4i16*)(vb + dt * 4096 + s2 * 1024 + 512));
            vf[dt][s2] = (bf16x8){lo[0], lo[1], lo[2], lo[3], hi[0], hi[1], hi[2], hi[3]};
        }
    }
    __builtin_amdgcn_sched_barrier(0);
    o[0] = __builtin_amdgcn_mfma_f32_32x32x16_bf16(pa0, vf[0][0], o[0], 0, 0, 0);
    o[1] = __builtin_amdgcn_mfma_f32_32x32x16_bf16(pa0, vf[1][0], o[1], 0, 0, 0);
    o[0] = __builtin_amdgcn_mfma_f32_32x32x16_bf16(pa1, vf[0][1], o[0], 0, 0, 0);
    o[1] = __builtin_amdgcn_mfma_f32_32x32x16_bf16(pa1, vf[1][1], o[1], 0, 0, 0);
}

__device__ __forceinline__ void pv_sub2(f32x16* oa, f32x16* ob, const LAS unsigned char* buf, int sub, const bf16x8& a0, const bf16x8& a1, const bf16x8& b0, const bf16x8& b1, int lane) {
    const int h = lane >> 5, g16 = (lane >> 4) & 1, q4 = (lane & 15) >> 2, p4 = lane & 3;
    const LAS unsigned char* vb = buf + 8192 + (32 * sub + 4 * h + q4) * 64 + (16 * g16 + 4 * p4) * 2;
#pragma unroll
    for (int dt = 0; dt < 2; ++dt) {
#pragma unroll
        for (int s2 = 0; s2 < 2; ++s2) {
            const v4i16 lo = __builtin_amdgcn_ds_read_tr16_b64_v4i16((LAS v4i16*)(vb + dt * 4096 + s2 * 1024));
            const v4i16 hi = __builtin_amdgcn_ds_read_tr16_b64_v4i16((LAS v4i16*)(vb + dt * 4096 + s2 * 1024 + 512));
            const bf16x8 vf = (bf16x8){lo[0], lo[1], lo[2], lo[3], hi[0], hi[1], hi[2], hi[3]};
            oa[dt] = __builtin_amdgcn_mfma_f32_32x32x16_bf16(s2 == 0 ? a0 : a1, vf, oa[dt], 0, 0, 0);
            ob[dt] = __builtin_amdgcn_mfma_f32_32x32x16_bf16(s2 == 0 ? b0 : b1, vf, ob[dt], 0, 0, 0);
        }
    }
}

struct BandArgs {
    const bf16_t* Hb;
    int cq, ck, cv;
    int rate, cls, f0, maxd;
    const float* bias;
    float M;
    float sinkterm;
    bf16_t* OA; float* DA;
    bf16_t* Y; int ycol;
    int hd; size_t brow;
};
constexpr int B_TAB = 98304, B_WSCR = 106496;
template <int MODE>
__device__ __forceinline__ void banded_unit(LAS unsigned char* lds, const BandArgs& P) {
    const int tid = opq(threadIdx.x), lane = tid & 63, w = __builtin_amdgcn_readfirstlane(tid >> 6), h = lane >> 5;
    LAS float* sb = (LAS float*)(lds + L_SB);
    LAS float* tbl = (LAS float*)(lds + B_TAB);
    const int KPREV = ((P.maxd + 63) >> 6) << 6;
    const int t0 = (KPREV - P.f0) > 0 ? ((KPREV - P.f0) >> 6) : 0;
    const int srow = tid >> 3, sch = tid & 7;
    StageRegs sr[6];
#pragma unroll
    for (int i = 0; i < 6; ++i) {
        int kf = P.f0 - KPREV + 64 * i + srow; kf = kf < 0 ? 0 : kf;
        const bf16_t* rp = P.Hb + ((size_t)kf * P.rate + P.cls) * HP;
        stage_load(sr[i], rp + P.ck, rp + P.cv, true, sch);
    }
    const int fq0 = P.f0 + 32 * w;
    bf16x8 qf[4];
    {
        const size_t tq = (size_t)(fq0 + (lane & 31)) * P.rate + P.cls;
        const bf16_t* qp = P.Hb + tq * HP + P.cq + 8 * h;
#pragma unroll
        for (int s = 0; s < 4; ++s) qf[s] = *(const bf16x8*)(qp + 16 * s);
    }
    if (tid < 32) sb[tid] = (P.bias[tid * 16] - P.M) * LOG2E;
    __syncthreads();
    const int DMAXI = P.maxd + 62, TS = P.maxd + 125, TSP = (TS + 7) & ~3;
    for (int e = tid; e < 4 * TSP; e += 512) {
        const int sh = e / TSP, j = e - sh * TSP + sh, dist = DMAXI - j;
        tbl[e] = (j < TS && dist >= 0 && dist <= P.maxd) ? sb[t5_bucket(dist * P.rate)] : -1e30f;
    }
    f32x16 o[2]; o[0] = (f32x16){}; o[1] = (f32x16){};
    float den = 0.f;
#pragma unroll
    for (int i = 0; i < 6; ++i) stage_write(lds + i * KVB, sr[i], srow, sch);
    asm volatile("" : "+v"(qf[0]), "+v"(qf[1]), "+v"(qf[2]), "+v"(qf[3]));
    __syncthreads();
#pragma unroll 1
    for (int t = t0; t < 6; ++t) {
        const LAS unsigned char* buf = lds + t * KVB;
        const int kf0 = P.f0 - KPREV + 64 * t;
#pragma unroll
        for (int sub = 0; sub < 2; ++sub) {
            const int kfs = kf0 + 32 * sub;
            if (kfs <= fq0 + 31 && kfs + 31 >= fq0 - P.maxd) {
                const int jb = DMAXI - ((fq0 - kfs) + (lane & 31) - 4 * h);
                f32x16 acc = load_tab16(tbl, TSP, jb);
                qk_sub<0, 4>(acc, buf, sub, qf, lane);
                den += exp_sum16(acc);
                bf16x8 pa0, pa1; pack_p(acc, pa0, pa1);
                pv_sub(o, buf, sub, pa0, pa1, lane);
            }
        }
    }
    float dtot = den + __shfl_xor(den, 32);
    if (MODE == 1) dtot += P.sinkterm;
    LAS float* ws_ = (LAS float*)(lds + B_WSCR) + w * 64;
    if (h == 0) ws_[lane] = dtot;
    if (MODE == 0 && h == 0) {
        const size_t tq = (size_t)(fq0 + lane) * P.rate + P.cls;
        P.DA[(P.brow + tq) * 4 + P.hd] = dtot;
    }
    asm volatile("s_waitcnt lgkmcnt(0)" ::: "memory");
#pragma unroll
    for (int r = 0; r < 16; ++r) {
        const int qi = crow(r, h);
        const float inv = __builtin_amdgcn_rcpf(ws_[qi]);
        const size_t row = P.brow + (size_t)(fq0 + qi) * P.rate + P.cls;
#pragma unroll
        for (int dt = 0; dt < 2; ++dt) {
            const int d = 32 * dt + (lane & 31);
            const float val = o[dt][r] * inv;
            if (MODE == 0) P.OA[row * 256 + P.hd * 64 + d] = f2bf(val);
            else P.Y[row * DM + P.ycol + d] = f2bf(val * bf2f(P.Hb[(row - P.brow) * HP + C_SILU + P.ycol + d]));
        }
    }
}

__device__ __forceinline__ void diff_p1(const LAS float* tp, const LAS unsigned char* buf, int sub, const bf16x8* qf, int lane, bf16x8& pa0, bf16x8& pa1, bf16x8& pb0, bf16x8& pb1) {
    const f32x4 t0 = *(const LAS f32x4*)(tp), t1 = *(const LAS f32x4*)(tp + 8), t2 = *(const LAS f32x4*)(tp + 16), t3 = *(const LAS f32x4*)(tp + 24);
    const f32x16 T = (f32x16){t0[0], t0[1], t0[2], t0[3], t1[0], t1[1], t1[2], t1[3], t2[0], t2[1], t2[2], t2[3], t3[0], t3[1], t3[2], t3[3]};
    const int key = 32 * sub + (lane & 31), h = lane >> 5;
    const LAS unsigned char* kp = buf + key * 128;
    const bf16x8 k0 = *(const LAS bf16x8*)(kp + (((0 + h) ^ (key & 7)) << 4)), k1 = *(const LAS bf16x8*)(kp + (((2 + h) ^ (key & 7)) << 4));
    const bf16x8 k2 = *(const LAS bf16x8*)(kp + (((4 + h) ^ (key & 7)) << 4)), k3 = *(const LAS bf16x8*)(kp + (((6 + h) ^ (key & 7)) << 4));
    f32x16 a1 = __builtin_amdgcn_mfma_f32_32x32x16_bf16(k0, qf[0], T, 0, 0, 0);
    f32x16 a2 = __builtin_amdgcn_mfma_f32_32x32x16_bf16(k2, qf[2], T, 0, 0, 0);
    a1 = __builtin_amdgcn_mfma_f32_32x32x16_bf16(k1, qf[1], a1, 0, 0, 0);
    a2 = __builtin_amdgcn_mfma_f32_32x32x16_bf16(k3, qf[3], a2, 0, 0, 0);
#pragma unroll
    for (int r = 0; r < 16; ++r) { a1[r] = __builtin_amdgcn_exp2f(a1[r]); a2[r] = __builtin_amdgcn_exp2f(a2[r]); }
    pack_p(a1, pa0, pa1); pack_p(a2, pb0, pb1);
}
__device__ __forceinline__ void diff_p2(const LAS unsigned char* buf, int sub, int lane, const bf16x8& pa0, const bf16x8& pa1, const bf16x8& pb0, const bf16x8& pb1, f32x16& dn1, f32x16& dn2, f32x16* o1, f32x16* o2) {
    const bf16x8 ones = (bf16x8){0x3F80, 0x3F80, 0x3F80, 0x3F80, 0x3F80, 0x3F80, 0x3F80, 0x3F80};
    const int h = lane >> 5, g16 = (lane >> 4) & 1, q4 = (lane & 15) >> 2, p4 = lane & 3;
    const LAS unsigned char* vb = buf + 8192 + (32 * sub + 4 * h + q4) * 64 + (16 * g16 + 4 * p4) * 2;
    bf16x8 vf[2][2];
#pragma unroll
    for (int dt = 0; dt < 2; ++dt) {
#pragma unroll
        for (int s2 = 0; s2 < 2; ++s2) {
            const v4i16 lo = __builtin_amdgcn_ds_read_tr16_b64_v4i16((LAS v4i16*)(vb + dt * 4096 + s2 * 1024));
            const v4i16 hi = __builtin_amdgcn_ds_read_tr16_b64_v4i16((LAS v4i16*)(vb + dt * 4096 + s2 * 1024 + 512));
            vf[dt][s2] = (bf16x8){lo[0], lo[1], lo[2], lo[3], hi[0], hi[1], hi[2], hi[3]};
        }
    }
    __builtin_amdgcn_sched_barrier(0);
    dn1 = __builtin_amdgcn_mfma_f32_32x32x16_bf16(pa0, ones, dn1, 0, 0, 0);
    dn2 = __builtin_amdgcn_mfma_f32_32x32x16_bf16(pb0, ones, dn2, 0, 0, 0);
    dn1 = __builtin_amdgcn_mfma_f32_32x32x16_bf16(pa1, ones, dn1, 0, 0, 0);
    dn2 = __builtin_amdgcn_mfma_f32_32x32x16_bf16(pb1, ones, dn2, 0, 0, 0);
    o1[0] = __builtin_amdgcn_mfma_f32_32x32x16_bf16(pa0, vf[0][0], o1[0], 0, 0, 0);
    o2[0] = __builtin_amdgcn_mfma_f32_32x32x16_bf16(pb0, vf[0][0], o2[0], 0, 0, 0);
    o1[1] = __builtin_amdgcn_mfma_f32_32x32x16_bf16(pa0, vf[1][0], o1[1], 0, 0, 0);
    o2[1] = __builtin_amdgcn_mfma_f32_32x32x16_bf16(pb0, vf[1][0], o2[1], 0, 0, 0);
    o1[0] = __builtin_amdgcn_mfma_f32_32x32x16_bf16(pa1, vf[0][1], o1[0], 0, 0, 0);
    o2[0] = __builtin_amdgcn_mfma_f32_32x32x16_bf16(pb1, vf[0][1], o2[0], 0, 0, 0);
    o1[1] = __builtin_amdgcn_mfma_f32_32x32x16_bf16(pa1, vf[1][1], o1[1], 0, 0, 0);
    o2[1] = __builtin_amdgcn_mfma_f32_32x32x16_bf16(pb1, vf[1][1], o2[1], 0, 0, 0);
}

struct DiffArgs {
    const bf16_t* Hb; int hd, qb; size_t brow;
    const float* bias; float M; float lam, lambda_init; const float* subln;
    bf16_t* Y;
};
constexpr int D_SB = 49152, D_TAB = 49664;
__device__ __forceinline__ void diff_unit(LAS unsigned char* lds, const DiffArgs& P) {
    const int tid = opq(threadIdx.x), lane = tid & 63, w = __builtin_amdgcn_readfirstlane(tid >> 6), h = lane >> 5;
    LAS float* sb = (LAS float*)(lds + D_SB);
    LAS float* tbl = (LAS float*)(lds + D_TAB);
    constexpr int DTOP = 1574, TS = DTOP + 63, TSP = (TS + 7) & ~3;
    __syncthreads();
    if (tid < 32) sb[tid] = (P.bias[tid * 16] - P.M) * LOG2E;
    __syncthreads();
    for (int e = tid; e < 4 * TSP; e += 512) {
        const int sh = e / TSP, j = e - sh * TSP + sh, dist = DTOP - j;
        tbl[e] = (j < TS && dist >= 0) ? sb[t5_bucket(dist)] : -1e30f;
    }
    LAS float* farc = tbl + 4 * TSP;
    LAS float* deadr = farc + 32;
    if (tid < 32) { farc[tid] = sb[31]; deadr[tid] = -1e30f; }
    const int q0w = P.qb * 256 + 32 * w;
    const int cq = C_CQ + 64 * P.hd, ck = C_CK + 64 * P.hd, cv = C_CV + 64 * P.hd;
    bf16x8 qf[4];
    {
        const bf16_t* qp = P.Hb + (size_t)(q0w + (lane & 31)) * HP + cq + 8 * h;
#pragma unroll
        for (int s = 0; s < 4; ++s) qf[s] = *(const bf16x8*)(qp + 16 * s);
        asm volatile("" : "+v"(qf[0]), "+v"(qf[1]), "+v"(qf[2]), "+v"(qf[3]));
    }
    const int ntl = 4 * (P.qb + 1);
    const int srow = tid >> 3, sch = tid & 7;
    f32x16 o1[2], o2[2]; o1[0] = (f32x16){}; o1[1] = (f32x16){}; o2[0] = (f32x16){}; o2[1] = (f32x16){};
    f32x16 dn1 = (f32x16){}, dn2 = (f32x16){};
    StageRegs sr;
    {
        const bf16_t* rp = P.Hb + (size_t)srow * HP;
        stage_load(sr, rp + ck, rp + cv, true, sch);
        stage_write(lds, sr, srow, sch);
    }
    __syncthreads();
#define DIFF_TP(KS) ({ const int ks_ = (KS); const int jb_ = DTOP - ((q0w - ks_) + (lane & 31) - 4 * h), sh_ = jb_ & 3; \
        const LAS float* tp_ = tbl + sh_ * TSP + (jb_ - sh_); tp_ = (q0w - ks_ - 31 >= 1513) ? farc : tp_; tp_ = (ks_ > q0w + 31) ? deadr : tp_; tp_; })
#define DIFF_STAGE_LOAD(t) do { const int tn_ = (t) + 1 < ntl ? (t) + 1 : (t); const bf16_t* rp_ = P.Hb + (size_t)(64 * tn_ + srow) * HP; stage_load(sr, rp_ + ck, rp_ + cv, true, sch); } while (0)
    if (w < 4) {
        int cur = 0;
        for (int t = 0; t < ntl; ++t) {
            LAS unsigned char* buf = lds + cur * KVB;
            const int nxt = cur == 2 ? 0 : cur + 1;
            DIFF_STAGE_LOAD(t);
            bf16x8 pa0, pa1, pb0, pb1;
            diff_p1(DIFF_TP(64 * t), buf, 0, qf, lane, pa0, pa1, pb0, pb1);
            diff_p2(buf, 0, lane, pa0, pa1, pb0, pb1, dn1, dn2, o1, o2);
            diff_p1(DIFF_TP(64 * t + 32), buf, 1, qf, lane, pa0, pa1, pb0, pb1);
            diff_p2(buf, 1, lane, pa0, pa1, pb0, pb1, dn1, dn2, o1, o2);
            stage_write(lds + nxt * KVB, sr, srow, sch);
            __syncthreads();
            cur = nxt;
        }
    } else {
        const bf16x8 zero8 = (bf16x8){0, 0, 0, 0, 0, 0, 0, 0};
        bf16x8 qa0 = zero8, qa1 = zero8, qb0 = zero8, qb1 = zero8;
        int cur = 0, prv = 0;
        __builtin_amdgcn_s_setprio(1);
        for (int t = 0; t < ntl; ++t) {
            LAS unsigned char* buf = lds + cur * KVB;
            const int nxt = cur == 2 ? 0 : cur + 1;
            DIFF_STAGE_LOAD(t);
            diff_p2(lds + prv * KVB, 1, lane, qa0, qa1, qb0, qb1, dn1, dn2, o1, o2);
            bf16x8 pa0, pa1, pb0, pb1;
            diff_p1(DIFF_TP(64 * t), buf, 0, qf, lane, pa0, pa1, pb0, pb1);
            diff_p2(buf, 0, lane, pa0, pa1, pb0, pb1, dn1, dn2, o1, o2);
            diff_p1(DIFF_TP(64 * t + 32), buf, 1, qf, lane, qa0, qa1, qb0, qb1);
            stage_write(lds + nxt * KVB, sr, srow, sch);
            __syncthreads();
            prv = cur; cur = nxt;
        }
        diff_p2(lds + prv * KVB, 1, lane, qa0, qa1, qb0, qb1, dn1, dn2, o1, o2);
        __builtin_amdgcn_s_setprio(0);
    }
    __syncthreads();
#undef DIFF_TP
#undef DIFF_STAGE_LOAD
    const float g0 = P.subln[lane & 31] * (1.f - P.lambda_init), g1 = P.subln[32 + (lane & 31)] * (1.f - P.lambda_init);
    const int ycol = 512 + 64 * P.hd;
#pragma unroll
    for (int r = 0; r < 16; ++r) {
        const int qi = crow(r, h);
        const float i1 = __builtin_amdgcn_rcpf(dn1[r]), i2 = P.lam * __builtin_amdgcn_rcpf(dn2[r]);
        const float a0 = o1[0][r] * i1 - o2[0][r] * i2, a1 = o1[1][r] * i1 - o2[1][r] * i2;
        float ss = a0 * a0 + a1 * a1;
        ss += __shfl_xor(ss, 1); ss += __shfl_xor(ss, 2); ss += __shfl_xor(ss, 4); ss += __shfl_xor(ss, 8); ss += __shfl_xor(ss, 16);
        const float rs = rsqrtf(ss * (1.f / 64.f) + 1e-6f);
        const size_t trow = (size_t)(q0w + qi);
        const bf16_t* sp = P.Hb + trow * HP + C_SILU + ycol;
        bf16_t* yp = P.Y + (P.brow + trow) * DM + ycol;
        yp[lane & 31] = f2bf(a0 * rs * g0 * bf2f(sp[lane & 31]));
        yp[32 + (lane & 31)] = f2bf(a1 * rs * g1 * bf2f(sp[32 + (lane & 31)]));
    }
}
struct CmpArgs {
    const bf16_t* Hb;
    int col;
    int rt;
    const float* pos;
    const bf16_t* W1T;
    const float* b1;
    const bf16_t* W2T;
    const float* b2;
    const float* gain;
    bf16_t* OUT;
};
__device__ __forceinline__ void cmp_unit(LAS unsigned char* lds, const CmpArgs& P) {
    const int tid = opq(threadIdx.x), lane = tid & 63, w = __builtin_amdgcn_readfirstlane(tid >> 6), h = lane >> 5;
    LAS unsigned char* hidl = lds + L_KV;
    LAS float* ssx = (LAS float*)(lds + L_KV + 32768 - 512);
    LAS unsigned char* abuf = lds + L_TAB;
    f32x16 acc = (f32x16){};
    const bf16_t* w1p = P.W1T + (size_t)w * (8 * 16 * 64 * 8) + lane * 8;
    u32x4 araw[2]; f32x4 apos[2][2];
#define CMP_ALOAD(ch) do { _Pragma("unroll") for (int q_ = 0; q_ < 2; ++q_) { const int p_ = tid + 512 * q_, row_ = p_ >> 5, kc_ = p_ & 31; \
        int ir_ = 32 * P.rt + row_; if (ir_ > 510) ir_ = 510; const int tok_ = 4 * (ch) + (kc_ >> 3), d_ = 8 * (kc_ & 7); \
        araw[q_] = *(const u32x4*)(P.Hb + (size_t)(16 * ir_ + tok_) * HP + P.col + d_); \
        apos[q_][0] = *(const f32x4*)(P.pos + tok_ * 64 + d_); apos[q_][1] = *(const f32x4*)(P.pos + tok_ * 64 + d_ + 4); } } while (0)
#define CMP_AWRITE(bufi) do { _Pragma("unroll") for (int q_ = 0; q_ < 2; ++q_) { const int p_ = tid + 512 * q_, row_ = p_ >> 5, kc_ = p_ & 31; u32x4 aw_; \
        aw_.x = cvtpk(__uint_as_float(araw[q_].x << 16) + apos[q_][0][0], __uint_as_float(araw[q_].x & 0xffff0000u) + apos[q_][0][1]); \
        aw_.y = cvtpk(__uint_as_float(araw[q_].y << 16) + apos[q_][0][2], __uint_as_float(araw[q_].y & 0xffff0000u) + apos[q_][0][3]); \
        aw_.z = cvtpk(__uint_as_float(araw[q_].z << 16) + apos[q_][1][0], __uint_as_float(araw[q_].z & 0xffff0000u) + apos[q_][1][1]); \
        aw_.w = cvtpk(__uint_as_float(araw[q_].w << 16) + apos[q_][1][2], __uint_as_float(araw[q_].w & 0xffff0000u) + apos[q_][1][3]); \
        *(LAS u32x4*)(abuf + (bufi) * 16896 + row_ * 528 + kc_ * 16) = aw_; } } while (0)
    CMP_ALOAD(0); CMP_AWRITE(0);
    __syncthreads();
    for (int ch = 0; ch < 8; ++ch) {
        const int cn = ch + 1 < 8 ? ch + 1 : ch;
        CMP_ALOAD(cn);
        const LAS unsigned char* ab = abuf + (ch & 1) * 16896 + (lane & 31) * 528 + 16 * h;
        bf16x8 bfr[16];
#pragma unroll
        for (int ks = 0; ks < 16; ++ks) bfr[ks] = *(const bf16x8*)(w1p + (ch * 16 + ks) * 512);
#pragma unroll
        for (int ks = 0; ks < 16; ++ks) {
            const bf16x8 af = *(const LAS bf16x8*)(ab + 32 * ks);
            acc = __builtin_amdgcn_mfma_f32_32x32x16_bf16(af, bfr[ks], acc, 0, 0, 0);
        }
        CMP_AWRITE((ch + 1) & 1);
        __syncthreads();
    }
#undef CMP_ALOAD
#undef CMP_AWRITE
    {
        const int j = 32 * w + (lane & 31); const float bb = P.b1[j];
#pragma unroll
        for (int r = 0; r < 16; ++r) {
            const float x = acc[r] + bb;
            const float u = 0.7978845608028654f * (x + 0.044715f * x * x * x);
            const float th = 1.f - 2.f / (1.f + __expf(2.f * u));
            const float gl = 0.5f * x * (1.f + th);
            *(LAS bf16_t*)(hidl + crow(r, h) * 528 + j * 2) = f2bf(gl);
        }
    }
    __syncthreads();
    float outv[16]; float ssp[16];
    if (w < 2) {
        f32x16 a2 = (f32x16){};
        const bf16_t* w2p = P.W2T + (size_t)(32 * w + (lane & 31)) * 256 + 8 * h;
#pragma unroll
        for (int ks = 0; ks < 16; ++ks) {
            const bf16x8 af = *(const LAS bf16x8*)(hidl + (lane & 31) * 528 + (16 * ks + 8 * h) * 2);
            const bf16x8 bfr = *(const bf16x8*)(w2p + 16 * ks);
            a2 = __builtin_amdgcn_mfma_f32_32x32x16_bf16(af, bfr, a2, 0, 0, 0);
        }
        const float bb = P.b2[32 * w + (lane & 31)];
#pragma unroll
        for (int r = 0; r < 16; ++r) {
            outv[r] = a2[r] + bb;
            float ss = outv[r] * outv[r];
            ss += __shfl_xor(ss, 1); ss += __shfl_xor(ss, 2); ss += __shfl_xor(ss, 4); ss += __shfl_xor(ss, 8); ss += __shfl_xor(ss, 16);
            ssp[r] = ss;
            if ((lane & 31) == 0) ssx[w * 32 + crow(r, h)] = ss;
        }
    }
    __syncthreads();
    if (w < 2) {
        const int d = 32 * w + (lane & 31);
        const float gn = P.gain ? P.gain[d] : 1.f;
#pragma unroll
        for (int r = 0; r < 16; ++r) {
            const int row = 32 * P.rt + crow(r, h);
            float v = outv[r];
            if (P.gain) { const float tot = ssx[crow(r, h)] + ssx[32 + crow(r, h)]; v = v * rsqrtf(tot * (1.f / 64.f) + 1e-6f) * gn; }
            if (row <= 510) P.OUT[(size_t)row * 64 + d] = f2bf(v);
        }
    }
    __syncthreads();
}

struct NsaArgs {
    const bf16_t* Hb; size_t brow; int qb;
    const bf16_t* KC; const bf16_t* VC;
    const float* bias;
    const float* Mv;
    bf16_t* Y; unsigned* cdone;
    float* scr;
};
constexpr int GTOP = 2015, GTS = 2519, WTOP = 549, WTS = 588, DEAD = 4 * GTS + 4 * WTS;
__device__ __forceinline__ void nsa_unit(LAS unsigned char* lds, const NsaArgs& P) {
    const int tid = opq(threadIdx.x), lane = tid & 63, w = __builtin_amdgcn_readfirstlane(tid >> 6), hh = lane >> 5;
    const int n = lane & 31, q8 = n >> 2, hd = n & 3;
    LAS float* tg = (LAS float*)(lds + L_TAB);
    LAS float* tw = tg + 4 * GTS;
    LAS float* dead = tg + DEAD;
    LAS float* impw = (LAS float*)(lds + L_IMP) + w * 1024;
    LAS unsigned* selw = (LAS unsigned*)(lds + L_SEL) + w * 32;
    LAS unsigned* uni = (LAS unsigned*)(lds + L_SEL) + 256;
    LAS float* ws_ = (LAS float*)(lds + L_WSCR) + w * 256;
    LAS float* sbh = (LAS float*)(lds + L_SB);
    if (tid < 128) sbh[tid] = (P.bias[(tid & 31) * 16 + (tid >> 5)] - P.Mv[tid >> 5]) * LOG2E;
    __syncthreads();
    for (int e = tid; e < 4 * GTS; e += 512) { const int hq = e / GTS, j = e % GTS, dist = GTOP - j;
        tg[e] = dist >= 0 ? sbh[hq * 32 + t5_bucket(dist)] : -1e30f; }
    for (int e = tid; e < 4 * WTS; e += 512) { const int hq = e / WTS, j = e % WTS, dist = WTOP - j;
        tw[e] = (dist >= 0 && dist <= 511) ? sbh[hq * 32 + t5_bucket(dist)] : -1e30f; }
    if (tid < 64) dead[tid] = -1e30f;
    if (tid < 4) uni[tid] = 0u;
    const float cfar = sbh[hd * 32 + 31];
    const int tq = 64 * P.qb + 8 * w + q8;
    const int twmin = 64 * P.qb + 8 * w, twmax = twmin + 7;
    bf16x8 qf[4];
    {
        const bf16_t* qp = P.Hb + (size_t)tq * HP + C_DQ + 64 * hd + 8 * hh;
#pragma unroll
        for (int s = 0; s < 4; ++s) qf[s] = *(const bf16x8*)(qp + 16 * s);
        asm volatile("" : "+v"(qf[0]), "+v"(qf[1]), "+v"(qf[2]), "+v"(qf[3]));
    }
    {
        const bf16_t* gp = P.Hb + (size_t)tq * HP + C_GT + 3 * hd;
        if (hh == 0) { ws_[n] = bf2f(gp[0]); ws_[32 + n] = bf2f(gp[1]); ws_[64 + n] = bf2f(gp[2]); }
    }
    const int srow = tid >> 3, sch = tid & 7;
    StageRegs sr;
    f32x16 o[2], outv[2];
    float den = 0.f;
    o[0] = (f32x16){}; o[1] = (f32x16){};
    {
        const int kt0 = P.qb >= 8 ? P.qb - 8 : 0, nkt = P.qb - kt0 + 1;
        {
            const bf16_t* rp = P.Hb + (size_t)(64 * kt0 + srow) * HP;
            stage_load(sr, rp + C_KW, rp + C_VW, true, sch);
            stage_write(lds + L_KV, sr, srow, sch);
        }
        __syncthreads();
        for (int t = 0; t < nkt; ++t) {
            LAS unsigned char* buf = lds + L_KV + (t & 1) * KVB;
            if (t + 1 < nkt) { const bf16_t* rp = P.Hb + (size_t)(64 * (kt0 + t + 1) + srow) * HP; stage_load(sr, rp + C_KW, rp + C_VW, true, sch); }
#pragma unroll
            for (int sub = 0; sub < 2; ++sub) {
                const int kb = 64 * (kt0 + t) + 32 * sub;
                if (kb <= twmax && kb + 31 >= twmin - 511) {
                    f32x16 acc;
                    const LAS float* tb = tw + hd * WTS + (WTOP - (tq - kb - 4 * hh));
#pragma unroll
                    for (int r = 0; r < 16; ++r) acc[r] = tb[(r & 3) + 8 * (r >> 2)];
                    qk_sub<0, 4>(acc, buf, sub, qf, lane);
#pragma unroll
                    for (int r = 0; r < 1; ++r) den += exp_sum16(acc);
                    bf16x8 pa0, pa1; pack_p(acc, pa0, pa1);
                    pv_sub(o, buf, sub, pa0, pa1, lane);
                }
            }
            if (t + 1 < nkt) stage_write(lds + L_KV + ((t + 1) & 1) * KVB, sr, srow, sch);
            __syncthreads();
        }
    }
    {
        const float dt = den + __shfl_xor(den, 32);
        if (hh == 0) ws_[128 + n] = __builtin_amdgcn_rcpf(dt);
        asm volatile("s_waitcnt lgkmcnt(0)" ::: "memory");
#pragma unroll
        for (int r = 0; r < 16; ++r) { const int nn = crow(r, hh); const float gi = ws_[64 + nn] * ws_[128 + nn]; outv[0][r] = o[0][r] * gi; outv[1][r] = o[1][r] * gi; }
    }
    if (opq(threadIdx.x) == 128) {
        unsigned sp = 0;
        while (__hip_atomic_load(P.cdone, __ATOMIC_RELAXED, __HIP_MEMORY_SCOPE_AGENT) < 64u) { __builtin_amdgcn_s_sleep(2); if (++sp > (1u << 24)) break; }
        __builtin_amdgcn_fence(__ATOMIC_ACQUIRE, "agent"); asm volatile("s_waitcnt vmcnt(0)" ::: "memory");
    }
    __syncthreads();
    const int tlast = 64 * P.qb + 63;
    const int ntc = tlast >= 31 ? (((tlast - 31) >> 4) >> 6) + 1 : 0;
    float invden = 0.f; den = 0.f;
    o[0] = (f32x16){}; o[1] = (f32x16){};
    if (ntc > 0) {
        u32x4 kreg[8];
#pragma unroll
        for (int t = 0; t < 8; ++t) { const int tt = t < ntc ? t : 0; kreg[t] = *(const u32x4*)(P.KC + (size_t)(64 * tt + srow) * 64 + sch * 8); }
#pragma unroll
        for (int t = 0; t < 8; ++t) *(LAS u32x4*)(lds + (t < 4 ? L_KV + t * 8192 : L_IMP + (t - 4) * 8192) + srow * 128 + ((sch ^ (srow & 7)) << 4)) = kreg[t];
        __syncthreads();
#pragma unroll 1
        for (int t = 0; t < ntc; ++t) {
            const LAS unsigned char* buf = lds + (t < 4 ? L_KV + t * 8192 : L_IMP + (t - 4) * 8192);
#pragma unroll
            for (int sub = 0; sub < 2; ++sub) {
                const int cb = 64 * t + 32 * sub;
                if (16 * cb + 31 <= twmax) {
                    f32x16 acc;
                    const int dmin = twmin - 16 * (cb + 31) - 31;
                    if (dmin >= 1513) acc = splat16(cfar);
                    else {
                        const LAS float* tb = tg + hd * GTS + (GTOP - (tq - 31 - 16 * cb - 64 * hh));
#pragma unroll
                        for (int r = 0; r < 16; ++r) acc[r] = tb[16 * ((r & 3) + 8 * (r >> 2))];
                    }
                    qk_sub<0, 4>(acc, buf, sub, qf, lane);
                    den += exp_sum16(acc);
                }
            }
        }
        __syncthreads();
    }
    { const float dt = den + __shfl_xor(den, 32); invden = dt > 0.f ? 1.f / dt : 0.f; }
    for (int e = lane; e < 1024; e += 64) impw[e] = 0.f;
    {
        if (ntc > 0) {
            __syncthreads();
            stage_load(sr, P.KC + (size_t)srow * 64, P.VC + (size_t)srow * 64, true, sch);
            stage_write(lds + L_KV, sr, srow, sch);
            __syncthreads();
            for (int t = 0; t < ntc; ++t) {
                LAS unsigned char* buf = lds + L_KV + (t & 1) * KVB;
                if (t + 1 < ntc) stage_load(sr, P.KC + (size_t)(64 * (t + 1) + srow) * 64, P.VC + (size_t)(64 * (t + 1) + srow) * 64, true, sch);
#pragma unroll
                for (int sub = 0; sub < 2; ++sub) {
                    const int cb = 64 * t + 32 * sub;
                    if (16 * cb + 31 <= twmax) {
                        f32x16 acc;
                        const int dmin = twmin - 16 * (cb + 31) - 31;
                        if (dmin >= 1513) acc = splat16(cfar);
                        else {
                            const LAS float* tb = tg + hd * GTS + (GTOP - (tq - 31 - 16 * cb - 64 * hh));
#pragma unroll
                            for (int r = 0; r < 16; ++r) acc[r] = tb[16 * ((r & 3) + 8 * (r >> 2))];
                        }
                        qk_sub<0, 4>(acc, buf, sub, qf, lane);
#pragma unroll
                        for (int r = 0; r < 16; ++r) acc[r] = __builtin_amdgcn_exp2f(acc[r]) * invden;
#pragma unroll
                        for (int g = 0; g < 4; ++g) {
                            float G = (acc[4 * g] + acc[4 * g + 1]) + (acc[4 * g + 2] + acc[4 * g + 3]), C = acc[4 * g + 3];
                            G += dpp_f<DPP_XOR1>(G); G += dpp_f<DPP_XOR2>(G); C += dpp_f<DPP_XOR1>(C); C += dpp_f<DPP_XOR2>(C);
                            if (hd == 0) {
                                const int j = (cb >> 2) + 2 * g + hh;
                                __hip_atomic_fetch_add(impw + q8 * 128 + j, G, __ATOMIC_RELAXED, __HIP_MEMORY_SCOPE_WORKGROUP);
                                if (j + 1 < 128) __hip_atomic_fetch_add(impw + q8 * 128 + j + 1, C, __ATOMIC_RELAXED, __HIP_MEMORY_SCOPE_WORKGROUP);
                            }
                        }
                        bf16x8 pa0, pa1; pack_p(acc, pa0, pa1);
                        pv_sub(o, buf, sub, pa0, pa1, lane);
                    }
                }
                if (t + 1 < ntc) stage_write(lds + L_KV + ((t + 1) & 1) * KVB, sr, srow, sch);
                __syncthreads();
            }
        }
    }
    asm volatile("s_waitcnt lgkmcnt(0)" ::: "memory");
#pragma unroll
    for (int r = 0; r < 16; ++r) { const float g0 = ws_[crow(r, hh)]; outv[0][r] += o[0][r] * g0; outv[1][r] += o[1][r] * g0; }
    {
        float* sp = P.scr + tid;
#pragma unroll
        for (int r = 0; r < 16; ++r) { sp[r * 512] = outv[0][r]; sp[(16 + r) * 512] = outv[1][r]; }
    }
    {
        const int qsel = lane >> 3, sb = lane & 7;
        unsigned key[16];
#pragma unroll
        for (int i4 = 0; i4 < 4; ++i4) {
            const f32x4 v = *(const LAS f32x4*)(impw + qsel * 128 + sb * 16 + 4 * i4);
#pragma unroll
            for (int e = 0; e < 4; ++e) {
                const int j = sb * 16 + 4 * i4 + e;
                const bool forced = (j == 0) | (j == P.qb) | (j == P.qb - 1);
                key[4 * i4 + e] = forced ? 0xFFFFFFFFu : (j <= P.qb ? __float_as_uint(v[e]) + 1u : 0u);
            }
        }
        unsigned T = 0u;
        for (int bit = 31; bit >= 0; --bit) {
            const unsigned cand = T | (1u << bit);
            int cnt = 0;
#pragma unroll
            for (int i = 0; i < 16; ++i) cnt += key[i] >= cand ? 1 : 0;
            cnt += dpp_i<DPP_XOR1>(cnt); cnt += dpp_i<DPP_XOR2>(cnt); cnt += dpp_i<DPP_HMIRROR>(cnt);
            if (cnt >= 16) T = cand;
        }
        int cgt = 0, ceq = 0;
#pragma unroll
        for (int i = 0; i < 16; ++i) { cgt += key[i] > T ? 1 : 0; ceq += key[i] == T ? 1 : 0; }
        int cg = cgt; cg += dpp_i<DPP_XOR1>(cg); cg += dpp_i<DPP_XOR2>(cg); cg += dpp_i<DPP_HMIRROR>(cg);
        int pre = 0;
#pragma unroll
        for (int k = 0; k < 8; ++k) { const int v = __shfl(ceq, (lane & ~7) + k); if (k < sb) pre += v; }
        int need = 16 - cg - pre;
        unsigned bits = 0u;
#pragma unroll
        for (int i = 0; i < 16; ++i) {
            const int j = sb * 16 + i;
            bool s_ = key[i] > T;
            if (key[i] == T) { if (need > 0) { s_ = true; } --need; }
            if (s_ && j <= P.qb) bits |= 1u << i;
        }
        const unsigned other = __shfl_xor(bits, 1);
        const unsigned word = (sb & 1) ? ((bits << 16) | other) : (bits | (other << 16));
        if ((sb & 1) == 0) { selw[qsel * 4 + (sb >> 1)] = word; __hip_atomic_fetch_or(uni + (sb >> 1), word, __ATOMIC_RELAXED, __HIP_MEMORY_SCOPE_WORKGROUP); }
    }
    __syncthreads();
    unsigned lm0 = selw[q8 * 4 + 0], lm1 = selw[q8 * 4 + 1], lm2 = selw[q8 * 4 + 2], lm3 = selw[q8 * 4 + 3];
    unsigned wm0 = 0, wm1 = 0, wm2 = 0, wm3 = 0;
#pragma unroll
    for (int k = 0; k < 8; ++k) { wm0 |= selw[k * 4 + 0]; wm1 |= selw[k * 4 + 1]; wm2 |= selw[k * 4 + 2]; wm3 |= selw[k * 4 + 3]; }
    wm0 = __builtin_amdgcn_readfirstlane(wm0); wm1 = __builtin_amdgcn_readfirstlane(wm1); wm2 = __builtin_amdgcn_readfirstlane(wm2); wm3 = __builtin_amdgcn_readfirstlane(wm3);
    const unsigned um0 = __builtin_amdgcn_readfirstlane(uni[0]), um1 = __builtin_amdgcn_readfirstlane(uni[1]), um2 = __builtin_amdgcn_readfirstlane(uni[2]), um3 = __builtin_amdgcn_readfirstlane(uni[3]);
#define NSA_WORD(a0, a1, a2, a3, j) ((j) < 32 ? (a0) : ((j) < 64 ? (a1) : ((j) < 96 ? (a2) : (a3))))
#define NSA_NEXT(j, res) do { int _j = (j); res = 128; while (_j < 128) { const unsigned _w = NSA_WORD(um0, um1, um2, um3, _j) >> (_j & 31); if (_w) { res = _j + __builtin_ctz(_w); break; } _j = (_j | 31) + 1; } } while (0)
    o[0] = (f32x16){}; o[1] = (f32x16){}; den = 0.f;
#define NSA_SLC_COMPUTE(JJ, BUF) do { \
        if ((NSA_WORD(wm0, wm1, wm2, wm3, (JJ)) >> ((JJ) & 31)) & 1u) { \
            const bool lsel = (NSA_WORD(lm0, lm1, lm2, lm3, (JJ)) >> ((JJ) & 31)) & 1u; \
            _Pragma("unroll") for (int sub = 0; sub < 2; ++sub) { \
                const int kb = 64 * (JJ) + 32 * sub; \
                if (kb <= twmax) { \
                    f32x16 acc; \
                    if (twmin - kb - 31 >= 1513) acc = splat16(lsel ? cfar : -1e30f); \
                    else { const LAS float* tb = lsel ? tg + hd * GTS + (GTOP - (tq - kb - 4 * hh)) : dead; \
                        _Pragma("unroll") for (int r = 0; r < 16; ++r) acc[r] = tb[(r & 3) + 8 * (r >> 2)]; } \
                    qk_sub<0, 4>(acc, (BUF), sub, qf, lane); \
                    den += exp_sum16(acc); \
                    bf16x8 pa0, pa1; pack_p(acc, pa0, pa1); \
                    pv_sub(o, (BUF), sub, pa0, pa1, lane); \
                } } } } while (0)
#define NSA_SLC_LOAD(JJ, SR) do { const bf16_t* rp_ = P.Hb + (size_t)(64 * (JJ) + srow) * HP; stage_load(SR, rp_ + C_KS, rp_ + C_VS, true, sch); } while (0)
    {
        LAS unsigned char* pb0 = lds + L_KV; LAS unsigned char* pb1 = lds + L_IMP;
        StageRegs a0, a1, b0, b1;
#define NSA_PAIR(prev, ra, rb) do { ra = 128; if ((prev) < 128) { NSA_NEXT((prev) + 1, ra); } rb = 128; if (ra < 128) { NSA_NEXT(ra + 1, rb); } } while (0)
#define NSA_SLC_LOADC(JJ, SR) do { const int jc_ = (JJ) < 128 ? (JJ) : 0; NSA_SLC_LOAD(jc_, SR); } while (0)
        int ca, cb_, n1a, n1b, n2a, n2b, n3a, n3b;
        NSA_NEXT(0, ca); cb_ = 128; if (ca < 128) { NSA_NEXT(ca + 1, cb_); }
        NSA_PAIR(cb_, n1a, n1b); NSA_PAIR(n1b, n2a, n2b);
        NSA_SLC_LOADC(ca, b0); NSA_SLC_LOADC(cb_, b1);
        NSA_SLC_LOADC(n1a, a0); NSA_SLC_LOADC(n1b, a1);
        stage_write(pb0, b0, srow, sch); stage_write(pb0 + KVB, b1, srow, sch);
        NSA_SLC_LOADC(n2a, b0); NSA_SLC_LOADC(n2b, b1);
        __syncthreads();
        for (;;) {
            NSA_SLC_COMPUTE(ca, pb0);
            if (cb_ < 128) NSA_SLC_COMPUTE(cb_, pb0 + KVB);
            stage_write(pb1, a0, srow, sch); stage_write(pb1 + KVB, a1, srow, sch);
            NSA_PAIR(n2b, n3a, n3b);
            NSA_SLC_LOADC(n3a, a0); NSA_SLC_LOADC(n3b, a1);
            __syncthreads();
            if (n1a >= 128) break;
            NSA_SLC_COMPUTE(n1a, pb1);
            if (n1b < 128) NSA_SLC_COMPUTE(n1b, pb1 + KVB);
            stage_write(pb0, b0, srow, sch); stage_write(pb0 + KVB, b1, srow, sch);
            int n4a, n4b; NSA_PAIR(n3b, n4a, n4b);
            NSA_SLC_LOADC(n4a, b0); NSA_SLC_LOADC(n4b, b1);
            __syncthreads();
            if (n2a >= 128) break;
            ca = n2a; cb_ = n2b; n1a = n3a; n1b = n3b; n2a = n4a; n2b = n4b;
        }
#undef NSA_PAIR
#undef NSA_SLC_LOADC
    }
#undef NSA_SLC_COMPUTE
#undef NSA_SLC_LOAD
    {
        const float dt = den + __shfl_xor(den, 32);
        if (hh == 0) ws_[96 + n] = 1.f / dt;
        asm volatile("s_waitcnt lgkmcnt(0)" ::: "memory");
        const float* sp = P.scr + tid;
#pragma unroll
        for (int r = 0; r < 16; ++r) { const float gi = ws_[32 + crow(r, hh)] * ws_[96 + crow(r, hh)]; outv[0][r] = sp[r * 512] + o[0][r] * gi; outv[1][r] = sp[(16 + r) * 512] + o[1][r] * gi; }
    }
    {
#pragma unroll
        for (int r = 0; r < 16; ++r) {
            const int nn = crow(r, hh);
            const size_t trow = (size_t)(64 * P.qb + 8 * w + (nn >> 2));
            const int ycol = 768 + 64 * (nn & 3);
            const bf16_t* sp = P.Hb + trow * HP + C_SILU + ycol;
            bf16_t* yp = P.Y + (P.brow + trow) * DM + ycol;
            yp[n] = f2bf(outv[0][r] * bf2f(sp[n]));
            yp[32 + n] = f2bf(outv[1][r] * bf2f(sp[32 + n]));
        }
    }
    __syncthreads();
#undef NSA_WORD
#undef NSA_NEXT
}
}

#define XB_TMO      128
#define XB_XCNT(j)  (256  + 64 * (j))
#define XB_XSUB(j)  (1280 + 64 * (j))
#define XB_XGEN(j)  (2304 + 64 * (j))
#define XB_TOP      3328
#define XB_TOPGEN   3392
#define XCD_BAR_WORDS 3456
#define XB_SPIN_CAP (1u << 22)
__device__ __forceinline__ unsigned xb_ld(unsigned* p)              { return __hip_atomic_load(p, __ATOMIC_RELAXED, __HIP_MEMORY_SCOPE_AGENT); }
__device__ __forceinline__ unsigned xb_add(unsigned* p, unsigned v) { return __hip_atomic_fetch_add(p, v, __ATOMIC_RELAXED, __HIP_MEMORY_SCOPE_AGENT); }
__device__ __forceinline__ unsigned xb_xcc_id() { return (unsigned)__builtin_amdgcn_s_getreg((3 << 11) | 20) & 0xFu; }
#define XB_SPIN(cond, bar) do { unsigned _sp = 0; while (cond) { __builtin_amdgcn_s_sleep(1); \
    if ((++_sp & 255u) == 0u) { if (xb_ld(&(bar)[XB_TMO])) break; if (_sp > XB_SPIN_CAP) { atomicAdd(&(bar)[XB_TMO], 1u); break; } } } } while (0)
struct XcdBarrier { unsigned* bar; unsigned x; volatile LAS unsigned* st; };
__device__ __forceinline__ XcdBarrier xcd_barrier_post(unsigned* bar, volatile LAS unsigned* st) {
    XcdBarrier b; b.bar = bar; b.x = xb_xcc_id(); b.st = st;
    if (threadIdx.x == 0) (void)xb_add(&bar[XB_XCNT(b.x)], 1u);
    return b;
}
__device__ __forceinline__ void xcd_barrier_complete(unsigned* bar, unsigned x, unsigned& nloc, unsigned& nx) {
    const unsigned G = gridDim.x * gridDim.y * gridDim.z;
    unsigned sum, cnt, mine, sp = 0u;
    for (;;) {
        sum = 0u; cnt = 0u; mine = 0u;
#pragma unroll
        for (unsigned j = 0; j < 16; ++j) { const unsigned c = xb_ld(&bar[XB_XCNT(j)]); sum += c; cnt += (c > 0u) ? 1u : 0u; mine = (j == x) ? c : mine; }
        if (sum == G) break;
        __builtin_amdgcn_s_sleep(1);
        if ((++sp & 255u) == 0u) { if (xb_ld(&bar[XB_TMO])) break; if (sp > XB_SPIN_CAP) { atomicAdd(&bar[XB_TMO], 1u); break; } }
    }
    nloc = mine > 0u ? mine : 1u; nx = cnt > 0u ? cnt : 1u;
}
__device__ __forceinline__ void xcd_barrier(const XcdBarrier& b) {
    asm volatile("s_waitcnt vmcnt(0)" ::: "memory");
    __syncthreads();
    if (threadIdx.x == 0) {
        unsigned* bar = b.bar;
        __builtin_amdgcn_s_waitcnt(0);
        unsigned nloc = b.st[0], nx = b.st[1];
        if (nloc == 0u) { xcd_barrier_complete(bar, b.x, nloc, nx); b.st[0] = nloc; b.st[1] = nx; }
        const unsigned old = xb_add(&bar[XB_XSUB(b.x)], 1u);
        const unsigned gen = old / nloc;
        if (old + 1u == (gen + 1u) * nloc) {
            __builtin_amdgcn_fence(__ATOMIC_RELEASE, "agent");
            asm volatile("s_waitcnt vmcnt(0)" ::: "memory");
            const unsigned og = xb_add(&bar[XB_TOP], 1u);
            const unsigned tg = og / nx;
            if (og + 1u == (tg + 1u) * nx) xb_add(&bar[XB_TOPGEN], 1u);
            else XB_SPIN(xb_ld(&bar[XB_TOPGEN]) == tg, bar);
            __builtin_amdgcn_fence(__ATOMIC_ACQUIRE, "agent");
            xb_add(&bar[XB_XGEN(b.x)], 1u);
            asm volatile("s_waitcnt vmcnt(0)" ::: "memory");
        } else {
            XB_SPIN(xb_ld(&bar[XB_XGEN(b.x)]) == gen, bar);
            __builtin_amdgcn_fence(__ATOMIC_ACQUIRE, "agent");
            asm volatile("s_waitcnt vmcnt(0)" ::: "memory");
        }
    }
    __syncthreads();
}

constexpr int NT = 512, LDS_BYTES = 147456, MISC_OFF = 131072 + 320;
#ifndef R_C
#define R_C 1
#endif
#ifndef R_D
#define R_D 1
#endif
#ifndef R_AB
#define R_AB 1
#endif
#ifndef R_G1
#define R_G1 1
#endif
constexpr size_t MiB = 1u << 20;
constexpr size_t WS_CTL = 0, CTL_ZERO_BYTES = 65536;
constexpr size_t WS_X1B = 158 * MiB;
constexpr size_t OUT_OA = 0, OUT_NSCR = 24 * MiB;
constexpr size_t WS_H = 2 * MiB, WS_XN = 124 * MiB, WS_T0 = 158 * MiB, WS_IMP = 208 * MiB, WS_SEL = 217 * MiB, WS_HID = 218 * MiB, WS_KC = 221 * MiB, WS_VC = 222 * MiB, WS_WIN = 224 * MiB, WS_WOUT = 240 * MiB, WS_MX = 1 * MiB, WS_DA = 245 * MiB, WS_CW1 = 246 * MiB, WS_CW2 = 250 * MiB, WS_RSS = 251 * MiB;

struct Args { const float* in[15]; float* out; unsigned char* ws; };

__global__ void __launch_bounds__(NT, 2) mega_fwd(Args args) {
    extern __shared__ __attribute__((aligned(16))) unsigned char lds[];
    const int tid = threadIdx.x, lane = tid & 63, wid = tid >> 6;
    const int G = gridDim.x, bid = blockIdx.x;
    volatile LAS unsigned* MISC = (volatile LAS unsigned*)((LAS unsigned char*)lds + MISC_OFF);
    if (tid < 32) MISC[tid] = 0u;
    __syncthreads();
    unsigned char* ws = args.ws;
    XcdBarrier bar = xcd_barrier_post((unsigned*)(ws + WS_CTL) + 4096, MISC + 8);
    const float* x = args.in[0]; const float* tab = args.in[1]; const float* norm_w = args.in[2];
    const float* w_in = args.in[3]; const float* w_out = args.in[4]; const float* qk_gain = args.in[5];
    const float* qk_gain_diff = args.in[6]; const float* sinks = args.in[7]; const float* diff_lambda = args.in[8];
    const float* diff_subln = args.in[9]; const float* cmp_pos = args.in[10]; const float* cmp_w1 = args.in[11];
    const float* cmp_b1 = args.in[12]; const float* cmp_w2 = args.in[13]; const float* cmp_b2 = args.in[14];
    float* out = args.out;
    bf16_t* H = (bf16_t*)(ws + WS_H);
    bf16_t* XN = (bf16_t*)(ws + WS_XN); bf16_t* Y = XN;
    float* T0 = (float*)(ws + WS_T0);
    float* OC = T0; float* OS_ = T0 + (size_t)MROWS * 256; float* OW = T0 + (size_t)MROWS * 512; float* CT = T0;
    float* IMP = (float*)(ws + WS_IMP); unsigned* SEL = (unsigned*)(ws + WS_SEL); float* HID = (float*)(ws + WS_HID);
    float* KC = (float*)(ws + WS_KC); float* VC = (float*)(ws + WS_VC);
    const int GT = G * NT, GW = G * 8;
    bf16_t* WinT = (bf16_t*)(ws + WS_WIN); bf16_t* WoutT = (bf16_t*)(ws + WS_WOUT);
#define GRID_BAR() do { XcdBarrier b2_ = bar; asm volatile("" : "+s"(b2_.x)); xcd_barrier(b2_); } while (0)
    {
        LAS float* scr = (LAS float*)((LAS unsigned char*)lds + wid * 16384);
        const int gw0 = bid * 8 + wid;
        constexpr int I_IN = 16 * 120, I_OUT = 16 * 32, I_C1 = 32 * 8, I_C2 = 4 * 2, I_L = I_IN + I_OUT + 2 * I_C1 + 2 * I_C2, NITEMS = 2 * I_L;
        bf16_t* CW1T = (bf16_t*)(ws + WS_CW1); bf16_t* CW2T = (bf16_t*)(ws + WS_CW2);
        if (wid & 1) { for (int w = gw0; w < MROWS; w += 4 * GW) k_rmsnorm<4>(w, GW, lane, x, XN); }
        for (int it = gw0; it < NITEMS; it += GW) {
            const int l = it / I_L; int r = it % I_L;
            if (r < I_IN) { p0_transpose_item<0>(w_in + (size_t)l * DM * PW, WinT + (size_t)l * HP * DM, scr, r, lane, 1024, 1024, norm_w + l * DM); continue; } r -= I_IN;
            if (r < I_OUT) { p0_transpose_item<1>(w_out + (size_t)l * DM * DM, WoutT + (size_t)l * DM * DM, scr, r, lane); continue; } r -= I_OUT;
            if (r < 2 * I_C1) { const int kv = r / I_C1; p0_transpose_item<2>(cmp_w1 + (size_t)(l * 2 + kv) * 2048 * 256, CW1T + (size_t)(l * 2 + kv) * 256 * 2048, scr, r % I_C1, lane, 2048, 256); continue; } r -= 2 * I_C1;
            { const int kv = r / I_C2; p0_transpose_item<1>(cmp_w2 + (size_t)(l * 2 + kv) * 256 * 64, CW2T + (size_t)(l * 2 + kv) * 64 * 256, scr, r % I_C2, lane, 256, 64); }
        }
        if (bid == 1 && tid < 256) { bf16_t* KCb = (bf16_t*)(ws + WS_KC); KCb[(size_t)(tid >> 6) * 512 * 64 + 511 * 64 + (tid & 63)] = 0; }
        if (!(wid & 1)) { for (int w = gw0; w < MROWS; w += 4 * GW) k_rmsnorm<4>(w, GW, lane, x, XN); }
        for (int v = bid * NT + tid; v < MROWS; v += GT) ((unsigned long long*)(ws + WS_RSS))[v] = 0ull;
        if (bid < 4) {
            float* MX = (float*)(ws + WS_MX);
            const int idx = bid * 8 + wid, l = idx >> 4, gh = idx & 15;
            float red[11];
#pragma unroll
            for (int i = 0; i < 8; ++i) red[i] = fabsf(qk_gain[l * 512 + i * 64 + lane]);
            red[8] = lane < 32 ? fabsf(qk_gain_diff[l * 64 + lane]) : 0.f; red[9] = lane < 32 ? fabsf(qk_gain_diff[l * 64 + 32 + lane]) : 0.f;
            red[10] = lane < 32 ? fabsf(tab[lane * 16 + gh]) : 0.f;
            float s1 = lane < 32 ? diff_lambda[l * 128 + lane] * diff_lambda[l * 128 + 32 + lane] : 0.f;
            float s2 = lane < 32 ? diff_lambda[l * 128 + 64 + lane] * diff_lambda[l * 128 + 96 + lane] : 0.f;
            const float snk = sinks[l * 4 + (gh & 3)];
#pragma unroll
            for (int o = 1; o < 64; o <<= 1) {
#pragma unroll
                for (int i = 0; i < 11; ++i) red[i] = fmaxf(red[i], __shfl_xor(red[i], o));
                s1 += __shfl_xor(s1, o); s2 += __shfl_xor(s2, o);
            }
            const int grp = gh >> 2; const float mb = red[10]; float Mv;
            if (grp == 0) Mv = 8.f * red[0] * red[1] + mb;
            else if (grp == 1) Mv = fmaxf(8.f * red[2] * red[3] + mb, snk);
            else if (grp == 2) Mv = 5.656854249f * red[8] * red[9] + mb;
            else Mv = 8.f * red[4] * fmaxf(red[5], fmaxf(red[6], red[7])) + mb;
            if (lane == 0) MX[l * 16 + gh] = Mv;
            if (gh == 0 && lane == 0) { const float lambda_init = 0.8f - 0.6f * expf(-0.3f * (float)l); MX[32 + l] = expf(s1) - expf(s2) + lambda_init; MX[34 + l] = lambda_init; }
        }
    }
    GRID_BAR();
#pragma unroll 1
    for (int l = 0; l < 2; ++l) {
        bf16_t* X1B = (bf16_t*)(ws + WS_X1B);
        { pg8::Gemm g{l == 0 ? XN : X1B, WinT + (size_t)l * HP * DM, MROWS, HP, DM}; pg8::StaticOrder So; So.init(MROWS, HP, G, bid);
          pg8::EpiProj E{H, qk_gain + l * 512, qk_gain_diff + l * 64, l == 0 ? nullptr : (const float*)(ws + WS_RSS)};
          for (int rep = 0; rep < R_G1; ++rep) pg8::gemm_phase<pg8::EpiProj, pg8::StaticOrder, true, true>((LAS unsigned char*)lds, g, So, E); }
        GRID_BAR();
        {
            const float* MX = (const float*)(ws + WS_MX);
            bf16_t* OA = (bf16_t*)((unsigned char*)out + OUT_OA); float* DA = (float*)(ws + WS_DA);
            bf16_t* KCb = (bf16_t*)(ws + WS_KC);
            const bf16_t* CW1T = (const bf16_t*)(ws + WS_CW1); const bf16_t* CW2T = (const bf16_t*)(ws + WS_CW2);
            LAS unsigned* qw = (LAS unsigned*)((LAS unsigned char*)lds + att::L_Q);
            unsigned* qctr = (unsigned*)(ws + WS_CTL) + 8192 + 128 * l;
            unsigned* cdone = qctr + 64;
            constexpr int B0 = 64, B1 = B0 + 160 * R_C, B2 = B1 + 256 * R_D, B3 = B2 + 96 * R_C, B4 = B3 + 768 * R_AB, NUV = B4 + 256 * R_AB;
            for (;;) {
                if (opq(threadIdx.x) == 0) *qw = atomicAdd(qctr, 1u);
                __syncthreads();
                const int uv = (int)*qw;
                __syncthreads();
                if (uv >= NUV) break;
                int u;
                if (uv < B0) u = uv; else if (uv < B1) u = 64 + (uv - B0) / R_C; else if (uv < B2) u = 224 + (uv - B1) / R_D; else if (uv < B3) u = 480 + (uv - B2) / R_C;
                else if (uv < B4) u = 576 + (uv - B3) / R_AB; else u = 1344 + (uv - B4) / R_AB;
                if (u < 64) {
                    const int kv = u >> 5, b = (u >> 4) & 1, rt = u & 15;
                    att::CmpArgs P; P.Hb = H + (size_t)b * S * HP; P.col = kv == 0 ? C_KC : C_VC; P.rt = rt;
                    P.pos = cmp_pos + (size_t)(l * 2 + kv) * 2048; P.W1T = CW1T + (size_t)(l * 2 + kv) * 256 * 2048; P.b1 = cmp_b1 + (l * 2 + kv) * 256;
                    P.W2T = CW2T + (size_t)(l * 2 + kv) * 64 * 256; P.b2 = cmp_b2 + (l * 2 + kv) * 64; P.gain = kv == 0 ? qk_gain + l * 512 + 5 * 64 : nullptr;
                    P.OUT = KCb + (size_t)(kv * NB + b) * 512 * 64;
                    att::cmp_unit((LAS unsigned char*)lds, P);
                    asm volatile("s_waitcnt vmcnt(0)" ::: "memory");
                    __syncthreads();
                    if (opq(threadIdx.x) == 64) { __builtin_amdgcn_fence(__ATOMIC_RELEASE, "agent"); asm volatile("s_waitcnt vmcnt(0)" ::: "memory");
                        __hip_atomic_fetch_add(cdone, 1u, __ATOMIC_RELAXED, __HIP_MEMORY_SCOPE_AGENT); }
                    __syncthreads();
                } else if ((u >= 64 && u < 224) || (u >= 480 && u < 576)) {
                    int qb, bh;
                    if (u < 224) { qb = 31 - ((u - 64) >> 3); bh = (u - 64) & 7; } else { qb = 11 - ((u - 480) >> 3); bh = (u - 480) & 7; }
                    const int b = bh >> 2, hd = bh & 3;
                    att::DiffArgs P; P.Hb = H + (size_t)b * S * HP; P.hd = hd; P.qb = qb; P.brow = (size_t)b * S;
                    P.bias = tab + 8 + hd; P.M = MX[l * 16 + 8 + hd]; P.lam = MX[32 + l]; P.lambda_init = MX[34 + l]; P.subln = diff_subln + l * 64; P.Y = Y;
                    att::diff_unit((LAS unsigned char*)lds, P);
                } else if (u < 480) {
                    const int idx = u - 224, qb64 = 127 - (idx >> 1), b = idx & 1;
                    att::NsaArgs P; P.Hb = H + (size_t)b * S * HP; P.brow = (size_t)b * S; P.qb = qb64;
                    P.KC = KCb + (size_t)(0 * NB + b) * 512 * 64; P.VC = KCb + (size_t)(1 * NB + b) * 512 * 64;
                    P.bias = tab + 12; P.Mv = MX + l * 16 + 12; P.Y = Y; P.cdone = cdone; P.scr = (float*)((unsigned char*)out + OUT_NSCR) + (size_t)bid * 16384;
                    att::nsa_unit((LAS unsigned char*)lds, P);
                } else if (u < 1344) {
                    const int v = u - 576, cfg = v >> 8, b = (v >> 7) & 1, hd = (v >> 5) & 3, ti = v & 31;
                    const int rate = cfg == 0 ? 1 : (cfg == 1 ? 4 : 16), tpc = 32 / rate;
                    att::BandArgs P; P.Hb = H + (size_t)b * S * HP; P.cq = C_AQ + 64 * hd; P.ck = C_AK + 64 * hd; P.cv = C_AV + 64 * hd;
                    P.rate = rate; P.cls = ti / tpc; P.f0 = (ti % tpc) * 256; P.maxd = 128; P.bias = tab + hd; P.M = MX[l * 16 + hd]; P.sinkterm = 0.f;
                    P.OA = OA + (size_t)cfg * MROWS * 256; P.DA = DA + (size_t)cfg * MROWS * 4; P.Y = nullptr; P.ycol = 0; P.hd = hd; P.brow = (size_t)b * S;
                    att::banded_unit<0>((LAS unsigned char*)lds, P);
                } else {
                    const int v = u - 1344, b = (v >> 7) & 1, hd = (v >> 5) & 3, ti = v & 31;
                    att::BandArgs P; P.Hb = H + (size_t)b * S * HP; P.cq = C_BQ + 64 * hd; P.ck = C_BK + 64 * (hd >> 1); P.cv = C_BV + 64 * (hd >> 1);
                    P.rate = 1; P.cls = 0; P.f0 = ti * 256; P.maxd = 127; P.bias = tab + 4 + hd; P.M = MX[l * 16 + 4 + hd];
                    P.sinkterm = __expf(sinks[l * 4 + hd] - P.M);
                    P.OA = nullptr; P.DA = nullptr; P.Y = Y; P.ycol = 256 + 64 * hd; P.hd = hd; P.brow = (size_t)b * S;
                    att::banded_unit<1>((LAS unsigned char*)lds, P);
                }
            }
        }
        GRID_BAR();
        {
            const bf16_t* OA = (const bf16_t*)((unsigned char*)out + OUT_OA); const float* DA = (const float*)(ws + WS_DA);
            for (int v = (bid * NT + opq(threadIdx.x)); v < MROWS * 32; v += GT) {
                const int row = v >> 5, hd = (v >> 3) & 3, c8 = v & 7;
                float acc8[8] = {0.f, 0.f, 0.f, 0.f, 0.f, 0.f, 0.f, 0.f}; float dsum = 0.f;
#pragma unroll
                for (int cfg = 0; cfg < 3; ++cfg) {
                    const float dn = DA[((size_t)cfg * MROWS + row) * 4 + hd]; dsum += dn;
                    const uint4 r4 = *(const uint4*)(OA + ((size_t)cfg * MROWS + row) * 256 + hd * 64 + c8 * 8);
                    acc8[0] += dn * __uint_as_float(r4.x << 16); acc8[1] += dn * __uint_as_float(r4.x & 0xffff0000u);
                    acc8[2] += dn * __uint_as_float(r4.y << 16); acc8[3] += dn * __uint_as_float(r4.y & 0xffff0000u);
                    acc8[4] += dn * __uint_as_float(r4.z << 16); acc8[5] += dn * __uint_as_float(r4.z & 0xffff0000u);
                    acc8[6] += dn * __uint_as_float(r4.w << 16); acc8[7] += dn * __uint_as_float(r4.w & 0xffff0000u);
                }
                const float inv = 1.f / dsum;
                const uint4 s4 = *(const uint4*)(H + (size_t)row * HP + C_SILU + hd * 64 + c8 * 8);
                uint4 o4;
                o4.x = (unsigned)f2bf(acc8[0] * inv * __uint_as_float(s4.x << 16)) | ((unsigned)f2bf(acc8[1] * inv * __uint_as_float(s4.x & 0xffff0000u)) << 16);
                o4.y = (unsigned)f2bf(acc8[2] * inv * __uint_as_float(s4.y << 16)) | ((unsigned)f2bf(acc8[3] * inv * __uint_as_float(s4.y & 0xffff0000u)) << 16);
                o4.z = (unsigned)f2bf(acc8[4] * inv * __uint_as_float(s4.z << 16)) | ((unsigned)f2bf(acc8[5] * inv * __uint_as_float(s4.z & 0xffff0000u)) << 16);
                o4.w = (unsigned)f2bf(acc8[6] * inv * __uint_as_float(s4.w << 16)) | ((unsigned)f2bf(acc8[7] * inv * __uint_as_float(s4.w & 0xffff0000u)) << 16);
                *(uint4*)(Y + (size_t)row * DM + hd * 64 + c8 * 8) = o4;
            }
        }
        GRID_BAR();
        { pg8::Gemm g{Y, WoutT + (size_t)l * DM * DM, MROWS, DM, DM}; pg8::StaticOrder So; So.init(MROWS, DM, G, bid);
          pg8::EpiOut E{l == 0 ? x : nullptr, X1B, out, (LAS float*)((LAS unsigned char*)lds + 132096), X1B, (float*)(ws + WS_RSS)};
          pg8::gemm_phase<pg8::EpiOut, pg8::StaticOrder, true, true>((LAS unsigned char*)lds, g, So, E); }
        if (l == 0) GRID_BAR();
    }
}

extern "C" void kernel_launch(void* const* d_in, const int* in_sizes, int n_in, void* d_out, int out_size, void* d_ws, size_t ws_size, hipStream_t stream) {
    static int grid = 0;
    if (grid == 0) {
        int dev = 0, cus = 0;
        (void)hipGetDevice(&dev);
        (void)hipDeviceGetAttribute(&cus, hipDeviceAttributeMultiprocessorCount, dev);
        (void)hipFuncSetAttribute((const void*)mega_fwd, hipFuncAttributeMaxDynamicSharedMemorySize, LDS_BYTES);
        grid = cus > 0 ? cus : 256;
    }
    (void)hipMemsetAsync((char*)d_ws + WS_CTL, 0, CTL_ZERO_BYTES, stream);
    Args a{};
    for (int i = 0; i < 15; ++i) a.in[i] = (const float*)d_in[i];
    a.out = (float*)d_out; a.ws = (unsigned char*)d_ws;
    hipLaunchKernelGGL(mega_fwd, dim3(grid), dim3(NT), LDS_BYTES, stream, a);
}
```
